# Optimizing an MI355X kernel written in HIP

```python
import math
import jax, jax.numpy as jnp
from jax import lax
import numpy as np

D_MODEL = 1024
BATCH = 8
SEQ = 2048
DEPTH = 4
DEC_BATCH = 128
DEC_SEQ = 1
PAST_LEN = 16384
PAGE_SIZE = 128

N_MIXERS = 3
LAYER_MIXER = tuple(i % N_MIXERS for i in range(DEPTH))
N_RET_LAYERS = LAYER_MIXER.count(0)
N_SSD_LAYERS = LAYER_MIXER.count(1)
N_HG_LAYERS = LAYER_MIXER.count(2)
EPS = 1e-6

RET_HEADS = D_MODEL // 256
RET_QK_DIM = D_MODEL // RET_HEADS
RET_V_DIM = 2 * RET_QK_DIM
RET_CHUNK = 128
ROPE_BASE = 10000.0

SSD_D_INNER = 2 * D_MODEL
SSD_HEAD_DIM = 64
SSD_HEADS = SSD_D_INNER // SSD_HEAD_DIM
SSD_GROUPS = 4
SSD_STATE = 128
SSD_CONV = 4
SSD_CONV_DIM = SSD_D_INNER + 2 * SSD_GROUPS * SSD_STATE
SSD_CHUNK = 128
DT_MIN = 0.001
DT_MAX = 0.1

HG_KEY_DIM = 128
HG_HEADS = D_MODEL // HG_KEY_DIM
HG_VAL_DIM = D_MODEL // HG_HEADS
HG_CHUNK = 64

D_FF = -(-8 * D_MODEL // (3 * 256)) * 256

kernel_name = "hybrid_ret_ssd_hgrn2_adaln_step"


def _rmsnorm(x, w=None):
    y = x * lax.rsqrt(jnp.mean(x * x, axis=-1, keepdims=True) + EPS)
    return y if w is None else y * w


def _rotary(x, pos):
    half = x.shape[-1] // 2
    inv = 1.0 / (ROPE_BASE ** (jnp.arange(half, dtype=jnp.float32) / half))
    ang = pos.astype(jnp.float32)[:, None] * inv[None, :]
    cos = jnp.cos(ang)[None, :, None, :]
    sin = jnp.sin(ang)[None, :, None, :]
    x1, x2 = x[..., :half], x[..., half:]
    return jnp.concatenate([x1 * cos - x2 * sin, x2 * cos + x1 * sin], axis=-1)


def _chunk_recurrence(q, k, v, log_a, h0, chunk):
    B, L = q.shape[0], q.shape[1]
    c = min(chunk, L)
    n = -(-L // c)
    pad = n * c - L

    def prep(t):
        t = t.astype(jnp.float32)
        if pad:
            t = jnp.pad(t, [(0, 0), (0, pad)] + [(0, 0)] * (t.ndim - 2))
        return jnp.moveaxis(t.reshape((B, n, c) + t.shape[2:]), 1, 0)

    qs, ks, vs, las = prep(q), prep(k), prep(v), prep(log_a)
    mask = jnp.tril(jnp.ones((c, c), dtype=bool))
    per_channel = log_a.ndim == 4

    def step(S, blk):
        qc, kc, vc, ac = blk
        cum = jnp.cumsum(ac, axis=1)
        tot = cum[:, -1]
        seg = cum[:, :, None] - cum[:, None]
        if per_channel:
            dec = jnp.exp(jnp.where(mask[None, :, :, None, None], seg, -jnp.inf))
            scores = jnp.einsum('bihk,bjhk,bijhk->bijh', qc, kc, dec)
            q_in = qc * jnp.exp(cum)
            k_out = kc * jnp.exp(tot[:, None] - cum)
            s_dec = jnp.exp(tot)[..., None]
        else:
            dec = jnp.exp(jnp.where(mask[None, :, :, None], seg, -jnp.inf))
            scores = jnp.einsum('bihk,bjhk->bijh', qc, kc) * dec
            q_in = qc * jnp.exp(cum)[..., None]
            k_out = kc * jnp.exp(tot[:, None] - cum)[..., None]
            s_dec = jnp.exp(tot)[..., None, None]
        o = jnp.einsum('bijh,bjhv->bihv', scores, vc) + jnp.einsum('bihk,bhkv->bihv', q_in, S)
        S = S * s_dec + jnp.einsum('bjhk,bjhv->bhkv', k_out, vc)
        return S, o

    S, o = lax.scan(step, h0.astype(jnp.float32), (qs, ks, vs, las))
    o = jnp.moveaxis(o, 0, 1).reshape((B, n * c) + o.shape[3:])[:, :L]
    return o, S


def _retention(h, pos, state, w_in, w_out):
    B, L, _ = h.shape
    qk = RET_HEADS * RET_QK_DIM
    vd = RET_HEADS * RET_V_DIM
    q, k, v, g = jnp.split(h @ w_in, [qk, 2 * qk, 2 * qk + vd], axis=-1)
    q = _rotary(q.reshape(B, L, RET_HEADS, RET_QK_DIM), pos)
    k = _rotary(k.reshape(B, L, RET_HEADS, RET_QK_DIM), pos) * (RET_QK_DIM ** -0.5)
    v = v.reshape(B, L, RET_HEADS, RET_V_DIM)
    log_gamma = jnp.log1p(-jnp.exp2(-5.0 - jnp.arange(RET_HEADS, dtype=jnp.float32)))
    log_a = jnp.broadcast_to(log_gamma, (B, L, RET_HEADS))
    o, new_state = _chunk_recurrence(q, k, v, log_a, state, RET_CHUNK)
    o = _rmsnorm(o).reshape(B, L, vd)
    return (jax.nn.silu(g) * o) @ w_out, new_state


def _ssd(h, state, conv_buf, w_in, conv_w, conv_b, dt_bias, a_log, d_skip, norm_w, w_out):
    B, L, _ = h.shape
    z, xbc, dt = jnp.split(h @ w_in, [SSD_D_INNER, SSD_D_INNER + SSD_CONV_DIM], axis=-1)
    xpad = jnp.concatenate([conv_buf.astype(jnp.float32), xbc], axis=1)
    conv = conv_b + sum(xpad[:, w:w + L] * conv_w[w] for w in range(SSD_CONV))
    new_buf = xpad[:, L:]
    xbc = jax.nn.silu(conv)
    gn = SSD_GROUPS * SSD_STATE
    xs, bm, cm = jnp.split(xbc, [SSD_D_INNER, SSD_D_INNER + gn], axis=-1)
    dt = jax.nn.softplus(dt + dt_bias)
    a = -jnp.exp(a_log.astype(jnp.float32))
    xs = xs.reshape(B, L, SSD_HEADS, SSD_HEAD_DIM)
    rep = SSD_HEADS // SSD_GROUPS
    bm = jnp.repeat(bm.reshape(B, L, SSD_GROUPS, SSD_STATE), rep, axis=2)
    cm = jnp.repeat(cm.reshape(B, L, SSD_GROUPS, SSD_STATE), rep, axis=2)
    y, new_state = _chunk_recurrence(cm, bm, xs * dt[..., None], dt * a, state, SSD_CHUNK)
    y = y + d_skip[:, None] * xs
    y = y.reshape(B, L, SSD_D_INNER) * jax.nn.silu(z)
    y = _rmsnorm(y.reshape(B, L, SSD_GROUPS, SSD_D_INNER // SSD_GROUPS)).reshape(B, L, SSD_D_INNER) * norm_w
    return y @ w_out, new_state, new_buf


def _hgrn2(h, state, lb, w_in, norm_w, w_out):
    B, L, _ = h.shape
    kd = HG_HEADS * HG_KEY_DIM
    vd = HG_HEADS * HG_VAL_DIM
    q, f, i, g = jnp.split(h @ w_in, [kd, 2 * kd, 2 * kd + vd], axis=-1)
    q = jax.nn.silu(q).reshape(B, L, HG_HEADS, HG_KEY_DIM) * (HG_KEY_DIM ** -0.5)
    f = lb + (1.0 - lb) * jax.nn.sigmoid(f)
    k = (1.0 - f).reshape(B, L, HG_HEADS, HG_KEY_DIM)
    log_a = jnp.log(f).reshape(B, L, HG_HEADS, HG_KEY_DIM)
    v = i.reshape(B, L, HG_HEADS, HG_VAL_DIM)
    o, new_state = _chunk_recurrence(q, k, v, log_a, state, HG_CHUNK)
    o = _rmsnorm(o, norm_w).reshape(B, L, vd) * jax.nn.silu(g)
    return o @ w_out, new_state


def _swiglu(h, w_in, w_out):
    gate, up = jnp.split(h @ w_in, 2, axis=-1)
    return (jax.nn.silu(gate) * up) @ w_out


def _trunk(x, c, pos0, h_ret, h_ssd, conv_buf, h_hg, p):
    B, L, _ = x.shape
    x = x.astype(jnp.float32)
    pos = pos0 + jnp.arange(L, dtype=jnp.int32)
    c_act = jax.nn.silu(c.astype(jnp.float32))
    lb = jnp.cumsum(jax.nn.softmax(p['hg_lb_logits'].astype(jnp.float32), axis=0), axis=0)
    lb = lb - lb[:1]
    new_ret, new_ssd, new_conv, new_hg = [], [], [], []
    for layer in range(DEPTH):
        mod = c_act @ p['w_ada'][layer] + p['b_ada'][layer]
        sh_m, sc_m, g_m, sh_f, sc_f, g_f = [m[:, None, :] for m in jnp.split(mod, 6, axis=-1)]
        h = _rmsnorm(x, p['norm_mix_pre'][layer]) * (1.0 + sc_m) + sh_m
        kind = LAYER_MIXER[layer]
        j = LAYER_MIXER[:layer].count(kind)
        if kind == 0:
            out, s = _retention(h, pos, h_ret[j], p['ret_w_in'][j], p['ret_w_out'][j])
            new_ret.append(s)
        elif kind == 1:
            out, s, buf = _ssd(h, h_ssd[j], conv_buf[j], p['ssd_w_in'][j], p['ssd_conv_w'][j],
                               p['ssd_conv_b'][j], p['ssd_dt_bias'][j], p['ssd_a_log'][j],
                               p['ssd_d'][j], p['ssd_norm'][j], p['ssd_w_out'][j])
            new_ssd.append(s)
            new_conv.append(buf)
        else:
            out, s = _hgrn2(h, h_hg[j], lb[layer], p['hg_w_in'][j], p['hg_norm'][j], p['hg_w_out'][j])
            new_hg.append(s)
        x = x + g_m * _rmsnorm(out, p['norm_mix_post'][layer])
        h = _rmsnorm(x, p['norm_ffn_pre'][layer]) * (1.0 + sc_f) + sh_f
        x = x + g_f * _rmsnorm(_swiglu(h, p['ffn_w_in'][layer], p['ffn_w_out'][layer]), p['norm_ffn_post'][layer])
    return x, jnp.stack(new_ret), jnp.stack(new_ssd), jnp.stack(new_conv), jnp.stack(new_hg)


def setup_inputs(seed: int = 0) -> dict:
    key = jax.random.key(seed)
    keys = iter(jax.random.split(key, 32))

    def nrm(shape, scale):
        return scale * jax.random.normal(next(keys), shape, jnp.float32)

    def gain(shape):
        return 1.0 + nrm(shape, 0.05)

    D = D_MODEL
    ret_in = 2 * RET_HEADS * RET_QK_DIM + 2 * RET_HEADS * RET_V_DIM
    ssd_in = 2 * SSD_D_INNER + 2 * SSD_GROUPS * SSD_STATE + SSD_HEADS
    hg_in = 2 * HG_HEADS * HG_KEY_DIM + 2 * HG_HEADS * HG_VAL_DIM
    dt = jnp.exp(jax.random.uniform(next(keys), (N_SSD_LAYERS, SSD_HEADS), jnp.float32,
                                    math.log(DT_MIN), math.log(DT_MAX)))
    a_log = jnp.log(jax.random.uniform(next(keys), (N_SSD_LAYERS, SSD_HEADS), jnp.float32, 1.0, 16.0))
    return {
        'x_prompt': nrm((BATCH, SEQ, D), 1.0),
        'x_sample': nrm((DEC_BATCH, DEC_SEQ, D), 1.0),
        'c_prompt': nrm((BATCH, D), 1.0),
        'c_sample': nrm((DEC_BATCH, D), 1.0),
        'state_ret': nrm((N_RET_LAYERS, DEC_BATCH, RET_HEADS, RET_QK_DIM, RET_V_DIM), 0.1),
        'state_ssd': nrm((N_SSD_LAYERS, DEC_BATCH, SSD_HEADS, SSD_STATE, SSD_HEAD_DIM), 0.1),
        'state_conv': nrm((N_SSD_LAYERS, DEC_BATCH, SSD_CONV - 1, SSD_CONV_DIM), 1.0),
        'state_hgrn': nrm((N_HG_LAYERS, DEC_BATCH, HG_HEADS, HG_KEY_DIM, HG_VAL_DIM), 0.3),
        'w_ada': nrm((DEPTH, D, 6 * D), 0.5 * D ** -0.5),
        'b_ada': nrm((DEPTH, 6 * D), 0.1),
        'norm_mix_pre': gain((DEPTH, D)),
        'norm_mix_post': gain((DEPTH, D)),
        'norm_ffn_pre': gain((DEPTH, D)),
        'norm_ffn_post': gain((DEPTH, D)),
        'ret_w_in': nrm((N_RET_LAYERS, D, ret_in), D ** -0.5),
        'ret_w_out': nrm((N_RET_LAYERS, RET_HEADS * RET_V_DIM, D), (RET_HEADS * RET_V_DIM) ** -0.5),
        'ssd_w_in': nrm((N_SSD_LAYERS, D, ssd_in), D ** -0.5),
        'ssd_conv_w': nrm((N_SSD_LAYERS, SSD_CONV, SSD_CONV_DIM), SSD_CONV ** -0.5),
        'ssd_conv_b': nrm((N_SSD_LAYERS, SSD_CONV_DIM), 0.02),
        'ssd_dt_bias': dt + jnp.log(-jnp.expm1(-dt)),
        'ssd_a_log': a_log,
        'ssd_d': gain((N_SSD_LAYERS, SSD_HEADS)),
        'ssd_norm': gain((N_SSD_LAYERS, SSD_D_INNER)),
        'ssd_w_out': nrm((N_SSD_LAYERS, SSD_D_INNER, D), SSD_D_INNER ** -0.5),
        'hg_w_in': nrm((N_HG_LAYERS, D, hg_in), D ** -0.5),
        'hg_lb_logits': nrm((DEPTH, HG_HEADS * HG_KEY_DIM), 1.0),
        'hg_norm': gain((N_HG_LAYERS, HG_VAL_DIM)),
        'hg_w_out': nrm((N_HG_LAYERS, HG_HEADS * HG_VAL_DIM, D), (HG_HEADS * HG_VAL_DIM) ** -0.5),
        'ffn_w_in': nrm((DEPTH, D, 2 * D_FF), D ** -0.5),
        'ffn_w_out': nrm((DEPTH, D_FF, D), D_FF ** -0.5),
    }


def reference(x_prompt, x_sample, c_prompt, c_sample, state_ret, state_ssd, state_conv, state_hgrn,
              w_ada, b_ada, norm_mix_pre, norm_mix_post, norm_ffn_pre, norm_ffn_post,
              ret_w_in, ret_w_out, ssd_w_in, ssd_conv_w, ssd_conv_b, ssd_dt_bias, ssd_a_log,
              ssd_d, ssd_norm, ssd_w_out, hg_w_in, hg_lb_logits, hg_norm, hg_w_out,
              ffn_w_in, ffn_w_out):
    p = dict(w_ada=w_ada, b_ada=b_ada, norm_mix_pre=norm_mix_pre, norm_mix_post=norm_mix_post,
             norm_ffn_pre=norm_ffn_pre, norm_ffn_post=norm_ffn_post,
             ret_w_in=ret_w_in, ret_w_out=ret_w_out,
             ssd_w_in=ssd_w_in, ssd_conv_w=ssd_conv_w, ssd_conv_b=ssd_conv_b,
             ssd_dt_bias=ssd_dt_bias, ssd_a_log=ssd_a_log, ssd_d=ssd_d, ssd_norm=ssd_norm,
             ssd_w_out=ssd_w_out, hg_w_in=hg_w_in, hg_lb_logits=hg_lb_logits, hg_norm=hg_norm,
             hg_w_out=hg_w_out, ffn_w_in=ffn_w_in, ffn_w_out=ffn_w_out)
    bp = x_prompt.shape[0]
    f32 = jnp.float32
    ret0 = jnp.zeros((N_RET_LAYERS, bp, RET_HEADS, RET_QK_DIM, RET_V_DIM), f32)
    ssd0 = jnp.zeros((N_SSD_LAYERS, bp, SSD_HEADS, SSD_STATE, SSD_HEAD_DIM), f32)
    conv0 = jnp.zeros((N_SSD_LAYERS, bp, SSD_CONV - 1, SSD_CONV_DIM), f32)
    hg0 = jnp.zeros((N_HG_LAYERS, bp, HG_HEADS, HG_KEY_DIM, HG_VAL_DIM), f32)
    y_p, ret_p, ssd_p, conv_p, hg_p = _trunk(x_prompt, c_prompt, 0, ret0, ssd0, conv0, hg0, p)
    y_s, ret_s, ssd_s, conv_s, hg_s = _trunk(x_sample, c_sample, PAST_LEN, state_ret, state_ssd,
                                             state_conv, state_hgrn, p)
    return (y_p.astype(x_prompt.dtype), y_s.astype(x_sample.dtype),
            ret_p.astype(state_ret.dtype), ret_s.astype(state_ret.dtype),
            ssd_p.astype(state_ssd.dtype), ssd_s.astype(state_ssd.dtype),
            conv_p.astype(state_conv.dtype), conv_s.astype(state_conv.dtype),
            hg_p.astype(state_hgrn.dtype), hg_s.astype(state_hgrn.dtype))
```

```cpp
#include <hip/hip_runtime.h>
#include <cstdio>
#include <cstdint>
namespace pg8 {
#define PG8_LAS __attribute__((address_space(3)))
typedef unsigned short bf16_t;
typedef short bf16x8 __attribute__((ext_vector_type(8)));
typedef float f32x4 __attribute__((ext_vector_type(4)));
typedef unsigned u32x4 __attribute__((ext_vector_type(4)));
constexpr int BM = 256, BK = 64, HALF = 128, HTB = HALF * BK * 2  , STAGE_BYTES = 8 * HTB, NXCD = 8, WGM = 8;

__host__ __device__ __forceinline__ int lds_byte(int r, int c) { const int st = (r >> 4) * 2 + (c >> 5), rr = r & 15, cc = c & 31, ob = rr * 64 + cc * 2; return st * 1024 + (ob ^ (((ob >> 9) & 1) << 5)); }
__host__ __device__ __forceinline__ void stage_rc(int b, int& R, int& C) { const int st = b / 1024, sb = b % 1024, swz = sb ^ (((sb >> 9) & 1) << 5); R = (st >> 1) * 16 + swz / 64; C = (st & 1) * 32 + (swz % 64) / 2; }
__host__ __device__ __forceinline__ int perm32(int rho) { const int n = rho >> 4, i = rho & 15; return 8 * (i >> 2) + 4 * n + (i & 3); }

struct Unit { int pm, pn; };
struct Gemm { const bf16_t* A; const bf16_t* Bt; int M, N, K; };

struct StaticOrder {
    int nM, nN, nwg, G, c;
    __host__ __device__ void init(int M, int N, int G_, int c_) { nM = M / BM; nN = N / BM; nwg = nM * nN; G = G_; c = c_; }
    __host__ __device__ bool next(int i, Unit& u) const {
        const long L = (long)i * G + c; if (L >= nwg) return false;
        int wgid = (int)L; { const int q = nwg / NXCD, r = nwg % NXCD, xcd = wgid % NXCD, off = wgid / NXCD; wgid = (xcd < r ? xcd * (q + 1) : r * (q + 1) + (xcd - r) * q) + off; }
        const int nig = WGM * nN, gid = wgid / nig, fm = gid * WGM, gsz = (nM - fm) < WGM ? (nM - fm) : WGM;
        u.pm = fm + ((wgid % nig) % gsz); u.pn = (wgid % nig) / gsz; return true;
    }
    __device__ __forceinline__ void a_ready(const Unit&) const {}
    __device__ __forceinline__ void done(const Unit&) const {}
};

__device__ __forceinline__ unsigned cvt_pk_bf16(float lo, float hi) { unsigned r; asm volatile("v_cvt_pk_bf16_f32 %0, %1, %2" : "=v"(r) : "v"(lo), "v"(hi)); return r; }
typedef float f32x2 __attribute__((ext_vector_type(2)));
template <class Epi, class Sched, bool ALIGN_EPI = false, bool SP2 = false>
__device__ __forceinline__ void gemm_phase(PG8_LAS unsigned char* lds, const Gemm g, const Sched& S, const Epi& E) {
    const int tid = threadIdx.x, wid = __builtin_amdgcn_readfirstlane(tid >> 6), lane = tid & 63, wr = wid >> 2, wc = wid & 3, fr = lane & 15, fq = lane >> 4;
    const int K = g.K, nt = K / BK;
    unsigned voffA[2], voffB[2];
#pragma unroll
    for (int i = 0; i < 2; ++i) { int R, C; stage_rc(tid * 16 + i * 8192, R, C); const int Rb = Epi::PERM ? ((R & ~31) + perm32(R & 31)) : R;
        voffA[i] = (unsigned)(R * K + C) * 2u; voffB[i] = (unsigned)(Rb * K + C) * 2u; }
    const size_t kstep = (size_t)(BK * 2);
    const size_t hstep = (size_t)HALF * K * 2;
    const size_t tstep = 2 * hstep;
    const unsigned ldsw = (unsigned)wid * 1024u;
    const int aoff = lds_byte(wr * 64 + fr, fq * 8), boff = lds_byte(wc * 32 + fr, fq * 8);
#define PG8_SA(b, h) (((b) * 2 + (h)) * HTB)
#define PG8_SB(b, h) ((4 + (b) * 2 + (h)) * HTB)
#define PG8_STAGE(bufoff, gbase, voff) do { _Pragma("unroll") for (int _i = 0; _i < 2; ++_i) \
        __builtin_amdgcn_global_load_lds((const unsigned*)((const char*)(gbase) + (voff)[_i]), (PG8_LAS unsigned*)(lds + (bufoff) + ldsw + _i * 8192), 16, 0, 0); } while (0)
#define PG8_LDA(dst, b, h) do { _Pragma("unroll") for (int m = 0; m < 4; ++m) _Pragma("unroll") for (int k = 0; k < 2; ++k) dst[m][k] = *(const PG8_LAS bf16x8*)(lds + PG8_SA(b, h) + aoff + m * 2048 + k * 1024); } while (0)
#define PG8_LDB(dst, b, h) do { _Pragma("unroll") for (int n = 0; n < 2; ++n) _Pragma("unroll") for (int k = 0; k < 2; ++k) dst[n][k] = *(const PG8_LAS bf16x8*)(lds + PG8_SB(b, h) + boff + n * 2048 + k * 1024); } while (0)
#define PG8_MMA(ai, bj, At, Bt) do { __builtin_amdgcn_s_setprio(1); _Pragma("unroll") for (int m = 0; m < 4; ++m) _Pragma("unroll") for (int n = 0; n < 2; ++n) _Pragma("unroll") for (int k = 0; k < 2; ++k) \
        acc[ai][bj][m][n] = __builtin_amdgcn_mfma_f32_16x16x32_bf16(Bt[n][k], At[m][k], acc[ai][bj][m][n], 0, 0, 0); __builtin_amdgcn_s_setprio(0); } while (0)
#define PG8_WAIT_V(n) asm volatile("s_waitcnt vmcnt(" #n ")" ::: "memory")
#define PG8_WAIT_L(n) asm volatile("s_waitcnt lgkmcnt(" #n ")" ::: "memory")
#define PG8_BAR __builtin_amdgcn_s_barrier()
#define PG8_SCHED __builtin_amdgcn_sched_barrier(0)
    Unit cur, nxt; int ui = 0;
    if (!S.next(0, cur)) return;
    f32x4 acc[2][2][4][2];
#pragma unroll
    for (int a = 0; a < 2; ++a)
#pragma unroll
        for (int b = 0; b < 2; ++b)
#pragma unroll
            for (int m = 0; m < 4; ++m)
#pragma unroll
                for (int n = 0; n < 2; ++n) acc[a][b][m][n] = (f32x4){0.f, 0.f, 0.f, 0.f};
    bf16x8 At[4][2], B0[2][2], B1[2][2];
    const char* cA = (const char*)g.A + (size_t)cur.pm * tstep; const char* cB = (const char*)g.Bt + (size_t)cur.pn * tstep;
    S.a_ready(cur);
    if constexpr (SP2) {
        PG8_STAGE(PG8_SB(0, 0), cB, voffB); PG8_STAGE(PG8_SB(0, 1), cB + hstep, voffB); PG8_STAGE(PG8_SA(0, 0), cA, voffA); PG8_STAGE(PG8_SA(0, 1), cA + hstep, voffA);
        if (wr == 1) PG8_BAR;
        PG8_WAIT_V(2); PG8_BAR;
        PG8_STAGE(PG8_SB(1, 0), cB + kstep, voffB); PG8_STAGE(PG8_SA(1, 0), cA + kstep, voffA); PG8_STAGE(PG8_SB(1, 1), cB + hstep + kstep, voffB);
        PG8_WAIT_V(6); PG8_BAR;
    } else {
        PG8_STAGE(PG8_SB(0, 0), cB, voffB); PG8_STAGE(PG8_SA(0, 0), cA, voffA); PG8_STAGE(PG8_SB(0, 1), cB + hstep, voffB); PG8_STAGE(PG8_SA(0, 1), cA + hstep, voffA);
        if (wr == 1) PG8_BAR;
        PG8_WAIT_V(4); PG8_BAR;
        PG8_STAGE(PG8_SB(1, 0), cB + kstep, voffB); PG8_STAGE(PG8_SA(1, 0), cA + kstep, voffA); PG8_STAGE(PG8_SB(1, 1), cB + hstep + kstep, voffB);
        PG8_WAIT_V(6); PG8_BAR;
    }
    for (;;) {
        const bool has_next = S.next(ui + 1, nxt);
        const char* nA = has_next ? (const char*)g.A + (size_t)nxt.pm * tstep : cA; const char* nB = has_next ? (const char*)g.Bt + (size_t)nxt.pn * tstep : cB;
        for (int t = 0; t < nt; t += 2) {
            const bool last = (t == nt - 2);
            const char* a1 = cA + (size_t)(t + 1) * kstep;
            const char* a2 = last ? nA : cA + (size_t)(t + 2) * kstep; const char* b2 = last ? nB : cB + (size_t)(t + 2) * kstep;
            const char* a3 = a2 + kstep; const char* b3 = b2 + kstep;
            if (last && has_next) S.a_ready(nxt);
            if constexpr (SP2) {
            PG8_LDB(B0, 0, 0); PG8_LDB(B1, 0, 1); PG8_SCHED; PG8_LDA(At, 0, 0); PG8_STAGE(PG8_SA(1, 1), a1 + hstep, voffA);
            PG8_WAIT_V(8); PG8_WAIT_L(0); PG8_BAR; PG8_MMA(0, 0, At, B0); PG8_MMA(0, 1, At, B1); PG8_BAR; PG8_SCHED;
            PG8_LDA(At, 0, 1); PG8_STAGE(PG8_SB(0, 0), b2, voffB); PG8_STAGE(PG8_SB(0, 1), b2 + hstep, voffB); PG8_STAGE(PG8_SA(0, 0), a2, voffA);
            PG8_WAIT_V(8); PG8_WAIT_L(0); PG8_BAR; PG8_MMA(1, 0, At, B0); PG8_MMA(1, 1, At, B1); PG8_BAR; PG8_SCHED;
            PG8_LDB(B0, 1, 0); PG8_LDB(B1, 1, 1); PG8_SCHED; PG8_LDA(At, 1, 0); PG8_STAGE(PG8_SA(0, 1), a2 + hstep, voffA);
            PG8_WAIT_V(8); PG8_WAIT_L(0); PG8_BAR; PG8_MMA(0, 0, At, B0); PG8_MMA(0, 1, At, B1); PG8_BAR; PG8_SCHED;
            PG8_LDA(At, 1, 1); PG8_STAGE(PG8_SB(1, 0), b3, voffB); PG8_STAGE(PG8_SB(1, 1), b3 + hstep, voffB); PG8_STAGE(PG8_SA(1, 0), a3, voffA);
            PG8_WAIT_V(8); PG8_WAIT_L(0); PG8_BAR; PG8_MMA(1, 0, At, B0); PG8_MMA(1, 1, At, B1); PG8_BAR; PG8_SCHED;
            } else {
            PG8_LDB(B0, 0, 0); PG8_SCHED; PG8_LDA(At, 0, 0); PG8_STAGE(PG8_SA(1, 1), a1 + hstep, voffA);
            PG8_WAIT_L(8); PG8_BAR; PG8_WAIT_L(0); PG8_MMA(0, 0, At, B0); PG8_BAR; PG8_SCHED;
            PG8_LDB(B1, 0, 1); PG8_STAGE(PG8_SB(0, 0), b2, voffB);
            PG8_BAR; PG8_WAIT_L(0); PG8_MMA(0, 1, At, B1); PG8_BAR;
            PG8_LDA(At, 0, 1); PG8_STAGE(PG8_SA(0, 0), a2, voffA);
            PG8_BAR; PG8_WAIT_L(0); PG8_MMA(1, 0, At, B0); PG8_BAR; PG8_SCHED;
            PG8_STAGE(PG8_SB(0, 1), b2 + hstep, voffB);
            PG8_WAIT_V(6); PG8_BAR; PG8_MMA(1, 1, At, B1); PG8_BAR;
            PG8_LDB(B0, 1, 0); PG8_SCHED; PG8_LDA(At, 1, 0); PG8_STAGE(PG8_SA(0, 1), a2 + hstep, voffA);
            PG8_WAIT_L(8); PG8_BAR; PG8_WAIT_L(0); PG8_MMA(0, 0, At, B0); PG8_BAR; PG8_SCHED;
            PG8_LDB(B1, 1, 1); PG8_STAGE(PG8_SB(1, 0), b3, voffB);
            PG8_BAR; PG8_WAIT_L(0); PG8_MMA(0, 1, At, B1); PG8_BAR;
            PG8_LDA(At, 1, 1); PG8_STAGE(PG8_SA(1, 0), a3, voffA);
            PG8_BAR; PG8_WAIT_L(0); PG8_MMA(1, 0, At, B0); PG8_BAR; PG8_SCHED;
            PG8_STAGE(PG8_SB(1, 1), b3 + hstep, voffB);
            PG8_WAIT_V(6); PG8_BAR; PG8_MMA(1, 1, At, B1); PG8_BAR;
            }
        }
        if constexpr (ALIGN_EPI) { if (wr == 0) PG8_BAR; }
        if constexpr (!Epi::AFTER_DRAIN) { E(acc, cur, wr, wc, fr, fq); S.done(cur); }
        if (!has_next) break;
#pragma unroll
        for (int a = 0; a < 2; ++a)
#pragma unroll
            for (int b = 0; b < 2; ++b)
#pragma unroll
                for (int m = 0; m < 4; ++m)
#pragma unroll
                    for (int n = 0; n < 2; ++n) acc[a][b][m][n] = (f32x4){0.f, 0.f, 0.f, 0.f};
        cur = nxt; cA = nA; cB = nB; ++ui;
        if constexpr (ALIGN_EPI) { if (wr == 1) PG8_BAR; }
    }
    PG8_WAIT_V(0);
    if constexpr (!ALIGN_EPI) { if (wr == 0) PG8_BAR; }
    PG8_BAR;
    if constexpr (Epi::AFTER_DRAIN) { E.fused(acc, cur, wr, wc, fr, fq, lds, wid, lane); S.done(cur); }
#undef PG8_SA
#undef PG8_SB
#undef PG8_STAGE
#undef PG8_LDA
#undef PG8_LDB
#undef PG8_MMA
#undef PG8_WAIT_V
#undef PG8_WAIT_L
#undef PG8_BAR
#undef PG8_SCHED
}
}

#ifndef PG8_SP2
#define PG8_SP2 true
#endif
#ifndef PG8_ALIGN
#define PG8_ALIGN true
#endif
#ifndef MK_N_LAUNCHES
#define MK_N_LAUNCHES 35
#endif

constexpr int D = 1024, BP = 8, SEQ = 2048, MPR = BP * SEQ  , MS = 128  , MT = MPR + MS  ;
constexpr int NCOND = BP + MS;
constexpr int DFF = 2816, NMOD = 6 * D  , NMODALL = 4 * NMOD  ;
constexpr int RET_IN = 6144, SSD_IN = 5152, SSD_INM = 5120, HG_IN = 4096, FFN_IN = 2 * DFF;
constexpr float EPS = 1e-6f;
constexpr int NWAVES = 8;

constexpr size_t MiB = 1u << 20;
constexpr size_t WS_CTL = 0, CTL_ZERO_BYTES = 1 * MiB;
constexpr size_t WS_WADA = 1 * MiB;
constexpr size_t WS_WRETIN = WS_WADA + 48 * MiB;
constexpr size_t WS_WRETOUT = WS_WRETIN + 24 * MiB;
constexpr size_t WS_WSSDIN = WS_WRETOUT + 8 * MiB;
constexpr size_t WS_WSSDOUT = WS_WSSDIN + 11 * MiB;
constexpr size_t WS_WHGIN = WS_WSSDOUT + 4 * MiB;
constexpr size_t WS_WHGOUT = WS_WHGIN + 8 * MiB;
constexpr size_t WS_WFFNIN = WS_WHGOUT + 2 * MiB;
constexpr size_t WS_WFFNOUT = WS_WFFNIN + 44 * MiB;
constexpr size_t WS_MOD = WS_WFFNOUT + 22 * MiB;
constexpr size_t WS_CACT = WS_MOD + 24 * MiB;
constexpr size_t WS_LB = WS_CACT + 512 * 1024;
constexpr size_t WS_H = WS_CACT + 1 * MiB;
constexpr size_t WS_PROJ = WS_H + 33 * MiB;
constexpr size_t WS_RO = WS_PROJ + 200 * MiB;
constexpr size_t WS_GO = WS_RO + 65 * MiB;
constexpr size_t WS_OUT = WS_GO + 65 * MiB;
constexpr size_t WS_ACT = WS_OUT + 33 * MiB;
constexpr size_t WS_END = WS_ACT + 89 * MiB;
constexpr size_t PJ_RET_Q = 0, PJ_RET_K = PJ_RET_Q + (size_t)MT * 1024 * 2, PJ_RET_V = PJ_RET_K + (size_t)MT * 1024 * 2, PJ_RET_SG = PJ_RET_V + (size_t)MT * 2048 * 2;
constexpr size_t PJ_SSD_SZ = 0, PJ_SSD_XBC = PJ_SSD_SZ + (size_t)MT * 2048 * 2, PJ_SSD_DT = PJ_SSD_XBC + (size_t)MT * 3072 * 2;
constexpr size_t PJ_HG_Q = 0, PJ_HG_LA = PJ_HG_Q + (size_t)MT * 1024 * 2, PJ_HG_V = PJ_HG_LA + (size_t)MT * 1024 * 4, PJ_HG_SG = PJ_HG_V + (size_t)MT * 1024 * 2;
static_assert(PJ_RET_SG + (size_t)MT * 2048 * 2 <= 200 * MiB && PJ_SSD_DT + (size_t)MT * 32 * 4 <= 200 * MiB && PJ_HG_SG + (size_t)MT * 1024 * 2 <= 200 * MiB, "proj map");
constexpr int CW_BAR = 4096;

constexpr size_t O_Y = 0;
constexpr size_t O_RETP = (size_t)MT * D;
constexpr size_t O_RETS = O_RETP + (size_t)2 * 8 * 4 * 256 * 512;
constexpr size_t O_SSDP = O_RETS + (size_t)2 * 128 * 4 * 256 * 512;
constexpr size_t O_SSDS = O_SSDP + (size_t)8 * 32 * 128 * 64;
constexpr size_t O_CONVP = O_SSDS + (size_t)128 * 32 * 128 * 64;
constexpr size_t O_CONVS = O_CONVP + (size_t)8 * 3 * 3072;
constexpr size_t O_HGP = O_CONVS + (size_t)128 * 3 * 3072;
constexpr size_t O_HGS = O_HGP + (size_t)8 * 8 * 128 * 128;
constexpr size_t O_END = O_HGS + (size_t)128 * 8 * 128 * 128;
static_assert(O_END == 214245376ull, "output size");

constexpr int LDS_BYTES = 147456;
constexpr int LDSCTL_OFF = LDS_BYTES - 1024;
constexpr int SCR_BYTES = LDSCTL_OFF;

#define GAS __attribute__((address_space(1)))
#define LAS __attribute__((address_space(3)))
typedef unsigned short bf16;
typedef unsigned v4u __attribute__((ext_vector_type(4)));
typedef unsigned v2u __attribute__((ext_vector_type(2)));
typedef float f32x4 __attribute__((ext_vector_type(4)));
typedef short bf16x8 __attribute__((ext_vector_type(8)));
typedef short s16x4 __attribute__((ext_vector_type(4)));
typedef GAS unsigned gu32;
#define RLX_AGENT __ATOMIC_RELAXED, __HIP_MEMORY_SCOPE_AGENT
#define LDS_WAIT() asm volatile("s_waitcnt lgkmcnt(0)" ::: "memory")
#define VM_WAIT() asm volatile("s_waitcnt vmcnt(0)" ::: "memory")
typedef float f32x2_t __attribute__((ext_vector_type(2))); typedef __bf16 bf16x2_t __attribute__((ext_vector_type(2)));
__device__ __forceinline__ unsigned cvt_pk_bf16(float lo, float hi) { f32x2_t v = {lo, hi}; bf16x2_t b = __builtin_convertvector(v, bf16x2_t); return __builtin_bit_cast(unsigned, b); }
__device__ __forceinline__ float bf2f(unsigned b) { return __uint_as_float(b << 16); }
__device__ __forceinline__ float bflo(unsigned w) { return __uint_as_float(w << 16); }
__device__ __forceinline__ float bfhi(unsigned w) { return __uint_as_float(w & 0xffff0000u); }
__device__ __forceinline__ void unpack8(const v4u w, float (&f)[8]) { f[0] = bflo(w.x); f[1] = bfhi(w.x); f[2] = bflo(w.y); f[3] = bfhi(w.y); f[4] = bflo(w.z); f[5] = bfhi(w.z); f[6] = bflo(w.w); f[7] = bfhi(w.w); }
__device__ __forceinline__ v4u pack8(const float (&f)[8]) { v4u w; w.x = cvt_pk_bf16(f[0], f[1]); w.y = cvt_pk_bf16(f[2], f[3]); w.z = cvt_pk_bf16(f[4], f[5]); w.w = cvt_pk_bf16(f[6], f[7]); return w; }
__device__ __forceinline__ v4u pack8v(const f32x4 a, const f32x4 b) { v4u w; w.x = cvt_pk_bf16(a[0], a[1]); w.y = cvt_pk_bf16(a[2], a[3]); w.z = cvt_pk_bf16(b[0], b[1]); w.w = cvt_pk_bf16(b[2], b[3]); return w; }
__device__ __forceinline__ v2u pack4v(const f32x4 a) { v2u w; w.x = cvt_pk_bf16(a[0], a[1]); w.y = cvt_pk_bf16(a[2], a[3]); return w; }
__device__ __forceinline__ float sigmoidf_(float x) { return __builtin_amdgcn_rcpf(1.f + __expf(-x)); }
__device__ __forceinline__ float siluf_(float x) { return x * sigmoidf_(x); }
__device__ __forceinline__ float softplusf_(float x) { return x > 20.f ? x : log1pf(__expf(x)); }
__device__ __forceinline__ float wave_sum(float v) {
#pragma unroll
    for (int o = 1; o < 64; o <<= 1) v += __shfl_xor(v, o);
    return v;
}
__device__ __forceinline__ float grp16_sum(float v) {
#pragma unroll
    for (int o = 1; o < 16; o <<= 1) v += __shfl_xor(v, o);
    return v;
}
#define MFMA16(a, b, c) __builtin_amdgcn_mfma_f32_16x16x32_bf16((a), (b), (c), 0, 0, 0)
#define XB_TMO      128
#define XB_XCNT(j)  (256  + 64 * (j))
#define XB_XSUB(j)  (1280 + 64 * (j))
#define XB_XGEN(j)  (2304 + 64 * (j))
#define XB_TOP      3328
#define XB_TOPGEN   3392
#define XCD_BAR_WORDS 3456
#define XB_SPIN_CAP (1u << 18)

__device__ __forceinline__ unsigned xb_ld(unsigned* p)              { return __hip_atomic_load(p, __ATOMIC_RELAXED, __HIP_MEMORY_SCOPE_AGENT); }
__device__ __forceinline__ unsigned xb_add(unsigned* p, unsigned v) { return __hip_atomic_fetch_add(p, v, __ATOMIC_RELAXED, __HIP_MEMORY_SCOPE_AGENT); }
__device__ __forceinline__ unsigned xb_xcc_id() { return (unsigned)__builtin_amdgcn_s_getreg((3 << 11) | 20) & 0xFu; }
#define XB_SPIN(cond, bar) do { unsigned _sp = 0; while (cond) { __builtin_amdgcn_s_sleep(1); \
    if ((++_sp & 255u) == 0u) { if (xb_ld(&(bar)[XB_TMO])) break; if (_sp > XB_SPIN_CAP) { atomicAdd(&(bar)[XB_TMO], 1u); break; } } } } while (0)

struct XcdBarrier {
    unsigned* bar; unsigned x;
    volatile LAS unsigned* st;
};

__device__ __forceinline__ XcdBarrier xcd_barrier_post(unsigned* bar, volatile LAS unsigned* st) {
    XcdBarrier b; b.bar = bar; b.x = xb_xcc_id(); b.st = st;
    if (threadIdx.x == 0) (void)xb_add(&bar[XB_XCNT(b.x)], 1u);
    return b;
}
__device__ __forceinline__ void xcd_barrier_complete(unsigned* bar, unsigned x, unsigned& nloc, unsigned& nx) {
    const unsigned G = gridDim.x * gridDim.y * gridDim.z;
    unsigned sum, cnt, mine, sp = 0u;
    for (;;) {
        sum = 0u; cnt = 0u; mine = 0u;
#pragma unroll
        for (unsigned j = 0; j < 16; ++j) { const unsigned c = xb_ld(&bar[XB_XCNT(j)]); sum += c; cnt += (c > 0u) ? 1u : 0u; mine = (j == x) ? c : mine; }
        if (sum == G) break;
        __builtin_amdgcn_s_sleep(1);
        if ((++sp & 255u) == 0u) { if (xb_ld(&bar[XB_TMO])) break; if (sp > XB_SPIN_CAP) { atomicAdd(&bar[XB_TMO], 1u); break; } }
    }
    nloc = mine > 0u ? mine : 1u; nx = cnt > 0u ? cnt : 1u;
}

__device__ __forceinline__ void xcd_barrier(const XcdBarrier& b) {
    asm volatile("s_waitcnt vmcnt(0)" ::: "memory");
    __syncthreads();
    if (threadIdx.x == 0) {
        unsigned* bar = b.bar;
        __builtin_amdgcn_s_waitcnt(0);
        unsigned nloc = b.st[0], nx = b.st[1];
        if (nloc == 0u) { xcd_barrier_complete(bar, b.x, nloc, nx); b.st[0] = nloc; b.st[1] = nx; }
        const unsigned old = xb_add(&bar[XB_XSUB(b.x)], 1u);
        const unsigned gen = old / nloc;
        if (old + 1u == (gen + 1u) * nloc) {
            __builtin_amdgcn_fence(__ATOMIC_RELEASE, "agent");
            asm volatile("s_waitcnt vmcnt(0)" ::: "memory");
            const unsigned og = xb_add(&bar[XB_TOP], 1u);
            const unsigned tg = og / nx;
            if (og + 1u == (tg + 1u) * nx) xb_add(&bar[XB_TOPGEN], 1u);
            else XB_SPIN(xb_ld(&bar[XB_TOPGEN]) == tg, bar);
            __builtin_amdgcn_fence(__ATOMIC_ACQUIRE, "agent");
            xb_add(&bar[XB_XGEN(b.x)], 1u);
            asm volatile("s_waitcnt vmcnt(0)" ::: "memory");
        } else {
            XB_SPIN(xb_ld(&bar[XB_XGEN(b.x)]) == gen, bar);
            __builtin_amdgcn_fence(__ATOMIC_ACQUIRE, "agent");
            asm volatile("s_waitcnt vmcnt(0)" ::: "memory");
        }
    }
    __syncthreads();
}


struct Frame {
    LAS unsigned char* lds;
    int tid, lane, wave;
    int vcu, G;
};

template <class Fn> struct EpiGen {
    static constexpr bool PERM = true, AFTER_DRAIN = false;
    Fn f;
    __device__ __forceinline__ void operator()(const pg8::f32x4 (&acc)[2][2][4][2], const pg8::Unit& u, int wr, int wc, int fr, int fq) const {
        const int ca = u.pn * 256 + wc * 32 + 8 * fq;
#pragma unroll
        for (int ai = 0; ai < 2; ++ai)
#pragma unroll
            for (int m = 0; m < 4; ++m) {
                const int row = u.pm * 256 + ai * 128 + wr * 64 + m * 16 + fr;
                f.emit(row, ca, ca + 128, acc[ai][0][m][0], acc[ai][0][m][1], acc[ai][1][m][0], acc[ai][1][m][1]);
            }
    }
};
__device__ __forceinline__ void st8bf(bf16* p, const f32x4 a, const f32x4 b) { *(GAS v4u*)p = pack8v(a, b); }
__device__ __forceinline__ f32x4 silu4(const f32x4 a) { f32x4 r; r[0] = siluf_(a[0]); r[1] = siluf_(a[1]); r[2] = siluf_(a[2]); r[3] = siluf_(a[3]); return r; }

struct EmitRetIn {
    bf16 *Q, *K, *V, *SG;
    __device__ __forceinline__ void emit(int row, int ca, int cb, const f32x4 a0, const f32x4 a1, const f32x4 b0, const f32x4 b1) const {
        const int pn = ca >> 8, ch = ca & 255;
        if (pn < 8) {
            const float pos = row < MPR ? (float)(row & (SEQ - 1)) : 16384.f;
            const float sc = pn < 4 ? 1.f : 0.0625f;
            float x1[8] = {a0[0], a0[1], a0[2], a0[3], a1[0], a1[1], a1[2], a1[3]}, x2[8] = {b0[0], b0[1], b0[2], b0[3], b1[0], b1[1], b1[2], b1[3]}, o1[8], o2[8];
#pragma unroll
            for (int e = 0; e < 8; ++e) {
                const float inv = exp2f(-(float)(ch + e) * (13.287712379549449f / 128.f));
                float t = pos * inv * 0.15915494309189535f; t -= floorf(t);
                const float s = __builtin_amdgcn_sinf(t), c = __builtin_amdgcn_cosf(t);
                o1[e] = (x1[e] * c - x2[e] * s) * sc; o2[e] = (x2[e] * c + x1[e] * s) * sc;
            }
            bf16* dst = (pn < 4 ? Q : K) + (size_t)row * 1024 + (pn & 3) * 256 + ch;
            *(GAS v4u*)dst = pack8(o1); *(GAS v4u*)(dst + 128) = pack8(o2);
        } else if (pn < 16) {
            bf16* dst = V + (size_t)row * 2048 + (pn - 8) * 256 + ch; st8bf(dst, a0, a1); st8bf(dst + 128, b0, b1);
        } else {
            bf16* dst = SG + (size_t)row * 2048 + (pn - 16) * 256 + ch; st8bf(dst, silu4(a0), silu4(a1)); st8bf(dst + 128, silu4(b0), silu4(b1));
        }
    }
};
struct EmitSsdIn {
    bf16 *SZ, *XBC;
    __device__ __forceinline__ void emit(int row, int ca, int cb, const f32x4 a0, const f32x4 a1, const f32x4 b0, const f32x4 b1) const {
        const int pn = ca >> 8, ch = ca & 255;
        if (pn < 8) { bf16* dst = SZ + (size_t)row * 2048 + pn * 256 + ch; st8bf(dst, silu4(a0), silu4(a1)); st8bf(dst + 128, silu4(b0), silu4(b1)); }
        else { bf16* dst = XBC + (size_t)row * 3072 + (pn - 8) * 256 + ch; st8bf(dst, a0, a1); st8bf(dst + 128, b0, b1); }
    }
};
struct EmitDt {
    float* DT;
    __device__ __forceinline__ void emit(int row, int ca, int cb, const f32x4 a0, const f32x4 a1, const f32x4 b0, const f32x4 b1) const {
        float* d = DT + (size_t)row * 32; *(GAS f32x4*)(d + (ca - SSD_INM)) = a0; *(GAS f32x4*)(d + (ca - SSD_INM) + 4) = a1; *(GAS f32x4*)(d + (cb - SSD_INM)) = b0; *(GAS f32x4*)(d + (cb - SSD_INM) + 4) = b1;
    }
};
struct EmitHgIn {
    bf16 *HQ, *HV, *HSG; float* LA; const float* lb;
    __device__ __forceinline__ f32x4 logf4(const f32x4 x, const float* l) const { f32x4 r;
#pragma unroll
        for (int e = 0; e < 4; ++e) { const float b = l[e]; r[e] = logf(b + (1.f - b) * sigmoidf_(x[e])); } return r; }
    __device__ __forceinline__ void emit(int row, int ca, int cb, const f32x4 a0, const f32x4 a1, const f32x4 b0, const f32x4 b1) const {
        const int pn = ca >> 8, ch = ca & 255;
        if (pn < 4) { bf16* dst = HQ + (size_t)row * 1024 + pn * 256 + ch; const float s = 0.08838834764831845f; st8bf(dst, silu4(a0) * s, silu4(a1) * s); st8bf(dst + 128, silu4(b0) * s, silu4(b1) * s); }
        else if (pn < 8) { const int col = (pn - 4) * 256 + ch; float* dst = LA + (size_t)row * 1024 + col;
            *(GAS f32x4*)dst = logf4(a0, lb + col); *(GAS f32x4*)(dst + 4) = logf4(a1, lb + col + 4); *(GAS f32x4*)(dst + 128) = logf4(b0, lb + col + 128); *(GAS f32x4*)(dst + 132) = logf4(b1, lb + col + 132); }
        else if (pn < 12) { bf16* dst = HV + (size_t)row * 1024 + (pn - 8) * 256 + ch; st8bf(dst, a0, a1); st8bf(dst + 128, b0, b1); }
        else { bf16* dst = HSG + (size_t)row * 1024 + (pn - 12) * 256 + ch; st8bf(dst, silu4(a0), silu4(a1)); st8bf(dst + 128, silu4(b0), silu4(b1)); }
    }
};
struct EmitOut {
    bf16* OUT;
    __device__ __forceinline__ void emit(int row, int ca, int cb, const f32x4 a0, const f32x4 a1, const f32x4 b0, const f32x4 b1) const {
        bf16* dst = OUT + (size_t)row * 1024; st8bf(dst + ca, a0, a1); st8bf(dst + cb, b0, b1);
    }
};
struct EmitFfnIn {
    bf16* ACT;
    __device__ __forceinline__ void emit(int row, int ca, int cb, const f32x4 a0, const f32x4 a1, const f32x4 b0, const f32x4 b1) const {
        bf16* dst = ACT + (size_t)row * DFF + (ca >> 8) * 128 + (ca & 255); st8bf(dst, silu4(a0) * b0, silu4(a1) * b1);
    }
};
struct EmitMod {
    float* MOD; const float* bias;
    __device__ __forceinline__ void emit(int row, int ca, int cb, const f32x4 a0, const f32x4 a1, const f32x4 b0, const f32x4 b1) const {
        float* d = MOD + (size_t)row * NMODALL;
        *(GAS f32x4*)(d + ca) = a0 + *(const GAS f32x4*)(bias + ca); *(GAS f32x4*)(d + ca + 4) = a1 + *(const GAS f32x4*)(bias + ca + 4);
        *(GAS f32x4*)(d + cb) = b0 + *(const GAS f32x4*)(bias + cb); *(GAS f32x4*)(d + cb + 4) = b1 + *(const GAS f32x4*)(bias + cb + 4);
    }
};

template <class Fn>
__device__ __forceinline__ void skinny_gemm(Frame& F, const bf16* A, int K, int nrg, int rowbase, const bf16* Bt, int ncu, bool dtmode, const Fn& f, int wg0) {
    const int w = F.wave, lane = F.lane, fr = lane & 15, fq = lane >> 4, KW = K >> 3;
    LAS float* red = (LAS float*)F.lds;
    const int nun = nrg * ncu;
    int first = (F.vcu - wg0) % F.G; if (first < 0) first += F.G;
    for (int u = first; u < nun; u += F.G) {
        const int rg = u / ncu, cu = u - rg * ncu;
        int ca, cb; if (dtmode) { ca = SSD_INM; cb = SSD_INM + 16; } else { ca = 256 * (cu >> 3) + 16 * (cu & 7); cb = ca + 128; }
        const bf16* ap = A + (size_t)(rg * 128 + fr) * K + w * KW + fq * 8;
        const bf16* bpa = Bt + (size_t)(ca + fr) * K + w * KW + fq * 8;
        const bf16* bpb = Bt + (size_t)(cb + fr) * K + w * KW + fq * 8;
        f32x4 acc[8][2];
#pragma unroll
        for (int mt = 0; mt < 8; ++mt) { acc[mt][0] = (f32x4){0.f, 0.f, 0.f, 0.f}; acc[mt][1] = (f32x4){0.f, 0.f, 0.f, 0.f}; }
        for (int k0 = 0; k0 < KW; k0 += 32) {
            const bf16x8 b0 = *(const GAS bf16x8*)(bpa + k0), b1 = *(const GAS bf16x8*)(bpb + k0);
            bf16x8 a[8];
#pragma unroll
            for (int mt = 0; mt < 8; ++mt) a[mt] = *(const GAS bf16x8*)(ap + (size_t)mt * 16 * K + k0);
#pragma unroll
            for (int mt = 0; mt < 8; ++mt) { acc[mt][0] = MFMA16(a[mt], b0, acc[mt][0]); acc[mt][1] = MFMA16(a[mt], b1, acc[mt][1]); }
        }
        __syncthreads();
#pragma unroll
        for (int mt = 0; mt < 8; ++mt)
#pragma unroll
            for (int nt = 0; nt < 2; ++nt)
#pragma unroll
                for (int r = 0; r < 4; ++r) red[(w * 128 + mt * 16 + fq * 4 + r) * 33 + nt * 16 + fr] = acc[mt][nt][r];
        __syncthreads();
        if (F.tid < 256) {
            const int row = F.tid >> 1, hf = F.tid & 1;
            float va[8], vb[8];
#pragma unroll
            for (int e = 0; e < 8; ++e) { va[e] = 0.f; vb[e] = 0.f; }
#pragma unroll
            for (int ww = 0; ww < 8; ++ww) { const LAS float* p = red + (ww * 128 + row) * 33 + hf * 8;
#pragma unroll
                for (int e = 0; e < 8; ++e) { va[e] += p[e]; vb[e] += p[16 + e]; } }
            f.emit(rowbase + rg * 128 + row, ca + hf * 8, cb + hf * 8, (f32x4){va[0], va[1], va[2], va[3]}, (f32x4){va[4], va[5], va[6], va[7]}, (f32x4){vb[0], vb[1], vb[2], vb[3]}, (f32x4){vb[4], vb[5], vb[6], vb[7]});
        }
    }
    __syncthreads();
}
static_assert(8 * 128 * 33 * 4 <= SCR_BYTES, "skinny reduction buffer");

__device__ __forceinline__ int cond_of_row(int row) { return row < MPR ? (row >> 11) : (BP + row - MPR); }
template <int MODE>
__device__ __forceinline__ void resnorm_phase(Frame& F, const float* xp, const float* xs, float* X, const bf16* Y, bf16* H, const float* MOD,
                                              const float* wpost, int goff, const float* wpre, int shoff, int scoff) {
    const int gw = F.vcu * NWAVES + F.wave, NGW = F.G * NWAVES, lane = F.lane;
    for (int row = gw; row < MT; row += NGW) {
        const float* modr = MOD + (size_t)cond_of_row(row) * NMODALL;
        f32x4 x[4];
        if (MODE == 0) {
            const float* src = row < MPR ? xp + (size_t)row * D : xs + (size_t)(row - MPR) * D;
#pragma unroll
            for (int j = 0; j < 4; ++j) x[j] = *(const GAS f32x4*)(src + 4 * lane + 256 * j);
        } else {
            f32x4 y[4]; float ss = 0.f;
#pragma unroll
            for (int j = 0; j < 4; ++j) { x[j] = *(const GAS f32x4*)(X + (size_t)row * D + 4 * lane + 256 * j);
                const v2u yw = *(const GAS v2u*)(Y + (size_t)row * D + 4 * lane + 256 * j);
                y[j] = (f32x4){bflo(yw.x), bfhi(yw.x), bflo(yw.y), bfhi(yw.y)};
                ss += (y[j][0] * y[j][0] + y[j][1] * y[j][1]) + (y[j][2] * y[j][2] + y[j][3] * y[j][3]); }
            const float r1 = rsqrtf(wave_sum(ss) * (1.f / D) + EPS);
#pragma unroll
            for (int j = 0; j < 4; ++j) { const f32x4 g = *(const GAS f32x4*)(modr + goff + 4 * lane + 256 * j), wp = *(const GAS f32x4*)(wpost + 4 * lane + 256 * j);
                x[j] = x[j] + g * (y[j] * r1) * wp; }
        }
#pragma unroll
        for (int j = 0; j < 4; ++j) *(GAS f32x4*)(X + (size_t)row * D + 4 * lane + 256 * j) = x[j];
        if (MODE != 2) {
            float s2 = 0.f;
#pragma unroll
            for (int j = 0; j < 4; ++j) s2 += (x[j][0] * x[j][0] + x[j][1] * x[j][1]) + (x[j][2] * x[j][2] + x[j][3] * x[j][3]);
            const float r2 = rsqrtf(wave_sum(s2) * (1.f / D) + EPS);
#pragma unroll
            for (int j = 0; j < 4; ++j) { const int c = 4 * lane + 256 * j;
                const f32x4 wp = *(const GAS f32x4*)(wpre + c), sc = *(const GAS f32x4*)(modr + scoff + c), sh = *(const GAS f32x4*)(modr + shoff + c);
                const f32x4 h = (x[j] * r2) * wp * (sc + 1.f) + sh;
                *(GAS v2u*)(H + (size_t)row * D + c) = pack4v(h); }
        }
    }
}
template <int MIX>
__device__ __forceinline__ void gatenorm_phase(Frame& F, const bf16* RO, const bf16* GATE, bf16* GO, const float* nw) {
    const int gw = F.vcu * NWAVES + F.wave, NGW = F.G * NWAVES, lane = F.lane;
    constexpr int W = (MIX == 2) ? 1024 : 2048, NJ = W / 512;
    for (int row = gw; row < MT; row += NGW) {
        float u[NJ][8], r[NJ];
#pragma unroll
        for (int j = 0; j < NJ; ++j) {
            const int c = 8 * lane + 512 * j;
            float o[8], g[8];
            unpack8(*(const GAS v4u*)(RO + (size_t)row * W + c), o); unpack8(*(const GAS v4u*)(GATE + (size_t)row * W + c), g);
            float ss = 0.f;
#pragma unroll
            for (int e = 0; e < 8; ++e) {
                if (MIX == 0) { u[j][e] = o[e] * g[e]; ss += o[e] * o[e]; }
                else if (MIX == 1) { u[j][e] = o[e] * g[e]; ss += u[j][e] * u[j][e]; }
                else { u[j][e] = o[e] * g[e]; ss += o[e] * o[e]; }
            }
            if (MIX == 2) r[j] = rsqrtf(grp16_sum(ss) * (1.f / 128.f) + EPS); else r[j] = rsqrtf(wave_sum(ss) * (1.f / 512.f) + EPS);
        }
#pragma unroll
        for (int j = 0; j < NJ; ++j) {
            const int c = 8 * lane + 512 * j;
            float v[8];
#pragma unroll
            for (int e = 0; e < 8; ++e) { float wgt = 1.f; if (MIX == 1) wgt = nw[c + e]; if (MIX == 2) wgt = nw[(c + e) & 127]; v[e] = u[j][e] * r[j] * wgt; }
            *(GAS v4u*)(GO + (size_t)row * W + c) = pack8(v);
        }
    }
}

template <int OFF> __device__ __forceinline__ bf16x8 tr_frag(unsigned addr) {
    s16x4 lo, hi;
    asm volatile("ds_read_b64_tr_b16 %0, %2\n\tds_read_b64_tr_b16 %1, %2 offset:%3\n\ts_waitcnt lgkmcnt(0)" : "=&v"(lo), "=&v"(hi) : "v"(addr), "i"(OFF) : "memory");
    return __builtin_shufflevector(lo, hi, 0, 1, 2, 3, 4, 5, 6, 7);
}
template <int OFF> __device__ __forceinline__ void tr_frag2(unsigned a0, unsigned a1, bf16x8& f0, bf16x8& f1) {
    s16x4 l0, h0, l1, h1;
    asm volatile("ds_read_b64_tr_b16 %0, %4\n\tds_read_b64_tr_b16 %1, %4 offset:%6\n\tds_read_b64_tr_b16 %2, %5\n\tds_read_b64_tr_b16 %3, %5 offset:%6\n\ts_waitcnt lgkmcnt(0)"
                 : "=&v"(l0), "=&v"(h0), "=&v"(l1), "=&v"(h1) : "v"(a0), "v"(a1), "i"(OFF) : "memory");
    f0 = __builtin_shufflevector(l0, h0, 0, 1, 2, 3, 4, 5, 6, 7); f1 = __builtin_shufflevector(l1, h1, 0, 1, 2, 3, 4, 5, 6, 7);
}

template <class Cf, class OutFn>
__device__ __forceinline__ void rec_step(LAS unsigned char* lds, const int w, const int lane, f32x4 (&S)[Cf::KPW][Cf::VS / 16], const LAS float* cum, const OutFn& out, const int tok0) {
    constexpr int C = Cf::C, KD = Cf::KD, VS = Cf::VS, NIT = C / 16, NJT = C / 16, NVT = VS / 16, KSK = KD / 32, KSC = C / 32;
    constexpr int RSK = Cf::RSK, RSV = Cf::RSV, RSP = Cf::RSP;
    constexpr bool CH = Cf::CH;
    const int fr = lane & 15, fq = lane >> 4, q4 = fr >> 2, p4 = fr & 3;
    const unsigned lbase = (unsigned)(size_t)lds;
    constexpr int NP = NIT * NJT, PPW = (NP + 7) / 8;
#pragma unroll
    for (int tt = 0; tt < PPW; ++tt) { const int t = w + 8 * tt;
        if (t < NP) { const int it = t / NJT, jt = t % NJT;
            f32x4 p = (f32x4){0.f, 0.f, 0.f, 0.f};
            if (jt <= it) {
#pragma unroll
                for (int ks = 0; ks < KSK; ++ks) {
                    const bf16x8 a = *(const LAS bf16x8*)(lds + Cf::KA + (16 * jt + fr) * RSK + (32 * ks + 8 * fq) * 2);
                    const bf16x8 b = *(const LAS bf16x8*)(lds + Cf::QA + (16 * it + fr) * RSK + (32 * ks + 8 * fq) * 2);
                    p = MFMA16(a, b, p); }
                const int i = 16 * it + fr;
                if (!CH) { const float ci = cum[i];
#pragma unroll
                    for (int r = 0; r < 4; ++r) { const int j = 16 * jt + 4 * fq + r; const float e = __expf(fminf(ci - cum[j], 0.f)); p[r] = (j <= i) ? p[r] * e : 0.f; } }
                else {
#pragma unroll
                    for (int r = 0; r < 4; ++r) { const int j = 16 * jt + 4 * fq + r; p[r] = (j <= i) ? p[r] : 0.f; } }
            }
            *(LAS v2u*)(lds + Cf::PM + (16 * it + fr) * RSP + (16 * jt + 4 * fq) * 2) = pack4v(p);
        } }
    constexpr int NO = NVT * NIT, OPW = (NO + 7) / 8;
    f32x4 O[OPW];
#pragma unroll
    for (int tt = 0; tt < OPW; ++tt) { const int t = w + 8 * tt; O[tt] = (f32x4){0.f, 0.f, 0.f, 0.f};
        if (t < NO) { const int vt = t / NIT, it = t % NIT; f32x4 o = (f32x4){0.f, 0.f, 0.f, 0.f};
#pragma unroll
            for (int ks = 0; ks < KSK; ++ks) {
                const bf16x8 a = *(const LAS bf16x8*)(lds + Cf::ST + (16 * vt + fr) * RSK + (32 * ks + 8 * fq) * 2);
                const bf16x8 b = *(const LAS bf16x8*)(lds + Cf::QB + (16 * it + fr) * RSK + (32 * ks + 8 * fq) * 2);
                o = MFMA16(a, b, o); }
            if (!CH) o = o * __expf(cum[16 * it + fr]);
            O[tt] = o; } }
#pragma unroll
    for (int ki = 0; ki < Cf::KPW; ++ki) { const int kt = w + 8 * ki;
        if (!CH) { const float d = __expf(cum[C - 1]);
#pragma unroll
            for (int vt = 0; vt < NVT; ++vt) S[ki][vt] = S[ki][vt] * d; }
        else { const LAS float* ds = (const LAS float*)(lds + Cf::DS) + 16 * kt + 4 * fq; const f32x4 d = (f32x4){ds[0], ds[1], ds[2], ds[3]};
#pragma unroll
            for (int vt = 0; vt < NVT; ++vt) S[ki][vt] = S[ki][vt] * d; }
#pragma unroll
        for (int ks = 0; ks < KSC; ++ks) {
            const bf16x8 a = tr_frag<4 * RSK>(lbase + Cf::KB + (32 * ks + 8 * fq + q4) * RSK + (16 * kt + 4 * p4) * 2);
#pragma unroll
            for (int vt = 0; vt < NVT; vt += 2) { bf16x8 b0, b1;
                tr_frag2<4 * RSV>(lbase + Cf::VB + (32 * ks + 8 * fq + q4) * RSV + (16 * vt + 4 * p4) * 2, lbase + Cf::VB + (32 * ks + 8 * fq + q4) * RSV + (16 * (vt + 1) + 4 * p4) * 2, b0, b1);
                S[ki][vt] = MFMA16(a, b0, S[ki][vt]); S[ki][vt + 1] = MFMA16(a, b1, S[ki][vt + 1]); } } }
    __syncthreads();
#pragma unroll
    for (int tt = 0; tt < OPW; ++tt) { const int t = w + 8 * tt;
        if (t < NO) { const int vt = t / NIT, it = t % NIT; f32x4 o = O[tt];
#pragma unroll
            for (int ks = 0; ks < KSC; ++ks) {
                const bf16x8 a = tr_frag<4 * RSV>(lbase + Cf::V + (32 * ks + 8 * fq + q4) * RSV + (16 * vt + 4 * p4) * 2);
                const bf16x8 b = *(const LAS bf16x8*)(lds + Cf::PM + (16 * it + fr) * RSP + (32 * ks + 8 * fq) * 2);
                o = MFMA16(a, b, o); }
            out(tok0 + 16 * it + fr, 16 * it + fr, 16 * vt + 4 * fq, o); } }
#pragma unroll
    for (int ki = 0; ki < Cf::KPW; ++ki) { const int kt = w + 8 * ki;
#pragma unroll
        for (int vt = 0; vt < NVT; ++vt) *(LAS v2u*)(lds + Cf::ST + (16 * vt + fr) * RSK + (16 * kt + 4 * fq) * 2) = pack4v(S[ki][vt]); }
    __syncthreads();
}
template <class Cf> __device__ __forceinline__ void rec_zero_state(Frame& F, f32x4 (&S)[Cf::KPW][Cf::VS / 16]) {
#pragma unroll
    for (int ki = 0; ki < Cf::KPW; ++ki)
#pragma unroll
        for (int vt = 0; vt < Cf::VS / 16; ++vt) S[ki][vt] = (f32x4){0.f, 0.f, 0.f, 0.f};
    for (int o = F.tid * 16; o < Cf::VS * Cf::RSK; o += 512 * 16) *(LAS v4u*)(F.lds + Cf::ST + o) = (v4u){0u, 0u, 0u, 0u};
}
template <class Cf> __device__ __forceinline__ void rec_store_state(Frame& F, const f32x4 (&S)[Cf::KPW][Cf::VS / 16], float* dst, int ldv) {
    const int fr = F.lane & 15, fq = F.lane >> 4;
#pragma unroll
    for (int ki = 0; ki < Cf::KPW; ++ki) { const int kt = F.wave + 8 * ki;
#pragma unroll
        for (int vt = 0; vt < Cf::VS / 16; ++vt)
#pragma unroll
            for (int r = 0; r < 4; ++r) dst[(size_t)(16 * kt + 4 * fq + r) * ldv + 16 * vt + fr] = S[ki][vt][r]; }
}

struct CfRet { static constexpr int C = 64, KD = 256, VS = 64, KPW = 2, RSK = 528, RSV = 144, RSP = 144; static constexpr bool CH = false;
    static constexpr int QA = 0, KA = 33792, QB = QA, KB = KA, V = 67584, VB = 76800, PM = 86016, ST = 95232, CUM = 129024, DS = 0, END = 129280; };
static_assert(CfRet::END <= SCR_BYTES, "ret lds");
struct RetOut { bf16* dst;
    __device__ __forceinline__ void operator()(int tok, int i, int vv0, const f32x4 o) const { *(GAS v2u*)(dst + (size_t)tok * 2048 + vv0) = pack4v(o); } };
__device__ __forceinline__ void ret_prompt_item(Frame& F, int item, const bf16* Q, const bf16* K, const bf16* V, bf16* RO, float* st_out) {
    const int b = item >> 5, h = (item >> 3) & 3, vs = item & 7, tid = F.tid;
    const float lg = logf(1.f - exp2f(-5.f - (float)h));
    LAS float* cum = (LAS float*)(F.lds + CfRet::CUM);
    __syncthreads();
    if (tid < 64) cum[tid] = (float)(tid + 1) * lg;
    f32x4 S[CfRet::KPW][4];
    rec_zero_state<CfRet>(F, S);
    const bf16* qg = Q + (size_t)(b * SEQ) * 1024 + h * 256; const bf16* kg = K + (size_t)(b * SEQ) * 1024 + h * 256; const bf16* vg = V + (size_t)(b * SEQ) * 2048 + h * 512 + vs * 64;
    const RetOut out{RO + (size_t)(b * SEQ) * 2048 + h * 512 + vs * 64};
    v4u qr[4], kr[4], vr;
#pragma unroll
    for (int i = 0; i < 4; ++i) { const int pc = tid + 512 * i, row = pc >> 5, c16 = pc & 31; qr[i] = *(const GAS v4u*)(qg + (size_t)row * 1024 + c16 * 8); kr[i] = *(const GAS v4u*)(kg + (size_t)row * 1024 + c16 * 8); }
    vr = *(const GAS v4u*)(vg + (size_t)(tid >> 3) * 2048 + (tid & 7) * 8);
    const float vsc = __expf((float)(63 - (tid >> 3)) * lg);
    for (int c = 0; c < SEQ / 64; ++c) {
#pragma unroll
        for (int i = 0; i < 4; ++i) { const int pc = tid + 512 * i, row = pc >> 5, c16 = pc & 31;
            *(LAS v4u*)(F.lds + CfRet::QA + row * 528 + c16 * 16) = qr[i]; *(LAS v4u*)(F.lds + CfRet::KA + row * 528 + c16 * 16) = kr[i]; }
        { const int row = tid >> 3, c16 = tid & 7; *(LAS v4u*)(F.lds + CfRet::V + row * 144 + c16 * 16) = vr;
          float f[8]; unpack8(vr, f);
#pragma unroll
          for (int e = 0; e < 8; ++e) f[e] *= vsc;
          *(LAS v4u*)(F.lds + CfRet::VB + row * 144 + c16 * 16) = pack8(f); }
        if (c + 1 < SEQ / 64) { const size_t r0 = (size_t)(c + 1) * 64;
#pragma unroll
            for (int i = 0; i < 4; ++i) { const int pc = tid + 512 * i, row = pc >> 5, c16 = pc & 31; qr[i] = *(const GAS v4u*)(qg + (r0 + row) * 1024 + c16 * 8); kr[i] = *(const GAS v4u*)(kg + (r0 + row) * 1024 + c16 * 8); }
            vr = *(const GAS v4u*)(vg + (r0 + (tid >> 3)) * 2048 + (tid & 7) * 8); }
        __syncthreads();
        rec_step<CfRet>(F.lds, F.wave, F.lane, S, cum, out, c * 64);
    }
    rec_store_state<CfRet>(F, S, st_out + ((size_t)(b * 4 + h) * 256) * 512 + vs * 64, 512);
}
__device__ __forceinline__ void ret_sample_items(Frame& F, const bf16* Q, const bf16* K, const bf16* V, bf16* RO, const float* st_in, float* st_out) {
    LAS float* qk = (LAS float*)F.lds; LAS float* red = qk + 512;
    const int tid = F.tid, lane = F.lane, w = F.wave;
    for (int item = F.vcu; item < MS * 4; item += F.G) {
        const int bs = item >> 2, h = item & 3; const size_t row = MPR + bs;
        __syncthreads();
        qk[tid] = tid < 256 ? bf2f(Q[row * 1024 + h * 256 + tid]) : bf2f(K[row * 1024 + h * 256 + (tid - 256)]);
        float v[8]; unpack8(*(const GAS v4u*)(V + row * 2048 + h * 512 + 8 * lane), v);
        __syncthreads();
        const float g = 1.f - exp2f(-5.f - (float)h);
        const float* sin = st_in + ((size_t)(bs * 4 + h) * 256) * 512 + 8 * lane; float* sout = st_out + ((size_t)(bs * 4 + h) * 256) * 512 + 8 * lane;
        float o[8];
#pragma unroll
        for (int e = 0; e < 8; ++e) o[e] = 0.f;
#pragma unroll 8
        for (int r = 0; r < 32; ++r) { const int kk = 32 * w + r;
            f32x4 s0 = __builtin_nontemporal_load((const GAS f32x4*)(sin + (size_t)kk * 512)), s1 = __builtin_nontemporal_load((const GAS f32x4*)(sin + (size_t)kk * 512 + 4));
            const float kf = qk[256 + kk], qf = qk[kk];
#pragma unroll
            for (int e = 0; e < 4; ++e) { s0[e] = g * s0[e] + kf * v[e]; s1[e] = g * s1[e] + kf * v[4 + e]; o[e] += s0[e] * qf; o[4 + e] += s1[e] * qf; }
            __builtin_nontemporal_store(s0, (GAS f32x4*)(sout + (size_t)kk * 512)); __builtin_nontemporal_store(s1, (GAS f32x4*)(sout + (size_t)kk * 512 + 4)); }
#pragma unroll
        for (int e = 0; e < 8; ++e) red[w * 512 + 8 * lane + e] = o[e];
        __syncthreads();
        float acc = 0.f;
#pragma unroll
        for (int ww = 0; ww < 8; ++ww) acc += red[ww * 512 + tid];
        RO[row * 2048 + h * 512 + tid] = (bf16)(cvt_pk_bf16(acc, acc) & 0xffffu);
    }
    __syncthreads();
}

struct CfSsd { static constexpr int C = 64, KD = 128, VS = 64, KPW = 1, RSK = 272, RSV = 144, RSP = 144; static constexpr bool CH = false;
    static constexpr int QA = 0, KA = 17408, QB = QA, KB = KA, V = 34816, VB = 44032, PM = 53248, ST = 62464, XS = 79872, CUM = 89088, CW = 89600, DS = 0, END = 96000; };
static_assert(CfSsd::END <= SCR_BYTES, "ssd lds");
struct SsdOut { bf16* dst; const LAS unsigned char* xs; float Dh;
    __device__ __forceinline__ void operator()(int tok, int i, int vv0, const f32x4 o) const {
        const v2u xw = *(const LAS v2u*)(xs + i * 144 + vv0 * 2);
        const f32x4 x = (f32x4){bflo(xw.x), bfhi(xw.x), bflo(xw.y), bfhi(xw.y)};
        *(GAS v2u*)(dst + (size_t)tok * 2048 + vv0) = pack4v(o + x * Dh); } };
__device__ __forceinline__ int ssd_gcol(int lch, int head, int grp) { return lch < 64 ? head * 64 + lch : (lch < 192 ? 2048 + grp * 128 + (lch - 64) : 2560 + grp * 128 + (lch - 192)); }
__device__ __forceinline__ void ssd_prompt_item(Frame& F, int item, const bf16* XBC, const float* DT, bf16* T, float* st_out,
                                                const float* conv_w, const float* conv_b, const float* dt_bias, const float* a_log, const float* d_skip) {
    const int b = item >> 5, head = item & 31, grp = head >> 3, tid = F.tid, lane = F.lane, w = F.wave;
    const float a = -expf(a_log[head]), dtb = dt_bias[head], Dh = d_skip[head];
    LAS float* cw = (LAS float*)(F.lds + CfSsd::CW); LAS float* cumb = (LAS float*)(F.lds + CfSsd::CUM);
    __syncthreads();
    for (int idx = tid; idx < 1600; idx += 512) { const int tap = idx / 320, lch = idx - tap * 320, gch = ssd_gcol(lch, head, grp); cw[idx] = tap < 4 ? conv_w[tap * 3072 + gch] : conv_b[gch]; }
    f32x4 S[CfSsd::KPW][4];
    rec_zero_state<CfSsd>(F, S);
    const bf16* xg = XBC + (size_t)(b * SEQ) * 3072; const float* dtg = DT + (size_t)(b * SEQ) * 32 + head;
    const SsdOut out{T + (size_t)(b * SEQ) * 2048 + head * 64, F.lds + CfSsd::XS, Dh};
#define SSD_CUM(cc) do { if (w == 0) { const int tk_ = (cc) * 64 + lane; float v_ = softplusf_(dtg[(size_t)tk_ * 32] + dtb) * a; \
        _Pragma("unroll") for (int o_ = 1; o_ < 64; o_ <<= 1) { const float u_ = __shfl_up(v_, o_); if (lane >= o_) v_ += u_; } cumb[((cc) & 1) * 64 + lane] = v_; } } while (0)
    SSD_CUM(0);
    __syncthreads();
    for (int c = 0; c < SEQ / 64; ++c) {
        const LAS float* cum = cumb + (c & 1) * 64; const float tot = cum[63];
#pragma unroll 1
        for (int r = 0; r < 5; ++r) { const int op = tid + 512 * r, i = op / 40, cg = op - i * 40, lch = 8 * cg, gcol = ssd_gcol(lch, head, grp), tok = c * 64 + i;
            float acc[8];
#pragma unroll
            for (int e = 0; e < 8; ++e) acc[e] = cw[4 * 320 + lch + e];
#pragma unroll
            for (int tap = 0; tap < 4; ++tap) { const int tk = tok - 3 + tap;
                if (tk >= 0) { float x[8]; unpack8(*(const GAS v4u*)(xg + (size_t)tk * 3072 + gcol), x);
#pragma unroll
                    for (int e = 0; e < 8; ++e) acc[e] += x[e] * cw[tap * 320 + lch + e]; } }
#pragma unroll
            for (int e = 0; e < 8; ++e) acc[e] = siluf_(acc[e]);
            if (cg < 8) { const float dtv = softplusf_(dtg[(size_t)tok * 32] + dtb), wj = dtv * __expf(tot - cum[i]);
                *(LAS v4u*)(F.lds + CfSsd::XS + i * 144 + lch * 2) = pack8(acc);
                float f[8];
#pragma unroll
                for (int e = 0; e < 8; ++e) f[e] = acc[e] * dtv;
                *(LAS v4u*)(F.lds + CfSsd::V + i * 144 + lch * 2) = pack8(f);
#pragma unroll
                for (int e = 0; e < 8; ++e) f[e] = acc[e] * wj;
                *(LAS v4u*)(F.lds + CfSsd::VB + i * 144 + lch * 2) = pack8(f); }
            else if (cg < 24) *(LAS v4u*)(F.lds + CfSsd::KA + i * 272 + (lch - 64) * 2) = pack8(acc);
            else *(LAS v4u*)(F.lds + CfSsd::QA + i * 272 + (lch - 192) * 2) = pack8(acc);
        }
        if (c + 1 < SEQ / 64) SSD_CUM(c + 1);
        __syncthreads();
        rec_step<CfSsd>(F.lds, w, lane, S, cum, out, c * 64);
    }
#undef SSD_CUM
    rec_store_state<CfSsd>(F, S, st_out + ((size_t)(b * 32 + head) * 128) * 64, 64);
}
__device__ __forceinline__ void ssd_sample_items(Frame& F, const bf16* XBC, const float* DT, bf16* T, const float* st_in, float* st_out, const float* conv_st,
                                                 const float* conv_w, const float* conv_b, const float* dt_bias, const float* a_log, const float* d_skip) {
    const int gw = F.vcu * NWAVES + F.wave, NGW = F.G * NWAVES, lane = F.lane;
    LAS float* scr = (LAS float*)(F.lds + F.wave * 2048);
    __syncthreads();
    for (int item = gw; item < MS * 32; item += NGW) {
        const int bs = item >> 5, head = item & 31, grp = head >> 3; const size_t row = MPR + bs;
        asm volatile("" ::: "memory");
#pragma unroll
        for (int r = 0; r < 5; ++r) { const int lch = lane + 64 * r, gch = ssd_gcol(lch, head, grp);
            float acc = conv_b[gch];
#pragma unroll
            for (int tap = 0; tap < 3; ++tap) acc += conv_st[((size_t)bs * 3 + tap) * 3072 + gch] * conv_w[tap * 3072 + gch];
            acc += bf2f(XBC[row * 3072 + gch]) * conv_w[3 * 3072 + gch];
            scr[lch] = siluf_(acc); }
        LDS_WAIT();
        const float dtv = softplusf_(DT[row * 32 + head] + dt_bias[head]), dA = __expf(dtv * -expf(a_log[head])), Dh = d_skip[head];
        const int v4 = (lane & 15) * 4, kq = lane >> 4;
        const f32x4 xs4 = (f32x4){scr[v4], scr[v4 + 1], scr[v4 + 2], scr[v4 + 3]}, xd = xs4 * dtv;
        const float* sin = st_in + ((size_t)(bs * 32 + head) * 128) * 64 + v4; float* sout = st_out + ((size_t)(bs * 32 + head) * 128) * 64 + v4;
        f32x4 y = (f32x4){0.f, 0.f, 0.f, 0.f};
#pragma unroll 8
        for (int i = 0; i < 32; ++i) { const int kk = 4 * i + kq;
            f32x4 s = __builtin_nontemporal_load((const GAS f32x4*)(sin + (size_t)kk * 64));
            s = s * dA + xd * scr[64 + kk];
            __builtin_nontemporal_store(s, (GAS f32x4*)(sout + (size_t)kk * 64));
            y = y + s * scr[192 + kk]; }
#pragma unroll
        for (int e = 0; e < 4; ++e) { y[e] += __shfl_xor(y[e], 16); y[e] += __shfl_xor(y[e], 32); }
        if (lane < 16) *(GAS v2u*)(T + row * 2048 + head * 64 + v4) = pack4v(y + xs4 * Dh);
        LDS_WAIT();
    }
    __syncthreads();
}
__device__ __forceinline__ void ssd_conv_out(Frame& F, const bf16* XBC, const float* conv_st, float* outp, float* outs) {
    const int NP_ = BP * 3 * 3072, NS_ = MS * 3 * 3072;
    for (int idx = F.vcu * 512 + F.tid; idx < NP_ + NS_; idx += F.G * 512) {
        if (idx < NP_) { const int b = idx / 9216, rem = idx - b * 9216, wi = rem / 3072, ch = rem - wi * 3072; outp[idx] = bf2f(XBC[(size_t)(b * SEQ + SEQ - 3 + wi) * 3072 + ch]); }
        else { const int k = idx - NP_, bs = k / 9216, rem = k - bs * 9216, wi = rem / 3072, ch = rem - wi * 3072;
            outs[k] = wi < 2 ? conv_st[((size_t)bs * 3 + wi + 1) * 3072 + ch] : bf2f(XBC[(size_t)(MPR + bs) * 3072 + ch]); }
    }
}

struct CfHg { static constexpr int C = 32, KD = 128, VS = 32, KPW = 1, RSK = 272, RSV = 80, RSP = 80; static constexpr bool CH = true;
    static constexpr int QA = 0, KA = 8704, QB = 17408, KB = 26112, V = 34816, VB = V, PM = 37376, ST = 39936, DS = 48640, PART = 49152, CUM = 0, END = 51200; };
static_assert(CfHg::END <= SCR_BYTES, "hgrn lds");
struct HgOut { bf16* dst;
    __device__ __forceinline__ void operator()(int tok, int i, int vv0, const f32x4 o) const { *(GAS v2u*)(dst + (size_t)tok * 1024 + vv0) = pack4v(o); } };
__device__ __forceinline__ void st_bf16_lds(LAS unsigned char* p, float x) { *(LAS unsigned short*)p = (unsigned short)(cvt_pk_bf16(x, x) & 0xffffu); }
__device__ __forceinline__ void hg_prompt_item(Frame& F, int item, const bf16* HQ, const float* LA, const bf16* HV, bf16* RO, float* st_out) {
    const int b = item >> 5, h = (item >> 2) & 7, vs = item & 3, tid = F.tid, kk = tid & 127, tg = tid >> 7;
    LAS float* part = (LAS float*)(F.lds + CfHg::PART); LAS float* dsv = (LAS float*)(F.lds + CfHg::DS);
    __syncthreads();
    f32x4 S[CfHg::KPW][2];
    rec_zero_state<CfHg>(F, S);
    const size_t base = (size_t)(b * SEQ) * 1024 + h * 128;
    const HgOut out{RO + base + vs * 32};
    float la[8]; unsigned short qr[8]; v4u vr = (v4u){0u, 0u, 0u, 0u};
#pragma unroll
    for (int e = 0; e < 8; ++e) { const size_t ix = base + (size_t)(8 * tg + e) * 1024 + kk; la[e] = LA[ix]; qr[e] = HQ[ix]; }
    if (tid < 128) vr = *(const GAS v4u*)(HV + base + (size_t)(tid >> 2) * 1024 + vs * 32 + (tid & 3) * 8);
    for (int c = 0; c < SEQ / 32; ++c) {
        float lc[8]; lc[0] = la[0];
#pragma unroll
        for (int e = 1; e < 8; ++e) lc[e] = lc[e - 1] + la[e];
        part[tg * 128 + kk] = lc[7];
        __syncthreads();
        const float p0 = part[kk], p1 = part[128 + kk], p2 = part[256 + kk], p3 = part[384 + kk];
        const float off = (tg > 0 ? p0 : 0.f) + (tg > 1 ? p1 : 0.f) + (tg > 2 ? p2 : 0.f), tot = (p0 + p1) + (p2 + p3), ref = p0 + p1;
#pragma unroll
        for (int e = 0; e < 8; ++e) { const int i = 8 * tg + e; const float cm = off + lc[e], kf = 1.f - __expf(la[e]), qv = bf2f(qr[e]);
            const float ea = __expf(fminf(fmaxf(cm - ref, -80.f), 80.f)), eb = __expf(fminf(fmaxf(ref - cm, -80.f), 80.f));
            st_bf16_lds(F.lds + CfHg::QA + i * 272 + kk * 2, qv * ea); st_bf16_lds(F.lds + CfHg::KA + i * 272 + kk * 2, kf * eb);
            st_bf16_lds(F.lds + CfHg::QB + i * 272 + kk * 2, qv * __expf(cm)); st_bf16_lds(F.lds + CfHg::KB + i * 272 + kk * 2, kf * __expf(tot - cm)); }
        if (tg == 0) dsv[kk] = __expf(tot);
        if (tid < 128) *(LAS v4u*)(F.lds + CfHg::V + (tid >> 2) * 80 + (tid & 3) * 16) = vr;
        if (c + 1 < SEQ / 32) { const size_t b2 = base + (size_t)(c + 1) * 32 * 1024;
#pragma unroll
            for (int e = 0; e < 8; ++e) { const size_t ix = b2 + (size_t)(8 * tg + e) * 1024 + kk; la[e] = LA[ix]; qr[e] = HQ[ix]; }
            if (tid < 128) vr = *(const GAS v4u*)(HV + b2 + (size_t)(tid >> 2) * 1024 + vs * 32 + (tid & 3) * 8); }
        __syncthreads();
        rec_step<CfHg>(F.lds, F.wave, F.lane, S, (const LAS float*)nullptr, out, c * 32);
    }
    rec_store_state<CfHg>(F, S, st_out + ((size_t)(b * 8 + h) * 128) * 128 + vs * 32, 128);
}
__device__ __forceinline__ void hg_sample_items(Frame& F, const bf16* HQ, const float* LA, const bf16* HV, bf16* RO, const float* st_in, float* st_out) {
    const int gw = F.vcu * NWAVES + F.wave, NGW = F.G * NWAVES, lane = F.lane;
    LAS float* scr = (LAS float*)(F.lds + F.wave * 2048);
    __syncthreads();
    for (int item = gw; item < MS * 16; item += NGW) {
        const int bs = item >> 4, h = (item >> 1) & 7, vh = item & 1; const size_t rb = (size_t)(MPR + bs) * 1024 + h * 128;
        asm volatile("" ::: "memory");
#pragma unroll
        for (int r = 0; r < 2; ++r) { const int kk = lane + 64 * r; scr[kk] = __expf(LA[rb + kk]); scr[128 + kk] = bf2f(HQ[rb + kk]); }
        LDS_WAIT();
        const int v4 = (lane & 15) * 4, kq = lane >> 4;
        const v2u iw = *(const GAS v2u*)(HV + rb + vh * 64 + v4);
        const f32x4 iv = (f32x4){bflo(iw.x), bfhi(iw.x), bflo(iw.y), bfhi(iw.y)};
        const float* sin = st_in + ((size_t)(bs * 8 + h) * 128) * 128 + vh * 64 + v4; float* sout = st_out + ((size_t)(bs * 8 + h) * 128) * 128 + vh * 64 + v4;
        f32x4 o = (f32x4){0.f, 0.f, 0.f, 0.f};
#pragma unroll 8
        for (int i = 0; i < 32; ++i) { const int kk = 4 * i + kq; const float f = scr[kk];
            f32x4 s = __builtin_nontemporal_load((const GAS f32x4*)(sin + (size_t)kk * 128));
            s = s * f + iv * (1.f - f);
            __builtin_nontemporal_store(s, (GAS f32x4*)(sout + (size_t)kk * 128));
            o = o + s * scr[128 + kk]; }
#pragma unroll
        for (int e = 0; e < 4; ++e) { o[e] += __shfl_xor(o[e], 16); o[e] += __shfl_xor(o[e], 32); }
        if (lane < 16) *(GAS v2u*)(RO + rb + vh * 64 + v4) = pack4v(o);
        LDS_WAIT();
    }
    __syncthreads();
}

__device__ __forceinline__ void p0_transpose_item(const float* W, int K, int N, bf16* WT, LAS float* scr, int item, int lane, bool inter) {
    const int nblk = N / 32, kb = item / nblk, nb = item - kb * nblk, k0 = 64 * kb, n0 = 32 * nb;
    int s0 = n0; if (inter) { const int t = n0 >> 8, j = n0 & 255; s0 = j < 128 ? 128 * t + j : DFF + 128 * t + (j - 128); }
#pragma unroll 8
    for (int i = 0; i < 32; ++i) { const int kk = 2 * i + (lane >> 5); scr[kk * 33 + (lane & 31)] = W[(size_t)(k0 + kk) * N + s0 + (lane & 31)]; }
    LDS_WAIT(); asm volatile("" ::: "memory");
    const int c = lane & 7;
#pragma unroll
    for (int j = 0; j < 4; ++j) { const int n = (lane >> 3) + 8 * j; const LAS float* s = scr + (8 * c) * 33 + n;
        v4u o; o.x = cvt_pk_bf16(s[0 * 33], s[1 * 33]); o.y = cvt_pk_bf16(s[2 * 33], s[3 * 33]); o.z = cvt_pk_bf16(s[4 * 33], s[5 * 33]); o.w = cvt_pk_bf16(s[6 * 33], s[7 * 33]);
        *(GAS v4u*)(WT + (size_t)(n0 + n) * K + k0 + 8 * c) = o; }
    LDS_WAIT(); asm volatile("" ::: "memory");
}
__device__ __forceinline__ void p0_matrix(Frame& F, const float* W, int K, int N, bf16* WT, bool inter, int& itbase) {
    const int gw = F.vcu * NWAVES + F.wave, NGW = F.G * NWAVES, nit = (K / 64) * (N / 32);
    LAS float* scr = (LAS float*)(F.lds + F.wave * 16384);
    int first = (gw - itbase) % NGW; if (first < 0) first += NGW;
    for (int it = first; it < nit; it += NGW) p0_transpose_item(W, K, N, WT, scr, it, F.lane, inter);
    itbase += nit;
}

struct Args { const float* in[30]; float* out; unsigned char* ws; int ph_lo, ph_hi; };
enum { I_XP = 0, I_XS, I_CP, I_CS, I_SRET, I_SSSD, I_SCONV, I_SHG, I_WADA, I_BADA, I_NMPRE, I_NMPOST, I_NFPRE, I_NFPOST, I_RETIN, I_RETOUT, I_SSDIN, I_CONVW, I_CONVB, I_DTB, I_ALOG, I_SSDD,
       I_SSDNORM, I_SSDOUT, I_HGIN, I_HGLB, I_HGNORM, I_HGOUT, I_FFNIN, I_FFNOUT };
constexpr int N_PHASES = 3 + 8 * 4;

__global__ void __launch_bounds__(NWAVES * 64, 2) mk_fwd(Args args) {
    extern __shared__ __attribute__((aligned(16))) unsigned char lds_raw[];
    Frame F;
    F.lds = (LAS unsigned char*)lds_raw;
    F.tid = threadIdx.x; F.lane = F.tid & 63; F.wave = __builtin_amdgcn_readfirstlane(F.tid >> 6);
    F.G = gridDim.x; { const int bx = blockIdx.x; F.vcu = (F.G % 8 == 0) ? (bx % 8) * (F.G / 8) + bx / 8 : bx; }
    unsigned char* ws = args.ws;
    gu32* ctl = (gu32*)(ws + WS_CTL);
    for (int u = F.tid; u < (LDS_BYTES - LDSCTL_OFF) / 4; u += NWAVES * 64) ((LAS unsigned*)(F.lds + LDSCTL_OFF))[u] = 0u;
    __syncthreads();
    XcdBarrier bar; bar.bar = (unsigned*)(ctl + CW_BAR); bar.x = 0; bar.st = nullptr;
    if (MK_N_LAUNCHES == 1) bar = xcd_barrier_post((unsigned*)(ctl + CW_BAR), (volatile LAS unsigned*)(F.lds + LDSCTL_OFF) + 8);
    const int lo = args.ph_lo, hi = args.ph_hi;
#define IN(k) (lo <= (k) && (k) < hi)
#define SEAM(k) do { if (IN((k) + 1)) xcd_barrier(bar); } while (0)
#define INP(i) (args.in[i])
    float* const out = args.out;
    float* const X = out + O_Y;
    bf16* const Hb = (bf16*)(ws + WS_H); bf16* const RO = (bf16*)(ws + WS_RO); bf16* const GO = (bf16*)(ws + WS_GO); bf16* const OUTB = (bf16*)(ws + WS_OUT); bf16* const ACT = (bf16*)(ws + WS_ACT);
    float* const MOD = (float*)(ws + WS_MOD); float* const LB = (float*)(ws + WS_LB);
    bf16* const CACT = (bf16*)(ws + WS_CACT);
    bf16* const WADA = (bf16*)(ws + WS_WADA);
    unsigned char* const PJ = ws + WS_PROJ;

    if (IN(0)) {
        int itb = 0;
#pragma unroll 1
        for (int l = 0; l < 4; ++l) p0_matrix(F, INP(I_WADA) + (size_t)l * D * NMOD, D, NMOD, WADA + (size_t)l * NMOD * D, false, itb);
#pragma unroll 1
        for (int j = 0; j < 2; ++j) p0_matrix(F, INP(I_RETIN) + (size_t)j * D * RET_IN, D, RET_IN, (bf16*)(ws + WS_WRETIN) + (size_t)j * RET_IN * D, false, itb);
#pragma unroll 1
        for (int j = 0; j < 2; ++j) p0_matrix(F, INP(I_RETOUT) + (size_t)j * 2048 * D, 2048, D, (bf16*)(ws + WS_WRETOUT) + (size_t)j * D * 2048, false, itb);
        p0_matrix(F, INP(I_SSDIN), D, SSD_IN, (bf16*)(ws + WS_WSSDIN), false, itb);
        p0_matrix(F, INP(I_SSDOUT), 2048, D, (bf16*)(ws + WS_WSSDOUT), false, itb);
        p0_matrix(F, INP(I_HGIN), D, HG_IN, (bf16*)(ws + WS_WHGIN), false, itb);
        p0_matrix(F, INP(I_HGOUT), D, D, (bf16*)(ws + WS_WHGOUT), false, itb);
#pragma unroll 1
        for (int l = 0; l < 4; ++l) p0_matrix(F, INP(I_FFNIN) + (size_t)l * D * FFN_IN, D, FFN_IN, (bf16*)(ws + WS_WFFNIN) + (size_t)l * FFN_IN * D, true, itb);
#pragma unroll 1
        for (int l = 0; l < 4; ++l) p0_matrix(F, INP(I_FFNOUT) + (size_t)l * DFF * D, DFF, D, (bf16*)(ws + WS_WFFNOUT) + (size_t)l * D * DFF, false, itb);
        for (int idx = F.vcu * 512 + F.tid; idx < 256 * 128; idx += F.G * 512) { const int row = idx >> 7, c8 = (idx & 127) * 8; v4u o = (v4u){0u, 0u, 0u, 0u};
            if (row < NCOND) { const float* src = row < BP ? INP(I_CP) + (size_t)row * D : INP(I_CS) + (size_t)(row - BP) * D;
                const f32x4 a = *(const GAS f32x4*)(src + c8), b = *(const GAS f32x4*)(src + c8 + 4); o = pack8v(silu4(a), silu4(b)); }
            *(GAS v4u*)(CACT + (size_t)row * D + c8) = o; }
        for (int idx = F.vcu * 512 + F.tid; idx < 1024; idx += F.G * 512) { const float* lg = INP(I_HGLB);
            const float l0 = lg[idx], l1 = lg[1024 + idx], l2 = lg[2048 + idx], l3 = lg[3072 + idx], m = fmaxf(fmaxf(l0, l1), fmaxf(l2, l3));
            const float e0 = expf(l0 - m), e1 = expf(l1 - m), e2 = expf(l2 - m), e3 = expf(l3 - m); LB[idx] = (e1 + e2) / ((e0 + e1) + (e2 + e3)); }
        SEAM(0);
    }
    if (IN(1)) {
        const EmitMod E{MOD, INP(I_BADA)};
        skinny_gemm(F, CACT, D, 2, 0, WADA, (NMODALL / 256) * 8, false, E, 0);
        SEAM(1);
    }
    if (IN(2)) {
        resnorm_phase<0>(F, INP(I_XP), INP(I_XS), X, nullptr, Hb, MOD, nullptr, 0, INP(I_NMPRE), 0 * NMOD + 0 * D, 0 * NMOD + 1 * D);
        SEAM(2);
    }

#define MAIN_GEMM(EmitT, eobj, Aptr, Btptr, N_, K_) do { pg8::Gemm g_{(const pg8::bf16_t*)(Aptr), (const pg8::bf16_t*)(Btptr), MPR, (N_), (K_)}; pg8::StaticOrder S_; S_.init(MPR, (N_), F.G, (int)blockIdx.x); \
        const EpiGen<EmitT> E_{eobj}; pg8::gemm_phase<EpiGen<EmitT>, pg8::StaticOrder, PG8_ALIGN, PG8_SP2>(F.lds, g_, S_, E_); } while (0)
#define FFN_BLOCK(L, pb, LASTL) do { \
    if (IN((pb) + 4)) { resnorm_phase<1>(F, nullptr, nullptr, X, OUTB, Hb, MOD, INP(I_NMPOST) + (L) * D, (L) * NMOD + 2 * D, INP(I_NFPRE) + (L) * D, (L) * NMOD + 3 * D, (L) * NMOD + 4 * D); SEAM((pb) + 4); } \
    if (IN((pb) + 5)) { const bf16* wt_ = (const bf16*)(ws + WS_WFFNIN) + (size_t)(L) * FFN_IN * D; const EmitFfnIn e_{ACT}; \
        MAIN_GEMM(EmitFfnIn, e_, Hb, wt_, FFN_IN, D); skinny_gemm(F, Hb + (size_t)MPR * D, D, 1, MPR, wt_, (FFN_IN / 256) * 8, false, e_, 0); SEAM((pb) + 5); } \
    if (IN((pb) + 6)) { const bf16* wt_ = (const bf16*)(ws + WS_WFFNOUT) + (size_t)(L) * D * DFF; const EmitOut e_{OUTB}; \
        MAIN_GEMM(EmitOut, e_, ACT, wt_, D, DFF); skinny_gemm(F, ACT + (size_t)MPR * DFF, DFF, 1, MPR, wt_, (D / 256) * 8, false, e_, 0); SEAM((pb) + 6); } \
    if (IN((pb) + 7)) { if (LASTL) resnorm_phase<2>(F, nullptr, nullptr, X, OUTB, Hb, MOD, INP(I_NFPOST) + (L) * D, (L) * NMOD + 5 * D, nullptr, 0, 0); \
        else resnorm_phase<1>(F, nullptr, nullptr, X, OUTB, Hb, MOD, INP(I_NFPOST) + (L) * D, (L) * NMOD + 5 * D, INP(I_NMPRE) + ((L) + 1) * D, ((L) + 1) * NMOD + 0 * D, ((L) + 1) * NMOD + 1 * D); \
        if (!(LASTL)) SEAM((pb) + 7); } } while (0)
#define OUT_PROJ(pb, wt, K_) do { if (IN((pb) + 3)) { const EmitOut e_{OUTB}; MAIN_GEMM(EmitOut, e_, GO, (wt), D, (K_)); skinny_gemm(F, GO + (size_t)MPR * (K_), (K_), 1, MPR, (wt), (D / 256) * 8, false, e_, 0); SEAM((pb) + 3); } } while (0)
#define RET_LAYER(L, J, pb) do { \
    bf16* const Qp_ = (bf16*)(PJ + PJ_RET_Q); bf16* const Kp_ = (bf16*)(PJ + PJ_RET_K); bf16* const Vp_ = (bf16*)(PJ + PJ_RET_V); bf16* const SGp_ = (bf16*)(PJ + PJ_RET_SG); \
    if (IN((pb) + 0)) { const bf16* wt_ = (const bf16*)(ws + WS_WRETIN) + (size_t)(J) * RET_IN * D; const EmitRetIn e_{Qp_, Kp_, Vp_, SGp_}; \
        MAIN_GEMM(EmitRetIn, e_, Hb, wt_, RET_IN, D); skinny_gemm(F, Hb + (size_t)MPR * D, D, 1, MPR, wt_, (RET_IN / 256) * 8, false, e_, 0); SEAM((pb) + 0); } \
    if (IN((pb) + 1)) { for (int item = F.vcu; item < 256; item += F.G) ret_prompt_item(F, item, Qp_, Kp_, Vp_, RO, out + O_RETP + (size_t)(J) * 8 * 4 * 256 * 512); \
        ret_sample_items(F, Qp_, Kp_, Vp_, RO, INP(I_SRET) + (size_t)(J) * 128 * 4 * 256 * 512, out + O_RETS + (size_t)(J) * 128 * 4 * 256 * 512); SEAM((pb) + 1); } \
    if (IN((pb) + 2)) { gatenorm_phase<0>(F, RO, SGp_, GO, nullptr); SEAM((pb) + 2); } \
    OUT_PROJ(pb, (const bf16*)(ws + WS_WRETOUT) + (size_t)(J) * D * 2048, 2048); \
    } while (0)

    RET_LAYER(0, 0, 3);
    FFN_BLOCK(0, 3, false);
    {
        constexpr int pb = 11;
        bf16* const SZ_ = (bf16*)(PJ + PJ_SSD_SZ); bf16* const XBC_ = (bf16*)(PJ + PJ_SSD_XBC); float* const DT_ = (float*)(PJ + PJ_SSD_DT);
        if (IN(pb + 0)) { const bf16* wt_ = (const bf16*)(ws + WS_WSSDIN); const EmitSsdIn e_{SZ_, XBC_}; const EmitDt ed_{DT_};
            MAIN_GEMM(EmitSsdIn, e_, Hb, wt_, SSD_INM, D);
            skinny_gemm(F, Hb + (size_t)MPR * D, D, 1, MPR, wt_, (SSD_INM / 256) * 8, false, e_, 0);
            skinny_gemm(F, Hb, D, MT / 128, 0, wt_, 1, true, ed_, 160);
            SEAM(pb + 0); }
        if (IN(pb + 1)) {
            for (int item = F.vcu; item < 256; item += F.G) ssd_prompt_item(F, item, XBC_, DT_, RO, out + O_SSDP, INP(I_CONVW), INP(I_CONVB), INP(I_DTB), INP(I_ALOG), INP(I_SSDD));
            ssd_sample_items(F, XBC_, DT_, RO, INP(I_SSSD), out + O_SSDS, INP(I_SCONV), INP(I_CONVW), INP(I_CONVB), INP(I_DTB), INP(I_ALOG), INP(I_SSDD));
            ssd_conv_out(F, XBC_, INP(I_SCONV), out + O_CONVP, out + O_CONVS);
            SEAM(pb + 1); }
        if (IN(pb + 2)) { gatenorm_phase<1>(F, RO, SZ_, GO, INP(I_SSDNORM)); SEAM(pb + 2); }
        OUT_PROJ(pb, (const bf16*)(ws + WS_WSSDOUT), 2048);
    }
    FFN_BLOCK(1, 11, false);
    {
        constexpr int pb = 19;
        bf16* const HQ_ = (bf16*)(PJ + PJ_HG_Q); float* const LA_ = (float*)(PJ + PJ_HG_LA); bf16* const HV_ = (bf16*)(PJ + PJ_HG_V); bf16* const HSG_ = (bf16*)(PJ + PJ_HG_SG);
        if (IN(pb + 0)) { const bf16* wt_ = (const bf16*)(ws + WS_WHGIN); const EmitHgIn e_{HQ_, HV_, HSG_, LA_, LB};
            MAIN_GEMM(EmitHgIn, e_, Hb, wt_, HG_IN, D); skinny_gemm(F, Hb + (size_t)MPR * D, D, 1, MPR, wt_, (HG_IN / 256) * 8, false, e_, 0); SEAM(pb + 0); }
        if (IN(pb + 1)) {
            for (int item = F.vcu; item < 256; item += F.G) hg_prompt_item(F, item, HQ_, LA_, HV_, RO, out + O_HGP);
            hg_sample_items(F, HQ_, LA_, HV_, RO, INP(I_SHG), out + O_HGS);
            SEAM(pb + 1); }
        if (IN(pb + 2)) { gatenorm_phase<2>(F, RO, HSG_, GO, INP(I_HGNORM)); SEAM(pb + 2); }
        OUT_PROJ(pb, (const bf16*)(ws + WS_WHGOUT), 1024);
    }
    FFN_BLOCK(2, 19, false);
    RET_LAYER(3, 1, 27);
    FFN_BLOCK(3, 27, true);
#undef IN
#undef SEAM
}

extern "C" void kernel_launch(void* const* d_in, const int* in_sizes, int n_in, void* d_out, int out_size, void* d_ws, size_t ws_size, hipStream_t stream) {
    static int grid = 0;
    if (grid == 0) {
        if (n_in != 30 || (size_t)out_size != O_END || ws_size < WS_END) { fprintf(stderr, "kernel_launch: unexpected shapes (n_in %d out %d ws %zu)\n", n_in, out_size, ws_size); grid = -1; return; }
        int dev = 0, cus = 0, per_cu = 0;
        if (hipGetDevice(&dev) != hipSuccess || hipDeviceGetAttribute(&cus, hipDeviceAttributeMultiprocessorCount, dev) != hipSuccess) { grid = -1; return; }
        if (hipFuncSetAttribute((const void*)mk_fwd, hipFuncAttributeMaxDynamicSharedMemorySize, LDS_BYTES) != hipSuccess) { fprintf(stderr, "kernel_launch: hipFuncSetAttribute failed\n"); grid = -1; return; }
        if (hipOccupancyMaxActiveBlocksPerMultiprocessor(&per_cu, (const void*)mk_fwd, NWAVES * 64, LDS_BYTES) != hipSuccess || per_cu < 1) { fprintf(stderr, "kernel_launch: occupancy query says %d\n", per_cu); }
        (void)hipGetLastError();
        grid = cus;
    }
    if (grid < 0) return;
    if (hipMemsetAsync((char*)d_ws + WS_CTL, 0, CTL_ZERO_BYTES, stream) != hipSuccess) { fprintf(stderr, "kernel_launch: memset failed\n"); return; }
    Args a{};
    for (int i = 0; i < 30; ++i) a.in[i] = (const float*)d_in[i];
    a.out = (float*)d_out; a.ws = (unsigned char*)d_ws;
#if MK_N_LAUNCHES == 1
    a.ph_lo = 0; a.ph_hi = N_PHASES;
    hipLaunchKernelGGL(mk_fwd, dim3(grid), dim3(NWAVES * 64), LDS_BYTES, stream, a);
#else
    for (int p = 0; p < N_PHASES; ++p) { a.ph_lo = p; a.ph_hi = p + 1; hipLaunchKernelGGL(mk_fwd, dim3(grid), dim3(NWAVES * 64), LDS_BYTES, stream, a); }
#endif
    const hipError_t le = hipPeekAtLastError();
    if (le != hipSuccess) fprintf(stderr, "kernel_launch: launch failed: %s\n", hipGetErrorName(le));
}
```

```cpp
#include <hip/hip_runtime.h>
#include <cstdio>
#include <cstdint>
namespace pg8 {
#define PG8_LAS __attribute__((address_space(3)))
typedef unsigned short bf16_t;
typedef short bf16x8 __attribute__((ext_vector_type(8)));
typedef float f32x4 __attribute__((ext_vector_type(4)));
typedef unsigned u32x4 __attribute__((ext_vector_type(4)));
constexpr int BM = 256, BK = 64, HALF = 128, HTB = HALF * BK * 2  , STAGE_BYTES = 8 * HTB, NXCD = 8, WGM = 8;

__host__ __device__ __forceinline__ int lds_byte(int r, int c) { const int st = (r >> 4) * 2 + (c >> 5), rr = r & 15, cc = c & 31, ob = rr * 64 + cc * 2; return st * 1024 + (ob ^ (((ob >> 9) & 1) << 5)); }
__host__ __device__ __forceinline__ void stage_rc(int b, int& R, int& C) { const int st = b / 1024, sb = b % 1024, swz = sb ^ (((sb >> 9) & 1) << 5); R = (st >> 1) * 16 + swz / 64; C = (st & 1) * 32 + (swz % 64) / 2; }
__host__ __device__ __forceinline__ int perm32(int rho) { const int n = rho >> 4, i = rho & 15; return 8 * (i >> 2) + 4 * n + (i & 3); }

struct Unit { int pm, pn; };
struct Gemm { const bf16_t* A; const bf16_t* Bt; int M, N, K; };

struct StaticOrder {
    int nM, nN, nwg, G, c;
    __host__ __device__ void init(int M, int N, int G_, int c_) { nM = M / BM; nN = N / BM; nwg = nM * nN; G = G_; c = c_; }
    __host__ __device__ bool next(int i, Unit& u) const {
        const long L = (long)i * G + c; if (L >= nwg) return false;
        int wgid = (int)L; { const int q = nwg / NXCD, r = nwg % NXCD, xcd = wgid % NXCD, off = wgid / NXCD; wgid = (xcd < r ? xcd * (q + 1) : r * (q + 1) + (xcd - r) * q) + off; }
        const int nig = WGM * nN, gid = wgid / nig, fm = gid * WGM, gsz = (nM - fm) < WGM ? (nM - fm) : WGM;
        u.pm = fm + ((wgid % nig) % gsz); u.pn = (wgid % nig) / gsz; return true;
    }
    __device__ __forceinline__ void a_ready(const Unit&) const {}
    __device__ __forceinline__ void done(const Unit&) const {}
};

__device__ __forceinline__ unsigned cvt_pk_bf16(float lo, float hi) { unsigned r; asm volatile("v_cvt_pk_bf16_f32 %0, %1, %2" : "=v"(r) : "v"(lo), "v"(hi)); return r; }
typedef float f32x2 __attribute__((ext_vector_type(2)));
template <class Epi, class Sched, bool ALIGN_EPI = false, bool SP2 = false>
__device__ __forceinline__ void gemm_phase(PG8_LAS unsigned char* lds, const Gemm g, const Sched& S, const Epi& E) {
    const int tid = threadIdx.x, wid = __builtin_amdgcn_readfirstlane(tid >> 6), lane = tid & 63, wr = wid >> 2, wc = wid & 3, fr = lane & 15, fq = lane >> 4;
    const int K = g.K, nt = K / BK;
    unsigned voffA[2], voffB[2];
#pragma unroll
    for (int i = 0; i < 2; ++i) { int R, C; stage_rc(tid * 16 + i * 8192, R, C); const int Rb = Epi::PERM ? ((R & ~31) + perm32(R & 31)) : R;
        voffA[i] = (unsigned)(R * K + C) * 2u; voffB[i] = (unsigned)(Rb * K + C) * 2u; }
    const size_t kstep = (size_t)(BK * 2);
    const size_t hstep = (size_t)HALF * K * 2;
    const size_t tstep = 2 * hstep;
    const unsigned ldsw = (unsigned)wid * 1024u;
    const int aoff = lds_byte(wr * 64 + fr, fq * 8), boff = lds_byte(wc * 32 + fr, fq * 8);
#define PG8_SA(b, h) (((b) * 2 + (h)) * HTB)
#define PG8_SB(b, h) ((4 + (b) * 2 + (h)) * HTB)
#define PG8_STAGE(bufoff, gbase, voff) do { _Pragma("unroll") for (int _i = 0; _i < 2; ++_i) \
        __builtin_amdgcn_global_load_lds((const unsigned*)((const char*)(gbase) + (voff)[_i]), (PG8_LAS unsigned*)(lds + (bufoff) + ldsw + _i * 8192), 16, 0, 0); } while (0)
#define PG8_LDA(dst, b, h) do { _Pragma("unroll") for (int m = 0; m < 4; ++m) _Pragma("unroll") for (int k = 0; k < 2; ++k) dst[m][k] = *(const PG8_LAS bf16x8*)(lds + PG8_SA(b, h) + aoff + m * 2048 + k * 1024); } while (0)
#define PG8_LDB(dst, b, h) do { _Pragma("unroll") for (int n = 0; n < 2; ++n) _Pragma("unroll") for (int k = 0; k < 2; ++k) dst[n][k] = *(const PG8_LAS bf16x8*)(lds + PG8_SB(b, h) + boff + n * 2048 + k * 1024); } while (0)
#define PG8_MMA(ai, bj, At, Bt) do { __builtin_amdgcn_s_setprio(1); _Pragma("unroll") for (int m = 0; m < 4; ++m) _Pragma("unroll") for (int n = 0; n < 2; ++n) _Pragma("unroll") for (int k = 0; k < 2; ++k) \
        acc[ai][bj][m][n] = __builtin_amdgcn_mfma_f32_16x16x32_bf16(Bt[n][k], At[m][k], acc[ai][bj][m][n], 0, 0, 0); __builtin_amdgcn_s_setprio(0); } while (0)
#define PG8_WAIT_V(n) asm volatile("s_waitcnt vmcnt(" #n ")" ::: "memory")
#define PG8_WAIT_L(n) asm volatile("s_waitcnt lgkmcnt(" #n ")" ::: "memory")
#define PG8_BAR __builtin_amdgcn_s_barrier()
#define PG8_SCHED __builtin_amdgcn_sched_barrier(0)
    Unit cur, nxt; int ui = 0;
    if (!S.next(0, cur)) return;
    f32x4 acc[2][2][4][2];
#pragma unroll
    for (int a = 0; a < 2; ++a)
#pragma unroll
        for (int b = 0; b < 2; ++b)
#pragma unroll
            for (int m = 0; m < 4; ++m)
#pragma unroll
                for (int n = 0; n < 2; ++n) acc[a][b][m][n] = (f32x4){0.f, 0.f, 0.f, 0.f};
    bf16x8 At[4][2], B0[2][2], B1[2][2];
    const char* cA = (const char*)g.A + (size_t)cur.pm * tstep; const char* cB = (const char*)g.Bt + (size_t)cur.pn * tstep;
    S.a_ready(cur);
    if constexpr (SP2) {
        PG8_STAGE(PG8_SB(0, 0), cB, voffB); PG8_STAGE(PG8_SB(0, 1), cB + hstep, voffB); PG8_STAGE(PG8_SA(0, 0), cA, voffA); PG8_STAGE(PG8_SA(0, 1), cA + hstep, voffA);
        if (wr == 1) PG8_BAR;
        PG8_WAIT_V(2); PG8_BAR;
        PG8_STAGE(PG8_SB(1, 0), cB + kstep, voffB); PG8_STAGE(PG8_SA(1, 0), cA + kstep, voffA); PG8_STAGE(PG8_SB(1, 1), cB + hstep + kstep, voffB);
        PG8_WAIT_V(6); PG8_BAR;
    } else {
        PG8_STAGE(PG8_SB(0, 0), cB, voffB); PG8_STAGE(PG8_SA(0, 0), cA, voffA); PG8_STAGE(PG8_SB(0, 1), cB + hstep, voffB); PG8_STAGE(PG8_SA(0, 1), cA + hstep, voffA);
        if (wr == 1) PG8_BAR;
        PG8_WAIT_V(4); PG8_BAR;
        PG8_STAGE(PG8_SB(1, 0), cB + kstep, voffB); PG8_STAGE(PG8_SA(1, 0), cA + kstep, voffA); PG8_STAGE(PG8_SB(1, 1), cB + hstep + kstep, voffB);
        PG8_WAIT_V(6); PG8_BAR;
    }
    for (;;) {
        const bool has_next = S.next(ui + 1, nxt);
        const char* nA = has_next ? (const char*)g.A + (size_t)nxt.pm * tstep : cA; const char* nB = has_next ? (const char*)g.Bt + (size_t)nxt.pn * tstep : cB;
        for (int t = 0; t < nt; t += 2) {
            const bool last = (t == nt - 2);
            const char* a1 = cA + (size_t)(t + 1) * kstep;
            const char* a2 = last ? nA : cA + (size_t)(t + 2) * kstep; const char* b2 = last ? nB : cB + (size_t)(t + 2) * kstep;
            const char* a3 = a2 + kstep; const char* b3 = b2 + kstep;
            if (last && has_next) S.a_ready(nxt);
            if constexpr (SP2) {
            PG8_LDB(B0, 0, 0); PG8_LDB(B1, 0, 1); PG8_SCHED; PG8_LDA(At, 0, 0); PG8_STAGE(PG8_SA(1, 1), a1 + hstep, voffA);
            PG8_WAIT_V(8); PG8_WAIT_L(0); PG8_BAR; PG8_MMA(0, 0, At, B0); PG8_MMA(0, 1, At, B1); PG8_BAR; PG8_SCHED;
            PG8_LDA(At, 0, 1); PG8_STAGE(PG8_SB(0, 0), b2, voffB); PG8_STAGE(PG8_SB(0, 1), b2 + hstep, voffB); PG8_STAGE(PG8_SA(0, 0), a2, voffA);
            PG8_WAIT_V(8); PG8_WAIT_L(0); PG8_BAR; PG8_MMA(1, 0, At, B0); PG8_MMA(1, 1, At, B1); PG8_BAR; PG8_SCHED;
            PG8_LDB(B0, 1, 0); PG8_LDB(B1, 1, 1); PG8_SCHED; PG8_LDA(At, 1, 0); PG8_STAGE(PG8_SA(0, 1), a2 + hstep, voffA);
            PG8_WAIT_V(8); PG8_WAIT_L(0); PG8_BAR; PG8_MMA(0, 0, At, B0); PG8_MMA(0, 1, At, B1); PG8_BAR; PG8_SCHED;
            PG8_LDA(At, 1, 1); PG8_STAGE(PG8_SB(1, 0), b3, voffB); PG8_STAGE(PG8_SB(1, 1), b3 + hstep, voffB); PG8_STAGE(PG8_SA(1, 0), a3, voffA);
            PG8_WAIT_V(8); PG8_WAIT_L(0); PG8_BAR; PG8_MMA(1, 0, At, B0); PG8_MMA(1, 1, At, B1); PG8_BAR; PG8_SCHED;
            } else {
            PG8_LDB(B0, 0, 0); PG8_SCHED; PG8_LDA(At, 0, 0); PG8_STAGE(PG8_SA(1, 1), a1 + hstep, voffA);
            PG8_WAIT_L(8); PG8_BAR; PG8_WAIT_L(0); PG8_MMA(0, 0, At, B0); PG8_BAR; PG8_SCHED;
            PG8_LDB(B1, 0, 1); PG8_STAGE(PG8_SB(0, 0), b2, voffB);
            PG8_BAR; PG8_WAIT_L(0); PG8_MMA(0, 1, At, B1); PG8_BAR;
            PG8_LDA(At, 0, 1); PG8_STAGE(PG8_SA(0, 0), a2, voffA);
            PG8_BAR; PG8_WAIT_L(0); PG8_MMA(1, 0, At, B0); PG8_BAR; PG8_SCHED;
            PG8_STAGE(PG8_SB(0, 1), b2 + hstep, voffB);
            PG8_WAIT_V(6); PG8_BAR; PG8_MMA(1, 1, At, B1); PG8_BAR;
            PG8_LDB(B0, 1, 0); PG8_SCHED; PG8_LDA(At, 1, 0); PG8_STAGE(PG8_SA(0, 1), a2 + hstep, voffA);
            PG8_WAIT_L(8); PG8_BAR; PG8_WAIT_L(0); PG8_MMA(0, 0, At, B0); PG8_BAR; PG8_SCHED;
            PG8_LDB(B1, 1, 1); PG8_STAGE(PG8_SB(1, 0), b3, voffB);
            PG8_BAR; PG8_WAIT_L(0); PG8_MMA(0, 1, At, B1); PG8_BAR;
            PG8_LDA(At, 1, 1); PG8_STAGE(PG8_SA(1, 0), a3, voffA);
            PG8_BAR; PG8_WAIT_L(0); PG8_MMA(1, 0, At, B0); PG8_BAR; PG8_SCHED;
            PG8_STAGE(PG8_SB(1, 1), b3 + hstep, voffB);
            PG8_WAIT_V(6); PG8_BAR; PG8_MMA(1, 1, At, B1); PG8_BAR;
            }
        }
        if constexpr (ALIGN_EPI) { if (wr == 0) PG8_BAR; }
        if constexpr (!Epi::AFTER_DRAIN) { E(acc, cur, wr, wc, fr, fq); S.done(cur); }
        if (!has_next) break;
#pragma unroll
        for (int a = 0; a < 2; ++a)
#pragma unroll
            for (int b = 0; b < 2; ++b)
#pragma unroll
                for (int m = 0; m < 4; ++m)
#pragma unroll
                    for (int n = 0; n < 2; ++n) acc[a][b][m][n] = (f32x4){0.f, 0.f, 0.f, 0.f};
        cur = nxt; cA = nA; cB = nB; ++ui;
        if constexpr (ALIGN_EPI) { if (wr == 1) PG8_BAR; }
    }
    PG8_WAIT_V(0);
    if constexpr (!ALIGN_EPI) { if (wr == 0) PG8_BAR; }
    PG8_BAR;
    if constexpr (Epi::AFTER_DRAIN) { E.fused(acc, cur, wr, wc, fr, fq, lds, wid, lane); S.done(cur); }
#undef PG8_SA
#undef PG8_SB
#undef PG8_STAGE
#undef PG8_LDA
#undef PG8_LDB
#undef PG8_MMA
#undef PG8_WAIT_V
#undef PG8_WAIT_L
#undef PG8_BAR
#undef PG8_SCHED
}
}

#ifndef PG8_SP2
#define PG8_SP2 true
#endif
#ifndef PG8_ALIGN
#define PG8_ALIGN true
#endif
#ifndef MK_N_LAUNCHES
#define MK_N_LAUNCHES 1
#endif

constexpr int D = 1024, BP = 8, SEQ = 2048, MPR = BP * SEQ  , MS = 128  , MT = MPR + MS  ;
constexpr int NCOND = BP + MS;
constexpr int DFF = 2816, NMOD = 6 * D  , NMODALL = 4 * NMOD  ;
constexpr int RET_IN = 6144, SSD_IN = 5152, SSD_INM = 5120, HG_IN = 4096, FFN_IN = 2 * DFF;
constexpr float EPS = 1e-6f;
constexpr int NWAVES = 8;

constexpr size_t MiB = 1u << 20;
constexpr size_t WS_CTL = 0, CTL_ZERO_BYTES = 1 * MiB;
constexpr size_t WS_WADA = 1 * MiB;
constexpr size_t WS_WRETIN = WS_WADA + 48 * MiB;
constexpr size_t WS_WRETOUT = WS_WRETIN + 24 * MiB;
constexpr size_t WS_WSSDIN = WS_WRETOUT + 8 * MiB;
constexpr size_t WS_WSSDOUT = WS_WSSDIN + 11 * MiB;
constexpr size_t WS_WHGIN = WS_WSSDOUT + 4 * MiB;
constexpr size_t WS_WHGOUT = WS_WHGIN + 8 * MiB;
constexpr size_t WS_WFFNIN = WS_WHGOUT + 2 * MiB;
constexpr size_t WS_WFFNOUT = WS_WFFNIN + 44 * MiB;
constexpr size_t WS_MOD = WS_WFFNOUT + 22 * MiB;
constexpr size_t WS_CACT = WS_MOD + 24 * MiB;
constexpr size_t WS_LB = WS_CACT + 512 * 1024;
constexpr size_t WS_H = WS_CACT + 1 * MiB;
constexpr size_t WS_PROJ = WS_H + 33 * MiB;
constexpr size_t WS_RO = WS_PROJ + 200 * MiB;
constexpr size_t WS_GO = WS_RO + 65 * MiB;
constexpr size_t WS_OUT = WS_GO + 65 * MiB;
constexpr size_t WS_ACT = WS_OUT + 33 * MiB;
constexpr size_t WS_END = WS_ACT + 89 * MiB;
constexpr size_t PJ_RET_Q = 0, PJ_RET_K = PJ_RET_Q + (size_t)MT * 1024 * 2, PJ_RET_V = PJ_RET_K + (size_t)MT * 1024 * 2, PJ_RET_SG = PJ_RET_V + (size_t)MT * 2048 * 2;
constexpr size_t PJ_SSD_SZ = 0, PJ_SSD_XBC = PJ_SSD_SZ + (size_t)MT * 2048 * 2, PJ_SSD_DT = PJ_SSD_XBC + (size_t)MT * 3072 * 2;
constexpr size_t PJ_HG_Q = 0, PJ_HG_LA = PJ_HG_Q + (size_t)MT * 1024 * 2, PJ_HG_V = PJ_HG_LA + (size_t)MT * 1024 * 4, PJ_HG_SG = PJ_HG_V + (size_t)MT * 1024 * 2;
static_assert(PJ_RET_SG + (size_t)MT * 2048 * 2 <= 200 * MiB && PJ_SSD_DT + (size_t)MT * 32 * 4 <= 200 * MiB && PJ_HG_SG + (size_t)MT * 1024 * 2 <= 200 * MiB, "proj map");
constexpr int CW_BAR = 4096;

constexpr size_t O_Y = 0;
constexpr size_t O_RETP = (size_t)MT * D;
constexpr size_t O_RETS = O_RETP + (size_t)2 * 8 * 4 * 256 * 512;
constexpr size_t O_SSDP = O_RETS + (size_t)2 * 128 * 4 * 256 * 512;
constexpr size_t O_SSDS = O_SSDP + (size_t)8 * 32 * 128 * 64;
constexpr size_t O_CONVP = O_SSDS + (size_t)128 * 32 * 128 * 64;
constexpr size_t O_CONVS = O_CONVP + (size_t)8 * 3 * 3072;
constexpr size_t O_HGP = O_CONVS + (size_t)128 * 3 * 3072;
constexpr size_t O_HGS = O_HGP + (size_t)8 * 8 * 128 * 128;
constexpr size_t O_END = O_HGS + (size_t)128 * 8 * 128 * 128;
static_assert(O_END == 214245376ull, "output size");

constexpr int LDS_BYTES = 147456;
constexpr int LDSCTL_OFF = LDS_BYTES - 1024;
constexpr int SCR_BYTES = LDSCTL_OFF;

#define GAS __attribute__((address_space(1)))
#define LAS __attribute__((address_space(3)))
typedef unsigned short bf16;
typedef unsigned v4u __attribute__((ext_vector_type(4)));
typedef unsigned v2u __attribute__((ext_vector_type(2)));
typedef float f32x4 __attribute__((ext_vector_type(4)));
typedef short bf16x8 __attribute__((ext_vector_type(8)));
typedef short s16x4 __attribute__((ext_vector_type(4)));
typedef GAS unsigned gu32;
#define RLX_AGENT __ATOMIC_RELAXED, __HIP_MEMORY_SCOPE_AGENT
#define LDS_WAIT() asm volatile("s_waitcnt lgkmcnt(0)" ::: "memory")
#define VM_WAIT() asm volatile("s_waitcnt vmcnt(0)" ::: "memory")
typedef float f32x2_t __attribute__((ext_vector_type(2))); typedef __bf16 bf16x2_t __attribute__((ext_vector_type(2)));
__device__ __forceinline__ unsigned cvt_pk_bf16(float lo, float hi) { f32x2_t v = {lo, hi}; bf16x2_t b = __builtin_convertvector(v, bf16x2_t); return __builtin_bit_cast(unsigned, b); }
__device__ __forceinline__ float bf2f(unsigned b) { return __uint_as_float(b << 16); }
__device__ __forceinline__ float bflo(unsigned w) { return __uint_as_float(w << 16); }
__device__ __forceinline__ float bfhi(unsigned w) { return __uint_as_float(w & 0xffff0000u); }
__device__ __forceinline__ void unpack8(const v4u w, float (&f)[8]) { f[0] = bflo(w.x); f[1] = bfhi(w.x); f[2] = bflo(w.y); f[3] = bfhi(w.y); f[4] = bflo(w.z); f[5] = bfhi(w.z); f[6] = bflo(w.w); f[7] = bfhi(w.w); }
__device__ __forceinline__ v4u pack8(const float (&f)[8]) { v4u w; w.x = cvt_pk_bf16(f[0], f[1]); w.y = cvt_pk_bf16(f[2], f[3]); w.z = cvt_pk_bf16(f[4], f[5]); w.w = cvt_pk_bf16(f[6], f[7]); return w; }
__device__ __forceinline__ v4u pack8v(const f32x4 a, const f32x4 b) { v4u w; w.x = cvt_pk_bf16(a[0], a[1]); w.y = cvt_pk_bf16(a[2], a[3]); w.z = cvt_pk_bf16(b[0], b[1]); w.w = cvt_pk_bf16(b[2], b[3]); return w; }
__device__ __forceinline__ v2u pack4v(const f32x4 a) { v2u w; w.x = cvt_pk_bf16(a[0], a[1]); w.y = cvt_pk_bf16(a[2], a[3]); return w; }
__device__ __forceinline__ float sigmoidf_(float x) { return __builtin_amdgcn_rcpf(1.f + __expf(-x)); }
__device__ __forceinline__ float siluf_(float x) { return x * sigmoidf_(x); }
__device__ __forceinline__ float softplusf_(float x) { return x > 20.f ? x : log1pf(__expf(x)); }
__device__ __forceinline__ float wave_sum(float v) {
#pragma unroll
    for (int o = 1; o < 64; o <<= 1) v += __shfl_xor(v, o);
    return v;
}
__device__ __forceinline__ float grp16_sum(float v) {
#pragma unroll
    for (int o = 1; o < 16; o <<= 1) v += __shfl_xor(v, o);
    return v;
}
#define MFMA16(a, b, c) __builtin_amdgcn_mfma_f32_16x16x32_bf16((a), (b), (c), 0, 0, 0)
#define XB_TMO      128
#define XB_XCNT(j)  (256  + 64 * (j))
#define XB_XSUB(j)  (1280 + 64 * (j))
#define XB_XGEN(j)  (2304 + 64 * (j))
#define XB_TOP      3328
#define XB_TOPGEN   3392
#define XCD_BAR_WORDS 3456
#define XB_SPIN_CAP (1u << 18)

__device__ __forceinline__ unsigned xb_ld(unsigned* p)              { return __hip_atomic_load(p, __ATOMIC_RELAXED, __HIP_MEMORY_SCOPE_AGENT); }
__device__ __forceinline__ unsigned xb_add(unsigned* p, unsigned v) { return __hip_atomic_fetch_add(p, v, __ATOMIC_RELAXED, __HIP_MEMORY_SCOPE_AGENT); }
__device__ __forceinline__ unsigned xb_xcc_id() { return (unsigned)__builtin_amdgcn_s_getreg((3 << 11) | 20) & 0xFu; }
#define XB_SPIN(cond, bar) do { unsigned _sp = 0; while (cond) { __builtin_amdgcn_s_sleep(1); \
    if ((++_sp & 255u) == 0u) { if (xb_ld(&(bar)[XB_TMO])) break; if (_sp > XB_SPIN_CAP) { atomicAdd(&(bar)[XB_TMO], 1u); break; } } } } while (0)

struct XcdBarrier {
    unsigned* bar; unsigned x;
    volatile LAS unsigned* st;
};

__device__ __forceinline__ XcdBarrier xcd_barrier_post(unsigned* bar, volatile LAS unsigned* st) {
    XcdBarrier b; b.bar = bar; b.x = xb_xcc_id(); b.st = st;
    if (threadIdx.x == 0) (void)xb_add(&bar[XB_XCNT(b.x)], 1u);
    return b;
}
__device__ __forceinline__ void xcd_barrier_complete(unsigned* bar, unsigned x, unsigned& nloc, unsigned& nx) {
    const unsigned G = gridDim.x * gridDim.y * gridDim.z;
    unsigned sum, cnt, mine, sp = 0u;
    for (;;) {
        sum = 0u; cnt = 0u; mine = 0u;
#pragma unroll
        for (unsigned j = 0; j < 16; ++j) { const unsigned c = xb_ld(&bar[XB_XCNT(j)]); sum += c; cnt += (c > 0u) ? 1u : 0u; mine = (j == x) ? c : mine; }
        if (sum == G) break;
        __builtin_amdgcn_s_sleep(1);
        if ((++sp & 255u) == 0u) { if (xb_ld(&bar[XB_TMO])) break; if (sp > XB_SPIN_CAP) { atomicAdd(&bar[XB_TMO], 1u); break; } }
    }
    nloc = mine > 0u ? mine : 1u; nx = cnt > 0u ? cnt : 1u;
}

__device__ __forceinline__ void xcd_barrier(const XcdBarrier& b) {
    asm volatile("s_waitcnt vmcnt(0)" ::: "memory");
    __syncthreads();
    if (threadIdx.x == 0) {
        unsigned* bar = b.bar;
        __builtin_amdgcn_s_waitcnt(0);
        unsigned nloc = b.st[0], nx = b.st[1];
        if (nloc == 0u) { xcd_barrier_complete(bar, b.x, nloc, nx); b.st[0] = nloc; b.st[1] = nx; }
        const unsigned old = xb_add(&bar[XB_XSUB(b.x)], 1u);
        const unsigned gen = old / nloc;
        if (old + 1u == (gen + 1u) * nloc) {
            __builtin_amdgcn_fence(__ATOMIC_RELEASE, "agent");
            asm volatile("s_waitcnt vmcnt(0)" ::: "memory");
            const unsigned og = xb_add(&bar[XB_TOP], 1u);
            const unsigned tg = og / nx;
            if (og + 1u == (tg + 1u) * nx) xb_add(&bar[XB_TOPGEN], 1u);
            else XB_SPIN(xb_ld(&bar[XB_TOPGEN]) == tg, bar);
            __builtin_amdgcn_fence(__ATOMIC_ACQUIRE, "agent");
            xb_add(&bar[XB_XGEN(b.x)], 1u);
            asm volatile("s_waitcnt vmcnt(0)" ::: "memory");
        } else {
            XB_SPIN(xb_ld(&bar[XB_XGEN(b.x)]) == gen, bar);
            __builtin_amdgcn_fence(__ATOMIC_ACQUIRE, "agent");
            asm volatile("s_waitcnt vmcnt(0)" ::: "memory");
        }
    }
    __syncthreads();
}


struct Frame {
    LAS unsigned char* lds;
    int tid, lane, wave;
    int vcu, G;
};

template <class Fn> struct EpiGen {
    static constexpr bool PERM = true, AFTER_DRAIN = false;
    Fn f;
    __device__ __forceinline__ void operator()(const pg8::f32x4 (&acc)[2][2][4][2], const pg8::Unit& u, int wr, int wc, int fr, int fq) const {
        const int ca = u.pn * 256 + wc * 32 + 8 * fq;
#pragma unroll
        for (int ai = 0; ai < 2; ++ai)
#pragma unroll
            for (int m = 0; m < 4; ++m) {
                const int row = u.pm * 256 + ai * 128 + wr * 64 + m * 16 + fr;
                f.emit(row, ca, ca + 128, acc[ai][0][m][0], acc[ai][0][m][1], acc[ai][1][m][0], acc[ai][1][m][1]);
            }
    }
};
__device__ __forceinline__ void st8bf(bf16* p, const f32x4 a, const f32x4 b) { *(GAS v4u*)p = pack8v(a, b); }
__device__ __forceinline__ f32x4 silu4(const f32x4 a) { f32x4 r; r[0] = siluf_(a[0]); r[1] = siluf_(a[1]); r[2] = siluf_(a[2]); r[3] = siluf_(a[3]); return r; }

struct EmitRetIn {
    bf16 *Q, *K, *V, *SG;
    __device__ __forceinline__ void emit(int row, int ca, int cb, const f32x4 a0, const f32x4 a1, const f32x4 b0, const f32x4 b1) const {
        const int pn = ca >> 8, ch = ca & 255;
        if (pn < 8) {
            const float pos = row < MPR ? (float)(row & (SEQ - 1)) : 16384.f;
            const float sc = pn < 4 ? 1.f : 0.0625f;
            float x1[8] = {a0[0], a0[1], a0[2], a0[3], a1[0], a1[1], a1[2], a1[3]}, x2[8] = {b0[0], b0[1], b0[2], b0[3], b1[0], b1[1], b1[2], b1[3]}, o1[8], o2[8];
#pragma unroll
            for (int e = 0; e < 8; ++e) {
                const float inv = exp2f(-(float)(ch + e) * (13.287712379549449f / 128.f));
                float t = pos * inv * 0.15915494309189535f; t -= floorf(t);
                const float s = __builtin_amdgcn_sinf(t), c = __builtin_amdgcn_cosf(t);
                o1[e] = (x1[e] * c - x2[e] * s) * sc; o2[e] = (x2[e] * c + x1[e] * s) * sc;
            }
            bf16* dst = (pn < 4 ? Q : K) + (size_t)row * 1024 + (pn & 3) * 256 + ch;
            *(GAS v4u*)dst = pack8(o1); *(GAS v4u*)(dst + 128) = pack8(o2);
        } else if (pn < 16) {
            bf16* dst = V + (size_t)row * 2048 + (pn - 8) * 256 + ch; st8bf(dst, a0, a1); st8bf(dst + 128, b0, b1);
        } else {
            bf16* dst = SG + (size_t)row * 2048 + (pn - 16) * 256 + ch; st8bf(dst, silu4(a0), silu4(a1)); st8bf(dst + 128, silu4(b0), silu4(b1));
        }
    }
};
struct EmitSsdIn {
    bf16 *SZ, *XBC;
    __device__ __forceinline__ void emit(int row, int ca, int cb, const f32x4 a0, const f32x4 a1, const f32x4 b0, const f32x4 b1) const {
        const int pn = ca >> 8, ch = ca & 255;
        if (pn < 8) { bf16* dst = SZ + (size_t)row * 2048 + pn * 256 + ch; st8bf(dst, silu4(a0), silu4(a1)); st8bf(dst + 128, silu4(b0), silu4(b1)); }
        else { bf16* dst = XBC + (size_t)row * 3072 + (pn - 8) * 256 + ch; st8bf(dst, a0, a1); st8bf(dst + 128, b0, b1); }
    }
};
struct EmitDt {
    float* DT;
    __device__ __forceinline__ void emit(int row, int ca, int cb, const f32x4 a0, const f32x4 a1, const f32x4 b0, const f32x4 b1) const {
        float* d = DT + (size_t)row * 32; *(GAS f32x4*)(d + (ca - SSD_INM)) = a0; *(GAS f32x4*)(d + (ca - SSD_INM) + 4) = a1; *(GAS f32x4*)(d + (cb - SSD_INM)) = b0; *(GAS f32x4*)(d + (cb - SSD_INM) + 4) = b1;
    }
};
struct EmitHgIn {
    bf16 *HQ, *HV, *HSG; float* LA; const float* lb;
    __device__ __forceinline__ f32x4 logf4(const f32x4 x, const float* l) const { f32x4 r;
#pragma unroll
        for (int e = 0; e < 4; ++e) { const float b = l[e]; r[e] = logf(b + (1.f - b) * sigmoidf_(x[e])); } return r; }
    __device__ __forceinline__ void emit(int row, int ca, int cb, const f32x4 a0, const f32x4 a1, const f32x4 b0, const f32x4 b1) const {
        const int pn = ca >> 8, ch = ca & 255;
        if (pn < 4) { bf16* dst = HQ + (size_t)row * 1024 + pn * 256 + ch; const float s = 0.08838834764831845f; st8bf(dst, silu4(a0) * s, silu4(a1) * s); st8bf(dst + 128, silu4(b0) * s, silu4(b1) * s); }
        else if (pn < 8) { const int col = (pn - 4) * 256 + ch; float* dst = LA + (size_t)row * 1024 + col;
            *(GAS f32x4*)dst = logf4(a0, lb + col); *(GAS f32x4*)(dst + 4) = logf4(a1, lb + col + 4); *(GAS f32x4*)(dst + 128) = logf4(b0, lb + col + 128); *(GAS f32x4*)(dst + 132) = logf4(b1, lb + col + 132); }
        else if (pn < 12) { bf16* dst = HV + (size_t)row * 1024 + (pn - 8) * 256 + ch; st8bf(dst, a0, a1); st8bf(dst + 128, b0, b1); }
        else { bf16* dst = HSG + (size_t)row * 1024 + (pn - 12) * 256 + ch; st8bf(dst, silu4(a0), silu4(a1)); st8bf(dst + 128, silu4(b0), silu4(b1)); }
    }
};
struct EmitOut {
    bf16* OUT;
    __device__ __forceinline__ void emit(int row, int ca, int cb, const f32x4 a0, const f32x4 a1, const f32x4 b0, const f32x4 b1) const {
        bf16* dst = OUT + (size_t)row * 1024; st8bf(dst + ca, a0, a1); st8bf(dst + cb, b0, b1);
    }
};
struct EmitFfnIn {
    bf16* ACT;
    __device__ __forceinline__ void emit(int row, int ca, int cb, const f32x4 a0, const f32x4 a1, const f32x4 b0, const f32x4 b1) const {
        bf16* dst = ACT + (size_t)row * DFF + (ca >> 8) * 128 + (ca & 255); st8bf(dst, silu4(a0) * b0, silu4(a1) * b1);
    }
};
struct EmitMod {
    float* MOD; const float* bias;
    __device__ __forceinline__ void emit(int row, int ca, int cb, const f32x4 a0, const f32x4 a1, const f32x4 b0, const f32x4 b1) const {
        float* d = MOD + (size_t)row * NMODALL;
        *(GAS f32x4*)(d + ca) = a0 + *(const GAS f32x4*)(bias + ca); *(GAS f32x4*)(d + ca + 4) = a1 + *(const GAS f32x4*)(bias + ca + 4);
        *(GAS f32x4*)(d + cb) = b0 + *(const GAS f32x4*)(bias + cb); *(GAS f32x4*)(d + cb + 4) = b1 + *(const GAS f32x4*)(bias + cb + 4);
    }
};

template <class Fn>
__device__ __forceinline__ void skinny_gemm(Frame& F, const bf16* A, int K, int nrg, int rowbase, const bf16* Bt, int ncu, bool dtmode, const Fn& f, int wg0) {
    const int w = F.wave, lane = F.lane, fr = lane & 15, fq = lane >> 4, KW = K >> 3;
    LAS float* red = (LAS float*)F.lds;
    const int nun = nrg * ncu;
    int first = (F.vcu - wg0) % F.G; if (first < 0) first += F.G;
    for (int u = first; u < nun; u += F.G) {
        const int rg = u / ncu, cu = u - rg * ncu;
        int ca, cb; if (dtmode) { ca = SSD_INM; cb = SSD_INM + 16; } else { ca = 256 * (cu >> 3) + 16 * (cu & 7); cb = ca + 128; }
        const bf16* ap = A + (size_t)(rg * 128 + fr) * K + w * KW + fq * 8;
        const bf16* bpa = Bt + (size_t)(ca + fr) * K + w * KW + fq * 8;
        const bf16* bpb = Bt + (size_t)(cb + fr) * K + w * KW + fq * 8;
        f32x4 acc[8][2];
#pragma unroll
        for (int mt = 0; mt < 8; ++mt) { acc[mt][0] = (f32x4){0.f, 0.f, 0.f, 0.f}; acc[mt][1] = (f32x4){0.f, 0.f, 0.f, 0.f}; }
        for (int k0 = 0; k0 < KW; k0 += 32) {
            const bf16x8 b0 = *(const GAS bf16x8*)(bpa + k0), b1 = *(const GAS bf16x8*)(bpb + k0);
            bf16x8 a[8];
#pragma unroll
            for (int mt = 0; mt < 8; ++mt) a[mt] = *(const GAS bf16x8*)(ap + (size_t)mt * 16 * K + k0);
#pragma unroll
            for (int mt = 0; mt < 8; ++mt) { acc[mt][0] = MFMA16(a[mt], b0, acc[mt][0]); acc[mt][1] = MFMA16(a[mt], b1, acc[mt][1]); }
        }
        __syncthreads();
#pragma unroll
        for (int mt = 0; mt < 8; ++mt)
#pragma unroll
            for (int nt = 0; nt < 2; ++nt)
#pragma unroll
                for (int r = 0; r < 4; ++r) red[(w * 128 + mt * 16 + fq * 4 + r) * 33 + nt * 16 + fr] = acc[mt][nt][r];
        __syncthreads();
        if (F.tid < 256) {
            const int row = F.tid >> 1, hf = F.tid & 1;
            float va[8], vb[8];
#pragma unroll
            for (int e = 0; e < 8; ++e) { va[e] = 0.f; vb[e] = 0.f; }
#pragma unroll
            for (int ww = 0; ww < 8; ++ww) { const LAS float* p = red + (ww * 128 + row) * 33 + hf * 8;
#pragma unroll
                for (int e = 0; e < 8; ++e) { va[e] += p[e]; vb[e] += p[16 + e]; } }
            f.emit(rowbase + rg * 128 + row, ca + hf * 8, cb + hf * 8, (f32x4){va[0], va[1], va[2], va[3]}, (f32x4){va[4], va[5], va[6], va[7]}, (f32x4){vb[0], vb[1], vb[2], vb[3]}, (f32x4){vb[4], vb[5], vb[6], vb[7]});
        }
    }
    __syncthreads();
}
static_assert(8 * 128 * 33 * 4 <= SCR_BYTES, "skinny reduction buffer");

__device__ __forceinline__ int cond_of_row(int row) { return row < MPR ? (row >> 11) : (BP + row - MPR); }
template <int MODE>
__device__ __forceinline__ void resnorm_phase(Frame& F, const float* xp, const float* xs, float* X, const bf16* Y, bf16* H, const float* MOD,
                                              const float* wpost, int goff, const float* wpre, int shoff, int scoff) {
    const int gw = F.vcu * NWAVES + F.wave, NGW = F.G * NWAVES, lane = F.lane;
    for (int row = gw; row < MT; row += NGW) {
        const float* modr = MOD + (size_t)cond_of_row(row) * NMODALL;
        f32x4 x[4];
        if (MODE == 0) {
            const float* src = row < MPR ? xp + (size_t)row * D : xs + (size_t)(row - MPR) * D;
#pragma unroll
            for (int j = 0; j < 4; ++j) x[j] = *(const GAS f32x4*)(src + 4 * lane + 256 * j);
        } else {
            f32x4 y[4]; float ss = 0.f;
#pragma unroll
            for (int j = 0; j < 4; ++j) { x[j] = *(const GAS f32x4*)(X + (size_t)row * D + 4 * lane + 256 * j);
                const v2u yw = *(const GAS v2u*)(Y + (size_t)row * D + 4 * lane + 256 * j);
                y[j] = (f32x4){bflo(yw.x), bfhi(yw.x), bflo(yw.y), bfhi(yw.y)};
                ss += (y[j][0] * y[j][0] + y[j][1] * y[j][1]) + (y[j][2] * y[j][2] + y[j][3] * y[j][3]); }
            const float r1 = rsqrtf(wave_sum(ss) * (1.f / D) + EPS);
#pragma unroll
            for (int j = 0; j < 4; ++j) { const f32x4 g = *(const GAS f32x4*)(modr + goff + 4 * lane + 256 * j), wp = *(const GAS f32x4*)(wpost + 4 * lane + 256 * j);
                x[j] = x[j] + g * (y[j] * r1) * wp; }
        }
#pragma unroll
        for (int j = 0; j < 4; ++j) *(GAS f32x4*)(X + (size_t)row * D + 4 * lane + 256 * j) = x[j];
        if (MODE != 2) {
            float s2 = 0.f;
#pragma unroll
            for (int j = 0; j < 4; ++j) s2 += (x[j][0] * x[j][0] + x[j][1] * x[j][1]) + (x[j][2] * x[j][2] + x[j][3] * x[j][3]);
            const float r2 = rsqrtf(wave_sum(s2) * (1.f / D) + EPS);
#pragma unroll
            for (int j = 0; j < 4; ++j) { const int c = 4 * lane + 256 * j;
                const f32x4 wp = *(const GAS f32x4*)(wpre + c), sc = *(const GAS f32x4*)(modr + scoff + c), sh = *(const GAS f32x4*)(modr + shoff + c);
                const f32x4 h = (x[j] * r2) * wp * (sc + 1.f) + sh;
                *(GAS v2u*)(H + (size_t)row * D + c) = pack4v(h); }
        }
    }
}
template <int MIX>
__device__ __forceinline__ void gatenorm_phase(Frame& F, const bf16* RO, const bf16* GATE, bf16* GO, const float* nw) {
    const int gw = F.vcu * NWAVES + F.wave, NGW = F.G * NWAVES, lane = F.lane;
    constexpr int W = (MIX == 2) ? 1024 : 2048, NJ = W / 512;
    for (int row = gw; row < MT; row += NGW) {
        float u[NJ][8], r[NJ];
#pragma unroll
        for (int j = 0; j < NJ; ++j) {
            const int c = 8 * lane + 512 * j;
            float o[8], g[8];
            unpack8(*(const GAS v4u*)(RO + (size_t)row * W + c), o); unpack8(*(const GAS v4u*)(GATE + (size_t)row * W + c), g);
            float ss = 0.f;
#pragma unroll
            for (int e = 0; e < 8; ++e) {
                if (MIX == 0) { u[j][e] = o[e] * g[e]; ss += o[e] * o[e]; }
                else if (MIX == 1) { u[j][e] = o[e] * g[e]; ss += u[j][e] * u[j][e]; }
                else { u[j][e] = o[e] * g[e]; ss += o[e] * o[e]; }
            }
            if (MIX == 2) r[j] = rsqrtf(grp16_sum(ss) * (1.f / 128.f) + EPS); else r[j] = rsqrtf(wave_sum(ss) * (1.f / 512.f) + EPS);
        }
#pragma unroll
        for (int j = 0; j < NJ; ++j) {
            const int c = 8 * lane + 512 * j;
            float v[8];
#pragma unroll
            for (int e = 0; e < 8; ++e) { float wgt = 1.f; if (MIX == 1) wgt = nw[c + e]; if (MIX == 2) wgt = nw[(c + e) & 127]; v[e] = u[j][e] * r[j] * wgt; }
            *(GAS v4u*)(GO + (size_t)row * W + c) = pack8(v);
        }
    }
}

template <int OFF> __device__ __forceinline__ bf16x8 tr_frag(unsigned addr) {
    s16x4 lo, hi;
    asm volatile("ds_read_b64_tr_b16 %0, %2\n\tds_read_b64_tr_b16 %1, %2 offset:%3\n\ts_waitcnt lgkmcnt(0)" : "=&v"(lo), "=&v"(hi) : "v"(addr), "i"(OFF) : "memory");
    return __builtin_shufflevector(lo, hi, 0, 1, 2, 3, 4, 5, 6, 7);
}
template <int OFF> __device__ __forceinline__ void tr_frag2(unsigned a0, unsigned a1, bf16x8& f0, bf16x8& f1) {
    s16x4 l0, h0, l1, h1;
    asm volatile("ds_read_b64_tr_b16 %0, %4\n\tds_read_b64_tr_b16 %1, %4 offset:%6\n\tds_read_b64_tr_b16 %2, %5\n\tds_read_b64_tr_b16 %3, %5 offset:%6\n\ts_waitcnt lgkmcnt(0)"
                 : "=&v"(l0), "=&v"(h0), "=&v"(l1), "=&v"(h1) : "v"(a0), "v"(a1), "i"(OFF) : "memory");
    f0 = __builtin_shufflevector(l0, h0, 0, 1, 2, 3, 4, 5, 6, 7); f1 = __builtin_shufflevector(l1, h1, 0, 1, 2, 3, 4, 5, 6, 7);
}

template <class Cf, class OutFn>
__device__ __forceinline__ void rec_step(LAS unsigned char* lds, const int w, const int lane, f32x4 (&S)[Cf::KPW][Cf::VS / 16], const LAS float* cum, const OutFn& out, const int tok0) {
    constexpr int C = Cf::C, KD = Cf::KD, VS = Cf::VS, NIT = C / 16, NJT = C / 16, NVT = VS / 16, KSK = KD / 32, KSC = C / 32;
    constexpr int RSK = Cf::RSK, RSV = Cf::RSV, RSP = Cf::RSP;
    constexpr bool CH = Cf::CH;
    const int fr = lane & 15, fq = lane >> 4, q4 = fr >> 2, p4 = fr & 3;
    const unsigned lbase = (unsigned)(size_t)lds;
    constexpr int NP = NIT * NJT, PPW = (NP + 7) / 8;
#pragma unroll
    for (int tt = 0; tt < PPW; ++tt) { const int t = w + 8 * tt;
        if (t < NP) { const int it = t / NJT, jt = t % NJT;
            f32x4 p = (f32x4){0.f, 0.f, 0.f, 0.f};
            if (jt <= it) {
#pragma unroll
                for (int ks = 0; ks < KSK; ++ks) {
                    const bf16x8 a = *(const LAS bf16x8*)(lds + Cf::KA + (16 * jt + fr) * RSK + (32 * ks + 8 * fq) * 2);
                    const bf16x8 b = *(const LAS bf16x8*)(lds + Cf::QA + (16 * it + fr) * RSK + (32 * ks + 8 * fq) * 2);
                    p = MFMA16(a, b, p); }
                const int i = 16 * it + fr;
                if (!CH) { const float ci = cum[i];
#pragma unroll
                    for (int r = 0; r < 4; ++r) { const int j = 16 * jt + 4 * fq + r; const float e = __expf(fminf(ci - cum[j], 0.f)); p[r] = (j <= i) ? p[r] * e : 0.f; } }
                else {
#pragma unroll
                    for (int r = 0; r < 4; ++r) { const int j = 16 * jt + 4 * fq + r; p[r] = (j <= i) ? p[r] : 0.f; } }
            }
            *(LAS v2u*)(lds + Cf::PM + (16 * it + fr) * RSP + (16 * jt + 4 * fq) * 2) = pack4v(p);
        } }
    constexpr int NO = NVT * NIT, OPW = (NO + 7) / 8;
    f32x4 O[OPW];
#pragma unroll
    for (int tt = 0; tt < OPW; ++tt) { const int t = w + 8 * tt; O[tt] = (f32x4){0.f, 0.f, 0.f, 0.f};
        if (t < NO) { const int vt = t / NIT, it = t % NIT; f32x4 o = (f32x4){0.f, 0.f, 0.f, 0.f};
#pragma unroll
            for (int ks = 0; ks < KSK; ++ks) {
                const bf16x8 a = *(const LAS bf16x8*)(lds + Cf::ST + (16 * vt + fr) * RSK + (32 * ks + 8 * fq) * 2);
                const bf16x8 b = *(const LAS bf16x8*)(lds + Cf::QB + (16 * it + fr) * RSK + (32 * ks + 8 * fq) * 2);
                o = MFMA16(a, b, o); }
            if (!CH) o = o * __expf(cum[16 * it + fr]);
            O[tt] = o; } }
#pragma unroll
    for (int ki = 0; ki < Cf::KPW; ++ki) { const int kt = w + 8 * ki;
        if (!CH) { const float d = __expf(cum[C - 1]);
#pragma unroll
            for (int vt = 0; vt < NVT; ++vt) S[ki][vt] = S[ki][vt] * d; }
        else { const LAS float* ds = (const LAS float*)(lds + Cf::DS) + 16 * kt + 4 * fq; const f32x4 d = (f32x4){ds[0], ds[1], ds[2], ds[3]};
#pragma unroll
            for (int vt = 0; vt < NVT; ++vt) S[ki][vt] = S[ki][vt] * d; }
#pragma unroll
        for (int ks = 0; ks < KSC; ++ks) {
            const bf16x8 a = tr_frag<4 * RSK>(lbase + Cf::KB + (32 * ks + 8 * fq + q4) * RSK + (16 * kt + 4 * p4) * 2);
#pragma unroll
            for (int vt = 0; vt < NVT; vt += 2) { bf16x8 b0, b1;
                tr_frag2<4 * RSV>(lbase + Cf::VB + (32 * ks + 8 * fq + q4) * RSV + (16 * vt + 4 * p4) * 2, lbase + Cf::VB + (32 * ks + 8 * fq + q4) * RSV + (16 * (vt + 1) + 4 * p4) * 2, b0, b1);
                S[ki][vt] = MFMA16(a, b0, S[ki][vt]); S[ki][vt + 1] = MFMA16(a, b1, S[ki][vt + 1]); } } }
    __syncthreads();
#pragma unroll
    for (int tt = 0; tt < OPW; ++tt) { const int t = w + 8 * tt;
        if (t < NO) { const int vt = t / NIT, it = t % NIT; f32x4 o = O[tt];
#pragma unroll
            for (int ks = 0; ks < KSC; ++ks) {
                const bf16x8 a = tr_frag<4 * RSV>(lbase + Cf::V + (32 * ks + 8 * fq + q4) * RSV + (16 * vt + 4 * p4) * 2);
                const bf16x8 b = *(const LAS bf16x8*)(lds + Cf::PM + (16 * it + fr) * RSP + (32 * ks + 8 * fq) * 2);
                o = MFMA16(a, b, o); }
            out(tok0 + 16 * it + fr, 16 * it + fr, 16 * vt + 4 * fq, o); } }
#pragma unroll
    for (int ki = 0; ki < Cf::KPW; ++ki) { const int kt = w + 8 * ki;
#pragma unroll
        for (int vt = 0; vt < NVT; ++vt) *(LAS v2u*)(lds + Cf::ST + (16 * vt + fr) * RSK + (16 * kt + 4 * fq) * 2) = pack4v(S[ki][vt]); }
    __syncthreads();
}
template <class Cf> __device__ __forceinline__ void rec_zero_state(Frame& F, f32x4 (&S)[Cf::KPW][Cf::VS / 16]) {
#pragma unroll
    for (int ki = 0; ki < Cf::KPW; ++ki)
#pragma unroll
        for (int vt = 0; vt < Cf::VS / 16; ++vt) S[ki][vt] = (f32x4){0.f, 0.f, 0.f, 0.f};
    for (int o = F.tid * 16; o < Cf::VS * Cf::RSK; o += 512 * 16) *(LAS v4u*)(F.lds + Cf::ST + o) = (v4u){0u, 0u, 0u, 0u};
}
template <class Cf> __device__ __forceinline__ void rec_store_state(Frame& F, const f32x4 (&S)[Cf::KPW][Cf::VS / 16], float* dst, int ldv) {
    const int fr = F.lane & 15, fq = F.lane >> 4;
#pragma unroll
    for (int ki = 0; ki < Cf::KPW; ++ki) { const int kt = F.wave + 8 * ki;
#pragma unroll
        for (int vt = 0; vt < Cf::VS / 16; ++vt)
#pragma unroll
            for (int r = 0; r < 4; ++r) dst[(size_t)(16 * kt + 4 * fq + r) * ldv + 16 * vt + fr] = S[ki][vt][r]; }
}

struct CfRet { static constexpr int C = 64, KD = 256, VS = 64, KPW = 2, RSK = 528, RSV = 144, RSP = 144; static constexpr bool CH = false;
    static constexpr int QA = 0, KA = 33792, QB = QA, KB = KA, V = 67584, VB = 76800, PM = 86016, ST = 95232, CUM = 129024, DS = 0, END = 129280; };
static_assert(CfRet::END <= SCR_BYTES, "ret lds");
struct RetOut { bf16* dst;
    __device__ __forceinline__ void operator()(int tok, int i, int vv0, const f32x4 o) const { *(GAS v2u*)(dst + (size_t)tok * 2048 + vv0) = pack4v(o); } };
__device__ __forceinline__ void ret_prompt_item(Frame& F, int item, const bf16* Q, const bf16* K, const bf16* V, bf16* RO, float* st_out) {
    const int b = item >> 5, h = (item >> 3) & 3, vs = item & 7, tid = F.tid;
    const float lg = logf(1.f - exp2f(-5.f - (float)h));
    LAS float* cum = (LAS float*)(F.lds + CfRet::CUM);
    __syncthreads();
    if (tid < 64) cum[tid] = (float)(tid + 1) * lg;
    f32x4 S[CfRet::KPW][4];
    rec_zero_state<CfRet>(F, S);
    const bf16* qg = Q + (size_t)(b * SEQ) * 1024 + h * 256; const bf16* kg = K + (size_t)(b * SEQ) * 1024 + h * 256; const bf16* vg = V + (size_t)(b * SEQ) * 2048 + h * 512 + vs * 64;
    const RetOut out{RO + (size_t)(b * SEQ) * 2048 + h * 512 + vs * 64};
    v4u qr[4], kr[4], vr;
#pragma unroll
    for (int i = 0; i < 4; ++i) { const int pc = tid + 512 * i, row = pc >> 5, c16 = pc & 31; qr[i] = *(const GAS v4u*)(qg + (size_t)row * 1024 + c16 * 8); kr[i] = *(const GAS v4u*)(kg + (size_t)row * 1024 + c16 * 8); }
    vr = *(const GAS v4u*)(vg + (size_t)(tid >> 3) * 2048 + (tid & 7) * 8);
    const float vsc = __expf((float)(63 - (tid >> 3)) * lg);
    for (int c = 0; c < SEQ / 64; ++c) {
#pragma unroll
        for (int i = 0; i < 4; ++i) { const int pc = tid + 512 * i, row = pc >> 5, c16 = pc & 31;
            *(LAS v4u*)(F.lds + CfRet::QA + row * 528 + c16 * 16) = qr[i]; *(LAS v4u*)(F.lds + CfRet::KA + row * 528 + c16 * 16) = kr[i]; }
        { const int row = tid >> 3, c16 = tid & 7; *(LAS v4u*)(F.lds + CfRet::V + row * 144 + c16 * 16) = vr;
          float f[8]; unpack8(vr, f);
#pragma unroll
          for (int e = 0; e < 8; ++e) f[e] *= vsc;
          *(LAS v4u*)(F.lds + CfRet::VB + row * 144 + c16 * 16) = pack8(f); }
        if (c + 1 < SEQ / 64) { const size_t r0 = (size_t)(c + 1) * 64;
#pragma unroll
            for (int i = 0; i < 4; ++i) { const int pc = tid + 512 * i, row = pc >> 5, c16 = pc & 31; qr[i] = *(const GAS v4u*)(qg + (r0 + row) * 1024 + c16 * 8); kr[i] = *(const GAS v4u*)(kg + (r0 + row) * 1024 + c16 * 8); }
            vr = *(const GAS v4u*)(vg + (r0 + (tid >> 3)) * 2048 + (tid & 7) * 8); }
        __syncthreads();
        rec_step<CfRet>(F.lds, F.wave, F.lane, S, cum, out, c * 64);
    }
    rec_store_state<CfRet>(F, S, st_out + ((size_t)(b * 4 + h) * 256) * 512 + vs * 64, 512);
}
__device__ __forceinline__ void ret_sample_items(Frame& F, const bf16* Q, const bf16* K, const bf16* V, bf16* RO, const float* st_in, float* st_out) {
    LAS float* qk = (LAS float*)F.lds; LAS float* red = qk + 512;
    const int tid = F.tid, lane = F.lane, w = F.wave;
    for (int item = F.vcu; item < MS * 4; item += F.G) {
        const int bs = item >> 2, h = item & 3; const size_t row = MPR + bs;
        __syncthreads();
        qk[tid] = tid < 256 ? bf2f(Q[row * 1024 + h * 256 + tid]) : bf2f(K[row * 1024 + h * 256 + (tid - 256)]);
        float v[8]; unpack8(*(const GAS v4u*)(V + row * 2048 + h * 512 + 8 * lane), v);
        __syncthreads();
        const float g = 1.f - exp2f(-5.f - (float)h);
        const float* sin = st_in + ((size_t)(bs * 4 + h) * 256) * 512 + 8 * lane; float* sout = st_out + ((size_t)(bs * 4 + h) * 256) * 512 + 8 * lane;
        float o[8];
#pragma unroll
        for (int e = 0; e < 8; ++e) o[e] = 0.f;
#pragma unroll 8
        for (int r = 0; r < 32; ++r) { const int kk = 32 * w + r;
            f32x4 s0 = __builtin_nontemporal_load((const GAS f32x4*)(sin + (size_t)kk * 512)), s1 = __builtin_nontemporal_load((const GAS f32x4*)(sin + (size_t)kk * 512 + 4));
            const float kf = qk[256 + kk], qf = qk[kk];
#pragma unroll
            for (int e = 0; e < 4; ++e) { s0[e] = g * s0[e] + kf * v[e]; s1[e] = g * s1[e] + kf * v[4 + e]; o[e] += s0[e] * qf; o[4 + e] += s1[e] * qf; }
            __builtin_nontemporal_store(s0, (GAS f32x4*)(sout + (size_t)kk * 512)); __builtin_nontemporal_store(s1, (GAS f32x4*)(sout + (size_t)kk * 512 + 4)); }
#pragma unroll
        for (int e = 0; e < 8; ++e) red[w * 512 + 8 * lane + e] = o[e];
        __syncthreads();
        float acc = 0.f;
#pragma unroll
        for (int ww = 0; ww < 8; ++ww) acc += red[ww * 512 + tid];
        RO[row * 2048 + h * 512 + tid] = (bf16)(cvt_pk_bf16(acc, acc) & 0xffffu);
    }
    __syncthreads();
}

struct CfSsd { static constexpr int C = 64, KD = 128, VS = 64, KPW = 1, RSK = 272, RSV = 144, RSP = 144; static constexpr bool CH = false;
    static constexpr int QA = 0, KA = 17408, QB = QA, KB = KA, V = 34816, VB = 44032, PM = 53248, ST = 62464, XS = 79872, CUM = 89088, CW = 89600, DS = 0, END = 96000; };
static_assert(CfSsd::END <= SCR_BYTES, "ssd lds");
struct SsdOut { bf16* dst; const LAS unsigned char* xs; float Dh;
    __device__ __forceinline__ void operator()(int tok, int i, int vv0, const f32x4 o) const {
        const v2u xw = *(const LAS v2u*)(xs + i * 144 + vv0 * 2);
        const f32x4 x = (f32x4){bflo(xw.x), bfhi(xw.x), bflo(xw.y), bfhi(xw.y)};
        *(GAS v2u*)(dst + (size_t)tok * 2048 + vv0) = pack4v(o + x * Dh); } };
__device__ __forceinline__ int ssd_gcol(int lch, int head, int grp) { return lch < 64 ? head * 64 + lch : (lch < 192 ? 2048 + grp * 128 + (lch - 64) : 2560 + grp * 128 + (lch - 192)); }
__device__ __forceinline__ void ssd_prompt_item(Frame& F, int item, const bf16* XBC, const float* DT, bf16* T, float* st_out,
                                                const float* conv_w, const float* conv_b, const float* dt_bias, const float* a_log, const float* d_skip) {
    const int b = item >> 5, head = item & 31, grp = head >> 3, tid = F.tid, lane = F.lane, w = F.wave;
    const float a = -expf(a_log[head]), dtb = dt_bias[head], Dh = d_skip[head];
    LAS float* cw = (LAS float*)(F.lds + CfSsd::CW); LAS float* cumb = (LAS float*)(F.lds + CfSsd::CUM);
    __syncthreads();
    for (int idx = tid; idx < 1600; idx += 512) { const int tap = idx / 320, lch = idx - tap * 320, gch = ssd_gcol(lch, head, grp); cw[idx] = tap < 4 ? conv_w[tap * 3072 + gch] : conv_b[gch]; }
    f32x4 S[CfSsd::KPW][4];
    rec_zero_state<CfSsd>(F, S);
    const bf16* xg = XBC + (size_t)(b * SEQ) * 3072; const float* dtg = DT + (size_t)(b * SEQ) * 32 + head;
    const SsdOut out{T + (size_t)(b * SEQ) * 2048 + head * 64, F.lds + CfSsd::XS, Dh};
#define SSD_CUM(cc) do { if (w == 0) { const int tk_ = (cc) * 64 + lane; float v_ = softplusf_(dtg[(size_t)tk_ * 32] + dtb) * a; \
        _Pragma("unroll") for (int o_ = 1; o_ < 64; o_ <<= 1) { const float u_ = __shfl_up(v_, o_); if (lane >= o_) v_ += u_; } cumb[((cc) & 1) * 64 + lane] = v_; } } while (0)
    SSD_CUM(0);
    __syncthreads();
    for (int c = 0; c < SEQ / 64; ++c) {
        const LAS float* cum = cumb + (c & 1) * 64; const float tot = cum[63];
#pragma unroll 1
        for (int r = 0; r < 5; ++r) { const int op = tid + 512 * r, i = op / 40, cg = op - i * 40, lch = 8 * cg, gcol = ssd_gcol(lch, head, grp), tok = c * 64 + i;
            float acc[8];
#pragma unroll
            for (int e = 0; e < 8; ++e) acc[e] = cw[4 * 320 + lch + e];
#pragma unroll
            for (int tap = 0; tap < 4; ++tap) { const int tk = tok - 3 + tap;
                if (tk >= 0) { float x[8]; unpack8(*(const GAS v4u*)(xg + (size_t)tk * 3072 + gcol), x);
#pragma unroll
                    for (int e = 0; e < 8; ++e) acc[e] += x[e] * cw[tap * 320 + lch + e]; } }
#pragma unroll
            for (int e = 0; e < 8; ++e) acc[e] = siluf_(acc[e]);
            if (cg < 8) { const float dtv = softplusf_(dtg[(size_t)tok * 32] + dtb), wj = dtv * __expf(tot - cum[i]);
                *(LAS v4u*)(F.lds + CfSsd::XS + i * 144 + lch * 2) = pack8(acc);
                float f[8];
#pragma unroll
                for (int e = 0; e < 8; ++e) f[e] = acc[e] * dtv;
                *(LAS v4u*)(F.lds + CfSsd::V + i * 144 + lch * 2) = pack8(f);
#pragma unroll
                for (int e = 0; e < 8; ++e) f[e] = acc[e] * wj;
                *(LAS v4u*)(F.lds + CfSsd::VB + i * 144 + lch * 2) = pack8(f); }
            else if (cg < 24) *(LAS v4u*)(F.lds + CfSsd::KA + i * 272 + (lch - 64) * 2) = pack8(acc);
            else *(LAS v4u*)(F.lds + CfSsd::QA + i * 272 + (lch - 192) * 2) = pack8(acc);
        }
        if (c + 1 < SEQ / 64) SSD_CUM(c + 1);
        __syncthreads();
        rec_step<CfSsd>(F.lds, w, lane, S, cum, out, c * 64);
    }
#undef SSD_CUM
    rec_store_state<CfSsd>(F, S, st_out + ((size_t)(b * 32 + head) * 128) * 64, 64);
}
__device__ __forceinline__ void ssd_sample_items(Frame& F, const bf16* XBC, const float* DT, bf16* T, const float* st_in, float* st_out, const float* conv_st,
                                                 const float* conv_w, const float* conv_b, const float* dt_bias, const float* a_log, const float* d_skip) {
    const int gw = F.vcu * NWAVES + F.wave, NGW = F.G * NWAVES, lane = F.lane;
    LAS float* scr = (LAS float*)(F.lds + F.wave * 2048);
    __syncthreads();
    for (int item = gw; item < MS * 32; item += NGW) {
        const int bs = item >> 5, head = item & 31, grp = head >> 3; const size_t row = MPR + bs;
        asm volatile("" ::: "memory");
#pragma unroll
        for (int r = 0; r < 5; ++r) { const int lch = lane + 64 * r, gch = ssd_gcol(lch, head, grp);
            float acc = conv_b[gch];
#pragma unroll
            for (int tap = 0; tap < 3; ++tap) acc += conv_st[((size_t)bs * 3 + tap) * 3072 + gch] * conv_w[tap * 3072 + gch];
            acc += bf2f(XBC[row * 3072 + gch]) * conv_w[3 * 3072 + gch];
            scr[lch] = siluf_(acc); }
        LDS_WAIT();
        const float dtv = softplusf_(DT[row * 32 + head] + dt_bias[head]), dA = __expf(dtv * -expf(a_log[head])), Dh = d_skip[head];
        const int v4 = (lane & 15) * 4, kq = lane >> 4;
        const f32x4 xs4 = (f32x4){scr[v4], scr[v4 + 1], scr[v4 + 2], scr[v4 + 3]}, xd = xs4 * dtv;
        const float* sin = st_in + ((size_t)(bs * 32 + head) * 128) * 64 + v4; float* sout = st_out + ((size_t)(bs * 32 + head) * 128) * 64 + v4;
        f32x4 y = (f32x4){0.f, 0.f, 0.f, 0.f};
#pragma unroll 8
        for (int i = 0; i < 32; ++i) { const int kk = 4 * i + kq;
            f32x4 s = __builtin_nontemporal_load((const GAS f32x4*)(sin + (size_t)kk * 64));
            s = s * dA + xd * scr[64 + kk];
            __builtin_nontemporal_store(s, (GAS f32x4*)(sout + (size_t)kk * 64));
            y = y + s * scr[192 + kk]; }
#pragma unroll
        for (int e = 0; e < 4; ++e) { y[e] += __shfl_xor(y[e], 16); y[e] += __shfl_xor(y[e], 32); }
        if (lane < 16) *(GAS v2u*)(T + row * 2048 + head * 64 + v4) = pack4v(y + xs4 * Dh);
        LDS_WAIT();
    }
    __syncthreads();
}
__device__ __forceinline__ void ssd_conv_out(Frame& F, const bf16* XBC, const float* conv_st, float* outp, float* outs) {
    const int NP_ = BP * 3 * 3072, NS_ = MS * 3 * 3072;
    for (int idx = F.vcu * 512 + F.tid; idx < NP_ + NS_; idx += F.G * 512) {
        if (idx < NP_) { const int b = idx / 9216, rem = idx - b * 9216, wi = rem / 3072, ch = rem - wi * 3072; outp[idx] = bf2f(XBC[(size_t)(b * SEQ + SEQ - 3 + wi) * 3072 + ch]); }
        else { const int k = idx - NP_, bs = k / 9216, rem = k - bs * 9216, wi = rem / 3072, ch = rem - wi * 3072;
            outs[k] = wi < 2 ? conv_st[((size_t)bs * 3 + wi + 1) * 3072 + ch] : bf2f(XBC[(size_t)(MPR + bs) * 3072 + ch]); }
    }
}

struct CfHg { static constexpr int C = 32, KD = 128, VS = 32, KPW = 1, RSK = 272, RSV = 80, RSP = 80; static constexpr bool CH = true;
    static constexpr int QA = 0, KA = 8704, QB = 17408, KB = 26112, V = 34816, VB = V, PM = 37376, ST = 39936, DS = 48640, PART = 49152, CUM = 0, END = 51200; };
static_assert(CfHg::END <= SCR_BYTES, "hgrn lds");
struct HgOut { bf16* dst;
    __device__ __forceinline__ void operator()(int tok, int i, int vv0, const f32x4 o) const { *(GAS v2u*)(dst + (size_t)tok * 1024 + vv0) = pack4v(o); } };
__device__ __forceinline__ void st_bf16_lds(LAS unsigned char* p, float x) { *(LAS unsigned short*)p = (unsigned short)(cvt_pk_bf16(x, x) & 0xffffu); }
__device__ __forceinline__ void hg_prompt_item(Frame& F, int item, const bf16* HQ, const float* LA, const bf16* HV, bf16* RO, float* st_out) {
    const int b = item >> 5, h = (item >> 2) & 7, vs = item & 3, tid = F.tid, kk = tid & 127, tg = tid >> 7;
    LAS float* part = (LAS float*)(F.lds + CfHg::PART); LAS float* dsv = (LAS float*)(F.lds + CfHg::DS);
    __syncthreads();
    f32x4 S[CfHg::KPW][2];
    rec_zero_state<CfHg>(F, S);
    const size_t base = (size_t)(b * SEQ) * 1024 + h * 128;
    const HgOut out{RO + base + vs * 32};
    float la[8]; unsigned short qr[8]; v4u vr = (v4u){0u, 0u, 0u, 0u};
#pragma unroll
    for (int e = 0; e < 8; ++e) { const size_t ix = base + (size_t)(8 * tg + e) * 1024 + kk; la[e] = LA[ix]; qr[e] = HQ[ix]; }
    if (tid < 128) vr = *(const GAS v4u*)(HV + base + (size_t)(tid >> 2) * 1024 + vs * 32 + (tid & 3) * 8);
    for (int c = 0; c < SEQ / 32; ++c) {
        float lc[8]; lc[0] = la[0];
#pragma unroll
        for (int e = 1; e < 8; ++e) lc[e] = lc[e - 1] + la[e];
        part[tg * 128 + kk] = lc[7];
        __syncthreads();
        const float p0 = part[kk], p1 = part[128 + kk], p2 = part[256 + kk], p3 = part[384 + kk];
        const float off = (tg > 0 ? p0 : 0.f) + (tg > 1 ? p1 : 0.f) + (tg > 2 ? p2 : 0.f), tot = (p0 + p1) + (p2 + p3), ref = p0 + p1;
#pragma unroll
        for (int e = 0; e < 8; ++e) { const int i = 8 * tg + e; const float cm = off + lc[e], kf = 1.f - __expf(la[e]), qv = bf2f(qr[e]);
            const float ea = __expf(fminf(fmaxf(cm - ref, -80.f), 80.f)), eb = __expf(fminf(fmaxf(ref - cm, -80.f), 80.f));
            st_bf16_lds(F.lds + CfHg::QA + i * 272 + kk * 2, qv * ea); st_bf16_lds(F.lds + CfHg::KA + i * 272 + kk * 2, kf * eb);
            st_bf16_lds(F.lds + CfHg::QB + i * 272 + kk * 2, qv * __expf(cm)); st_bf16_lds(F.lds + CfHg::KB + i * 272 + kk * 2, kf * __expf(tot - cm)); }
        if (tg == 0) dsv[kk] = __expf(tot);
        if (tid < 128) *(LAS v4u*)(F.lds + CfHg::V + (tid >> 2) * 80 + (tid & 3) * 16) = vr;
        if (c + 1 < SEQ / 32) { const size_t b2 = base + (size_t)(c + 1) * 32 * 1024;
#pragma unroll
            for (int e = 0; e < 8; ++e) { const size_t ix = b2 + (size_t)(8 * tg + e) * 1024 + kk; la[e] = LA[ix]; qr[e] = HQ[ix]; }
            if (tid < 128) vr = *(const GAS v4u*)(HV + b2 + (size_t)(tid >> 2) * 1024 + vs * 32 + (tid & 3) * 8); }
        __syncthreads();
        rec_step<CfHg>(F.lds, F.wave, F.lane, S, (const LAS float*)nullptr, out, c * 32);
    }
    rec_store_state<CfHg>(F, S, st_out + ((size_t)(b * 8 + h) * 128) * 128 + vs * 32, 128);
}
__device__ __forceinline__ void hg_sample_items(Frame& F, const bf16* HQ, const float* LA, const bf16* HV, bf16* RO, const float* st_in, float* st_out) {
    const int gw = F.vcu * NWAVES + F.wave, NGW = F.G * NWAVES, lane = F.lane;
    LAS float* scr = (LAS float*)(F.lds + F.wave * 2048);
    __syncthreads();
    for (int item = gw; item < MS * 16; item += NGW) {
        const int bs = item >> 4, h = (item >> 1) & 7, vh = item & 1; const size_t rb = (size_t)(MPR + bs) * 1024 + h * 128;
        asm volatile("" ::: "memory");
#pragma unroll
        for (int r = 0; r < 2; ++r) { const int kk = lane + 64 * r; scr[kk] = __expf(LA[rb + kk]); scr[128 + kk] = bf2f(HQ[rb + kk]); }
        LDS_WAIT();
        const int v4 = (lane & 15) * 4, kq = lane >> 4;
        const v2u iw = *(const GAS v2u*)(HV + rb + vh * 64 + v4);
        const f32x4 iv = (f32x4){bflo(iw.x), bfhi(iw.x), bflo(iw.y), bfhi(iw.y)};
        const float* sin = st_in + ((size_t)(bs * 8 + h) * 128) * 128 + vh * 64 + v4; float* sout = st_out + ((size_t)(bs * 8 + h) * 128) * 128 + vh * 64 + v4;
        f32x4 o = (f32x4){0.f, 0.f, 0.f, 0.f};
#pragma unroll 8
        for (int i = 0; i < 32; ++i) { const int kk = 4 * i + kq; const float f = scr[kk];
            f32x4 s = __builtin_nontemporal_load((const GAS f32x4*)(sin + (size_t)kk * 128));
            s = s * f + iv * (1.f - f);
            __builtin_nontemporal_store(s, (GAS f32x4*)(sout + (size_t)kk * 128));
            o = o + s * scr[128 + kk]; }
#pragma unroll
        for (int e = 0; e < 4; ++e) { o[e] += __shfl_xor(o[e], 16); o[e] += __shfl_xor(o[e], 32); }
        if (lane < 16) *(GAS v2u*)(RO + rb + vh * 64 + v4) = pack4v(o);
        LDS_WAIT();
    }
    __syncthreads();
}

__device__ __forceinline__ void p0_transpose_item(const float* W, int K, int N, bf16* WT, LAS float* scr, int item, int lane, bool inter) {
    const int nblk = N / 32, kb = item / nblk, nb = item - kb * nblk, k0 = 64 * kb, n0 = 32 * nb;
    int s0 = n0; if (inter) { const int t = n0 >> 8, j = n0 & 255; s0 = j < 128 ? 128 * t + j : DFF + 128 * t + (j - 128); }
#pragma unroll 8
    for (int i = 0; i < 32; ++i) { const int kk = 2 * i + (lane >> 5); scr[kk * 33 + (lane & 31)] = W[(size_t)(k0 + kk) * N + s0 + (lane & 31)]; }
    LDS_WAIT(); asm volatile("" ::: "memory");
    const int c = lane & 7;
#pragma unroll
    for (int j = 0; j < 4; ++j) { const int n = (lane >> 3) + 8 * j; const LAS float* s = scr + (8 * c) * 33 + n;
        v4u o; o.x = cvt_pk_bf16(s[0 * 33], s[1 * 33]); o.y = cvt_pk_bf16(s[2 * 33], s[3 * 33]); o.z = cvt_pk_bf16(s[4 * 33], s[5 * 33]); o.w = cvt_pk_bf16(s[6 * 33], s[7 * 33]);
        *(GAS v4u*)(WT + (size_t)(n0 + n) * K + k0 + 8 * c) = o; }
    LDS_WAIT(); asm volatile("" ::: "memory");
}
__device__ __forceinline__ void p0_matrix(Frame& F, const float* W, int K, int N, bf16* WT, bool inter, int& itbase) {
    const int gw = F.vcu * NWAVES + F.wave, NGW = F.G * NWAVES, nit = (K / 64) * (N / 32);
    LAS float* scr = (LAS float*)(F.lds + F.wave * 16384);
    int first = (gw - itbase) % NGW; if (first < 0) first += NGW;
    for (int it = first; it < nit; it += NGW) p0_transpose_item(W, K, N, WT, scr, it, F.lane, inter);
    itbase += nit;
}

struct Args { const float* in[30]; float* out; unsigned char* ws; int ph_lo, ph_hi; };
enum { I_XP = 0, I_XS, I_CP, I_CS, I_SRET, I_SSSD, I_SCONV, I_SHG, I_WADA, I_BADA, I_NMPRE, I_NMPOST, I_NFPRE, I_NFPOST, I_RETIN, I_RETOUT, I_SSDIN, I_CONVW, I_CONVB, I_DTB, I_ALOG, I_SSDD,
       I_SSDNORM, I_SSDOUT, I_HGIN, I_HGLB, I_HGNORM, I_HGOUT, I_FFNIN, I_FFNOUT };
constexpr int N_PHASES = 3 + 8 * 4;

__global__ void __launch_bounds__(NWAVES * 64, 2) mk_fwd(Args args) {
    extern __shared__ __attribute__((aligned(16))) unsigned char lds_raw[];
    Frame F;
    F.lds = (LAS unsigned char*)lds_raw;
    F.tid = threadIdx.x; F.lane = F.tid & 63; F.wave = __builtin_amdgcn_readfirstlane(F.tid >> 6);
    F.G = gridDim.x; { const int bx = blockIdx.x; F.vcu = (F.G % 8 == 0) ? (bx % 8) * (F.G / 8) + bx / 8 : bx; }
    unsigned char* ws = args.ws;
    gu32* ctl = (gu32*)(ws + WS_CTL);
    for (int u = F.tid; u < (LDS_BYTES - LDSCTL_OFF) / 4; u += NWAVES * 64) ((LAS unsigned*)(F.lds + LDSCTL_OFF))[u] = 0u;
    __syncthreads();
    XcdBarrier bar; bar.bar = (unsigned*)(ctl + CW_BAR); bar.x = 0; bar.st = nullptr;
    if (MK_N_LAUNCHES == 1) bar = xcd_barrier_post((unsigned*)(ctl + CW_BAR), (volatile LAS unsigned*)(F.lds + LDSCTL_OFF) + 8);
    const int lo = args.ph_lo, hi = args.ph_hi;
#define IN(k) (lo <= (k) && (k) < hi)
#define SEAM(k) do { if (IN((k) + 1)) xcd_barrier(bar); } while (0)
#define INP(i) (args.in[i])
    float* const out = args.out;
    float* const X = out + O_Y;
    bf16* const Hb = (bf16*)(ws + WS_H); bf16* const RO = (bf16*)(ws + WS_RO); bf16* const GO = (bf16*)(ws + WS_GO); bf16* const OUTB = (bf16*)(ws + WS_OUT); bf16* const ACT = (bf16*)(ws + WS_ACT);
    float* const MOD = (float*)(ws + WS_MOD); float* const LB = (float*)(ws + WS_LB);
    bf16* const CACT = (bf16*)(ws + WS_CACT);
    bf16* const WADA = (bf16*)(ws + WS_WADA);
    unsigned char* const PJ = ws + WS_PROJ;

    if (IN(0)) {
        int itb = 0;
#pragma unroll 1
        for (int l = 0; l < 4; ++l) p0_matrix(F, INP(I_WADA) + (size_t)l * D * NMOD, D, NMOD, WADA + (size_t)l * NMOD * D, false, itb);
#pragma unroll 1
        for (int j = 0; j < 2; ++j) p0_matrix(F, INP(I_RETIN) + (size_t)j * D * RET_IN, D, RET_IN, (bf16*)(ws + WS_WRETIN) + (size_t)j * RET_IN * D, false, itb);
#pragma unroll 1
        for (int j = 0; j < 2; ++j) p0_matrix(F, INP(I_RETOUT) + (size_t)j * 2048 * D, 2048, D, (bf16*)(ws + WS_WRETOUT) + (size_t)j * D * 2048, false, itb);
        p0_matrix(F, INP(I_SSDIN), D, SSD_IN, (bf16*)(ws + WS_WSSDIN), false, itb);
        p0_matrix(F, INP(I_SSDOUT), 2048, D, (bf16*)(ws + WS_WSSDOUT), false, itb);
        p0_matrix(F, INP(I_HGIN), D, HG_IN, (bf16*)(ws + WS_WHGIN), false, itb);
        p0_matrix(F, INP(I_HGOUT), D, D, (bf16*)(ws + WS_WHGOUT), false, itb);
#pragma unroll 1
        for (int l = 0; l < 4; ++l) p0_matrix(F, INP(I_FFNIN) + (size_t)l * D * FFN_IN, D, FFN_IN, (bf16*)(ws + WS_WFFNIN) + (size_t)l * FFN_IN * D, true, itb);
#pragma unroll 1
        for (int l = 0; l < 4; ++l) p0_matrix(F, INP(I_FFNOUT) + (size_t)l * DFF * D, DFF, D, (bf16*)(ws + WS_WFFNOUT) + (size_t)l * D * DFF, false, itb);
        for (int idx = F.vcu * 512 + F.tid; idx < 256 * 128; idx += F.G * 512) { const int row = idx >> 7, c8 = (idx & 127) * 8; v4u o = (v4u){0u, 0u, 0u, 0u};
            if (row < NCOND) { const float* src = row < BP ? INP(I_CP) + (size_t)row * D : INP(I_CS) + (size_t)(row - BP) * D;
                const f32x4 a = *(const GAS f32x4*)(src + c8), b = *(const GAS f32x4*)(src + c8 + 4); o = pack8v(silu4(a), silu4(b)); }
            *(GAS v4u*)(CACT + (size_t)row * D + c8) = o; }
        for (int idx = F.vcu * 512 + F.tid; idx < 1024; idx += F.G * 512) { const float* lg = INP(I_HGLB);
            const float l0 = lg[idx], l1 = lg[1024 + idx], l2 = lg[2048 + idx], l3 = lg[3072 + idx], m = fmaxf(fmaxf(l0, l1), fmaxf(l2, l3));
            const float e0 = expf(l0 - m), e1 = expf(l1 - m), e2 = expf(l2 - m), e3 = expf(l3 - m); LB[idx] = (e1 + e2) / ((e0 + e1) + (e2 + e3)); }
        SEAM(0);
    }
    if (IN(1)) {
        const EmitMod E{MOD, INP(I_BADA)};
        skinny_gemm(F, CACT, D, 2, 0, WADA, (NMODALL / 256) * 8, false, E, 0);
        SEAM(1);
    }
    if (IN(2)) {
        resnorm_phase<0>(F, INP(I_XP), INP(I_XS), X, nullptr, Hb, MOD, nullptr, 0, INP(I_NMPRE), 0 * NMOD + 0 * D, 0 * NMOD + 1 * D);
        SEAM(2);
    }

#define MAIN_GEMM(EmitT, eobj, Aptr, Btptr, N_, K_) do { pg8::Gemm g_{(const pg8::bf16_t*)(Aptr), (const pg8::bf16_t*)(Btptr), MPR, (N_), (K_)}; pg8::StaticOrder S_; S_.init(MPR, (N_), F.G, (int)blockIdx.x); \
        const EpiGen<EmitT> E_{eobj}; pg8::gemm_phase<EpiGen<EmitT>, pg8::StaticOrder, PG8_ALIGN, PG8_SP2>(F.lds, g_, S_, E_); } while (0)
#define FFN_BLOCK(L, pb, LASTL) do { \
    if (IN((pb) + 4)) { resnorm_phase<1>(F, nullptr, nullptr, X, OUTB, Hb, MOD, INP(I_NMPOST) + (L) * D, (L) * NMOD + 2 * D, INP(I_NFPRE) + (L) * D, (L) * NMOD + 3 * D, (L) * NMOD + 4 * D); SEAM((pb) + 4); } \
    if (IN((pb) + 5)) { const bf16* wt_ = (const bf16*)(ws + WS_WFFNIN) + (size_t)(L) * FFN_IN * D; const EmitFfnIn e_{ACT}; \
        MAIN_GEMM(EmitFfnIn, e_, Hb, wt_, FFN_IN, D); skinny_gemm(F, Hb + (size_t)MPR * D, D, 1, MPR, wt_, (FFN_IN / 256) * 8, false, e_, 0); SEAM((pb) + 5); } \
    if (IN((pb) + 6)) { const bf16* wt_ = (const bf16*)(ws + WS_WFFNOUT) + (size_t)(L) * D * DFF; const EmitOut e_{OUTB}; \
        MAIN_GEMM(EmitOut, e_, ACT, wt_, D, DFF); skinny_gemm(F, ACT + (size_t)MPR * DFF, DFF, 1, MPR, wt_, (D / 256) * 8, false, e_, 0); SEAM((pb) + 6); } \
    if (IN((pb) + 7)) { if (LASTL) resnorm_phase<2>(F, nullptr, nullptr, X, OUTB, Hb, MOD, INP(I_NFPOST) + (L) * D, (L) * NMOD + 5 * D, nullptr, 0, 0); \
        else resnorm_phase<1>(F, nullptr, nullptr, X, OUTB, Hb, MOD, INP(I_NFPOST) + (L) * D, (L) * NMOD + 5 * D, INP(I_NMPRE) + ((L) + 1) * D, ((L) + 1) * NMOD + 0 * D, ((L) + 1) * NMOD + 1 * D); \
        if (!(LASTL)) SEAM((pb) + 7); } } while (0)
#define OUT_PROJ(pb, wt, K_) do { if (IN((pb) + 3)) { const EmitOut e_{OUTB}; MAIN_GEMM(EmitOut, e_, GO, (wt), D, (K_)); skinny_gemm(F, GO + (size_t)MPR * (K_), (K_), 1, MPR, (wt), (D / 256) * 8, false, e_, 0); SEAM((pb) + 3); } } while (0)
#define RET_LAYER(L, J, pb) do { \
    bf16* const Qp_ = (bf16*)(PJ + PJ_RET_Q); bf16* const Kp_ = (bf16*)(PJ + PJ_RET_K); bf16* const Vp_ = (bf16*)(PJ + PJ_RET_V); bf16* const SGp_ = (bf16*)(PJ + PJ_RET_SG); \
    if (IN((pb) + 0)) { const bf16* wt_ = (const bf16*)(ws + WS_WRETIN) + (size_t)(J) * RET_IN * D; const EmitRetIn e_{Qp_, Kp_, Vp_, SGp_}; \
        MAIN_GEMM(EmitRetIn, e_, Hb, wt_, RET_IN, D); skinny_gemm(F, Hb + (size_t)MPR * D, D, 1, MPR, wt_, (RET_IN / 256) * 8, false, e_, 0); SEAM((pb) + 0); } \
    if (IN((pb) + 1)) { for (int item = F.vcu; item < 256; item += F.G) ret_prompt_item(F, item, Qp_, Kp_, Vp_, RO, out + O_RETP + (size_t)(J) * 8 * 4 * 256 * 512); \
        ret_sample_items(F, Qp_, Kp_, Vp_, RO, INP(I_SRET) + (size_t)(J) * 128 * 4 * 256 * 512, out + O_RETS + (size_t)(J) * 128 * 4 * 256 * 512); SEAM((pb) + 1); } \
    if (IN((pb) + 2)) { gatenorm_phase<0>(F, RO, SGp_, GO, nullptr); SEAM((pb) + 2); } \
    OUT_PROJ(pb, (const bf16*)(ws + WS_WRETOUT) + (size_t)(J) * D * 2048, 2048); \
    } while (0)

    RET_LAYER(0, 0, 3);
    FFN_BLOCK(0, 3, false);
    {
        constexpr int pb = 11;
        bf16* const SZ_ = (bf16*)(PJ + PJ_SSD_SZ); bf16* const XBC_ = (bf16*)(PJ + PJ_SSD_XBC); float* const DT_ = (float*)(PJ + PJ_SSD_DT);
        if (IN(pb + 0)) { const bf16* wt_ = (const bf16*)(ws + WS_WSSDIN); const EmitSsdIn e_{SZ_, XBC_}; const EmitDt ed_{DT_};
            MAIN_GEMM(EmitSsdIn, e_, Hb, wt_, SSD_INM, D);
            skinny_gemm(F, Hb + (size_t)MPR * D, D, 1, MPR, wt_, (SSD_INM / 256) * 8, false, e_, 0);
            skinny_gemm(F, Hb, D, MT / 128, 0, wt_, 1, true, ed_, 160);
            SEAM(pb + 0); }
        if (IN(pb + 1)) {
            for (int item = F.vcu; item < 256; item += F.G) ssd_prompt_item(F, item, XBC_, DT_, RO, out + O_SSDP, INP(I_CONVW), INP(I_CONVB), INP(I_DTB), INP(I_ALOG), INP(I_SSDD));
            ssd_sample_items(F, XBC_, DT_, RO, INP(I_SSSD), out + O_SSDS, INP(I_SCONV), INP(I_CONVW), INP(I_CONVB), INP(I_DTB), INP(I_ALOG), INP(I_SSDD));
            ssd_conv_out(F, XBC_, INP(I_SCONV), out + O_CONVP, out + O_CONVS);
            SEAM(pb + 1); }
        if (IN(pb + 2)) { gatenorm_phase<1>(F, RO, SZ_, GO, INP(I_SSDNORM)); SEAM(pb + 2); }
        OUT_PROJ(pb, (const bf16*)(ws + WS_WSSDOUT), 2048);
    }
    FFN_BLOCK(1, 11, false);
    {
        constexpr int pb = 19;
        bf16* const HQ_ = (bf16*)(PJ + PJ_HG_Q); float* const LA_ = (float*)(PJ + PJ_HG_LA); bf16* const HV_ = (bf16*)(PJ + PJ_HG_V); bf16* const HSG_ = (bf16*)(PJ + PJ_HG_SG);
        if (IN(pb + 0)) { const bf16* wt_ = (const bf16*)(ws + WS_WHGIN); const EmitHgIn e_{HQ_, HV_, HSG_, LA_, LB};
            MAIN_GEMM(EmitHgIn, e_, Hb, wt_, HG_IN, D); skinny_gemm(F, Hb + (size_t)MPR * D, D, 1, MPR, wt_, (HG_IN / 256) * 8, false, e_, 0); SEAM(pb + 0); }
        if (IN(pb + 1)) {
            for (int item = F.vcu; item < 256; item += F.G) hg_prompt_item(F, item, HQ_, LA_, HV_, RO, out + O_HGP);
            hg_sample_items(F, HQ_, LA_, HV_, RO, INP(I_SHG), out + O_HGS);
            SEAM(pb + 1); }
        if (IN(pb + 2)) { gatenorm_phase<2>(F, RO, HSG_, GO, INP(I_HGNORM)); SEAM(pb + 2); }
        OUT_PROJ(pb, (const bf16*)(ws + WS_WHGOUT), 1024);
    }
    FFN_BLOCK(2, 19, false);
    RET_LAYER(3, 1, 27);
    FFN_BLOCK(3, 27, true);
#undef IN
#undef SEAM
}

extern "C" void kernel_launch(void* const* d_in, const int* in_sizes, int n_in, void* d_out, int out_size, void* d_ws, size_t ws_size, hipStream_t stream) {
    static int grid = 0;
    if (grid == 0) {
        if (n_in != 30 || (size_t)out_size != O_END || ws_size < WS_END) { fprintf(stderr, "kernel_launch: unexpected shapes (n_in %d out %d ws %zu)\n", n_in, out_size, ws_size); grid = -1; return; }
        int dev = 0, cus = 0, per_cu = 0;
        if (hipGetDevice(&dev) != hipSuccess || hipDeviceGetAttribute(&cus, hipDeviceAttributeMultiprocessorCount, dev) != hipSuccess) { grid = -1; return; }
        if (hipFuncSetAttribute((const void*)mk_fwd, hipFuncAttributeMaxDynamicSharedMemorySize, LDS_BYTES) != hipSuccess) { fprintf(stderr, "kernel_launch: hipFuncSetAttribute failed\n"); grid = -1; return; }
        if (hipOccupancyMaxActiveBlocksPerMultiprocessor(&per_cu, (const void*)mk_fwd, NWAVES * 64, LDS_BYTES) != hipSuccess || per_cu < 1) { fprintf(stderr, "kernel_launch: occupancy query says %d\n", per_cu); }
        (void)hipGetLastError();
        grid = cus;
    }
    if (grid < 0) return;
    if (hipMemsetAsync((char*)d_ws + WS_CTL, 0, CTL_ZERO_BYTES, stream) != hipSuccess) { fprintf(stderr, "kernel_launch: memset failed\n"); return; }
    Args a{};
    for (int i = 0; i < 30; ++i) a.in[i] = (const float*)d_in[i];
    a.out = (float*)d_out; a.ws = (unsigned char*)d_ws;
#if MK_N_LAUNCHES == 1
    a.ph_lo = 0; a.ph_hi = N_PHASES;
    hipLaunchKernelGGL(mk_fwd, dim3(grid), dim3(NWAVES * 64), LDS_BYTES, stream, a);
#else
    for (int p = 0; p < N_PHASES; ++p) { a.ph_lo = p; a.ph_hi = p + 1; hipLaunchKernelGGL(mk_fwd, dim3(grid), dim3(NWAVES * 64), LDS_BYTES, stream, a); }
#endif
    const hipError_t le = hipPeekAtLastError();
    if (le != hipSuccess) fprintf(stderr, "kernel_launch: launch failed: %s\n", hipGetErrorName(le));
}
```

```cpp
#include <hip/hip_runtime.h>
#include <cstdio>
#include <cstdint>
namespace pg8 {
#define PG8_LAS __attribute__((address_space(3)))
typedef unsigned short bf16_t;
typedef short bf16x8 __attribute__((ext_vector_type(8)));
typedef float f32x4 __attribute__((ext_vector_type(4)));
typedef unsigned u32x4 __attribute__((ext_vector_type(4)));
constexpr int BM = 256, BK = 64, HALF = 128, HTB = HALF * BK * 2  , STAGE_BYTES = 8 * HTB, NXCD = 8, WGM = 8;

__host__ __device__ __forceinline__ int lds_byte(int r, int c) { const int st = (r >> 4) * 2 + (c >> 5), rr = r & 15, cc = c & 31, ob = rr * 64 + cc * 2; return st * 1024 + (ob ^ (((ob >> 9) & 1) << 5)); }
__host__ __device__ __forceinline__ void stage_rc(int b, int& R, int& C) { const int st = b / 1024, sb = b % 1024, swz = sb ^ (((sb >> 9) & 1) << 5); R = (st >> 1) * 16 + swz / 64; C = (st & 1) * 32 + (swz % 64) / 2; }
__host__ __device__ __forceinline__ int perm32(int rho) { const int n = rho >> 4, i = rho & 15; return 8 * (i >> 2) + 4 * n + (i & 3); }

struct Unit { int pm, pn; };
struct Gemm { const bf16_t* A; const bf16_t* Bt; int M, N, K; };

struct StaticOrder {
    int nM, nN, nwg, G, c;
    __host__ __device__ void init(int M, int N, int G_, int c_) { nM = M / BM; nN = N / BM; nwg = nM * nN; G = G_; c = c_; }
    __host__ __device__ bool next(int i, Unit& u) const {
        const long L = (long)i * G + c; if (L >= nwg) return false;
        int wgid = (int)L; { const int q = nwg / NXCD, r = nwg % NXCD, xcd = wgid % NXCD, off = wgid / NXCD; wgid = (xcd < r ? xcd * (q + 1) : r * (q + 1) + (xcd - r) * q) + off; }
        const int nig = WGM * nN, gid = wgid / nig, fm = gid * WGM, gsz = (nM - fm) < WGM ? (nM - fm) : WGM;
        u.pm = fm + ((wgid % nig) % gsz); u.pn = (wgid % nig) / gsz; return true;
    }
    __device__ __forceinline__ void a_ready(const Unit&) const {}
    __device__ __forceinline__ void done(const Unit&) const {}
};

__device__ __forceinline__ unsigned cvt_pk_bf16(float lo, float hi) { unsigned r; asm volatile("v_cvt_pk_bf16_f32 %0, %1, %2" : "=v"(r) : "v"(lo), "v"(hi)); return r; }
typedef float f32x2 __attribute__((ext_vector_type(2)));
template <class Epi, class Sched, bool ALIGN_EPI = false, bool SP2 = false>
__device__ __forceinline__ void gemm_phase(PG8_LAS unsigned char* lds, const Gemm g, const Sched& S, const Epi& E) {
    const int tid = threadIdx.x, wid = __builtin_amdgcn_readfirstlane(tid >> 6), lane = tid & 63, wr = wid >> 2, wc = wid & 3, fr = lane & 15, fq = lane >> 4;
    const int K = g.K, nt = K / BK;
    unsigned voffA[2], voffB[2];
#pragma unroll
    for (int i = 0; i < 2; ++i) { int R, C; stage_rc(tid * 16 + i * 8192, R, C); const int Rb = Epi::PERM ? ((R & ~31) + perm32(R & 31)) : R;
        voffA[i] = (unsigned)(R * K + C) * 2u; voffB[i] = (unsigned)(Rb * K + C) * 2u; }
    const size_t kstep = (size_t)(BK * 2);
    const size_t hstep = (size_t)HALF * K * 2;
    const size_t tstep = 2 * hstep;
    const unsigned ldsw = (unsigned)wid * 1024u;
    const int aoff = lds_byte(wr * 64 + fr, fq * 8), boff = lds_byte(wc * 32 + fr, fq * 8);
#define PG8_SA(b, h) (((b) * 2 + (h)) * HTB)
#define PG8_SB(b, h) ((4 + (b) * 2 + (h)) * HTB)
#define PG8_STAGE(bufoff, gbase, voff) do { _Pragma("unroll") for (int _i = 0; _i < 2; ++_i) \
        __builtin_amdgcn_global_load_lds((const unsigned*)((const char*)(gbase) + (voff)[_i]), (PG8_LAS unsigned*)(lds + (bufoff) + ldsw + _i * 8192), 16, 0, 0); } while (0)
#define PG8_LDA(dst, b, h) do { _Pragma("unroll") for (int m = 0; m < 4; ++m) _Pragma("unroll") for (int k = 0; k < 2; ++k) dst[m][k] = *(const PG8_LAS bf16x8*)(lds + PG8_SA(b, h) + aoff + m * 2048 + k * 1024); } while (0)
#define PG8_LDB(dst, b, h) do { _Pragma("unroll") for (int n = 0; n < 2; ++n) _Pragma("unroll") for (int k = 0; k < 2; ++k) dst[n][k] = *(const PG8_LAS bf16x8*)(lds + PG8_SB(b, h) + boff + n * 2048 + k * 1024); } while (0)
#define PG8_MMA(ai, bj, At, Bt) do { __builtin_amdgcn_s_setprio(1); _Pragma("unroll") for (int m = 0; m < 4; ++m) _Pragma("unroll") for (int n = 0; n < 2; ++n) _Pragma("unroll") for (int k = 0; k < 2; ++k) \
        acc[ai][bj][m][n] = __builtin_amdgcn_mfma_f32_16x16x32_bf16(Bt[n][k], At[m][k], acc[ai][bj][m][n], 0, 0, 0); __builtin_amdgcn_s_setprio(0); } while (0)
#define PG8_WAIT_V(n) asm volatile("s_waitcnt vmcnt(" #n ")" ::: "memory")
#define PG8_WAIT_L(n) asm volatile("s_waitcnt lgkmcnt(" #n ")" ::: "memory")
#define PG8_BAR __builtin_amdgcn_s_barrier()
#define PG8_SCHED __builtin_amdgcn_sched_barrier(0)
    Unit cur, nxt; int ui = 0;
    if (!S.next(0, cur)) return;
    f32x4 acc[2][2][4][2];
#pragma unroll
    for (int a = 0; a < 2; ++a)
#pragma unroll
        for (int b = 0; b < 2; ++b)
#pragma unroll
            for (int m = 0; m < 4; ++m)
#pragma unroll
                for (int n = 0; n < 2; ++n) acc[a][b][m][n] = (f32x4){0.f, 0.f, 0.f, 0.f};
    bf16x8 At[4][2], B0[2][2], B1[2][2];
    const char* cA = (const char*)g.A + (size_t)cur.pm * tstep; const char* cB = (const char*)g.Bt + (size_t)cur.pn * tstep;
    S.a_ready(cur);
    if constexpr (SP2) {
        PG8_STAGE(PG8_SB(0, 0), cB, voffB); PG8_STAGE(PG8_SB(0, 1), cB + hstep, voffB); PG8_STAGE(PG8_SA(0, 0), cA, voffA); PG8_STAGE(PG8_SA(0, 1), cA + hstep, voffA);
        if (wr == 1) PG8_BAR;
        PG8_WAIT_V(2); PG8_BAR;
        PG8_STAGE(PG8_SB(1, 0), cB + kstep, voffB); PG8_STAGE(PG8_SA(1, 0), cA + kstep, voffA); PG8_STAGE(PG8_SB(1, 1), cB + hstep + kstep, voffB);
        PG8_WAIT_V(6); PG8_BAR;
    } else {
        PG8_STAGE(PG8_SB(0, 0), cB, voffB); PG8_STAGE(PG8_SA(0, 0), cA, voffA); PG8_STAGE(PG8_SB(0, 1), cB + hstep, voffB); PG8_STAGE(PG8_SA(0, 1), cA + hstep, voffA);
        if (wr == 1) PG8_BAR;
        PG8_WAIT_V(4); PG8_BAR;
        PG8_STAGE(PG8_SB(1, 0), cB + kstep, voffB); PG8_STAGE(PG8_SA(1, 0), cA + kstep, voffA); PG8_STAGE(PG8_SB(1, 1), cB + hstep + kstep, voffB);
        PG8_WAIT_V(6); PG8_BAR;
    }
    for (;;) {
        const bool has_next = S.next(ui + 1, nxt);
        const char* nA = has_next ? (const char*)g.A + (size_t)nxt.pm * tstep : cA; const char* nB = has_next ? (const char*)g.Bt + (size_t)nxt.pn * tstep : cB;
        for (int t = 0; t < nt; t += 2) {
            const bool last = (t == nt - 2);
            const char* a1 = cA + (size_t)(t + 1) * kstep;
            const char* a2 = last ? nA : cA + (size_t)(t + 2) * kstep; const char* b2 = last ? nB : cB + (size_t)(t + 2) * kstep;
            const char* a3 = a2 + kstep; const char* b3 = b2 + kstep;
            if (last && has_next) S.a_ready(nxt);
            if constexpr (SP2) {
            PG8_LDB(B0, 0, 0); PG8_LDB(B1, 0, 1); PG8_SCHED; PG8_LDA(At, 0, 0); PG8_STAGE(PG8_SA(1, 1), a1 + hstep, voffA);
            PG8_WAIT_V(8); PG8_WAIT_L(0); PG8_BAR; PG8_MMA(0, 0, At, B0); PG8_MMA(0, 1, At, B1); PG8_BAR; PG8_SCHED;
            PG8_LDA(At, 0, 1); PG8_STAGE(PG8_SB(0, 0), b2, voffB); PG8_STAGE(PG8_SB(0, 1), b2 + hstep, voffB); PG8_STAGE(PG8_SA(0, 0), a2, voffA);
            PG8_WAIT_V(8); PG8_WAIT_L(0); PG8_BAR; PG8_MMA(1, 0, At, B0); PG8_MMA(1, 1, At, B1); PG8_BAR; PG8_SCHED;
            PG8_LDB(B0, 1, 0); PG8_LDB(B1, 1, 1); PG8_SCHED; PG8_LDA(At, 1, 0); PG8_STAGE(PG8_SA(0, 1), a2 + hstep, voffA);
            PG8_WAIT_V(8); PG8_WAIT_L(0); PG8_BAR; PG8_MMA(0, 0, At, B0); PG8_MMA(0, 1, At, B1); PG8_BAR; PG8_SCHED;
            PG8_LDA(At, 1, 1); PG8_STAGE(PG8_SB(1, 0), b3, voffB); PG8_STAGE(PG8_SB(1, 1), b3 + hstep, voffB); PG8_STAGE(PG8_SA(1, 0), a3, voffA);
            PG8_WAIT_V(8); PG8_WAIT_L(0); PG8_BAR; PG8_MMA(1, 0, At, B0); PG8_MMA(1, 1, At, B1); PG8_BAR; PG8_SCHED;
            } else {
            PG8_LDB(B0, 0, 0); PG8_SCHED; PG8_LDA(At, 0, 0); PG8_STAGE(PG8_SA(1, 1), a1 + hstep, voffA);
            PG8_WAIT_L(8); PG8_BAR; PG8_WAIT_L(0); PG8_MMA(0, 0, At, B0); PG8_BAR; PG8_SCHED;
            PG8_LDB(B1, 0, 1); PG8_STAGE(PG8_SB(0, 0), b2, voffB);
            PG8_BAR; PG8_WAIT_L(0); PG8_MMA(0, 1, At, B1); PG8_BAR;
            PG8_LDA(At, 0, 1); PG8_STAGE(PG8_SA(0, 0), a2, voffA);
            PG8_BAR; PG8_WAIT_L(0); PG8_MMA(1, 0, At, B0); PG8_BAR; PG8_SCHED;
            PG8_STAGE(PG8_SB(0, 1), b2 + hstep, voffB);
            PG8_WAIT_V(6); PG8_BAR; PG8_MMA(1, 1, At, B1); PG8_BAR;
            PG8_LDB(B0, 1, 0); PG8_SCHED; PG8_LDA(At, 1, 0); PG8_STAGE(PG8_SA(0, 1), a2 + hstep, voffA);
            PG8_WAIT_L(8); PG8_BAR; PG8_WAIT_L(0); PG8_MMA(0, 0, At, B0); PG8_BAR; PG8_SCHED;
            PG8_LDB(B1, 1, 1); PG8_STAGE(PG8_SB(1, 0), b3, voffB);
            PG8_BAR; PG8_WAIT_L(0); PG8_MMA(0, 1, At, B1); PG8_BAR;
            PG8_LDA(At, 1, 1); PG8_STAGE(PG8_SA(1, 0), a3, voffA);
            PG8_BAR; PG8_WAIT_L(0); PG8_MMA(1, 0, At, B0); PG8_BAR; PG8_SCHED;
            PG8_STAGE(PG8_SB(1, 1), b3 + hstep, voffB);
            PG8_WAIT_V(6); PG8_BAR; PG8_MMA(1, 1, At, B1); PG8_BAR;
            }
        }
        if constexpr (ALIGN_EPI) { if (wr == 0) PG8_BAR; }
        if constexpr (!Epi::AFTER_DRAIN) { E(acc, cur, wr, wc, fr, fq); S.done(cur); }
        if (!has_next) break;
#pragma unroll
        for (int a = 0; a < 2; ++a)
#pragma unroll
            for (int b = 0; b < 2; ++b)
#pragma unroll
                for (int m = 0; m < 4; ++m)
#pragma unroll
                    for (int n = 0; n < 2; ++n) acc[a][b][m][n] = (f32x4){0.f, 0.f, 0.f, 0.f};
        cur = nxt; cA = nA; cB = nB; ++ui;
        if constexpr (ALIGN_EPI) { if (wr == 1) PG8_BAR; }
    }
    PG8_WAIT_V(0);
    if constexpr (!ALIGN_EPI) { if (wr == 0) PG8_BAR; }
    PG8_BAR;
    if constexpr (Epi::AFTER_DRAIN) { E.fused(acc, cur, wr, wc, fr, fq, lds, wid, lane); S.done(cur); }
#undef PG8_SA
#undef PG8_SB
#undef PG8_STAGE
#undef PG8_LDA
#undef PG8_LDB
#undef PG8_MMA
#undef PG8_WAIT_V
#undef PG8_WAIT_L
#undef PG8_BAR
#undef PG8_SCHED
}
}

#ifndef PG8_SP2
#define PG8_SP2 true
#endif
#ifndef PG8_ALIGN
#define PG8_ALIGN true
#endif
#ifndef MK_N_LAUNCHES
#define MK_N_LAUNCHES 1
#endif

constexpr int D = 1024, BP = 8, SEQ = 2048, MPR = BP * SEQ  , MS = 128  , MT = MPR + MS  ;
constexpr int NCOND = BP + MS;
constexpr int DFF = 2816, NMOD = 6 * D  , NMODALL = 4 * NMOD  ;
constexpr int RET_IN = 6144, SSD_IN = 5152, SSD_INM = 5120, HG_IN = 4096, FFN_IN = 2 * DFF;
constexpr float EPS = 1e-6f;
constexpr int NWAVES = 8;

constexpr size_t MiB = 1u << 20;
constexpr size_t WS_CTL = 0, CTL_ZERO_BYTES = 1 * MiB;
constexpr size_t WS_WADA = 1 * MiB;
constexpr size_t WS_WRETIN = WS_WADA + 48 * MiB;
constexpr size_t WS_WRETOUT = WS_WRETIN + 24 * MiB;
constexpr size_t WS_WSSDIN = WS_WRETOUT + 8 * MiB;
constexpr size_t WS_WSSDOUT = WS_WSSDIN + 11 * MiB;
constexpr size_t WS_WHGIN = WS_WSSDOUT + 4 * MiB;
constexpr size_t WS_WHGOUT = WS_WHGIN + 8 * MiB;
constexpr size_t WS_WFFNIN = WS_WHGOUT + 2 * MiB;
constexpr size_t WS_WFFNOUT = WS_WFFNIN + 44 * MiB;
constexpr size_t WS_MOD = WS_WFFNOUT + 22 * MiB;
constexpr size_t WS_CACT = WS_MOD + 24 * MiB;
constexpr size_t WS_LB = WS_CACT + 512 * 1024;
constexpr size_t WS_H = WS_CACT + 1 * MiB;
constexpr size_t WS_PROJ = WS_H + 33 * MiB;
constexpr size_t WS_RO = WS_PROJ + 200 * MiB;
constexpr size_t WS_GO = WS_RO + 65 * MiB;
constexpr size_t WS_OUT = WS_GO + 65 * MiB;
constexpr size_t WS_ACT = WS_OUT + 33 * MiB;
constexpr size_t WS_END = WS_ACT + 89 * MiB;
constexpr size_t PJ_RET_Q = 0, PJ_RET_K = PJ_RET_Q + (size_t)MT * 1024 * 2, PJ_RET_V = PJ_RET_K + (size_t)MT * 1024 * 2, PJ_RET_SG = PJ_RET_V + (size_t)MT * 2048 * 2;
constexpr size_t PJ_SSD_SZ = 0, PJ_SSD_XBC = PJ_SSD_SZ + (size_t)MT * 2048 * 2, PJ_SSD_DT = PJ_SSD_XBC + (size_t)MT * 3072 * 2;
constexpr size_t PJ_HG_Q = 0, PJ_HG_LA = PJ_HG_Q + (size_t)MT * 1024 * 2, PJ_HG_V = PJ_HG_LA + (size_t)MT * 1024 * 4, PJ_HG_SG = PJ_HG_V + (size_t)MT * 1024 * 2;
static_assert(PJ_RET_SG + (size_t)MT * 2048 * 2 <= 200 * MiB && PJ_SSD_DT + (size_t)MT * 32 * 4 <= 200 * MiB && PJ_HG_SG + (size_t)MT * 1024 * 2 <= 200 * MiB, "proj map");
constexpr int CW_BAR = 4096;

constexpr size_t O_Y = 0;
constexpr size_t O_RETP = (size_t)MT * D;
constexpr size_t O_RETS = O_RETP + (size_t)2 * 8 * 4 * 256 * 512;
constexpr size_t O_SSDP = O_RETS + (size_t)2 * 128 * 4 * 256 * 512;
constexpr size_t O_SSDS = O_SSDP + (size_t)8 * 32 * 128 * 64;
constexpr size_t O_CONVP = O_SSDS + (size_t)128 * 32 * 128 * 64;
constexpr size_t O_CONVS = O_CONVP + (size_t)8 * 3 * 3072;
constexpr size_t O_HGP = O_CONVS + (size_t)128 * 3 * 3072;
constexpr size_t O_HGS = O_HGP + (size_t)8 * 8 * 128 * 128;
constexpr size_t O_END = O_HGS + (size_t)128 * 8 * 128 * 128;
static_assert(O_END == 214245376ull, "output size");

constexpr int LDS_BYTES = 147456;
constexpr int LDSCTL_OFF = LDS_BYTES - 1024;
constexpr int SCR_BYTES = LDSCTL_OFF;

#define GAS __attribute__((address_space(1)))
#define LAS __attribute__((address_space(3)))
typedef unsigned short bf16;
typedef unsigned v4u __attribute__((ext_vector_type(4)));
typedef unsigned v2u __attribute__((ext_vector_type(2)));
typedef float f32x4 __attribute__((ext_vector_type(4)));
typedef short bf16x8 __attribute__((ext_vector_type(8)));
typedef short s16x4 __attribute__((ext_vector_type(4)));
typedef GAS unsigned gu32;
#define RLX_AGENT __ATOMIC_RELAXED, __HIP_MEMORY_SCOPE_AGENT
#define LDS_WAIT() asm volatile("s_waitcnt lgkmcnt(0)" ::: "memory")
#define VM_WAIT() asm volatile("s_waitcnt vmcnt(0)" ::: "memory")
typedef float f32x2_t __attribute__((ext_vector_type(2))); typedef __bf16 bf16x2_t __attribute__((ext_vector_type(2)));
__device__ __forceinline__ unsigned cvt_pk_bf16(float lo, float hi) { f32x2_t v = {lo, hi}; bf16x2_t b = __builtin_convertvector(v, bf16x2_t); return __builtin_bit_cast(unsigned, b); }
__device__ __forceinline__ float bf2f(unsigned b) { return __uint_as_float(b << 16); }
__device__ __forceinline__ float bflo(unsigned w) { return __uint_as_float(w << 16); }
__device__ __forceinline__ float bfhi(unsigned w) { return __uint_as_float(w & 0xffff0000u); }
__device__ __forceinline__ void unpack8(const v4u w, float (&f)[8]) { f[0] = bflo(w.x); f[1] = bfhi(w.x); f[2] = bflo(w.y); f[3] = bfhi(w.y); f[4] = bflo(w.z); f[5] = bfhi(w.z); f[6] = bflo(w.w); f[7] = bfhi(w.w); }
__device__ __forceinline__ v4u pack8(const float (&f)[8]) { v4u w; w.x = cvt_pk_bf16(f[0], f[1]); w.y = cvt_pk_bf16(f[2], f[3]); w.z = cvt_pk_bf16(f[4], f[5]); w.w = cvt_pk_bf16(f[6], f[7]); return w; }
__device__ __forceinline__ v4u pack8v(const f32x4 a, const f32x4 b) { v4u w; w.x = cvt_pk_bf16(a[0], a[1]); w.y = cvt_pk_bf16(a[2], a[3]); w.z = cvt_pk_bf16(b[0], b[1]); w.w = cvt_pk_bf16(b[2], b[3]); return w; }
__device__ __forceinline__ v2u pack4v(const f32x4 a) { v2u w; w.x = cvt_pk_bf16(a[0], a[1]); w.y = cvt_pk_bf16(a[2], a[3]); return w; }
__device__ __forceinline__ float sigmoidf_(float x) { return __builtin_amdgcn_rcpf(1.f + __expf(-x)); }
__device__ __forceinline__ float siluf_(float x) { return x * sigmoidf_(x); }
__device__ __forceinline__ float softplusf_(float x) { return x > 20.f ? x : log1pf(__expf(x)); }
__device__ __forceinline__ float wave_sum(float v) {
#pragma unroll
    for (int o = 1; o < 64; o <<= 1) v += __shfl_xor(v, o);
    return v;
}
__device__ __forceinline__ float grp16_sum(float v) {
#pragma unroll
    for (int o = 1; o < 16; o <<= 1) v += __shfl_xor(v, o);
    return v;
}
#define MFMA16(a, b, c) __builtin_amdgcn_mfma_f32_16x16x32_bf16((a), (b), (c), 0, 0, 0)
#define XB_TMO      128
#define XB_XCNT(j)  (256  + 64 * (j))
#define XB_XSUB(j)  (1280 + 64 * (j))
#define XB_XGEN(j)  (2304 + 64 * (j))
#define XB_TOP      3328
#define XB_TOPGEN   3392
#define XCD_BAR_WORDS 3456
#define XB_SPIN_CAP (1u << 18)

__device__ __forceinline__ unsigned xb_ld(unsigned* p)              { return __hip_atomic_load(p, __ATOMIC_RELAXED, __HIP_MEMORY_SCOPE_AGENT); }
__device__ __forceinline__ unsigned xb_add(unsigned* p, unsigned v) { return __hip_atomic_fetch_add(p, v, __ATOMIC_RELAXED, __HIP_MEMORY_SCOPE_AGENT); }
__device__ __forceinline__ unsigned xb_xcc_id() { return (unsigned)__builtin_amdgcn_s_getreg((3 << 11) | 20) & 0xFu; }
#define XB_SPIN(cond, bar) do { unsigned _sp = 0; while (cond) { __builtin_amdgcn_s_sleep(1); \
    if ((++_sp & 255u) == 0u) { if (xb_ld(&(bar)[XB_TMO])) break; if (_sp > XB_SPIN_CAP) { atomicAdd(&(bar)[XB_TMO], 1u); break; } } } } while (0)

struct XcdBarrier {
    unsigned* bar; unsigned x;
    volatile LAS unsigned* st;
};

__device__ __forceinline__ XcdBarrier xcd_barrier_post(unsigned* bar, volatile LAS unsigned* st) {
    XcdBarrier b; b.bar = bar; b.x = xb_xcc_id(); b.st = st;
    if (threadIdx.x == 0) (void)xb_add(&bar[XB_XCNT(b.x)], 1u);
    return b;
}
__device__ __forceinline__ void xcd_barrier_complete(unsigned* bar, unsigned x, unsigned& nloc, unsigned& nx) {
    const unsigned G = gridDim.x * gridDim.y * gridDim.z;
    unsigned sum, cnt, mine, sp = 0u;
    for (;;) {
        sum = 0u; cnt = 0u; mine = 0u;
#pragma unroll
        for (unsigned j = 0; j < 16; ++j) { const unsigned c = xb_ld(&bar[XB_XCNT(j)]); sum += c; cnt += (c > 0u) ? 1u : 0u; mine = (j == x) ? c : mine; }
        if (sum == G) break;
        __builtin_amdgcn_s_sleep(1);
        if ((++sp & 255u) == 0u) { if (xb_ld(&bar[XB_TMO])) break; if (sp > XB_SPIN_CAP) { atomicAdd(&bar[XB_TMO], 1u); break; } }
    }
    nloc = mine > 0u ? mine : 1u; nx = cnt > 0u ? cnt : 1u;
}

__device__ __forceinline__ void xcd_barrier(const XcdBarrier& b) {
    asm volatile("s_waitcnt vmcnt(0)" ::: "memory");
    __syncthreads();
    if (threadIdx.x == 0) {
        unsigned* bar = b.bar;
        __builtin_amdgcn_s_waitcnt(0);
        unsigned nloc = b.st[0], nx = b.st[1];
        if (nloc == 0u) { xcd_barrier_complete(bar, b.x, nloc, nx); b.st[0] = nloc; b.st[1] = nx; }
        const unsigned old = xb_add(&bar[XB_XSUB(b.x)], 1u);
        const unsigned gen = old / nloc;
        if (old + 1u == (gen + 1u) * nloc) {
            __builtin_amdgcn_fence(__ATOMIC_RELEASE, "agent");
            asm volatile("s_waitcnt vmcnt(0)" ::: "memory");
            const unsigned og = xb_add(&bar[XB_TOP], 1u);
            const unsigned tg = og / nx;
            if (og + 1u == (tg + 1u) * nx) xb_add(&bar[XB_TOPGEN], 1u);
            else XB_SPIN(xb_ld(&bar[XB_TOPGEN]) == tg, bar);
            __builtin_amdgcn_fence(__ATOMIC_ACQUIRE, "agent");
            xb_add(&bar[XB_XGEN(b.x)], 1u);
            asm volatile("s_waitcnt vmcnt(0)" ::: "memory");
        } else {
            XB_SPIN(xb_ld(&bar[XB_XGEN(b.x)]) == gen, bar);
            __builtin_amdgcn_fence(__ATOMIC_ACQUIRE, "agent");
            asm volatile("s_waitcnt vmcnt(0)" ::: "memory");
        }
    }
    __syncthreads();
}


struct Frame {
    LAS unsigned char* lds;
    int tid, lane, wave;
    int vcu, G;
};

template <class Fn> struct EpiGen {
    static constexpr bool PERM = true, AFTER_DRAIN = false;
    Fn f;
    __device__ __forceinline__ void operator()(const pg8::f32x4 (&acc)[2][2][4][2], const pg8::Unit& u, int wr, int wc, int fr, int fq) const {
        const int ca = u.pn * 256 + wc * 32 + 8 * fq;
#pragma unroll
        for (int ai = 0; ai < 2; ++ai)
#pragma unroll
            for (int m = 0; m < 4; ++m) {
                const int row = u.pm * 256 + ai * 128 + wr * 64 + m * 16 + fr;
                f.emit(row, ca, ca + 128, acc[ai][0][m][0], acc[ai][0][m][1], acc[ai][1][m][0], acc[ai][1][m][1]);
            }
    }
};
__device__ __forceinline__ void st8bf(bf16* p, const f32x4 a, const f32x4 b) { *(GAS v4u*)p = pack8v(a, b); }
__device__ __forceinline__ f32x4 silu4(const f32x4 a) { f32x4 r; r[0] = siluf_(a[0]); r[1] = siluf_(a[1]); r[2] = siluf_(a[2]); r[3] = siluf_(a[3]); return r; }

struct EmitRetIn {
    bf16 *Q, *K, *V, *SG;
    __device__ __forceinline__ void emit(int row, int ca, int cb, const f32x4 a0, const f32x4 a1, const f32x4 b0, const f32x4 b1) const {
        const int pn = ca >> 8, ch = ca & 255;
        if (pn < 8) {
            const float pos = row < MPR ? (float)(row & (SEQ - 1)) : 16384.f;
            const float sc = pn < 4 ? 1.f : 0.0625f;
            float x1[8] = {a0[0], a0[1], a0[2], a0[3], a1[0], a1[1], a1[2], a1[3]}, x2[8] = {b0[0], b0[1], b0[2], b0[3], b1[0], b1[1], b1[2], b1[3]}, o1[8], o2[8];
#pragma unroll
            for (int e = 0; e < 8; ++e) {
                const float inv = exp2f(-(float)(ch + e) * (13.287712379549449f / 128.f));
                float t = pos * inv * 0.15915494309189535f; t -= floorf(t);
                const float s = __builtin_amdgcn_sinf(t), c = __builtin_amdgcn_cosf(t);
                o1[e] = (x1[e] * c - x2[e] * s) * sc; o2[e] = (x2[e] * c + x1[e] * s) * sc;
            }
            bf16* dst = (pn < 4 ? Q : K) + (size_t)row * 1024 + (pn & 3) * 256 + ch;
            *(GAS v4u*)dst = pack8(o1); *(GAS v4u*)(dst + 128) = pack8(o2);
        } else if (pn < 16) {
            bf16* dst = V + (size_t)row * 2048 + (pn - 8) * 256 + ch; st8bf(dst, a0, a1); st8bf(dst + 128, b0, b1);
        } else {
            bf16* dst = SG + (size_t)row * 2048 + (pn - 16) * 256 + ch; st8bf(dst, silu4(a0), silu4(a1)); st8bf(dst + 128, silu4(b0), silu4(b1));
        }
    }
};
struct EmitSsdIn {
    bf16 *SZ, *XBC;
    __device__ __forceinline__ void emit(int row, int ca, int cb, const f32x4 a0, const f32x4 a1, const f32x4 b0, const f32x4 b1) const {
        const int pn = ca >> 8, ch = ca & 255;
        if (pn < 8) { bf16* dst = SZ + (size_t)row * 2048 + pn * 256 + ch; st8bf(dst, silu4(a0), silu4(a1)); st8bf(dst + 128, silu4(b0), silu4(b1)); }
        else { bf16* dst = XBC + (size_t)row * 3072 + (pn - 8) * 256 + ch; st8bf(dst, a0, a1); st8bf(dst + 128, b0, b1); }
    }
};
struct EmitDt {
    float* DT;
    __device__ __forceinline__ void emit(int row, int ca, int cb, const f32x4 a0, const f32x4 a1, const f32x4 b0, const f32x4 b1) const {
        float* d = DT + (size_t)row * 32; *(GAS f32x4*)(d + (ca - SSD_INM)) = a0; *(GAS f32x4*)(d + (ca - SSD_INM) + 4) = a1; *(GAS f32x4*)(d + (cb - SSD_INM)) = b0; *(GAS f32x4*)(d + (cb - SSD_INM) + 4) = b1;
    }
};
struct EmitHgIn {
    bf16 *HQ, *HV, *HSG; float* LA; const float* lb;
    __device__ __forceinline__ f32x4 logf4(const f32x4 x, const float* l) const { f32x4 r;
#pragma unroll
        for (int e = 0; e < 4; ++e) { const float b = l[e]; r[e] = logf(b + (1.f - b) * sigmoidf_(x[e])); } return r; }
    __device__ __forceinline__ void emit(int row, int ca, int cb, const f32x4 a0, const f32x4 a1, const f32x4 b0, const f32x4 b1) const {
        const int pn = ca >> 8, ch = ca & 255;
        if (pn < 4) { bf16* dst = HQ + (size_t)row * 1024 + pn * 256 + ch; const float s = 0.08838834764831845f; st8bf(dst, silu4(a0) * s, silu4(a1) * s); st8bf(dst + 128, silu4(b0) * s, silu4(b1) * s); }
        else if (pn < 8) { const int col = (pn - 4) * 256 + ch; float* dst = LA + (size_t)row * 1024 + col;
            *(GAS f32x4*)dst = logf4(a0, lb + col); *(GAS f32x4*)(dst + 4) = logf4(a1, lb + col + 4); *(GAS f32x4*)(dst + 128) = logf4(b0, lb + col + 128); *(GAS f32x4*)(dst + 132) = logf4(b1, lb + col + 132); }
        else if (pn < 12) { bf16* dst = HV + (size_t)row * 1024 + (pn - 8) * 256 + ch; st8bf(dst, a0, a1); st8bf(dst + 128, b0, b1); }
        else { bf16* dst = HSG + (size_t)row * 1024 + (pn - 12) * 256 + ch; st8bf(dst, silu4(a0), silu4(a1)); st8bf(dst + 128, silu4(b0), silu4(b1)); }
    }
};
struct EmitOut {
    bf16* OUT;
    __device__ __forceinline__ void emit(int row, int ca, int cb, const f32x4 a0, const f32x4 a1, const f32x4 b0, const f32x4 b1) const {
        bf16* dst = OUT + (size_t)row * 1024; st8bf(dst + ca, a0, a1); st8bf(dst + cb, b0, b1);
    }
};
struct EmitFfnIn {
    bf16* ACT;
    __device__ __forceinline__ void emit(int row, int ca, int cb, const f32x4 a0, const f32x4 a1, const f32x4 b0, const f32x4 b1) const {
        bf16* dst = ACT + (size_t)row * DFF + (ca >> 8) * 128 + (ca & 255); st8bf(dst, silu4(a0) * b0, silu4(a1) * b1);
    }
};
struct EmitMod {
    float* MOD; const float* bias;
    __device__ __forceinline__ void emit(int row, int ca, int cb, const f32x4 a0, const f32x4 a1, const f32x4 b0, const f32x4 b1) const {
        float* d = MOD + (size_t)row * NMODALL;
        *(GAS f32x4*)(d + ca) = a0 + *(const GAS f32x4*)(bias + ca); *(GAS f32x4*)(d + ca + 4) = a1 + *(const GAS f32x4*)(bias + ca + 4);
        *(GAS f32x4*)(d + cb) = b0 + *(const GAS f32x4*)(bias + cb); *(GAS f32x4*)(d + cb + 4) = b1 + *(const GAS f32x4*)(bias + cb + 4);
    }
};

template <int NMT, class Fn>
__device__ __forceinline__ void skinny_gemm(Frame& F, const bf16* A, int K, int nrg, int nrows, int rowbase, const bf16* Bt, int ncu, bool dtmode, const Fn& f, int wg0, int span) {
    const int w = F.wave, lane = F.lane, fr = lane & 15, fq = lane >> 4, KW = K >> 3, nsteps = KW >> 5;
    constexpr int R = NMT * 16;
    LAS unsigned char* red = F.lds;
    const int nun = nrg * ncu, me = (int)blockIdx.x - wg0;
    if (me >= 0 && me < span) {
    for (int u = me; u < nun; u += span) {
        const int rg = u / ncu, cu = u - rg * ncu;
        int ca, cb; if (dtmode) { ca = SSD_INM; cb = SSD_INM + 16; } else { ca = 256 * (cu >> 3) + 16 * (cu & 7); cb = ca + 128; }
        int nact = (nrows - rg * R + 15) >> 4; nact = nact > NMT ? NMT : nact;
        const bf16* ap = A + (size_t)(rg * R + fr) * K + w * KW + fq * 8;
        const bf16* bpa = Bt + (size_t)(ca + fr) * K + w * KW + fq * 8;
        const bf16* bpb = Bt + (size_t)(cb + fr) * K + w * KW + fq * 8;
        f32x4 acc[NMT][2];
#pragma unroll
        for (int mt = 0; mt < NMT; ++mt) { acc[mt][0] = (f32x4){0.f, 0.f, 0.f, 0.f}; acc[mt][1] = (f32x4){0.f, 0.f, 0.f, 0.f}; }
        bf16x8 ca_[NMT], cb0, cb1, na_[NMT], nb0, nb1;
        cb0 = *(const GAS bf16x8*)(bpa); cb1 = *(const GAS bf16x8*)(bpb);
#pragma unroll
        for (int mt = 0; mt < NMT; ++mt) { ca_[mt] = (bf16x8){0, 0, 0, 0, 0, 0, 0, 0}; if (mt < nact) ca_[mt] = *(const GAS bf16x8*)(ap + (size_t)mt * 16 * K); }
#pragma unroll 2
        for (int s = 0; s < nsteps; ++s) {
            const int k1 = (s + 1 < nsteps ? s + 1 : s) * 32;
            nb0 = *(const GAS bf16x8*)(bpa + k1); nb1 = *(const GAS bf16x8*)(bpb + k1);
#pragma unroll
            for (int mt = 0; mt < NMT; ++mt) { na_[mt] = ca_[mt]; if (mt < nact) na_[mt] = *(const GAS bf16x8*)(ap + (size_t)mt * 16 * K + k1); }
#pragma unroll
            for (int mt = 0; mt < NMT; ++mt) if (mt < nact) { acc[mt][0] = MFMA16(cb0, ca_[mt], acc[mt][0]); acc[mt][1] = MFMA16(cb1, ca_[mt], acc[mt][1]); }
            cb0 = nb0; cb1 = nb1;
#pragma unroll
            for (int mt = 0; mt < NMT; ++mt) ca_[mt] = na_[mt];
        }
        __syncthreads();
#pragma unroll
        for (int mt = 0; mt < NMT; ++mt)
#pragma unroll
            for (int nt = 0; nt < 2; ++nt) { const int row = mt * 16 + fr; *(LAS f32x4*)(red + ((w * R + row) * 8 + ((4 * nt + fq) ^ (row & 7))) * 16) = acc[mt][nt]; }
        __syncthreads();
        if (F.tid < 2 * R) {
            const int row = F.tid >> 1, hf = F.tid & 1;
            f32x4 va0 = (f32x4){0.f, 0.f, 0.f, 0.f}, va1 = va0, vb0 = va0, vb1 = va0;
#pragma unroll
            for (int ww = 0; ww < 8; ++ww) { const LAS unsigned char* pr = red + (ww * R + row) * 128;
                va0 += *(const LAS f32x4*)(pr + ((2 * hf) ^ (row & 7)) * 16); va1 += *(const LAS f32x4*)(pr + ((2 * hf + 1) ^ (row & 7)) * 16);
                vb0 += *(const LAS f32x4*)(pr + ((4 + 2 * hf) ^ (row & 7)) * 16); vb1 += *(const LAS f32x4*)(pr + ((5 + 2 * hf) ^ (row & 7)) * 16); }
            if (rg * R + row < nrows) f.emit(rowbase + rg * R + row, ca + hf * 8, cb + hf * 8, va0, va1, vb0, vb1);
        }
    }
    }
    __syncthreads();
}
static_assert(8 * 128 * 128 <= SCR_BYTES, "skinny reduction buffer");

__device__ __forceinline__ int cond_of_row(int row) { return row < MPR ? (row >> 11) : (BP + row - MPR); }
template <int MODE>
__device__ __forceinline__ void resnorm_phase(Frame& F, const float* xp, const float* xs, float* X, const bf16* Y, bf16* H, const float* MOD,
                                              const float* wpost, int goff, const float* wpre, int shoff, int scoff) {
    const int gw = F.vcu * NWAVES + F.wave, NGW = F.G * NWAVES, lane = F.lane;
    for (int row = gw; row < MT; row += NGW) {
        const float* modr = MOD + (size_t)cond_of_row(row) * NMODALL;
        f32x4 x[4];
        if (MODE == 0) {
            const float* src = row < MPR ? xp + (size_t)row * D : xs + (size_t)(row - MPR) * D;
#pragma unroll
            for (int j = 0; j < 4; ++j) x[j] = *(const GAS f32x4*)(src + 4 * lane + 256 * j);
        } else {
            f32x4 y[4]; float ss = 0.f;
#pragma unroll
            for (int j = 0; j < 4; ++j) { x[j] = *(const GAS f32x4*)(X + (size_t)row * D + 4 * lane + 256 * j);
                const v2u yw = *(const GAS v2u*)(Y + (size_t)row * D + 4 * lane + 256 * j);
                y[j] = (f32x4){bflo(yw.x), bfhi(yw.x), bflo(yw.y), bfhi(yw.y)};
                ss += (y[j][0] * y[j][0] + y[j][1] * y[j][1]) + (y[j][2] * y[j][2] + y[j][3] * y[j][3]); }
            const float r1 = rsqrtf(wave_sum(ss) * (1.f / D) + EPS);
#pragma unroll
            for (int j = 0; j < 4; ++j) { const f32x4 g = *(const GAS f32x4*)(modr + goff + 4 * lane + 256 * j), wp = *(const GAS f32x4*)(wpost + 4 * lane + 256 * j);
                x[j] = x[j] + g * (y[j] * r1) * wp; }
        }
#pragma unroll
        for (int j = 0; j < 4; ++j) *(GAS f32x4*)(X + (size_t)row * D + 4 * lane + 256 * j) = x[j];
        if (MODE != 2) {
            float s2 = 0.f;
#pragma unroll
            for (int j = 0; j < 4; ++j) s2 += (x[j][0] * x[j][0] + x[j][1] * x[j][1]) + (x[j][2] * x[j][2] + x[j][3] * x[j][3]);
            const float r2 = rsqrtf(wave_sum(s2) * (1.f / D) + EPS);
#pragma unroll
            for (int j = 0; j < 4; ++j) { const int c = 4 * lane + 256 * j;
                const f32x4 wp = *(const GAS f32x4*)(wpre + c), sc = *(const GAS f32x4*)(modr + scoff + c), sh = *(const GAS f32x4*)(modr + shoff + c);
                const f32x4 h = (x[j] * r2) * wp * (sc + 1.f) + sh;
                *(GAS v2u*)(H + (size_t)row * D + c) = pack4v(h); }
        }
    }
}
template <int MIX>
__device__ __forceinline__ void gatenorm_phase(Frame& F, const bf16* RO, const bf16* GATE, bf16* GO, const float* nw) {
    const int gw = F.vcu * NWAVES + F.wave, NGW = F.G * NWAVES, lane = F.lane;
    constexpr int W = (MIX == 2) ? 1024 : 2048, NJ = W / 512;
    for (int row = gw; row < MT; row += NGW) {
        float u[NJ][8], r[NJ];
#pragma unroll
        for (int j = 0; j < NJ; ++j) {
            const int c = 8 * lane + 512 * j;
            float o[8], g[8];
            unpack8(*(const GAS v4u*)(RO + (size_t)row * W + c), o); unpack8(*(const GAS v4u*)(GATE + (size_t)row * W + c), g);
            float ss = 0.f;
#pragma unroll
            for (int e = 0; e < 8; ++e) {
                if (MIX == 0) { u[j][e] = o[e] * g[e]; ss += o[e] * o[e]; }
                else if (MIX == 1) { u[j][e] = o[e] * g[e]; ss += u[j][e] * u[j][e]; }
                else { u[j][e] = o[e] * g[e]; ss += o[e] * o[e]; }
            }
            if (MIX == 2) r[j] = rsqrtf(grp16_sum(ss) * (1.f / 128.f) + EPS); else r[j] = rsqrtf(wave_sum(ss) * (1.f / 512.f) + EPS);
        }
#pragma unroll
        for (int j = 0; j < NJ; ++j) {
            const int c = 8 * lane + 512 * j;
            float v[8];
#pragma unroll
            for (int e = 0; e < 8; ++e) { float wgt = 1.f; if (MIX == 1) wgt = nw[c + e]; if (MIX == 2) wgt = nw[(c + e) & 127]; v[e] = u[j][e] * r[j] * wgt; }
            *(GAS v4u*)(GO + (size_t)row * W + c) = pack8(v);
        }
    }
}

template <int OFF> __device__ __forceinline__ bf16x8 tr_frag(unsigned addr) {
    s16x4 lo, hi;
    asm volatile("ds_read_b64_tr_b16 %0, %2\n\tds_read_b64_tr_b16 %1, %2 offset:%3\n\ts_waitcnt lgkmcnt(0)" : "=&v"(lo), "=&v"(hi) : "v"(addr), "i"(OFF) : "memory");
    return __builtin_shufflevector(lo, hi, 0, 1, 2, 3, 4, 5, 6, 7);
}
template <int OFF> __device__ __forceinline__ void tr_frag2(unsigned a0, unsigned a1, bf16x8& f0, bf16x8& f1) {
    s16x4 l0, h0, l1, h1;
    asm volatile("ds_read_b64_tr_b16 %0, %4\n\tds_read_b64_tr_b16 %1, %4 offset:%6\n\tds_read_b64_tr_b16 %2, %5\n\tds_read_b64_tr_b16 %3, %5 offset:%6\n\ts_waitcnt lgkmcnt(0)"
                 : "=&v"(l0), "=&v"(h0), "=&v"(l1), "=&v"(h1) : "v"(a0), "v"(a1), "i"(OFF) : "memory");
    f0 = __builtin_shufflevector(l0, h0, 0, 1, 2, 3, 4, 5, 6, 7); f1 = __builtin_shufflevector(l1, h1, 0, 1, 2, 3, 4, 5, 6, 7);
}

template <class Cf, class OutFn>
__device__ __forceinline__ void rec_step(LAS unsigned char* lds, const int w, const int lane, f32x4 (&S)[Cf::KPW][Cf::VS / 16], const LAS float* cum, const OutFn& out, const int tok0) {
    constexpr int C = Cf::C, KD = Cf::KD, VS = Cf::VS, NIT = C / 16, NJT = C / 16, NVT = VS / 16, KSK = KD / 32, KSC = C / 32;
    constexpr int RSK = Cf::RSK, RSV = Cf::RSV, RSP = Cf::RSP;
    constexpr bool CH = Cf::CH;
    const int fr = lane & 15, fq = lane >> 4, q4 = fr >> 2, p4 = fr & 3;
    const unsigned lbase = (unsigned)(size_t)lds;
    constexpr int NP = NIT * NJT, PPW = (NP + 7) / 8;
#pragma unroll
    for (int tt = 0; tt < PPW; ++tt) { const int t = w + 8 * tt;
        if (t < NP) { const int it = t / NJT, jt = t % NJT;
            f32x4 p = (f32x4){0.f, 0.f, 0.f, 0.f};
            if (jt <= it) {
#pragma unroll
                for (int ks = 0; ks < KSK; ++ks) {
                    const bf16x8 a = *(const LAS bf16x8*)(lds + Cf::KA + (16 * jt + fr) * RSK + (32 * ks + 8 * fq) * 2);
                    const bf16x8 b = *(const LAS bf16x8*)(lds + Cf::QA + (16 * it + fr) * RSK + (32 * ks + 8 * fq) * 2);
                    p = MFMA16(a, b, p); }
                const int i = 16 * it + fr;
                if (!CH) { const float ci = cum[i];
#pragma unroll
                    for (int r = 0; r < 4; ++r) { const int j = 16 * jt + 4 * fq + r; const float e = __expf(fminf(ci - cum[j], 0.f)); p[r] = (j <= i) ? p[r] * e : 0.f; } }
                else {
#pragma unroll
                    for (int r = 0; r < 4; ++r) { const int j = 16 * jt + 4 * fq + r; p[r] = (j <= i) ? p[r] : 0.f; } }
            }
            *(LAS v2u*)(lds + Cf::PM + (16 * it + fr) * RSP + (16 * jt + 4 * fq) * 2) = pack4v(p);
        } }
    constexpr int NO = NVT * NIT, OPW = (NO + 7) / 8;
    f32x4 O[OPW];
#pragma unroll
    for (int tt = 0; tt < OPW; ++tt) { const int t = w + 8 * tt; O[tt] = (f32x4){0.f, 0.f, 0.f, 0.f};
        if (t < NO) { const int vt = t / NIT, it = t % NIT; f32x4 o = (f32x4){0.f, 0.f, 0.f, 0.f};
#pragma unroll
            for (int ks = 0; ks < KSK; ++ks) {
                const bf16x8 a = *(const LAS bf16x8*)(lds + Cf::ST + (16 * vt + fr) * RSK + (32 * ks + 8 * fq) * 2);
                const bf16x8 b = *(const LAS bf16x8*)(lds + Cf::QB + (16 * it + fr) * RSK + (32 * ks + 8 * fq) * 2);
                o = MFMA16(a, b, o); }
            if (!CH) o = o * __expf(cum[16 * it + fr]);
            O[tt] = o; } }
#pragma unroll
    for (int ki = 0; ki < Cf::KPW; ++ki) { const int kt = w + 8 * ki;
        if (!CH) { const float d = __expf(cum[C - 1]);
#pragma unroll
            for (int vt = 0; vt < NVT; ++vt) S[ki][vt] = S[ki][vt] * d; }
        else { const LAS float* ds = (const LAS float*)(lds + Cf::DS) + 16 * kt + 4 * fq; const f32x4 d = (f32x4){ds[0], ds[1], ds[2], ds[3]};
#pragma unroll
            for (int vt = 0; vt < NVT; ++vt) S[ki][vt] = S[ki][vt] * d; }
#pragma unroll
        for (int ks = 0; ks < KSC; ++ks) {
            const bf16x8 a = tr_frag<4 * RSK>(lbase + Cf::KB + (32 * ks + 8 * fq + q4) * RSK + (16 * kt + 4 * p4) * 2);
#pragma unroll
            for (int vt = 0; vt < NVT; vt += 2) { bf16x8 b0, b1;
                tr_frag2<4 * RSV>(lbase + Cf::VB + (32 * ks + 8 * fq + q4) * RSV + (16 * vt + 4 * p4) * 2, lbase + Cf::VB + (32 * ks + 8 * fq + q4) * RSV + (16 * (vt + 1) + 4 * p4) * 2, b0, b1);
                S[ki][vt] = MFMA16(a, b0, S[ki][vt]); S[ki][vt + 1] = MFMA16(a, b1, S[ki][vt + 1]); } } }
    __syncthreads();
#pragma unroll
    for (int tt = 0; tt < OPW; ++tt) { const int t = w + 8 * tt;
        if (t < NO) { const int vt = t / NIT, it = t % NIT; f32x4 o = O[tt];
#pragma unroll
            for (int ks = 0; ks < KSC; ++ks) {
                const bf16x8 a = tr_frag<4 * RSV>(lbase + Cf::V + (32 * ks + 8 * fq + q4) * RSV + (16 * vt + 4 * p4) * 2);
                const bf16x8 b = *(const LAS bf16x8*)(lds + Cf::PM + (16 * it + fr) * RSP + (32 * ks + 8 * fq) * 2);
                o = MFMA16(a, b, o); }
            out(tok0 + 16 * it + fr, 16 * it + fr, 16 * vt + 4 * fq, o); } }
#pragma unroll
    for (int ki = 0; ki < Cf::KPW; ++ki) { const int kt = w + 8 * ki;
#pragma unroll
        for (int vt = 0; vt < NVT; ++vt) *(LAS v2u*)(lds + Cf::ST + (16 * vt + fr) * RSK + (16 * kt + 4 * fq) * 2) = pack4v(S[ki][vt]); }
    __syncthreads();
}
template <class Cf> __device__ __forceinline__ void rec_zero_state(Frame& F, f32x4 (&S)[Cf::KPW][Cf::VS / 16]) {
#pragma unroll
    for (int ki = 0; ki < Cf::KPW; ++ki)
#pragma unroll
        for (int vt = 0; vt < Cf::VS / 16; ++vt) S[ki][vt] = (f32x4){0.f, 0.f, 0.f, 0.f};
    for (int o = F.tid * 16; o < Cf::VS * Cf::RSK; o += 512 * 16) *(LAS v4u*)(F.lds + Cf::ST + o) = (v4u){0u, 0u, 0u, 0u};
}
template <class Cf> __device__ __forceinline__ void rec_store_state(Frame& F, const f32x4 (&S)[Cf::KPW][Cf::VS / 16], float* dst, int ldv) {
    const int fr = F.lane & 15, fq = F.lane >> 4;
#pragma unroll
    for (int ki = 0; ki < Cf::KPW; ++ki) { const int kt = F.wave + 8 * ki;
#pragma unroll
        for (int vt = 0; vt < Cf::VS / 16; ++vt)
#pragma unroll
            for (int r = 0; r < 4; ++r) dst[(size_t)(16 * kt + 4 * fq + r) * ldv + 16 * vt + fr] = S[ki][vt][r]; }
}

struct CfRet { static constexpr int C = 64, KD = 256, VS = 64, KPW = 2, RSK = 528, RSV = 144, RSP = 144; static constexpr bool CH = false;
    static constexpr int QA = 0, KA = 33792, QB = QA, KB = KA, V = 67584, VB = 76800, PM = 86016, ST = 95232, CUM = 129024, DS = 0, END = 129280; };
static_assert(CfRet::END <= SCR_BYTES, "ret lds");
struct RetOut { bf16* dst;
    __device__ __forceinline__ void operator()(int tok, int i, int vv0, const f32x4 o) const { *(GAS v2u*)(dst + (size_t)tok * 2048 + vv0) = pack4v(o); } };
__device__ __forceinline__ void ret_prompt_item(Frame& F, int item, const bf16* Q, const bf16* K, const bf16* V, bf16* RO, float* st_out) {
    const int b = item >> 5, h = (item >> 3) & 3, vs = item & 7, tid = F.tid;
    const float lg = logf(1.f - exp2f(-5.f - (float)h));
    LAS float* cum = (LAS float*)(F.lds + CfRet::CUM);
    __syncthreads();
    if (tid < 64) cum[tid] = (float)(tid + 1) * lg;
    f32x4 S[CfRet::KPW][4];
    rec_zero_state<CfRet>(F, S);
    const bf16* qg = Q + (size_t)(b * SEQ) * 1024 + h * 256; const bf16* kg = K + (size_t)(b * SEQ) * 1024 + h * 256; const bf16* vg = V + (size_t)(b * SEQ) * 2048 + h * 512 + vs * 64;
    const RetOut out{RO + (size_t)(b * SEQ) * 2048 + h * 512 + vs * 64};
    v4u qr[4], kr[4], vr;
#pragma unroll
    for (int i = 0; i < 4; ++i) { const int pc = tid + 512 * i, row = pc >> 5, c16 = pc & 31; qr[i] = *(const GAS v4u*)(qg + (size_t)row * 1024 + c16 * 8); kr[i] = *(const GAS v4u*)(kg + (size_t)row * 1024 + c16 * 8); }
    vr = *(const GAS v4u*)(vg + (size_t)(tid >> 3) * 2048 + (tid & 7) * 8);
    const float vsc = __expf((float)(63 - (tid >> 3)) * lg);
    for (int c = 0; c < SEQ / 64; ++c) {
#pragma unroll
        for (int i = 0; i < 4; ++i) { const int pc = tid + 512 * i, row = pc >> 5, c16 = pc & 31;
            *(LAS v4u*)(F.lds + CfRet::QA + row * 528 + c16 * 16) = qr[i]; *(LAS v4u*)(F.lds + CfRet::KA + row * 528 + c16 * 16) = kr[i]; }
        { const int row = tid >> 3, c16 = tid & 7; *(LAS v4u*)(F.lds + CfRet::V + row * 144 + c16 * 16) = vr;
          float f[8]; unpack8(vr, f);
#pragma unroll
          for (int e = 0; e < 8; ++e) f[e] *= vsc;
          *(LAS v4u*)(F.lds + CfRet::VB + row * 144 + c16 * 16) = pack8(f); }
        if (c + 1 < SEQ / 64) { const size_t r0 = (size_t)(c + 1) * 64;
#pragma unroll
            for (int i = 0; i < 4; ++i) { const int pc = tid + 512 * i, row = pc >> 5, c16 = pc & 31; qr[i] = *(const GAS v4u*)(qg + (r0 + row) * 1024 + c16 * 8); kr[i] = *(const GAS v4u*)(kg + (r0 + row) * 1024 + c16 * 8); }
            vr = *(const GAS v4u*)(vg + (r0 + (tid >> 3)) * 2048 + (tid & 7) * 8); }
        __syncthreads();
        rec_step<CfRet>(F.lds, F.wave, F.lane, S, cum, out, c * 64);
    }
    rec_store_state<CfRet>(F, S, st_out + ((size_t)(b * 4 + h) * 256) * 512 + vs * 64, 512);
}
__device__ __forceinline__ void ret_sample_items(Frame& F, const bf16* Q, const bf16* K, const bf16* V, bf16* RO, const float* st_in, float* st_out) {
    LAS float* qk = (LAS float*)F.lds; LAS float* red = qk + 512;
    const int tid = F.tid, lane = F.lane, w = F.wave;
    for (int item = F.vcu; item < MS * 4; item += F.G) {
        const int bs = item >> 2, h = item & 3; const size_t row = MPR + bs;
        __syncthreads();
        qk[tid] = tid < 256 ? bf2f(Q[row * 1024 + h * 256 + tid]) : bf2f(K[row * 1024 + h * 256 + (tid - 256)]);
        float v[8]; unpack8(*(const GAS v4u*)(V + row * 2048 + h * 512 + 8 * lane), v);
        __syncthreads();
        const float g = 1.f - exp2f(-5.f - (float)h);
        const float* sin = st_in + ((size_t)(bs * 4 + h) * 256) * 512 + 8 * lane; float* sout = st_out + ((size_t)(bs * 4 + h) * 256) * 512 + 8 * lane;
        float o[8];
#pragma unroll
        for (int e = 0; e < 8; ++e) o[e] = 0.f;
#pragma unroll 8
        for (int r = 0; r < 32; ++r) { const int kk = 32 * w + r;
            f32x4 s0 = __builtin_nontemporal_load((const GAS f32x4*)(sin + (size_t)kk * 512)), s1 = __builtin_nontemporal_load((const GAS f32x4*)(sin + (size_t)kk * 512 + 4));
            const float kf = qk[256 + kk], qf = qk[kk];
#pragma unroll
            for (int e = 0; e < 4; ++e) { s0[e] = g * s0[e] + kf * v[e]; s1[e] = g * s1[e] + kf * v[4 + e]; o[e] += s0[e] * qf; o[4 + e] += s1[e] * qf; }
            __builtin_nontemporal_store(s0, (GAS f32x4*)(sout + (size_t)kk * 512)); __builtin_nontemporal_store(s1, (GAS f32x4*)(sout + (size_t)kk * 512 + 4)); }
#pragma unroll
        for (int e = 0; e < 8; ++e) red[w * 512 + 8 * lane + e] = o[e];
        __syncthreads();
        float acc = 0.f;
#pragma unroll
        for (int ww = 0; ww < 8; ++ww) acc += red[ww * 512 + tid];
        RO[row * 2048 + h * 512 + tid] = (bf16)(cvt_pk_bf16(acc, acc) & 0xffffu);
    }
    __syncthreads();
}

struct CfSsd { static constexpr int C = 64, KD = 128, VS = 64, KPW = 1, RSK = 272, RSV = 144, RSP = 144; static constexpr bool CH = false;
    static constexpr int QA = 0, KA = 17408, QB = QA, KB = KA, V = 34816, VB = 44032, PM = 53248, ST = 62464, XS = 79872, CUM = 89088, CW = 89600, DS = 0, END = 96000; };
static_assert(CfSsd::END <= SCR_BYTES, "ssd lds");
struct SsdOut { bf16* dst; const LAS unsigned char* xs; float Dh;
    __device__ __forceinline__ void operator()(int tok, int i, int vv0, const f32x4 o) const {
        const v2u xw = *(const LAS v2u*)(xs + i * 144 + vv0 * 2);
        const f32x4 x = (f32x4){bflo(xw.x), bfhi(xw.x), bflo(xw.y), bfhi(xw.y)};
        *(GAS v2u*)(dst + (size_t)tok * 2048 + vv0) = pack4v(o + x * Dh); } };
__device__ __forceinline__ int ssd_gcol(int lch, int head, int grp) { return lch < 64 ? head * 64 + lch : (lch < 192 ? 2048 + grp * 128 + (lch - 64) : 2560 + grp * 128 + (lch - 192)); }
__device__ __forceinline__ void ssd_prompt_item(Frame& F, int item, const bf16* XBC, const float* DT, bf16* T, float* st_out,
                                                const float* conv_w, const float* conv_b, const float* dt_bias, const float* a_log, const float* d_skip) {
    const int b = item >> 5, head = item & 31, grp = head >> 3, tid = F.tid, lane = F.lane, w = F.wave;
    const float a = -expf(a_log[head]), dtb = dt_bias[head], Dh = d_skip[head];
    LAS float* cw = (LAS float*)(F.lds + CfSsd::CW); LAS float* cumb = (LAS float*)(F.lds + CfSsd::CUM);
    __syncthreads();
    for (int idx = tid; idx < 1600; idx += 512) { const int tap = idx / 320, lch = idx - tap * 320, gch = ssd_gcol(lch, head, grp); cw[idx] = tap < 4 ? conv_w[tap * 3072 + gch] : conv_b[gch]; }
    f32x4 S[CfSsd::KPW][4];
    rec_zero_state<CfSsd>(F, S);
    const bf16* xg = XBC + (size_t)(b * SEQ) * 3072; const float* dtg = DT + (size_t)(b * SEQ) * 32 + head;
    const SsdOut out{T + (size_t)(b * SEQ) * 2048 + head * 64, F.lds + CfSsd::XS, Dh};
#define SSD_CUM(cc) do { if (w == 0) { const int tk_ = (cc) * 64 + lane; float v_ = softplusf_(dtg[(size_t)tk_ * 32] + dtb) * a; \
        _Pragma("unroll") for (int o_ = 1; o_ < 64; o_ <<= 1) { const float u_ = __shfl_up(v_, o_); if (lane >= o_) v_ += u_; } cumb[((cc) & 1) * 64 + lane] = v_; } } while (0)
    SSD_CUM(0);
    __syncthreads();
    for (int c = 0; c < SEQ / 64; ++c) {
        const LAS float* cum = cumb + (c & 1) * 64; const float tot = cum[63];
#pragma unroll 1
        for (int r = 0; r < 5; ++r) { const int op = tid + 512 * r, i = op / 40, cg = op - i * 40, lch = 8 * cg, gcol = ssd_gcol(lch, head, grp), tok = c * 64 + i;
            float acc[8];
#pragma unroll
            for (int e = 0; e < 8; ++e) acc[e] = cw[4 * 320 + lch + e];
#pragma unroll
            for (int tap = 0; tap < 4; ++tap) { const int tk = tok - 3 + tap;
                if (tk >= 0) { float x[8]; unpack8(*(const GAS v4u*)(xg + (size_t)tk * 3072 + gcol), x);
#pragma unroll
                    for (int e = 0; e < 8; ++e) acc[e] += x[e] * cw[tap * 320 + lch + e]; } }
#pragma unroll
            for (int e = 0; e < 8; ++e) acc[e] = siluf_(acc[e]);
            if (cg < 8) { const float dtv = softplusf_(dtg[(size_t)tok * 32] + dtb), wj = dtv * __expf(tot - cum[i]);
                *(LAS v4u*)(F.lds + CfSsd::XS + i * 144 + lch * 2) = pack8(acc);
                float f[8];
#pragma unroll
                for (int e = 0; e < 8; ++e) f[e] = acc[e] * dtv;
                *(LAS v4u*)(F.lds + CfSsd::V + i * 144 + lch * 2) = pack8(f);
#pragma unroll
                for (int e = 0; e < 8; ++e) f[e] = acc[e] * wj;
                *(LAS v4u*)(F.lds + CfSsd::VB + i * 144 + lch * 2) = pack8(f); }
            else if (cg < 24) *(LAS v4u*)(F.lds + CfSsd::KA + i * 272 + (lch - 64) * 2) = pack8(acc);
            else *(LAS v4u*)(F.lds + CfSsd::QA + i * 272 + (lch - 192) * 2) = pack8(acc);
        }
        if (c + 1 < SEQ / 64) SSD_CUM(c + 1);
        __syncthreads();
        rec_step<CfSsd>(F.lds, w, lane, S, cum, out, c * 64);
    }
#undef SSD_CUM
    rec_store_state<CfSsd>(F, S, st_out + ((size_t)(b * 32 + head) * 128) * 64, 64);
}
__device__ __forceinline__ void ssd_sample_items(Frame& F, const bf16* XBC, const float* DT, bf16* T, const float* st_in, float* st_out, const float* conv_st,
                                                 const float* conv_w, const float* conv_b, const float* dt_bias, const float* a_log, const float* d_skip) {
    const int gw = F.vcu * NWAVES + F.wave, NGW = F.G * NWAVES, lane = F.lane;
    LAS float* scr = (LAS float*)(F.lds + F.wave * 2048);
    __syncthreads();
    for (int item = gw; item < MS * 32; item += NGW) {
        const int bs = item >> 5, head = item & 31, grp = head >> 3; const size_t row = MPR + bs;
        asm volatile("" ::: "memory");
#pragma unroll
        for (int r = 0; r < 5; ++r) { const int lch = lane + 64 * r, gch = ssd_gcol(lch, head, grp);
            float acc = conv_b[gch];
#pragma unroll
            for (int tap = 0; tap < 3; ++tap) acc += conv_st[((size_t)bs * 3 + tap) * 3072 + gch] * conv_w[tap * 3072 + gch];
            acc += bf2f(XBC[row * 3072 + gch]) * conv_w[3 * 3072 + gch];
            scr[lch] = siluf_(acc); }
        LDS_WAIT();
        const float dtv = softplusf_(DT[row * 32 + head] + dt_bias[head]), dA = __expf(dtv * -expf(a_log[head])), Dh = d_skip[head];
        const int v4 = (lane & 15) * 4, kq = lane >> 4;
        const f32x4 xs4 = (f32x4){scr[v4], scr[v4 + 1], scr[v4 + 2], scr[v4 + 3]}, xd = xs4 * dtv;
        const float* sin = st_in + ((size_t)(bs * 32 + head) * 128) * 64 + v4; float* sout = st_out + ((size_t)(bs * 32 + head) * 128) * 64 + v4;
        f32x4 y = (f32x4){0.f, 0.f, 0.f, 0.f};
#pragma unroll 8
        for (int i = 0; i < 32; ++i) { const int kk = 4 * i + kq;
            f32x4 s = __builtin_nontemporal_load((const GAS f32x4*)(sin + (size_t)kk * 64));
            s = s * dA + xd * scr[64 + kk];
            __builtin_nontemporal_store(s, (GAS f32x4*)(sout + (size_t)kk * 64));
            y = y + s * scr[192 + kk]; }
#pragma unroll
        for (int e = 0; e < 4; ++e) { y[e] += __shfl_xor(y[e], 16); y[e] += __shfl_xor(y[e], 32); }
        if (lane < 16) *(GAS v2u*)(T + row * 2048 + head * 64 + v4) = pack4v(y + xs4 * Dh);
        LDS_WAIT();
    }
    __syncthreads();
}
__device__ __forceinline__ void ssd_conv_out(Frame& F, const bf16* XBC, const float* conv_st, float* outp, float* outs) {
    const int NP_ = BP * 3 * 3072, NS_ = MS * 3 * 3072;
    for (int idx = F.vcu * 512 + F.tid; idx < NP_ + NS_; idx += F.G * 512) {
        if (idx < NP_) { const int b = idx / 9216, rem = idx - b * 9216, wi = rem / 3072, ch = rem - wi * 3072; outp[idx] = bf2f(XBC[(size_t)(b * SEQ + SEQ - 3 + wi) * 3072 + ch]); }
        else { const int k = idx - NP_, bs = k / 9216, rem = k - bs * 9216, wi = rem / 3072, ch = rem - wi * 3072;
            outs[k] = wi < 2 ? conv_st[((size_t)bs * 3 + wi + 1) * 3072 + ch] : bf2f(XBC[(size_t)(MPR + bs) * 3072 + ch]); }
    }
}

struct CfHg { static constexpr int C = 32, KD = 128, VS = 32, KPW = 1, RSK = 272, RSV = 80, RSP = 80; static constexpr bool CH = true;
    static constexpr int QA = 0, KA = 8704, QB = 17408, KB = 26112, V = 34816, VB = V, PM = 37376, ST = 39936, DS = 48640, PART = 49152, CUM = 0, END = 51200; };
static_assert(CfHg::END <= SCR_BYTES, "hgrn lds");
struct HgOut { bf16* dst;
    __device__ __forceinline__ void operator()(int tok, int i, int vv0, const f32x4 o) const { *(GAS v2u*)(dst + (size_t)tok * 1024 + vv0) = pack4v(o); } };
__device__ __forceinline__ void st_bf16_lds(LAS unsigned char* p, float x) { *(LAS unsigned short*)p = (unsigned short)(cvt_pk_bf16(x, x) & 0xffffu); }
__device__ __forceinline__ void hg_prompt_item(Frame& F, int item, const bf16* HQ, const float* LA, const bf16* HV, bf16* RO, float* st_out) {
    const int b = item >> 5, h = (item >> 2) & 7, vs = item & 3, tid = F.tid, kk = tid & 127, tg = tid >> 7;
    LAS float* part = (LAS float*)(F.lds + CfHg::PART); LAS float* dsv = (LAS float*)(F.lds + CfHg::DS);
    __syncthreads();
    f32x4 S[CfHg::KPW][2];
    rec_zero_state<CfHg>(F, S);
    const size_t base = (size_t)(b * SEQ) * 1024 + h * 128;
    const HgOut out{RO + base + vs * 32};
    float la[8]; unsigned short qr[8]; v4u vr = (v4u){0u, 0u, 0u, 0u};
#pragma unroll
    for (int e = 0; e < 8; ++e) { const size_t ix = base + (size_t)(8 * tg + e) * 1024 + kk; la[e] = LA[ix]; qr[e] = HQ[ix]; }
    if (tid < 128) vr = *(const GAS v4u*)(HV + base + (size_t)(tid >> 2) * 1024 + vs * 32 + (tid & 3) * 8);
    for (int c = 0; c < SEQ / 32; ++c) {
        float lc[8]; lc[0] = la[0];
#pragma unroll
        for (int e = 1; e < 8; ++e) lc[e] = lc[e - 1] + la[e];
        part[tg * 128 + kk] = lc[7];
        __syncthreads();
        const float p0 = part[kk], p1 = part[128 + kk], p2 = part[256 + kk], p3 = part[384 + kk];
        const float off = (tg > 0 ? p0 : 0.f) + (tg > 1 ? p1 : 0.f) + (tg > 2 ? p2 : 0.f), tot = (p0 + p1) + (p2 + p3), ref = p0 + p1;
#pragma unroll
        for (int e = 0; e < 8; ++e) { const int i = 8 * tg + e; const float cm = off + lc[e], kf = 1.f - __expf(la[e]), qv = bf2f(qr[e]);
            const float ea = __expf(fminf(fmaxf(cm - ref, -80.f), 80.f)), eb = __expf(fminf(fmaxf(ref - cm, -80.f), 80.f));
            st_bf16_lds(F.lds + CfHg::QA + i * 272 + kk * 2, qv * ea); st_bf16_lds(F.lds + CfHg::KA + i * 272 + kk * 2, kf * eb);
            st_bf16_lds(F.lds + CfHg::QB + i * 272 + kk * 2, qv * __expf(cm)); st_bf16_lds(F.lds + CfHg::KB + i * 272 + kk * 2, kf * __expf(tot - cm)); }
        if (tg == 0) dsv[kk] = __expf(tot);
        if (tid < 128) *(LAS v4u*)(F.lds + CfHg::V + (tid >> 2) * 80 + (tid & 3) * 16) = vr;
        if (c + 1 < SEQ / 32) { const size_t b2 = base + (size_t)(c + 1) * 32 * 1024;
#pragma unroll
            for (int e = 0; e < 8; ++e) { const size_t ix = b2 + (size_t)(8 * tg + e) * 1024 + kk; la[e] = LA[ix]; qr[e] = HQ[ix]; }
            if (tid < 128) vr = *(const GAS v4u*)(HV + b2 + (size_t)(tid >> 2) * 1024 + vs * 32 + (tid & 3) * 8); }
        __syncthreads();
        rec_step<CfHg>(F.lds, F.wave, F.lane, S, (const LAS float*)nullptr, out, c * 32);
    }
    rec_store_state<CfHg>(F, S, st_out + ((size_t)(b * 8 + h) * 128) * 128 + vs * 32, 128);
}
__device__ __forceinline__ void hg_sample_items(Frame& F, const bf16* HQ, const float* LA, const bf16* HV, bf16* RO, const float* st_in, float* st_out) {
    const int gw = F.vcu * NWAVES + F.wave, NGW = F.G * NWAVES, lane = F.lane;
    LAS float* scr = (LAS float*)(F.lds + F.wave * 2048);
    __syncthreads();
    for (int item = gw; item < MS * 16; item += NGW) {
        const int bs = item >> 4, h = (item >> 1) & 7, vh = item & 1; const size_t rb = (size_t)(MPR + bs) * 1024 + h * 128;
        asm volatile("" ::: "memory");
#pragma unroll
        for (int r = 0; r < 2; ++r) { const int kk = lane + 64 * r; scr[kk] = __expf(LA[rb + kk]); scr[128 + kk] = bf2f(HQ[rb + kk]); }
        LDS_WAIT();
        const int v4 = (lane & 15) * 4, kq = lane >> 4;
        const v2u iw = *(const GAS v2u*)(HV + rb + vh * 64 + v4);
        const f32x4 iv = (f32x4){bflo(iw.x), bfhi(iw.x), bflo(iw.y), bfhi(iw.y)};
        const float* sin = st_in + ((size_t)(bs * 8 + h) * 128) * 128 + vh * 64 + v4; float* sout = st_out + ((size_t)(bs * 8 + h) * 128) * 128 + vh * 64 + v4;
        f32x4 o = (f32x4){0.f, 0.f, 0.f, 0.f};
#pragma unroll 8
        for (int i = 0; i < 32; ++i) { const int kk = 4 * i + kq; const float f = scr[kk];
            f32x4 s = __builtin_nontemporal_load((const GAS f32x4*)(sin + (size_t)kk * 128));
            s = s * f + iv * (1.f - f);
            __builtin_nontemporal_store(s, (GAS f32x4*)(sout + (size_t)kk * 128));
            o = o + s * scr[128 + kk]; }
#pragma unroll
        for (int e = 0; e < 4; ++e) { o[e] += __shfl_xor(o[e], 16); o[e] += __shfl_xor(o[e], 32); }
        if (lane < 16) *(GAS v2u*)(RO + rb + vh * 64 + v4) = pack4v(o);
        LDS_WAIT();
    }
    __syncthreads();
}

__device__ __forceinline__ void p0_transpose_item(const float* W, int K, int N, bf16* WT, LAS float* scr, int item, int lane, bool inter) {
    const int nblk = N / 32, kb = item / nblk, nb = item - kb * nblk, k0 = 64 * kb, n0 = 32 * nb;
    int s0 = n0; if (inter) { const int t = n0 >> 8, j = n0 & 255; s0 = j < 128 ? 128 * t + j : DFF + 128 * t + (j - 128); }
#pragma unroll 8
    for (int i = 0; i < 32; ++i) { const int kk = 2 * i + (lane >> 5); scr[kk * 33 + (lane & 31)] = W[(size_t)(k0 + kk) * N + s0 + (lane & 31)]; }
    LDS_WAIT(); asm volatile("" ::: "memory");
    const int c = lane & 7;
#pragma unroll
    for (int j = 0; j < 4; ++j) { const int n = (lane >> 3) + 8 * j; const LAS float* s = scr + (8 * c) * 33 + n;
        v4u o; o.x = cvt_pk_bf16(s[0 * 33], s[1 * 33]); o.y = cvt_pk_bf16(s[2 * 33], s[3 * 33]); o.z = cvt_pk_bf16(s[4 * 33], s[5 * 33]); o.w = cvt_pk_bf16(s[6 * 33], s[7 * 33]);
        *(GAS v4u*)(WT + (size_t)(n0 + n) * K + k0 + 8 * c) = o; }
    LDS_WAIT(); asm volatile("" ::: "memory");
}
__device__ __forceinline__ void p0_matrix(Frame& F, const float* W, int K, int N, bf16* WT, bool inter, int& itbase) {
    const int gw = F.vcu * NWAVES + F.wave, NGW = F.G * NWAVES, nit = (K / 64) * (N / 32);
    LAS float* scr = (LAS float*)(F.lds + F.wave * 16384);
    int first = (gw - itbase) % NGW; if (first < 0) first += NGW;
    for (int it = first; it < nit; it += NGW) p0_transpose_item(W, K, N, WT, scr, it, F.lane, inter);
    itbase += nit;
}

#ifndef REP_PROMPT
#define REP_PROMPT 1
#endif
#ifndef REP_SAMPLE
#define REP_SAMPLE 1
#endif
#ifndef REP_GEMM
#define REP_GEMM 1
#endif
#ifndef REP_GN
#define REP_GN 1
#endif
#ifndef REP_P0
#define REP_P0 1
#endif
#ifndef REP_SKINNY
#define REP_SKINNY 1
#endif
#define REPEAT(n) _Pragma("unroll 1") for (int rep_ = 0; rep_ < (n); ++rep_)
struct Args { const float* in[30]; float* out; unsigned char* ws; int ph_lo, ph_hi; };
enum { I_XP = 0, I_XS, I_CP, I_CS, I_SRET, I_SSSD, I_SCONV, I_SHG, I_WADA, I_BADA, I_NMPRE, I_NMPOST, I_NFPRE, I_NFPOST, I_RETIN, I_RETOUT, I_SSDIN, I_CONVW, I_CONVB, I_DTB, I_ALOG, I_SSDD,
       I_SSDNORM, I_SSDOUT, I_HGIN, I_HGLB, I_HGNORM, I_HGOUT, I_FFNIN, I_FFNOUT };
constexpr int N_PHASES = 3 + 8 * 4;

__global__ void __launch_bounds__(NWAVES * 64, 2) mk_fwd(Args args) {
    extern __shared__ __attribute__((aligned(16))) unsigned char lds_raw[];
    Frame F;
    F.lds = (LAS unsigned char*)lds_raw;
    F.tid = threadIdx.x; F.lane = F.tid & 63; F.wave = __builtin_amdgcn_readfirstlane(F.tid >> 6);
    F.G = gridDim.x; { const int bx = blockIdx.x; F.vcu = (F.G % 8 == 0) ? (bx % 8) * (F.G / 8) + bx / 8 : bx; }
    unsigned char* ws = args.ws;
    gu32* ctl = (gu32*)(ws + WS_CTL);
    for (int u = F.tid; u < (LDS_BYTES - LDSCTL_OFF) / 4; u += NWAVES * 64) ((LAS unsigned*)(F.lds + LDSCTL_OFF))[u] = 0u;
    __syncthreads();
    XcdBarrier bar; bar.bar = (unsigned*)(ctl + CW_BAR); bar.x = 0; bar.st = nullptr;
    if (MK_N_LAUNCHES == 1) bar = xcd_barrier_post((unsigned*)(ctl + CW_BAR), (volatile LAS unsigned*)(F.lds + LDSCTL_OFF) + 8);
    const int lo = args.ph_lo, hi = args.ph_hi;
#define IN(k) (lo <= (k) && (k) < hi)
#define SEAM(k) do { if (IN((k) + 1)) xcd_barrier(bar); } while (0)
#define INP(i) (args.in[i])
    float* const out = args.out;
    float* const X = out + O_Y;
    bf16* const Hb = (bf16*)(ws + WS_H); bf16* const RO = (bf16*)(ws + WS_RO); bf16* const GO = (bf16*)(ws + WS_GO); bf16* const OUTB = (bf16*)(ws + WS_OUT); bf16* const ACT = (bf16*)(ws + WS_ACT);
    float* const MOD = (float*)(ws + WS_MOD); float* const LB = (float*)(ws + WS_LB);
    bf16* const CACT = (bf16*)(ws + WS_CACT);
    bf16* const WADA = (bf16*)(ws + WS_WADA);
    unsigned char* const PJ = ws + WS_PROJ;

    if (IN(0)) { REPEAT(REP_P0) {
        int itb = 0;
#pragma unroll 1
        for (int l = 0; l < 4; ++l) p0_matrix(F, INP(I_WADA) + (size_t)l * D * NMOD, D, NMOD, WADA + (size_t)l * NMOD * D, false, itb);
#pragma unroll 1
        for (int j = 0; j < 2; ++j) p0_matrix(F, INP(I_RETIN) + (size_t)j * D * RET_IN, D, RET_IN, (bf16*)(ws + WS_WRETIN) + (size_t)j * RET_IN * D, false, itb);
#pragma unroll 1
        for (int j = 0; j < 2; ++j) p0_matrix(F, INP(I_RETOUT) + (size_t)j * 2048 * D, 2048, D, (bf16*)(ws + WS_WRETOUT) + (size_t)j * D * 2048, false, itb);
        p0_matrix(F, INP(I_SSDIN), D, SSD_IN, (bf16*)(ws + WS_WSSDIN), false, itb);
        p0_matrix(F, INP(I_SSDOUT), 2048, D, (bf16*)(ws + WS_WSSDOUT), false, itb);
        p0_matrix(F, INP(I_HGIN), D, HG_IN, (bf16*)(ws + WS_WHGIN), false, itb);
        p0_matrix(F, INP(I_HGOUT), D, D, (bf16*)(ws + WS_WHGOUT), false, itb);
#pragma unroll 1
        for (int l = 0; l < 4; ++l) p0_matrix(F, INP(I_FFNIN) + (size_t)l * D * FFN_IN, D, FFN_IN, (bf16*)(ws + WS_WFFNIN) + (size_t)l * FFN_IN * D, true, itb);
#pragma unroll 1
        for (int l = 0; l < 4; ++l) p0_matrix(F, INP(I_FFNOUT) + (size_t)l * DFF * D, DFF, D, (bf16*)(ws + WS_WFFNOUT) + (size_t)l * D * DFF, false, itb);
        for (int idx = F.vcu * 512 + F.tid; idx < 256 * 128; idx += F.G * 512) { const int row = idx >> 7, c8 = (idx & 127) * 8; v4u o = (v4u){0u, 0u, 0u, 0u};
            if (row < NCOND) { const float* src = row < BP ? INP(I_CP) + (size_t)row * D : INP(I_CS) + (size_t)(row - BP) * D;
                const f32x4 a = *(const GAS f32x4*)(src + c8), b = *(const GAS f32x4*)(src + c8 + 4); o = pack8v(silu4(a), silu4(b)); }
            *(GAS v4u*)(CACT + (size_t)row * D + c8) = o; }
        for (int idx = F.vcu * 512 + F.tid; idx < 1024; idx += F.G * 512) { const float* lg = INP(I_HGLB);
            const float l0 = lg[idx], l1 = lg[1024 + idx], l2 = lg[2048 + idx], l3 = lg[3072 + idx], m = fmaxf(fmaxf(l0, l1), fmaxf(l2, l3));
            const float e0 = expf(l0 - m), e1 = expf(l1 - m), e2 = expf(l2 - m), e3 = expf(l3 - m); LB[idx] = (e1 + e2) / ((e0 + e1) + (e2 + e3)); }
        }
        SEAM(0);
    }
    if (IN(1)) {
        const EmitMod E{MOD, INP(I_BADA)};
        REPEAT(REP_SKINNY) skinny_gemm<8>(F, CACT, D, 2, NCOND, 0, WADA, (NMODALL / 256) * 8, false, E, 0, F.G);
        SEAM(1);
    }
    if (IN(2)) {
        resnorm_phase<0>(F, INP(I_XP), INP(I_XS), X, nullptr, Hb, MOD, nullptr, 0, INP(I_NMPRE), 0 * NMOD + 0 * D, 0 * NMOD + 1 * D);
        SEAM(2);
    }

#define MAIN_GEMM(EmitT, eobj, Aptr, Btptr, N_, K_) do { pg8::Gemm g_{(const pg8::bf16_t*)(Aptr), (const pg8::bf16_t*)(Btptr), MPR, (N_), (K_)}; pg8::StaticOrder S_; S_.init(MPR, (N_), F.G, (int)blockIdx.x); \
        const EpiGen<EmitT> E_{eobj}; _Pragma("unroll") for (int rg_ = 0; rg_ < REP_GEMM; ++rg_) pg8::gemm_phase<EpiGen<EmitT>, pg8::StaticOrder, PG8_ALIGN, PG8_SP2>(F.lds, g_, S_, E_); } while (0)
#define FFN_BLOCK(L, pb, LASTL) do { \
    if (IN((pb) + 4)) { resnorm_phase<1>(F, nullptr, nullptr, X, OUTB, Hb, MOD, INP(I_NMPOST) + (L) * D, (L) * NMOD + 2 * D, INP(I_NFPRE) + (L) * D, (L) * NMOD + 3 * D, (L) * NMOD + 4 * D); SEAM((pb) + 4); } \
    if (IN((pb) + 5)) { const bf16* wt_ = (const bf16*)(ws + WS_WFFNIN) + (size_t)(L) * FFN_IN * D; const EmitFfnIn e_{ACT}; \
        MAIN_GEMM(EmitFfnIn, e_, Hb, wt_, FFN_IN, D); REPEAT(REP_SKINNY) skinny_gemm<8>(F, Hb + (size_t)MPR * D, D, 1, MS, MPR, wt_, (FFN_IN / 256) * 8, false, e_, F.G / 2, F.G / 2); SEAM((pb) + 5); } \
    if (IN((pb) + 6)) { const bf16* wt_ = (const bf16*)(ws + WS_WFFNOUT) + (size_t)(L) * D * DFF; const EmitOut e_{OUTB}; \
        MAIN_GEMM(EmitOut, e_, ACT, wt_, D, DFF); REPEAT(REP_SKINNY) skinny_gemm<4>(F, ACT + (size_t)MPR * DFF, DFF, 2, MS, MPR, wt_, (D / 256) * 8, false, e_, 0, F.G); SEAM((pb) + 6); } \
    if (IN((pb) + 7)) { if (LASTL) resnorm_phase<2>(F, nullptr, nullptr, X, OUTB, Hb, MOD, INP(I_NFPOST) + (L) * D, (L) * NMOD + 5 * D, nullptr, 0, 0); \
        else resnorm_phase<1>(F, nullptr, nullptr, X, OUTB, Hb, MOD, INP(I_NFPOST) + (L) * D, (L) * NMOD + 5 * D, INP(I_NMPRE) + ((L) + 1) * D, ((L) + 1) * NMOD + 0 * D, ((L) + 1) * NMOD + 1 * D); \
        if (!(LASTL)) SEAM((pb) + 7); } } while (0)
#define OUT_PROJ(pb, wt, K_) do { if (IN((pb) + 3)) { const EmitOut e_{OUTB}; MAIN_GEMM(EmitOut, e_, GO, (wt), D, (K_)); REPEAT(REP_SKINNY) skinny_gemm<4>(F, GO + (size_t)MPR * (K_), (K_), 2, MS, MPR, (wt), (D / 256) * 8, false, e_, 0, F.G); SEAM((pb) + 3); } } while (0)
#define RET_LAYER(L, J, pb) do { \
    bf16* const Qp_ = (bf16*)(PJ + PJ_RET_Q); bf16* const Kp_ = (bf16*)(PJ + PJ_RET_K); bf16* const Vp_ = (bf16*)(PJ + PJ_RET_V); bf16* const SGp_ = (bf16*)(PJ + PJ_RET_SG); \
    if (IN((pb) + 0)) { const bf16* wt_ = (const bf16*)(ws + WS_WRETIN) + (size_t)(J) * RET_IN * D; const EmitRetIn e_{Qp_, Kp_, Vp_, SGp_}; \
        MAIN_GEMM(EmitRetIn, e_, Hb, wt_, RET_IN, D); REPEAT(REP_SKINNY) skinny_gemm<8>(F, Hb + (size_t)MPR * D, D, 1, MS, MPR, wt_, (RET_IN / 256) * 8, false, e_, 0, F.G); SEAM((pb) + 0); } \
    if (IN((pb) + 1)) { REPEAT(REP_PROMPT) for (int item = F.vcu; item < 256; item += F.G) ret_prompt_item(F, item, Qp_, Kp_, Vp_, RO, out + O_RETP + (size_t)(J) * 8 * 4 * 256 * 512); \
        REPEAT(REP_SAMPLE) ret_sample_items(F, Qp_, Kp_, Vp_, RO, INP(I_SRET) + (size_t)(J) * 128 * 4 * 256 * 512, out + O_RETS + (size_t)(J) * 128 * 4 * 256 * 512); SEAM((pb) + 1); } \
    if (IN((pb) + 2)) { REPEAT(REP_GN) gatenorm_phase<0>(F, RO, SGp_, GO, nullptr); SEAM((pb) + 2); } \
    OUT_PROJ(pb, (const bf16*)(ws + WS_WRETOUT) + (size_t)(J) * D * 2048, 2048); \
    } while (0)

    RET_LAYER(0, 0, 3);
    FFN_BLOCK(0, 3, false);
    {
        constexpr int pb = 11;
        bf16* const SZ_ = (bf16*)(PJ + PJ_SSD_SZ); bf16* const XBC_ = (bf16*)(PJ + PJ_SSD_XBC); float* const DT_ = (float*)(PJ + PJ_SSD_DT);
        if (IN(pb + 0)) { const bf16* wt_ = (const bf16*)(ws + WS_WSSDIN); const EmitSsdIn e_{SZ_, XBC_}; const EmitDt ed_{DT_};
            MAIN_GEMM(EmitSsdIn, e_, Hb, wt_, SSD_INM, D);
            REPEAT(REP_SKINNY) skinny_gemm<8>(F, Hb + (size_t)MPR * D, D, 1, MS, MPR, wt_, (SSD_INM / 256) * 8, false, e_, 0, F.G);
            REPEAT(REP_SKINNY) skinny_gemm<8>(F, Hb, D, MT / 128, MT, 0, wt_, 1, true, ed_, 100, 129);
            SEAM(pb + 0); }
        if (IN(pb + 1)) {
            REPEAT(REP_PROMPT) for (int item = F.vcu; item < 256; item += F.G) ssd_prompt_item(F, item, XBC_, DT_, RO, out + O_SSDP, INP(I_CONVW), INP(I_CONVB), INP(I_DTB), INP(I_ALOG), INP(I_SSDD));
            REPEAT(REP_SAMPLE) ssd_sample_items(F, XBC_, DT_, RO, INP(I_SSSD), out + O_SSDS, INP(I_SCONV), INP(I_CONVW), INP(I_CONVB), INP(I_DTB), INP(I_ALOG), INP(I_SSDD));
            ssd_conv_out(F, XBC_, INP(I_SCONV), out + O_CONVP, out + O_CONVS);
            SEAM(pb + 1); }
        if (IN(pb + 2)) { REPEAT(REP_GN) gatenorm_phase<1>(F, RO, SZ_, GO, INP(I_SSDNORM)); SEAM(pb + 2); }
        OUT_PROJ(pb, (const bf16*)(ws + WS_WSSDOUT), 2048);
    }
    FFN_BLOCK(1, 11, false);
    {
        constexpr int pb = 19;
        bf16* const HQ_ = (bf16*)(PJ + PJ_HG_Q); float* const LA_ = (float*)(PJ + PJ_HG_LA); bf16* const HV_ = (bf16*)(PJ + PJ_HG_V); bf16* const HSG_ = (bf16*)(PJ + PJ_HG_SG);
        if (IN(pb + 0)) { const bf16* wt_ = (const bf16*)(ws + WS_WHGIN); const EmitHgIn e_{HQ_, HV_, HSG_, LA_, LB};
            MAIN_GEMM(EmitHgIn, e_, Hb, wt_, HG_IN, D); REPEAT(REP_SKINNY) skinny_gemm<8>(F, Hb + (size_t)MPR * D, D, 1, MS, MPR, wt_, (HG_IN / 256) * 8, false, e_, 0, F.G); SEAM(pb + 0); }
        if (IN(pb + 1)) {
            REPEAT(REP_PROMPT) for (int item = F.vcu; item < 256; item += F.G) hg_prompt_item(F, item, HQ_, LA_, HV_, RO, out + O_HGP);
            REPEAT(REP_SAMPLE) hg_sample_items(F, HQ_, LA_, HV_, RO, INP(I_SHG), out + O_HGS);
            SEAM(pb + 1); }
        if (IN(pb + 2)) { REPEAT(REP_GN) gatenorm_phase<2>(F, RO, HSG_, GO, INP(I_HGNORM)); SEAM(pb + 2); }
        OUT_PROJ(pb, (const bf16*)(ws + WS_WHGOUT), 1024);
    }
    FFN_BLOCK(2, 19, false);
    RET_LAYER(3, 1, 27);
    FFN_BLOCK(3, 27, true);
#undef IN
#undef SEAM
}

extern "C" void kernel_launch(void* const* d_in, const int* in_sizes, int n_in, void* d_out, int out_size, void* d_ws, size_t ws_size, hipStream_t stream) {
    static int grid = 0;
    if (grid == 0) {
        if (n_in != 30 || (size_t)out_size != O_END || ws_size < WS_END) { fprintf(stderr, "kernel_launch: unexpected shapes (n_in %d out %d ws %zu)\n", n_in, out_size, ws_size); grid = -1; return; }
        int dev = 0, cus = 0, per_cu = 0;
        if (hipGetDevice(&dev) != hipSuccess || hipDeviceGetAttribute(&cus, hipDeviceAttributeMultiprocessorCount, dev) != hipSuccess) { grid = -1; return; }
        if (hipFuncSetAttribute((const void*)mk_fwd, hipFuncAttributeMaxDynamicSharedMemorySize, LDS_BYTES) != hipSuccess) { fprintf(stderr, "kernel_launch: hipFuncSetAttribute failed\n"); grid = -1; return; }
        if (hipOccupancyMaxActiveBlocksPerMultiprocessor(&per_cu, (const void*)mk_fwd, NWAVES * 64, LDS_BYTES) != hipSuccess || per_cu < 1) { fprintf(stderr, "kernel_launch: occupancy query says %d\n", per_cu); }
        (void)hipGetLastError();
        grid = cus;
    }
    if (grid < 0) return;
    if (hipMemsetAsync((char*)d_ws + WS_CTL, 0, CTL_ZERO_BYTES, stream) != hipSuccess) { fprintf(stderr, "kernel_launch: memset failed\n"); return; }
    Args a{};
    for (int i = 0; i < 30; ++i) a.in[i] = (const float*)d_in[i];
    a.out = (float*)d_out; a.ws = (unsigned char*)d_ws;
#if MK_N_LAUNCHES == 1
    a.ph_lo = 0; a.ph_hi = N_PHASES;
    hipLaunchKernelGGL(mk_fwd, dim3(grid), dim3(NWAVES * 64), LDS_BYTES, stream, a);
#else
    for (int p = 0; p < N_PHASES; ++p) { a.ph_lo = p; a.ph_hi = p + 1; hipLaunchKernelGGL(mk_fwd, dim3(grid), dim3(NWAVES * 64), LDS_BYTES, stream, a); }
#endif
    const hipError_t le = hipPeekAtLastError();
    if (le != hipSuccess) fprintf(stderr, "kernel_launch: launch failed: %s\n", hipGetErrorName(le));
}
```

```cpp
#include <hip/hip_runtime.h>
#include <cstdio>
#include <cstdint>
namespace pg8 {
#define PG8_LAS __attribute__((address_space(3)))
typedef unsigned short bf16_t;
typedef short bf16x8 __attribute__((ext_vector_type(8)));
typedef float f32x4 __attribute__((ext_vector_type(4)));
typedef unsigned u32x4 __attribute__((ext_vector_type(4)));
constexpr int BM = 256, BK = 64, HALF = 128, HTB = HALF * BK * 2  , STAGE_BYTES = 8 * HTB, NXCD = 8, WGM = 8;

__host__ __device__ __forceinline__ int lds_byte(int r, int c) { const int st = (r >> 4) * 2 + (c >> 5), rr = r & 15, cc = c & 31, ob = rr * 64 + cc * 2; return st * 1024 + (ob ^ (((ob >> 9) & 1) << 5)); }
__host__ __device__ __forceinline__ void stage_rc(int b, int& R, int& C) { const int st = b / 1024, sb = b % 1024, swz = sb ^ (((sb >> 9) & 1) << 5); R = (st >> 1) * 16 + swz / 64; C = (st & 1) * 32 + (swz % 64) / 2; }
__host__ __device__ __forceinline__ int perm32(int rho) { const int n = rho >> 4, i = rho & 15; return 8 * (i >> 2) + 4 * n + (i & 3); }

struct Unit { int pm, pn; };
struct Gemm { const bf16_t* A; const bf16_t* Bt; int M, N, K; };

struct StaticOrder {
    int nM, nN, nwg, G, c;
    __host__ __device__ void init(int M, int N, int G_, int c_) { nM = M / BM; nN = N / BM; nwg = nM * nN; G = G_; c = c_; }
    __host__ __device__ bool next(int i, Unit& u) const {
        const long L = (long)i * G + c; if (L >= nwg) return false;
        int wgid = (int)L; { const int q = nwg / NXCD, r = nwg % NXCD, xcd = wgid % NXCD, off = wgid / NXCD; wgid = (xcd < r ? xcd * (q + 1) : r * (q + 1) + (xcd - r) * q) + off; }
        const int nig = WGM * nN, gid = wgid / nig, fm = gid * WGM, gsz = (nM - fm) < WGM ? (nM - fm) : WGM;
        u.pm = fm + ((wgid % nig) % gsz); u.pn = (wgid % nig) / gsz; return true;
    }
    __device__ __forceinline__ void a_ready(const Unit&) const {}
    __device__ __forceinline__ void done(const Unit&) const {}
};

__device__ __forceinline__ unsigned cvt_pk_bf16(float lo, float hi) { unsigned r; asm volatile("v_cvt_pk_bf16_f32 %0, %1, %2" : "=v"(r) : "v"(lo), "v"(hi)); return r; }
typedef float f32x2 __attribute__((ext_vector_type(2)));
template <class Epi, class Sched, bool ALIGN_EPI = false, bool SP2 = false>
__device__ __forceinline__ void gemm_phase(PG8_LAS unsigned char* lds, const Gemm g, const Sched& S, const Epi& E) {
    const int tid = threadIdx.x, wid = __builtin_amdgcn_readfirstlane(tid >> 6), lane = tid & 63, wr = wid >> 2, wc = wid & 3, fr = lane & 15, fq = lane >> 4;
    const int K = g.K, nt = K / BK;
    unsigned voffA[2], voffB[2];
#pragma unroll
    for (int i = 0; i < 2; ++i) { int R, C; stage_rc(tid * 16 + i * 8192, R, C); const int Rb = Epi::PERM ? ((R & ~31) + perm32(R & 31)) : R;
        voffA[i] = (unsigned)(R * K + C) * 2u; voffB[i] = (unsigned)(Rb * K + C) * 2u; }
    const size_t kstep = (size_t)(BK * 2);
    const size_t hstep = (size_t)HALF * K * 2;
    const size_t tstep = 2 * hstep;
    const unsigned ldsw = (unsigned)wid * 1024u;
    const int aoff = lds_byte(wr * 64 + fr, fq * 8), boff = lds_byte(wc * 32 + fr, fq * 8);
#define PG8_SA(b, h) (((b) * 2 + (h)) * HTB)
#define PG8_SB(b, h) ((4 + (b) * 2 + (h)) * HTB)
#define PG8_STAGE(bufoff, gbase, voff) do { _Pragma("unroll") for (int _i = 0; _i < 2; ++_i) \
        __builtin_amdgcn_global_load_lds((const unsigned*)((const char*)(gbase) + (voff)[_i]), (PG8_LAS unsigned*)(lds + (bufoff) + ldsw + _i * 8192), 16, 0, 0); } while (0)
#define PG8_LDA(dst, b, h) do { _Pragma("unroll") for (int m = 0; m < 4; ++m) _Pragma("unroll") for (int k = 0; k < 2; ++k) dst[m][k] = *(const PG8_LAS bf16x8*)(lds + PG8_SA(b, h) + aoff + m * 2048 + k * 1024); } while (0)
#define PG8_LDB(dst, b, h) do { _Pragma("unroll") for (int n = 0; n < 2; ++n) _Pragma("unroll") for (int k = 0; k < 2; ++k) dst[n][k] = *(const PG8_LAS bf16x8*)(lds + PG8_SB(b, h) + boff + n * 2048 + k * 1024); } while (0)
#define PG8_MMA(ai, bj, At, Bt) do { __builtin_amdgcn_s_setprio(1); _Pragma("unroll") for (int m = 0; m < 4; ++m) _Pragma("unroll") for (int n = 0; n < 2; ++n) _Pragma("unroll") for (int k = 0; k < 2; ++k) \
        acc[ai][bj][m][n] = __builtin_amdgcn_mfma_f32_16x16x32_bf16(Bt[n][k], At[m][k], acc[ai][bj][m][n], 0, 0, 0); __builtin_amdgcn_s_setprio(0); } while (0)
#define PG8_WAIT_V(n) asm volatile("s_waitcnt vmcnt(" #n ")" ::: "memory")
#define PG8_WAIT_L(n) asm volatile("s_waitcnt lgkmcnt(" #n ")" ::: "memory")
#define PG8_BAR __builtin_amdgcn_s_barrier()
#define PG8_SCHED __builtin_amdgcn_sched_barrier(0)
    Unit cur, nxt; int ui = 0;
    if (!S.next(0, cur)) return;
    f32x4 acc[2][2][4][2];
#pragma unroll
    for (int a = 0; a < 2; ++a)
#pragma unroll
        for (int b = 0; b < 2; ++b)
#pragma unroll
            for (int m = 0; m < 4; ++m)
#pragma unroll
                for (int n = 0; n < 2; ++n) acc[a][b][m][n] = (f32x4){0.f, 0.f, 0.f, 0.f};
    bf16x8 At[4][2], B0[2][2], B1[2][2];
    const char* cA = (const char*)g.A + (size_t)cur.pm * tstep; const char* cB = (const char*)g.Bt + (size_t)cur.pn * tstep;
    S.a_ready(cur);
    if constexpr (SP2) {
        PG8_STAGE(PG8_SB(0, 0), cB, voffB); PG8_STAGE(PG8_SB(0, 1), cB + hstep, voffB); PG8_STAGE(PG8_SA(0, 0), cA, voffA); PG8_STAGE(PG8_SA(0, 1), cA + hstep, voffA);
        if (wr == 1) PG8_BAR;
        PG8_WAIT_V(2); PG8_BAR;
        PG8_STAGE(PG8_SB(1, 0), cB + kstep, voffB); PG8_STAGE(PG8_SA(1, 0), cA + kstep, voffA); PG8_STAGE(PG8_SB(1, 1), cB + hstep + kstep, voffB);
        PG8_WAIT_V(6); PG8_BAR;
    } else {
        PG8_STAGE(PG8_SB(0, 0), cB, voffB); PG8_STAGE(PG8_SA(0, 0), cA, voffA); PG8_STAGE(PG8_SB(0, 1), cB + hstep, voffB); PG8_STAGE(PG8_SA(0, 1), cA + hstep, voffA);
        if (wr == 1) PG8_BAR;
        PG8_WAIT_V(4); PG8_BAR;
        PG8_STAGE(PG8_SB(1, 0), cB + kstep, voffB); PG8_STAGE(PG8_SA(1, 0), cA + kstep, voffA); PG8_STAGE(PG8_SB(1, 1), cB + hstep + kstep, voffB);
        PG8_WAIT_V(6); PG8_BAR;
    }
    for (;;) {
        const bool has_next = S.next(ui + 1, nxt);
        const char* nA = has_next ? (const char*)g.A + (size_t)nxt.pm * tstep : cA; const char* nB = has_next ? (const char*)g.Bt + (size_t)nxt.pn * tstep : cB;
        for (int t = 0; t < nt; t += 2) {
            const bool last = (t == nt - 2);
            const char* a1 = cA + (size_t)(t + 1) * kstep;
            const char* a2 = last ? nA : cA + (size_t)(t + 2) * kstep; const char* b2 = last ? nB : cB + (size_t)(t + 2) * kstep;
            const char* a3 = a2 + kstep; const char* b3 = b2 + kstep;
            if (last && has_next) S.a_ready(nxt);
            if constexpr (SP2) {
            PG8_LDB(B0, 0, 0); PG8_LDB(B1, 0, 1); PG8_SCHED; PG8_LDA(At, 0, 0); PG8_STAGE(PG8_SA(1, 1), a1 + hstep, voffA);
            PG8_WAIT_V(8); PG8_WAIT_L(0); PG8_BAR; PG8_MMA(0, 0, At, B0); PG8_MMA(0, 1, At, B1); PG8_BAR; PG8_SCHED;
            PG8_LDA(At, 0, 1); PG8_STAGE(PG8_SB(0, 0), b2, voffB); PG8_STAGE(PG8_SB(0, 1), b2 + hstep, voffB); PG8_STAGE(PG8_SA(0, 0), a2, voffA);
            PG8_WAIT_V(8); PG8_WAIT_L(0); PG8_BAR; PG8_MMA(1, 0, At, B0); PG8_MMA(1, 1, At, B1); PG8_BAR; PG8_SCHED;
            PG8_LDB(B0, 1, 0); PG8_LDB(B1, 1, 1); PG8_SCHED; PG8_LDA(At, 1, 0); PG8_STAGE(PG8_SA(0, 1), a2 + hstep, voffA);
            PG8_WAIT_V(8); PG8_WAIT_L(0); PG8_BAR; PG8_MMA(0, 0, At, B0); PG8_MMA(0, 1, At, B1); PG8_BAR; PG8_SCHED;
            PG8_LDA(At, 1, 1); PG8_STAGE(PG8_SB(1, 0), b3, voffB); PG8_STAGE(PG8_SB(1, 1), b3 + hstep, voffB); PG8_STAGE(PG8_SA(1, 0), a3, voffA);
            PG8_WAIT_V(8); PG8_WAIT_L(0); PG8_BAR; PG8_MMA(1, 0, At, B0); PG8_MMA(1, 1, At, B1); PG8_BAR; PG8_SCHED;
            } else {
            PG8_LDB(B0, 0, 0); PG8_SCHED; PG8_LDA(At, 0, 0); PG8_STAGE(PG8_SA(1, 1), a1 + hstep, voffA);
            PG8_WAIT_L(8); PG8_BAR; PG8_WAIT_L(0); PG8_MMA(0, 0, At, B0); PG8_BAR; PG8_SCHED;
            PG8_LDB(B1, 0, 1); PG8_STAGE(PG8_SB(0, 0), b2, voffB);
            PG8_BAR; PG8_WAIT_L(0); PG8_MMA(0, 1, At, B1); PG8_BAR;
            PG8_LDA(At, 0, 1); PG8_STAGE(PG8_SA(0, 0), a2, voffA);
            PG8_BAR; PG8_WAIT_L(0); PG8_MMA(1, 0, At, B0); PG8_BAR; PG8_SCHED;
            PG8_STAGE(PG8_SB(0, 1), b2 + hstep, voffB);
            PG8_WAIT_V(6); PG8_BAR; PG8_MMA(1, 1, At, B1); PG8_BAR;
            PG8_LDB(B0, 1, 0); PG8_SCHED; PG8_LDA(At, 1, 0); PG8_STAGE(PG8_SA(0, 1), a2 + hstep, voffA);
            PG8_WAIT_L(8); PG8_BAR; PG8_WAIT_L(0); PG8_MMA(0, 0, At, B0); PG8_BAR; PG8_SCHED;
            PG8_LDB(B1, 1, 1); PG8_STAGE(PG8_SB(1, 0), b3, voffB);
            PG8_BAR; PG8_WAIT_L(0); PG8_MMA(0, 1, At, B1); PG8_BAR;
            PG8_LDA(At, 1, 1); PG8_STAGE(PG8_SA(1, 0), a3, voffA);
            PG8_BAR; PG8_WAIT_L(0); PG8_MMA(1, 0, At, B0); PG8_BAR; PG8_SCHED;
            PG8_STAGE(PG8_SB(1, 1), b3 + hstep, voffB);
            PG8_WAIT_V(6); PG8_BAR; PG8_MMA(1, 1, At, B1); PG8_BAR;
            }
        }
        if constexpr (ALIGN_EPI) { if (wr == 0) PG8_BAR; }
        if constexpr (!Epi::AFTER_DRAIN) { E(acc, cur, wr, wc, fr, fq); S.done(cur); }
        if (!has_next) break;
#pragma unroll
        for (int a = 0; a < 2; ++a)
#pragma unroll
            for (int b = 0; b < 2; ++b)
#pragma unroll
                for (int m = 0; m < 4; ++m)
#pragma unroll
                    for (int n = 0; n < 2; ++n) acc[a][b][m][n] = (f32x4){0.f, 0.f, 0.f, 0.f};
        cur = nxt; cA = nA; cB = nB; ++ui;
        if constexpr (ALIGN_EPI) { if (wr == 1) PG8_BAR; }
    }
    PG8_WAIT_V(0);
    if constexpr (!ALIGN_EPI) { if (wr == 0) PG8_BAR; }
    PG8_BAR;
    if constexpr (Epi::AFTER_DRAIN) { E.fused(acc, cur, wr, wc, fr, fq, lds, wid, lane); S.done(cur); }
#undef PG8_SA
#undef PG8_SB
#undef PG8_STAGE
#undef PG8_LDA
#undef PG8_LDB
#undef PG8_MMA
#undef PG8_WAIT_V
#undef PG8_WAIT_L
#undef PG8_BAR
#undef PG8_SCHED
}
}

#ifndef PG8_SP2
#define PG8_SP2 true
#endif
#ifndef PG8_ALIGN
#define PG8_ALIGN true
#endif
#ifndef MK_N_LAUNCHES
#define MK_N_LAUNCHES 1
#endif

constexpr int D = 1024, BP = 8, SEQ = 2048, MPR = BP * SEQ  , MS = 128  , MT = MPR + MS  ;
constexpr int NCOND = BP + MS;
constexpr int DFF = 2816, NMOD = 6 * D  , NMODALL = 4 * NMOD  ;
constexpr int RET_IN = 6144, SSD_IN = 5152, SSD_INM = 5120, HG_IN = 4096, FFN_IN = 2 * DFF;
constexpr float EPS = 1e-6f;
constexpr int NWAVES = 8;

constexpr size_t MiB = 1u << 20;
constexpr size_t WS_CTL = 0, CTL_ZERO_BYTES = 1 * MiB;
constexpr size_t WS_WADA = 1 * MiB;
constexpr size_t WS_WRETIN = WS_WADA + 48 * MiB;
constexpr size_t WS_WRETOUT = WS_WRETIN + 24 * MiB;
constexpr size_t WS_WSSDIN = WS_WRETOUT + 8 * MiB;
constexpr size_t WS_WSSDOUT = WS_WSSDIN + 11 * MiB;
constexpr size_t WS_WHGIN = WS_WSSDOUT + 4 * MiB;
constexpr size_t WS_WHGOUT = WS_WHGIN + 8 * MiB;
constexpr size_t WS_WFFNIN = WS_WHGOUT + 2 * MiB;
constexpr size_t WS_WFFNOUT = WS_WFFNIN + 44 * MiB;
constexpr size_t WS_MOD = WS_WFFNOUT + 22 * MiB;
constexpr size_t WS_CACT = WS_MOD + 24 * MiB;
constexpr size_t WS_LB = WS_CACT + 512 * 1024;
constexpr size_t WS_H = WS_CACT + 1 * MiB;
constexpr size_t WS_PROJ = WS_H + 33 * MiB;
constexpr size_t WS_RO = WS_PROJ + 200 * MiB;
constexpr size_t WS_GO = WS_RO + 65 * MiB;
constexpr size_t WS_OUT = WS_GO + 65 * MiB;
constexpr size_t WS_ACT = WS_OUT + 33 * MiB;
constexpr size_t WS_END = WS_ACT + 89 * MiB;
constexpr size_t PJ_RET_Q = 0, PJ_RET_K = PJ_RET_Q + (size_t)MT * 1024 * 2, PJ_RET_V = PJ_RET_K + (size_t)MT * 1024 * 2, PJ_RET_SG = PJ_RET_V + (size_t)MT * 2048 * 2;
constexpr size_t PJ_SSD_SZ = 0, PJ_SSD_XBC = PJ_SSD_SZ + (size_t)MT * 2048 * 2, PJ_SSD_DT = PJ_SSD_XBC + (size_t)MT * 3072 * 2;
constexpr size_t PJ_HG_Q = 0, PJ_HG_LA = PJ_HG_Q + (size_t)MT * 1024 * 2, PJ_HG_V = PJ_HG_LA + (size_t)MT * 1024 * 4, PJ_HG_SG = PJ_HG_V + (size_t)MT * 1024 * 2;
static_assert(PJ_RET_SG + (size_t)MT * 2048 * 2 <= 200 * MiB && PJ_SSD_DT + (size_t)MT * 32 * 4 <= 200 * MiB && PJ_HG_SG + (size_t)MT * 1024 * 2 <= 200 * MiB, "proj map");
constexpr int CW_BAR = 4096;

constexpr size_t O_Y = 0;
constexpr size_t O_RETP = (size_t)MT * D;
constexpr size_t O_RETS = O_RETP + (size_t)2 * 8 * 4 * 256 * 512;
constexpr size_t O_SSDP = O_RETS + (size_t)2 * 128 * 4 * 256 * 512;
constexpr size_t O_SSDS = O_SSDP + (size_t)8 * 32 * 128 * 64;
constexpr size_t O_CONVP = O_SSDS + (size_t)128 * 32 * 128 * 64;
constexpr size_t O_CONVS = O_CONVP + (size_t)8 * 3 * 3072;
constexpr size_t O_HGP = O_CONVS + (size_t)128 * 3 * 3072;
constexpr size_t O_HGS = O_HGP + (size_t)8 * 8 * 128 * 128;
constexpr size_t O_END = O_HGS + (size_t)128 * 8 * 128 * 128;
static_assert(O_END == 214245376ull, "output size");

constexpr int LDS_BYTES = 147456;
constexpr int LDSCTL_OFF = LDS_BYTES - 1024;
constexpr int SCR_BYTES = LDSCTL_OFF;

#define GAS __attribute__((address_space(1)))
#define LAS __attribute__((address_space(3)))
typedef unsigned short bf16;
typedef unsigned v4u __attribute__((ext_vector_type(4)));
typedef unsigned v2u __attribute__((ext_vector_type(2)));
typedef float f32x4 __attribute__((ext_vector_type(4)));
typedef short bf16x8 __attribute__((ext_vector_type(8)));
typedef short s16x4 __attribute__((ext_vector_type(4)));
typedef GAS unsigned gu32;
#define RLX_AGENT __ATOMIC_RELAXED, __HIP_MEMORY_SCOPE_AGENT
#define LDS_WAIT() asm volatile("s_waitcnt lgkmcnt(0)" ::: "memory")
#define VM_WAIT() asm volatile("s_waitcnt vmcnt(0)" ::: "memory")
typedef float f32x2_t __attribute__((ext_vector_type(2))); typedef __bf16 bf16x2_t __attribute__((ext_vector_type(2)));
__device__ __forceinline__ unsigned cvt_pk_bf16(float lo, float hi) { f32x2_t v = {lo, hi}; bf16x2_t b = __builtin_convertvector(v, bf16x2_t); return __builtin_bit_cast(unsigned, b); }
__device__ __forceinline__ float bf2f(unsigned b) { return __uint_as_float(b << 16); }
__device__ __forceinline__ float bflo(unsigned w) { return __uint_as_float(w << 16); }
__device__ __forceinline__ float bfhi(unsigned w) { return __uint_as_float(w & 0xffff0000u); }
__device__ __forceinline__ void unpack8(const v4u w, float (&f)[8]) { f[0] = bflo(w.x); f[1] = bfhi(w.x); f[2] = bflo(w.y); f[3] = bfhi(w.y); f[4] = bflo(w.z); f[5] = bfhi(w.z); f[6] = bflo(w.w); f[7] = bfhi(w.w); }
__device__ __forceinline__ v4u pack8(const float (&f)[8]) { v4u w; w.x = cvt_pk_bf16(f[0], f[1]); w.y = cvt_pk_bf16(f[2], f[3]); w.z = cvt_pk_bf16(f[4], f[5]); w.w = cvt_pk_bf16(f[6], f[7]); return w; }
__device__ __forceinline__ v4u pack8v(const f32x4 a, const f32x4 b) { v4u w; w.x = cvt_pk_bf16(a[0], a[1]); w.y = cvt_pk_bf16(a[2], a[3]); w.z = cvt_pk_bf16(b[0], b[1]); w.w = cvt_pk_bf16(b[2], b[3]); return w; }
__device__ __forceinline__ v2u pack4v(const f32x4 a) { v2u w; w.x = cvt_pk_bf16(a[0], a[1]); w.y = cvt_pk_bf16(a[2], a[3]); return w; }
__device__ __forceinline__ float sigmoidf_(float x) { return __builtin_amdgcn_rcpf(1.f + __expf(-x)); }
__device__ __forceinline__ float siluf_(float x) { return x * sigmoidf_(x); }
__device__ __forceinline__ float softplusf_(float x) { return x > 20.f ? x : log1pf(__expf(x)); }
__device__ __forceinline__ float wave_sum(float v) {
#pragma unroll
    for (int o = 1; o < 64; o <<= 1) v += __shfl_xor(v, o);
    return v;
}
__device__ __forceinline__ float grp16_sum(float v) {
#pragma unroll
    for (int o = 1; o < 16; o <<= 1) v += __shfl_xor(v, o);
    return v;
}
#define MFMA16(a, b, c) __builtin_amdgcn_mfma_f32_16x16x32_bf16((a), (b), (c), 0, 0, 0)
#define XB_TMO      128
#define XB_XCNT(j)  (256  + 64 * (j))
#define XB_XSUB(j)  (1280 + 64 * (j))
#define XB_XGEN(j)  (2304 + 64 * (j))
#define XB_TOP      3328
#define XB_TOPGEN   3392
#define XCD_BAR_WORDS 3456
#define XB_SPIN_CAP (1u << 18)

__device__ __forceinline__ unsigned xb_ld(unsigned* p)              { return __hip_atomic_load(p, __ATOMIC_RELAXED, __HIP_MEMORY_SCOPE_AGENT); }
__device__ __forceinline__ unsigned xb_add(unsigned* p, unsigned v) { return __hip_atomic_fetch_add(p, v, __ATOMIC_RELAXED, __HIP_MEMORY_SCOPE_AGENT); }
__device__ __forceinline__ unsigned xb_xcc_id() { return (unsigned)__builtin_amdgcn_s_getreg((3 << 11) | 20) & 0xFu; }
#define XB_SPIN(cond, bar) do { unsigned _sp = 0; while (cond) { __builtin_amdgcn_s_sleep(1); \
    if ((++_sp & 255u) == 0u) { if (xb_ld(&(bar)[XB_TMO])) break; if (_sp > XB_SPIN_CAP) { atomicAdd(&(bar)[XB_TMO], 1u); break; } } } } while (0)

struct XcdBarrier {
    unsigned* bar; unsigned x;
    volatile LAS unsigned* st;
};

__device__ __forceinline__ XcdBarrier xcd_barrier_post(unsigned* bar, volatile LAS unsigned* st) {
    XcdBarrier b; b.bar = bar; b.x = xb_xcc_id(); b.st = st;
    if (threadIdx.x == 0) (void)xb_add(&bar[XB_XCNT(b.x)], 1u);
    return b;
}
__device__ __forceinline__ void xcd_barrier_complete(unsigned* bar, unsigned x, unsigned& nloc, unsigned& nx) {
    const unsigned G = gridDim.x * gridDim.y * gridDim.z;
    unsigned sum, cnt, mine, sp = 0u;
    for (;;) {
        sum = 0u; cnt = 0u; mine = 0u;
#pragma unroll
        for (unsigned j = 0; j < 16; ++j) { const unsigned c = xb_ld(&bar[XB_XCNT(j)]); sum += c; cnt += (c > 0u) ? 1u : 0u; mine = (j == x) ? c : mine; }
        if (sum == G) break;
        __builtin_amdgcn_s_sleep(1);
        if ((++sp & 255u) == 0u) { if (xb_ld(&bar[XB_TMO])) break; if (sp > XB_SPIN_CAP) { atomicAdd(&bar[XB_TMO], 1u); break; } }
    }
    nloc = mine > 0u ? mine : 1u; nx = cnt > 0u ? cnt : 1u;
}

__device__ __forceinline__ void xcd_barrier(const XcdBarrier& b) {
    asm volatile("s_waitcnt vmcnt(0)" ::: "memory");
    __syncthreads();
    if (threadIdx.x == 0) {
        unsigned* bar = b.bar;
        __builtin_amdgcn_s_waitcnt(0);
        unsigned nloc = b.st[0], nx = b.st[1];
        if (nloc == 0u) { xcd_barrier_complete(bar, b.x, nloc, nx); b.st[0] = nloc; b.st[1] = nx; }
        const unsigned old = xb_add(&bar[XB_XSUB(b.x)], 1u);
        const unsigned gen = old / nloc;
        if (old + 1u == (gen + 1u) * nloc) {
            __builtin_amdgcn_fence(__ATOMIC_RELEASE, "agent");
            asm volatile("s_waitcnt vmcnt(0)" ::: "memory");
            const unsigned og = xb_add(&bar[XB_TOP], 1u);
            const unsigned tg = og / nx;
            if (og + 1u == (tg + 1u) * nx) xb_add(&bar[XB_TOPGEN], 1u);
            else XB_SPIN(xb_ld(&bar[XB_TOPGEN]) == tg, bar);
            __builtin_amdgcn_fence(__ATOMIC_ACQUIRE, "agent");
            xb_add(&bar[XB_XGEN(b.x)], 1u);
            asm volatile("s_waitcnt vmcnt(0)" ::: "memory");
        } else {
            XB_SPIN(xb_ld(&bar[XB_XGEN(b.x)]) == gen, bar);
            __builtin_amdgcn_fence(__ATOMIC_ACQUIRE, "agent");
            asm volatile("s_waitcnt vmcnt(0)" ::: "memory");
        }
    }
    __syncthreads();
}


struct Frame {
    LAS unsigned char* lds;
    int tid, lane, wave;
    int vcu, G;
};

template <class Fn> struct EpiGen {
    static constexpr bool PERM = true, AFTER_DRAIN = false;
    Fn f;
    __device__ __forceinline__ void operator()(const pg8::f32x4 (&acc)[2][2][4][2], const pg8::Unit& u, int wr, int wc, int fr, int fq) const {
        const int ca = u.pn * 256 + wc * 32 + 8 * fq;
#pragma unroll
        for (int ai = 0; ai < 2; ++ai)
#pragma unroll
            for (int m = 0; m < 4; ++m) {
                const int row = u.pm * 256 + ai * 128 + wr * 64 + m * 16 + fr;
                f.emit(row, ca, ca + 128, acc[ai][0][m][0], acc[ai][0][m][1], acc[ai][1][m][0], acc[ai][1][m][1]);
            }
    }
};
__device__ __forceinline__ void st8bf(bf16* p, const f32x4 a, const f32x4 b) { *(GAS v4u*)p = pack8v(a, b); }
__device__ __forceinline__ f32x4 silu4(const f32x4 a) { f32x4 r; r[0] = siluf_(a[0]); r[1] = siluf_(a[1]); r[2] = siluf_(a[2]); r[3] = siluf_(a[3]); return r; }

struct EmitRetIn {
    bf16 *Q, *K, *V, *SG;
    __device__ __forceinline__ void emit(int row, int ca, int cb, const f32x4 a0, const f32x4 a1, const f32x4 b0, const f32x4 b1) const {
        const int pn = ca >> 8, ch = ca & 255;
        if (pn < 8) {
            const float pos = row < MPR ? (float)(row & (SEQ - 1)) : 16384.f;
            const float sc = pn < 4 ? 1.f : 0.0625f;
            float x1[8] = {a0[0], a0[1], a0[2], a0[3], a1[0], a1[1], a1[2], a1[3]}, x2[8] = {b0[0], b0[1], b0[2], b0[3], b1[0], b1[1], b1[2], b1[3]}, o1[8], o2[8];
#pragma unroll
            for (int e = 0; e < 8; ++e) {
                const float inv = exp2f(-(float)(ch + e) * (13.287712379549449f / 128.f));
                float t = pos * inv * 0.15915494309189535f; t -= floorf(t);
                const float s = __builtin_amdgcn_sinf(t), c = __builtin_amdgcn_cosf(t);
                o1[e] = (x1[e] * c - x2[e] * s) * sc; o2[e] = (x2[e] * c + x1[e] * s) * sc;
            }
            bf16* dst = (pn < 4 ? Q : K) + (size_t)row * 1024 + (pn & 3) * 256 + ch;
            *(GAS v4u*)dst = pack8(o1); *(GAS v4u*)(dst + 128) = pack8(o2);
        } else if (pn < 16) {
            bf16* dst = V + (size_t)row * 2048 + (pn - 8) * 256 + ch; st8bf(dst, a0, a1); st8bf(dst + 128, b0, b1);
        } else {
            bf16* dst = SG + (size_t)row * 2048 + (pn - 16) * 256 + ch; st8bf(dst, silu4(a0), silu4(a1)); st8bf(dst + 128, silu4(b0), silu4(b1));
        }
    }
};
struct EmitSsdIn {
    bf16 *SZ, *XBC;
    __device__ __forceinline__ void emit(int row, int ca, int cb, const f32x4 a0, const f32x4 a1, const f32x4 b0, const f32x4 b1) const {
        const int pn = ca >> 8, ch = ca & 255;
        if (pn < 8) { bf16* dst = SZ + (size_t)row * 2048 + pn * 256 + ch; st8bf(dst, silu4(a0), silu4(a1)); st8bf(dst + 128, silu4(b0), silu4(b1)); }
        else { bf16* dst = XBC + (size_t)row * 3072 + (pn - 8) * 256 + ch; st8bf(dst, a0, a1); st8bf(dst + 128, b0, b1); }
    }
};
struct EmitDt {
    float* DT;
    __device__ __forceinline__ void emit(int row, int ca, int cb, const f32x4 a0, const f32x4 a1, const f32x4 b0, const f32x4 b1) const {
        float* d = DT + (size_t)row * 32; *(GAS f32x4*)(d + (ca - SSD_INM)) = a0; *(GAS f32x4*)(d + (ca - SSD_INM) + 4) = a1; *(GAS f32x4*)(d + (cb - SSD_INM)) = b0; *(GAS f32x4*)(d + (cb - SSD_INM) + 4) = b1;
    }
};
struct EmitHgIn {
    bf16 *HQ, *HV, *HSG; float* LA; const float* lb;
    __device__ __forceinline__ f32x4 logf4(const f32x4 x, const float* l) const { f32x4 r;
#pragma unroll
        for (int e = 0; e < 4; ++e) { const float b = l[e]; r[e] = logf(b + (1.f - b) * sigmoidf_(x[e])); } return r; }
    __device__ __forceinline__ void emit(int row, int ca, int cb, const f32x4 a0, const f32x4 a1, const f32x4 b0, const f32x4 b1) const {
        const int pn = ca >> 8, ch = ca & 255;
        if (pn < 4) { bf16* dst = HQ + (size_t)row * 1024 + pn * 256 + ch; const float s = 0.08838834764831845f; st8bf(dst, silu4(a0) * s, silu4(a1) * s); st8bf(dst + 128, silu4(b0) * s, silu4(b1) * s); }
        else if (pn < 8) { const int col = (pn - 4) * 256 + ch; float* dst = LA + (size_t)row * 1024 + col;
            *(GAS f32x4*)dst = logf4(a0, lb + col); *(GAS f32x4*)(dst + 4) = logf4(a1, lb + col + 4); *(GAS f32x4*)(dst + 128) = logf4(b0, lb + col + 128); *(GAS f32x4*)(dst + 132) = logf4(b1, lb + col + 132); }
        else if (pn < 12) { bf16* dst = HV + (size_t)row * 1024 + (pn - 8) * 256 + ch; st8bf(dst, a0, a1); st8bf(dst + 128, b0, b1); }
        else { bf16* dst = HSG + (size_t)row * 1024 + (pn - 12) * 256 + ch; st8bf(dst, silu4(a0), silu4(a1)); st8bf(dst + 128, silu4(b0), silu4(b1)); }
    }
};
struct EmitOut {
    bf16* OUT;
    __device__ __forceinline__ void emit(int row, int ca, int cb, const f32x4 a0, const f32x4 a1, const f32x4 b0, const f32x4 b1) const {
        bf16* dst = OUT + (size_t)row * 1024; st8bf(dst + ca, a0, a1); st8bf(dst + cb, b0, b1);
    }
};
struct EmitFfnIn {
    bf16* ACT;
    __device__ __forceinline__ void emit(int row, int ca, int cb, const f32x4 a0, const f32x4 a1, const f32x4 b0, const f32x4 b1) const {
        bf16* dst = ACT + (size_t)row * DFF + (ca >> 8) * 128 + (ca & 255); st8bf(dst, silu4(a0) * b0, silu4(a1) * b1);
    }
};
struct EmitMod {
    float* MOD; const float* bias;
    __device__ __forceinline__ void emit(int row, int ca, int cb, const f32x4 a0, const f32x4 a1, const f32x4 b0, const f32x4 b1) const {
        float* d = MOD + (size_t)row * NMODALL;
        *(GAS f32x4*)(d + ca) = a0 + *(const GAS f32x4*)(bias + ca); *(GAS f32x4*)(d + ca + 4) = a1 + *(const GAS f32x4*)(bias + ca + 4);
        *(GAS f32x4*)(d + cb) = b0 + *(const GAS f32x4*)(bias + cb); *(GAS f32x4*)(d + cb + 4) = b1 + *(const GAS f32x4*)(bias + cb + 4);
    }
};

template <int NMT, class Fn>
__device__ __forceinline__ void skinny_gemm(Frame& F, const bf16* A, int K, int nrg, int nrows, int rowbase, const bf16* Bt, int ncu, bool dtmode, const Fn& f, int wg0, int span) {
    const int w = F.wave, lane = F.lane, fr = lane & 15, fq = lane >> 4, KW = K >> 3, nsteps = KW >> 5;
    constexpr int R = NMT * 16;
    LAS unsigned char* red = F.lds;
    const int nun = nrg * ncu, me = (int)blockIdx.x - wg0;
    if (me >= 0 && me < span) {
    for (int u = me; u < nun; u += span) {
        const int rg = u / ncu, cu = u - rg * ncu;
        int ca, cb; if (dtmode) { ca = SSD_INM; cb = SSD_INM + 16; } else { ca = 256 * (cu >> 3) + 16 * (cu & 7); cb = ca + 128; }
        int nact = (nrows - rg * R + 15) >> 4; nact = nact > NMT ? NMT : nact;
        const bf16* ap = A + (size_t)(rg * R + fr) * K + w * KW + fq * 8;
        const bf16* bpa = Bt + (size_t)(ca + fr) * K + w * KW + fq * 8;
        const bf16* bpb = Bt + (size_t)(cb + fr) * K + w * KW + fq * 8;
        f32x4 acc[NMT][2];
#pragma unroll
        for (int mt = 0; mt < NMT; ++mt) { acc[mt][0] = (f32x4){0.f, 0.f, 0.f, 0.f}; acc[mt][1] = (f32x4){0.f, 0.f, 0.f, 0.f}; }
        bf16x8 ca_[NMT], cb0, cb1, na_[NMT], nb0, nb1;
        cb0 = *(const GAS bf16x8*)(bpa); cb1 = *(const GAS bf16x8*)(bpb);
#pragma unroll
        for (int mt = 0; mt < NMT; ++mt) { ca_[mt] = (bf16x8){0, 0, 0, 0, 0, 0, 0, 0}; if (mt < nact) ca_[mt] = *(const GAS bf16x8*)(ap + (size_t)mt * 16 * K); }
#pragma unroll 2
        for (int s = 0; s < nsteps; ++s) {
            const int k1 = (s + 1 < nsteps ? s + 1 : s) * 32;
            nb0 = *(const GAS bf16x8*)(bpa + k1); nb1 = *(const GAS bf16x8*)(bpb + k1);
#pragma unroll
            for (int mt = 0; mt < NMT; ++mt) { na_[mt] = ca_[mt]; if (mt < nact) na_[mt] = *(const GAS bf16x8*)(ap + (size_t)mt * 16 * K + k1); }
#pragma unroll
            for (int mt = 0; mt < NMT; ++mt) if (mt < nact) { acc[mt][0] = MFMA16(cb0, ca_[mt], acc[mt][0]); acc[mt][1] = MFMA16(cb1, ca_[mt], acc[mt][1]); }
            cb0 = nb0; cb1 = nb1;
#pragma unroll
            for (int mt = 0; mt < NMT; ++mt) ca_[mt] = na_[mt];
        }
        __syncthreads();
#pragma unroll
        for (int mt = 0; mt < NMT; ++mt)
#pragma unroll
            for (int nt = 0; nt < 2; ++nt) { const int row = mt * 16 + fr; *(LAS f32x4*)(red + ((w * R + row) * 8 + ((4 * nt + fq) ^ (row & 7))) * 16) = acc[mt][nt]; }
        __syncthreads();
        if (F.tid < 2 * R) {
            const int row = F.tid >> 1, hf = F.tid & 1;
            f32x4 va0 = (f32x4){0.f, 0.f, 0.f, 0.f}, va1 = va0, vb0 = va0, vb1 = va0;
#pragma unroll
            for (int ww = 0; ww < 8; ++ww) { const LAS unsigned char* pr = red + (ww * R + row) * 128;
                va0 += *(const LAS f32x4*)(pr + ((2 * hf) ^ (row & 7)) * 16); va1 += *(const LAS f32x4*)(pr + ((2 * hf + 1) ^ (row & 7)) * 16);
                vb0 += *(const LAS f32x4*)(pr + ((4 + 2 * hf) ^ (row & 7)) * 16); vb1 += *(const LAS f32x4*)(pr + ((5 + 2 * hf) ^ (row & 7)) * 16); }
            if (rg * R + row < nrows) f.emit(rowbase + rg * R + row, ca + hf * 8, cb + hf * 8, va0, va1, vb0, vb1);
        }
    }
    }
    __syncthreads();
}
static_assert(8 * 128 * 128 <= SCR_BYTES, "skinny reduction buffer");

__device__ __forceinline__ int cond_of_row(int row) { return row < MPR ? (row >> 11) : (BP + row - MPR); }
template <int MODE>
__device__ __forceinline__ void resnorm_phase(Frame& F, const float* xp, const float* xs, float* X, const bf16* Y, bf16* H, const float* MOD,
                                              const float* wpost, int goff, const float* wpre, int shoff, int scoff) {
    const int gw = F.vcu * NWAVES + F.wave, NGW = F.G * NWAVES, lane = F.lane;
    for (int row = gw; row < MT; row += NGW) {
        const float* modr = MOD + (size_t)cond_of_row(row) * NMODALL;
        f32x4 x[4];
        if (MODE == 0) {
            const float* src = row < MPR ? xp + (size_t)row * D : xs + (size_t)(row - MPR) * D;
#pragma unroll
            for (int j = 0; j < 4; ++j) x[j] = *(const GAS f32x4*)(src + 4 * lane + 256 * j);
        } else {
            f32x4 y[4]; float ss = 0.f;
#pragma unroll
            for (int j = 0; j < 4; ++j) { x[j] = *(const GAS f32x4*)(X + (size_t)row * D + 4 * lane + 256 * j);
                const v2u yw = *(const GAS v2u*)(Y + (size_t)row * D + 4 * lane + 256 * j);
                y[j] = (f32x4){bflo(yw.x), bfhi(yw.x), bflo(yw.y), bfhi(yw.y)};
                ss += (y[j][0] * y[j][0] + y[j][1] * y[j][1]) + (y[j][2] * y[j][2] + y[j][3] * y[j][3]); }
            const float r1 = rsqrtf(wave_sum(ss) * (1.f / D) + EPS);
#pragma unroll
            for (int j = 0; j < 4; ++j) { const f32x4 g = *(const GAS f32x4*)(modr + goff + 4 * lane + 256 * j), wp = *(const GAS f32x4*)(wpost + 4 * lane + 256 * j);
                x[j] = x[j] + g * (y[j] * r1) * wp; }
        }
#pragma unroll
        for (int j = 0; j < 4; ++j) *(GAS f32x4*)(X + (size_t)row * D + 4 * lane + 256 * j) = x[j];
        if (MODE != 2) {
            float s2 = 0.f;
#pragma unroll
            for (int j = 0; j < 4; ++j) s2 += (x[j][0] * x[j][0] + x[j][1] * x[j][1]) + (x[j][2] * x[j][2] + x[j][3] * x[j][3]);
            const float r2 = rsqrtf(wave_sum(s2) * (1.f / D) + EPS);
#pragma unroll
            for (int j = 0; j < 4; ++j) { const int c = 4 * lane + 256 * j;
                const f32x4 wp = *(const GAS f32x4*)(wpre + c), sc = *(const GAS f32x4*)(modr + scoff + c), sh = *(const GAS f32x4*)(modr + shoff + c);
                const f32x4 h = (x[j] * r2) * wp * (sc + 1.f) + sh;
                *(GAS v2u*)(H + (size_t)row * D + c) = pack4v(h); }
        }
    }
}
template <int MIX>
__device__ __forceinline__ void gatenorm_phase(Frame& F, const bf16* RO, const bf16* GATE, bf16* GO, const float* nw) {
    const int gw = F.vcu * NWAVES + F.wave, NGW = F.G * NWAVES, lane = F.lane;
    constexpr int W = (MIX == 2) ? 1024 : 2048, NJ = W / 512;
    for (int row = gw; row < MT; row += NGW) {
        float u[NJ][8], r[NJ];
#pragma unroll
        for (int j = 0; j < NJ; ++j) {
            const int c = 8 * lane + 512 * j;
            float o[8], g[8];
            unpack8(*(const GAS v4u*)(RO + (size_t)row * W + c), o); unpack8(*(const GAS v4u*)(GATE + (size_t)row * W + c), g);
            float ss = 0.f;
#pragma unroll
            for (int e = 0; e < 8; ++e) {
                if (MIX == 0) { u[j][e] = o[e] * g[e]; ss += o[e] * o[e]; }
                else if (MIX == 1) { u[j][e] = o[e] * g[e]; ss += u[j][e] * u[j][e]; }
                else { u[j][e] = o[e] * g[e]; ss += o[e] * o[e]; }
            }
            if (MIX == 2) r[j] = rsqrtf(grp16_sum(ss) * (1.f / 128.f) + EPS); else r[j] = rsqrtf(wave_sum(ss) * (1.f / 512.f) + EPS);
        }
#pragma unroll
        for (int j = 0; j < NJ; ++j) {
            const int c = 8 * lane + 512 * j;
            float v[8];
#pragma unroll
            for (int e = 0; e < 8; ++e) { float wgt = 1.f; if (MIX == 1) wgt = nw[c + e]; if (MIX == 2) wgt = nw[(c + e) & 127]; v[e] = u[j][e] * r[j] * wgt; }
            *(GAS v4u*)(GO + (size_t)row * W + c) = pack8(v);
        }
    }
}

template <int OFF> __device__ __forceinline__ bf16x8 tr_frag(unsigned addr) {
    s16x4 lo, hi;
    asm volatile("ds_read_b64_tr_b16 %0, %2\n\tds_read_b64_tr_b16 %1, %2 offset:%3\n\ts_waitcnt lgkmcnt(0)" : "=&v"(lo), "=&v"(hi) : "v"(addr), "i"(OFF) : "memory");
    return __builtin_shufflevector(lo, hi, 0, 1, 2, 3, 4, 5, 6, 7);
}
template <int OFF> __device__ __forceinline__ void tr_frag2(unsigned a0, unsigned a1, bf16x8& f0, bf16x8& f1) {
    s16x4 l0, h0, l1, h1;
    asm volatile("ds_read_b64_tr_b16 %0, %4\n\tds_read_b64_tr_b16 %1, %4 offset:%6\n\tds_read_b64_tr_b16 %2, %5\n\tds_read_b64_tr_b16 %3, %5 offset:%6\n\ts_waitcnt lgkmcnt(0)"
                 : "=&v"(l0), "=&v"(h0), "=&v"(l1), "=&v"(h1) : "v"(a0), "v"(a1), "i"(OFF) : "memory");
    f0 = __builtin_shufflevector(l0, h0, 0, 1, 2, 3, 4, 5, 6, 7); f1 = __builtin_shufflevector(l1, h1, 0, 1, 2, 3, 4, 5, 6, 7);
}

template <class Cf, class OutFn>
__device__ __forceinline__ void rec_step(LAS unsigned char* lds, const int w, const int lane, f32x4 (&S)[Cf::KPW][Cf::VS / 16], const LAS float* cum, const OutFn& out, const int tok0) {
    constexpr int C = Cf::C, KD = Cf::KD, VS = Cf::VS, NIT = C / 16, NJT = C / 16, NVT = VS / 16, KSK = KD / 32, KSC = C / 32;
    constexpr int RSK = Cf::RSK, RSV = Cf::RSV, RSP = Cf::RSP;
    constexpr bool CH = Cf::CH;
    const int fr = lane & 15, fq = lane >> 4, q4 = fr >> 2, p4 = fr & 3;
    const unsigned lbase = (unsigned)(size_t)lds;
    constexpr int NP = NIT * NJT, PPW = (NP + 7) / 8;
#pragma unroll
    for (int tt = 0; tt < PPW; ++tt) { const int t = w + 8 * tt;
        if (t < NP) { const int it = t / NJT, jt = t % NJT;
            f32x4 p = (f32x4){0.f, 0.f, 0.f, 0.f};
            if (jt <= it) {
#pragma unroll
                for (int ks = 0; ks < KSK; ++ks) {
                    const bf16x8 a = *(const LAS bf16x8*)(lds + Cf::KA + (16 * jt + fr) * RSK + (32 * ks + 8 * fq) * 2);
                    const bf16x8 b = *(const LAS bf16x8*)(lds + Cf::QA + (16 * it + fr) * RSK + (32 * ks + 8 * fq) * 2);
                    p = MFMA16(a, b, p); }
                const int i = 16 * it + fr;
                if (!CH) { const float ci = cum[i];
#pragma unroll
                    for (int r = 0; r < 4; ++r) { const int j = 16 * jt + 4 * fq + r; const float e = __expf(fminf(ci - cum[j], 0.f)); p[r] = (j <= i) ? p[r] * e : 0.f; } }
                else {
#pragma unroll
                    for (int r = 0; r < 4; ++r) { const int j = 16 * jt + 4 * fq + r; p[r] = (j <= i) ? p[r] : 0.f; } }
            }
            *(LAS v2u*)(lds + Cf::PM + (16 * it + fr) * RSP + (16 * jt + 4 * fq) * 2) = pack4v(p);
        } }
    constexpr int NO = NVT * NIT, OPW = (NO + 7) / 8;
    f32x4 O[OPW];
#pragma unroll
    for (int tt = 0; tt < OPW; ++tt) { const int t = w + 8 * tt; O[tt] = (f32x4){0.f, 0.f, 0.f, 0.f};
        if (t < NO) { const int vt = t / NIT, it = t % NIT; f32x4 o = (f32x4){0.f, 0.f, 0.f, 0.f};
#pragma unroll
            for (int ks = 0; ks < KSK; ++ks) {
                const bf16x8 a = *(const LAS bf16x8*)(lds + Cf::ST + (16 * vt + fr) * RSK + (32 * ks + 8 * fq) * 2);
                const bf16x8 b = *(const LAS bf16x8*)(lds + Cf::QB + (16 * it + fr) * RSK + (32 * ks + 8 * fq) * 2);
                o = MFMA16(a, b, o); }
            if (!CH) o = o * __expf(cum[16 * it + fr]);
            O[tt] = o; } }
#pragma unroll
    for (int ki = 0; ki < Cf::KPW; ++ki) { const int kt = w + 8 * ki;
        if (!CH) { const float d = __expf(cum[C - 1]);
#pragma unroll
            for (int vt = 0; vt < NVT; ++vt) S[ki][vt] = S[ki][vt] * d; }
        else { const LAS float* ds = (const LAS float*)(lds + Cf::DS) + 16 * kt + 4 * fq; const f32x4 d = (f32x4){ds[0], ds[1], ds[2], ds[3]};
#pragma unroll
            for (int vt = 0; vt < NVT; ++vt) S[ki][vt] = S[ki][vt] * d; }
#pragma unroll
        for (int ks = 0; ks < KSC; ++ks) {
            const bf16x8 a = tr_frag<4 * RSK>(lbase + Cf::KB + (32 * ks + 8 * fq + q4) * RSK + (16 * kt + 4 * p4) * 2);
#pragma unroll
            for (int vt = 0; vt < NVT; vt += 2) { bf16x8 b0, b1;
                tr_frag2<4 * RSV>(lbase + Cf::VB + (32 * ks + 8 * fq + q4) * RSV + (16 * vt + 4 * p4) * 2, lbase + Cf::VB + (32 * ks + 8 * fq + q4) * RSV + (16 * (vt + 1) + 4 * p4) * 2, b0, b1);
                S[ki][vt] = MFMA16(a, b0, S[ki][vt]); S[ki][vt + 1] = MFMA16(a, b1, S[ki][vt + 1]); } } }
    __syncthreads();
#pragma unroll
    for (int tt = 0; tt < OPW; ++tt) { const int t = w + 8 * tt;
        if (t < NO) { const int vt = t / NIT, it = t % NIT; f32x4 o = O[tt];
#pragma unroll
            for (int ks = 0; ks < KSC; ++ks) {
                const bf16x8 a = tr_frag<4 * RSV>(lbase + Cf::V + (32 * ks + 8 * fq + q4) * RSV + (16 * vt + 4 * p4) * 2);
                const bf16x8 b = *(const LAS bf16x8*)(lds + Cf::PM + (16 * it + fr) * RSP + (32 * ks + 8 * fq) * 2);
                o = MFMA16(a, b, o); }
            out(tok0 + 16 * it + fr, 16 * it + fr, 16 * vt + 4 * fq, o); } }
#pragma unroll
    for (int ki = 0; ki < Cf::KPW; ++ki) { const int kt = w + 8 * ki;
#pragma unroll
        for (int vt = 0; vt < NVT; ++vt) *(LAS v2u*)(lds + Cf::ST + (16 * vt + fr) * RSK + (16 * kt + 4 * fq) * 2) = pack4v(S[ki][vt]); }
    __syncthreads();
}
template <class Cf> __device__ __forceinline__ void rec_zero_state(Frame& F, f32x4 (&S)[Cf::KPW][Cf::VS / 16]) {
#pragma unroll
    for (int ki = 0; ki < Cf::KPW; ++ki)
#pragma unroll
        for (int vt = 0; vt < Cf::VS / 16; ++vt) S[ki][vt] = (f32x4){0.f, 0.f, 0.f, 0.f};
    for (int o = F.tid * 16; o < Cf::VS * Cf::RSK; o += 512 * 16) *(LAS v4u*)(F.lds + Cf::ST + o) = (v4u){0u, 0u, 0u, 0u};
}
template <class Cf> __device__ __forceinline__ void rec_store_state(Frame& F, const f32x4 (&S)[Cf::KPW][Cf::VS / 16], float* dst, int ldv) {
    const int fr = F.lane & 15, fq = F.lane >> 4;
#pragma unroll
    for (int ki = 0; ki < Cf::KPW; ++ki) { const int kt = F.wave + 8 * ki;
#pragma unroll
        for (int vt = 0; vt < Cf::VS / 16; ++vt)
#pragma unroll
            for (int r = 0; r < 4; ++r) dst[(size_t)(16 * kt + 4 * fq + r) * ldv + 16 * vt + fr] = S[ki][vt][r]; }
}

struct CfRet { static constexpr int C = 64, KD = 256, VS = 64, KPW = 2, RSK = 528, RSV = 144, RSP = 144; static constexpr bool CH = false;
    static constexpr int QA = 0, KA = 33792, QB = QA, KB = KA, V = 67584, VB = 76800, PM = 86016, ST = 95232, CUM = 129024, DS = 0, END = 129280; };
static_assert(CfRet::END <= SCR_BYTES, "ret lds");
struct RetOut { bf16* dst;
    __device__ __forceinline__ void operator()(int tok, int i, int vv0, const f32x4 o) const { *(GAS v2u*)(dst + (size_t)tok * 2048 + vv0) = pack4v(o); } };
__device__ __forceinline__ void ret_prompt_item(Frame& F, int item, const bf16* Q, const bf16* K, const bf16* V, bf16* RO, float* st_out) {
    const int b = item >> 5, h = (item >> 3) & 3, vs = item & 7, tid = F.tid;
    const float lg = logf(1.f - exp2f(-5.f - (float)h));
    LAS float* cum = (LAS float*)(F.lds + CfRet::CUM);
    __syncthreads();
    if (tid < 64) cum[tid] = (float)(tid + 1) * lg;
    f32x4 S[CfRet::KPW][4];
    rec_zero_state<CfRet>(F, S);
    const bf16* qg = Q + (size_t)(b * SEQ) * 1024 + h * 256; const bf16* kg = K + (size_t)(b * SEQ) * 1024 + h * 256; const bf16* vg = V + (size_t)(b * SEQ) * 2048 + h * 512 + vs * 64;
    const RetOut out{RO + (size_t)(b * SEQ) * 2048 + h * 512 + vs * 64};
    v4u qr[4], kr[4], vr;
#pragma unroll
    for (int i = 0; i < 4; ++i) { const int pc = tid + 512 * i, row = pc >> 5, c16 = pc & 31; qr[i] = *(const GAS v4u*)(qg + (size_t)row * 1024 + c16 * 8); kr[i] = *(const GAS v4u*)(kg + (size_t)row * 1024 + c16 * 8); }
    vr = *(const GAS v4u*)(vg + (size_t)(tid >> 3) * 2048 + (tid & 7) * 8);
    const float vsc = __expf((float)(63 - (tid >> 3)) * lg);
    for (int c = 0; c < SEQ / 64; ++c) {
#pragma unroll
        for (int i = 0; i < 4; ++i) { const int pc = tid + 512 * i, row = pc >> 5, c16 = pc & 31;
            *(LAS v4u*)(F.lds + CfRet::QA + row * 528 + c16 * 16) = qr[i]; *(LAS v4u*)(F.lds + CfRet::KA + row * 528 + c16 * 16) = kr[i]; }
        { const int row = tid >> 3, c16 = tid & 7; *(LAS v4u*)(F.lds + CfRet::V + row * 144 + c16 * 16) = vr;
          float f[8]; unpack8(vr, f);
#pragma unroll
          for (int e = 0; e < 8; ++e) f[e] *= vsc;
          *(LAS v4u*)(F.lds + CfRet::VB + row * 144 + c16 * 16) = pack8(f); }
        if (c + 1 < SEQ / 64) { const size_t r0 = (size_t)(c + 1) * 64;
#pragma unroll
            for (int i = 0; i < 4; ++i) { const int pc = tid + 512 * i, row = pc >> 5, c16 = pc & 31; qr[i] = *(const GAS v4u*)(qg + (r0 + row) * 1024 + c16 * 8); kr[i] = *(const GAS v4u*)(kg + (r0 + row) * 1024 + c16 * 8); }
            vr = *(const GAS v4u*)(vg + (r0 + (tid >> 3)) * 2048 + (tid & 7) * 8); }
        __syncthreads();
        rec_step<CfRet>(F.lds, F.wave, F.lane, S, cum, out, c * 64);
    }
    rec_store_state<CfRet>(F, S, st_out + ((size_t)(b * 4 + h) * 256) * 512 + vs * 64, 512);
}
__device__ __forceinline__ void ret_sample_items(Frame& F, const bf16* Q, const bf16* K, const bf16* V, bf16* RO, const float* st_in, float* st_out) {
    LAS float* qk = (LAS float*)F.lds; LAS float* red = qk + 512;
    const int tid = F.tid, lane = F.lane, w = F.wave;
    for (int item = F.vcu; item < MS * 4; item += F.G) {
        const int bs = item >> 2, h = item & 3; const size_t row = MPR + bs;
        __syncthreads();
        qk[tid] = tid < 256 ? bf2f(Q[row * 1024 + h * 256 + tid]) : bf2f(K[row * 1024 + h * 256 + (tid - 256)]);
        float v[8]; unpack8(*(const GAS v4u*)(V + row * 2048 + h * 512 + 8 * lane), v);
        __syncthreads();
        const float g = 1.f - exp2f(-5.f - (float)h);
        const float* sin = st_in + ((size_t)(bs * 4 + h) * 256) * 512 + 8 * lane; float* sout = st_out + ((size_t)(bs * 4 + h) * 256) * 512 + 8 * lane;
        float o[8];
#pragma unroll
        for (int e = 0; e < 8; ++e) o[e] = 0.f;
#pragma unroll 8
        for (int r = 0; r < 32; ++r) { const int kk = 32 * w + r;
            f32x4 s0 = __builtin_nontemporal_load((const GAS f32x4*)(sin + (size_t)kk * 512)), s1 = __builtin_nontemporal_load((const GAS f32x4*)(sin + (size_t)kk * 512 + 4));
            const float kf = qk[256 + kk], qf = qk[kk];
#pragma unroll
            for (int e = 0; e < 4; ++e) { s0[e] = g * s0[e] + kf * v[e]; s1[e] = g * s1[e] + kf * v[4 + e]; o[e] += s0[e] * qf; o[4 + e] += s1[e] * qf; }
            __builtin_nontemporal_store(s0, (GAS f32x4*)(sout + (size_t)kk * 512)); __builtin_nontemporal_store(s1, (GAS f32x4*)(sout + (size_t)kk * 512 + 4)); }
#pragma unroll
        for (int e = 0; e < 8; ++e) red[w * 512 + 8 * lane + e] = o[e];
        __syncthreads();
        float acc = 0.f;
#pragma unroll
        for (int ww = 0; ww < 8; ++ww) acc += red[ww * 512 + tid];
        RO[row * 2048 + h * 512 + tid] = (bf16)(cvt_pk_bf16(acc, acc) & 0xffffu);
    }
    __syncthreads();
}

struct CfSsd { static constexpr int C = 64, KD = 128, VS = 64, KPW = 1, RSK = 272, RSV = 144, RSP = 144; static constexpr bool CH = false;
    static constexpr int QA = 0, KA = 17408, QB = QA, KB = KA, V = 34816, VB = 44032, PM = 53248, ST = 62464, XS = 79872, CUM = 89088, DTV = 89600, RAW = 90112, RSR = 656, DS = 0, END = RAW + 67 * 656; };
static_assert(CfSsd::END <= SCR_BYTES, "ssd lds");
struct SsdOut { bf16* dst; const LAS unsigned char* xs; float Dh;
    __device__ __forceinline__ void operator()(int tok, int i, int vv0, const f32x4 o) const {
        const v2u xw = *(const LAS v2u*)(xs + i * 144 + vv0 * 2);
        const f32x4 x = (f32x4){bflo(xw.x), bfhi(xw.x), bflo(xw.y), bfhi(xw.y)};
        *(GAS v2u*)(dst + (size_t)tok * 2048 + vv0) = pack4v(o + x * Dh); } };
__device__ __forceinline__ int ssd_gcol(int lch, int head, int grp) { return lch < 64 ? head * 64 + lch : (lch < 192 ? 2048 + grp * 128 + (lch - 64) : 2560 + grp * 128 + (lch - 192)); }
__device__ __forceinline__ void ssd_prompt_item(Frame& F, int item, const bf16* XBC, const float* DT, bf16* T, float* st_out,
                                                const float* conv_w, const float* conv_b, const float* dt_bias, const float* a_log, const float* d_skip) {
    const int b = item >> 5, head = item & 31, grp = head >> 3, tid = F.tid, lane = F.lane, w = F.wave;
    const float a = -expf(a_log[head]), dtb = dt_bias[head], Dh = d_skip[head];
    LAS float* cumb = (LAS float*)(F.lds + CfSsd::CUM); LAS float* dtvb = (LAS float*)(F.lds + CfSsd::DTV);
    __syncthreads();
    f32x4 S[CfSsd::KPW][4];
    rec_zero_state<CfSsd>(F, S);
    const bf16* xg = XBC + (size_t)(b * SEQ) * 3072; const float* dtg = DT + (size_t)(b * SEQ) * 32 + head;
    const SsdOut out{T + (size_t)(b * SEQ) * 2048 + head * 64, F.lds + CfSsd::XS, Dh};
    const bool conv_thr = tid < 440; const int cg = tid % 40, tb = tid / 40, gcolc = ssd_gcol(8 * cg, head, grp);
    float wr[4][8], br[8];
#pragma unroll
    for (int e = 0; e < 8; ++e) { br[e] = conv_b[gcolc + e];
#pragma unroll
        for (int tap = 0; tap < 4; ++tap) wr[tap][e] = conv_w[tap * 3072 + gcolc + e]; }
    const bool stg_thr = tid < 480; const int r0 = tid / 40;
    v4u raw[6];
#define SSD_LOAD_RAW(cc) do { const bf16* rp_ = xg + ((long)((cc) * 64 - 3 + r0) * 3072 + gcolc); _Pragma("unroll") for (int k_ = 0; k_ < 6; ++k_) { const int row_ = r0 + 12 * k_, tk_ = (cc) * 64 - 3 + row_; \
        raw[k_] = (v4u){0u, 0u, 0u, 0u}; if (stg_thr && row_ < 67 && tk_ >= 0) raw[k_] = *(const GAS v4u*)(rp_ + (long)k_ * 12 * 3072); } } while (0)
#define SSD_CUM(cc) do { if (w == 0) { const float dtv_ = softplusf_(dtn + dtb); float v_ = dtv_ * a; \
        _Pragma("unroll") for (int o_ = 1; o_ < 64; o_ <<= 1) { const float u_ = __shfl_up(v_, o_); if (lane >= o_) v_ += u_; } cumb[((cc) & 1) * 64 + lane] = v_; dtvb[((cc) & 1) * 64 + lane] = dtv_; } } while (0)
    float dtn = 0.f;
    if (w == 0) dtn = dtg[(size_t)lane * 32];
    SSD_CUM(0);
    if (w == 0) dtn = dtg[(size_t)(64 + lane) * 32];
    SSD_LOAD_RAW(0);
    for (int c = 0; c < SEQ / 64; ++c) {
#pragma unroll
        for (int k = 0; k < 6; ++k) { const int row = r0 + 12 * k; if (stg_thr && row < 67) *(LAS v4u*)(F.lds + CfSsd::RAW + row * CfSsd::RSR + cg * 16) = raw[k]; }
        if (c + 1 < SEQ / 64) { SSD_CUM(c + 1); if (w == 0 && c + 2 < SEQ / 64) dtn = dtg[(size_t)((c + 2) * 64 + lane) * 32]; SSD_LOAD_RAW(c + 1); }
        __syncthreads();
        const LAS float* cum = cumb + (c & 1) * 64; const LAS float* dtv = dtvb + (c & 1) * 64; const float tot = cum[63];
        if (conv_thr) {
            float win[3][8];
#pragma unroll
            for (int r = 0; r < 3; ++r) unpack8(*(const LAS v4u*)(F.lds + CfSsd::RAW + (6 * tb + r) * CfSsd::RSR + cg * 16), win[r]);
#pragma unroll
            for (int k = 0; k < 6; ++k) { const int i = 6 * tb + k;
                if (i < 64) {
                    float x3[8], acc[8]; unpack8(*(const LAS v4u*)(F.lds + CfSsd::RAW + (i + 3) * CfSsd::RSR + cg * 16), x3);
#pragma unroll
                    for (int e = 0; e < 8; ++e) { acc[e] = br[e] + win[0][e] * wr[0][e] + win[1][e] * wr[1][e] + win[2][e] * wr[2][e] + x3[e] * wr[3][e]; acc[e] = siluf_(acc[e]);
                        win[0][e] = win[1][e]; win[1][e] = win[2][e]; win[2][e] = x3[e]; }
                    if (cg < 8) { const float dv = dtv[i], wj = dv * __expf(tot - cum[i]);
                        *(LAS v4u*)(F.lds + CfSsd::XS + i * 144 + cg * 16) = pack8(acc);
                        float f[8];
#pragma unroll
                        for (int e = 0; e < 8; ++e) f[e] = acc[e] * dv;
                        *(LAS v4u*)(F.lds + CfSsd::V + i * 144 + cg * 16) = pack8(f);
#pragma unroll
                        for (int e = 0; e < 8; ++e) f[e] = acc[e] * wj;
                        *(LAS v4u*)(F.lds + CfSsd::VB + i * 144 + cg * 16) = pack8(f); }
                    else if (cg < 24) *(LAS v4u*)(F.lds + CfSsd::KA + i * 272 + (cg - 8) * 16) = pack8(acc);
                    else *(LAS v4u*)(F.lds + CfSsd::QA + i * 272 + (cg - 24) * 16) = pack8(acc);
                } }
        }
        __syncthreads();
        rec_step<CfSsd>(F.lds, w, lane, S, cum, out, c * 64);
    }
#undef SSD_CUM
#undef SSD_LOAD_RAW
    rec_store_state<CfSsd>(F, S, st_out + ((size_t)(b * 32 + head) * 128) * 64, 64);
}
__device__ __forceinline__ void ssd_sample_items(Frame& F, const bf16* XBC, const float* DT, bf16* T, const float* st_in, float* st_out, const float* conv_st,
                                                 const float* conv_w, const float* conv_b, const float* dt_bias, const float* a_log, const float* d_skip) {
    const int gw = F.vcu * NWAVES + F.wave, NGW = F.G * NWAVES, lane = F.lane;
    LAS float* scr = (LAS float*)(F.lds + F.wave * 2048);
    __syncthreads();
    for (int item = gw; item < MS * 32; item += NGW) {
        const int bs = item >> 5, head = item & 31, grp = head >> 3; const size_t row = MPR + bs;
        asm volatile("" ::: "memory");
#pragma unroll
        for (int r = 0; r < 5; ++r) { const int lch = lane + 64 * r, gch = ssd_gcol(lch, head, grp);
            float acc = conv_b[gch];
#pragma unroll
            for (int tap = 0; tap < 3; ++tap) acc += conv_st[((size_t)bs * 3 + tap) * 3072 + gch] * conv_w[tap * 3072 + gch];
            acc += bf2f(XBC[row * 3072 + gch]) * conv_w[3 * 3072 + gch];
            scr[lch] = siluf_(acc); }
        LDS_WAIT();
        const float dtv = softplusf_(DT[row * 32 + head] + dt_bias[head]), dA = __expf(dtv * -expf(a_log[head])), Dh = d_skip[head];
        const int v4 = (lane & 15) * 4, kq = lane >> 4;
        const f32x4 xs4 = (f32x4){scr[v4], scr[v4 + 1], scr[v4 + 2], scr[v4 + 3]}, xd = xs4 * dtv;
        const float* sin = st_in + ((size_t)(bs * 32 + head) * 128) * 64 + v4; float* sout = st_out + ((size_t)(bs * 32 + head) * 128) * 64 + v4;
        f32x4 y = (f32x4){0.f, 0.f, 0.f, 0.f};
#pragma unroll 8
        for (int i = 0; i < 32; ++i) { const int kk = 4 * i + kq;
            f32x4 s = __builtin_nontemporal_load((const GAS f32x4*)(sin + (size_t)kk * 64));
            s = s * dA + xd * scr[64 + kk];
            __builtin_nontemporal_store(s, (GAS f32x4*)(sout + (size_t)kk * 64));
            y = y + s * scr[192 + kk]; }
#pragma unroll
        for (int e = 0; e < 4; ++e) { y[e] += __shfl_xor(y[e], 16); y[e] += __shfl_xor(y[e], 32); }
        if (lane < 16) *(GAS v2u*)(T + row * 2048 + head * 64 + v4) = pack4v(y + xs4 * Dh);
        LDS_WAIT();
    }
    __syncthreads();
}
__device__ __forceinline__ void ssd_conv_out(Frame& F, const bf16* XBC, const float* conv_st, float* outp, float* outs) {
    const int NP_ = BP * 3 * 3072, NS_ = MS * 3 * 3072;
    for (int idx = F.vcu * 512 + F.tid; idx < NP_ + NS_; idx += F.G * 512) {
        if (idx < NP_) { const int b = idx / 9216, rem = idx - b * 9216, wi = rem / 3072, ch = rem - wi * 3072; outp[idx] = bf2f(XBC[(size_t)(b * SEQ + SEQ - 3 + wi) * 3072 + ch]); }
        else { const int k = idx - NP_, bs = k / 9216, rem = k - bs * 9216, wi = rem / 3072, ch = rem - wi * 3072;
            outs[k] = wi < 2 ? conv_st[((size_t)bs * 3 + wi + 1) * 3072 + ch] : bf2f(XBC[(size_t)(MPR + bs) * 3072 + ch]); }
    }
}

struct CfHg { static constexpr int C = 32, KD = 128, VS = 32, KPW = 1, RSK = 272, RSV = 80, RSP = 80; static constexpr bool CH = true;
    static constexpr int QA = 0, KA = 8704, QB = 17408, KB = 26112, V = 34816, VB = V, PM = 37376, ST = 39936, DS = 48640, PART = 49152, CUM = 0, END = 51200; };
static_assert(CfHg::END <= SCR_BYTES, "hgrn lds");
struct HgOut { bf16* dst;
    __device__ __forceinline__ void operator()(int tok, int i, int vv0, const f32x4 o) const { *(GAS v2u*)(dst + (size_t)tok * 1024 + vv0) = pack4v(o); } };
__device__ __forceinline__ void st_bf16_lds(LAS unsigned char* p, float x) { *(LAS unsigned short*)p = (unsigned short)(cvt_pk_bf16(x, x) & 0xffffu); }
__device__ __forceinline__ void hg_prompt_item(Frame& F, int item, const bf16* HQ, const float* LA, const bf16* HV, bf16* RO, float* st_out) {
    const int b = item >> 5, h = (item >> 2) & 7, vs = item & 3, tid = F.tid, kk = tid & 127, tg = tid >> 7;
    LAS float* part = (LAS float*)(F.lds + CfHg::PART); LAS float* dsv = (LAS float*)(F.lds + CfHg::DS);
    __syncthreads();
    f32x4 S[CfHg::KPW][2];
    rec_zero_state<CfHg>(F, S);
    const size_t base = (size_t)(b * SEQ) * 1024 + h * 128;
    const HgOut out{RO + base + vs * 32};
    float la[8]; unsigned short qr[8]; v4u vr = (v4u){0u, 0u, 0u, 0u};
#pragma unroll
    for (int e = 0; e < 8; ++e) { const size_t ix = base + (size_t)(8 * tg + e) * 1024 + kk; la[e] = LA[ix]; qr[e] = HQ[ix]; }
    if (tid < 128) vr = *(const GAS v4u*)(HV + base + (size_t)(tid >> 2) * 1024 + vs * 32 + (tid & 3) * 8);
    for (int c = 0; c < SEQ / 32; ++c) {
        float lc[8]; lc[0] = la[0];
#pragma unroll
        for (int e = 1; e < 8; ++e) lc[e] = lc[e - 1] + la[e];
        part[tg * 128 + kk] = lc[7];
        __syncthreads();
        const float p0 = part[kk], p1 = part[128 + kk], p2 = part[256 + kk], p3 = part[384 + kk];
        const float off = (tg > 0 ? p0 : 0.f) + (tg > 1 ? p1 : 0.f) + (tg > 2 ? p2 : 0.f), tot = (p0 + p1) + (p2 + p3), ref = p0 + p1;
#pragma unroll
        for (int e = 0; e < 8; ++e) { const int i = 8 * tg + e; const float cm = off + lc[e], kf = 1.f - __expf(la[e]), qv = bf2f(qr[e]);
            const float ea = __expf(fminf(fmaxf(cm - ref, -80.f), 80.f)), eb = __expf(fminf(fmaxf(ref - cm, -80.f), 80.f));
            st_bf16_lds(F.lds + CfHg::QA + i * 272 + kk * 2, qv * ea); st_bf16_lds(F.lds + CfHg::KA + i * 272 + kk * 2, kf * eb);
            st_bf16_lds(F.lds + CfHg::QB + i * 272 + kk * 2, qv * __expf(cm)); st_bf16_lds(F.lds + CfHg::KB + i * 272 + kk * 2, kf * __expf(tot - cm)); }
        if (tg == 0) dsv[kk] = __expf(tot);
        if (tid < 128) *(LAS v4u*)(F.lds + CfHg::V + (tid >> 2) * 80 + (tid & 3) * 16) = vr;
        if (c + 1 < SEQ / 32) { const size_t b2 = base + (size_t)(c + 1) * 32 * 1024;
#pragma unroll
            for (int e = 0; e < 8; ++e) { const size_t ix = b2 + (size_t)(8 * tg + e) * 1024 + kk; la[e] = LA[ix]; qr[e] = HQ[ix]; }
            if (tid < 128) vr = *(const GAS v4u*)(HV + b2 + (size_t)(tid >> 2) * 1024 + vs * 32 + (tid & 3) * 8); }
        __syncthreads();
        rec_step<CfHg>(F.lds, F.wave, F.lane, S, (const LAS float*)nullptr, out, c * 32);
    }
    rec_store_state<CfHg>(F, S, st_out + ((size_t)(b * 8 + h) * 128) * 128 + vs * 32, 128);
}
__device__ __forceinline__ void hg_sample_items(Frame& F, const bf16* HQ, const float* LA, const bf16* HV, bf16* RO, const float* st_in, float* st_out) {
    const int gw = F.vcu * NWAVES + F.wave, NGW = F.G * NWAVES, lane = F.lane;
    LAS float* scr = (LAS float*)(F.lds + F.wave * 2048);
    __syncthreads();
    for (int item = gw; item < MS * 16; item += NGW) {
        const int bs = item >> 4, h = (item >> 1) & 7, vh = item & 1; const size_t rb = (size_t)(MPR + bs) * 1024 + h * 128;
        asm volatile("" ::: "memory");
#pragma unroll
        for (int r = 0; r < 2; ++r) { const int kk = lane + 64 * r; scr[kk] = __expf(LA[rb + kk]); scr[128 + kk] = bf2f(HQ[rb + kk]); }
        LDS_WAIT();
        const int v4 = (lane & 15) * 4, kq = lane >> 4;
        const v2u iw = *(const GAS v2u*)(HV + rb + vh * 64 + v4);
        const f32x4 iv = (f32x4){bflo(iw.x), bfhi(iw.x), bflo(iw.y), bfhi(iw.y)};
        const float* sin = st_in + ((size_t)(bs * 8 + h) * 128) * 128 + vh * 64 + v4; float* sout = st_out + ((size_t)(bs * 8 + h) * 128) * 128 + vh * 64 + v4;
        f32x4 o = (f32x4){0.f, 0.f, 0.f, 0.f};
#pragma unroll 8
        for (int i = 0; i < 32; ++i) { const int kk = 4 * i + kq; const float f = scr[kk];
            f32x4 s = __builtin_nontemporal_load((const GAS f32x4*)(sin + (size_t)kk * 128));
            s = s * f + iv * (1.f - f);
            __builtin_nontemporal_store(s, (GAS f32x4*)(sout + (size_t)kk * 128));
            o = o + s * scr[128 + kk]; }
#pragma unroll
        for (int e = 0; e < 4; ++e) { o[e] += __shfl_xor(o[e], 16); o[e] += __shfl_xor(o[e], 32); }
        if (lane < 16) *(GAS v2u*)(RO + rb + vh * 64 + v4) = pack4v(o);
        LDS_WAIT();
    }
    __syncthreads();
}

__device__ __forceinline__ void p0_transpose_item(const float* W, int K, int N, bf16* WT, LAS float* scr, int item, int lane, bool inter) {
    const int nblk = N / 32, kb = item / nblk, nb = item - kb * nblk, k0 = 64 * kb, n0 = 32 * nb;
    int s0 = n0; if (inter) { const int t = n0 >> 8, j = n0 & 255; s0 = j < 128 ? 128 * t + j : DFF + 128 * t + (j - 128); }
#pragma unroll 8
    for (int i = 0; i < 32; ++i) { const int kk = 2 * i + (lane >> 5); scr[kk * 33 + (lane & 31)] = W[(size_t)(k0 + kk) * N + s0 + (lane & 31)]; }
    LDS_WAIT(); asm volatile("" ::: "memory");
    const int c = lane & 7;
#pragma unroll
    for (int j = 0; j < 4; ++j) { const int n = (lane >> 3) + 8 * j; const LAS float* s = scr + (8 * c) * 33 + n;
        v4u o; o.x = cvt_pk_bf16(s[0 * 33], s[1 * 33]); o.y = cvt_pk_bf16(s[2 * 33], s[3 * 33]); o.z = cvt_pk_bf16(s[4 * 33], s[5 * 33]); o.w = cvt_pk_bf16(s[6 * 33], s[7 * 33]);
        *(GAS v4u*)(WT + (size_t)(n0 + n) * K + k0 + 8 * c) = o; }
    LDS_WAIT(); asm volatile("" ::: "memory");
}
__device__ __forceinline__ void p0_matrix(Frame& F, const float* W, int K, int N, bf16* WT, bool inter, int& itbase) {
    const int gw = F.vcu * NWAVES + F.wave, NGW = F.G * NWAVES, nit = (K / 64) * (N / 32);
    LAS float* scr = (LAS float*)(F.lds + F.wave * 16384);
    int first = (gw - itbase) % NGW; if (first < 0) first += NGW;
    for (int it = first; it < nit; it += NGW) p0_transpose_item(W, K, N, WT, scr, it, F.lane, inter);
    itbase += nit;
}

#ifndef REP_PROMPT
#define REP_PROMPT 1
#endif
#ifndef REP_PROMPT_SSD
#define REP_PROMPT_SSD REP_PROMPT
#endif
#ifndef REP_PROMPT_HG
#define REP_PROMPT_HG REP_PROMPT
#endif
#ifndef REP_SAMPLE
#define REP_SAMPLE 1
#endif
#ifndef REP_GEMM
#define REP_GEMM 1
#endif
#ifndef REP_GN
#define REP_GN 1
#endif
#ifndef REP_P0
#define REP_P0 1
#endif
#ifndef REP_SKINNY
#define REP_SKINNY 1
#endif
#define REPEAT(n) _Pragma("unroll 1") for (int rep_ = 0; rep_ < (n); ++rep_)
struct Args { const float* in[30]; float* out; unsigned char* ws; int ph_lo, ph_hi; };
enum { I_XP = 0, I_XS, I_CP, I_CS, I_SRET, I_SSSD, I_SCONV, I_SHG, I_WADA, I_BADA, I_NMPRE, I_NMPOST, I_NFPRE, I_NFPOST, I_RETIN, I_RETOUT, I_SSDIN, I_CONVW, I_CONVB, I_DTB, I_ALOG, I_SSDD,
       I_SSDNORM, I_SSDOUT, I_HGIN, I_HGLB, I_HGNORM, I_HGOUT, I_FFNIN, I_FFNOUT };
constexpr int N_PHASES = 3 + 8 * 4;

__global__ void __launch_bounds__(NWAVES * 64, 2) mk_fwd(Args args) {
    extern __shared__ __attribute__((aligned(16))) unsigned char lds_raw[];
    Frame F;
    F.lds = (LAS unsigned char*)lds_raw;
    F.tid = threadIdx.x; F.lane = F.tid & 63; F.wave = __builtin_amdgcn_readfirstlane(F.tid >> 6);
    F.G = gridDim.x; { const int bx = blockIdx.x; F.vcu = (F.G % 8 == 0) ? (bx % 8) * (F.G / 8) + bx / 8 : bx; }
    unsigned char* ws = args.ws;
    gu32* ctl = (gu32*)(ws + WS_CTL);
    for (int u = F.tid; u < (LDS_BYTES - LDSCTL_OFF) / 4; u += NWAVES * 64) ((LAS unsigned*)(F.lds + LDSCTL_OFF))[u] = 0u;
    __syncthreads();
    XcdBarrier bar; bar.bar = (unsigned*)(ctl + CW_BAR); bar.x = 0; bar.st = nullptr;
    if (MK_N_LAUNCHES == 1) bar = xcd_barrier_post((unsigned*)(ctl + CW_BAR), (volatile LAS unsigned*)(F.lds + LDSCTL_OFF) + 8);
    const int lo = args.ph_lo, hi = args.ph_hi;
#define IN(k) (lo <= (k) && (k) < hi)
#define SEAM(k) do { if (IN((k) + 1)) xcd_barrier(bar); } while (0)
#define INP(i) (args.in[i])
    float* const out = args.out;
    float* const X = out + O_Y;
    bf16* const Hb = (bf16*)(ws + WS_H); bf16* const RO = (bf16*)(ws + WS_RO); bf16* const GO = (bf16*)(ws + WS_GO); bf16* const OUTB = (bf16*)(ws + WS_OUT); bf16* const ACT = (bf16*)(ws + WS_ACT);
    float* const MOD = (float*)(ws + WS_MOD); float* const LB = (float*)(ws + WS_LB);
    bf16* const CACT = (bf16*)(ws + WS_CACT);
    bf16* const WADA = (bf16*)(ws + WS_WADA);
    unsigned char* const PJ = ws + WS_PROJ;

    if (IN(0)) { REPEAT(REP_P0) {
        int itb = 0;
#pragma unroll 1
        for (int l = 0; l < 4; ++l) p0_matrix(F, INP(I_WADA) + (size_t)l * D * NMOD, D, NMOD, WADA + (size_t)l * NMOD * D, false, itb);
#pragma unroll 1
        for (int j = 0; j < 2; ++j) p0_matrix(F, INP(I_RETIN) + (size_t)j * D * RET_IN, D, RET_IN, (bf16*)(ws + WS_WRETIN) + (size_t)j * RET_IN * D, false, itb);
#pragma unroll 1
        for (int j = 0; j < 2; ++j) p0_matrix(F, INP(I_RETOUT) + (size_t)j * 2048 * D, 2048, D, (bf16*)(ws + WS_WRETOUT) + (size_t)j * D * 2048, false, itb);
        p0_matrix(F, INP(I_SSDIN), D, SSD_IN, (bf16*)(ws + WS_WSSDIN), false, itb);
        p0_matrix(F, INP(I_SSDOUT), 2048, D, (bf16*)(ws + WS_WSSDOUT), false, itb);
        p0_matrix(F, INP(I_HGIN), D, HG_IN, (bf16*)(ws + WS_WHGIN), false, itb);
        p0_matrix(F, INP(I_HGOUT), D, D, (bf16*)(ws + WS_WHGOUT), false, itb);
#pragma unroll 1
        for (int l = 0; l < 4; ++l) p0_matrix(F, INP(I_FFNIN) + (size_t)l * D * FFN_IN, D, FFN_IN, (bf16*)(ws + WS_WFFNIN) + (size_t)l * FFN_IN * D, true, itb);
#pragma unroll 1
        for (int l = 0; l < 4; ++l) p0_matrix(F, INP(I_FFNOUT) + (size_t)l * DFF * D, DFF, D, (bf16*)(ws + WS_WFFNOUT) + (size_t)l * D * DFF, false, itb);
        for (int idx = F.vcu * 512 + F.tid; idx < 256 * 128; idx += F.G * 512) { const int row = idx >> 7, c8 = (idx & 127) * 8; v4u o = (v4u){0u, 0u, 0u, 0u};
            if (row < NCOND) { const float* src = row < BP ? INP(I_CP) + (size_t)row * D : INP(I_CS) + (size_t)(row - BP) * D;
                const f32x4 a = *(const GAS f32x4*)(src + c8), b = *(const GAS f32x4*)(src + c8 + 4); o = pack8v(silu4(a), silu4(b)); }
            *(GAS v4u*)(CACT + (size_t)row * D + c8) = o; }
        for (int idx = F.vcu * 512 + F.tid; idx < 1024; idx += F.G * 512) { const float* lg = INP(I_HGLB);
            const float l0 = lg[idx], l1 = lg[1024 + idx], l2 = lg[2048 + idx], l3 = lg[3072 + idx], m = fmaxf(fmaxf(l0, l1), fmaxf(l2, l3));
            const float e0 = expf(l0 - m), e1 = expf(l1 - m), e2 = expf(l2 - m), e3 = expf(l3 - m); LB[idx] = (e1 + e2) / ((e0 + e1) + (e2 + e3)); }
        }
        SEAM(0);
    }
    if (IN(1)) {
        const EmitMod E{MOD, INP(I_BADA)};
        REPEAT(REP_SKINNY) skinny_gemm<8>(F, CACT, D, 2, NCOND, 0, WADA, (NMODALL / 256) * 8, false, E, 0, F.G);
        SEAM(1);
    }
    if (IN(2)) {
        resnorm_phase<0>(F, INP(I_XP), INP(I_XS), X, nullptr, Hb, MOD, nullptr, 0, INP(I_NMPRE), 0 * NMOD + 0 * D, 0 * NMOD + 1 * D);
        SEAM(2);
    }

#define MAIN_GEMM(EmitT, eobj, Aptr, Btptr, N_, K_) do { pg8::Gemm g_{(const pg8::bf16_t*)(Aptr), (const pg8::bf16_t*)(Btptr), MPR, (N_), (K_)}; pg8::StaticOrder S_; S_.init(MPR, (N_), F.G, (int)blockIdx.x); \
        const EpiGen<EmitT> E_{eobj}; _Pragma("unroll") for (int rg_ = 0; rg_ < REP_GEMM; ++rg_) pg8::gemm_phase<EpiGen<EmitT>, pg8::StaticOrder, PG8_ALIGN, PG8_SP2>(F.lds, g_, S_, E_); } while (0)
#define FFN_BLOCK(L, pb, LASTL) do { \
    if (IN((pb) + 4)) { resnorm_phase<1>(F, nullptr, nullptr, X, OUTB, Hb, MOD, INP(I_NMPOST) + (L) * D, (L) * NMOD + 2 * D, INP(I_NFPRE) + (L) * D, (L) * NMOD + 3 * D, (L) * NMOD + 4 * D); SEAM((pb) + 4); } \
    if (IN((pb) + 5)) { const bf16* wt_ = (const bf16*)(ws + WS_WFFNIN) + (size_t)(L) * FFN_IN * D; const EmitFfnIn e_{ACT}; \
        MAIN_GEMM(EmitFfnIn, e_, Hb, wt_, FFN_IN, D); REPEAT(REP_SKINNY) skinny_gemm<8>(F, Hb + (size_t)MPR * D, D, 1, MS, MPR, wt_, (FFN_IN / 256) * 8, false, e_, F.G / 2, F.G / 2); SEAM((pb) + 5); } \
    if (IN((pb) + 6)) { const bf16* wt_ = (const bf16*)(ws + WS_WFFNOUT) + (size_t)(L) * D * DFF; const EmitOut e_{OUTB}; \
        MAIN_GEMM(EmitOut, e_, ACT, wt_, D, DFF); REPEAT(REP_SKINNY) skinny_gemm<4>(F, ACT + (size_t)MPR * DFF, DFF, 2, MS, MPR, wt_, (D / 256) * 8, false, e_, 0, F.G); SEAM((pb) + 6); } \
    if (IN((pb) + 7)) { if (LASTL) resnorm_phase<2>(F, nullptr, nullptr, X, OUTB, Hb, MOD, INP(I_NFPOST) + (L) * D, (L) * NMOD + 5 * D, nullptr, 0, 0); \
        else resnorm_phase<1>(F, nullptr, nullptr, X, OUTB, Hb, MOD, INP(I_NFPOST) + (L) * D, (L) * NMOD + 5 * D, INP(I_NMPRE) + ((L) + 1) * D, ((L) + 1) * NMOD + 0 * D, ((L) + 1) * NMOD + 1 * D); \
        if (!(LASTL)) SEAM((pb) + 7); } } while (0)
#define OUT_PROJ(pb, wt, K_) do { if (IN((pb) + 3)) { const EmitOut e_{OUTB}; MAIN_GEMM(EmitOut, e_, GO, (wt), D, (K_)); REPEAT(REP_SKINNY) skinny_gemm<4>(F, GO + (size_t)MPR * (K_), (K_), 2, MS, MPR, (wt), (D / 256) * 8, false, e_, 0, F.G); SEAM((pb) + 3); } } while (0)
#define RET_LAYER(L, J, pb) do { \
    bf16* const Qp_ = (bf16*)(PJ + PJ_RET_Q); bf16* const Kp_ = (bf16*)(PJ + PJ_RET_K); bf16* const Vp_ = (bf16*)(PJ + PJ_RET_V); bf16* const SGp_ = (bf16*)(PJ + PJ_RET_SG); \
    if (IN((pb) + 0)) { const bf16* wt_ = (const bf16*)(ws + WS_WRETIN) + (size_t)(J) * RET_IN * D; const EmitRetIn e_{Qp_, Kp_, Vp_, SGp_}; \
        MAIN_GEMM(EmitRetIn, e_, Hb, wt_, RET_IN, D); REPEAT(REP_SKINNY) skinny_gemm<8>(F, Hb + (size_t)MPR * D, D, 1, MS, MPR, wt_, (RET_IN / 256) * 8, false, e_, 0, F.G); SEAM((pb) + 0); } \
    if (IN((pb) + 1)) { REPEAT(REP_PROMPT) for (int item = F.vcu; item < 256; item += F.G) ret_prompt_item(F, item, Qp_, Kp_, Vp_, RO, out + O_RETP + (size_t)(J) * 8 * 4 * 256 * 512); \
        REPEAT(REP_SAMPLE) ret_sample_items(F, Qp_, Kp_, Vp_, RO, INP(I_SRET) + (size_t)(J) * 128 * 4 * 256 * 512, out + O_RETS + (size_t)(J) * 128 * 4 * 256 * 512); SEAM((pb) + 1); } \
    if (IN((pb) + 2)) { REPEAT(REP_GN) gatenorm_phase<0>(F, RO, SGp_, GO, nullptr); SEAM((pb) + 2); } \
    OUT_PROJ(pb, (const bf16*)(ws + WS_WRETOUT) + (size_t)(J) * D * 2048, 2048); \
    } while (0)

    RET_LAYER(0, 0, 3);
    FFN_BLOCK(0, 3, false);
    {
        constexpr int pb = 11;
        bf16* const SZ_ = (bf16*)(PJ + PJ_SSD_SZ); bf16* const XBC_ = (bf16*)(PJ + PJ_SSD_XBC); float* const DT_ = (float*)(PJ + PJ_SSD_DT);
        if (IN(pb + 0)) { const bf16* wt_ = (const bf16*)(ws + WS_WSSDIN); const EmitSsdIn e_{SZ_, XBC_}; const EmitDt ed_{DT_};
            MAIN_GEMM(EmitSsdIn, e_, Hb, wt_, SSD_INM, D);
            REPEAT(REP_SKINNY) skinny_gemm<8>(F, Hb + (size_t)MPR * D, D, 1, MS, MPR, wt_, (SSD_INM / 256) * 8, false, e_, 0, F.G);
            REPEAT(REP_SKINNY) skinny_gemm<8>(F, Hb, D, MT / 128, MT, 0, wt_, 1, true, ed_, 100, 129);
            SEAM(pb + 0); }
        if (IN(pb + 1)) {
            REPEAT(REP_PROMPT_SSD) for (int item = F.vcu; item < 256; item += F.G) ssd_prompt_item(F, item, XBC_, DT_, RO, out + O_SSDP, INP(I_CONVW), INP(I_CONVB), INP(I_DTB), INP(I_ALOG), INP(I_SSDD));
            REPEAT(REP_SAMPLE) ssd_sample_items(F, XBC_, DT_, RO, INP(I_SSSD), out + O_SSDS, INP(I_SCONV), INP(I_CONVW), INP(I_CONVB), INP(I_DTB), INP(I_ALOG), INP(I_SSDD));
            ssd_conv_out(F, XBC_, INP(I_SCONV), out + O_CONVP, out + O_CONVS);
            SEAM(pb + 1); }
        if (IN(pb + 2)) { REPEAT(REP_GN) gatenorm_phase<1>(F, RO, SZ_, GO, INP(I_SSDNORM)); SEAM(pb + 2); }
        OUT_PROJ(pb, (const bf16*)(ws + WS_WSSDOUT), 2048);
    }
    FFN_BLOCK(1, 11, false);
    {
        constexpr int pb = 19;
        bf16* const HQ_ = (bf16*)(PJ + PJ_HG_Q); float* const LA_ = (float*)(PJ + PJ_HG_LA); bf16* const HV_ = (bf16*)(PJ + PJ_HG_V); bf16* const HSG_ = (bf16*)(PJ + PJ_HG_SG);
        if (IN(pb + 0)) { const bf16* wt_ = (const bf16*)(ws + WS_WHGIN); const EmitHgIn e_{HQ_, HV_, HSG_, LA_, LB};
            MAIN_GEMM(EmitHgIn, e_, Hb, wt_, HG_IN, D); REPEAT(REP_SKINNY) skinny_gemm<8>(F, Hb + (size_t)MPR * D, D, 1, MS, MPR, wt_, (HG_IN / 256) * 8, false, e_, 0, F.G); SEAM(pb + 0); }
        if (IN(pb + 1)) {
            REPEAT(REP_PROMPT_HG) for (int item = F.vcu; item < 256; item += F.G) hg_prompt_item(F, item, HQ_, LA_, HV_, RO, out + O_HGP);
            REPEAT(REP_SAMPLE) hg_sample_items(F, HQ_, LA_, HV_, RO, INP(I_SHG), out + O_HGS);
            SEAM(pb + 1); }
        if (IN(pb + 2)) { REPEAT(REP_GN) gatenorm_phase<2>(F, RO, HSG_, GO, INP(I_HGNORM)); SEAM(pb + 2); }
        OUT_PROJ(pb, (const bf16*)(ws + WS_WHGOUT), 1024);
    }
    FFN_BLOCK(2, 19, false);
    RET_LAYER(3, 1, 27);
    FFN_BLOCK(3, 27, true);
#undef IN
#undef SEAM
}

extern "C" void kernel_launch(void* const* d_in, const int* in_sizes, int n_in, void* d_out, int out_size, void* d_ws, size_t ws_size, hipStream_t stream) {
    static int grid = 0;
    if (grid == 0) {
        if (n_in != 30 || (size_t)out_size != O_END || ws_size < WS_END) { fprintf(stderr, "kernel_launch: unexpected shapes (n_in %d out %d ws %zu)\n", n_in, out_size, ws_size); grid = -1; return; }
        int dev = 0, cus = 0, per_cu = 0;
        if (hipGetDevice(&dev) != hipSuccess || hipDeviceGetAttribute(&cus, hipDeviceAttributeMultiprocessorCount, dev) != hipSuccess) { grid = -1; return; }
        if (hipFuncSetAttribute((const void*)mk_fwd, hipFuncAttributeMaxDynamicSharedMemorySize, LDS_BYTES) != hipSuccess) { fprintf(stderr, "kernel_launch: hipFuncSetAttribute failed\n"); grid = -1; return; }
        if (hipOccupancyMaxActiveBlocksPerMultiprocessor(&per_cu, (const void*)mk_fwd, NWAVES * 64, LDS_BYTES) != hipSuccess || per_cu < 1) { fprintf(stderr, "kernel_launch: occupancy query says %d\n", per_cu); }
        (void)hipGetLastError();
        grid = cus;
    }
    if (grid < 0) return;
    if (hipMemsetAsync((char*)d_ws + WS_CTL, 0, CTL_ZERO_BYTES, stream) != hipSuccess) { fprintf(stderr, "kernel_launch: memset failed\n"); return; }
    Args a{};
    for (int i = 0; i < 30; ++i) a.in[i] = (const float*)d_in[i];
    a.out = (float*)d_out; a.ws = (unsigned char*)d_ws;
#if MK_N_LAUNCHES == 1
    a.ph_lo = 0; a.ph_hi = N_PHASES;
    hipLaunchKernelGGL(mk_fwd, dim3(grid), dim3(NWAVES * 64), LDS_BYTES, stream, a);
#else
    for (int p = 0; p < N_PHASES; ++p) { a.ph_lo = p; a.ph_hi = p + 1; hipLaunchKernelGGL(mk_fwd, dim3(grid), dim3(NWAVES * 64), LDS_BYTES, stream, a); }
#endif
    const hipError_t le = hipPeekAtLastError();
    if (le != hipSuccess) fprintf(stderr, "kernel_launch: launch failed: %s\n", hipGetErrorName(le));
}
```

```cpp
#include <hip/hip_runtime.h>
#include <cstdio>
#include <cstdint>
namespace pg8 {
#define PG8_LAS __attribute__((address_space(3)))
typedef unsigned short bf16_t;
typedef short bf16x8 __attribute__((ext_vector_type(8)));
typedef float f32x4 __attribute__((ext_vector_type(4)));
typedef unsigned u32x4 __attribute__((ext_vector_type(4)));
constexpr int BM = 256, BK = 64, HALF = 128, HTB = HALF * BK * 2  , STAGE_BYTES = 8 * HTB, NXCD = 8, WGM = 8;

__host__ __device__ __forceinline__ int lds_byte(int r, int c) { const int st = (r >> 4) * 2 + (c >> 5), rr = r & 15, cc = c & 31, ob = rr * 64 + cc * 2; return st * 1024 + (ob ^ (((ob >> 9) & 1) << 5)); }
__host__ __device__ __forceinline__ void stage_rc(int b, int& R, int& C) { const int st = b / 1024, sb = b % 1024, swz = sb ^ (((sb >> 9) & 1) << 5); R = (st >> 1) * 16 + swz / 64; C = (st & 1) * 32 + (swz % 64) / 2; }
__host__ __device__ __forceinline__ int perm32(int rho) { const int n = rho >> 4, i = rho & 15; return 8 * (i >> 2) + 4 * n + (i & 3); }

struct Unit { int pm, pn; };
struct Gemm { const bf16_t* A; const bf16_t* Bt; int M, N, K; };

struct StaticOrder {
    int nM, nN, nwg, G, c;
    __host__ __device__ void init(int M, int N, int G_, int c_) { nM = M / BM; nN = N / BM; nwg = nM * nN; G = G_; c = c_; }
    __host__ __device__ bool next(int i, Unit& u) const {
        const long L = (long)i * G + c; if (L >= nwg) return false;
        int wgid = (int)L; { const int q = nwg / NXCD, r = nwg % NXCD, xcd = wgid % NXCD, off = wgid / NXCD; wgid = (xcd < r ? xcd * (q + 1) : r * (q + 1) + (xcd - r) * q) + off; }
        const int nig = WGM * nN, gid = wgid / nig, fm = gid * WGM, gsz = (nM - fm) < WGM ? (nM - fm) : WGM;
        u.pm = fm + ((wgid % nig) % gsz); u.pn = (wgid % nig) / gsz; return true;
    }
    __device__ __forceinline__ void a_ready(const Unit&) const {}
    __device__ __forceinline__ void done(const Unit&) const {}
};

__device__ __forceinline__ unsigned cvt_pk_bf16(float lo, float hi) { unsigned r; asm volatile("v_cvt_pk_bf16_f32 %0, %1, %2" : "=v"(r) : "v"(lo), "v"(hi)); return r; }
typedef float f32x2 __attribute__((ext_vector_type(2)));
template <class Epi, class Sched, bool ALIGN_EPI = false, bool SP2 = false>
__device__ __forceinline__ void gemm_phase(PG8_LAS unsigned char* lds, const Gemm g, const Sched& S, const Epi& E) {
    const int tid = threadIdx.x, wid = __builtin_amdgcn_readfirstlane(tid >> 6), lane = tid & 63, wr = wid >> 2, wc = wid & 3, fr = lane & 15, fq = lane >> 4;
    const int K = g.K, nt = K / BK;
    unsigned voffA[2], voffB[2];
#pragma unroll
    for (int i = 0; i < 2; ++i) { int R, C; stage_rc(tid * 16 + i * 8192, R, C); const int Rb = Epi::PERM ? ((R & ~31) + perm32(R & 31)) : R;
        voffA[i] = (unsigned)(R * K + C) * 2u; voffB[i] = (unsigned)(Rb * K + C) * 2u; }
    const size_t kstep = (size_t)(BK * 2);
    const size_t hstep = (size_t)HALF * K * 2;
    const size_t tstep = 2 * hstep;
    const unsigned ldsw = (unsigned)wid * 1024u;
    const int aoff = lds_byte(wr * 64 + fr, fq * 8), boff = lds_byte(wc * 32 + fr, fq * 8);
#define PG8_SA(b, h) (((b) * 2 + (h)) * HTB)
#define PG8_SB(b, h) ((4 + (b) * 2 + (h)) * HTB)
#define PG8_STAGE(bufoff, gbase, voff) do { _Pragma("unroll") for (int _i = 0; _i < 2; ++_i) \
        __builtin_amdgcn_global_load_lds((const unsigned*)((const char*)(gbase) + (voff)[_i]), (PG8_LAS unsigned*)(lds + (bufoff) + ldsw + _i * 8192), 16, 0, 0); } while (0)
#define PG8_LDA(dst, b, h) do { _Pragma("unroll") for (int m = 0; m < 4; ++m) _Pragma("unroll") for (int k = 0; k < 2; ++k) dst[m][k] = *(const PG8_LAS bf16x8*)(lds + PG8_SA(b, h) + aoff + m * 2048 + k * 1024); } while (0)
#define PG8_LDB(dst, b, h) do { _Pragma("unroll") for (int n = 0; n < 2; ++n) _Pragma("unroll") for (int k = 0; k < 2; ++k) dst[n][k] = *(const PG8_LAS bf16x8*)(lds + PG8_SB(b, h) + boff + n * 2048 + k * 1024); } while (0)
#define PG8_MMA(ai, bj, At, Bt) do { __builtin_amdgcn_s_setprio(1); _Pragma("unroll") for (int m = 0; m < 4; ++m) _Pragma("unroll") for (int n = 0; n < 2; ++n) _Pragma("unroll") for (int k = 0; k < 2; ++k) \
        acc[ai][bj][m][n] = __builtin_amdgcn_mfma_f32_16x16x32_bf16(Bt[n][k], At[m][k], acc[ai][bj][m][n], 0, 0, 0); __builtin_amdgcn_s_setprio(0); } while (0)
#define PG8_WAIT_V(n) asm volatile("s_waitcnt vmcnt(" #n ")" ::: "memory")
#define PG8_WAIT_L(n) asm volatile("s_waitcnt lgkmcnt(" #n ")" ::: "memory")
#define PG8_BAR __builtin_amdgcn_s_barrier()
#define PG8_SCHED __builtin_amdgcn_sched_barrier(0)
    Unit cur, nxt; int ui = 0;
    if (!S.next(0, cur)) return;
    f32x4 acc[2][2][4][2];
#pragma unroll
    for (int a = 0; a < 2; ++a)
#pragma unroll
        for (int b = 0; b < 2; ++b)
#pragma unroll
            for (int m = 0; m < 4; ++m)
#pragma unroll
                for (int n = 0; n < 2; ++n) acc[a][b][m][n] = (f32x4){0.f, 0.f, 0.f, 0.f};
    bf16x8 At[4][2], B0[2][2], B1[2][2];
    const char* cA = (const char*)g.A + (size_t)cur.pm * tstep; const char* cB = (const char*)g.Bt + (size_t)cur.pn * tstep;
    S.a_ready(cur);
    if constexpr (SP2) {
        PG8_STAGE(PG8_SB(0, 0), cB, voffB); PG8_STAGE(PG8_SB(0, 1), cB + hstep, voffB); PG8_STAGE(PG8_SA(0, 0), cA, voffA); PG8_STAGE(PG8_SA(0, 1), cA + hstep, voffA);
        if (wr == 1) PG8_BAR;
        PG8_WAIT_V(2); PG8_BAR;
        PG8_STAGE(PG8_SB(1, 0), cB + kstep, voffB); PG8_STAGE(PG8_SA(1, 0), cA + kstep, voffA); PG8_STAGE(PG8_SB(1, 1), cB + hstep + kstep, voffB);
        PG8_WAIT_V(6); PG8_BAR;
    } else {
        PG8_STAGE(PG8_SB(0, 0), cB, voffB); PG8_STAGE(PG8_SA(0, 0), cA, voffA); PG8_STAGE(PG8_SB(0, 1), cB + hstep, voffB); PG8_STAGE(PG8_SA(0, 1), cA + hstep, voffA);
        if (wr == 1) PG8_BAR;
        PG8_WAIT_V(4); PG8_BAR;
        PG8_STAGE(PG8_SB(1, 0), cB + kstep, voffB); PG8_STAGE(PG8_SA(1, 0), cA + kstep, voffA); PG8_STAGE(PG8_SB(1, 1), cB + hstep + kstep, voffB);
        PG8_WAIT_V(6); PG8_BAR;
    }
    for (;;) {
        const bool has_next = S.next(ui + 1, nxt);
        const char* nA = has_next ? (const char*)g.A + (size_t)nxt.pm * tstep : cA; const char* nB = has_next ? (const char*)g.Bt + (size_t)nxt.pn * tstep : cB;
        for (int t = 0; t < nt; t += 2) {
            const bool last = (t == nt - 2);
            const char* a1 = cA + (size_t)(t + 1) * kstep;
            const char* a2 = last ? nA : cA + (size_t)(t + 2) * kstep; const char* b2 = last ? nB : cB + (size_t)(t + 2) * kstep;
            const char* a3 = a2 + kstep; const char* b3 = b2 + kstep;
            if (last && has_next) S.a_ready(nxt);
            if constexpr (SP2) {
            PG8_LDB(B0, 0, 0); PG8_LDB(B1, 0, 1); PG8_SCHED; PG8_LDA(At, 0, 0); PG8_STAGE(PG8_SA(1, 1), a1 + hstep, voffA);
            PG8_WAIT_V(8); PG8_WAIT_L(0); PG8_BAR; PG8_MMA(0, 0, At, B0); PG8_MMA(0, 1, At, B1); PG8_BAR; PG8_SCHED;
            PG8_LDA(At, 0, 1); PG8_STAGE(PG8_SB(0, 0), b2, voffB); PG8_STAGE(PG8_SB(0, 1), b2 + hstep, voffB); PG8_STAGE(PG8_SA(0, 0), a2, voffA);
            PG8_WAIT_V(8); PG8_WAIT_L(0); PG8_BAR; PG8_MMA(1, 0, At, B0); PG8_MMA(1, 1, At, B1); PG8_BAR; PG8_SCHED;
            PG8_LDB(B0, 1, 0); PG8_LDB(B1, 1, 1); PG8_SCHED; PG8_LDA(At, 1, 0); PG8_STAGE(PG8_SA(0, 1), a2 + hstep, voffA);
            PG8_WAIT_V(8); PG8_WAIT_L(0); PG8_BAR; PG8_MMA(0, 0, At, B0); PG8_MMA(0, 1, At, B1); PG8_BAR; PG8_SCHED;
            PG8_LDA(At, 1, 1); PG8_STAGE(PG8_SB(1, 0), b3, voffB); PG8_STAGE(PG8_SB(1, 1), b3 + hstep, voffB); PG8_STAGE(PG8_SA(1, 0), a3, voffA);
            PG8_WAIT_V(8); PG8_WAIT_L(0); PG8_BAR; PG8_MMA(1, 0, At, B0); PG8_MMA(1, 1, At, B1); PG8_BAR; PG8_SCHED;
            } else {
            PG8_LDB(B0, 0, 0); PG8_SCHED; PG8_LDA(At, 0, 0); PG8_STAGE(PG8_SA(1, 1), a1 + hstep, voffA);
            PG8_WAIT_L(8); PG8_BAR; PG8_WAIT_L(0); PG8_MMA(0, 0, At, B0); PG8_BAR; PG8_SCHED;
            PG8_LDB(B1, 0, 1); PG8_STAGE(PG8_SB(0, 0), b2, voffB);
            PG8_BAR; PG8_WAIT_L(0); PG8_MMA(0, 1, At, B1); PG8_BAR;
            PG8_LDA(At, 0, 1); PG8_STAGE(PG8_SA(0, 0), a2, voffA);
            PG8_BAR; PG8_WAIT_L(0); PG8_MMA(1, 0, At, B0); PG8_BAR; PG8_SCHED;
            PG8_STAGE(PG8_SB(0, 1), b2 + hstep, voffB);
            PG8_WAIT_V(6); PG8_BAR; PG8_MMA(1, 1, At, B1); PG8_BAR;
            PG8_LDB(B0, 1, 0); PG8_SCHED; PG8_LDA(At, 1, 0); PG8_STAGE(PG8_SA(0, 1), a2 + hstep, voffA);
            PG8_WAIT_L(8); PG8_BAR; PG8_WAIT_L(0); PG8_MMA(0, 0, At, B0); PG8_BAR; PG8_SCHED;
            PG8_LDB(B1, 1, 1); PG8_STAGE(PG8_SB(1, 0), b3, voffB);
            PG8_BAR; PG8_WAIT_L(0); PG8_MMA(0, 1, At, B1); PG8_BAR;
            PG8_LDA(At, 1, 1); PG8_STAGE(PG8_SA(1, 0), a3, voffA);
            PG8_BAR; PG8_WAIT_L(0); PG8_MMA(1, 0, At, B0); PG8_BAR; PG8_SCHED;
            PG8_STAGE(PG8_SB(1, 1), b3 + hstep, voffB);
            PG8_WAIT_V(6); PG8_BAR; PG8_MMA(1, 1, At, B1); PG8_BAR;
            }
        }
        if constexpr (ALIGN_EPI) { if (wr == 0) PG8_BAR; }
        if constexpr (!Epi::AFTER_DRAIN) { E(acc, cur, wr, wc, fr, fq); S.done(cur); }
        if (!has_next) break;
#pragma unroll
        for (int a = 0; a < 2; ++a)
#pragma unroll
            for (int b = 0; b < 2; ++b)
#pragma unroll
                for (int m = 0; m < 4; ++m)
#pragma unroll
                    for (int n = 0; n < 2; ++n) acc[a][b][m][n] = (f32x4){0.f, 0.f, 0.f, 0.f};
        cur = nxt; cA = nA; cB = nB; ++ui;
        if constexpr (ALIGN_EPI) { if (wr == 1) PG8_BAR; }
    }
    PG8_WAIT_V(0);
    if constexpr (!ALIGN_EPI) { if (wr == 0) PG8_BAR; }
    PG8_BAR;
    if constexpr (Epi::AFTER_DRAIN) { E.fused(acc, cur, wr, wc, fr, fq, lds, wid, lane); S.done(cur); }
#undef PG8_SA
#undef PG8_SB
#undef PG8_STAGE
#undef PG8_LDA
#undef PG8_LDB
#undef PG8_MMA
#undef PG8_WAIT_V
#undef PG8_WAIT_L
#undef PG8_BAR
#undef PG8_SCHED
}
}

#ifndef PG8_SP2
#define PG8_SP2 true
#endif
#ifndef PG8_ALIGN
#define PG8_ALIGN true
#endif
#ifndef MK_N_LAUNCHES
#define MK_N_LAUNCHES 1
#endif

constexpr int D = 1024, BP = 8, SEQ = 2048, MPR = BP * SEQ  , MS = 128  , MT = MPR + MS  ;
constexpr int NCOND = BP + MS;
constexpr int DFF = 2816, NMOD = 6 * D  , NMODALL = 4 * NMOD  ;
constexpr int RET_IN = 6144, SSD_IN = 5152, SSD_INM = 5120, HG_IN = 4096, FFN_IN = 2 * DFF;
constexpr float EPS = 1e-6f;
constexpr int NWAVES = 8;

constexpr size_t MiB = 1u << 20;
constexpr size_t WS_CTL = 0, CTL_ZERO_BYTES = 1 * MiB;
constexpr size_t WS_WADA = 1 * MiB;
constexpr size_t WS_WRETIN = WS_WADA + 48 * MiB;
constexpr size_t WS_WRETOUT = WS_WRETIN + 24 * MiB;
constexpr size_t WS_WSSDIN = WS_WRETOUT + 8 * MiB;
constexpr size_t WS_WSSDOUT = WS_WSSDIN + 11 * MiB;
constexpr size_t WS_WHGIN = WS_WSSDOUT + 4 * MiB;
constexpr size_t WS_WHGOUT = WS_WHGIN + 8 * MiB;
constexpr size_t WS_WFFNIN = WS_WHGOUT + 2 * MiB;
constexpr size_t WS_WFFNOUT = WS_WFFNIN + 44 * MiB;
constexpr size_t WS_MOD = WS_WFFNOUT + 22 * MiB;
constexpr size_t WS_CACT = WS_MOD + 24 * MiB;
constexpr size_t WS_LB = WS_CACT + 512 * 1024;
constexpr size_t WS_H = WS_CACT + 1 * MiB;
constexpr size_t WS_PROJ = WS_H + 33 * MiB;
constexpr size_t WS_RO = WS_PROJ + 200 * MiB;
constexpr size_t WS_GO = WS_RO + 65 * MiB;
constexpr size_t WS_OUT = WS_GO + 65 * MiB;
constexpr size_t WS_ACT = WS_OUT + 33 * MiB;
constexpr size_t WS_END = WS_ACT + 89 * MiB;
constexpr size_t PJ_RET_Q = 0, PJ_RET_K = PJ_RET_Q + (size_t)MT * 1024 * 2, PJ_RET_V = PJ_RET_K + (size_t)MT * 1024 * 2, PJ_RET_SG = PJ_RET_V + (size_t)MT * 2048 * 2;
constexpr size_t PJ_SSD_SZ = 0, PJ_SSD_XBC = PJ_SSD_SZ + (size_t)MT * 2048 * 2, PJ_SSD_DT = PJ_SSD_XBC + (size_t)MT * 3072 * 2;
constexpr size_t PJ_HG_Q = 0, PJ_HG_LA = PJ_HG_Q + (size_t)MT * 1024 * 2, PJ_HG_V = PJ_HG_LA + (size_t)MT * 1024 * 4, PJ_HG_SG = PJ_HG_V + (size_t)MT * 1024 * 2;
static_assert(PJ_RET_SG + (size_t)MT * 2048 * 2 <= 200 * MiB && PJ_SSD_DT + (size_t)MT * 32 * 4 <= 200 * MiB && PJ_HG_SG + (size_t)MT * 1024 * 2 <= 200 * MiB, "proj map");
constexpr int CW_BAR = 4096;

constexpr size_t O_Y = 0;
constexpr size_t O_RETP = (size_t)MT * D;
constexpr size_t O_RETS = O_RETP + (size_t)2 * 8 * 4 * 256 * 512;
constexpr size_t O_SSDP = O_RETS + (size_t)2 * 128 * 4 * 256 * 512;
constexpr size_t O_SSDS = O_SSDP + (size_t)8 * 32 * 128 * 64;
constexpr size_t O_CONVP = O_SSDS + (size_t)128 * 32 * 128 * 64;
constexpr size_t O_CONVS = O_CONVP + (size_t)8 * 3 * 3072;
constexpr size_t O_HGP = O_CONVS + (size_t)128 * 3 * 3072;
constexpr size_t O_HGS = O_HGP + (size_t)8 * 8 * 128 * 128;
constexpr size_t O_END = O_HGS + (size_t)128 * 8 * 128 * 128;
static_assert(O_END == 214245376ull, "output size");

constexpr int LDS_BYTES = 147456;
constexpr int LDSCTL_OFF = LDS_BYTES - 1024;
constexpr int SCR_BYTES = LDSCTL_OFF;

#define GAS __attribute__((address_space(1)))
#define LAS __attribute__((address_space(3)))
typedef unsigned short bf16;
typedef unsigned v4u __attribute__((ext_vector_type(4)));
typedef unsigned v2u __attribute__((ext_vector_type(2)));
typedef float f32x4 __attribute__((ext_vector_type(4)));
typedef short bf16x8 __attribute__((ext_vector_type(8)));
typedef short s16x4 __attribute__((ext_vector_type(4)));
typedef GAS unsigned gu32;
#define RLX_AGENT __ATOMIC_RELAXED, __HIP_MEMORY_SCOPE_AGENT
#define LDS_WAIT() asm volatile("s_waitcnt lgkmcnt(0)" ::: "memory")
#define VM_WAIT() asm volatile("s_waitcnt vmcnt(0)" ::: "memory")
typedef float f32x2_t __attribute__((ext_vector_type(2))); typedef __bf16 bf16x2_t __attribute__((ext_vector_type(2)));
__device__ __forceinline__ unsigned cvt_pk_bf16(float lo, float hi) { f32x2_t v = {lo, hi}; bf16x2_t b = __builtin_convertvector(v, bf16x2_t); return __builtin_bit_cast(unsigned, b); }
__device__ __forceinline__ float bf2f(unsigned b) { return __uint_as_float(b << 16); }
__device__ __forceinline__ float bflo(unsigned w) { return __uint_as_float(w << 16); }
__device__ __forceinline__ float bfhi(unsigned w) { return __uint_as_float(w & 0xffff0000u); }
__device__ __forceinline__ void unpack8(const v4u w, float (&f)[8]) { f[0] = bflo(w.x); f[1] = bfhi(w.x); f[2] = bflo(w.y); f[3] = bfhi(w.y); f[4] = bflo(w.z); f[5] = bfhi(w.z); f[6] = bflo(w.w); f[7] = bfhi(w.w); }
__device__ __forceinline__ v4u pack8(const float (&f)[8]) { v4u w; w.x = cvt_pk_bf16(f[0], f[1]); w.y = cvt_pk_bf16(f[2], f[3]); w.z = cvt_pk_bf16(f[4], f[5]); w.w = cvt_pk_bf16(f[6], f[7]); return w; }
__device__ __forceinline__ v4u pack8v(const f32x4 a, const f32x4 b) { v4u w; w.x = cvt_pk_bf16(a[0], a[1]); w.y = cvt_pk_bf16(a[2], a[3]); w.z = cvt_pk_bf16(b[0], b[1]); w.w = cvt_pk_bf16(b[2], b[3]); return w; }
__device__ __forceinline__ v2u pack4v(const f32x4 a) { v2u w; w.x = cvt_pk_bf16(a[0], a[1]); w.y = cvt_pk_bf16(a[2], a[3]); return w; }
__device__ __forceinline__ float sigmoidf_(float x) { return __builtin_amdgcn_rcpf(1.f + __expf(-x)); }
__device__ __forceinline__ float siluf_(float x) { return x * sigmoidf_(x); }
__device__ __forceinline__ float softplusf_(float x) { return x > 20.f ? x : log1pf(__expf(x)); }
__device__ __forceinline__ float wave_sum(float v) {
#pragma unroll
    for (int o = 1; o < 64; o <<= 1) v += __shfl_xor(v, o);
    return v;
}
__device__ __forceinline__ float grp16_sum(float v) {
#pragma unroll
    for (int o = 1; o < 16; o <<= 1) v += __shfl_xor(v, o);
    return v;
}
#define MFMA16(a, b, c) __builtin_amdgcn_mfma_f32_16x16x32_bf16((a), (b), (c), 0, 0, 0)
#define XB_TMO      128
#define XB_XCNT(j)  (256  + 64 * (j))
#define XB_XSUB(j)  (1280 + 64 * (j))
#define XB_XGEN(j)  (2304 + 64 * (j))
#define XB_TOP      3328
#define XB_TOPGEN   3392
#define XCD_BAR_WORDS 3456
#define XB_SPIN_CAP (1u << 18)

__device__ __forceinline__ unsigned xb_ld(unsigned* p)              { return __hip_atomic_load(p, __ATOMIC_RELAXED, __HIP_MEMORY_SCOPE_AGENT); }
__device__ __forceinline__ unsigned xb_add(unsigned* p, unsigned v) { return __hip_atomic_fetch_add(p, v, __ATOMIC_RELAXED, __HIP_MEMORY_SCOPE_AGENT); }
__device__ __forceinline__ unsigned xb_xcc_id() { return (unsigned)__builtin_amdgcn_s_getreg((3 << 11) | 20) & 0xFu; }
#define XB_SPIN(cond, bar) do { unsigned _sp = 0; while (cond) { __builtin_amdgcn_s_sleep(1); \
    if ((++_sp & 255u) == 0u) { if (xb_ld(&(bar)[XB_TMO])) break; if (_sp > XB_SPIN_CAP) { atomicAdd(&(bar)[XB_TMO], 1u); break; } } } } while (0)

struct XcdBarrier {
    unsigned* bar; unsigned x;
    volatile LAS unsigned* st;
};

__device__ __forceinline__ XcdBarrier xcd_barrier_post(unsigned* bar, volatile LAS unsigned* st) {
    XcdBarrier b; b.bar = bar; b.x = xb_xcc_id(); b.st = st;
    if (threadIdx.x == 0) (void)xb_add(&bar[XB_XCNT(b.x)], 1u);
    return b;
}
__device__ __forceinline__ void xcd_barrier_complete(unsigned* bar, unsigned x, unsigned& nloc, unsigned& nx) {
    const unsigned G = gridDim.x * gridDim.y * gridDim.z;
    unsigned sum, cnt, mine, sp = 0u;
    for (;;) {
        sum = 0u; cnt = 0u; mine = 0u;
#pragma unroll
        for (unsigned j = 0; j < 16; ++j) { const unsigned c = xb_ld(&bar[XB_XCNT(j)]); sum += c; cnt += (c > 0u) ? 1u : 0u; mine = (j == x) ? c : mine; }
        if (sum == G) break;
        __builtin_amdgcn_s_sleep(1);
        if ((++sp & 255u) == 0u) { if (xb_ld(&bar[XB_TMO])) break; if (sp > XB_SPIN_CAP) { atomicAdd(&bar[XB_TMO], 1u); break; } }
    }
    nloc = mine > 0u ? mine : 1u; nx = cnt > 0u ? cnt : 1u;
}

__device__ __forceinline__ void xcd_barrier(const XcdBarrier& b) {
    asm volatile("s_waitcnt vmcnt(0)" ::: "memory");
    __syncthreads();
    if (threadIdx.x == 0) {
        unsigned* bar = b.bar;
        __builtin_amdgcn_s_waitcnt(0);
        unsigned nloc = b.st[0], nx = b.st[1];
        if (nloc == 0u) { xcd_barrier_complete(bar, b.x, nloc, nx); b.st[0] = nloc; b.st[1] = nx; }
        const unsigned old = xb_add(&bar[XB_XSUB(b.x)], 1u);
        const unsigned gen = old / nloc;
        if (old + 1u == (gen + 1u) * nloc) {
            __builtin_amdgcn_fence(__ATOMIC_RELEASE, "agent");
            asm volatile("s_waitcnt vmcnt(0)" ::: "memory");
            const unsigned og = xb_add(&bar[XB_TOP], 1u);
            const unsigned tg = og / nx;
            if (og + 1u == (tg + 1u) * nx) xb_add(&bar[XB_TOPGEN], 1u);
            else XB_SPIN(xb_ld(&bar[XB_TOPGEN]) == tg, bar);
            __builtin_amdgcn_fence(__ATOMIC_ACQUIRE, "agent");
            xb_add(&bar[XB_XGEN(b.x)], 1u);
            asm volatile("s_waitcnt vmcnt(0)" ::: "memory");
        } else {
            XB_SPIN(xb_ld(&bar[XB_XGEN(b.x)]) == gen, bar);
            __builtin_amdgcn_fence(__ATOMIC_ACQUIRE, "agent");
            asm volatile("s_waitcnt vmcnt(0)" ::: "memory");
        }
    }
    __syncthreads();
}


struct Frame {
    LAS unsigned char* lds;
    int tid, lane, wave;
    int vcu, G;
};

template <class Fn> struct EpiGen {
    static constexpr bool PERM = true, AFTER_DRAIN = false;
    Fn f;
    __device__ __forceinline__ void operator()(const pg8::f32x4 (&acc)[2][2][4][2], const pg8::Unit& u, int wr, int wc, int fr, int fq) const {
        const int ca = u.pn * 256 + wc * 32 + 8 * fq;
#pragma unroll
        for (int ai = 0; ai < 2; ++ai)
#pragma unroll
            for (int m = 0; m < 4; ++m) {
                const int row = u.pm * 256 + ai * 128 + wr * 64 + m * 16 + fr;
                f.emit(row, ca, ca + 128, acc[ai][0][m][0], acc[ai][0][m][1], acc[ai][1][m][0], acc[ai][1][m][1]);
            }
    }
};
__device__ __forceinline__ void st8bf(bf16* p, const f32x4 a, const f32x4 b) { *(GAS v4u*)p = pack8v(a, b); }
__device__ __forceinline__ f32x4 silu4(const f32x4 a) { f32x4 r; r[0] = siluf_(a[0]); r[1] = siluf_(a[1]); r[2] = siluf_(a[2]); r[3] = siluf_(a[3]); return r; }

struct EmitRetIn {
    bf16 *Q, *K, *V, *SG;
    __device__ __forceinline__ void emit(int row, int ca, int cb, const f32x4 a0, const f32x4 a1, const f32x4 b0, const f32x4 b1) const {
        const int pn = ca >> 8, ch = ca & 255;
        if (pn < 8) {
            const float pos = row < MPR ? (float)(row & (SEQ - 1)) : 16384.f;
            const float sc = pn < 4 ? 1.f : 0.0625f;
            float x1[8] = {a0[0], a0[1], a0[2], a0[3], a1[0], a1[1], a1[2], a1[3]}, x2[8] = {b0[0], b0[1], b0[2], b0[3], b1[0], b1[1], b1[2], b1[3]}, o1[8], o2[8];
#pragma unroll
            for (int e = 0; e < 8; ++e) {
                const float inv = exp2f(-(float)(ch + e) * (13.287712379549449f / 128.f));
                float t = pos * inv * 0.15915494309189535f; t -= floorf(t);
                const float s = __builtin_amdgcn_sinf(t), c = __builtin_amdgcn_cosf(t);
                o1[e] = (x1[e] * c - x2[e] * s) * sc; o2[e] = (x2[e] * c + x1[e] * s) * sc;
            }
            bf16* dst = (pn < 4 ? Q : K) + (size_t)row * 1024 + (pn & 3) * 256 + ch;
            *(GAS v4u*)dst = pack8(o1); *(GAS v4u*)(dst + 128) = pack8(o2);
        } else if (pn < 16) {
            bf16* dst = V + (size_t)row * 2048 + (pn - 8) * 256 + ch; st8bf(dst, a0, a1); st8bf(dst + 128, b0, b1);
        } else {
            bf16* dst = SG + (size_t)row * 2048 + (pn - 16) * 256 + ch; st8bf(dst, silu4(a0), silu4(a1)); st8bf(dst + 128, silu4(b0), silu4(b1));
        }
    }
};
struct EmitSsdIn {
    bf16 *SZ, *XBC;
    __device__ __forceinline__ void emit(int row, int ca, int cb, const f32x4 a0, const f32x4 a1, const f32x4 b0, const f32x4 b1) const {
        const int pn = ca >> 8, ch = ca & 255;
        if (pn < 8) { bf16* dst = SZ + (size_t)row * 2048 + pn * 256 + ch; st8bf(dst, silu4(a0), silu4(a1)); st8bf(dst + 128, silu4(b0), silu4(b1)); }
        else { bf16* dst = XBC + (size_t)row * 3072 + (pn - 8) * 256 + ch; st8bf(dst, a0, a1); st8bf(dst + 128, b0, b1); }
    }
};
struct EmitDt {
    float* DT;
    __device__ __forceinline__ void emit(int row, int ca, int cb, const f32x4 a0, const f32x4 a1, const f32x4 b0, const f32x4 b1) const {
        float* d = DT + (size_t)row * 32; *(GAS f32x4*)(d + (ca - SSD_INM)) = a0; *(GAS f32x4*)(d + (ca - SSD_INM) + 4) = a1; *(GAS f32x4*)(d + (cb - SSD_INM)) = b0; *(GAS f32x4*)(d + (cb - SSD_INM) + 4) = b1;
    }
};
struct EmitHgIn {
    bf16 *HQ, *HV, *HSG; float* LA; const float* lb;
    __device__ __forceinline__ f32x4 logf4(const f32x4 x, const float* l) const { f32x4 r;
#pragma unroll
        for (int e = 0; e < 4; ++e) { const float b = l[e]; r[e] = logf(b + (1.f - b) * sigmoidf_(x[e])); } return r; }
    __device__ __forceinline__ void emit(int row, int ca, int cb, const f32x4 a0, const f32x4 a1, const f32x4 b0, const f32x4 b1) const {
        const int pn = ca >> 8, ch = ca & 255;
        if (pn < 4) { bf16* dst = HQ + (size_t)row * 1024 + pn * 256 + ch; const float s = 0.08838834764831845f; st8bf(dst, silu4(a0) * s, silu4(a1) * s); st8bf(dst + 128, silu4(b0) * s, silu4(b1) * s); }
        else if (pn < 8) { const int col = (pn - 4) * 256 + ch; float* dst = LA + (size_t)row * 1024 + col;
            *(GAS f32x4*)dst = logf4(a0, lb + col); *(GAS f32x4*)(dst + 4) = logf4(a1, lb + col + 4); *(GAS f32x4*)(dst + 128) = logf4(b0, lb + col + 128); *(GAS f32x4*)(dst + 132) = logf4(b1, lb + col + 132); }
        else if (pn < 12) { bf16* dst = HV + (size_t)row * 1024 + (pn - 8) * 256 + ch; st8bf(dst, a0, a1); st8bf(dst + 128, b0, b1); }
        else { bf16* dst = HSG + (size_t)row * 1024 + (pn - 12) * 256 + ch; st8bf(dst, silu4(a0), silu4(a1)); st8bf(dst + 128, silu4(b0), silu4(b1)); }
    }
};
struct EmitOut {
    bf16* OUT;
    __device__ __forceinline__ void emit(int row, int ca, int cb, const f32x4 a0, const f32x4 a1, const f32x4 b0, const f32x4 b1) const {
        bf16* dst = OUT + (size_t)row * 1024; st8bf(dst + ca, a0, a1); st8bf(dst + cb, b0, b1);
    }
};
struct EmitFfnIn {
    bf16* ACT;
    __device__ __forceinline__ void emit(int row, int ca, int cb, const f32x4 a0, const f32x4 a1, const f32x4 b0, const f32x4 b1) const {
        bf16* dst = ACT + (size_t)row * DFF + (ca >> 8) * 128 + (ca & 255); st8bf(dst, silu4(a0) * b0, silu4(a1) * b1);
    }
};
struct EmitMod {
    float* MOD; const float* bias;
    __device__ __forceinline__ void emit(int row, int ca, int cb, const f32x4 a0, const f32x4 a1, const f32x4 b0, const f32x4 b1) const {
        float* d = MOD + (size_t)row * NMODALL;
        *(GAS f32x4*)(d + ca) = a0 + *(const GAS f32x4*)(bias + ca); *(GAS f32x4*)(d + ca + 4) = a1 + *(const GAS f32x4*)(bias + ca + 4);
        *(GAS f32x4*)(d + cb) = b0 + *(const GAS f32x4*)(bias + cb); *(GAS f32x4*)(d + cb + 4) = b1 + *(const GAS f32x4*)(bias + cb + 4);
    }
};

template <int NMT, class Fn>
__device__ __forceinline__ void skinny_gemm(Frame& F, const bf16* A, int K, int nrg, int nrows, int rowbase, const bf16* Bt, int ncu, bool dtmode, const Fn& f, int wg0, int span) {
    const int w = F.wave, lane = F.lane, fr = lane & 15, fq = lane >> 4, KW = K >> 3, nsteps = KW >> 5;
    constexpr int R = NMT * 16;
    LAS unsigned char* red = F.lds;
    const int nun = nrg * ncu, me = (int)blockIdx.x - wg0;
    if (me >= 0 && me < span) {
    for (int u = me; u < nun; u += span) {
        const int rg = u / ncu, cu = u - rg * ncu;
        int ca, cb; if (dtmode) { ca = SSD_INM; cb = SSD_INM + 16; } else { ca = 256 * (cu >> 3) + 16 * (cu & 7); cb = ca + 128; }
        int nact = (nrows - rg * R + 15) >> 4; nact = nact > NMT ? NMT : nact;
        const bf16* ap = A + (size_t)(rg * R + fr) * K + w * KW + fq * 8;
        const bf16* bpa = Bt + (size_t)(ca + fr) * K + w * KW + fq * 8;
        const bf16* bpb = Bt + (size_t)(cb + fr) * K + w * KW + fq * 8;
        f32x4 acc[NMT][2];
#pragma unroll
        for (int mt = 0; mt < NMT; ++mt) { acc[mt][0] = (f32x4){0.f, 0.f, 0.f, 0.f}; acc[mt][1] = (f32x4){0.f, 0.f, 0.f, 0.f}; }
        bf16x8 ca_[NMT], cb0, cb1, na_[NMT], nb0, nb1;
        cb0 = *(const GAS bf16x8*)(bpa); cb1 = *(const GAS bf16x8*)(bpb);
#pragma unroll
        for (int mt = 0; mt < NMT; ++mt) { ca_[mt] = (bf16x8){0, 0, 0, 0, 0, 0, 0, 0}; if (mt < nact) ca_[mt] = *(const GAS bf16x8*)(ap + (size_t)mt * 16 * K); }
#pragma unroll 2
        for (int s = 0; s < nsteps; ++s) {
            const int k1 = (s + 1 < nsteps ? s + 1 : s) * 32;
            nb0 = *(const GAS bf16x8*)(bpa + k1); nb1 = *(const GAS bf16x8*)(bpb + k1);
#pragma unroll
            for (int mt = 0; mt < NMT; ++mt) { na_[mt] = ca_[mt]; if (mt < nact) na_[mt] = *(const GAS bf16x8*)(ap + (size_t)mt * 16 * K + k1); }
#pragma unroll
            for (int mt = 0; mt < NMT; ++mt) if (mt < nact) { acc[mt][0] = MFMA16(cb0, ca_[mt], acc[mt][0]); acc[mt][1] = MFMA16(cb1, ca_[mt], acc[mt][1]); }
            cb0 = nb0; cb1 = nb1;
#pragma unroll
            for (int mt = 0; mt < NMT; ++mt) ca_[mt] = na_[mt];
        }
        __syncthreads();
#pragma unroll
        for (int mt = 0; mt < NMT; ++mt)
#pragma unroll
            for (int nt = 0; nt < 2; ++nt) { const int row = mt * 16 + fr; *(LAS f32x4*)(red + ((w * R + row) * 8 + ((4 * nt + fq) ^ (row & 7))) * 16) = acc[mt][nt]; }
        __syncthreads();
        if (F.tid < 2 * R) {
            const int row = F.tid >> 1, hf = F.tid & 1;
            f32x4 va0 = (f32x4){0.f, 0.f, 0.f, 0.f}, va1 = va0, vb0 = va0, vb1 = va0;
#pragma unroll
            for (int ww = 0; ww < 8; ++ww) { const LAS unsigned char* pr = red + (ww * R + row) * 128;
                va0 += *(const LAS f32x4*)(pr + ((2 * hf) ^ (row & 7)) * 16); va1 += *(const LAS f32x4*)(pr + ((2 * hf + 1) ^ (row & 7)) * 16);
                vb0 += *(const LAS f32x4*)(pr + ((4 + 2 * hf) ^ (row & 7)) * 16); vb1 += *(const LAS f32x4*)(pr + ((5 + 2 * hf) ^ (row & 7)) * 16); }
            if (rg * R + row < nrows) f.emit(rowbase + rg * R + row, ca + hf * 8, cb + hf * 8, va0, va1, vb0, vb1);
        }
    }
    }
    __syncthreads();
}
static_assert(8 * 128 * 128 <= SCR_BYTES, "skinny reduction buffer");

__device__ __forceinline__ int cond_of_row(int row) { return row < MPR ? (row >> 11) : (BP + row - MPR); }
struct RnParams { f32x4 gwp[4], a[4], sh[4]; };
template <int MODE>
__device__ __forceinline__ void rn_load_params(RnParams& P, const float* modr, const float* wpost, int goff, const float* wpre, int shoff, int scoff, int lane) {
#pragma unroll
    for (int j = 0; j < 4; ++j) { const int c = 4 * lane + 256 * j;
        if (MODE != 0) P.gwp[j] = *(const GAS f32x4*)(modr + goff + c) * *(const GAS f32x4*)(wpost + c);
        if (MODE != 2) { P.a[j] = *(const GAS f32x4*)(wpre + c) * (*(const GAS f32x4*)(modr + scoff + c) + 1.f); P.sh[j] = *(const GAS f32x4*)(modr + shoff + c); } }
}
template <int MODE>
__device__ __forceinline__ void rn_row(const RnParams& P, f32x4 (&x)[4], const v2u (&yw)[4], float* Xrow, bf16* Hrow, int lane) {
    if (MODE != 0) {
        f32x4 y[4]; float ss = 0.f;
#pragma unroll
        for (int j = 0; j < 4; ++j) { y[j] = (f32x4){bflo(yw[j].x), bfhi(yw[j].x), bflo(yw[j].y), bfhi(yw[j].y)}; ss += (y[j][0] * y[j][0] + y[j][1] * y[j][1]) + (y[j][2] * y[j][2] + y[j][3] * y[j][3]); }
        const float r1 = rsqrtf(wave_sum(ss) * (1.f / D) + EPS);
#pragma unroll
        for (int j = 0; j < 4; ++j) x[j] = x[j] + P.gwp[j] * (y[j] * r1);
    }
#pragma unroll
    for (int j = 0; j < 4; ++j) *(GAS f32x4*)(Xrow + 4 * lane + 256 * j) = x[j];
    if (MODE != 2) {
        float s2 = 0.f;
#pragma unroll
        for (int j = 0; j < 4; ++j) s2 += (x[j][0] * x[j][0] + x[j][1] * x[j][1]) + (x[j][2] * x[j][2] + x[j][3] * x[j][3]);
        const float r2 = rsqrtf(wave_sum(s2) * (1.f / D) + EPS);
#pragma unroll
        for (int j = 0; j < 4; ++j) *(GAS v2u*)(Hrow + 4 * lane + 256 * j) = pack4v((x[j] * r2) * P.a[j] + P.sh[j]);
    }
}
template <int MODE>
__device__ __forceinline__ void resnorm_phase(Frame& F, const float* xp, const float* xs, float* X, const bf16* Y, bf16* H, const float* MOD,
                                              const float* wpost, int goff, const float* wpre, int shoff, int scoff) {
    const int gw = F.vcu * NWAVES + F.wave, NGW = F.G * NWAVES, lane = F.lane;
    const int per = (MPR + NGW - 1) / NGW;
    RnParams P;
    for (int r0 = gw * per; r0 < MPR; r0 += NGW * per) {
        const int r1 = (r0 + per < MPR) ? r0 + per : MPR;
        int cond = r0 >> 11;
        rn_load_params<MODE>(P, MOD + (size_t)cond * NMODALL, wpost, goff, wpre, shoff, scoff, lane);
        f32x4 xn[4]; v2u yn[4];
        const float* src = (MODE == 0) ? xp : X;
#pragma unroll
        for (int j = 0; j < 4; ++j) { xn[j] = *(const GAS f32x4*)(src + (size_t)r0 * D + 4 * lane + 256 * j); yn[j] = (v2u){0u, 0u}; if (MODE != 0) yn[j] = *(const GAS v2u*)(Y + (size_t)r0 * D + 4 * lane + 256 * j); }
        for (int row = r0; row < r1; ++row) {
            f32x4 x[4]; v2u yw[4];
#pragma unroll
            for (int j = 0; j < 4; ++j) { x[j] = xn[j]; yw[j] = yn[j]; }
            if ((row >> 11) != cond) { cond = row >> 11; rn_load_params<MODE>(P, MOD + (size_t)cond * NMODALL, wpost, goff, wpre, shoff, scoff, lane); }
            if (row + 1 < r1) {
#pragma unroll
                for (int j = 0; j < 4; ++j) { xn[j] = *(const GAS f32x4*)(src + (size_t)(row + 1) * D + 4 * lane + 256 * j); if (MODE != 0) yn[j] = *(const GAS v2u*)(Y + (size_t)(row + 1) * D + 4 * lane + 256 * j); } }
            rn_row<MODE>(P, x, yw, X + (size_t)row * D, H + (size_t)row * D, lane);
        }
    }
    for (int row = MPR + gw; row < MT; row += NGW) {
        rn_load_params<MODE>(P, MOD + (size_t)cond_of_row(row) * NMODALL, wpost, goff, wpre, shoff, scoff, lane);
        f32x4 x[4]; v2u yw[4];
        const float* src = (MODE == 0) ? xs + (size_t)(row - MPR) * D : X + (size_t)row * D;
#pragma unroll
        for (int j = 0; j < 4; ++j) { x[j] = *(const GAS f32x4*)(src + 4 * lane + 256 * j); yw[j] = (v2u){0u, 0u}; if (MODE != 0) yw[j] = *(const GAS v2u*)(Y + (size_t)row * D + 4 * lane + 256 * j); }
        rn_row<MODE>(P, x, yw, X + (size_t)row * D, H + (size_t)row * D, lane);
    }
}
template <int MIX>
__device__ __forceinline__ void gatenorm_phase(Frame& F, const bf16* RO, const bf16* GATE, bf16* GO, const float* nw) {
    const int gw = F.vcu * NWAVES + F.wave, NGW = F.G * NWAVES, lane = F.lane;
    constexpr int W = (MIX == 2) ? 1024 : 2048, NJ = W / 512;
    const int per = (MPR + NGW - 1) / NGW;
    float wv[NJ][8];
#pragma unroll
    for (int j = 0; j < NJ; ++j)
#pragma unroll
        for (int e = 0; e < 8; ++e) { const int c = 8 * lane + 512 * j + e; wv[j][e] = (MIX == 1) ? nw[c] : ((MIX == 2) ? nw[c & 127] : 1.f); }
#pragma unroll 1
    for (int seg = 0; seg < 2; ++seg) {
        const int r0 = seg == 0 ? gw * per : MPR + gw;
        const int r1 = seg == 0 ? ((r0 + per < MPR) ? r0 + per : MPR) : ((r0 < MT) ? r0 + 1 : r0);
        if (r0 >= r1) continue;
        v4u on[NJ], gn[NJ];
#pragma unroll
        for (int j = 0; j < NJ; ++j) { on[j] = *(const GAS v4u*)(RO + (size_t)r0 * W + 8 * lane + 512 * j); gn[j] = *(const GAS v4u*)(GATE + (size_t)r0 * W + 8 * lane + 512 * j); }
        for (int row = r0; row < r1; ++row) {
            v4u oc[NJ], gc[NJ];
#pragma unroll
            for (int j = 0; j < NJ; ++j) { oc[j] = on[j]; gc[j] = gn[j]; }
            if (row + 1 < r1) {
#pragma unroll
                for (int j = 0; j < NJ; ++j) { on[j] = *(const GAS v4u*)(RO + (size_t)(row + 1) * W + 8 * lane + 512 * j); gn[j] = *(const GAS v4u*)(GATE + (size_t)(row + 1) * W + 8 * lane + 512 * j); } }
            float u[NJ][8], r[NJ];
#pragma unroll
            for (int j = 0; j < NJ; ++j) {
                float o[8], g[8]; unpack8(oc[j], o); unpack8(gc[j], g);
                float ss = 0.f;
#pragma unroll
                for (int e = 0; e < 8; ++e) { u[j][e] = o[e] * g[e]; ss += (MIX == 1) ? u[j][e] * u[j][e] : o[e] * o[e]; }
                if (MIX == 2) r[j] = rsqrtf(grp16_sum(ss) * (1.f / 128.f) + EPS); else r[j] = rsqrtf(wave_sum(ss) * (1.f / 512.f) + EPS);
            }
#pragma unroll
            for (int j = 0; j < NJ; ++j) { float v[8];
#pragma unroll
                for (int e = 0; e < 8; ++e) v[e] = u[j][e] * r[j] * wv[j][e];
                *(GAS v4u*)(GO + (size_t)row * W + 8 * lane + 512 * j) = pack8(v); }
        }
    }
}

template <int OFF> __device__ __forceinline__ bf16x8 tr_frag(unsigned addr) {
    s16x4 lo, hi;
    asm volatile("ds_read_b64_tr_b16 %0, %2\n\tds_read_b64_tr_b16 %1, %2 offset:%3\n\ts_waitcnt lgkmcnt(0)" : "=&v"(lo), "=&v"(hi) : "v"(addr), "i"(OFF) : "memory");
    return __builtin_shufflevector(lo, hi, 0, 1, 2, 3, 4, 5, 6, 7);
}
template <int OFF> __device__ __forceinline__ void tr_frag2(unsigned a0, unsigned a1, bf16x8& f0, bf16x8& f1) {
    s16x4 l0, h0, l1, h1;
    asm volatile("ds_read_b64_tr_b16 %0, %4\n\tds_read_b64_tr_b16 %1, %4 offset:%6\n\tds_read_b64_tr_b16 %2, %5\n\tds_read_b64_tr_b16 %3, %5 offset:%6\n\ts_waitcnt lgkmcnt(0)"
                 : "=&v"(l0), "=&v"(h0), "=&v"(l1), "=&v"(h1) : "v"(a0), "v"(a1), "i"(OFF) : "memory");
    f0 = __builtin_shufflevector(l0, h0, 0, 1, 2, 3, 4, 5, 6, 7); f1 = __builtin_shufflevector(l1, h1, 0, 1, 2, 3, 4, 5, 6, 7);
}

#define LDS_BARRIER() do { asm volatile("s_waitcnt lgkmcnt(0)" ::: "memory"); __builtin_amdgcn_s_barrier(); asm volatile("" ::: "memory"); } while (0)
#define TRRD(dst, addr, off) asm volatile("ds_read_b64_tr_b16 %0, %1 offset:%2" : "=&v"(dst) : "v"(addr), "i"(off) : "memory")
#define TR_WAIT() do { asm volatile("s_waitcnt lgkmcnt(0)" ::: "memory"); __builtin_amdgcn_sched_barrier(0); } while (0)
#define TR_JOIN(lo, hi) __builtin_shufflevector(lo, hi, 0, 1, 2, 3, 4, 5, 6, 7)
template <class Cf, class OutFn>
__device__ __forceinline__ void rec_step(LAS unsigned char* lds, const int w, const int lane, f32x4 (&S)[Cf::KPW][Cf::VS / 16], const LAS float* cum, const OutFn& out, const int tok0) {
    constexpr int C = Cf::C, KD = Cf::KD, VS = Cf::VS, NIT = C / 16, NJT = C / 16, NVT = VS / 16, KSK = KD / 32, KSC = C / 32;
    constexpr int RSK = Cf::RSK, RSV = Cf::RSV, RSP = Cf::RSP;
    constexpr bool CH = Cf::CH;
    const int fr = lane & 15, fq = lane >> 4, q4 = fr >> 2, p4 = fr & 3;
    const unsigned lbase = (unsigned)(size_t)lds;
    constexpr int NP = NIT * NJT, PPW = (NP + 7) / 8, NO = NVT * NIT, OPW = (NO + 7) / 8;
    static_assert((NIT == 4 && NVT == 4) || (NP <= 8 && NO <= 8), "tile deal");
    constexpr bool SHQ = (NIT == 4) && !CH;
    const int it = (NIT == 4) ? (w & 3) : (w / NJT);
    f32x4 O[OPW];
    if constexpr (SHQ) {
        f32x4 p[2] = {(f32x4){0.f, 0.f, 0.f, 0.f}, (f32x4){0.f, 0.f, 0.f, 0.f}};
        f32x4 o2[2] = {(f32x4){0.f, 0.f, 0.f, 0.f}, (f32x4){0.f, 0.f, 0.f, 0.f}};
        const int j0 = w >> 2;
#pragma unroll
        for (int ks = 0; ks < KSK; ++ks) {
            const bf16x8 qf = *(const LAS bf16x8*)(lds + Cf::QA + (16 * it + fr) * RSK + (32 * ks + 8 * fq) * 2);
#pragma unroll
            for (int tt = 0; tt < 2; ++tt) { const int jt = j0 + 2 * tt;
                if (jt <= it) { const bf16x8 a = *(const LAS bf16x8*)(lds + Cf::KA + (16 * jt + fr) * RSK + (32 * ks + 8 * fq) * 2); p[tt] = MFMA16(a, qf, p[tt]); }
                const bf16x8 s = *(const LAS bf16x8*)(lds + Cf::ST + (16 * jt + fr) * RSK + (32 * ks + 8 * fq) * 2); o2[tt] = MFMA16(s, qf, o2[tt]); }
        }
        const int i = 16 * it + fr; const float ci = cum[i], ei = __expf(ci);
#pragma unroll
        for (int tt = 0; tt < 2; ++tt) { const int jt = j0 + 2 * tt;
#pragma unroll
            for (int r = 0; r < 4; ++r) { const int j = 16 * jt + 4 * fq + r; const float e = __expf(fminf(ci - cum[j], 0.f)); p[tt][r] = (j <= i) ? p[tt][r] * e : 0.f; }
            *(LAS v2u*)(lds + Cf::PM + (16 * it + fr) * RSP + (16 * jt + 4 * fq) * 2) = pack4v(p[tt]);
            O[tt] = o2[tt] * ei; }
    } else {
#pragma unroll
        for (int tt = 0; tt < PPW; ++tt) { const int t = w + 8 * tt;
            if (t < NP) { const int it1 = t / NJT, jt = t % NJT;
                f32x4 p = (f32x4){0.f, 0.f, 0.f, 0.f};
                if (jt <= it1) {
#pragma unroll
                    for (int ks = 0; ks < KSK; ++ks) {
                        const bf16x8 a = *(const LAS bf16x8*)(lds + Cf::KA + (16 * jt + fr) * RSK + (32 * ks + 8 * fq) * 2);
                        const bf16x8 b = *(const LAS bf16x8*)(lds + Cf::QA + (16 * it1 + fr) * RSK + (32 * ks + 8 * fq) * 2);
                        p = MFMA16(a, b, p); }
                    const int i = 16 * it1 + fr;
                    if (!CH) { const float ci = cum[i];
#pragma unroll
                        for (int r = 0; r < 4; ++r) { const int j = 16 * jt + 4 * fq + r; const float e = __expf(fminf(ci - cum[j], 0.f)); p[r] = (j <= i) ? p[r] * e : 0.f; } }
                    else {
#pragma unroll
                        for (int r = 0; r < 4; ++r) { const int j = 16 * jt + 4 * fq + r; p[r] = (j <= i) ? p[r] : 0.f; } }
                }
                *(LAS v2u*)(lds + Cf::PM + (16 * it1 + fr) * RSP + (16 * jt + 4 * fq) * 2) = pack4v(p);
            } }
#pragma unroll
        for (int tt = 0; tt < OPW; ++tt) { const int t = w + 8 * tt; O[tt] = (f32x4){0.f, 0.f, 0.f, 0.f};
            if (t < NO) { const int vt = t / NIT, it3 = t % NIT; f32x4 o = (f32x4){0.f, 0.f, 0.f, 0.f};
#pragma unroll
                for (int ks = 0; ks < KSK; ++ks) {
                    const bf16x8 a = *(const LAS bf16x8*)(lds + Cf::ST + (16 * vt + fr) * RSK + (32 * ks + 8 * fq) * 2);
                    const bf16x8 b = *(const LAS bf16x8*)(lds + Cf::QB + (16 * it3 + fr) * RSK + (32 * ks + 8 * fq) * 2);
                    o = MFMA16(a, b, o); }
                if (!CH) o = o * __expf(cum[16 * it3 + fr]);
                O[tt] = o; } }
    }
#pragma unroll
    for (int ki = 0; ki < Cf::KPW; ++ki) { const int kt = w + 8 * ki;
        if (!CH) { const float d = __expf(cum[C - 1]);
#pragma unroll
            for (int vt = 0; vt < NVT; ++vt) S[ki][vt] = S[ki][vt] * d; }
        else { const LAS float* ds = (const LAS float*)(lds + Cf::DS) + 16 * kt + 4 * fq; const f32x4 d = (f32x4){ds[0], ds[1], ds[2], ds[3]};
#pragma unroll
            for (int vt = 0; vt < NVT; ++vt) S[ki][vt] = S[ki][vt] * d; } }
    {
        s16x4 vl[KSC][NVT], vh[KSC][NVT], kl[KSC][Cf::KPW], kh[KSC][Cf::KPW];
#pragma unroll
        for (int ks = 0; ks < KSC; ++ks) {
#pragma unroll
            for (int vt = 0; vt < NVT; ++vt) { const unsigned ad = lbase + Cf::VB + (32 * ks + 8 * fq + q4) * RSV + (16 * vt + 4 * p4) * 2; TRRD(vl[ks][vt], ad, 0); TRRD(vh[ks][vt], ad, 4 * RSV); }
#pragma unroll
            for (int ki = 0; ki < Cf::KPW; ++ki) { const unsigned ad = lbase + Cf::KB + (32 * ks + 8 * fq + q4) * RSK + (16 * (w + 8 * ki) + 4 * p4) * 2; TRRD(kl[ks][ki], ad, 0); TRRD(kh[ks][ki], ad, 4 * RSK); } }
        TR_WAIT();
#pragma unroll
        for (int ks = 0; ks < KSC; ++ks)
#pragma unroll
            for (int ki = 0; ki < Cf::KPW; ++ki) { const bf16x8 a = TR_JOIN(kl[ks][ki], kh[ks][ki]);
#pragma unroll
                for (int vt = 0; vt < NVT; ++vt) S[ki][vt] = MFMA16(a, TR_JOIN(vl[ks][vt], vh[ks][vt]), S[ki][vt]); }
    }
    LDS_BARRIER();
    if constexpr (NIT == 4) {
        const int v0 = w >> 2;
        s16x4 al[KSC][2], ah[KSC][2]; bf16x8 pb[KSC];
#pragma unroll
        for (int ks = 0; ks < KSC; ++ks) {
#pragma unroll
            for (int tt = 0; tt < 2; ++tt) { const unsigned ad = lbase + Cf::V + (32 * ks + 8 * fq + q4) * RSV + (16 * (v0 + 2 * tt) + 4 * p4) * 2; TRRD(al[ks][tt], ad, 0); TRRD(ah[ks][tt], ad, 4 * RSV); } }
#pragma unroll
        for (int ks = 0; ks < KSC; ++ks) pb[ks] = *(const LAS bf16x8*)(lds + Cf::PM + (16 * it + fr) * RSP + (32 * ks + 8 * fq) * 2);
        TR_WAIT();
#pragma unroll
        for (int ks = 0; ks < KSC; ++ks) { O[0] = MFMA16(TR_JOIN(al[ks][0], ah[ks][0]), pb[ks], O[0]); O[1] = MFMA16(TR_JOIN(al[ks][1], ah[ks][1]), pb[ks], O[1]); }
        out(tok0 + 16 * it + fr, 16 * it + fr, 16 * v0 + 4 * fq, O[0]);
        out(tok0 + 16 * it + fr, 16 * it + fr, 16 * (v0 + 2) + 4 * fq, O[1]);
    } else {
#pragma unroll
        for (int tt = 0; tt < OPW; ++tt) { const int t = w + 8 * tt;
            if (t < NO) { const int vt = t / NIT, it2 = t % NIT; f32x4 o = O[tt];
#pragma unroll
                for (int ks = 0; ks < KSC; ++ks) {
                    const bf16x8 a = tr_frag<4 * RSV>(lbase + Cf::V + (32 * ks + 8 * fq + q4) * RSV + (16 * vt + 4 * p4) * 2);
                    const bf16x8 b = *(const LAS bf16x8*)(lds + Cf::PM + (16 * it2 + fr) * RSP + (32 * ks + 8 * fq) * 2);
                    o = MFMA16(a, b, o); }
                out(tok0 + 16 * it2 + fr, 16 * it2 + fr, 16 * vt + 4 * fq, o); } }
    }
#pragma unroll
    for (int ki = 0; ki < Cf::KPW; ++ki) { const int kt = w + 8 * ki;
#pragma unroll
        for (int vt = 0; vt < NVT; ++vt) *(LAS v2u*)(lds + Cf::ST + (16 * vt + fr) * RSK + (16 * kt + 4 * fq) * 2) = pack4v(S[ki][vt]); }
    LDS_BARRIER();
}
template <class Cf> __device__ __forceinline__ void rec_zero_state(Frame& F, f32x4 (&S)[Cf::KPW][Cf::VS / 16]) {
#pragma unroll
    for (int ki = 0; ki < Cf::KPW; ++ki)
#pragma unroll
        for (int vt = 0; vt < Cf::VS / 16; ++vt) S[ki][vt] = (f32x4){0.f, 0.f, 0.f, 0.f};
    for (int o = F.tid * 16; o < Cf::VS * Cf::RSK; o += 512 * 16) *(LAS v4u*)(F.lds + Cf::ST + o) = (v4u){0u, 0u, 0u, 0u};
}
template <class Cf> __device__ __forceinline__ void rec_store_state(Frame& F, const f32x4 (&S)[Cf::KPW][Cf::VS / 16], float* dst, int ldv) {
    const int fr = F.lane & 15, fq = F.lane >> 4;
#pragma unroll
    for (int ki = 0; ki < Cf::KPW; ++ki) { const int kt = F.wave + 8 * ki;
#pragma unroll
        for (int vt = 0; vt < Cf::VS / 16; ++vt)
#pragma unroll
            for (int r = 0; r < 4; ++r) dst[(size_t)(16 * kt + 4 * fq + r) * ldv + 16 * vt + fr] = S[ki][vt][r]; }
}

struct CfRet { static constexpr int C = 64, KD = 256, VS = 64, KPW = 2, RSK = 528, RSV = 144, RSP = 144; static constexpr bool CH = false;
    static constexpr int QA = 0, KA = 33792, QB = QA, KB = KA, V = 67584, VB = 76800, PM = 86016, ST = 95232, CUM = 129024, DS = 0, END = 129280; };
static_assert(CfRet::END <= SCR_BYTES, "ret lds");
struct RetOut { bf16* dst;
    __device__ __forceinline__ void operator()(int tok, int i, int vv0, const f32x4 o) const { *(GAS v2u*)(dst + (size_t)tok * 2048 + vv0) = pack4v(o); } };
__device__ __forceinline__ void ret_prompt_item(Frame& F, int item, const bf16* Q, const bf16* K, const bf16* V, bf16* RO, float* st_out) {
    const int b = item >> 5, h = (item >> 3) & 3, vs = item & 7, tid = F.tid;
    const float lg = logf(1.f - exp2f(-5.f - (float)h));
    LAS float* cum = (LAS float*)(F.lds + CfRet::CUM);
    __syncthreads();
    if (tid < 64) cum[tid] = (float)(tid + 1) * lg;
    f32x4 S[CfRet::KPW][4];
    rec_zero_state<CfRet>(F, S);
    const bf16* qg = Q + (size_t)(b * SEQ) * 1024 + h * 256; const bf16* kg = K + (size_t)(b * SEQ) * 1024 + h * 256; const bf16* vg = V + (size_t)(b * SEQ) * 2048 + h * 512 + vs * 64;
    const RetOut out{RO + (size_t)(b * SEQ) * 2048 + h * 512 + vs * 64};
    v4u qr[4], kr[4], vr;
#pragma unroll
    for (int i = 0; i < 4; ++i) { const int pc = tid + 512 * i, row = pc >> 5, c16 = pc & 31; qr[i] = *(const GAS v4u*)(qg + (size_t)row * 1024 + c16 * 8); kr[i] = *(const GAS v4u*)(kg + (size_t)row * 1024 + c16 * 8); }
    vr = *(const GAS v4u*)(vg + (size_t)(tid >> 3) * 2048 + (tid & 7) * 8);
    const float vsc = __expf((float)(63 - (tid >> 3)) * lg);
    for (int c = 0; c < SEQ / 64; ++c) {
#pragma unroll
        for (int i = 0; i < 4; ++i) { const int pc = tid + 512 * i, row = pc >> 5, c16 = pc & 31;
            *(LAS v4u*)(F.lds + CfRet::QA + row * 528 + c16 * 16) = qr[i]; *(LAS v4u*)(F.lds + CfRet::KA + row * 528 + c16 * 16) = kr[i]; }
        { const int row = tid >> 3, c16 = tid & 7; *(LAS v4u*)(F.lds + CfRet::V + row * 144 + c16 * 16) = vr;
          float f[8]; unpack8(vr, f);
#pragma unroll
          for (int e = 0; e < 8; ++e) f[e] *= vsc;
          *(LAS v4u*)(F.lds + CfRet::VB + row * 144 + c16 * 16) = pack8(f); }
        if (c + 1 < SEQ / 64) { const size_t r0 = (size_t)(c + 1) * 64;
#pragma unroll
            for (int i = 0; i < 4; ++i) { const int pc = tid + 512 * i, row = pc >> 5, c16 = pc & 31; qr[i] = *(const GAS v4u*)(qg + (r0 + row) * 1024 + c16 * 8); kr[i] = *(const GAS v4u*)(kg + (r0 + row) * 1024 + c16 * 8); }
            vr = *(const GAS v4u*)(vg + (r0 + (tid >> 3)) * 2048 + (tid & 7) * 8); }
        LDS_BARRIER();
        rec_step<CfRet>(F.lds, F.wave, F.lane, S, cum, out, c * 64);
    }
    rec_store_state<CfRet>(F, S, st_out + ((size_t)(b * 4 + h) * 256) * 512 + vs * 64, 512);
}
__device__ __forceinline__ void ret_sample_items(Frame& F, const bf16* Q, const bf16* K, const bf16* V, bf16* RO, const float* st_in, float* st_out) {
    LAS float* qk = (LAS float*)F.lds; LAS float* red = qk + 512;
    const int tid = F.tid, lane = F.lane, w = F.wave;
    for (int item = F.vcu; item < MS * 4; item += F.G) {
        const int bs = item >> 2, h = item & 3; const size_t row = MPR + bs;
        __syncthreads();
        qk[tid] = tid < 256 ? bf2f(Q[row * 1024 + h * 256 + tid]) : bf2f(K[row * 1024 + h * 256 + (tid - 256)]);
        float v[8]; unpack8(*(const GAS v4u*)(V + row * 2048 + h * 512 + 8 * lane), v);
        __syncthreads();
        const float g = 1.f - exp2f(-5.f - (float)h);
        const float* sin = st_in + ((size_t)(bs * 4 + h) * 256) * 512 + 8 * lane; float* sout = st_out + ((size_t)(bs * 4 + h) * 256) * 512 + 8 * lane;
        float o[8];
#pragma unroll
        for (int e = 0; e < 8; ++e) o[e] = 0.f;
#pragma unroll 8
        for (int r = 0; r < 32; ++r) { const int kk = 32 * w + r;
            f32x4 s0 = __builtin_nontemporal_load((const GAS f32x4*)(sin + (size_t)kk * 512)), s1 = __builtin_nontemporal_load((const GAS f32x4*)(sin + (size_t)kk * 512 + 4));
            const float kf = qk[256 + kk], qf = qk[kk];
#pragma unroll
            for (int e = 0; e < 4; ++e) { s0[e] = g * s0[e] + kf * v[e]; s1[e] = g * s1[e] + kf * v[4 + e]; o[e] += s0[e] * qf; o[4 + e] += s1[e] * qf; }
            __builtin_nontemporal_store(s0, (GAS f32x4*)(sout + (size_t)kk * 512)); __builtin_nontemporal_store(s1, (GAS f32x4*)(sout + (size_t)kk * 512 + 4)); }
#pragma unroll
        for (int e = 0; e < 8; ++e) red[w * 512 + 8 * lane + e] = o[e];
        __syncthreads();
        float acc = 0.f;
#pragma unroll
        for (int ww = 0; ww < 8; ++ww) acc += red[ww * 512 + tid];
        RO[row * 2048 + h * 512 + tid] = (bf16)(cvt_pk_bf16(acc, acc) & 0xffffu);
    }
    __syncthreads();
}

struct CfSsd { static constexpr int C = 64, KD = 128, VS = 64, KPW = 1, RSK = 272, RSV = 144, RSP = 144; static constexpr bool CH = false;
    static constexpr int QA = 0, KA = 17408, QB = QA, KB = KA, V = 34816, VB = 44032, PM = 53248, ST = 62464, XS = 79872, CUM = 89088, DTV = 89600, RAW = 90112, RSR = 656, DS = 0, END = RAW + 67 * 656; };
static_assert(CfSsd::END <= SCR_BYTES, "ssd lds");
struct SsdOut { bf16* dst; const LAS unsigned char* xs; float Dh;
    __device__ __forceinline__ void operator()(int tok, int i, int vv0, const f32x4 o) const {
        const v2u xw = *(const LAS v2u*)(xs + i * 144 + vv0 * 2);
        const f32x4 x = (f32x4){bflo(xw.x), bfhi(xw.x), bflo(xw.y), bfhi(xw.y)};
        *(GAS v2u*)(dst + (size_t)tok * 2048 + vv0) = pack4v(o + x * Dh); } };
__device__ __forceinline__ int ssd_gcol(int lch, int head, int grp) { return lch < 64 ? head * 64 + lch : (lch < 192 ? 2048 + grp * 128 + (lch - 64) : 2560 + grp * 128 + (lch - 192)); }
__device__ __forceinline__ void ssd_prompt_item(Frame& F, int item, const bf16* XBC, const float* DT, bf16* T, float* st_out,
                                                const float* conv_w, const float* conv_b, const float* dt_bias, const float* a_log, const float* d_skip) {
    const int b = item >> 5, head = item & 31, grp = head >> 3, tid = F.tid, lane = F.lane, w = F.wave;
    const float a = -expf(a_log[head]), dtb = dt_bias[head], Dh = d_skip[head];
    LAS float* cumb = (LAS float*)(F.lds + CfSsd::CUM); LAS float* dtvb = (LAS float*)(F.lds + CfSsd::DTV);
    __syncthreads();
    f32x4 S[CfSsd::KPW][4];
    rec_zero_state<CfSsd>(F, S);
    const bf16* xg = XBC + (size_t)(b * SEQ) * 3072; const float* dtg = DT + (size_t)(b * SEQ) * 32 + head;
    const SsdOut out{T + (size_t)(b * SEQ) * 2048 + head * 64, F.lds + CfSsd::XS, Dh};
    const bool conv_thr = tid < 440; const int cg = tid % 40, tb = tid / 40, gcolc = ssd_gcol(8 * cg, head, grp);
    float wr[4][8], br[8];
#pragma unroll
    for (int e = 0; e < 8; ++e) { br[e] = conv_b[gcolc + e];
#pragma unroll
        for (int tap = 0; tap < 4; ++tap) wr[tap][e] = conv_w[tap * 3072 + gcolc + e]; }
    const bool stg_thr = tid < 480; const int r0 = tid / 40;
    v4u raw[6];
#define SSD_LOAD_RAW(cc) do { const bf16* rp_ = xg + ((long)((cc) * 64 - 3 + r0) * 3072 + gcolc); _Pragma("unroll") for (int k_ = 0; k_ < 6; ++k_) { const int row_ = r0 + 12 * k_, tk_ = (cc) * 64 - 3 + row_; \
        raw[k_] = (v4u){0u, 0u, 0u, 0u}; if (stg_thr && row_ < 67 && tk_ >= 0) raw[k_] = *(const GAS v4u*)(rp_ + (long)k_ * 12 * 3072); } } while (0)
#define SSD_CUM(cc) do { if (w == 0) { const float dtv_ = softplusf_(dtn + dtb); float v_ = dtv_ * a; \
        _Pragma("unroll") for (int o_ = 1; o_ < 64; o_ <<= 1) { const float u_ = __shfl_up(v_, o_); if (lane >= o_) v_ += u_; } cumb[((cc) & 1) * 64 + lane] = v_; dtvb[((cc) & 1) * 64 + lane] = dtv_; } } while (0)
    float dtn = 0.f;
    if (w == 0) dtn = dtg[(size_t)lane * 32];
    SSD_CUM(0);
    if (w == 0) dtn = dtg[(size_t)(64 + lane) * 32];
    SSD_LOAD_RAW(0);
    for (int c = 0; c < SEQ / 64; ++c) {
#pragma unroll
        for (int k = 0; k < 6; ++k) { const int row = r0 + 12 * k; if (stg_thr && row < 67) *(LAS v4u*)(F.lds + CfSsd::RAW + row * CfSsd::RSR + cg * 16) = raw[k]; }
        if (c + 1 < SEQ / 64) { SSD_CUM(c + 1); if (w == 0 && c + 2 < SEQ / 64) dtn = dtg[(size_t)((c + 2) * 64 + lane) * 32]; SSD_LOAD_RAW(c + 1); }
        LDS_BARRIER();
        const LAS float* cum = cumb + (c & 1) * 64; const LAS float* dtv = dtvb + (c & 1) * 64; const float tot = cum[63];
        if (conv_thr) {
            float win[3][8];
#pragma unroll
            for (int r = 0; r < 3; ++r) unpack8(*(const LAS v4u*)(F.lds + CfSsd::RAW + (6 * tb + r) * CfSsd::RSR + cg * 16), win[r]);
#pragma unroll
            for (int k = 0; k < 6; ++k) { const int i = 6 * tb + k;
                if (i < 64) {
                    float x3[8], acc[8]; unpack8(*(const LAS v4u*)(F.lds + CfSsd::RAW + (i + 3) * CfSsd::RSR + cg * 16), x3);
#pragma unroll
                    for (int e = 0; e < 8; ++e) { acc[e] = br[e] + win[0][e] * wr[0][e] + win[1][e] * wr[1][e] + win[2][e] * wr[2][e] + x3[e] * wr[3][e]; acc[e] = siluf_(acc[e]);
                        win[0][e] = win[1][e]; win[1][e] = win[2][e]; win[2][e] = x3[e]; }
                    if (cg < 8) { const float dv = dtv[i], wj = dv * __expf(tot - cum[i]);
                        *(LAS v4u*)(F.lds + CfSsd::XS + i * 144 + cg * 16) = pack8(acc);
                        float f[8];
#pragma unroll
                        for (int e = 0; e < 8; ++e) f[e] = acc[e] * dv;
                        *(LAS v4u*)(F.lds + CfSsd::V + i * 144 + cg * 16) = pack8(f);
#pragma unroll
                        for (int e = 0; e < 8; ++e) f[e] = acc[e] * wj;
                        *(LAS v4u*)(F.lds + CfSsd::VB + i * 144 + cg * 16) = pack8(f); }
                    else if (cg < 24) *(LAS v4u*)(F.lds + CfSsd::KA + i * 272 + (cg - 8) * 16) = pack8(acc);
                    else *(LAS v4u*)(F.lds + CfSsd::QA + i * 272 + (cg - 24) * 16) = pack8(acc);
                } }
        }
        LDS_BARRIER();
        rec_step<CfSsd>(F.lds, w, lane, S, cum, out, c * 64);
    }
#undef SSD_CUM
#undef SSD_LOAD_RAW
    rec_store_state<CfSsd>(F, S, st_out + ((size_t)(b * 32 + head) * 128) * 64, 64);
}
__device__ __forceinline__ void ssd_sample_items(Frame& F, const bf16* XBC, const float* DT, bf16* T, const float* st_in, float* st_out, const float* conv_st,
                                                 const float* conv_w, const float* conv_b, const float* dt_bias, const float* a_log, const float* d_skip) {
    const int gw = F.vcu * NWAVES + F.wave, NGW = F.G * NWAVES, lane = F.lane;
    LAS float* scr = (LAS float*)(F.lds + F.wave * 2048);
    __syncthreads();
    for (int item = gw; item < MS * 32; item += NGW) {
        const int bs = item >> 5, head = item & 31, grp = head >> 3; const size_t row = MPR + bs;
        asm volatile("" ::: "memory");
#pragma unroll
        for (int r = 0; r < 5; ++r) { const int lch = lane + 64 * r, gch = ssd_gcol(lch, head, grp);
            float acc = conv_b[gch];
#pragma unroll
            for (int tap = 0; tap < 3; ++tap) acc += conv_st[((size_t)bs * 3 + tap) * 3072 + gch] * conv_w[tap * 3072 + gch];
            acc += bf2f(XBC[row * 3072 + gch]) * conv_w[3 * 3072 + gch];
            scr[lch] = siluf_(acc); }
        LDS_WAIT();
        const float dtv = softplusf_(DT[row * 32 + head] + dt_bias[head]), dA = __expf(dtv * -expf(a_log[head])), Dh = d_skip[head];
        const int v4 = (lane & 15) * 4, kq = lane >> 4;
        const f32x4 xs4 = (f32x4){scr[v4], scr[v4 + 1], scr[v4 + 2], scr[v4 + 3]}, xd = xs4 * dtv;
        const float* sin = st_in + ((size_t)(bs * 32 + head) * 128) * 64 + v4; float* sout = st_out + ((size_t)(bs * 32 + head) * 128) * 64 + v4;
        f32x4 y = (f32x4){0.f, 0.f, 0.f, 0.f};
#pragma unroll 8
        for (int i = 0; i < 32; ++i) { const int kk = 4 * i + kq;
            f32x4 s = __builtin_nontemporal_load((const GAS f32x4*)(sin + (size_t)kk * 64));
            s = s * dA + xd * scr[64 + kk];
            __builtin_nontemporal_store(s, (GAS f32x4*)(sout + (size_t)kk * 64));
            y = y + s * scr[192 + kk]; }
#pragma unroll
        for (int e = 0; e < 4; ++e) { y[e] += __shfl_xor(y[e], 16); y[e] += __shfl_xor(y[e], 32); }
        if (lane < 16) *(GAS v2u*)(T + row * 2048 + head * 64 + v4) = pack4v(y + xs4 * Dh);
        LDS_WAIT();
    }
    __syncthreads();
}
__device__ __forceinline__ void ssd_conv_out(Frame& F, const bf16* XBC, const float* conv_st, float* outp, float* outs) {
    const int NP_ = BP * 3 * 3072, NS_ = MS * 3 * 3072;
    for (int idx = F.vcu * 512 + F.tid; idx < NP_ + NS_; idx += F.G * 512) {
        if (idx < NP_) { const int b = idx / 9216, rem = idx - b * 9216, wi = rem / 3072, ch = rem - wi * 3072; outp[idx] = bf2f(XBC[(size_t)(b * SEQ + SEQ - 3 + wi) * 3072 + ch]); }
        else { const int k = idx - NP_, bs = k / 9216, rem = k - bs * 9216, wi = rem / 3072, ch = rem - wi * 3072;
            outs[k] = wi < 2 ? conv_st[((size_t)bs * 3 + wi + 1) * 3072 + ch] : bf2f(XBC[(size_t)(MPR + bs) * 3072 + ch]); }
    }
}

struct CfHg { static constexpr int C = 32, KD = 128, VS = 32, KPW = 1, RSK = 272, RSV = 80, RSP = 80; static constexpr bool CH = true;
    static constexpr int QA = 0, KA = 8704, QB = 17408, KB = 26112, V = 34816, VB = V, PM = 37376, ST = 39936, DS = 48640, PART = 49152, CUM = 0, END = 51200; };
static_assert(CfHg::END <= SCR_BYTES, "hgrn lds");
struct HgOut { bf16* dst;
    __device__ __forceinline__ void operator()(int tok, int i, int vv0, const f32x4 o) const { *(GAS v2u*)(dst + (size_t)tok * 1024 + vv0) = pack4v(o); } };
__device__ __forceinline__ void st_bf16_lds(LAS unsigned char* p, float x) { *(LAS unsigned short*)p = (unsigned short)(cvt_pk_bf16(x, x) & 0xffffu); }
__device__ __forceinline__ void hg_prompt_item(Frame& F, int item, const bf16* HQ, const float* LA, const bf16* HV, bf16* RO, float* st_out) {
    const int b = item >> 5, h = (item >> 2) & 7, vs = item & 3, tid = F.tid, kk = tid & 127, tg = tid >> 7;
    LAS float* part = (LAS float*)(F.lds + CfHg::PART); LAS float* dsv = (LAS float*)(F.lds + CfHg::DS);
    __syncthreads();
    f32x4 S[CfHg::KPW][2];
    rec_zero_state<CfHg>(F, S);
    const size_t base = (size_t)(b * SEQ) * 1024 + h * 128;
    const HgOut out{RO + base + vs * 32};
    float la[8]; unsigned short qr[8]; v4u vr = (v4u){0u, 0u, 0u, 0u};
#pragma unroll
    for (int e = 0; e < 8; ++e) { const size_t ix = base + (size_t)(8 * tg + e) * 1024 + kk; la[e] = LA[ix]; qr[e] = HQ[ix]; }
    if (tid < 128) vr = *(const GAS v4u*)(HV + base + (size_t)(tid >> 2) * 1024 + vs * 32 + (tid & 3) * 8);
    for (int c = 0; c < SEQ / 32; ++c) {
        float lc[8]; lc[0] = la[0];
#pragma unroll
        for (int e = 1; e < 8; ++e) lc[e] = lc[e - 1] + la[e];
        part[tg * 128 + kk] = lc[7];
        LDS_BARRIER();
        const float p0 = part[kk], p1 = part[128 + kk], p2 = part[256 + kk], p3 = part[384 + kk];
        const float off = (tg > 0 ? p0 : 0.f) + (tg > 1 ? p1 : 0.f) + (tg > 2 ? p2 : 0.f), tot = (p0 + p1) + (p2 + p3), ref = p0 + p1;
#pragma unroll
        for (int e = 0; e < 8; ++e) { const int i = 8 * tg + e; const float cm = off + lc[e], kf = 1.f - __expf(la[e]), qv = bf2f(qr[e]);
            const float ea = __expf(fminf(fmaxf(cm - ref, -80.f), 80.f)), eb = __expf(fminf(fmaxf(ref - cm, -80.f), 80.f));
            st_bf16_lds(F.lds + CfHg::QA + i * 272 + kk * 2, qv * ea); st_bf16_lds(F.lds + CfHg::KA + i * 272 + kk * 2, kf * eb);
            st_bf16_lds(F.lds + CfHg::QB + i * 272 + kk * 2, qv * __expf(cm)); st_bf16_lds(F.lds + CfHg::KB + i * 272 + kk * 2, kf * __expf(tot - cm)); }
        if (tg == 0) dsv[kk] = __expf(tot);
        if (tid < 128) *(LAS v4u*)(F.lds + CfHg::V + (tid >> 2) * 80 + (tid & 3) * 16) = vr;
        if (c + 1 < SEQ / 32) { const size_t b2 = base + (size_t)(c + 1) * 32 * 1024;
#pragma unroll
            for (int e = 0; e < 8; ++e) { const size_t ix = b2 + (size_t)(8 * tg + e) * 1024 + kk; la[e] = LA[ix]; qr[e] = HQ[ix]; }
            if (tid < 128) vr = *(const GAS v4u*)(HV + b2 + (size_t)(tid >> 2) * 1024 + vs * 32 + (tid & 3) * 8); }
        LDS_BARRIER();
        rec_step<CfHg>(F.lds, F.wave, F.lane, S, (const LAS float*)nullptr, out, c * 32);
    }
    rec_store_state<CfHg>(F, S, st_out + ((size_t)(b * 8 + h) * 128) * 128 + vs * 32, 128);
}
__device__ __forceinline__ void hg_sample_items(Frame& F, const bf16* HQ, const float* LA, const bf16* HV, bf16* RO, const float* st_in, float* st_out) {
    const int gw = F.vcu * NWAVES + F.wave, NGW = F.G * NWAVES, lane = F.lane;
    LAS float* scr = (LAS float*)(F.lds + F.wave * 2048);
    __syncthreads();
    for (int item = gw; item < MS * 16; item += NGW) {
        const int bs = item >> 4, h = (item >> 1) & 7, vh = item & 1; const size_t rb = (size_t)(MPR + bs) * 1024 + h * 128;
        asm volatile("" ::: "memory");
#pragma unroll
        for (int r = 0; r < 2; ++r) { const int kk = lane + 64 * r; scr[kk] = __expf(LA[rb + kk]); scr[128 + kk] = bf2f(HQ[rb + kk]); }
        LDS_WAIT();
        const int v4 = (lane & 15) * 4, kq = lane >> 4;
        const v2u iw = *(const GAS v2u*)(HV + rb + vh * 64 + v4);
        const f32x4 iv = (f32x4){bflo(iw.x), bfhi(iw.x), bflo(iw.y), bfhi(iw.y)};
        const float* sin = st_in + ((size_t)(bs * 8 + h) * 128) * 128 + vh * 64 + v4; float* sout = st_out + ((size_t)(bs * 8 + h) * 128) * 128 + vh * 64 + v4;
        f32x4 o = (f32x4){0.f, 0.f, 0.f, 0.f};
#pragma unroll 8
        for (int i = 0; i < 32; ++i) { const int kk = 4 * i + kq; const float f = scr[kk];
            f32x4 s = __builtin_nontemporal_load((const GAS f32x4*)(sin + (size_t)kk * 128));
            s = s * f + iv * (1.f - f);
            __builtin_nontemporal_store(s, (GAS f32x4*)(sout + (size_t)kk * 128));
            o = o + s * scr[128 + kk]; }
#pragma unroll
        for (int e = 0; e < 4; ++e) { o[e] += __shfl_xor(o[e], 16); o[e] += __shfl_xor(o[e], 32); }
        if (lane < 16) *(GAS v2u*)(RO + rb + vh * 64 + v4) = pack4v(o);
        LDS_WAIT();
    }
    __syncthreads();
}

__device__ __forceinline__ void p0_transpose_item(const float* W, int K, int N, bf16* WT, LAS float* scr, int item, int lane, bool inter) {
    const int nblk = N / 32, kb = item / nblk, nb = item - kb * nblk, k0 = 64 * kb, n0 = 32 * nb;
    int s0 = n0; if (inter) { const int t = n0 >> 8, j = n0 & 255; s0 = j < 128 ? 128 * t + j : DFF + 128 * t + (j - 128); }
#pragma unroll 8
    for (int i = 0; i < 32; ++i) { const int kk = 2 * i + (lane >> 5); scr[kk * 33 + (lane & 31)] = W[(size_t)(k0 + kk) * N + s0 + (lane & 31)]; }
    LDS_WAIT(); asm volatile("" ::: "memory");
    const int c = lane & 7;
#pragma unroll
    for (int j = 0; j < 4; ++j) { const int n = (lane >> 3) + 8 * j; const LAS float* s = scr + (8 * c) * 33 + n;
        v4u o; o.x = cvt_pk_bf16(s[0 * 33], s[1 * 33]); o.y = cvt_pk_bf16(s[2 * 33], s[3 * 33]); o.z = cvt_pk_bf16(s[4 * 33], s[5 * 33]); o.w = cvt_pk_bf16(s[6 * 33], s[7 * 33]);
        *(GAS v4u*)(WT + (size_t)(n0 + n) * K + k0 + 8 * c) = o; }
    LDS_WAIT(); asm volatile("" ::: "memory");
}
__device__ __forceinline__ void p0_matrix(Frame& F, const float* W, int K, int N, bf16* WT, bool inter, int& itbase) {
    const int gw = F.vcu * NWAVES + F.wave, NGW = F.G * NWAVES, nit = (K / 64) * (N / 32);
    LAS float* scr = (LAS float*)(F.lds + F.wave * 16384);
    int first = (gw - itbase) % NGW; if (first < 0) first += NGW;
    for (int it = first; it < nit; it += NGW) p0_transpose_item(W, K, N, WT, scr, it, F.lane, inter);
    itbase += nit;
}

#ifndef REP_PROMPT
#define REP_PROMPT 1
#endif
#ifndef REP_PROMPT_SSD
#define REP_PROMPT_SSD REP_PROMPT
#endif
#ifndef REP_PROMPT_HG
#define REP_PROMPT_HG REP_PROMPT
#endif
#ifndef REP_SAMPLE
#define REP_SAMPLE 1
#endif
#ifndef REP_GEMM
#define REP_GEMM 1
#endif
#ifndef REP_GN
#define REP_GN 1
#endif
#ifndef REP_P0
#define REP_P0 1
#endif
#ifndef REP_SKINNY
#define REP_SKINNY 1
#endif
#define REPEAT(n) _Pragma("unroll 1") for (int rep_ = 0; rep_ < (n); ++rep_)
struct Args { const float* in[30]; float* out; unsigned char* ws; int ph_lo, ph_hi; };
enum { I_XP = 0, I_XS, I_CP, I_CS, I_SRET, I_SSSD, I_SCONV, I_SHG, I_WADA, I_BADA, I_NMPRE, I_NMPOST, I_NFPRE, I_NFPOST, I_RETIN, I_RETOUT, I_SSDIN, I_CONVW, I_CONVB, I_DTB, I_ALOG, I_SSDD,
       I_SSDNORM, I_SSDOUT, I_HGIN, I_HGLB, I_HGNORM, I_HGOUT, I_FFNIN, I_FFNOUT };
constexpr int N_PHASES = 3 + 8 * 4;

__global__ void __launch_bounds__(NWAVES * 64, 2) mk_fwd(Args args) {
    extern __shared__ __attribute__((aligned(16))) unsigned char lds_raw[];
    Frame F;
    F.lds = (LAS unsigned char*)lds_raw;
    F.tid = threadIdx.x; F.lane = F.tid & 63; F.wave = __builtin_amdgcn_readfirstlane(F.tid >> 6);
    F.G = gridDim.x; { const int bx = blockIdx.x; F.vcu = (F.G % 8 == 0) ? (bx % 8) * (F.G / 8) + bx / 8 : bx; }
    unsigned char* ws = args.ws;
    gu32* ctl = (gu32*)(ws + WS_CTL);
    for (int u = F.tid; u < (LDS_BYTES - LDSCTL_OFF) / 4; u += NWAVES * 64) ((LAS unsigned*)(F.lds + LDSCTL_OFF))[u] = 0u;
    __syncthreads();
    XcdBarrier bar; bar.bar = (unsigned*)(ctl + CW_BAR); bar.x = 0; bar.st = nullptr;
    if (MK_N_LAUNCHES == 1) bar = xcd_barrier_post((unsigned*)(ctl + CW_BAR), (volatile LAS unsigned*)(F.lds + LDSCTL_OFF) + 8);
    const int lo = args.ph_lo, hi = args.ph_hi;
#define IN(k) (lo <= (k) && (k) < hi)
#define SEAM(k) do { if (IN((k) + 1)) xcd_barrier(bar); } while (0)
#define INP(i) (args.in[i])
    float* const out = args.out;
    float* const X = out + O_Y;
    bf16* const Hb = (bf16*)(ws + WS_H); bf16* const RO = (bf16*)(ws + WS_RO); bf16* const GO = (bf16*)(ws + WS_GO); bf16* const OUTB = (bf16*)(ws + WS_OUT); bf16* const ACT = (bf16*)(ws + WS_ACT);
    float* const MOD = (float*)(ws + WS_MOD); float* const LB = (float*)(ws + WS_LB);
    bf16* const CACT = (bf16*)(ws + WS_CACT);
    bf16* const WADA = (bf16*)(ws + WS_WADA);
    unsigned char* const PJ = ws + WS_PROJ;

    if (IN(0)) { REPEAT(REP_P0) {
        int itb = 0;
#pragma unroll 1
        for (int l = 0; l < 4; ++l) p0_matrix(F, INP(I_WADA) + (size_t)l * D * NMOD, D, NMOD, WADA + (size_t)l * NMOD * D, false, itb);
#pragma unroll 1
        for (int j = 0; j < 2; ++j) p0_matrix(F, INP(I_RETIN) + (size_t)j * D * RET_IN, D, RET_IN, (bf16*)(ws + WS_WRETIN) + (size_t)j * RET_IN * D, false, itb);
#pragma unroll 1
        for (int j = 0; j < 2; ++j) p0_matrix(F, INP(I_RETOUT) + (size_t)j * 2048 * D, 2048, D, (bf16*)(ws + WS_WRETOUT) + (size_t)j * D * 2048, false, itb);
        p0_matrix(F, INP(I_SSDIN), D, SSD_IN, (bf16*)(ws + WS_WSSDIN), false, itb);
        p0_matrix(F, INP(I_SSDOUT), 2048, D, (bf16*)(ws + WS_WSSDOUT), false, itb);
        p0_matrix(F, INP(I_HGIN), D, HG_IN, (bf16*)(ws + WS_WHGIN), false, itb);
        p0_matrix(F, INP(I_HGOUT), D, D, (bf16*)(ws + WS_WHGOUT), false, itb);
#pragma unroll 1
        for (int l = 0; l < 4; ++l) p0_matrix(F, INP(I_FFNIN) + (size_t)l * D * FFN_IN, D, FFN_IN, (bf16*)(ws + WS_WFFNIN) + (size_t)l * FFN_IN * D, true, itb);
#pragma unroll 1
        for (int l = 0; l < 4; ++l) p0_matrix(F, INP(I_FFNOUT) + (size_t)l * DFF * D, DFF, D, (bf16*)(ws + WS_WFFNOUT) + (size_t)l * D * DFF, false, itb);
        for (int idx = F.vcu * 512 + F.tid; idx < 256 * 128; idx += F.G * 512) { const int row = idx >> 7, c8 = (idx & 127) * 8; v4u o = (v4u){0u, 0u, 0u, 0u};
            if (row < NCOND) { const float* src = row < BP ? INP(I_CP) + (size_t)row * D : INP(I_CS) + (size_t)(row - BP) * D;
                const f32x4 a = *(const GAS f32x4*)(src + c8), b = *(const GAS f32x4*)(src + c8 + 4); o = pack8v(silu4(a), silu4(b)); }
            *(GAS v4u*)(CACT + (size_t)row * D + c8) = o; }
        for (int idx = F.vcu * 512 + F.tid; idx < 1024; idx += F.G * 512) { const float* lg = INP(I_HGLB);
            const float l0 = lg[idx], l1 = lg[1024 + idx], l2 = lg[2048 + idx], l3 = lg[3072 + idx], m = fmaxf(fmaxf(l0, l1), fmaxf(l2, l3));
            const float e0 = expf(l0 - m), e1 = expf(l1 - m), e2 = expf(l2 - m), e3 = expf(l3 - m); LB[idx] = (e1 + e2) / ((e0 + e1) + (e2 + e3)); }
        }
        SEAM(0);
    }
    if (IN(1)) {
        const EmitMod E{MOD, INP(I_BADA)};
        REPEAT(REP_SKINNY) skinny_gemm<8>(F, CACT, D, 2, NCOND, 0, WADA, (NMODALL / 256) * 8, false, E, 0, F.G);
        SEAM(1);
    }
    if (IN(2)) {
        resnorm_phase<0>(F, INP(I_XP), INP(I_XS), X, nullptr, Hb, MOD, nullptr, 0, INP(I_NMPRE), 0 * NMOD + 0 * D, 0 * NMOD + 1 * D);
        SEAM(2);
    }

#define MAIN_GEMM(EmitT, eobj, Aptr, Btptr, N_, K_) do { pg8::Gemm g_{(const pg8::bf16_t*)(Aptr), (const pg8::bf16_t*)(Btptr), MPR, (N_), (K_)}; pg8::StaticOrder S_; S_.init(MPR, (N_), F.G, (int)blockIdx.x); \
        const EpiGen<EmitT> E_{eobj}; _Pragma("unroll") for (int rg_ = 0; rg_ < REP_GEMM; ++rg_) pg8::gemm_phase<EpiGen<EmitT>, pg8::StaticOrder, PG8_ALIGN, PG8_SP2>(F.lds, g_, S_, E_); } while (0)
#define FFN_BLOCK(L, pb, LASTL) do { \
    if (IN((pb) + 4)) { resnorm_phase<1>(F, nullptr, nullptr, X, OUTB, Hb, MOD, INP(I_NMPOST) + (L) * D, (L) * NMOD + 2 * D, INP(I_NFPRE) + (L) * D, (L) * NMOD + 3 * D, (L) * NMOD + 4 * D); SEAM((pb) + 4); } \
    if (IN((pb) + 5)) { const bf16* wt_ = (const bf16*)(ws + WS_WFFNIN) + (size_t)(L) * FFN_IN * D; const EmitFfnIn e_{ACT}; \
        MAIN_GEMM(EmitFfnIn, e_, Hb, wt_, FFN_IN, D); REPEAT(REP_SKINNY) skinny_gemm<8>(F, Hb + (size_t)MPR * D, D, 1, MS, MPR, wt_, (FFN_IN / 256) * 8, false, e_, F.G / 2, F.G / 2); SEAM((pb) + 5); } \
    if (IN((pb) + 6)) { const bf16* wt_ = (const bf16*)(ws + WS_WFFNOUT) + (size_t)(L) * D * DFF; const EmitOut e_{OUTB}; \
        MAIN_GEMM(EmitOut, e_, ACT, wt_, D, DFF); REPEAT(REP_SKINNY) skinny_gemm<4>(F, ACT + (size_t)MPR * DFF, DFF, 2, MS, MPR, wt_, (D / 256) * 8, false, e_, 0, F.G); SEAM((pb) + 6); } \
    if (IN((pb) + 7)) { if (LASTL) resnorm_phase<2>(F, nullptr, nullptr, X, OUTB, Hb, MOD, INP(I_NFPOST) + (L) * D, (L) * NMOD + 5 * D, nullptr, 0, 0); \
        else resnorm_phase<1>(F, nullptr, nullptr, X, OUTB, Hb, MOD, INP(I_NFPOST) + (L) * D, (L) * NMOD + 5 * D, INP(I_NMPRE) + ((L) + 1) * D, ((L) + 1) * NMOD + 0 * D, ((L) + 1) * NMOD + 1 * D); \
        if (!(LASTL)) SEAM((pb) + 7); } } while (0)
#define OUT_PROJ(pb, wt, K_) do { if (IN((pb) + 3)) { const EmitOut e_{OUTB}; MAIN_GEMM(EmitOut, e_, GO, (wt), D, (K_)); REPEAT(REP_SKINNY) skinny_gemm<4>(F, GO + (size_t)MPR * (K_), (K_), 2, MS, MPR, (wt), (D / 256) * 8, false, e_, 0, F.G); SEAM((pb) + 3); } } while (0)
#define RET_LAYER(L, J, pb) do { \
    bf16* const Qp_ = (bf16*)(PJ + PJ_RET_Q); bf16* const Kp_ = (bf16*)(PJ + PJ_RET_K); bf16* const Vp_ = (bf16*)(PJ + PJ_RET_V); bf16* const SGp_ = (bf16*)(PJ + PJ_RET_SG); \
    if (IN((pb) + 0)) { const bf16* wt_ = (const bf16*)(ws + WS_WRETIN) + (size_t)(J) * RET_IN * D; const EmitRetIn e_{Qp_, Kp_, Vp_, SGp_}; \
        MAIN_GEMM(EmitRetIn, e_, Hb, wt_, RET_IN, D); REPEAT(REP_SKINNY) skinny_gemm<8>(F, Hb + (size_t)MPR * D, D, 1, MS, MPR, wt_, (RET_IN / 256) * 8, false, e_, 0, F.G); SEAM((pb) + 0); } \
    if (IN((pb) + 1)) { REPEAT(REP_PROMPT) for (int item = F.vcu; item < 256; item += F.G) ret_prompt_item(F, item, Qp_, Kp_, Vp_, RO, out + O_RETP + (size_t)(J) * 8 * 4 * 256 * 512); \
        REPEAT(REP_SAMPLE) ret_sample_items(F, Qp_, Kp_, Vp_, RO, INP(I_SRET) + (size_t)(J) * 128 * 4 * 256 * 512, out + O_RETS + (size_t)(J) * 128 * 4 * 256 * 512); SEAM((pb) + 1); } \
    if (IN((pb) + 2)) { REPEAT(REP_GN) gatenorm_phase<0>(F, RO, SGp_, GO, nullptr); SEAM((pb) + 2); } \
    OUT_PROJ(pb, (const bf16*)(ws + WS_WRETOUT) + (size_t)(J) * D * 2048, 2048); \
    } while (0)

    RET_LAYER(0, 0, 3);
    FFN_BLOCK(0, 3, false);
    {
        constexpr int pb = 11;
        bf16* const SZ_ = (bf16*)(PJ + PJ_SSD_SZ); bf16* const XBC_ = (bf16*)(PJ + PJ_SSD_XBC); float* const DT_ = (float*)(PJ + PJ_SSD_DT);
        if (IN(pb + 0)) { const bf16* wt_ = (const bf16*)(ws + WS_WSSDIN); const EmitSsdIn e_{SZ_, XBC_}; const EmitDt ed_{DT_};
            MAIN_GEMM(EmitSsdIn, e_, Hb, wt_, SSD_INM, D);
            REPEAT(REP_SKINNY) skinny_gemm<8>(F, Hb + (size_t)MPR * D, D, 1, MS, MPR, wt_, (SSD_INM / 256) * 8, false, e_, 0, F.G);
            REPEAT(REP_SKINNY) skinny_gemm<8>(F, Hb, D, MT / 128, MT, 0, wt_, 1, true, ed_, 100, 129);
            SEAM(pb + 0); }
        if (IN(pb + 1)) {
            REPEAT(REP_PROMPT_SSD) for (int item = F.vcu; item < 256; item += F.G) ssd_prompt_item(F, item, XBC_, DT_, RO, out + O_SSDP, INP(I_CONVW), INP(I_CONVB), INP(I_DTB), INP(I_ALOG), INP(I_SSDD));
            REPEAT(REP_SAMPLE) ssd_sample_items(F, XBC_, DT_, RO, INP(I_SSSD), out + O_SSDS, INP(I_SCONV), INP(I_CONVW), INP(I_CONVB), INP(I_DTB), INP(I_ALOG), INP(I_SSDD));
            ssd_conv_out(F, XBC_, INP(I_SCONV), out + O_CONVP, out + O_CONVS);
            SEAM(pb + 1); }
        if (IN(pb + 2)) { REPEAT(REP_GN) gatenorm_phase<1>(F, RO, SZ_, GO, INP(I_SSDNORM)); SEAM(pb + 2); }
        OUT_PROJ(pb, (const bf16*)(ws + WS_WSSDOUT), 2048);
    }
    FFN_BLOCK(1, 11, false);
    {
        constexpr int pb = 19;
        bf16* const HQ_ = (bf16*)(PJ + PJ_HG_Q); float* const LA_ = (float*)(PJ + PJ_HG_LA); bf16* const HV_ = (bf16*)(PJ + PJ_HG_V); bf16* const HSG_ = (bf16*)(PJ + PJ_HG_SG);
        if (IN(pb + 0)) { const bf16* wt_ = (const bf16*)(ws + WS_WHGIN); const EmitHgIn e_{HQ_, HV_, HSG_, LA_, LB};
            MAIN_GEMM(EmitHgIn, e_, Hb, wt_, HG_IN, D); REPEAT(REP_SKINNY) skinny_gemm<8>(F, Hb + (size_t)MPR * D, D, 1, MS, MPR, wt_, (HG_IN / 256) * 8, false, e_, 0, F.G); SEAM(pb + 0); }
        if (IN(pb + 1)) {
            REPEAT(REP_PROMPT_HG) for (int item = F.vcu; item < 256; item += F.G) hg_prompt_item(F, item, HQ_, LA_, HV_, RO, out + O_HGP);
            REPEAT(REP_SAMPLE) hg_sample_items(F, HQ_, LA_, HV_, RO, INP(I_SHG), out + O_HGS);
            SEAM(pb + 1); }
        if (IN(pb + 2)) { REPEAT(REP_GN) gatenorm_phase<2>(F, RO, HSG_, GO, INP(I_HGNORM)); SEAM(pb + 2); }
        OUT_PROJ(pb, (const bf16*)(ws + WS_WHGOUT), 1024);
    }
    FFN_BLOCK(2, 19, false);
    RET_LAYER(3, 1, 27);
    FFN_BLOCK(3, 27, true);
#undef IN
#undef SEAM
}

extern "C" void kernel_launch(void* const* d_in, const int* in_sizes, int n_in, void* d_out, int out_size, void* d_ws, size_t ws_size, hipStream_t stream) {
    static int grid = 0;
    if (grid == 0) {
        if (n_in != 30 || (size_t)out_size != O_END || ws_size < WS_END) { fprintf(stderr, "kernel_launch: unexpected shapes (n_in %d out %d ws %zu)\n", n_in, out_size, ws_size); grid = -1; return; }
        int dev = 0, cus = 0, per_cu = 0;
        if (hipGetDevice(&dev) != hipSuccess || hipDeviceGetAttribute(&cus, hipDeviceAttributeMultiprocessorCount, dev) != hipSuccess) { grid = -1; return; }
        if (hipFuncSetAttribute((const void*)mk_fwd, hipFuncAttributeMaxDynamicSharedMemorySize, LDS_BYTES) != hipSuccess) { fprintf(stderr, "kernel_launch: hipFuncSetAttribute failed\n"); grid = -1; return; }
        if (hipOccupancyMaxActiveBlocksPerMultiprocessor(&per_cu, (const void*)mk_fwd, NWAVES * 64, LDS_BYTES) != hipSuccess || per_cu < 1) { fprintf(stderr, "kernel_launch: occupancy query says %d\n", per_cu); }
        (void)hipGetLastError();
        grid = cus;
    }
    if (grid < 0) return;
    if (hipMemsetAsync((char*)d_ws + WS_CTL, 0, CTL_ZERO_BYTES, stream) != hipSuccess) { fprintf(stderr, "kernel_launch: memset failed\n"); return; }
    Args a{};
    for (int i = 0; i < 30; ++i) a.in[i] = (const float*)d_in[i];
    a.out = (float*)d_out; a.ws = (unsigned char*)d_ws;
#if MK_N_LAUNCHES == 1
    a.ph_lo = 0; a.ph_hi = N_PHASES;
    hipLaunchKernelGGL(mk_fwd, dim3(grid), dim3(NWAVES * 64), LDS_BYTES, stream, a);
#else
    for (int p = 0; p < N_PHASES; ++p) { a.ph_lo = p; a.ph_hi = p + 1; hipLaunchKernelGGL(mk_fwd, dim3(grid), dim3(NWAVES * 64), LDS_BYTES, stream, a); }
#endif
    const hipError_t le = hipPeekAtLastError();
    if (le != hipSuccess) fprintf(stderr, "kernel_launch: launch failed: %s\n", hipGetErrorName(le));
}
```

```cpp
#include <hip/hip_runtime.h>
#include <cstdio>
#include <cstdint>
namespace pg8 {
#define PG8_LAS __attribute__((address_space(3)))
typedef unsigned short bf16_t;
typedef short bf16x8 __attribute__((ext_vector_type(8)));
typedef float f32x4 __attribute__((ext_vector_type(4)));
typedef unsigned u32x4 __attribute__((ext_vector_type(4)));
constexpr int BM = 256, BK = 64, HALF = 128, HTB = HALF * BK * 2  , STAGE_BYTES = 8 * HTB, NXCD = 8, WGM = 8;

__host__ __device__ __forceinline__ int lds_byte(int r, int c) { const int st = (r >> 4) * 2 + (c >> 5), rr = r & 15, cc = c & 31, ob = rr * 64 + cc * 2; return st * 1024 + (ob ^ (((ob >> 9) & 1) << 5)); }
__host__ __device__ __forceinline__ void stage_rc(int b, int& R, int& C) { const int st = b / 1024, sb = b % 1024, swz = sb ^ (((sb >> 9) & 1) << 5); R = (st >> 1) * 16 + swz / 64; C = (st & 1) * 32 + (swz % 64) / 2; }
__host__ __device__ __forceinline__ int perm32(int rho) { const int n = rho >> 4, i = rho & 15; return 8 * (i >> 2) + 4 * n + (i & 3); }

struct Unit { int pm, pn; };
struct Gemm { const bf16_t* A; const bf16_t* Bt; int M, N, K; };

struct StaticOrder {
    int nM, nN, nwg, G, c;
    __host__ __device__ void init(int M, int N, int G_, int c_) { nM = M / BM; nN = N / BM; nwg = nM * nN; G = G_; c = c_; }
    __host__ __device__ bool next(int i, Unit& u) const {
        const long L = (long)i * G + c; if (L >= nwg) return false;
        int wgid = (int)L; { const int q = nwg / NXCD, r = nwg % NXCD, xcd = wgid % NXCD, off = wgid / NXCD; wgid = (xcd < r ? xcd * (q + 1) : r * (q + 1) + (xcd - r) * q) + off; }
        const int nig = WGM * nN, gid = wgid / nig, fm = gid * WGM, gsz = (nM - fm) < WGM ? (nM - fm) : WGM;
        u.pm = fm + ((wgid % nig) % gsz); u.pn = (wgid % nig) / gsz; return true;
    }
    __device__ __forceinline__ void a_ready(const Unit&) const {}
    __device__ __forceinline__ void done(const Unit&) const {}
};

__device__ __forceinline__ unsigned cvt_pk_bf16(float lo, float hi) { unsigned r; asm volatile("v_cvt_pk_bf16_f32 %0, %1, %2" : "=v"(r) : "v"(lo), "v"(hi)); return r; }
typedef float f32x2 __attribute__((ext_vector_type(2)));
template <class Epi, class Sched, bool ALIGN_EPI = false, bool SP2 = false>
__device__ __forceinline__ void gemm_phase(PG8_LAS unsigned char* lds, const Gemm g, const Sched& S, const Epi& E) {
    const int tid = threadIdx.x, wid = __builtin_amdgcn_readfirstlane(tid >> 6), lane = tid & 63, wr = wid >> 2, wc = wid & 3, fr = lane & 15, fq = lane >> 4;
    const int K = g.K, nt = K / BK;
    unsigned voffA[2], voffB[2];
#pragma unroll
    for (int i = 0; i < 2; ++i) { int R, C; stage_rc(tid * 16 + i * 8192, R, C); const int Rb = Epi::PERM ? ((R & ~31) + perm32(R & 31)) : R;
        voffA[i] = (unsigned)(R * K + C) * 2u; voffB[i] = (unsigned)(Rb * K + C) * 2u; }
    const size_t kstep = (size_t)(BK * 2);
    const size_t hstep = (size_t)HALF * K * 2;
    const size_t tstep = 2 * hstep;
    const unsigned ldsw = (unsigned)wid * 1024u;
    const int aoff = lds_byte(wr * 64 + fr, fq * 8), boff = lds_byte(wc * 32 + fr, fq * 8);
#define PG8_SA(b, h) (((b) * 2 + (h)) * HTB)
#define PG8_SB(b, h) ((4 + (b) * 2 + (h)) * HTB)
#define PG8_STAGE(bufoff, gbase, voff) do { _Pragma("unroll") for (int _i = 0; _i < 2; ++_i) \
        __builtin_amdgcn_global_load_lds((const unsigned*)((const char*)(gbase) + (voff)[_i]), (PG8_LAS unsigned*)(lds + (bufoff) + ldsw + _i * 8192), 16, 0, 0); } while (0)
#define PG8_LDA(dst, b, h) do { _Pragma("unroll") for (int m = 0; m < 4; ++m) _Pragma("unroll") for (int k = 0; k < 2; ++k) dst[m][k] = *(const PG8_LAS bf16x8*)(lds + PG8_SA(b, h) + aoff + m * 2048 + k * 1024); } while (0)
#define PG8_LDB(dst, b, h) do { _Pragma("unroll") for (int n = 0; n < 2; ++n) _Pragma("unroll") for (int k = 0; k < 2; ++k) dst[n][k] = *(const PG8_LAS bf16x8*)(lds + PG8_SB(b, h) + boff + n * 2048 + k * 1024); } while (0)
#define PG8_MMA(ai, bj, At, Bt) do { __builtin_amdgcn_s_setprio(1); _Pragma("unroll") for (int m = 0; m < 4; ++m) _Pragma("unroll") for (int n = 0; n < 2; ++n) _Pragma("unroll") for (int k = 0; k < 2; ++k) \
        acc[ai][bj][m][n] = __builtin_amdgcn_mfma_f32_16x16x32_bf16(Bt[n][k], At[m][k], acc[ai][bj][m][n], 0, 0, 0); __builtin_amdgcn_s_setprio(0); } while (0)
#define PG8_WAIT_V(n) asm volatile("s_waitcnt vmcnt(" #n ")" ::: "memory")
#define PG8_WAIT_L(n) asm volatile("s_waitcnt lgkmcnt(" #n ")" ::: "memory")
#define PG8_BAR __builtin_amdgcn_s_barrier()
#define PG8_SCHED __builtin_amdgcn_sched_barrier(0)
    Unit cur, nxt; int ui = 0;
    if (!S.next(0, cur)) return;
    f32x4 acc[2][2][4][2];
#pragma unroll
    for (int a = 0; a < 2; ++a)
#pragma unroll
        for (int b = 0; b < 2; ++b)
#pragma unroll
            for (int m = 0; m < 4; ++m)
#pragma unroll
                for (int n = 0; n < 2; ++n) acc[a][b][m][n] = (f32x4){0.f, 0.f, 0.f, 0.f};
    bf16x8 At[4][2], B0[2][2], B1[2][2];
    const char* cA = (const char*)g.A + (size_t)cur.pm * tstep; const char* cB = (const char*)g.Bt + (size_t)cur.pn * tstep;
    S.a_ready(cur);
    if constexpr (SP2) {
        PG8_STAGE(PG8_SB(0, 0), cB, voffB); PG8_STAGE(PG8_SB(0, 1), cB + hstep, voffB); PG8_STAGE(PG8_SA(0, 0), cA, voffA); PG8_STAGE(PG8_SA(0, 1), cA + hstep, voffA);
        if (wr == 1) PG8_BAR;
        PG8_WAIT_V(2); PG8_BAR;
        PG8_STAGE(PG8_SB(1, 0), cB + kstep, voffB); PG8_STAGE(PG8_SA(1, 0), cA + kstep, voffA); PG8_STAGE(PG8_SB(1, 1), cB + hstep + kstep, voffB);
        PG8_WAIT_V(6); PG8_BAR;
    } else {
        PG8_STAGE(PG8_SB(0, 0), cB, voffB); PG8_STAGE(PG8_SA(0, 0), cA, voffA); PG8_STAGE(PG8_SB(0, 1), cB + hstep, voffB); PG8_STAGE(PG8_SA(0, 1), cA + hstep, voffA);
        if (wr == 1) PG8_BAR;
        PG8_WAIT_V(4); PG8_BAR;
        PG8_STAGE(PG8_SB(1, 0), cB + kstep, voffB); PG8_STAGE(PG8_SA(1, 0), cA + kstep, voffA); PG8_STAGE(PG8_SB(1, 1), cB + hstep + kstep, voffB);
        PG8_WAIT_V(6); PG8_BAR;
    }
    for (;;) {
        const bool has_next = S.next(ui + 1, nxt);
        const char* nA = has_next ? (const char*)g.A + (size_t)nxt.pm * tstep : cA; const char* nB = has_next ? (const char*)g.Bt + (size_t)nxt.pn * tstep : cB;
        for (int t = 0; t < nt; t += 2) {
            const bool last = (t == nt - 2);
            const char* a1 = cA + (size_t)(t + 1) * kstep;
            const char* a2 = last ? nA : cA + (size_t)(t + 2) * kstep; const char* b2 = last ? nB : cB + (size_t)(t + 2) * kstep;
            const char* a3 = a2 + kstep; const char* b3 = b2 + kstep;
            if (last && has_next) S.a_ready(nxt);
            if constexpr (SP2) {
            PG8_LDB(B0, 0, 0); PG8_LDB(B1, 0, 1); PG8_SCHED; PG8_LDA(At, 0, 0); PG8_STAGE(PG8_SA(1, 1), a1 + hstep, voffA);
            PG8_WAIT_V(8); PG8_WAIT_L(0); PG8_BAR; PG8_MMA(0, 0, At, B0); PG8_MMA(0, 1, At, B1); PG8_BAR; PG8_SCHED;
            PG8_LDA(At, 0, 1); PG8_STAGE(PG8_SB(0, 0), b2, voffB); PG8_STAGE(PG8_SB(0, 1), b2 + hstep, voffB); PG8_STAGE(PG8_SA(0, 0), a2, voffA);
            PG8_WAIT_V(8); PG8_WAIT_L(0); PG8_BAR; PG8_MMA(1, 0, At, B0); PG8_MMA(1, 1, At, B1); PG8_BAR; PG8_SCHED;
            PG8_LDB(B0, 1, 0); PG8_LDB(B1, 1, 1); PG8_SCHED; PG8_LDA(At, 1, 0); PG8_STAGE(PG8_SA(0, 1), a2 + hstep, voffA);
            PG8_WAIT_V(8); PG8_WAIT_L(0); PG8_BAR; PG8_MMA(0, 0, At, B0); PG8_MMA(0, 1, At, B1); PG8_BAR; PG8_SCHED;
            PG8_LDA(At, 1, 1); PG8_STAGE(PG8_SB(1, 0), b3, voffB); PG8_STAGE(PG8_SB(1, 1), b3 + hstep, voffB); PG8_STAGE(PG8_SA(1, 0), a3, voffA);
            PG8_WAIT_V(8); PG8_WAIT_L(0); PG8_BAR; PG8_MMA(1, 0, At, B0); PG8_MMA(1, 1, At, B1); PG8_BAR; PG8_SCHED;
            } else {
            PG8_LDB(B0, 0, 0); PG8_SCHED; PG8_LDA(At, 0, 0); PG8_STAGE(PG8_SA(1, 1), a1 + hstep, voffA);
            PG8_WAIT_L(8); PG8_BAR; PG8_WAIT_L(0); PG8_MMA(0, 0, At, B0); PG8_BAR; PG8_SCHED;
            PG8_LDB(B1, 0, 1); PG8_STAGE(PG8_SB(0, 0), b2, voffB);
            PG8_BAR; PG8_WAIT_L(0); PG8_MMA(0, 1, At, B1); PG8_BAR;
            PG8_LDA(At, 0, 1); PG8_STAGE(PG8_SA(0, 0), a2, voffA);
            PG8_BAR; PG8_WAIT_L(0); PG8_MMA(1, 0, At, B0); PG8_BAR; PG8_SCHED;
            PG8_STAGE(PG8_SB(0, 1), b2 + hstep, voffB);
            PG8_WAIT_V(6); PG8_BAR; PG8_MMA(1, 1, At, B1); PG8_BAR;
            PG8_LDB(B0, 1, 0); PG8_SCHED; PG8_LDA(At, 1, 0); PG8_STAGE(PG8_SA(0, 1), a2 + hstep, voffA);
            PG8_WAIT_L(8); PG8_BAR; PG8_WAIT_L(0); PG8_MMA(0, 0, At, B0); PG8_BAR; PG8_SCHED;
            PG8_LDB(B1, 1, 1); PG8_STAGE(PG8_SB(1, 0), b3, voffB);
            PG8_BAR; PG8_WAIT_L(0); PG8_MMA(0, 1, At, B1); PG8_BAR;
            PG8_LDA(At, 1, 1); PG8_STAGE(PG8_SA(1, 0), a3, voffA);
            PG8_BAR; PG8_WAIT_L(0); PG8_MMA(1, 0, At, B0); PG8_BAR; PG8_SCHED;
            PG8_STAGE(PG8_SB(1, 1), b3 + hstep, voffB);
            PG8_WAIT_V(6); PG8_BAR; PG8_MMA(1, 1, At, B1); PG8_BAR;
            }
        }
        if constexpr (ALIGN_EPI) { if (wr == 0) PG8_BAR; }
        if constexpr (!Epi::AFTER_DRAIN) { E(acc, cur, wr, wc, fr, fq); S.done(cur); }
        if (!has_next) break;
#pragma unroll
        for (int a = 0; a < 2; ++a)
#pragma unroll
            for (int b = 0; b < 2; ++b)
#pragma unroll
                for (int m = 0; m < 4; ++m)
#pragma unroll
                    for (int n = 0; n < 2; ++n) acc[a][b][m][n] = (f32x4){0.f, 0.f, 0.f, 0.f};
        cur = nxt; cA = nA; cB = nB; ++ui;
        if constexpr (ALIGN_EPI) { if (wr == 1) PG8_BAR; }
    }
    PG8_WAIT_V(0);
    if constexpr (!ALIGN_EPI) { if (wr == 0) PG8_BAR; }
    PG8_BAR;
    if constexpr (Epi::AFTER_DRAIN) { E.fused(acc, cur, wr, wc, fr, fq, lds, wid, lane); S.done(cur); }
#undef PG8_SA
#undef PG8_SB
#undef PG8_STAGE
#undef PG8_LDA
#undef PG8_LDB
#undef PG8_MMA
#undef PG8_WAIT_V
#undef PG8_WAIT_L
#undef PG8_BAR
#undef PG8_SCHED
}
}

#ifndef PG8_SP2
#define PG8_SP2 true
#endif
#ifndef PG8_ALIGN
#define PG8_ALIGN true
#endif
#ifndef MK_N_LAUNCHES
#define MK_N_LAUNCHES 1
#endif

constexpr int D = 1024, BP = 8, SEQ = 2048, MPR = BP * SEQ  , MS = 128  , MT = MPR + MS  ;
constexpr int NCOND = BP + MS;
constexpr int DFF = 2816, NMOD = 6 * D  , NMODALL = 4 * NMOD  ;
constexpr int RET_IN = 6144, SSD_IN = 5152, SSD_INM = 5120, HG_IN = 4096, FFN_IN = 2 * DFF;
constexpr float EPS = 1e-6f;
constexpr int NWAVES = 8;

constexpr size_t MiB = 1u << 20;
constexpr size_t WS_CTL = 0, CTL_ZERO_BYTES = 1 * MiB;
constexpr size_t WS_WADA = 1 * MiB;
constexpr size_t WS_WRETIN = WS_WADA + 48 * MiB;
constexpr size_t WS_WRETOUT = WS_WRETIN + 24 * MiB;
constexpr size_t WS_WSSDIN = WS_WRETOUT + 8 * MiB;
constexpr size_t WS_WSSDOUT = WS_WSSDIN + 11 * MiB;
constexpr size_t WS_WHGIN = WS_WSSDOUT + 4 * MiB;
constexpr size_t WS_WHGOUT = WS_WHGIN + 8 * MiB;
constexpr size_t WS_WFFNIN = WS_WHGOUT + 2 * MiB;
constexpr size_t WS_WFFNOUT = WS_WFFNIN + 44 * MiB;
constexpr size_t WS_MOD = WS_WFFNOUT + 22 * MiB;
constexpr size_t WS_CACT = WS_MOD + 24 * MiB;
constexpr size_t WS_LB = WS_CACT + 512 * 1024;
constexpr size_t WS_H = WS_CACT + 1 * MiB;
constexpr size_t WS_PROJ = WS_H + 33 * MiB;
constexpr size_t WS_RO = WS_PROJ + 200 * MiB;
constexpr size_t WS_GO = WS_RO + 65 * MiB;
constexpr size_t WS_OUT = WS_GO + 65 * MiB;
constexpr size_t WS_ACT = WS_OUT + 33 * MiB;
constexpr size_t WS_XB = WS_ACT + 89 * MiB;
constexpr size_t WS_END = WS_XB + 33 * MiB;
constexpr size_t PJ_RET_Q = 0, PJ_RET_K = PJ_RET_Q + (size_t)MT * 1024 * 2, PJ_RET_V = PJ_RET_K + (size_t)MT * 1024 * 2, PJ_RET_SG = PJ_RET_V + (size_t)MT * 2048 * 2;
constexpr size_t PJ_SSD_SZ = 0, PJ_SSD_XBC = PJ_SSD_SZ + (size_t)MT * 2048 * 2, PJ_SSD_DT = PJ_SSD_XBC + (size_t)MT * 3072 * 2;
constexpr size_t PJ_HG_Q = 0, PJ_HG_LA = PJ_HG_Q + (size_t)MT * 1024 * 2, PJ_HG_V = PJ_HG_LA + (size_t)MT * 1024 * 4, PJ_HG_SG = PJ_HG_V + (size_t)MT * 1024 * 2;
static_assert(PJ_RET_SG + (size_t)MT * 2048 * 2 <= 200 * MiB && PJ_SSD_DT + (size_t)MT * 32 * 4 <= 200 * MiB && PJ_HG_SG + (size_t)MT * 1024 * 2 <= 200 * MiB, "proj map");
constexpr int CW_BAR = 4096;

constexpr size_t O_Y = 0;
constexpr size_t O_RETP = (size_t)MT * D;
constexpr size_t O_RETS = O_RETP + (size_t)2 * 8 * 4 * 256 * 512;
constexpr size_t O_SSDP = O_RETS + (size_t)2 * 128 * 4 * 256 * 512;
constexpr size_t O_SSDS = O_SSDP + (size_t)8 * 32 * 128 * 64;
constexpr size_t O_CONVP = O_SSDS + (size_t)128 * 32 * 128 * 64;
constexpr size_t O_CONVS = O_CONVP + (size_t)8 * 3 * 3072;
constexpr size_t O_HGP = O_CONVS + (size_t)128 * 3 * 3072;
constexpr size_t O_HGS = O_HGP + (size_t)8 * 8 * 128 * 128;
constexpr size_t O_END = O_HGS + (size_t)128 * 8 * 128 * 128;
static_assert(O_END == 214245376ull, "output size");

constexpr int LDS_BYTES = 147456;
constexpr int LDSCTL_OFF = LDS_BYTES - 1024;
constexpr int SCR_BYTES = LDSCTL_OFF;

#define GAS __attribute__((address_space(1)))
#define LAS __attribute__((address_space(3)))
typedef unsigned short bf16;
typedef unsigned v4u __attribute__((ext_vector_type(4)));
typedef unsigned v2u __attribute__((ext_vector_type(2)));
typedef float f32x4 __attribute__((ext_vector_type(4)));
typedef short bf16x8 __attribute__((ext_vector_type(8)));
typedef short s16x4 __attribute__((ext_vector_type(4)));
typedef GAS unsigned gu32;
#define RLX_AGENT __ATOMIC_RELAXED, __HIP_MEMORY_SCOPE_AGENT
#define LDS_WAIT() asm volatile("s_waitcnt lgkmcnt(0)" ::: "memory")
#define VM_WAIT() asm volatile("s_waitcnt vmcnt(0)" ::: "memory")
typedef float f32x2_t __attribute__((ext_vector_type(2))); typedef __bf16 bf16x2_t __attribute__((ext_vector_type(2)));
__device__ __forceinline__ unsigned cvt_pk_bf16(float lo, float hi) { f32x2_t v = {lo, hi}; bf16x2_t b = __builtin_convertvector(v, bf16x2_t); return __builtin_bit_cast(unsigned, b); }
__device__ __forceinline__ float bf2f(unsigned b) { return __uint_as_float(b << 16); }
__device__ __forceinline__ float bflo(unsigned w) { return __uint_as_float(w << 16); }
__device__ __forceinline__ float bfhi(unsigned w) { return __uint_as_float(w & 0xffff0000u); }
__device__ __forceinline__ void unpack8(const v4u w, float (&f)[8]) { f[0] = bflo(w.x); f[1] = bfhi(w.x); f[2] = bflo(w.y); f[3] = bfhi(w.y); f[4] = bflo(w.z); f[5] = bfhi(w.z); f[6] = bflo(w.w); f[7] = bfhi(w.w); }
__device__ __forceinline__ v4u pack8(const float (&f)[8]) { v4u w; w.x = cvt_pk_bf16(f[0], f[1]); w.y = cvt_pk_bf16(f[2], f[3]); w.z = cvt_pk_bf16(f[4], f[5]); w.w = cvt_pk_bf16(f[6], f[7]); return w; }
__device__ __forceinline__ v4u pack8v(const f32x4 a, const f32x4 b) { v4u w; w.x = cvt_pk_bf16(a[0], a[1]); w.y = cvt_pk_bf16(a[2], a[3]); w.z = cvt_pk_bf16(b[0], b[1]); w.w = cvt_pk_bf16(b[2], b[3]); return w; }
__device__ __forceinline__ v2u pack4v(const f32x4 a) { v2u w; w.x = cvt_pk_bf16(a[0], a[1]); w.y = cvt_pk_bf16(a[2], a[3]); return w; }
__device__ __forceinline__ float sigmoidf_(float x) { return __builtin_amdgcn_rcpf(1.f + __expf(-x)); }
__device__ __forceinline__ float siluf_(float x) { return x * sigmoidf_(x); }
__device__ __forceinline__ float softplusf_(float x) { return x > 20.f ? x : log1pf(__expf(x)); }
__device__ __forceinline__ float wave_sum(float v) {
#pragma unroll
    for (int o = 1; o < 64; o <<= 1) v += __shfl_xor(v, o);
    return v;
}
__device__ __forceinline__ float grp16_sum(float v) {
#pragma unroll
    for (int o = 1; o < 16; o <<= 1) v += __shfl_xor(v, o);
    return v;
}
#define MFMA16(a, b, c) __builtin_amdgcn_mfma_f32_16x16x32_bf16((a), (b), (c), 0, 0, 0)
#define XB_TMO      128
#define XB_XCNT(j)  (256  + 64 * (j))
#define XB_XSUB(j)  (1280 + 64 * (j))
#define XB_XGEN(j)  (2304 + 64 * (j))
#define XB_TOP      3328
#define XB_TOPGEN   3392
#define XCD_BAR_WORDS 3456
#define XB_SPIN_CAP (1u << 18)

__device__ __forceinline__ unsigned xb_ld(unsigned* p)              { return __hip_atomic_load(p, __ATOMIC_RELAXED, __HIP_MEMORY_SCOPE_AGENT); }
__device__ __forceinline__ unsigned xb_add(unsigned* p, unsigned v) { return __hip_atomic_fetch_add(p, v, __ATOMIC_RELAXED, __HIP_MEMORY_SCOPE_AGENT); }
__device__ __forceinline__ unsigned xb_xcc_id() { return (unsigned)__builtin_amdgcn_s_getreg((3 << 11) | 20) & 0xFu; }
#define XB_SPIN(cond, bar) do { unsigned _sp = 0; while (cond) { __builtin_amdgcn_s_sleep(1); \
    if ((++_sp & 255u) == 0u) { if (xb_ld(&(bar)[XB_TMO])) break; if (_sp > XB_SPIN_CAP) { atomicAdd(&(bar)[XB_TMO], 1u); break; } } } } while (0)

struct XcdBarrier {
    unsigned* bar; unsigned x;
    volatile LAS unsigned* st;
};

__device__ __forceinline__ XcdBarrier xcd_barrier_post(unsigned* bar, volatile LAS unsigned* st) {
    XcdBarrier b; b.bar = bar; b.x = xb_xcc_id(); b.st = st;
    if (threadIdx.x == 0) (void)xb_add(&bar[XB_XCNT(b.x)], 1u);
    return b;
}
__device__ __forceinline__ void xcd_barrier_complete(unsigned* bar, unsigned x, unsigned& nloc, unsigned& nx) {
    const unsigned G = gridDim.x * gridDim.y * gridDim.z;
    unsigned sum, cnt, mine, sp = 0u;
    for (;;) {
        sum = 0u; cnt = 0u; mine = 0u;
#pragma unroll
        for (unsigned j = 0; j < 16; ++j) { const unsigned c = xb_ld(&bar[XB_XCNT(j)]); sum += c; cnt += (c > 0u) ? 1u : 0u; mine = (j == x) ? c : mine; }
        if (sum == G) break;
        __builtin_amdgcn_s_sleep(1);
        if ((++sp & 255u) == 0u) { if (xb_ld(&bar[XB_TMO])) break; if (sp > XB_SPIN_CAP) { atomicAdd(&bar[XB_TMO], 1u); break; } }
    }
    nloc = mine > 0u ? mine : 1u; nx = cnt > 0u ? cnt : 1u;
}

__device__ __forceinline__ void xcd_barrier(const XcdBarrier& b) {
    asm volatile("s_waitcnt vmcnt(0)" ::: "memory");
    __syncthreads();
    if (threadIdx.x == 0) {
        unsigned* bar = b.bar;
        __builtin_amdgcn_s_waitcnt(0);
        unsigned nloc = b.st[0], nx = b.st[1];
        if (nloc == 0u) { xcd_barrier_complete(bar, b.x, nloc, nx); b.st[0] = nloc; b.st[1] = nx; }
        const unsigned old = xb_add(&bar[XB_XSUB(b.x)], 1u);
        const unsigned gen = old / nloc;
        if (old + 1u == (gen + 1u) * nloc) {
            __builtin_amdgcn_fence(__ATOMIC_RELEASE, "agent");
            asm volatile("s_waitcnt vmcnt(0)" ::: "memory");
            const unsigned og = xb_add(&bar[XB_TOP], 1u);
            const unsigned tg = og / nx;
            if (og + 1u == (tg + 1u) * nx) xb_add(&bar[XB_TOPGEN], 1u);
            else XB_SPIN(xb_ld(&bar[XB_TOPGEN]) == tg, bar);
            __builtin_amdgcn_fence(__ATOMIC_ACQUIRE, "agent");
            xb_add(&bar[XB_XGEN(b.x)], 1u);
            asm volatile("s_waitcnt vmcnt(0)" ::: "memory");
        } else {
            XB_SPIN(xb_ld(&bar[XB_XGEN(b.x)]) == gen, bar);
            __builtin_amdgcn_fence(__ATOMIC_ACQUIRE, "agent");
            asm volatile("s_waitcnt vmcnt(0)" ::: "memory");
        }
    }
    __syncthreads();
}


struct Frame {
    LAS unsigned char* lds;
    int tid, lane, wave;
    int vcu, G;
};

template <class Fn> struct EpiGen {
    static constexpr bool PERM = true, AFTER_DRAIN = false;
    Fn f;
    __device__ __forceinline__ void operator()(const pg8::f32x4 (&acc)[2][2][4][2], const pg8::Unit& u, int wr, int wc, int fr, int fq) const {
        const int ca = u.pn * 256 + wc * 32 + 8 * fq;
#pragma unroll
        for (int ai = 0; ai < 2; ++ai)
#pragma unroll
            for (int m = 0; m < 4; ++m) {
                const int row = u.pm * 256 + ai * 128 + wr * 64 + m * 16 + fr;
                f.emit(row, ca, ca + 128, acc[ai][0][m][0], acc[ai][0][m][1], acc[ai][1][m][0], acc[ai][1][m][1]);
            }
    }
};
__device__ __forceinline__ void st8bf(bf16* p, const f32x4 a, const f32x4 b) { *(GAS v4u*)p = pack8v(a, b); }
__device__ __forceinline__ f32x4 silu4(const f32x4 a) { f32x4 r; r[0] = siluf_(a[0]); r[1] = siluf_(a[1]); r[2] = siluf_(a[2]); r[3] = siluf_(a[3]); return r; }

struct EmitRetIn {
    bf16 *Q, *K, *V, *SG;
    __device__ __forceinline__ void emit(int row, int ca, int cb, const f32x4 a0, const f32x4 a1, const f32x4 b0, const f32x4 b1) const {
        const int pn = ca >> 8, ch = ca & 255;
        if (pn < 8) {
            const float pos = row < MPR ? (float)(row & (SEQ - 1)) : 16384.f;
            const float sc = pn < 4 ? 1.f : 0.0625f;
            float x1[8] = {a0[0], a0[1], a0[2], a0[3], a1[0], a1[1], a1[2], a1[3]}, x2[8] = {b0[0], b0[1], b0[2], b0[3], b1[0], b1[1], b1[2], b1[3]}, o1[8], o2[8];
#pragma unroll
            for (int e = 0; e < 8; ++e) {
                const float inv = exp2f(-(float)(ch + e) * (13.287712379549449f / 128.f));
                float t = pos * inv * 0.15915494309189535f; t -= floorf(t);
                const float s = __builtin_amdgcn_sinf(t), c = __builtin_amdgcn_cosf(t);
                o1[e] = (x1[e] * c - x2[e] * s) * sc; o2[e] = (x2[e] * c + x1[e] * s) * sc;
            }
            bf16* dst = (pn < 4 ? Q : K) + (size_t)row * 1024 + (pn & 3) * 256 + ch;
            *(GAS v4u*)dst = pack8(o1); *(GAS v4u*)(dst + 128) = pack8(o2);
        } else if (pn < 16) {
            bf16* dst = V + (size_t)row * 2048 + (pn - 8) * 256 + ch; st8bf(dst, a0, a1); st8bf(dst + 128, b0, b1);
        } else {
            bf16* dst = SG + (size_t)row * 2048 + (pn - 16) * 256 + ch; st8bf(dst, silu4(a0), silu4(a1)); st8bf(dst + 128, silu4(b0), silu4(b1));
        }
    }
};
struct EmitSsdIn {
    bf16 *SZ, *XBC;
    __device__ __forceinline__ void emit(int row, int ca, int cb, const f32x4 a0, const f32x4 a1, const f32x4 b0, const f32x4 b1) const {
        const int pn = ca >> 8, ch = ca & 255;
        if (pn < 8) { bf16* dst = SZ + (size_t)row * 2048 + pn * 256 + ch; st8bf(dst, silu4(a0), silu4(a1)); st8bf(dst + 128, silu4(b0), silu4(b1)); }
        else { bf16* dst = XBC + (size_t)row * 3072 + (pn - 8) * 256 + ch; st8bf(dst, a0, a1); st8bf(dst + 128, b0, b1); }
    }
};
struct EmitDt {
    float* DT;
    __device__ __forceinline__ void emit(int row, int ca, int cb, const f32x4 a0, const f32x4 a1, const f32x4 b0, const f32x4 b1) const {
        float* d = DT + (size_t)row * 32; *(GAS f32x4*)(d + (ca - SSD_INM)) = a0; *(GAS f32x4*)(d + (ca - SSD_INM) + 4) = a1; *(GAS f32x4*)(d + (cb - SSD_INM)) = b0; *(GAS f32x4*)(d + (cb - SSD_INM) + 4) = b1;
    }
};
struct EmitHgIn {
    bf16 *HQ, *HV, *HSG; float* LA; const float* lb;
    __device__ __forceinline__ f32x4 logf4(const f32x4 x, const float* l) const { f32x4 r;
#pragma unroll
        for (int e = 0; e < 4; ++e) { const float b = l[e]; r[e] = logf(b + (1.f - b) * sigmoidf_(x[e])); } return r; }
    __device__ __forceinline__ void emit(int row, int ca, int cb, const f32x4 a0, const f32x4 a1, const f32x4 b0, const f32x4 b1) const {
        const int pn = ca >> 8, ch = ca & 255;
        if (pn < 4) { bf16* dst = HQ + (size_t)row * 1024 + pn * 256 + ch; const float s = 0.08838834764831845f; st8bf(dst, silu4(a0) * s, silu4(a1) * s); st8bf(dst + 128, silu4(b0) * s, silu4(b1) * s); }
        else if (pn < 8) { const int col = (pn - 4) * 256 + ch; float* dst = LA + (size_t)row * 1024 + col;
            *(GAS f32x4*)dst = logf4(a0, lb + col); *(GAS f32x4*)(dst + 4) = logf4(a1, lb + col + 4); *(GAS f32x4*)(dst + 128) = logf4(b0, lb + col + 128); *(GAS f32x4*)(dst + 132) = logf4(b1, lb + col + 132); }
        else if (pn < 12) { bf16* dst = HV + (size_t)row * 1024 + (pn - 8) * 256 + ch; st8bf(dst, a0, a1); st8bf(dst + 128, b0, b1); }
        else { bf16* dst = HSG + (size_t)row * 1024 + (pn - 12) * 256 + ch; st8bf(dst, silu4(a0), silu4(a1)); st8bf(dst + 128, silu4(b0), silu4(b1)); }
    }
};
struct EmitOut {
    bf16* OUT;
    __device__ __forceinline__ void emit(int row, int ca, int cb, const f32x4 a0, const f32x4 a1, const f32x4 b0, const f32x4 b1) const {
        bf16* dst = OUT + (size_t)row * 1024; st8bf(dst + ca, a0, a1); st8bf(dst + cb, b0, b1);
    }
};
struct EmitFfnIn {
    bf16* ACT;
    __device__ __forceinline__ void emit(int row, int ca, int cb, const f32x4 a0, const f32x4 a1, const f32x4 b0, const f32x4 b1) const {
        bf16* dst = ACT + (size_t)row * DFF + (ca >> 8) * 128 + (ca & 255); st8bf(dst, silu4(a0) * b0, silu4(a1) * b1);
    }
};
struct EmitMod {
    float* MOD; const float* bias;
    __device__ __forceinline__ void emit(int row, int ca, int cb, const f32x4 a0, const f32x4 a1, const f32x4 b0, const f32x4 b1) const {
        float* d = MOD + (size_t)row * NMODALL;
        *(GAS f32x4*)(d + ca) = a0 + *(const GAS f32x4*)(bias + ca); *(GAS f32x4*)(d + ca + 4) = a1 + *(const GAS f32x4*)(bias + ca + 4);
        *(GAS f32x4*)(d + cb) = b0 + *(const GAS f32x4*)(bias + cb); *(GAS f32x4*)(d + cb + 4) = b1 + *(const GAS f32x4*)(bias + cb + 4);
    }
};

template <int NMT, class Fn>
__device__ __forceinline__ void skinny_gemm(Frame& F, const bf16* A, int K, int nrg, int nrows, int rowbase, const bf16* Bt, int ncu, bool dtmode, const Fn& f, int wg0, int span) {
    const int w = F.wave, lane = F.lane, fr = lane & 15, fq = lane >> 4, KW = K >> 3, nsteps = KW >> 5;
    constexpr int R = NMT * 16;
    LAS unsigned char* red = F.lds;
    const int nun = nrg * ncu, me = (int)blockIdx.x - wg0;
    if (me >= 0 && me < span) {
    for (int u = me; u < nun; u += span) {
        const int rg = u / ncu, cu = u - rg * ncu;
        int ca, cb; if (dtmode) { ca = SSD_INM; cb = SSD_INM + 16; } else { ca = 256 * (cu >> 3) + 16 * (cu & 7); cb = ca + 128; }
        int nact = (nrows - rg * R + 15) >> 4; nact = nact > NMT ? NMT : nact;
        const bf16* ap = A + (size_t)(rg * R + fr) * K + w * KW + fq * 8;
        const bf16* bpa = Bt + (size_t)(ca + fr) * K + w * KW + fq * 8;
        const bf16* bpb = Bt + (size_t)(cb + fr) * K + w * KW + fq * 8;
        f32x4 acc[NMT][2];
#pragma unroll
        for (int mt = 0; mt < NMT; ++mt) { acc[mt][0] = (f32x4){0.f, 0.f, 0.f, 0.f}; acc[mt][1] = (f32x4){0.f, 0.f, 0.f, 0.f}; }
        bf16x8 ca_[NMT], cb0, cb1, na_[NMT], nb0, nb1;
        cb0 = *(const GAS bf16x8*)(bpa); cb1 = *(const GAS bf16x8*)(bpb);
#pragma unroll
        for (int mt = 0; mt < NMT; ++mt) { ca_[mt] = (bf16x8){0, 0, 0, 0, 0, 0, 0, 0}; if (mt < nact) ca_[mt] = *(const GAS bf16x8*)(ap + (size_t)mt * 16 * K); }
#pragma unroll 2
        for (int s = 0; s < nsteps; ++s) {
            const int k1 = (s + 1 < nsteps ? s + 1 : s) * 32;
            nb0 = *(const GAS bf16x8*)(bpa + k1); nb1 = *(const GAS bf16x8*)(bpb + k1);
#pragma unroll
            for (int mt = 0; mt < NMT; ++mt) { na_[mt] = ca_[mt]; if (mt < nact) na_[mt] = *(const GAS bf16x8*)(ap + (size_t)mt * 16 * K + k1); }
#pragma unroll
            for (int mt = 0; mt < NMT; ++mt) if (mt < nact) { acc[mt][0] = MFMA16(cb0, ca_[mt], acc[mt][0]); acc[mt][1] = MFMA16(cb1, ca_[mt], acc[mt][1]); }
            cb0 = nb0; cb1 = nb1;
#pragma unroll
            for (int mt = 0; mt < NMT; ++mt) ca_[mt] = na_[mt];
        }
        __syncthreads();
#pragma unroll
        for (int mt = 0; mt < NMT; ++mt)
#pragma unroll
            for (int nt = 0; nt < 2; ++nt) { const int row = mt * 16 + fr; *(LAS f32x4*)(red + ((w * R + row) * 8 + ((4 * nt + fq) ^ (row & 7))) * 16) = acc[mt][nt]; }
        __syncthreads();
        if (F.tid < 2 * R) {
            const int row = F.tid >> 1, hf = F.tid & 1;
            f32x4 va0 = (f32x4){0.f, 0.f, 0.f, 0.f}, va1 = va0, vb0 = va0, vb1 = va0;
#pragma unroll
            for (int ww = 0; ww < 8; ++ww) { const LAS unsigned char* pr = red + (ww * R + row) * 128;
                va0 += *(const LAS f32x4*)(pr + ((2 * hf) ^ (row & 7)) * 16); va1 += *(const LAS f32x4*)(pr + ((2 * hf + 1) ^ (row & 7)) * 16);
                vb0 += *(const LAS f32x4*)(pr + ((4 + 2 * hf) ^ (row & 7)) * 16); vb1 += *(const LAS f32x4*)(pr + ((5 + 2 * hf) ^ (row & 7)) * 16); }
            if (rg * R + row < nrows) f.emit(rowbase + rg * R + row, ca + hf * 8, cb + hf * 8, va0, va1, vb0, vb1);
        }
    }
    }
    __syncthreads();
}
static_assert(8 * 128 * 128 <= SCR_BYTES, "skinny reduction buffer");

__device__ __forceinline__ int cond_of_row(int row) { return row < MPR ? (row >> 11) : (BP + row - MPR); }
struct RnParams { f32x4 gwp[4], a[4], sh[4]; };
template <int MODE>
__device__ __forceinline__ void rn_load_params(RnParams& P, const float* modr, const float* wpost, int goff, const float* wpre, int shoff, int scoff, int lane) {
#pragma unroll
    for (int j = 0; j < 4; ++j) { const int c = 4 * lane + 256 * j;
        if (MODE != 0) P.gwp[j] = *(const GAS f32x4*)(modr + goff + c) * *(const GAS f32x4*)(wpost + c);
        if (MODE != 2) { P.a[j] = *(const GAS f32x4*)(wpre + c) * (*(const GAS f32x4*)(modr + scoff + c) + 1.f); P.sh[j] = *(const GAS f32x4*)(modr + shoff + c); } }
}
template <int MODE>
__device__ __forceinline__ void rn_row(const RnParams& P, f32x4 (&x)[4], const v2u (&yw)[4], bf16* Xbrow, float* Xfrow, bf16* Hrow, int lane) {
    if (MODE != 0) {
        f32x4 y[4]; float ss = 0.f;
#pragma unroll
        for (int j = 0; j < 4; ++j) { y[j] = (f32x4){bflo(yw[j].x), bfhi(yw[j].x), bflo(yw[j].y), bfhi(yw[j].y)}; ss += (y[j][0] * y[j][0] + y[j][1] * y[j][1]) + (y[j][2] * y[j][2] + y[j][3] * y[j][3]); }
        const float r1 = rsqrtf(wave_sum(ss) * (1.f / D) + EPS);
#pragma unroll
        for (int j = 0; j < 4; ++j) x[j] = x[j] + P.gwp[j] * (y[j] * r1);
    }
#pragma unroll
    for (int j = 0; j < 4; ++j) { if (MODE == 2) *(GAS f32x4*)(Xfrow + 4 * lane + 256 * j) = x[j]; else *(GAS v2u*)(Xbrow + 4 * lane + 256 * j) = pack4v(x[j]); }
    if (MODE != 2) {
        float s2 = 0.f;
#pragma unroll
        for (int j = 0; j < 4; ++j) s2 += (x[j][0] * x[j][0] + x[j][1] * x[j][1]) + (x[j][2] * x[j][2] + x[j][3] * x[j][3]);
        const float r2 = rsqrtf(wave_sum(s2) * (1.f / D) + EPS);
#pragma unroll
        for (int j = 0; j < 4; ++j) *(GAS v2u*)(Hrow + 4 * lane + 256 * j) = pack4v((x[j] * r2) * P.a[j] + P.sh[j]);
    }
}
__device__ __forceinline__ f32x4 ld_x4(const bf16* p) { const v2u w = *(const GAS v2u*)p; return (f32x4){bflo(w.x), bfhi(w.x), bflo(w.y), bfhi(w.y)}; }
template <int MODE>
__device__ __forceinline__ void resnorm_phase(Frame& F, const float* xp, const float* xs, bf16* Xb, float* Xf, const bf16* Y, bf16* H, const float* MOD,
                                              const float* wpost, int goff, const float* wpre, int shoff, int scoff) {
    const int gw = F.vcu * NWAVES + F.wave, NGW = F.G * NWAVES, lane = F.lane;
    const int per = (MPR + NGW - 1) / NGW;
    RnParams P;
    for (int r0 = gw * per; r0 < MPR; r0 += NGW * per) {
        const int r1 = (r0 + per < MPR) ? r0 + per : MPR;
        int cond = r0 >> 11;
        rn_load_params<MODE>(P, MOD + (size_t)cond * NMODALL, wpost, goff, wpre, shoff, scoff, lane);
        f32x4 xn[4]; v2u yn[4];
#pragma unroll
        for (int j = 0; j < 4; ++j) { const size_t o_ = (size_t)r0 * D + 4 * lane + 256 * j; xn[j] = (MODE == 0) ? *(const GAS f32x4*)(xp + o_) : ld_x4(Xb + o_); yn[j] = (v2u){0u, 0u}; if (MODE != 0) yn[j] = *(const GAS v2u*)(Y + o_); }
        for (int row = r0; row < r1; ++row) {
            f32x4 x[4]; v2u yw[4];
#pragma unroll
            for (int j = 0; j < 4; ++j) { x[j] = xn[j]; yw[j] = yn[j]; }
            if ((row >> 11) != cond) { cond = row >> 11; rn_load_params<MODE>(P, MOD + (size_t)cond * NMODALL, wpost, goff, wpre, shoff, scoff, lane); }
            if (row + 1 < r1) {
#pragma unroll
                for (int j = 0; j < 4; ++j) { const size_t o_ = (size_t)(row + 1) * D + 4 * lane + 256 * j; xn[j] = (MODE == 0) ? *(const GAS f32x4*)(xp + o_) : ld_x4(Xb + o_); if (MODE != 0) yn[j] = *(const GAS v2u*)(Y + o_); } }
            rn_row<MODE>(P, x, yw, Xb + (size_t)row * D, Xf + (size_t)row * D, H + (size_t)row * D, lane);
        }
    }
    for (int row = MPR + gw; row < MT; row += NGW) {
        rn_load_params<MODE>(P, MOD + (size_t)cond_of_row(row) * NMODALL, wpost, goff, wpre, shoff, scoff, lane);
        f32x4 x[4]; v2u yw[4];
#pragma unroll
        for (int j = 0; j < 4; ++j) { const int c_ = 4 * lane + 256 * j; x[j] = (MODE == 0) ? *(const GAS f32x4*)(xs + (size_t)(row - MPR) * D + c_) : ld_x4(Xb + (size_t)row * D + c_); yw[j] = (v2u){0u, 0u}; if (MODE != 0) yw[j] = *(const GAS v2u*)(Y + (size_t)row * D + c_); }
        rn_row<MODE>(P, x, yw, Xb + (size_t)row * D, Xf + (size_t)row * D, H + (size_t)row * D, lane);
    }
}
template <int MIX>
__device__ __forceinline__ void gatenorm_phase(Frame& F, const bf16* RO, const bf16* GATE, bf16* GO, const float* nw) {
    const int gw = F.vcu * NWAVES + F.wave, NGW = F.G * NWAVES, lane = F.lane;
    constexpr int W = (MIX == 2) ? 1024 : 2048, NJ = W / 512;
    const int per = (MPR + NGW - 1) / NGW;
    float wv[NJ][8];
#pragma unroll
    for (int j = 0; j < NJ; ++j)
#pragma unroll
        for (int e = 0; e < 8; ++e) { const int c = 8 * lane + 512 * j + e; wv[j][e] = (MIX == 1) ? nw[c] : ((MIX == 2) ? nw[c & 127] : 1.f); }
#pragma unroll 1
    for (int seg = 0; seg < 2; ++seg) {
        const int r0 = seg == 0 ? gw * per : MPR + gw;
        const int r1 = seg == 0 ? ((r0 + per < MPR) ? r0 + per : MPR) : ((r0 < MT) ? r0 + 1 : r0);
        if (r0 >= r1) continue;
        v4u on[NJ], gn[NJ];
#pragma unroll
        for (int j = 0; j < NJ; ++j) { on[j] = *(const GAS v4u*)(RO + (size_t)r0 * W + 8 * lane + 512 * j); gn[j] = *(const GAS v4u*)(GATE + (size_t)r0 * W + 8 * lane + 512 * j); }
        for (int row = r0; row < r1; ++row) {
            v4u oc[NJ], gc[NJ];
#pragma unroll
            for (int j = 0; j < NJ; ++j) { oc[j] = on[j]; gc[j] = gn[j]; }
            if (row + 1 < r1) {
#pragma unroll
                for (int j = 0; j < NJ; ++j) { on[j] = *(const GAS v4u*)(RO + (size_t)(row + 1) * W + 8 * lane + 512 * j); gn[j] = *(const GAS v4u*)(GATE + (size_t)(row + 1) * W + 8 * lane + 512 * j); } }
            float u[NJ][8], r[NJ];
#pragma unroll
            for (int j = 0; j < NJ; ++j) {
                float o[8], g[8]; unpack8(oc[j], o); unpack8(gc[j], g);
                float ss = 0.f;
#pragma unroll
                for (int e = 0; e < 8; ++e) { u[j][e] = o[e] * g[e]; ss += (MIX == 1) ? u[j][e] * u[j][e] : o[e] * o[e]; }
                if (MIX == 2) r[j] = rsqrtf(grp16_sum(ss) * (1.f / 128.f) + EPS); else r[j] = rsqrtf(wave_sum(ss) * (1.f / 512.f) + EPS);
            }
#pragma unroll
            for (int j = 0; j < NJ; ++j) { float v[8];
#pragma unroll
                for (int e = 0; e < 8; ++e) v[e] = u[j][e] * r[j] * wv[j][e];
                *(GAS v4u*)(GO + (size_t)row * W + 8 * lane + 512 * j) = pack8(v); }
        }
    }
}

template <int OFF> __device__ __forceinline__ bf16x8 tr_frag(unsigned addr) {
    s16x4 lo, hi;
    asm volatile("ds_read_b64_tr_b16 %0, %2\n\tds_read_b64_tr_b16 %1, %2 offset:%3\n\ts_waitcnt lgkmcnt(0)" : "=&v"(lo), "=&v"(hi) : "v"(addr), "i"(OFF) : "memory");
    return __builtin_shufflevector(lo, hi, 0, 1, 2, 3, 4, 5, 6, 7);
}
template <int OFF> __device__ __forceinline__ void tr_frag2(unsigned a0, unsigned a1, bf16x8& f0, bf16x8& f1) {
    s16x4 l0, h0, l1, h1;
    asm volatile("ds_read_b64_tr_b16 %0, %4\n\tds_read_b64_tr_b16 %1, %4 offset:%6\n\tds_read_b64_tr_b16 %2, %5\n\tds_read_b64_tr_b16 %3, %5 offset:%6\n\ts_waitcnt lgkmcnt(0)"
                 : "=&v"(l0), "=&v"(h0), "=&v"(l1), "=&v"(h1) : "v"(a0), "v"(a1), "i"(OFF) : "memory");
    f0 = __builtin_shufflevector(l0, h0, 0, 1, 2, 3, 4, 5, 6, 7); f1 = __builtin_shufflevector(l1, h1, 0, 1, 2, 3, 4, 5, 6, 7);
}

#define LDS_BARRIER() do { asm volatile("s_waitcnt lgkmcnt(0)" ::: "memory"); __builtin_amdgcn_s_barrier(); asm volatile("" ::: "memory"); } while (0)
#define TRRD(dst, addr, off) asm volatile("ds_read_b64_tr_b16 %0, %1 offset:%2" : "=&v"(dst) : "v"(addr), "i"(off) : "memory")
#define TR_WAIT() do { asm volatile("s_waitcnt lgkmcnt(0)" ::: "memory"); __builtin_amdgcn_sched_barrier(0); } while (0)
#define TR_JOIN(lo, hi) __builtin_shufflevector(lo, hi, 0, 1, 2, 3, 4, 5, 6, 7)
template <class Cf, class OutFn>
__device__ __forceinline__ void rec_step(LAS unsigned char* lds, const int w, const int lane, f32x4 (&S)[Cf::KPW][Cf::VS / 16], const LAS float* cum, const OutFn& out, const int tok0) {
    constexpr int C = Cf::C, KD = Cf::KD, VS = Cf::VS, NIT = C / 16, NJT = C / 16, NVT = VS / 16, KSK = KD / 32, KSC = C / 32;
    constexpr int RSK = Cf::RSK, RSV = Cf::RSV, RSP = Cf::RSP;
    constexpr bool CH = Cf::CH;
    const int fr = lane & 15, fq = lane >> 4, q4 = fr >> 2, p4 = fr & 3;
    const unsigned lbase = (unsigned)(size_t)lds;
    constexpr int NP = NIT * NJT, PPW = (NP + 7) / 8, NO = NVT * NIT, OPW = (NO + 7) / 8;
    static_assert((NIT == 4 && NVT == 4) || (NP <= 8 && NO <= 8), "tile deal");
    constexpr bool SHQ = (NIT == 4) && !CH;
    const int it = (NIT == 4) ? (w & 3) : (w / NJT);
    f32x4 O[OPW];
    if constexpr (SHQ) {
        f32x4 p[2] = {(f32x4){0.f, 0.f, 0.f, 0.f}, (f32x4){0.f, 0.f, 0.f, 0.f}};
        f32x4 o2[2] = {(f32x4){0.f, 0.f, 0.f, 0.f}, (f32x4){0.f, 0.f, 0.f, 0.f}};
        const int j0 = w >> 2;
#pragma unroll 4
        for (int ks = 0; ks < KSK; ++ks) {
            const bf16x8 qf = *(const LAS bf16x8*)(lds + Cf::QA + (16 * it + fr) * RSK + (32 * ks + 8 * fq) * 2);
#pragma unroll
            for (int tt = 0; tt < 2; ++tt) { const int jt = j0 + 2 * tt;
                if (jt <= it) { const bf16x8 a = *(const LAS bf16x8*)(lds + Cf::KA + (16 * jt + fr) * RSK + (32 * ks + 8 * fq) * 2); p[tt] = MFMA16(a, qf, p[tt]); }
                const bf16x8 s = *(const LAS bf16x8*)(lds + Cf::ST + (16 * jt + fr) * RSK + (32 * ks + 8 * fq) * 2); o2[tt] = MFMA16(s, qf, o2[tt]); }
        }
        const int i = 16 * it + fr; const float ci = cum[i], ei = __expf(ci);
#pragma unroll
        for (int tt = 0; tt < 2; ++tt) { const int jt = j0 + 2 * tt;
#pragma unroll
            for (int r = 0; r < 4; ++r) { const int j = 16 * jt + 4 * fq + r; const float e = __expf(fminf(ci - cum[j], 0.f)); p[tt][r] = (j <= i) ? p[tt][r] * e : 0.f; }
            *(LAS v2u*)(lds + Cf::PM + (16 * it + fr) * RSP + (16 * jt + 4 * fq) * 2) = pack4v(p[tt]);
            O[tt] = o2[tt] * ei; }
    } else {
#pragma unroll
        for (int tt = 0; tt < PPW; ++tt) { const int t = w + 8 * tt;
            if (t < NP) { const int it1 = t / NJT, jt = t % NJT;
                f32x4 p = (f32x4){0.f, 0.f, 0.f, 0.f};
                if (jt <= it1) {
#pragma unroll
                    for (int ks = 0; ks < KSK; ++ks) {
                        const bf16x8 a = *(const LAS bf16x8*)(lds + Cf::KA + (16 * jt + fr) * RSK + (32 * ks + 8 * fq) * 2);
                        const bf16x8 b = *(const LAS bf16x8*)(lds + Cf::QA + (16 * it1 + fr) * RSK + (32 * ks + 8 * fq) * 2);
                        p = MFMA16(a, b, p); }
                    const int i = 16 * it1 + fr;
                    if (!CH) { const float ci = cum[i];
#pragma unroll
                        for (int r = 0; r < 4; ++r) { const int j = 16 * jt + 4 * fq + r; const float e = __expf(fminf(ci - cum[j], 0.f)); p[r] = (j <= i) ? p[r] * e : 0.f; } }
                    else {
#pragma unroll
                        for (int r = 0; r < 4; ++r) { const int j = 16 * jt + 4 * fq + r; p[r] = (j <= i) ? p[r] : 0.f; } }
                }
                *(LAS v2u*)(lds + Cf::PM + (16 * it1 + fr) * RSP + (16 * jt + 4 * fq) * 2) = pack4v(p);
            } }
#pragma unroll
        for (int tt = 0; tt < OPW; ++tt) { const int t = w + 8 * tt; O[tt] = (f32x4){0.f, 0.f, 0.f, 0.f};
            if (t < NO) { const int vt = t / NIT, it3 = t % NIT; f32x4 o = (f32x4){0.f, 0.f, 0.f, 0.f};
#pragma unroll
                for (int ks = 0; ks < KSK; ++ks) {
                    const bf16x8 a = *(const LAS bf16x8*)(lds + Cf::ST + (16 * vt + fr) * RSK + (32 * ks + 8 * fq) * 2);
                    const bf16x8 b = *(const LAS bf16x8*)(lds + Cf::QB + (16 * it3 + fr) * RSK + (32 * ks + 8 * fq) * 2);
                    o = MFMA16(a, b, o); }
                if (!CH) o = o * __expf(cum[16 * it3 + fr]);
                O[tt] = o; } }
    }
#pragma unroll
    for (int ki = 0; ki < Cf::KPW; ++ki) { const int kt = w + 8 * ki;
        if (!CH) { const float d = __expf(cum[C - 1]);
#pragma unroll
            for (int vt = 0; vt < NVT; ++vt) S[ki][vt] = S[ki][vt] * d; }
        else { const LAS float* ds = (const LAS float*)(lds + Cf::DS) + 16 * kt + 4 * fq; const f32x4 d = (f32x4){ds[0], ds[1], ds[2], ds[3]};
#pragma unroll
            for (int vt = 0; vt < NVT; ++vt) S[ki][vt] = S[ki][vt] * d; } }
#pragma unroll
    for (int ks = 0; ks < KSC; ++ks) {
        s16x4 vl[NVT], vh[NVT], kl[Cf::KPW], kh[Cf::KPW];
#pragma unroll
        for (int vt = 0; vt < NVT; ++vt) { const unsigned ad = lbase + Cf::VB + (32 * ks + 8 * fq + q4) * RSV + (16 * vt + 4 * p4) * 2; TRRD(vl[vt], ad, 0); TRRD(vh[vt], ad, 4 * RSV); }
#pragma unroll
        for (int ki = 0; ki < Cf::KPW; ++ki) { const unsigned ad = lbase + Cf::KB + (32 * ks + 8 * fq + q4) * RSK + (16 * (w + 8 * ki) + 4 * p4) * 2; TRRD(kl[ki], ad, 0); TRRD(kh[ki], ad, 4 * RSK); }
        TR_WAIT();
#pragma unroll
        for (int ki = 0; ki < Cf::KPW; ++ki) { const bf16x8 a = TR_JOIN(kl[ki], kh[ki]);
#pragma unroll
            for (int vt = 0; vt < NVT; ++vt) S[ki][vt] = MFMA16(a, TR_JOIN(vl[vt], vh[vt]), S[ki][vt]); }
    }
    LDS_BARRIER();
    if constexpr (NIT == 4) {
        const int v0 = w >> 2;
        s16x4 al[KSC][2], ah[KSC][2]; bf16x8 pb[KSC];
#pragma unroll
        for (int ks = 0; ks < KSC; ++ks) {
#pragma unroll
            for (int tt = 0; tt < 2; ++tt) { const unsigned ad = lbase + Cf::V + (32 * ks + 8 * fq + q4) * RSV + (16 * (v0 + 2 * tt) + 4 * p4) * 2; TRRD(al[ks][tt], ad, 0); TRRD(ah[ks][tt], ad, 4 * RSV); } }
#pragma unroll
        for (int ks = 0; ks < KSC; ++ks) pb[ks] = *(const LAS bf16x8*)(lds + Cf::PM + (16 * it + fr) * RSP + (32 * ks + 8 * fq) * 2);
        TR_WAIT();
#pragma unroll
        for (int ks = 0; ks < KSC; ++ks) { O[0] = MFMA16(TR_JOIN(al[ks][0], ah[ks][0]), pb[ks], O[0]); O[1] = MFMA16(TR_JOIN(al[ks][1], ah[ks][1]), pb[ks], O[1]); }
        out(tok0 + 16 * it + fr, 16 * it + fr, 16 * v0 + 4 * fq, O[0]);
        out(tok0 + 16 * it + fr, 16 * it + fr, 16 * (v0 + 2) + 4 * fq, O[1]);
    } else {
#pragma unroll
        for (int tt = 0; tt < OPW; ++tt) { const int t = w + 8 * tt;
            if (t < NO) { const int vt = t / NIT, it2 = t % NIT; f32x4 o = O[tt];
#pragma unroll
                for (int ks = 0; ks < KSC; ++ks) {
                    const bf16x8 a = tr_frag<4 * RSV>(lbase + Cf::V + (32 * ks + 8 * fq + q4) * RSV + (16 * vt + 4 * p4) * 2);
                    const bf16x8 b = *(const LAS bf16x8*)(lds + Cf::PM + (16 * it2 + fr) * RSP + (32 * ks + 8 * fq) * 2);
                    o = MFMA16(a, b, o); }
                out(tok0 + 16 * it2 + fr, 16 * it2 + fr, 16 * vt + 4 * fq, o); } }
    }
#pragma unroll
    for (int ki = 0; ki < Cf::KPW; ++ki) { const int kt = w + 8 * ki;
#pragma unroll
        for (int vt = 0; vt < NVT; ++vt) *(LAS v2u*)(lds + Cf::ST + (16 * vt + fr) * RSK + (16 * kt + 4 * fq) * 2) = pack4v(S[ki][vt]); }
    LDS_BARRIER();
}
template <class Cf> __device__ __forceinline__ void rec_zero_state(Frame& F, f32x4 (&S)[Cf::KPW][Cf::VS / 16]) {
#pragma unroll
    for (int ki = 0; ki < Cf::KPW; ++ki)
#pragma unroll
        for (int vt = 0; vt < Cf::VS / 16; ++vt) S[ki][vt] = (f32x4){0.f, 0.f, 0.f, 0.f};
    for (int o = F.tid * 16; o < Cf::VS * Cf::RSK; o += 512 * 16) *(LAS v4u*)(F.lds + Cf::ST + o) = (v4u){0u, 0u, 0u, 0u};
}
template <class Cf> __device__ __forceinline__ void rec_store_state(Frame& F, const f32x4 (&S)[Cf::KPW][Cf::VS / 16], float* dst, int ldv) {
    const int fr = F.lane & 15, fq = F.lane >> 4;
#pragma unroll
    for (int ki = 0; ki < Cf::KPW; ++ki) { const int kt = F.wave + 8 * ki;
#pragma unroll
        for (int vt = 0; vt < Cf::VS / 16; ++vt)
#pragma unroll
            for (int r = 0; r < 4; ++r) dst[(size_t)(16 * kt + 4 * fq + r) * ldv + 16 * vt + fr] = S[ki][vt][r]; }
}

struct CfRet { static constexpr int C = 64, KD = 256, VS = 64, KPW = 2, RSK = 528, RSV = 144, RSP = 144; static constexpr bool CH = false;
    static constexpr int QA = 0, KA = 33792, QB = QA, KB = KA, V = 67584, VB = 76800, PM = 86016, ST = 95232, CUM = 129024, DS = 0, END = 129280; };
static_assert(CfRet::END <= SCR_BYTES, "ret lds");
struct RetOut { bf16* dst;
    __device__ __forceinline__ void operator()(int tok, int i, int vv0, const f32x4 o) const { *(GAS v2u*)(dst + (size_t)tok * 2048 + vv0) = pack4v(o); } };
template <bool fuse>
__device__ __forceinline__ void ret_prompt_item(Frame& F, int item, const bf16* Q, const bf16* K, const bf16* V, bf16* RO, float* st_out,
                                                const float* sst_in, float* sst_out) {
    const int b = item >> 5, h = (item >> 3) & 3, vs = item & 7, tid = F.tid;
    const float lg = logf(1.f - exp2f(-5.f - (float)h));
    LAS float* cum = (LAS float*)(F.lds + CfRet::CUM);
    LAS float* sqk = (LAS float*)(F.lds + CfRet::END);
    LAS float* sred = sqk + 1024;
    __syncthreads();
    if (tid < 64) cum[tid] = (float)(tid + 1) * lg;
    f32x4 S[CfRet::KPW][4];
    rec_zero_state<CfRet>(F, S);
    const bf16* qg = Q + (size_t)(b * SEQ) * 1024 + h * 256; const bf16* kg = K + (size_t)(b * SEQ) * 1024 + h * 256; const bf16* vg = V + (size_t)(b * SEQ) * 2048 + h * 512 + vs * 64;
    const RetOut out{RO + (size_t)(b * SEQ) * 2048 + h * 512 + vs * 64};
    v4u qr[4], kr[4], vr;
#pragma unroll
    for (int i = 0; i < 4; ++i) { const int pc = tid + 512 * i, row = pc >> 5, c16 = pc & 31; qr[i] = *(const GAS v4u*)(qg + (size_t)row * 1024 + c16 * 8); kr[i] = *(const GAS v4u*)(kg + (size_t)row * 1024 + c16 * 8); }
    vr = *(const GAS v4u*)(vg + (size_t)(tid >> 3) * 2048 + (tid & 7) * 8);
    const float vsc = __expf((float)(63 - (tid >> 3)) * lg);
    const int sc4 = (tid & 127) * 4, srq = tid >> 7;
    f32x4 sv = (f32x4){0.f, 0.f, 0.f, 0.f}, so = sv, sst[4]; float sg = 0.f; const float* sin = sst_in; float* sout = sst_out; size_t srow = 0; int shh = 0;
#define RET_S_SETUP(si) do { const int sit_ = F.vcu + 256 * (si), bs_ = sit_ >> 2; shh = sit_ & 3; srow = MPR + bs_; \
        sqk[(si) * 512 + tid] = tid < 256 ? bf2f(Q[srow * 1024 + shh * 256 + tid]) : bf2f(K[srow * 1024 + shh * 256 + (tid - 256)]); \
        const v2u vw_ = *(const GAS v2u*)(V + srow * 2048 + shh * 512 + sc4); sv = (f32x4){bflo(vw_.x), bfhi(vw_.x), bflo(vw_.y), bfhi(vw_.y)}; \
        so = (f32x4){0.f, 0.f, 0.f, 0.f}; sg = 1.f - exp2f(-5.f - (float)shh); \
        sin = sst_in + ((size_t)(bs_ * 4 + shh) * 256) * 512 + sc4; sout = sst_out + ((size_t)(bs_ * 4 + shh) * 256) * 512 + sc4; } while (0)
#define RET_S_LOAD(st_) do { _Pragma("unroll") for (int k_ = 0; k_ < 4; ++k_) sst[k_] = __builtin_nontemporal_load((const GAS f32x4*)(sin + (size_t)(16 * (st_) + srq + 4 * k_) * 512)); } while (0)
    if (fuse) { RET_S_SETUP(0); RET_S_LOAD(0); }
    for (int c = 0; c < SEQ / 64; ++c) {
        const int sidx = c >> 4, sstep = c & 15;
#pragma unroll
        for (int i = 0; i < 4; ++i) { const int pc = tid + 512 * i, row = pc >> 5, c16 = pc & 31;
            *(LAS v4u*)(F.lds + CfRet::QA + row * 528 + c16 * 16) = qr[i]; *(LAS v4u*)(F.lds + CfRet::KA + row * 528 + c16 * 16) = kr[i]; }
        { const int row = tid >> 3, c16 = tid & 7; *(LAS v4u*)(F.lds + CfRet::V + row * 144 + c16 * 16) = vr;
          float f[8]; unpack8(vr, f);
#pragma unroll
          for (int e = 0; e < 8; ++e) f[e] *= vsc;
          *(LAS v4u*)(F.lds + CfRet::VB + row * 144 + c16 * 16) = pack8(f); }
        if (c + 1 < SEQ / 64) { const size_t r0 = (size_t)(c + 1) * 64;
#pragma unroll
            for (int i = 0; i < 4; ++i) { const int pc = tid + 512 * i, row = pc >> 5, c16 = pc & 31; qr[i] = *(const GAS v4u*)(qg + (r0 + row) * 1024 + c16 * 8); kr[i] = *(const GAS v4u*)(kg + (r0 + row) * 1024 + c16 * 8); }
            vr = *(const GAS v4u*)(vg + (r0 + (tid >> 3)) * 2048 + (tid & 7) * 8); }
        LDS_BARRIER();
        rec_step<CfRet>(F.lds, F.wave, F.lane, S, cum, out, c * 64);
        if (fuse) {
#pragma unroll
            for (int k = 0; k < 4; ++k) { const int rr = 16 * sstep + srq + 4 * k; const float kf = sqk[sidx * 512 + 256 + rr], qf = sqk[sidx * 512 + rr];
                const f32x4 s = sst[k] * sg + sv * kf;
                __builtin_nontemporal_store(s, (GAS f32x4*)(sout + (size_t)rr * 512)); so = so + s * qf; }
            if (sstep == 0 && sidx == 1) {
                const float acc = (sred[tid] + sred[512 + tid]) + (sred[1024 + tid] + sred[1536 + tid]);
                const int sit0 = F.vcu, bs0 = sit0 >> 2, h0 = sit0 & 3;
                RO[(size_t)(MPR + bs0) * 2048 + h0 * 512 + tid] = (bf16)(cvt_pk_bf16(acc, acc) & 0xffffu); }
            if (sstep == 15) { *(LAS f32x4*)(sred + srq * 512 + sc4) = so; if (sidx == 0) RET_S_SETUP(1); }
            if (c + 1 < SEQ / 64) RET_S_LOAD((c + 1) & 15);
        }
    }
#undef RET_S_SETUP
#undef RET_S_LOAD
    if (fuse) { __syncthreads();
        const float acc = (sred[tid] + sred[512 + tid]) + (sred[1024 + tid] + sred[1536 + tid]);
        RO[srow * 2048 + shh * 512 + tid] = (bf16)(cvt_pk_bf16(acc, acc) & 0xffffu); }
    rec_store_state<CfRet>(F, S, st_out + ((size_t)(b * 4 + h) * 256) * 512 + vs * 64, 512);
}
static_assert(CfRet::END + 4096 + 8192 <= SCR_BYTES, "ret lds + sample stream");
__device__ __forceinline__ void ret_sample_items(Frame& F, const bf16* Q, const bf16* K, const bf16* V, bf16* RO, const float* st_in, float* st_out) {
    LAS float* qk = (LAS float*)F.lds; LAS float* red = qk + 512;
    const int tid = F.tid, lane = F.lane, w = F.wave;
    for (int item = F.vcu; item < MS * 4; item += F.G) {
        const int bs = item >> 2, h = item & 3; const size_t row = MPR + bs;
        __syncthreads();
        qk[tid] = tid < 256 ? bf2f(Q[row * 1024 + h * 256 + tid]) : bf2f(K[row * 1024 + h * 256 + (tid - 256)]);
        float v[8]; unpack8(*(const GAS v4u*)(V + row * 2048 + h * 512 + 8 * lane), v);
        __syncthreads();
        const float g = 1.f - exp2f(-5.f - (float)h);
        const float* sin = st_in + ((size_t)(bs * 4 + h) * 256) * 512 + 8 * lane; float* sout = st_out + ((size_t)(bs * 4 + h) * 256) * 512 + 8 * lane;
        float o[8];
#pragma unroll
        for (int e = 0; e < 8; ++e) o[e] = 0.f;
#pragma unroll 8
        for (int r = 0; r < 32; ++r) { const int kk = 32 * w + r;
            f32x4 s0 = __builtin_nontemporal_load((const GAS f32x4*)(sin + (size_t)kk * 512)), s1 = __builtin_nontemporal_load((const GAS f32x4*)(sin + (size_t)kk * 512 + 4));
            const float kf = qk[256 + kk], qf = qk[kk];
#pragma unroll
            for (int e = 0; e < 4; ++e) { s0[e] = g * s0[e] + kf * v[e]; s1[e] = g * s1[e] + kf * v[4 + e]; o[e] += s0[e] * qf; o[4 + e] += s1[e] * qf; }
            __builtin_nontemporal_store(s0, (GAS f32x4*)(sout + (size_t)kk * 512)); __builtin_nontemporal_store(s1, (GAS f32x4*)(sout + (size_t)kk * 512 + 4)); }
#pragma unroll
        for (int e = 0; e < 8; ++e) red[w * 512 + 8 * lane + e] = o[e];
        __syncthreads();
        float acc = 0.f;
#pragma unroll
        for (int ww = 0; ww < 8; ++ww) acc += red[ww * 512 + tid];
        RO[row * 2048 + h * 512 + tid] = (bf16)(cvt_pk_bf16(acc, acc) & 0xffffu);
    }
    __syncthreads();
}

struct CfSsd { static constexpr int C = 64, KD = 128, VS = 64, KPW = 1, RSK = 272, RSV = 144, RSP = 144; static constexpr bool CH = false;
    static constexpr int QA = 0, KA = 17408, QB = QA, KB = KA, V = 34816, VB = 44032, PM = 53248, ST = 62464, XS = 79872, CUM = 89088, DTV = 89600, RAW = 90112, RSR = 656, DS = 0, END = RAW + 67 * 656; };
static_assert(CfSsd::END <= SCR_BYTES, "ssd lds");
struct SsdOut { bf16* dst; const LAS unsigned char* xs; float Dh;
    __device__ __forceinline__ void operator()(int tok, int i, int vv0, const f32x4 o) const {
        const v2u xw = *(const LAS v2u*)(xs + i * 144 + vv0 * 2);
        const f32x4 x = (f32x4){bflo(xw.x), bfhi(xw.x), bflo(xw.y), bfhi(xw.y)};
        *(GAS v2u*)(dst + (size_t)tok * 2048 + vv0) = pack4v(o + x * Dh); } };
__device__ __forceinline__ int ssd_gcol(int lch, int head, int grp) { return lch < 64 ? head * 64 + lch : (lch < 192 ? 2048 + grp * 128 + (lch - 64) : 2560 + grp * 128 + (lch - 192)); }
__device__ __forceinline__ void ssd_prompt_item(Frame& F, int item, const bf16* XBC, const float* DT, bf16* T, float* st_out,
                                                const float* conv_w, const float* conv_b, const float* dt_bias, const float* a_log, const float* d_skip) {
    const int b = item >> 5, head = item & 31, grp = head >> 3, tid = F.tid, lane = F.lane, w = F.wave;
    const float a = -expf(a_log[head]), dtb = dt_bias[head], Dh = d_skip[head];
    LAS float* cumb = (LAS float*)(F.lds + CfSsd::CUM); LAS float* dtvb = (LAS float*)(F.lds + CfSsd::DTV);
    __syncthreads();
    f32x4 S[CfSsd::KPW][4];
    rec_zero_state<CfSsd>(F, S);
    const bf16* xg = XBC + (size_t)(b * SEQ) * 3072; const float* dtg = DT + (size_t)(b * SEQ) * 32 + head;
    const SsdOut out{T + (size_t)(b * SEQ) * 2048 + head * 64, F.lds + CfSsd::XS, Dh};
    const bool conv_thr = tid < 440; const int cg = tid % 40, tb = tid / 40, gcolc = ssd_gcol(8 * cg, head, grp);
    float wr[4][8], br[8];
#pragma unroll
    for (int e = 0; e < 8; ++e) { br[e] = conv_b[gcolc + e];
#pragma unroll
        for (int tap = 0; tap < 4; ++tap) wr[tap][e] = conv_w[tap * 3072 + gcolc + e]; }
    const bool stg_thr = tid < 480; const int r0 = tid / 40;
    v4u raw[6];
#define SSD_LOAD_RAW(cc) do { const bf16* rp_ = xg + ((long)((cc) * 64 - 3 + r0) * 3072 + gcolc); _Pragma("unroll") for (int k_ = 0; k_ < 6; ++k_) { const int row_ = r0 + 12 * k_, tk_ = (cc) * 64 - 3 + row_; \
        raw[k_] = (v4u){0u, 0u, 0u, 0u}; if (stg_thr && row_ < 67 && tk_ >= 0) raw[k_] = *(const GAS v4u*)(rp_ + (long)k_ * 12 * 3072); } } while (0)
#define SSD_CUM(cc) do { if (w == 0) { const float dtv_ = softplusf_(dtn + dtb); float v_ = dtv_ * a; \
        _Pragma("unroll") for (int o_ = 1; o_ < 64; o_ <<= 1) { const float u_ = __shfl_up(v_, o_); if (lane >= o_) v_ += u_; } cumb[((cc) & 1) * 64 + lane] = v_; dtvb[((cc) & 1) * 64 + lane] = dtv_; } } while (0)
    float dtn = 0.f;
    if (w == 0) dtn = dtg[(size_t)lane * 32];
    SSD_CUM(0);
    if (w == 0) dtn = dtg[(size_t)(64 + lane) * 32];
    SSD_LOAD_RAW(0);
    for (int c = 0; c < SEQ / 64; ++c) {
#pragma unroll
        for (int k = 0; k < 6; ++k) { const int row = r0 + 12 * k; if (stg_thr && row < 67) *(LAS v4u*)(F.lds + CfSsd::RAW + row * CfSsd::RSR + cg * 16) = raw[k]; }
        if (c + 1 < SEQ / 64) { SSD_CUM(c + 1); if (w == 0 && c + 2 < SEQ / 64) dtn = dtg[(size_t)((c + 2) * 64 + lane) * 32]; SSD_LOAD_RAW(c + 1); }
        LDS_BARRIER();
        const LAS float* cum = cumb + (c & 1) * 64; const LAS float* dtv = dtvb + (c & 1) * 64; const float tot = cum[63];
        if (conv_thr) {
            float win[3][8];
#pragma unroll
            for (int r = 0; r < 3; ++r) unpack8(*(const LAS v4u*)(F.lds + CfSsd::RAW + (6 * tb + r) * CfSsd::RSR + cg * 16), win[r]);
#pragma unroll
            for (int k = 0; k < 6; ++k) { const int i = 6 * tb + k;
                if (i < 64) {
                    float x3[8], acc[8]; unpack8(*(const LAS v4u*)(F.lds + CfSsd::RAW + (i + 3) * CfSsd::RSR + cg * 16), x3);
#pragma unroll
                    for (int e = 0; e < 8; ++e) { acc[e] = br[e] + win[0][e] * wr[0][e] + win[1][e] * wr[1][e] + win[2][e] * wr[2][e] + x3[e] * wr[3][e]; acc[e] = siluf_(acc[e]);
                        win[0][e] = win[1][e]; win[1][e] = win[2][e]; win[2][e] = x3[e]; }
                    if (cg < 8) { const float dv = dtv[i], wj = dv * __expf(tot - cum[i]);
                        *(LAS v4u*)(F.lds + CfSsd::XS + i * 144 + cg * 16) = pack8(acc);
                        float f[8];
#pragma unroll
                        for (int e = 0; e < 8; ++e) f[e] = acc[e] * dv;
                        *(LAS v4u*)(F.lds + CfSsd::V + i * 144 + cg * 16) = pack8(f);
#pragma unroll
                        for (int e = 0; e < 8; ++e) f[e] = acc[e] * wj;
                        *(LAS v4u*)(F.lds + CfSsd::VB + i * 144 + cg * 16) = pack8(f); }
                    else if (cg < 24) *(LAS v4u*)(F.lds + CfSsd::KA + i * 272 + (cg - 8) * 16) = pack8(acc);
                    else *(LAS v4u*)(F.lds + CfSsd::QA + i * 272 + (cg - 24) * 16) = pack8(acc);
                } }
        }
        LDS_BARRIER();
        rec_step<CfSsd>(F.lds, w, lane, S, cum, out, c * 64);
    }
#undef SSD_CUM
#undef SSD_LOAD_RAW
    rec_store_state<CfSsd>(F, S, st_out + ((size_t)(b * 32 + head) * 128) * 64, 64);
}
__device__ __forceinline__ void ssd_sample_items(Frame& F, const bf16* XBC, const float* DT, bf16* T, const float* st_in, float* st_out, const float* conv_st,
                                                 const float* conv_w, const float* conv_b, const float* dt_bias, const float* a_log, const float* d_skip) {
    const int gw = F.vcu * NWAVES + F.wave, NGW = F.G * NWAVES, lane = F.lane;
    LAS float* scr = (LAS float*)(F.lds + F.wave * 2048);
    __syncthreads();
    for (int item = gw; item < MS * 32; item += NGW) {
        const int bs = item >> 5, head = item & 31, grp = head >> 3; const size_t row = MPR + bs;
        asm volatile("" ::: "memory");
#pragma unroll
        for (int r = 0; r < 5; ++r) { const int lch = lane + 64 * r, gch = ssd_gcol(lch, head, grp);
            float acc = conv_b[gch];
#pragma unroll
            for (int tap = 0; tap < 3; ++tap) acc += conv_st[((size_t)bs * 3 + tap) * 3072 + gch] * conv_w[tap * 3072 + gch];
            acc += bf2f(XBC[row * 3072 + gch]) * conv_w[3 * 3072 + gch];
            scr[lch] = siluf_(acc); }
        LDS_WAIT();
        const float dtv = softplusf_(DT[row * 32 + head] + dt_bias[head]), dA = __expf(dtv * -expf(a_log[head])), Dh = d_skip[head];
        const int v4 = (lane & 15) * 4, kq = lane >> 4;
        const f32x4 xs4 = (f32x4){scr[v4], scr[v4 + 1], scr[v4 + 2], scr[v4 + 3]}, xd = xs4 * dtv;
        const float* sin = st_in + ((size_t)(bs * 32 + head) * 128) * 64 + v4; float* sout = st_out + ((size_t)(bs * 32 + head) * 128) * 64 + v4;
        f32x4 y = (f32x4){0.f, 0.f, 0.f, 0.f};
#pragma unroll 8
        for (int i = 0; i < 32; ++i) { const int kk = 4 * i + kq;
            f32x4 s = __builtin_nontemporal_load((const GAS f32x4*)(sin + (size_t)kk * 64));
            s = s * dA + xd * scr[64 + kk];
            __builtin_nontemporal_store(s, (GAS f32x4*)(sout + (size_t)kk * 64));
            y = y + s * scr[192 + kk]; }
#pragma unroll
        for (int e = 0; e < 4; ++e) { y[e] += __shfl_xor(y[e], 16); y[e] += __shfl_xor(y[e], 32); }
        if (lane < 16) *(GAS v2u*)(T + row * 2048 + head * 64 + v4) = pack4v(y + xs4 * Dh);
        LDS_WAIT();
    }
    __syncthreads();
}
__device__ __forceinline__ void ssd_conv_out(Frame& F, const bf16* XBC, const float* conv_st, float* outp, float* outs) {
    const int NP_ = BP * 3 * 3072, NS_ = MS * 3 * 3072;
    for (int idx = F.vcu * 512 + F.tid; idx < NP_ + NS_; idx += F.G * 512) {
        if (idx < NP_) { const int b = idx / 9216, rem = idx - b * 9216, wi = rem / 3072, ch = rem - wi * 3072; outp[idx] = bf2f(XBC[(size_t)(b * SEQ + SEQ - 3 + wi) * 3072 + ch]); }
        else { const int k = idx - NP_, bs = k / 9216, rem = k - bs * 9216, wi = rem / 3072, ch = rem - wi * 3072;
            outs[k] = wi < 2 ? conv_st[((size_t)bs * 3 + wi + 1) * 3072 + ch] : bf2f(XBC[(size_t)(MPR + bs) * 3072 + ch]); }
    }
}

struct CfHg { static constexpr int C = 32, KD = 128, VS = 32, KPW = 1, RSK = 272, RSV = 80, RSP = 80; static constexpr bool CH = true;
    static constexpr int QA = 0, KA = 8704, QB = 17408, KB = 26112, V = 34816, VB = V, PM = 37376, ST = 39936, DS = 48640, PART = 49152, CUM = 0, END = 51200; };
static_assert(CfHg::END <= SCR_BYTES, "hgrn lds");
struct HgOut { bf16* dst;
    __device__ __forceinline__ void operator()(int tok, int i, int vv0, const f32x4 o) const { *(GAS v2u*)(dst + (size_t)tok * 1024 + vv0) = pack4v(o); } };
__device__ __forceinline__ void st_bf16_lds(LAS unsigned char* p, float x) { *(LAS unsigned short*)p = (unsigned short)(cvt_pk_bf16(x, x) & 0xffffu); }
__device__ __forceinline__ void hg_prompt_item(Frame& F, int item, const bf16* HQ, const float* LA, const bf16* HV, bf16* RO, float* st_out) {
    const int b = item >> 5, h = (item >> 2) & 7, vs = item & 3, tid = F.tid, kk = tid & 127, tg = tid >> 7;
    LAS float* part = (LAS float*)(F.lds + CfHg::PART); LAS float* dsv = (LAS float*)(F.lds + CfHg::DS);
    __syncthreads();
    f32x4 S[CfHg::KPW][2];
    rec_zero_state<CfHg>(F, S);
    const size_t base = (size_t)(b * SEQ) * 1024 + h * 128;
    const HgOut out{RO + base + vs * 32};
    float la[8]; unsigned short qr[8]; v4u vr = (v4u){0u, 0u, 0u, 0u};
#pragma unroll
    for (int e = 0; e < 8; ++e) { const size_t ix = base + (size_t)(8 * tg + e) * 1024 + kk; la[e] = LA[ix]; qr[e] = HQ[ix]; }
    if (tid < 128) vr = *(const GAS v4u*)(HV + base + (size_t)(tid >> 2) * 1024 + vs * 32 + (tid & 3) * 8);
    for (int c = 0; c < SEQ / 32; ++c) {
        float lc[8]; lc[0] = la[0];
#pragma unroll
        for (int e = 1; e < 8; ++e) lc[e] = lc[e - 1] + la[e];
        part[tg * 128 + kk] = lc[7];
        LDS_BARRIER();
        const float p0 = part[kk], p1 = part[128 + kk], p2 = part[256 + kk], p3 = part[384 + kk];
        const float off = (tg > 0 ? p0 : 0.f) + (tg > 1 ? p1 : 0.f) + (tg > 2 ? p2 : 0.f), tot = (p0 + p1) + (p2 + p3), ref = p0 + p1;
#pragma unroll
        for (int e = 0; e < 8; ++e) { const int i = 8 * tg + e; const float cm = off + lc[e], kf = 1.f - __expf(la[e]), qv = bf2f(qr[e]);
            const float ea = __expf(fminf(fmaxf(cm - ref, -80.f), 80.f)), eb = __expf(fminf(fmaxf(ref - cm, -80.f), 80.f));
            st_bf16_lds(F.lds + CfHg::QA + i * 272 + kk * 2, qv * ea); st_bf16_lds(F.lds + CfHg::KA + i * 272 + kk * 2, kf * eb);
            st_bf16_lds(F.lds + CfHg::QB + i * 272 + kk * 2, qv * __expf(cm)); st_bf16_lds(F.lds + CfHg::KB + i * 272 + kk * 2, kf * __expf(tot - cm)); }
        if (tg == 0) dsv[kk] = __expf(tot);
        if (tid < 128) *(LAS v4u*)(F.lds + CfHg::V + (tid >> 2) * 80 + (tid & 3) * 16) = vr;
        if (c + 1 < SEQ / 32) { const size_t b2 = base + (size_t)(c + 1) * 32 * 1024;
#pragma unroll
            for (int e = 0; e < 8; ++e) { const size_t ix = b2 + (size_t)(8 * tg + e) * 1024 + kk; la[e] = LA[ix]; qr[e] = HQ[ix]; }
            if (tid < 128) vr = *(const GAS v4u*)(HV + b2 + (size_t)(tid >> 2) * 1024 + vs * 32 + (tid & 3) * 8); }
        LDS_BARRIER();
        rec_step<CfHg>(F.lds, F.wave, F.lane, S, (const LAS float*)nullptr, out, c * 32);
    }
    rec_store_state<CfHg>(F, S, st_out + ((size_t)(b * 8 + h) * 128) * 128 + vs * 32, 128);
}
__device__ __forceinline__ void hg_sample_items(Frame& F, const bf16* HQ, const float* LA, const bf16* HV, bf16* RO, const float* st_in, float* st_out) {
    const int gw = F.vcu * NWAVES + F.wave, NGW = F.G * NWAVES, lane = F.lane;
    LAS float* scr = (LAS float*)(F.lds + F.wave * 2048);
    __syncthreads();
    for (int item = gw; item < MS * 16; item += NGW) {
        const int bs = item >> 4, h = (item >> 1) & 7, vh = item & 1; const size_t rb = (size_t)(MPR + bs) * 1024 + h * 128;
        asm volatile("" ::: "memory");
#pragma unroll
        for (int r = 0; r < 2; ++r) { const int kk = lane + 64 * r; scr[kk] = __expf(LA[rb + kk]); scr[128 + kk] = bf2f(HQ[rb + kk]); }
        LDS_WAIT();
        const int v4 = (lane & 15) * 4, kq = lane >> 4;
        const v2u iw = *(const GAS v2u*)(HV + rb + vh * 64 + v4);
        const f32x4 iv = (f32x4){bflo(iw.x), bfhi(iw.x), bflo(iw.y), bfhi(iw.y)};
        const float* sin = st_in + ((size_t)(bs * 8 + h) * 128) * 128 + vh * 64 + v4; float* sout = st_out + ((size_t)(bs * 8 + h) * 128) * 128 + vh * 64 + v4;
        f32x4 o = (f32x4){0.f, 0.f, 0.f, 0.f};
#pragma unroll 8
        for (int i = 0; i < 32; ++i) { const int kk = 4 * i + kq; const float f = scr[kk];
            f32x4 s = __builtin_nontemporal_load((const GAS f32x4*)(sin + (size_t)kk * 128));
            s = s * f + iv * (1.f - f);
            __builtin_nontemporal_store(s, (GAS f32x4*)(sout + (size_t)kk * 128));
            o = o + s * scr[128 + kk]; }
#pragma unroll
        for (int e = 0; e < 4; ++e) { o[e] += __shfl_xor(o[e], 16); o[e] += __shfl_xor(o[e], 32); }
        if (lane < 16) *(GAS v2u*)(RO + rb + vh * 64 + v4) = pack4v(o);
        LDS_WAIT();
    }
    __syncthreads();
}

__device__ __forceinline__ void p0_transpose_item(const float* W, int K, int N, bf16* WT, LAS float* scr, int item, int lane, bool inter) {
    const int nblk = N / 32, kb = item / nblk, nb = item - kb * nblk, k0 = 64 * kb, n0 = 32 * nb;
    int s0 = n0; if (inter) { const int t = n0 >> 8, j = n0 & 255; s0 = j < 128 ? 128 * t + j : DFF + 128 * t + (j - 128); }
#pragma unroll 8
    for (int i = 0; i < 32; ++i) { const int kk = 2 * i + (lane >> 5); scr[kk * 33 + (lane & 31)] = W[(size_t)(k0 + kk) * N + s0 + (lane & 31)]; }
    LDS_WAIT(); asm volatile("" ::: "memory");
    const int c = lane & 7;
#pragma unroll
    for (int j = 0; j < 4; ++j) { const int n = (lane >> 3) + 8 * j; const LAS float* s = scr + (8 * c) * 33 + n;
        v4u o; o.x = cvt_pk_bf16(s[0 * 33], s[1 * 33]); o.y = cvt_pk_bf16(s[2 * 33], s[3 * 33]); o.z = cvt_pk_bf16(s[4 * 33], s[5 * 33]); o.w = cvt_pk_bf16(s[6 * 33], s[7 * 33]);
        *(GAS v4u*)(WT + (size_t)(n0 + n) * K + k0 + 8 * c) = o; }
    LDS_WAIT(); asm volatile("" ::: "memory");
}
__device__ __forceinline__ void p0_matrix(Frame& F, const float* W, int K, int N, bf16* WT, bool inter, int& itbase) {
    const int gw = F.vcu * NWAVES + F.wave, NGW = F.G * NWAVES, nit = (K / 64) * (N / 32);
    LAS float* scr = (LAS float*)(F.lds + F.wave * 16384);
    int first = (gw - itbase) % NGW; if (first < 0) first += NGW;
    for (int it = first; it < nit; it += NGW) p0_transpose_item(W, K, N, WT, scr, it, F.lane, inter);
    itbase += nit;
}

#ifndef REP_PROMPT
#define REP_PROMPT 1
#endif
#ifndef REP_PROMPT_SSD
#define REP_PROMPT_SSD REP_PROMPT
#endif
#ifndef REP_PROMPT_HG
#define REP_PROMPT_HG REP_PROMPT
#endif
#ifndef REP_SAMPLE
#define REP_SAMPLE 1
#endif
#ifndef REP_GEMM
#define REP_GEMM 1
#endif
#ifndef REP_GN
#define REP_GN 1
#endif
#ifndef REP_P0
#define REP_P0 1
#endif
#ifndef REP_SKINNY
#define REP_SKINNY 1
#endif
#define REPEAT(n) _Pragma("unroll 1") for (int rep_ = 0; rep_ < (n); ++rep_)
struct Args { const float* in[30]; float* out; unsigned char* ws; int ph_lo, ph_hi; };
enum { I_XP = 0, I_XS, I_CP, I_CS, I_SRET, I_SSSD, I_SCONV, I_SHG, I_WADA, I_BADA, I_NMPRE, I_NMPOST, I_NFPRE, I_NFPOST, I_RETIN, I_RETOUT, I_SSDIN, I_CONVW, I_CONVB, I_DTB, I_ALOG, I_SSDD,
       I_SSDNORM, I_SSDOUT, I_HGIN, I_HGLB, I_HGNORM, I_HGOUT, I_FFNIN, I_FFNOUT };
constexpr int N_PHASES = 3 + 8 * 4;

__global__ void __launch_bounds__(NWAVES * 64, 2) mk_fwd(Args args) {
    extern __shared__ __attribute__((aligned(16))) unsigned char lds_raw[];
    Frame F;
    F.lds = (LAS unsigned char*)lds_raw;
    F.tid = threadIdx.x; F.lane = F.tid & 63; F.wave = __builtin_amdgcn_readfirstlane(F.tid >> 6);
    F.G = gridDim.x; { const int bx = blockIdx.x; F.vcu = (F.G % 8 == 0) ? (bx % 8) * (F.G / 8) + bx / 8 : bx; }
    unsigned char* ws = args.ws;
    gu32* ctl = (gu32*)(ws + WS_CTL);
    for (int u = F.tid; u < (LDS_BYTES - LDSCTL_OFF) / 4; u += NWAVES * 64) ((LAS unsigned*)(F.lds + LDSCTL_OFF))[u] = 0u;
    __syncthreads();
    XcdBarrier bar; bar.bar = (unsigned*)(ctl + CW_BAR); bar.x = 0; bar.st = nullptr;
    if (MK_N_LAUNCHES == 1) bar = xcd_barrier_post((unsigned*)(ctl + CW_BAR), (volatile LAS unsigned*)(F.lds + LDSCTL_OFF) + 8);
    const int lo = args.ph_lo, hi = args.ph_hi;
#define IN(k) (lo <= (k) && (k) < hi)
#define SEAM(k) do { if (IN((k) + 1)) xcd_barrier(bar); } while (0)
#define INP(i) (args.in[i])
    float* const out = args.out;
    float* const X = out + O_Y;
    bf16* const XB = (bf16*)(ws + WS_XB);
    bf16* const Hb = (bf16*)(ws + WS_H); bf16* const RO = (bf16*)(ws + WS_RO); bf16* const GO = (bf16*)(ws + WS_GO); bf16* const OUTB = (bf16*)(ws + WS_OUT); bf16* const ACT = (bf16*)(ws + WS_ACT);
    float* const MOD = (float*)(ws + WS_MOD); float* const LB = (float*)(ws + WS_LB);
    bf16* const CACT = (bf16*)(ws + WS_CACT);
    bf16* const WADA = (bf16*)(ws + WS_WADA);
    unsigned char* const PJ = ws + WS_PROJ;

    if (IN(0)) { REPEAT(REP_P0) {
        int itb = 0;
#pragma unroll 1
        for (int l = 0; l < 4; ++l) p0_matrix(F, INP(I_WADA) + (size_t)l * D * NMOD, D, NMOD, WADA + (size_t)l * NMOD * D, false, itb);
#pragma unroll 1
        for (int j = 0; j < 2; ++j) p0_matrix(F, INP(I_RETIN) + (size_t)j * D * RET_IN, D, RET_IN, (bf16*)(ws + WS_WRETIN) + (size_t)j * RET_IN * D, false, itb);
#pragma unroll 1
        for (int j = 0; j < 2; ++j) p0_matrix(F, INP(I_RETOUT) + (size_t)j * 2048 * D, 2048, D, (bf16*)(ws + WS_WRETOUT) + (size_t)j * D * 2048, false, itb);
        p0_matrix(F, INP(I_SSDIN), D, SSD_IN, (bf16*)(ws + WS_WSSDIN), false, itb);
        p0_matrix(F, INP(I_SSDOUT), 2048, D, (bf16*)(ws + WS_WSSDOUT), false, itb);
        p0_matrix(F, INP(I_HGIN), D, HG_IN, (bf16*)(ws + WS_WHGIN), false, itb);
        p0_matrix(F, INP(I_HGOUT), D, D, (bf16*)(ws + WS_WHGOUT), false, itb);
#pragma unroll 1
        for (int l = 0; l < 4; ++l) p0_matrix(F, INP(I_FFNIN) + (size_t)l * D * FFN_IN, D, FFN_IN, (bf16*)(ws + WS_WFFNIN) + (size_t)l * FFN_IN * D, true, itb);
#pragma unroll 1
        for (int l = 0; l < 4; ++l) p0_matrix(F, INP(I_FFNOUT) + (size_t)l * DFF * D, DFF, D, (bf16*)(ws + WS_WFFNOUT) + (size_t)l * D * DFF, false, itb);
        for (int idx = F.vcu * 512 + F.tid; idx < 256 * 128; idx += F.G * 512) { const int row = idx >> 7, c8 = (idx & 127) * 8; v4u o = (v4u){0u, 0u, 0u, 0u};
            if (row < NCOND) { const float* src = row < BP ? INP(I_CP) + (size_t)row * D : INP(I_CS) + (size_t)(row - BP) * D;
                const f32x4 a = *(const GAS f32x4*)(src + c8), b = *(const GAS f32x4*)(src + c8 + 4); o = pack8v(silu4(a), silu4(b)); }
            *(GAS v4u*)(CACT + (size_t)row * D + c8) = o; }
        for (int idx = F.vcu * 512 + F.tid; idx < 1024; idx += F.G * 512) { const float* lg = INP(I_HGLB);
            const float l0 = lg[idx], l1 = lg[1024 + idx], l2 = lg[2048 + idx], l3 = lg[3072 + idx], m = fmaxf(fmaxf(l0, l1), fmaxf(l2, l3));
            const float e0 = expf(l0 - m), e1 = expf(l1 - m), e2 = expf(l2 - m), e3 = expf(l3 - m); LB[idx] = (e1 + e2) / ((e0 + e1) + (e2 + e3)); }
        }
        SEAM(0);
    }
    if (IN(1)) {
        const EmitMod E{MOD, INP(I_BADA)};
        REPEAT(REP_SKINNY) skinny_gemm<8>(F, CACT, D, 2, NCOND, 0, WADA, (NMODALL / 256) * 8, false, E, 0, F.G);
        SEAM(1);
    }
    if (IN(2)) {
        resnorm_phase<0>(F, INP(I_XP), INP(I_XS), XB, X, nullptr, Hb, MOD, nullptr, 0, INP(I_NMPRE), 0 * NMOD + 0 * D, 0 * NMOD + 1 * D);
        SEAM(2);
    }

#define MAIN_GEMM(EmitT, eobj, Aptr, Btptr, N_, K_) do { pg8::Gemm g_{(const pg8::bf16_t*)(Aptr), (const pg8::bf16_t*)(Btptr), MPR, (N_), (K_)}; pg8::StaticOrder S_; S_.init(MPR, (N_), F.G, (int)blockIdx.x); \
        const EpiGen<EmitT> E_{eobj}; _Pragma("unroll") for (int rg_ = 0; rg_ < REP_GEMM; ++rg_) pg8::gemm_phase<EpiGen<EmitT>, pg8::StaticOrder, PG8_ALIGN, PG8_SP2>(F.lds, g_, S_, E_); } while (0)
#define FFN_BLOCK(L, pb, LASTL) do { \
    if (IN((pb) + 4)) { resnorm_phase<1>(F, nullptr, nullptr, XB, X, OUTB, Hb, MOD, INP(I_NMPOST) + (L) * D, (L) * NMOD + 2 * D, INP(I_NFPRE) + (L) * D, (L) * NMOD + 3 * D, (L) * NMOD + 4 * D); SEAM((pb) + 4); } \
    if (IN((pb) + 5)) { const bf16* wt_ = (const bf16*)(ws + WS_WFFNIN) + (size_t)(L) * FFN_IN * D; const EmitFfnIn e_{ACT}; \
        MAIN_GEMM(EmitFfnIn, e_, Hb, wt_, FFN_IN, D); REPEAT(REP_SKINNY) skinny_gemm<8>(F, Hb + (size_t)MPR * D, D, 1, MS, MPR, wt_, (FFN_IN / 256) * 8, false, e_, F.G / 2, F.G / 2); SEAM((pb) + 5); } \
    if (IN((pb) + 6)) { const bf16* wt_ = (const bf16*)(ws + WS_WFFNOUT) + (size_t)(L) * D * DFF; const EmitOut e_{OUTB}; \
        MAIN_GEMM(EmitOut, e_, ACT, wt_, D, DFF); REPEAT(REP_SKINNY) skinny_gemm<4>(F, ACT + (size_t)MPR * DFF, DFF, 2, MS, MPR, wt_, (D / 256) * 8, false, e_, 0, F.G); SEAM((pb) + 6); } \
    if (IN((pb) + 7)) { if (LASTL) resnorm_phase<2>(F, nullptr, nullptr, XB, X, OUTB, Hb, MOD, INP(I_NFPOST) + (L) * D, (L) * NMOD + 5 * D, nullptr, 0, 0); \
        else resnorm_phase<1>(F, nullptr, nullptr, XB, X, OUTB, Hb, MOD, INP(I_NFPOST) + (L) * D, (L) * NMOD + 5 * D, INP(I_NMPRE) + ((L) + 1) * D, ((L) + 1) * NMOD + 0 * D, ((L) + 1) * NMOD + 1 * D); \
        if (!(LASTL)) SEAM((pb) + 7); } } while (0)
#define OUT_PROJ(pb, wt, K_) do { if (IN((pb) + 3)) { const EmitOut e_{OUTB}; MAIN_GEMM(EmitOut, e_, GO, (wt), D, (K_)); REPEAT(REP_SKINNY) skinny_gemm<4>(F, GO + (size_t)MPR * (K_), (K_), 2, MS, MPR, (wt), (D / 256) * 8, false, e_, 0, F.G); SEAM((pb) + 3); } } while (0)
#define RET_LAYER(L, J, pb) do { \
    bf16* const Qp_ = (bf16*)(PJ + PJ_RET_Q); bf16* const Kp_ = (bf16*)(PJ + PJ_RET_K); bf16* const Vp_ = (bf16*)(PJ + PJ_RET_V); bf16* const SGp_ = (bf16*)(PJ + PJ_RET_SG); \
    if (IN((pb) + 0)) { const bf16* wt_ = (const bf16*)(ws + WS_WRETIN) + (size_t)(J) * RET_IN * D; const EmitRetIn e_{Qp_, Kp_, Vp_, SGp_}; \
        MAIN_GEMM(EmitRetIn, e_, Hb, wt_, RET_IN, D); REPEAT(REP_SKINNY) skinny_gemm<8>(F, Hb + (size_t)MPR * D, D, 1, MS, MPR, wt_, (RET_IN / 256) * 8, false, e_, 0, F.G); SEAM((pb) + 0); } \
    if (IN((pb) + 1)) { const bool fuse_ = (F.G == 256); const float* ssi_ = INP(I_SRET) + (size_t)(J) * 128 * 4 * 256 * 512; float* sso_ = out + O_RETS + (size_t)(J) * 128 * 4 * 256 * 512; \
        if (fuse_) { REPEAT(REP_PROMPT) ret_prompt_item<true>(F, F.vcu, Qp_, Kp_, Vp_, RO, out + O_RETP + (size_t)(J) * 8 * 4 * 256 * 512, ssi_, sso_); } \
        else { for (int item = F.vcu; item < 256; item += F.G) ret_prompt_item<false>(F, item, Qp_, Kp_, Vp_, RO, out + O_RETP + (size_t)(J) * 8 * 4 * 256 * 512, ssi_, sso_); \
            REPEAT(REP_SAMPLE) ret_sample_items(F, Qp_, Kp_, Vp_, RO, ssi_, sso_); } SEAM((pb) + 1); } \
    if (IN((pb) + 2)) { REPEAT(REP_GN) gatenorm_phase<0>(F, RO, SGp_, GO, nullptr); SEAM((pb) + 2); } \
    OUT_PROJ(pb, (const bf16*)(ws + WS_WRETOUT) + (size_t)(J) * D * 2048, 2048); \
    } while (0)

    RET_LAYER(0, 0, 3);
    FFN_BLOCK(0, 3, false);
    {
        constexpr int pb = 11;
        bf16* const SZ_ = (bf16*)(PJ + PJ_SSD_SZ); bf16* const XBC_ = (bf16*)(PJ + PJ_SSD_XBC); float* const DT_ = (float*)(PJ + PJ_SSD_DT);
        if (IN(pb + 0)) { const bf16* wt_ = (const bf16*)(ws + WS_WSSDIN); const EmitSsdIn e_{SZ_, XBC_}; const EmitDt ed_{DT_};
            MAIN_GEMM(EmitSsdIn, e_, Hb, wt_, SSD_INM, D);
            REPEAT(REP_SKINNY) skinny_gemm<8>(F, Hb + (size_t)MPR * D, D, 1, MS, MPR, wt_, (SSD_INM / 256) * 8, false, e_, 0, F.G);
            REPEAT(REP_SKINNY) skinny_gemm<8>(F, Hb, D, MT / 128, MT, 0, wt_, 1, true, ed_, 100, 129);
            SEAM(pb + 0); }
        if (IN(pb + 1)) {
            REPEAT(REP_PROMPT_SSD) for (int item = F.vcu; item < 256; item += F.G) ssd_prompt_item(F, item, XBC_, DT_, RO, out + O_SSDP, INP(I_CONVW), INP(I_CONVB), INP(I_DTB), INP(I_ALOG), INP(I_SSDD));
            REPEAT(REP_SAMPLE) ssd_sample_items(F, XBC_, DT_, RO, INP(I_SSSD), out + O_SSDS, INP(I_SCONV), INP(I_CONVW), INP(I_CONVB), INP(I_DTB), INP(I_ALOG), INP(I_SSDD));
            ssd_conv_out(F, XBC_, INP(I_SCONV), out + O_CONVP, out + O_CONVS);
            SEAM(pb + 1); }
        if (IN(pb + 2)) { REPEAT(REP_GN) gatenorm_phase<1>(F, RO, SZ_, GO, INP(I_SSDNORM)); SEAM(pb + 2); }
        OUT_PROJ(pb, (const bf16*)(ws + WS_WSSDOUT), 2048);
    }
    FFN_BLOCK(1, 11, false);
    {
        constexpr int pb = 19;
        bf16* const HQ_ = (bf16*)(PJ + PJ_HG_Q); float* const LA_ = (float*)(PJ + PJ_HG_LA); bf16* const HV_ = (bf16*)(PJ + PJ_HG_V); bf16* const HSG_ = (bf16*)(PJ + PJ_HG_SG);
        if (IN(pb + 0)) { const bf16* wt_ = (const bf16*)(ws + WS_WHGIN); const EmitHgIn e_{HQ_, HV_, HSG_, LA_, LB};
            MAIN_GEMM(EmitHgIn, e_, Hb, wt_, HG_IN, D); REPEAT(REP_SKINNY) skinny_gemm<8>(F, Hb + (size_t)MPR * D, D, 1, MS, MPR, wt_, (HG_IN / 256) * 8, false, e_, 0, F.G); SEAM(pb + 0); }
        if (IN(pb + 1)) {
            REPEAT(REP_PROMPT_HG) for (int item = F.vcu; item < 256; item += F.G) hg_prompt_item(F, item, HQ_, LA_, HV_, RO, out + O_HGP);
            REPEAT(REP_SAMPLE) hg_sample_items(F, HQ_, LA_, HV_, RO, INP(I_SHG), out + O_HGS);
            SEAM(pb + 1); }
        if (IN(pb + 2)) { REPEAT(REP_GN) gatenorm_phase<2>(F, RO, HSG_, GO, INP(I_HGNORM)); SEAM(pb + 2); }
        OUT_PROJ(pb, (const bf16*)(ws + WS_WHGOUT), 1024);
    }
    FFN_BLOCK(2, 19, false);
    RET_LAYER(3, 1, 27);
    FFN_BLOCK(3, 27, true);
#undef IN
#undef SEAM
}

extern "C" void kernel_launch(void* const* d_in, const int* in_sizes, int n_in, void* d_out, int out_size, void* d_ws, size_t ws_size, hipStream_t stream) {
    static int grid = 0;
    if (grid == 0) {
        if (n_in != 30 || (size_t)out_size != O_END || ws_size < WS_END) { fprintf(stderr, "kernel_launch: unexpected shapes (n_in %d out %d ws %zu)\n", n_in, out_size, ws_size); grid = -1; return; }
        int dev = 0, cus = 0, per_cu = 0;
        if (hipGetDevice(&dev) != hipSuccess || hipDeviceGetAttribute(&cus, hipDeviceAttributeMultiprocessorCount, dev) != hipSuccess) { grid = -1; return; }
        if (hipFuncSetAttribute((const void*)mk_fwd, hipFuncAttributeMaxDynamicSharedMemorySize, LDS_BYTES) != hipSuccess) { fprintf(stderr, "kernel_launch: hipFuncSetAttribute failed\n"); grid = -1; return; }
        if (hipOccupancyMaxActiveBlocksPerMultiprocessor(&per_cu, (const void*)mk_fwd, NWAVES * 64, LDS_BYTES) != hipSuccess || per_cu < 1) { fprintf(stderr, "kernel_launch: occupancy query says %d\n", per_cu); }
        (void)hipGetLastError();
        grid = cus;
    }
    if (grid < 0) return;
    if (hipMemsetAsync((char*)d_ws + WS_CTL, 0, CTL_ZERO_BYTES, stream) != hipSuccess) { fprintf(stderr, "kernel_launch: memset failed\n"); return; }
    Args a{};
    for (int i = 0; i < 30; ++i) a.in[i] = (const float*)d_in[i];
    a.out = (float*)d_out; a.ws = (unsigned char*)d_ws;
#if MK_N_LAUNCHES == 1
    a.ph_lo = 0; a.ph_hi = N_PHASES;
    hipLaunchKernelGGL(mk_fwd, dim3(grid), dim3(NWAVES * 64), LDS_BYTES, stream, a);
#else
    for (int p = 0; p < N_PHASES; ++p) { a.ph_lo = p; a.ph_hi = p + 1; hipLaunchKernelGGL(mk_fwd, dim3(grid), dim3(NWAVES * 64), LDS_BYTES, stream, a); }
#endif
    const hipError_t le = hipPeekAtLastError();
    if (le != hipSuccess) fprintf(stderr, "kernel_launch: launch failed: %s\n", hipGetErrorName(le));
}
```

```cpp
#include <hip/hip_runtime.h>
#include <cstdio>
#include <cstdint>
namespace pg8 {
#define PG8_LAS __attribute__((address_space(3)))
typedef unsigned short bf16_t;
typedef short bf16x8 __attribute__((ext_vector_type(8)));
typedef float f32x4 __attribute__((ext_vector_type(4)));
typedef unsigned u32x4 __attribute__((ext_vector_type(4)));
constexpr int BM = 256, BK = 64, HALF = 128, HTB = HALF * BK * 2  , STAGE_BYTES = 8 * HTB, NXCD = 8, WGM = 8;

__host__ __device__ __forceinline__ int lds_byte(int r, int c) { const int st = (r >> 4) * 2 + (c >> 5), rr = r & 15, cc = c & 31, ob = rr * 64 + cc * 2; return st * 1024 + (ob ^ (((ob >> 9) & 1) << 5)); }
__host__ __device__ __forceinline__ void stage_rc(int b, int& R, int& C) { const int st = b / 1024, sb = b % 1024, swz = sb ^ (((sb >> 9) & 1) << 5); R = (st >> 1) * 16 + swz / 64; C = (st & 1) * 32 + (swz % 64) / 2; }
__host__ __device__ __forceinline__ int perm32(int rho) { const int n = rho >> 4, i = rho & 15; return 8 * (i >> 2) + 4 * n + (i & 3); }

struct Unit { int pm, pn; };
struct Gemm { const bf16_t* A; const bf16_t* Bt; int M, N, K; };

struct StaticOrder {
    int nM, nN, nwg, G, c;
    __host__ __device__ void init(int M, int N, int G_, int c_) { nM = M / BM; nN = N / BM; nwg = nM * nN; G = G_; c = c_; }
    __host__ __device__ bool next(int i, Unit& u) const {
        const long L = (long)i * G + c; if (L >= nwg) return false;
        int wgid = (int)L; { const int q = nwg / NXCD, r = nwg % NXCD, xcd = wgid % NXCD, off = wgid / NXCD; wgid = (xcd < r ? xcd * (q + 1) : r * (q + 1) + (xcd - r) * q) + off; }
        const int nig = WGM * nN, gid = wgid / nig, fm = gid * WGM, gsz = (nM - fm) < WGM ? (nM - fm) : WGM;
        u.pm = fm + ((wgid % nig) % gsz); u.pn = (wgid % nig) / gsz; return true;
    }
    __device__ __forceinline__ void a_ready(const Unit&) const {}
    __device__ __forceinline__ void done(const Unit&) const {}
};

__device__ __forceinline__ unsigned cvt_pk_bf16(float lo, float hi) { unsigned r; asm volatile("v_cvt_pk_bf16_f32 %0, %1, %2" : "=v"(r) : "v"(lo), "v"(hi)); return r; }
typedef float f32x2 __attribute__((ext_vector_type(2)));
template <class Epi, class Sched, bool ALIGN_EPI = false, bool SP2 = false>
__device__ __forceinline__ void gemm_phase(PG8_LAS unsigned char* lds, const Gemm g, const Sched& S, const Epi& E, const bool bpre = false) {
    const int tid = threadIdx.x, wid = __builtin_amdgcn_readfirstlane(tid >> 6), lane = tid & 63, wr = wid >> 2, wc = wid & 3, fr = lane & 15, fq = lane >> 4;
    const int K = g.K, nt = K / BK;
    unsigned voffA[2], voffB[2];
#pragma unroll
    for (int i = 0; i < 2; ++i) { int R, C; stage_rc(tid * 16 + i * 8192, R, C); const int Rb = Epi::PERM ? ((R & ~31) + perm32(R & 31)) : R;
        voffA[i] = (unsigned)(R * K + C) * 2u; voffB[i] = (unsigned)(Rb * K + C) * 2u; }
    const size_t kstep = (size_t)(BK * 2);
    const size_t hstep = (size_t)HALF * K * 2;
    const size_t tstep = 2 * hstep;
    const unsigned ldsw = (unsigned)wid * 1024u;
    const int aoff = lds_byte(wr * 64 + fr, fq * 8), boff = lds_byte(wc * 32 + fr, fq * 8);
#define PG8_SA(b, h) (((b) * 2 + (h)) * HTB)
#define PG8_SB(b, h) ((4 + (b) * 2 + (h)) * HTB)
#define PG8_STAGE(bufoff, gbase, voff) do { _Pragma("unroll") for (int _i = 0; _i < 2; ++_i) \
        __builtin_amdgcn_global_load_lds((const unsigned*)((const char*)(gbase) + (voff)[_i]), (PG8_LAS unsigned*)(lds + (bufoff) + ldsw + _i * 8192), 16, 0, 0); } while (0)
#define PG8_LDA(dst, b, h) do { _Pragma("unroll") for (int m = 0; m < 4; ++m) _Pragma("unroll") for (int k = 0; k < 2; ++k) dst[m][k] = *(const PG8_LAS bf16x8*)(lds + PG8_SA(b, h) + aoff + m * 2048 + k * 1024); } while (0)
#define PG8_LDB(dst, b, h) do { _Pragma("unroll") for (int n = 0; n < 2; ++n) _Pragma("unroll") for (int k = 0; k < 2; ++k) dst[n][k] = *(const PG8_LAS bf16x8*)(lds + PG8_SB(b, h) + boff + n * 2048 + k * 1024); } while (0)
#define PG8_MMA(ai, bj, At, Bt) do { __builtin_amdgcn_s_setprio(1); _Pragma("unroll") for (int m = 0; m < 4; ++m) _Pragma("unroll") for (int n = 0; n < 2; ++n) _Pragma("unroll") for (int k = 0; k < 2; ++k) \
        acc[ai][bj][m][n] = __builtin_amdgcn_mfma_f32_16x16x32_bf16(Bt[n][k], At[m][k], acc[ai][bj][m][n], 0, 0, 0); __builtin_amdgcn_s_setprio(0); } while (0)
#define PG8_WAIT_V(n) asm volatile("s_waitcnt vmcnt(" #n ")" ::: "memory")
#define PG8_WAIT_L(n) asm volatile("s_waitcnt lgkmcnt(" #n ")" ::: "memory")
#define PG8_BAR __builtin_amdgcn_s_barrier()
#define PG8_SCHED __builtin_amdgcn_sched_barrier(0)
    Unit cur, nxt; int ui = 0;
    if (!S.next(0, cur)) return;
    f32x4 acc[2][2][4][2];
#pragma unroll
    for (int a = 0; a < 2; ++a)
#pragma unroll
        for (int b = 0; b < 2; ++b)
#pragma unroll
            for (int m = 0; m < 4; ++m)
#pragma unroll
                for (int n = 0; n < 2; ++n) acc[a][b][m][n] = (f32x4){0.f, 0.f, 0.f, 0.f};
    bf16x8 At[4][2], B0[2][2], B1[2][2];
    const char* cA = (const char*)g.A + (size_t)cur.pm * tstep; const char* cB = (const char*)g.Bt + (size_t)cur.pn * tstep;
    S.a_ready(cur);
    if constexpr (SP2) {
        if (!(bpre && wid != 0)) { PG8_STAGE(PG8_SB(0, 0), cB, voffB); PG8_STAGE(PG8_SB(0, 1), cB + hstep, voffB); }
        PG8_STAGE(PG8_SA(0, 0), cA, voffA); PG8_STAGE(PG8_SA(0, 1), cA + hstep, voffA);
        if (wr == 1) PG8_BAR;
        PG8_WAIT_V(2); PG8_BAR;
        PG8_STAGE(PG8_SB(1, 0), cB + kstep, voffB); PG8_STAGE(PG8_SA(1, 0), cA + kstep, voffA); PG8_STAGE(PG8_SB(1, 1), cB + hstep + kstep, voffB);
        PG8_WAIT_V(6); PG8_BAR;
    } else {
        PG8_STAGE(PG8_SB(0, 0), cB, voffB); PG8_STAGE(PG8_SA(0, 0), cA, voffA); PG8_STAGE(PG8_SB(0, 1), cB + hstep, voffB); PG8_STAGE(PG8_SA(0, 1), cA + hstep, voffA);
        if (wr == 1) PG8_BAR;
        PG8_WAIT_V(4); PG8_BAR;
        PG8_STAGE(PG8_SB(1, 0), cB + kstep, voffB); PG8_STAGE(PG8_SA(1, 0), cA + kstep, voffA); PG8_STAGE(PG8_SB(1, 1), cB + hstep + kstep, voffB);
        PG8_WAIT_V(6); PG8_BAR;
    }
    for (;;) {
        const bool has_next = S.next(ui + 1, nxt);
        const char* nA = has_next ? (const char*)g.A + (size_t)nxt.pm * tstep : cA; const char* nB = has_next ? (const char*)g.Bt + (size_t)nxt.pn * tstep : cB;
        for (int t = 0; t < nt; t += 2) {
            const bool last = (t == nt - 2);
            const char* a1 = cA + (size_t)(t + 1) * kstep;
            const char* a2 = last ? nA : cA + (size_t)(t + 2) * kstep; const char* b2 = last ? nB : cB + (size_t)(t + 2) * kstep;
            const char* a3 = a2 + kstep; const char* b3 = b2 + kstep;
            if (last && has_next) S.a_ready(nxt);
            if constexpr (SP2) {
            PG8_LDB(B0, 0, 0); PG8_LDB(B1, 0, 1); PG8_SCHED; PG8_LDA(At, 0, 0); PG8_STAGE(PG8_SA(1, 1), a1 + hstep, voffA);
            PG8_WAIT_V(8); PG8_WAIT_L(0); PG8_BAR; PG8_MMA(0, 0, At, B0); PG8_MMA(0, 1, At, B1); PG8_BAR; PG8_SCHED;
            PG8_LDA(At, 0, 1); PG8_STAGE(PG8_SB(0, 0), b2, voffB); PG8_STAGE(PG8_SB(0, 1), b2 + hstep, voffB); PG8_STAGE(PG8_SA(0, 0), a2, voffA);
            PG8_WAIT_V(8); PG8_WAIT_L(0); PG8_BAR; PG8_MMA(1, 0, At, B0); PG8_MMA(1, 1, At, B1); PG8_BAR; PG8_SCHED;
            PG8_LDB(B0, 1, 0); PG8_LDB(B1, 1, 1); PG8_SCHED; PG8_LDA(At, 1, 0); PG8_STAGE(PG8_SA(0, 1), a2 + hstep, voffA);
            PG8_WAIT_V(8); PG8_WAIT_L(0); PG8_BAR; PG8_MMA(0, 0, At, B0); PG8_MMA(0, 1, At, B1); PG8_BAR; PG8_SCHED;
            PG8_LDA(At, 1, 1); PG8_STAGE(PG8_SB(1, 0), b3, voffB); PG8_STAGE(PG8_SB(1, 1), b3 + hstep, voffB); PG8_STAGE(PG8_SA(1, 0), a3, voffA);
            PG8_WAIT_V(8); PG8_WAIT_L(0); PG8_BAR; PG8_MMA(1, 0, At, B0); PG8_MMA(1, 1, At, B1); PG8_BAR; PG8_SCHED;
            } else {
            PG8_LDB(B0, 0, 0); PG8_SCHED; PG8_LDA(At, 0, 0); PG8_STAGE(PG8_SA(1, 1), a1 + hstep, voffA);
            PG8_WAIT_L(8); PG8_BAR; PG8_WAIT_L(0); PG8_MMA(0, 0, At, B0); PG8_BAR; PG8_SCHED;
            PG8_LDB(B1, 0, 1); PG8_STAGE(PG8_SB(0, 0), b2, voffB);
            PG8_BAR; PG8_WAIT_L(0); PG8_MMA(0, 1, At, B1); PG8_BAR;
            PG8_LDA(At, 0, 1); PG8_STAGE(PG8_SA(0, 0), a2, voffA);
            PG8_BAR; PG8_WAIT_L(0); PG8_MMA(1, 0, At, B0); PG8_BAR; PG8_SCHED;
            PG8_STAGE(PG8_SB(0, 1), b2 + hstep, voffB);
            PG8_WAIT_V(6); PG8_BAR; PG8_MMA(1, 1, At, B1); PG8_BAR;
            PG8_LDB(B0, 1, 0); PG8_SCHED; PG8_LDA(At, 1, 0); PG8_STAGE(PG8_SA(0, 1), a2 + hstep, voffA);
            PG8_WAIT_L(8); PG8_BAR; PG8_WAIT_L(0); PG8_MMA(0, 0, At, B0); PG8_BAR; PG8_SCHED;
            PG8_LDB(B1, 1, 1); PG8_STAGE(PG8_SB(1, 0), b3, voffB);
            PG8_BAR; PG8_WAIT_L(0); PG8_MMA(0, 1, At, B1); PG8_BAR;
            PG8_LDA(At, 1, 1); PG8_STAGE(PG8_SA(1, 0), a3, voffA);
            PG8_BAR; PG8_WAIT_L(0); PG8_MMA(1, 0, At, B0); PG8_BAR; PG8_SCHED;
            PG8_STAGE(PG8_SB(1, 1), b3 + hstep, voffB);
            PG8_WAIT_V(6); PG8_BAR; PG8_MMA(1, 1, At, B1); PG8_BAR;
            }
        }
        if constexpr (ALIGN_EPI) { if (wr == 0) PG8_BAR; }
        if constexpr (!Epi::AFTER_DRAIN) { E(acc, cur, wr, wc, fr, fq); S.done(cur); }
        if (!has_next) break;
#pragma unroll
        for (int a = 0; a < 2; ++a)
#pragma unroll
            for (int b = 0; b < 2; ++b)
#pragma unroll
                for (int m = 0; m < 4; ++m)
#pragma unroll
                    for (int n = 0; n < 2; ++n) acc[a][b][m][n] = (f32x4){0.f, 0.f, 0.f, 0.f};
        cur = nxt; cA = nA; cB = nB; ++ui;
        if constexpr (ALIGN_EPI) { if (wr == 1) PG8_BAR; }
    }
    PG8_WAIT_V(0);
    if constexpr (!ALIGN_EPI) { if (wr == 0) PG8_BAR; }
    PG8_BAR;
    if constexpr (Epi::AFTER_DRAIN) { E.fused(acc, cur, wr, wc, fr, fq, lds, wid, lane); S.done(cur); }
#undef PG8_SA
#undef PG8_SB
#undef PG8_STAGE
#undef PG8_LDA
#undef PG8_LDB
#undef PG8_MMA
#undef PG8_WAIT_V
#undef PG8_WAIT_L
#undef PG8_BAR
#undef PG8_SCHED
}
}

#ifndef PG8_SP2
#define PG8_SP2 true
#endif
#ifndef PG8_ALIGN
#define PG8_ALIGN true
#endif
#ifndef MK_N_LAUNCHES
#define MK_N_LAUNCHES 1
#endif

constexpr int D = 1024, BP = 8, SEQ = 2048, MPR = BP * SEQ  , MS = 128  , MT = MPR + MS  ;
constexpr int NCOND = BP + MS;
constexpr int DFF = 2816, NMOD = 6 * D  , NMODALL = 4 * NMOD  ;
constexpr int RET_IN = 6144, SSD_IN = 5152, SSD_INM = 5120, HG_IN = 4096, FFN_IN = 2 * DFF;
constexpr float EPS = 1e-6f;
constexpr int NWAVES = 8;

constexpr size_t MiB = 1u << 20;
constexpr size_t WS_CTL = 0, CTL_ZERO_BYTES = 1 * MiB;
constexpr size_t WS_WADA = 1 * MiB;
constexpr size_t WS_WRETIN = WS_WADA + 48 * MiB;
constexpr size_t WS_WRETOUT = WS_WRETIN + 24 * MiB;
constexpr size_t WS_WSSDIN = WS_WRETOUT + 8 * MiB;
constexpr size_t WS_WSSDOUT = WS_WSSDIN + 11 * MiB;
constexpr size_t WS_WHGIN = WS_WSSDOUT + 4 * MiB;
constexpr size_t WS_WHGOUT = WS_WHGIN + 8 * MiB;
constexpr size_t WS_WFFNIN = WS_WHGOUT + 2 * MiB;
constexpr size_t WS_WFFNOUT = WS_WFFNIN + 44 * MiB;
constexpr size_t WS_MOD = WS_WFFNOUT + 22 * MiB;
constexpr size_t WS_CACT = WS_MOD + 24 * MiB;
constexpr size_t WS_LB = WS_CACT + 512 * 1024;
constexpr size_t WS_H = WS_CACT + 1 * MiB;
constexpr size_t WS_PROJ = WS_H + 33 * MiB;
constexpr size_t WS_RO = WS_PROJ + 200 * MiB;
constexpr size_t WS_GO = WS_RO + 65 * MiB;
constexpr size_t WS_OUT = WS_GO + 65 * MiB;
constexpr size_t WS_ACT = WS_OUT + 33 * MiB;
constexpr size_t WS_XB = WS_ACT + 89 * MiB;
constexpr size_t WS_END = WS_XB + 33 * MiB;
constexpr size_t PJ_RET_Q = 0, PJ_RET_K = PJ_RET_Q + (size_t)MT * 1024 * 2, PJ_RET_V = PJ_RET_K + (size_t)MT * 1024 * 2, PJ_RET_SG = PJ_RET_V + (size_t)MT * 2048 * 2;
constexpr size_t PJ_SSD_SZ = 0, PJ_SSD_XBC = PJ_SSD_SZ + (size_t)MT * 2048 * 2, PJ_SSD_DT = PJ_SSD_XBC + (size_t)MT * 3072 * 2;
constexpr size_t PJ_HG_Q = 0, PJ_HG_LA = PJ_HG_Q + (size_t)MT * 1024 * 2, PJ_HG_V = PJ_HG_LA + (size_t)MT * 1024 * 4, PJ_HG_SG = PJ_HG_V + (size_t)MT * 1024 * 2;
static_assert(PJ_RET_SG + (size_t)MT * 2048 * 2 <= 200 * MiB && PJ_SSD_DT + (size_t)MT * 32 * 4 <= 200 * MiB && PJ_HG_SG + (size_t)MT * 1024 * 2 <= 200 * MiB, "proj map");
constexpr int CW_BAR = 4096;
#ifndef PANEL_SYNC
#define PANEL_SYNC 1
#endif
constexpr int CW_PANEL = 16384;

constexpr size_t O_Y = 0;
constexpr size_t O_RETP = (size_t)MT * D;
constexpr size_t O_RETS = O_RETP + (size_t)2 * 8 * 4 * 256 * 512;
constexpr size_t O_SSDP = O_RETS + (size_t)2 * 128 * 4 * 256 * 512;
constexpr size_t O_SSDS = O_SSDP + (size_t)8 * 32 * 128 * 64;
constexpr size_t O_CONVP = O_SSDS + (size_t)128 * 32 * 128 * 64;
constexpr size_t O_CONVS = O_CONVP + (size_t)8 * 3 * 3072;
constexpr size_t O_HGP = O_CONVS + (size_t)128 * 3 * 3072;
constexpr size_t O_HGS = O_HGP + (size_t)8 * 8 * 128 * 128;
constexpr size_t O_END = O_HGS + (size_t)128 * 8 * 128 * 128;
static_assert(O_END == 214245376ull, "output size");

constexpr int LDS_BYTES = 147456;
constexpr int LDSCTL_OFF = LDS_BYTES - 1024;
constexpr int SCR_BYTES = LDSCTL_OFF;

#define GAS __attribute__((address_space(1)))
#define LAS __attribute__((address_space(3)))
typedef unsigned short bf16;
typedef unsigned v4u __attribute__((ext_vector_type(4)));
typedef unsigned v2u __attribute__((ext_vector_type(2)));
typedef float f32x4 __attribute__((ext_vector_type(4)));
typedef short bf16x8 __attribute__((ext_vector_type(8)));
typedef short s16x4 __attribute__((ext_vector_type(4)));
typedef GAS unsigned gu32;
#define RLX_AGENT __ATOMIC_RELAXED, __HIP_MEMORY_SCOPE_AGENT
#define LDS_WAIT() asm volatile("s_waitcnt lgkmcnt(0)" ::: "memory")
#define VM_WAIT() asm volatile("s_waitcnt vmcnt(0)" ::: "memory")
typedef float f32x2_t __attribute__((ext_vector_type(2))); typedef __bf16 bf16x2_t __attribute__((ext_vector_type(2)));
__device__ __forceinline__ unsigned cvt_pk_bf16(float lo, float hi) { f32x2_t v = {lo, hi}; bf16x2_t b = __builtin_convertvector(v, bf16x2_t); return __builtin_bit_cast(unsigned, b); }
__device__ __forceinline__ float bf2f(unsigned b) { return __uint_as_float(b << 16); }
__device__ __forceinline__ float bflo(unsigned w) { return __uint_as_float(w << 16); }
__device__ __forceinline__ float bfhi(unsigned w) { return __uint_as_float(w & 0xffff0000u); }
__device__ __forceinline__ void unpack8(const v4u w, float (&f)[8]) { f[0] = bflo(w.x); f[1] = bfhi(w.x); f[2] = bflo(w.y); f[3] = bfhi(w.y); f[4] = bflo(w.z); f[5] = bfhi(w.z); f[6] = bflo(w.w); f[7] = bfhi(w.w); }
__device__ __forceinline__ v4u pack8(const float (&f)[8]) { v4u w; w.x = cvt_pk_bf16(f[0], f[1]); w.y = cvt_pk_bf16(f[2], f[3]); w.z = cvt_pk_bf16(f[4], f[5]); w.w = cvt_pk_bf16(f[6], f[7]); return w; }
__device__ __forceinline__ v4u pack8v(const f32x4 a, const f32x4 b) { v4u w; w.x = cvt_pk_bf16(a[0], a[1]); w.y = cvt_pk_bf16(a[2], a[3]); w.z = cvt_pk_bf16(b[0], b[1]); w.w = cvt_pk_bf16(b[2], b[3]); return w; }
__device__ __forceinline__ v2u pack4v(const f32x4 a) { v2u w; w.x = cvt_pk_bf16(a[0], a[1]); w.y = cvt_pk_bf16(a[2], a[3]); return w; }
__device__ __forceinline__ float sigmoidf_(float x) { return __builtin_amdgcn_rcpf(1.f + __expf(-x)); }
__device__ __forceinline__ float siluf_(float x) { return x * sigmoidf_(x); }
__device__ __forceinline__ float softplusf_(float x) { return x > 20.f ? x : log1pf(__expf(x)); }
__device__ __forceinline__ float wave_sum(float v) {
#pragma unroll
    for (int o = 1; o < 64; o <<= 1) v += __shfl_xor(v, o);
    return v;
}
__device__ __forceinline__ float grp16_sum(float v) {
#pragma unroll
    for (int o = 1; o < 16; o <<= 1) v += __shfl_xor(v, o);
    return v;
}
#define MFMA16(a, b, c) __builtin_amdgcn_mfma_f32_16x16x32_bf16((a), (b), (c), 0, 0, 0)
#define XB_TMO      128
#define XB_XCNT(j)  (256  + 64 * (j))
#define XB_XSUB(j)  (1280 + 64 * (j))
#define XB_XGEN(j)  (2304 + 64 * (j))
#define XB_TOP      3328
#define XB_TOPGEN   3392
#define XCD_BAR_WORDS 3456
#define XB_SPIN_CAP (1u << 18)

__device__ __forceinline__ unsigned xb_ld(unsigned* p)              { return __hip_atomic_load(p, __ATOMIC_RELAXED, __HIP_MEMORY_SCOPE_AGENT); }
__device__ __forceinline__ unsigned xb_add(unsigned* p, unsigned v) { return __hip_atomic_fetch_add(p, v, __ATOMIC_RELAXED, __HIP_MEMORY_SCOPE_AGENT); }
__device__ __forceinline__ unsigned xb_xcc_id() { return (unsigned)__builtin_amdgcn_s_getreg((3 << 11) | 20) & 0xFu; }
#define XB_SPIN(cond, bar) do { unsigned _sp = 0; while (cond) { __builtin_amdgcn_s_sleep(1); \
    if ((++_sp & 255u) == 0u) { if (xb_ld(&(bar)[XB_TMO])) break; if (_sp > XB_SPIN_CAP) { atomicAdd(&(bar)[XB_TMO], 1u); break; } } } } while (0)

struct XcdBarrier {
    unsigned* bar; unsigned x;
    volatile LAS unsigned* st;
};

__device__ __forceinline__ XcdBarrier xcd_barrier_post(unsigned* bar, volatile LAS unsigned* st) {
    XcdBarrier b; b.bar = bar; b.x = xb_xcc_id(); b.st = st;
    if (threadIdx.x == 0) (void)xb_add(&bar[XB_XCNT(b.x)], 1u);
    return b;
}
__device__ __forceinline__ void xcd_barrier_complete(unsigned* bar, unsigned x, unsigned& nloc, unsigned& nx) {
    const unsigned G = gridDim.x * gridDim.y * gridDim.z;
    unsigned sum, cnt, mine, sp = 0u;
    for (;;) {
        sum = 0u; cnt = 0u; mine = 0u;
#pragma unroll
        for (unsigned j = 0; j < 16; ++j) { const unsigned c = xb_ld(&bar[XB_XCNT(j)]); sum += c; cnt += (c > 0u) ? 1u : 0u; mine = (j == x) ? c : mine; }
        if (sum == G) break;
        __builtin_amdgcn_s_sleep(1);
        if ((++sp & 255u) == 0u) { if (xb_ld(&bar[XB_TMO])) break; if (sp > XB_SPIN_CAP) { atomicAdd(&bar[XB_TMO], 1u); break; } }
    }
    nloc = mine > 0u ? mine : 1u; nx = cnt > 0u ? cnt : 1u;
}

__device__ __forceinline__ void xcd_barrier(const XcdBarrier& b) {
    asm volatile("s_waitcnt vmcnt(0)" ::: "memory");
    __syncthreads();
    if (threadIdx.x == 0) {
        unsigned* bar = b.bar;
        __builtin_amdgcn_s_waitcnt(0);
        unsigned nloc = b.st[0], nx = b.st[1];
        if (nloc == 0u) { xcd_barrier_complete(bar, b.x, nloc, nx); b.st[0] = nloc; b.st[1] = nx; }
        const unsigned old = xb_add(&bar[XB_XSUB(b.x)], 1u);
        const unsigned gen = old / nloc;
        if (old + 1u == (gen + 1u) * nloc) {
            __builtin_amdgcn_fence(__ATOMIC_RELEASE, "agent");
            asm volatile("s_waitcnt vmcnt(0)" ::: "memory");
            const unsigned og = xb_add(&bar[XB_TOP], 1u);
            const unsigned tg = og / nx;
            if (og + 1u == (tg + 1u) * nx) xb_add(&bar[XB_TOPGEN], 1u);
            else XB_SPIN(xb_ld(&bar[XB_TOPGEN]) == tg, bar);
            __builtin_amdgcn_fence(__ATOMIC_ACQUIRE, "agent");
            xb_add(&bar[XB_XGEN(b.x)], 1u);
            asm volatile("s_waitcnt vmcnt(0)" ::: "memory");
        } else {
            XB_SPIN(xb_ld(&bar[XB_XGEN(b.x)]) == gen, bar);
            __builtin_amdgcn_fence(__ATOMIC_ACQUIRE, "agent");
            asm volatile("s_waitcnt vmcnt(0)" ::: "memory");
        }
    }
    __syncthreads();
}


struct Frame {
    LAS unsigned char* lds;
    int tid, lane, wave;
    int vcu, G;
};

__device__ __forceinline__ int panel_of_wg() { const int bx = blockIdx.x; return 8 * (bx & 7) + ((bx >> 3) & 7); }
__device__ __forceinline__ int panel_row0(const Frame& F) { const int bx = blockIdx.x; return 256 * panel_of_wg() + 64 * (bx >> 6) + 8 * F.wave; }
__device__ __forceinline__ gu32* panel_word(gu32* ctl, int seam, int idx) { return ctl + CW_PANEL + (seam * 66 + idx) * 64; }
#ifndef WT_ROW
#define WT_ROW 1
#endif
#ifndef WT_G3
#define WT_G3 1
#endif
#ifndef WT_OUT
#define WT_OUT 1
#endif
template <bool WT = true>
__device__ __forceinline__ void st16_wt(void* rowbase, int nbytes, int byteoff, const v4u v) {
    const __amdgpu_buffer_rsrc_t rs = __builtin_amdgcn_make_buffer_rsrc(rowbase, (short)0, nbytes, 0x00020000);
    __builtin_amdgcn_raw_buffer_store_b128(v, rs, byteoff, 0,   WT ? 16 : 0);
}
__device__ __forceinline__ void panel_publish(Frame& F, gu32* ctl, int seam, int pm, unsigned nsample, bool rel = false) {
    asm volatile("s_waitcnt vmcnt(0)" ::: "memory");
    __syncthreads();
    if (F.tid == 0) { if (rel) { __builtin_amdgcn_fence(__ATOMIC_RELEASE, "agent"); asm volatile("s_waitcnt vmcnt(0)" ::: "memory"); }
        (void)__hip_atomic_fetch_add(panel_word(ctl, seam, pm), 1u, RLX_AGENT); (void)__hip_atomic_fetch_add(panel_word(ctl, seam, 65), 1u, RLX_AGENT);
        if (nsample) (void)__hip_atomic_fetch_add(panel_word(ctl, seam, 64), nsample, RLX_AGENT); }
}
__device__ __forceinline__ void panel_wait(Frame& F, gu32* word, unsigned want, gu32* tmo) {
    if (F.wave == 0) { unsigned sp = 0;
        while ((unsigned)__builtin_amdgcn_readfirstlane(__hip_atomic_load(word, RLX_AGENT)) < want) { __builtin_amdgcn_s_sleep(1);
            if ((++sp & 255u) == 0u) { if (__builtin_amdgcn_readfirstlane(__hip_atomic_load(tmo, RLX_AGENT))) break;
                if (sp > (1u << 18)) { if (F.lane == 0) (void)__hip_atomic_fetch_add(tmo, 1u, RLX_AGENT); break; } } }
        __builtin_amdgcn_fence(__ATOMIC_ACQUIRE, "agent");
        asm volatile("s_waitcnt vmcnt(0)" ::: "memory"); }
    __syncthreads();
}

__device__ __forceinline__ void gemm_prefetch_b(LAS unsigned char* lds, const bf16* Bt, int N, int K, int G, int c, int tid, int wid) {
    pg8::StaticOrder S; S.init(MPR, N, G, c); pg8::Unit u; if (!S.next(0, u)) return;
    const size_t hstep = (size_t)pg8::HALF * K * 2;
    const char* cB = (const char*)Bt + (size_t)u.pn * (2 * hstep);
#pragma unroll
    for (int h = 0; h < 2; ++h)
#pragma unroll
        for (int i = 0; i < 2; ++i) { int R, C; pg8::stage_rc(tid * 16 + i * 8192, R, C); const int Rb = (R & ~31) + pg8::perm32(R & 31);
            __builtin_amdgcn_global_load_lds((const unsigned*)(cB + h * hstep + (size_t)(unsigned)(Rb * K + C) * 2u), (LAS unsigned*)(lds + (4 + h) * pg8::HTB + wid * 1024 + i * 8192), 16, 0, 0); }
}
__device__ __forceinline__ void xcd_barrier_pf(const XcdBarrier& b, Frame& F, const bf16* Bt, int N, int K) {
    asm volatile("s_waitcnt vmcnt(0)" ::: "memory");
    __syncthreads();
    if (F.wave != 0) gemm_prefetch_b(F.lds, Bt, N, K, F.G, (int)blockIdx.x, F.tid, F.wave);
    if (threadIdx.x == 0) {
        unsigned* bar = b.bar;
        __builtin_amdgcn_s_waitcnt(0);
        unsigned nloc = b.st[0], nx = b.st[1];
        if (nloc == 0u) { xcd_barrier_complete(bar, b.x, nloc, nx); b.st[0] = nloc; b.st[1] = nx; }
        const unsigned old = xb_add(&bar[XB_XSUB(b.x)], 1u);
        const unsigned gen = old / nloc;
        if (old + 1u == (gen + 1u) * nloc) {
            __builtin_amdgcn_fence(__ATOMIC_RELEASE, "agent");
            asm volatile("s_waitcnt vmcnt(0)" ::: "memory");
            const unsigned og = xb_add(&bar[XB_TOP], 1u);
            const unsigned tg = og / nx;
            if (og + 1u == (tg + 1u) * nx) xb_add(&bar[XB_TOPGEN], 1u);
            else XB_SPIN(xb_ld(&bar[XB_TOPGEN]) == tg, bar);
            __builtin_amdgcn_fence(__ATOMIC_ACQUIRE, "agent");
            xb_add(&bar[XB_XGEN(b.x)], 1u);
            asm volatile("s_waitcnt vmcnt(0)" ::: "memory");
        } else {
            XB_SPIN(xb_ld(&bar[XB_XGEN(b.x)]) == gen, bar);
            __builtin_amdgcn_fence(__ATOMIC_ACQUIRE, "agent");
            asm volatile("s_waitcnt vmcnt(0)" ::: "memory");
        }
    }
    __syncthreads();
}

template <class Fn> struct EpiGen {
    static constexpr bool PERM = true, AFTER_DRAIN = false;
    Fn f;
    __device__ __forceinline__ void operator()(const pg8::f32x4 (&acc)[2][2][4][2], const pg8::Unit& u, int wr, int wc, int fr, int fq) const {
        const int ca = u.pn * 256 + wc * 32 + 8 * fq;
#pragma unroll
        for (int ai = 0; ai < 2; ++ai)
#pragma unroll
            for (int m = 0; m < 4; ++m) {
                const int row = u.pm * 256 + ai * 128 + wr * 64 + m * 16 + fr;
                f.emit(row, ca, ca + 128, acc[ai][0][m][0], acc[ai][0][m][1], acc[ai][1][m][0], acc[ai][1][m][1]);
            }
    }
};
__device__ __forceinline__ void st8bf(bf16* p, const f32x4 a, const f32x4 b) { *(GAS v4u*)p = pack8v(a, b); }
__device__ __forceinline__ f32x4 silu4(const f32x4 a) { f32x4 r; r[0] = siluf_(a[0]); r[1] = siluf_(a[1]); r[2] = siluf_(a[2]); r[3] = siluf_(a[3]); return r; }

struct EmitRetIn {
    bf16 *Q, *K, *V, *SG;
    __device__ __forceinline__ void emit(int row, int ca, int cb, const f32x4 a0, const f32x4 a1, const f32x4 b0, const f32x4 b1) const {
        const int pn = ca >> 8, ch = ca & 255;
        if (pn < 8) {
            const float pos = row < MPR ? (float)(row & (SEQ - 1)) : 16384.f;
            const float sc = pn < 4 ? 1.f : 0.0625f;
            float x1[8] = {a0[0], a0[1], a0[2], a0[3], a1[0], a1[1], a1[2], a1[3]}, x2[8] = {b0[0], b0[1], b0[2], b0[3], b1[0], b1[1], b1[2], b1[3]}, o1[8], o2[8];
#pragma unroll
            for (int e = 0; e < 8; ++e) {
                const float inv = exp2f(-(float)(ch + e) * (13.287712379549449f / 128.f));
                float t = pos * inv * 0.15915494309189535f; t -= floorf(t);
                const float s = __builtin_amdgcn_sinf(t), c = __builtin_amdgcn_cosf(t);
                o1[e] = (x1[e] * c - x2[e] * s) * sc; o2[e] = (x2[e] * c + x1[e] * s) * sc;
            }
            bf16* dst = (pn < 4 ? Q : K) + (size_t)row * 1024 + (pn & 3) * 256 + ch;
            *(GAS v4u*)dst = pack8(o1); *(GAS v4u*)(dst + 128) = pack8(o2);
        } else if (pn < 16) {
            bf16* dst = V + (size_t)row * 2048 + (pn - 8) * 256 + ch; st8bf(dst, a0, a1); st8bf(dst + 128, b0, b1);
        } else {
            bf16* dst = SG + (size_t)row * 2048 + (pn - 16) * 256 + ch; st8bf(dst, silu4(a0), silu4(a1)); st8bf(dst + 128, silu4(b0), silu4(b1));
        }
    }
};
struct EmitSsdIn {
    bf16 *SZ, *XBC;
    __device__ __forceinline__ void emit(int row, int ca, int cb, const f32x4 a0, const f32x4 a1, const f32x4 b0, const f32x4 b1) const {
        const int pn = ca >> 8, ch = ca & 255;
        if (pn < 8) { bf16* dst = SZ + (size_t)row * 2048 + pn * 256 + ch; st8bf(dst, silu4(a0), silu4(a1)); st8bf(dst + 128, silu4(b0), silu4(b1)); }
        else { bf16* dst = XBC + (size_t)row * 3072 + (pn - 8) * 256 + ch; st8bf(dst, a0, a1); st8bf(dst + 128, b0, b1); }
    }
};
struct EmitDt {
    float* DT;
    __device__ __forceinline__ void emit(int row, int ca, int cb, const f32x4 a0, const f32x4 a1, const f32x4 b0, const f32x4 b1) const {
        float* d = DT + (size_t)row * 32; *(GAS f32x4*)(d + (ca - SSD_INM)) = a0; *(GAS f32x4*)(d + (ca - SSD_INM) + 4) = a1; *(GAS f32x4*)(d + (cb - SSD_INM)) = b0; *(GAS f32x4*)(d + (cb - SSD_INM) + 4) = b1;
    }
};
struct EmitHgIn {
    bf16 *HQ, *HV, *HSG; float* LA; const float* lb;
    __device__ __forceinline__ f32x4 logf4(const f32x4 x, const f32x4 l) const { f32x4 r;
#pragma unroll
        for (int e = 0; e < 4; ++e) r[e] = logf(l[e] + (1.f - l[e]) * sigmoidf_(x[e]));
        return r; }
    __device__ __forceinline__ void emit(int row, int ca, int cb, const f32x4 a0, const f32x4 a1, const f32x4 b0, const f32x4 b1) const {
        const int pn = ca >> 8, ch = ca & 255;
        if (pn < 4) { bf16* dst = HQ + (size_t)row * 1024 + pn * 256 + ch; const float s = 0.08838834764831845f; st8bf(dst, silu4(a0) * s, silu4(a1) * s); st8bf(dst + 128, silu4(b0) * s, silu4(b1) * s); }
        else if (pn < 8) { const int col = (pn - 4) * 256 + ch; float* dst = LA + (size_t)row * 1024 + col;
            const f32x4 l0 = *(const GAS f32x4*)(lb + col), l1 = *(const GAS f32x4*)(lb + col + 4), l2 = *(const GAS f32x4*)(lb + col + 128), l3 = *(const GAS f32x4*)(lb + col + 132);
            const f32x4 r0 = logf4(a0, l0), r1 = logf4(a1, l1), r2 = logf4(b0, l2), r3 = logf4(b1, l3);
            *(GAS f32x4*)dst = r0; *(GAS f32x4*)(dst + 4) = r1; *(GAS f32x4*)(dst + 128) = r2; *(GAS f32x4*)(dst + 132) = r3; }
        else if (pn < 12) { bf16* dst = HV + (size_t)row * 1024 + (pn - 8) * 256 + ch; st8bf(dst, a0, a1); st8bf(dst + 128, b0, b1); }
        else { bf16* dst = HSG + (size_t)row * 1024 + (pn - 12) * 256 + ch; st8bf(dst, silu4(a0), silu4(a1)); st8bf(dst + 128, silu4(b0), silu4(b1)); }
    }
};
struct EmitOut {
    bf16* OUT;
    __device__ __forceinline__ void emit(int row, int ca, int cb, const f32x4 a0, const f32x4 a1, const f32x4 b0, const f32x4 b1) const {
        if (PANEL_SYNC) { const int o_ = row * 2048; st16_wt<WT_OUT>(OUT, MT * 1024 * 2, o_ + ca * 2, pack8v(a0, a1)); st16_wt<WT_OUT>(OUT, MT * 1024 * 2, o_ + cb * 2, pack8v(b0, b1)); }
        else { bf16* dst = OUT + (size_t)row * 1024; st8bf(dst + ca, a0, a1); st8bf(dst + cb, b0, b1); }
    }
};
struct EmitFfnIn {
    bf16* ACT;
    __device__ __forceinline__ void emit(int row, int ca, int cb, const f32x4 a0, const f32x4 a1, const f32x4 b0, const f32x4 b1) const {
        if (PANEL_SYNC) st16_wt<WT_G3>(ACT, MT * DFF * 2, (row * DFF + (ca >> 8) * 128 + (ca & 255)) * 2, pack8v(silu4(a0) * b0, silu4(a1) * b1));
        else { bf16* dst = ACT + (size_t)row * DFF + (ca >> 8) * 128 + (ca & 255); st8bf(dst, silu4(a0) * b0, silu4(a1) * b1); }
    }
};
struct EmitMod {
    float* MOD; const float* bias;
    __device__ __forceinline__ void emit(int row, int ca, int cb, const f32x4 a0, const f32x4 a1, const f32x4 b0, const f32x4 b1) const {
        float* d = MOD + (size_t)row * NMODALL;
        const f32x4 q0 = *(const GAS f32x4*)(bias + ca), q1 = *(const GAS f32x4*)(bias + ca + 4), q2 = *(const GAS f32x4*)(bias + cb), q3 = *(const GAS f32x4*)(bias + cb + 4);
        *(GAS f32x4*)(d + ca) = a0 + q0; *(GAS f32x4*)(d + ca + 4) = a1 + q1; *(GAS f32x4*)(d + cb) = b0 + q2; *(GAS f32x4*)(d + cb + 4) = b1 + q3;
    }
};

__device__ __forceinline__ bf16x8 frag_perm(const bf16x8 v, const int addr) {
    const v4u u = __builtin_bit_cast(v4u, v); v4u r;
    r.x = (unsigned)__builtin_amdgcn_ds_bpermute(addr, (int)u.x); r.y = (unsigned)__builtin_amdgcn_ds_bpermute(addr, (int)u.y);
    r.z = (unsigned)__builtin_amdgcn_ds_bpermute(addr, (int)u.z); r.w = (unsigned)__builtin_amdgcn_ds_bpermute(addr, (int)u.w);
    return __builtin_bit_cast(bf16x8, r);
}
template <int NMT, class Fn>
__device__ __forceinline__ void skinny_gemm(Frame& F, const bf16* A, int K, int nrg, int nrows, int rowbase, const bf16* Bt, int ncu, bool dtmode, const Fn& f, int wg0, int span) {
    const int w = F.wave, lane = F.lane, fr = lane & 15, fq = lane >> 4;
    const int TP = K >> 6, pb = TP >> 3, prem = TP & 7, npairs = pb + (w < prem ? 1 : 0), kw0 = (w * pb + (w < prem ? w : prem)) * 64;
    constexpr int R = NMT * 16;
    LAS unsigned char* red = F.lds;
    const int nun = nrg * ncu, me = (int)blockIdx.x - wg0;
    if (me >= 0 && me < span) {
    for (int u = me; u < nun; u += span) {
        const int rg = u / ncu, cu = u - rg * ncu;
        int ca, cb; if (dtmode) { ca = SSD_INM; cb = SSD_INM + 16; } else { ca = 256 * (cu >> 3) + 16 * (cu & 7); cb = ca + 128; }
        const int lrow = lane >> 2, lpc = lane & 3;
        const bf16* ap = A + (size_t)(rg * R + lrow) * K + kw0 + lpc * 8;
        const bf16* bpa = Bt + (size_t)(ca + lrow) * K + kw0 + lpc * 8;
        const bf16* bpb = Bt + (size_t)(cb + lrow) * K + kw0 + lpc * 8;
        const int paddr = (4 * fr + fq) * 4;
        f32x4 acc[NMT][2];
#pragma unroll
        for (int mt = 0; mt < NMT; ++mt) { acc[mt][0] = (f32x4){0.f, 0.f, 0.f, 0.f}; acc[mt][1] = (f32x4){0.f, 0.f, 0.f, 0.f}; }
        constexpr int DEPTH = (NMT >= 8) ? 1 : 2;
        bf16x8 ra[DEPTH][2][NMT], rb0[DEPTH][2], rb1[DEPTH][2];
#define SK_LOAD(d_, pp_) do { _Pragma("unroll") for (int h_ = 0; h_ < 2; ++h_) { const int k_ = (pp_) * 64 + h_ * 32; \
            rb0[d_][h_] = *(const GAS bf16x8*)(bpa + k_); rb1[d_][h_] = *(const GAS bf16x8*)(bpb + k_); \
            _Pragma("unroll") for (int mt_ = 0; mt_ < NMT; ++mt_) ra[d_][h_][mt_] = *(const GAS bf16x8*)(ap + (size_t)mt_ * 16 * K + k_); } } while (0)
#define SK_MMA(d_) do { _Pragma("unroll") for (int h_ = 0; h_ < 2; ++h_) { const bf16x8 fb0_ = frag_perm(rb0[d_][h_], paddr), fb1_ = frag_perm(rb1[d_][h_], paddr); \
            _Pragma("unroll") for (int mt_ = 0; mt_ < NMT; ++mt_) { const bf16x8 fa_ = frag_perm(ra[d_][h_][mt_], paddr); \
                acc[mt_][0] = MFMA16(fb0_, fa_, acc[mt_][0]); acc[mt_][1] = MFMA16(fb1_, fa_, acc[mt_][1]); } } } while (0)
        if constexpr (DEPTH == 1) {
            SK_LOAD(0, 0);
            for (int pp = 0; pp < npairs; ++pp) { SK_MMA(0); SK_LOAD(0, pp + 1 < npairs ? pp + 1 : pp); }
        } else {
            SK_LOAD(0, 0); SK_LOAD(1, npairs > 1 ? 1 : 0);
            for (int pp = 0; pp < npairs; pp += 2) {
                SK_MMA(0); SK_LOAD(0, pp + 2 < npairs ? pp + 2 : pp);
                if (pp + 1 < npairs) { SK_MMA(1); SK_LOAD(1, pp + 3 < npairs ? pp + 3 : pp + 1); }
            }
        }
#undef SK_LOAD
#undef SK_MMA
        __syncthreads();
#pragma unroll
        for (int mt = 0; mt < NMT; ++mt)
#pragma unroll
            for (int nt = 0; nt < 2; ++nt) { const int row = mt * 16 + fr; *(LAS f32x4*)(red + ((w * R + row) * 8 + ((4 * nt + fq) ^ (row & 7))) * 16) = acc[mt][nt]; }
        __syncthreads();
        if (F.tid < 2 * R) {
            const int row = F.tid >> 1, hf = F.tid & 1;
            f32x4 va0 = (f32x4){0.f, 0.f, 0.f, 0.f}, va1 = va0, vb0 = va0, vb1 = va0;
#pragma unroll
            for (int ww = 0; ww < 8; ++ww) { const LAS unsigned char* pr = red + (ww * R + row) * 128;
                va0 += *(const LAS f32x4*)(pr + ((2 * hf) ^ (row & 7)) * 16); va1 += *(const LAS f32x4*)(pr + ((2 * hf + 1) ^ (row & 7)) * 16);
                vb0 += *(const LAS f32x4*)(pr + ((4 + 2 * hf) ^ (row & 7)) * 16); vb1 += *(const LAS f32x4*)(pr + ((5 + 2 * hf) ^ (row & 7)) * 16); }
            if (rg * R + row < nrows) f.emit(rowbase + rg * R + row, ca + hf * 8, cb + hf * 8, va0, va1, vb0, vb1);
        }
    }
    }
    __syncthreads();
}
static_assert(8 * 128 * 128 <= SCR_BYTES, "skinny reduction buffer");

__device__ __forceinline__ int cond_of_row(int row) { return row < MPR ? (row >> 11) : (BP + row - MPR); }
#define RNCOL(lane_, k_) (8 * (lane_) + 512 * ((k_) >> 1) + 4 * ((k_) & 1))
struct RnParams { f32x4 gwp[4], a[4], sh[4]; };
template <int MODE>
__device__ __forceinline__ void rn_load_params(RnParams& P, const float* modr, const float* wpost, int goff, const float* wpre, int shoff, int scoff, int lane) {
#pragma unroll
    for (int j = 0; j < 4; ++j) { const int c = RNCOL(lane, j);
        if (MODE != 0) P.gwp[j] = *(const GAS f32x4*)(modr + goff + c) * *(const GAS f32x4*)(wpost + c);
        if (MODE != 2) { P.a[j] = *(const GAS f32x4*)(wpre + c) * (*(const GAS f32x4*)(modr + scoff + c) + 1.f); P.sh[j] = *(const GAS f32x4*)(modr + shoff + c); } }
}
template <int MODE>
__device__ __forceinline__ void rn_row(const RnParams& P, f32x4 (&x)[4], const v2u (&yw)[4], bf16* Xbrow, float* Xfrow, bf16* Hrow, int lane, bool wt = false) {
    if (MODE != 0) {
        f32x4 y[4]; float ss = 0.f;
#pragma unroll
        for (int j = 0; j < 4; ++j) { y[j] = (f32x4){bflo(yw[j].x), bfhi(yw[j].x), bflo(yw[j].y), bfhi(yw[j].y)}; ss += (y[j][0] * y[j][0] + y[j][1] * y[j][1]) + (y[j][2] * y[j][2] + y[j][3] * y[j][3]); }
        const float r1 = rsqrtf(wave_sum(ss) * (1.f / D) + EPS);
#pragma unroll
        for (int j = 0; j < 4; ++j) x[j] = x[j] + P.gwp[j] * (y[j] * r1);
    }
#pragma unroll
    for (int j = 0; j < 4; ++j) { if (MODE == 2) *(GAS f32x4*)(Xfrow + RNCOL(lane, j)) = x[j]; else *(GAS v2u*)(Xbrow + RNCOL(lane, j)) = pack4v(x[j]); }
    if (MODE != 2) {
        float s2 = 0.f;
#pragma unroll
        for (int j = 0; j < 4; ++j) s2 += (x[j][0] * x[j][0] + x[j][1] * x[j][1]) + (x[j][2] * x[j][2] + x[j][3] * x[j][3]);
        const float r2 = rsqrtf(wave_sum(s2) * (1.f / D) + EPS);
#pragma unroll
        for (int j = 0; j < 4; ++j) x[j] = (x[j] * r2) * P.a[j] + P.sh[j];
        if (wt) { st16_wt<WT_ROW>(Hrow, D * 2, 16 * lane, pack8v(x[0], x[1])); st16_wt<WT_ROW>(Hrow, D * 2, 1024 + 16 * lane, pack8v(x[2], x[3])); }
        else {
#pragma unroll
            for (int j = 0; j < 4; ++j) *(GAS v2u*)(Hrow + RNCOL(lane, j)) = pack4v(x[j]); }
    }
}
__device__ __forceinline__ f32x4 ld_x4(const bf16* p) { const v2u w = *(const GAS v2u*)p; return (f32x4){bflo(w.x), bfhi(w.x), bflo(w.y), bfhi(w.y)}; }
template <int MODE>
__device__ __forceinline__ void resnorm_phase(Frame& F, const float* xp, const float* xs, bf16* Xb, float* Xf, const bf16* Y, bf16* H, const float* MOD,
                                              const float* wpost, int goff, const float* wpre, int shoff, int scoff, bool ps = false, gu32* swait = nullptr, gu32* tmo = nullptr) {
    const int gw = F.vcu * NWAVES + F.wave, NGW = F.G * NWAVES, lane = F.lane;
    const int per = (MPR + NGW - 1) / NGW;
    RnParams P;
    const int srow_ = MPR + gw; const bool has_s = (per == 8) && srow_ < MT;
    f32x4 sx_[4]; v2u sy_[4];
#pragma unroll
    for (int j = 0; j < 4; ++j) { sx_[j] = (f32x4){0.f, 0.f, 0.f, 0.f}; sy_[j] = (v2u){0u, 0u}; }
    if (has_s && swait != nullptr) panel_wait(F, swait, 256u, tmo);
    if (has_s) {
#pragma unroll
        for (int j = 0; j < 4; ++j) { const int c_ = RNCOL(lane, j); sx_[j] = (MODE == 0) ? *(const GAS f32x4*)(xs + (size_t)(srow_ - MPR) * D + c_) : ld_x4(Xb + (size_t)srow_ * D + c_); if (MODE != 0) sy_[j] = *(const GAS v2u*)(Y + (size_t)srow_ * D + c_); } }
    if (per == 8) {
        const int r0 = ps ? panel_row0(F) : gw * 8;
        rn_load_params<MODE>(P, MOD + (size_t)(r0 >> 11) * NMODALL, wpost, goff, wpre, shoff, scoff, lane);
        f32x4 qx[3][4]; v2u qy[3][4];
#define RN_FETCH(s_, row_) do { _Pragma("unroll") for (int j_ = 0; j_ < 4; ++j_) { const size_t o_ = (size_t)(row_) * D + RNCOL(lane, j_); \
            qx[s_][j_] = (MODE == 0) ? *(const GAS f32x4*)(xp + o_) : ld_x4(Xb + o_); qy[s_][j_] = (v2u){0u, 0u}; if (MODE != 0) qy[s_][j_] = *(const GAS v2u*)(Y + o_); } } while (0)
        RN_FETCH(0, r0); RN_FETCH(1, r0 + 1); RN_FETCH(2, r0 + 2);
#pragma unroll
        for (int i = 0; i < 8; ++i) {
            f32x4 x[4]; v2u yw[4];
#pragma unroll
            for (int j = 0; j < 4; ++j) { x[j] = qx[i % 3][j]; yw[j] = qy[i % 3][j]; }
            if (i + 3 < 8) RN_FETCH(i % 3, r0 + i + 3);
            rn_row<MODE>(P, x, yw, Xb + (size_t)(r0 + i) * D, Xf + (size_t)(r0 + i) * D, H + (size_t)(r0 + i) * D, lane, ps);
        }
#undef RN_FETCH
    } else
    for (int r0 = gw * per; r0 < MPR; r0 += NGW * per) {
        const int r1 = (r0 + per < MPR) ? r0 + per : MPR;
        int cond = r0 >> 11;
        rn_load_params<MODE>(P, MOD + (size_t)cond * NMODALL, wpost, goff, wpre, shoff, scoff, lane);
        f32x4 xn[4]; v2u yn[4];
#pragma unroll
        for (int j = 0; j < 4; ++j) { const size_t o_ = (size_t)r0 * D + RNCOL(lane, j); xn[j] = (MODE == 0) ? *(const GAS f32x4*)(xp + o_) : ld_x4(Xb + o_); yn[j] = (v2u){0u, 0u}; if (MODE != 0) yn[j] = *(const GAS v2u*)(Y + o_); }
        for (int row = r0; row < r1; ++row) {
            f32x4 x[4]; v2u yw[4];
#pragma unroll
            for (int j = 0; j < 4; ++j) { x[j] = xn[j]; yw[j] = yn[j]; }
            if ((row >> 11) != cond) { cond = row >> 11; rn_load_params<MODE>(P, MOD + (size_t)cond * NMODALL, wpost, goff, wpre, shoff, scoff, lane); }
            if (row + 1 < r1) {
#pragma unroll
                for (int j = 0; j < 4; ++j) { const size_t o_ = (size_t)(row + 1) * D + RNCOL(lane, j); xn[j] = (MODE == 0) ? *(const GAS f32x4*)(xp + o_) : ld_x4(Xb + o_); if (MODE != 0) yn[j] = *(const GAS v2u*)(Y + o_); } }
            rn_row<MODE>(P, x, yw, Xb + (size_t)row * D, Xf + (size_t)row * D, H + (size_t)row * D, lane);
        }
    }
    if (has_s) {
        rn_load_params<MODE>(P, MOD + (size_t)cond_of_row(srow_) * NMODALL, wpost, goff, wpre, shoff, scoff, lane);
        rn_row<MODE>(P, sx_, sy_, Xb + (size_t)srow_ * D, Xf + (size_t)srow_ * D, H + (size_t)srow_ * D, lane, ps);
    } else if (per != 8)
    for (int row = MPR + gw; row < MT; row += NGW) {
        rn_load_params<MODE>(P, MOD + (size_t)cond_of_row(row) * NMODALL, wpost, goff, wpre, shoff, scoff, lane);
        f32x4 x[4]; v2u yw[4];
#pragma unroll
        for (int j = 0; j < 4; ++j) { const int c_ = RNCOL(lane, j); x[j] = (MODE == 0) ? *(const GAS f32x4*)(xs + (size_t)(row - MPR) * D + c_) : ld_x4(Xb + (size_t)row * D + c_); yw[j] = (v2u){0u, 0u}; if (MODE != 0) yw[j] = *(const GAS v2u*)(Y + (size_t)row * D + c_); }
        rn_row<MODE>(P, x, yw, Xb + (size_t)row * D, Xf + (size_t)row * D, H + (size_t)row * D, lane);
    }
}
template <int MIX>
__device__ __forceinline__ void gatenorm_phase(Frame& F, const bf16* RO, const bf16* GATE, bf16* GO, const float* nw, bool ps = false) {
    const int gw = F.vcu * NWAVES + F.wave, NGW = F.G * NWAVES, lane = F.lane;
    constexpr int W = (MIX == 2) ? 1024 : 2048, NJ = W / 512;
    const int per = (MPR + NGW - 1) / NGW;
    float wv[NJ][8];
#pragma unroll
    for (int j = 0; j < NJ; ++j)
#pragma unroll
        for (int e = 0; e < 8; ++e) { const int c = 8 * lane + 512 * j + e; wv[j][e] = (MIX == 1) ? nw[c] : ((MIX == 2) ? nw[c & 127] : 1.f); }
    const int srow_ = MPR + gw; const bool has_s = (per == 8) && srow_ < MT;
    v4u so_[NJ], sg_[NJ];
#pragma unroll
    for (int j = 0; j < NJ; ++j) { so_[j] = (v4u){0u, 0u, 0u, 0u}; sg_[j] = so_[j]; }
    if (has_s) {
#pragma unroll
        for (int j = 0; j < NJ; ++j) { so_[j] = *(const GAS v4u*)(RO + (size_t)srow_ * W + 8 * lane + 512 * j); sg_[j] = *(const GAS v4u*)(GATE + (size_t)srow_ * W + 8 * lane + 512 * j); } }
    if (per == 8) {
        const int r0 = ps ? panel_row0(F) : gw * 8;
        v4u qo[3][NJ], qg[3][NJ];
#define GN_FETCH(s_, row_) do { _Pragma("unroll") for (int j_ = 0; j_ < NJ; ++j_) { qo[s_][j_] = *(const GAS v4u*)(RO + (size_t)(row_) * W + 8 * lane + 512 * j_); qg[s_][j_] = *(const GAS v4u*)(GATE + (size_t)(row_) * W + 8 * lane + 512 * j_); } } while (0)
        GN_FETCH(0, r0); GN_FETCH(1, r0 + 1); GN_FETCH(2, r0 + 2);
#pragma unroll
        for (int i = 0; i < 8; ++i) {
            v4u oc[NJ], gc[NJ];
#pragma unroll
            for (int j = 0; j < NJ; ++j) { oc[j] = qo[i % 3][j]; gc[j] = qg[i % 3][j]; }
            if (i + 3 < 8) GN_FETCH(i % 3, r0 + i + 3);
            float u[NJ][8], r[NJ];
#pragma unroll
            for (int j = 0; j < NJ; ++j) {
                float o[8], g[8]; unpack8(oc[j], o); unpack8(gc[j], g);
                float ss = 0.f;
#pragma unroll
                for (int e = 0; e < 8; ++e) { u[j][e] = o[e] * g[e]; ss += (MIX == 1) ? u[j][e] * u[j][e] : o[e] * o[e]; }
                if (MIX == 2) r[j] = rsqrtf(grp16_sum(ss) * (1.f / 128.f) + EPS); else r[j] = rsqrtf(wave_sum(ss) * (1.f / 512.f) + EPS);
            }
#pragma unroll
            for (int j = 0; j < NJ; ++j) { float v[8];
#pragma unroll
                for (int e = 0; e < 8; ++e) v[e] = u[j][e] * r[j] * wv[j][e];
                if (ps) st16_wt<WT_ROW>(GO + (size_t)(r0 + i) * W, W * 2, (8 * lane + 512 * j) * 2, pack8(v)); else *(GAS v4u*)(GO + (size_t)(r0 + i) * W + 8 * lane + 512 * j) = pack8(v); }
        }
#undef GN_FETCH
        if (has_s) {
            float u[NJ][8], r[NJ];
#pragma unroll
            for (int j = 0; j < NJ; ++j) {
                float o[8], g[8]; unpack8(so_[j], o); unpack8(sg_[j], g);
                float ss = 0.f;
#pragma unroll
                for (int e = 0; e < 8; ++e) { u[j][e] = o[e] * g[e]; ss += (MIX == 1) ? u[j][e] * u[j][e] : o[e] * o[e]; }
                if (MIX == 2) r[j] = rsqrtf(grp16_sum(ss) * (1.f / 128.f) + EPS); else r[j] = rsqrtf(wave_sum(ss) * (1.f / 512.f) + EPS);
            }
#pragma unroll
            for (int j = 0; j < NJ; ++j) { float v[8];
#pragma unroll
                for (int e = 0; e < 8; ++e) v[e] = u[j][e] * r[j] * wv[j][e];
                if (ps) st16_wt<WT_ROW>(GO + (size_t)srow_ * W, W * 2, (8 * lane + 512 * j) * 2, pack8(v)); else *(GAS v4u*)(GO + (size_t)srow_ * W + 8 * lane + 512 * j) = pack8(v); }
        }
    }
#pragma unroll 1
    for (int seg = (per == 8) ? 2 : 0; seg < 2; ++seg) {
        const int r0 = seg == 0 ? gw * per : MPR + gw;
        const int r1 = seg == 0 ? ((r0 + per < MPR) ? r0 + per : MPR) : ((r0 < MT) ? r0 + 1 : r0);
        if (r0 >= r1) continue;
        v4u on[NJ], gn[NJ];
#pragma unroll
        for (int j = 0; j < NJ; ++j) { on[j] = *(const GAS v4u*)(RO + (size_t)r0 * W + 8 * lane + 512 * j); gn[j] = *(const GAS v4u*)(GATE + (size_t)r0 * W + 8 * lane + 512 * j); }
        for (int row = r0; row < r1; ++row) {
            v4u oc[NJ], gc[NJ];
#pragma unroll
            for (int j = 0; j < NJ; ++j) { oc[j] = on[j]; gc[j] = gn[j]; }
            if (row + 1 < r1) {
#pragma unroll
                for (int j = 0; j < NJ; ++j) { on[j] = *(const GAS v4u*)(RO + (size_t)(row + 1) * W + 8 * lane + 512 * j); gn[j] = *(const GAS v4u*)(GATE + (size_t)(row + 1) * W + 8 * lane + 512 * j); } }
            float u[NJ][8], r[NJ];
#pragma unroll
            for (int j = 0; j < NJ; ++j) {
                float o[8], g[8]; unpack8(oc[j], o); unpack8(gc[j], g);
                float ss = 0.f;
#pragma unroll
                for (int e = 0; e < 8; ++e) { u[j][e] = o[e] * g[e]; ss += (MIX == 1) ? u[j][e] * u[j][e] : o[e] * o[e]; }
                if (MIX == 2) r[j] = rsqrtf(grp16_sum(ss) * (1.f / 128.f) + EPS); else r[j] = rsqrtf(wave_sum(ss) * (1.f / 512.f) + EPS);
            }
#pragma unroll
            for (int j = 0; j < NJ; ++j) { float v[8];
#pragma unroll
                for (int e = 0; e < 8; ++e) v[e] = u[j][e] * r[j] * wv[j][e];
                *(GAS v4u*)(GO + (size_t)row * W + 8 * lane + 512 * j) = pack8(v); }
        }
    }
}

template <int OFF> __device__ __forceinline__ bf16x8 tr_frag(unsigned addr) {
    s16x4 lo, hi;
    asm volatile("ds_read_b64_tr_b16 %0, %2\n\tds_read_b64_tr_b16 %1, %2 offset:%3\n\ts_waitcnt lgkmcnt(0)" : "=&v"(lo), "=&v"(hi) : "v"(addr), "i"(OFF) : "memory");
    return __builtin_shufflevector(lo, hi, 0, 1, 2, 3, 4, 5, 6, 7);
}
template <int OFF> __device__ __forceinline__ void tr_frag2(unsigned a0, unsigned a1, bf16x8& f0, bf16x8& f1) {
    s16x4 l0, h0, l1, h1;
    asm volatile("ds_read_b64_tr_b16 %0, %4\n\tds_read_b64_tr_b16 %1, %4 offset:%6\n\tds_read_b64_tr_b16 %2, %5\n\tds_read_b64_tr_b16 %3, %5 offset:%6\n\ts_waitcnt lgkmcnt(0)"
                 : "=&v"(l0), "=&v"(h0), "=&v"(l1), "=&v"(h1) : "v"(a0), "v"(a1), "i"(OFF) : "memory");
    f0 = __builtin_shufflevector(l0, h0, 0, 1, 2, 3, 4, 5, 6, 7); f1 = __builtin_shufflevector(l1, h1, 0, 1, 2, 3, 4, 5, 6, 7);
}

#define LDS_BARRIER() do { asm volatile("s_waitcnt lgkmcnt(0)" ::: "memory"); __builtin_amdgcn_s_barrier(); asm volatile("" ::: "memory"); } while (0)
#define TRRD(dst, addr, off) asm volatile("ds_read_b64_tr_b16 %0, %1 offset:%2" : "=&v"(dst) : "v"(addr), "i"(off) : "memory")
#define TR_WAIT() do { asm volatile("s_waitcnt lgkmcnt(0)" ::: "memory"); __builtin_amdgcn_sched_barrier(0); } while (0)
#define TR_JOIN(lo, hi) __builtin_shufflevector(lo, hi, 0, 1, 2, 3, 4, 5, 6, 7)
template <class Cf>
__device__ __forceinline__ void rec_step_a(LAS unsigned char* lds, const int w, const int lane, f32x4 (&S)[Cf::KPW][Cf::VS / 16], const LAS float* cum, f32x4 (&O)[(Cf::VS / 16 * Cf::C / 16 + 7) / 8]) {
    constexpr int C = Cf::C, KD = Cf::KD, VS = Cf::VS, NIT = C / 16, NJT = C / 16, NVT = VS / 16, KSK = KD / 32, KSC = C / 32;
    constexpr int RSK = Cf::RSK, RSV = Cf::RSV, RSP = Cf::RSP;
    constexpr bool CH = Cf::CH;
    const int fr = lane & 15, fq = lane >> 4, q4 = fr >> 2, p4 = fr & 3;
    const unsigned lbase = (unsigned)(size_t)lds;
    constexpr int NP = NIT * NJT, PPW = (NP + 7) / 8, NO = NVT * NIT, OPW = (NO + 7) / 8;
    static_assert((NIT == 4 && NVT == 4) || (NP <= 8 && NO <= 8), "tile deal");
    constexpr bool SHQ = (NIT == 4) && !CH;
    const int it = (NIT == 4) ? (w & 3) : (w / NJT);
    if constexpr (SHQ) {
        f32x4 p[2] = {(f32x4){0.f, 0.f, 0.f, 0.f}, (f32x4){0.f, 0.f, 0.f, 0.f}};
        f32x4 o2[2] = {(f32x4){0.f, 0.f, 0.f, 0.f}, (f32x4){0.f, 0.f, 0.f, 0.f}};
        const int j0 = w >> 2;
#pragma unroll 4
        for (int ks = 0; ks < KSK; ++ks) {
            const bf16x8 qf = *(const LAS bf16x8*)(lds + Cf::QA + (16 * it + fr) * RSK + (32 * ks + 8 * fq) * 2);
#pragma unroll
            for (int tt = 0; tt < 2; ++tt) { const int jt = j0 + 2 * tt;
                if (jt <= it) { const bf16x8 a = *(const LAS bf16x8*)(lds + Cf::KA + (16 * jt + fr) * RSK + (32 * ks + 8 * fq) * 2); p[tt] = MFMA16(a, qf, p[tt]); }
                const bf16x8 s = *(const LAS bf16x8*)(lds + Cf::ST + (16 * jt + fr) * RSK + (32 * ks + 8 * fq) * 2); o2[tt] = MFMA16(s, qf, o2[tt]); }
        }
        const int i = 16 * it + fr; const float ci = cum[i], ei = __expf(ci);
#pragma unroll
        for (int tt = 0; tt < 2; ++tt) { const int jt = j0 + 2 * tt;
#pragma unroll
            for (int r = 0; r < 4; ++r) { const int j = 16 * jt + 4 * fq + r; const float e = __expf(fminf(ci - cum[j], 0.f)); p[tt][r] = (j <= i) ? p[tt][r] * e : 0.f; }
            *(LAS v2u*)(lds + Cf::PM + (16 * it + fr) * RSP + (16 * jt + 4 * fq) * 2) = pack4v(p[tt]);
            O[tt] = o2[tt] * ei; }
    } else {
#pragma unroll
        for (int tt = 0; tt < PPW; ++tt) { const int t = w + 8 * tt;
            if (t < NP) { const int it1 = t / NJT, jt = t % NJT;
                f32x4 p = (f32x4){0.f, 0.f, 0.f, 0.f};
                if (jt <= it1) {
#pragma unroll
                    for (int ks = 0; ks < KSK; ++ks) {
                        const bf16x8 a = *(const LAS bf16x8*)(lds + Cf::KA + (16 * jt + fr) * RSK + (32 * ks + 8 * fq) * 2);
                        const bf16x8 b = *(const LAS bf16x8*)(lds + Cf::QA + (16 * it1 + fr) * RSK + (32 * ks + 8 * fq) * 2);
                        p = MFMA16(a, b, p); }
                    const int i = 16 * it1 + fr;
                    if (!CH) { const float ci = cum[i];
#pragma unroll
                        for (int r = 0; r < 4; ++r) { const int j = 16 * jt + 4 * fq + r; const float e = __expf(fminf(ci - cum[j], 0.f)); p[r] = (j <= i) ? p[r] * e : 0.f; } }
                    else {
#pragma unroll
                        for (int r = 0; r < 4; ++r) { const int j = 16 * jt + 4 * fq + r; p[r] = (j <= i) ? p[r] : 0.f; } }
                }
                *(LAS v2u*)(lds + Cf::PM + (16 * it1 + fr) * RSP + (16 * jt + 4 * fq) * 2) = pack4v(p);
            } }
#pragma unroll
        for (int tt = 0; tt < OPW; ++tt) { const int t = w + 8 * tt; O[tt] = (f32x4){0.f, 0.f, 0.f, 0.f};
            if (t < NO) { const int vt = t / NIT, it3 = t % NIT; f32x4 o = (f32x4){0.f, 0.f, 0.f, 0.f};
#pragma unroll
                for (int ks = 0; ks < KSK; ++ks) {
                    const bf16x8 a = *(const LAS bf16x8*)(lds + Cf::ST + (16 * vt + fr) * RSK + (32 * ks + 8 * fq) * 2);
                    const bf16x8 b = *(const LAS bf16x8*)(lds + Cf::QB + (16 * it3 + fr) * RSK + (32 * ks + 8 * fq) * 2);
                    o = MFMA16(a, b, o); }
                if (!CH) o = o * __expf(cum[16 * it3 + fr]);
                O[tt] = o; } }
    }
#pragma unroll
    for (int ki = 0; ki < Cf::KPW; ++ki) { const int kt = w + 8 * ki;
        if (!CH) { const float d = __expf(cum[C - 1]);
#pragma unroll
            for (int vt = 0; vt < NVT; ++vt) S[ki][vt] = S[ki][vt] * d; }
        else { const LAS float* ds = (const LAS float*)(lds + Cf::DS) + 16 * kt + 4 * fq; const f32x4 d = (f32x4){ds[0], ds[1], ds[2], ds[3]};
#pragma unroll
            for (int vt = 0; vt < NVT; ++vt) S[ki][vt] = S[ki][vt] * d; } }
#pragma unroll
    for (int ks = 0; ks < KSC; ++ks) {
        s16x4 vl[NVT], vh[NVT], kl[Cf::KPW], kh[Cf::KPW];
#pragma unroll
        for (int vt = 0; vt < NVT; ++vt) { const unsigned ad = lbase + Cf::VB + (32 * ks + 8 * fq + q4) * RSV + (16 * vt + 4 * p4) * 2; TRRD(vl[vt], ad, 0); TRRD(vh[vt], ad, 4 * RSV); }
#pragma unroll
        for (int ki = 0; ki < Cf::KPW; ++ki) { const unsigned ad = lbase + Cf::KB + (32 * ks + 8 * fq + q4) * RSK + (16 * (w + 8 * ki) + 4 * p4) * 2; TRRD(kl[ki], ad, 0); TRRD(kh[ki], ad, 4 * RSK); }
        TR_WAIT();
#pragma unroll
        for (int ki = 0; ki < Cf::KPW; ++ki) { const bf16x8 a = TR_JOIN(kl[ki], kh[ki]);
#pragma unroll
            for (int vt = 0; vt < NVT; ++vt) S[ki][vt] = MFMA16(a, TR_JOIN(vl[vt], vh[vt]), S[ki][vt]); }
    }
}
template <class Cf, class OutFn>
__device__ __forceinline__ void rec_step_b(LAS unsigned char* lds, const int w, const int lane, const f32x4 (&S)[Cf::KPW][Cf::VS / 16], f32x4 (&O)[(Cf::VS / 16 * Cf::C / 16 + 7) / 8], const OutFn& out, const int tok0) {
    constexpr int C = Cf::C, VS = Cf::VS, NIT = C / 16, NVT = VS / 16, KSC = C / 32;
    constexpr int RSK = Cf::RSK, RSV = Cf::RSV, RSP = Cf::RSP;
    constexpr int NO = NVT * NIT, OPW = (NO + 7) / 8;
    const int fr = lane & 15, fq = lane >> 4, q4 = fr >> 2, p4 = fr & 3;
    const unsigned lbase = (unsigned)(size_t)lds;
    const int it = (NIT == 4) ? (w & 3) : 0;
    if constexpr (NIT == 4) {
        const int v0 = w >> 2;
        s16x4 al[KSC][2], ah[KSC][2]; bf16x8 pb[KSC];
#pragma unroll
        for (int ks = 0; ks < KSC; ++ks) {
#pragma unroll
            for (int tt = 0; tt < 2; ++tt) { const unsigned ad = lbase + Cf::V + (32 * ks + 8 * fq + q4) * RSV + (16 * (v0 + 2 * tt) + 4 * p4) * 2; TRRD(al[ks][tt], ad, 0); TRRD(ah[ks][tt], ad, 4 * RSV); } }
#pragma unroll
        for (int ks = 0; ks < KSC; ++ks) pb[ks] = *(const LAS bf16x8*)(lds + Cf::PM + (16 * it + fr) * RSP + (32 * ks + 8 * fq) * 2);
        TR_WAIT();
#pragma unroll
        for (int ks = 0; ks < KSC; ++ks) { O[0] = MFMA16(TR_JOIN(al[ks][0], ah[ks][0]), pb[ks], O[0]); O[1] = MFMA16(TR_JOIN(al[ks][1], ah[ks][1]), pb[ks], O[1]); }
        out(tok0 + 16 * it + fr, 16 * it + fr, 16 * v0 + 4 * fq, O[0]);
        out(tok0 + 16 * it + fr, 16 * it + fr, 16 * (v0 + 2) + 4 * fq, O[1]);
    } else {
#pragma unroll
        for (int tt = 0; tt < OPW; ++tt) { const int t = w + 8 * tt;
            if (t < NO) { const int vt = t / NIT, it2 = t % NIT; f32x4 o = O[tt];
#pragma unroll
                for (int ks = 0; ks < KSC; ++ks) {
                    const bf16x8 a = tr_frag<4 * RSV>(lbase + Cf::V + (32 * ks + 8 * fq + q4) * RSV + (16 * vt + 4 * p4) * 2);
                    const bf16x8 b = *(const LAS bf16x8*)(lds + Cf::PM + (16 * it2 + fr) * RSP + (32 * ks + 8 * fq) * 2);
                    o = MFMA16(a, b, o); }
                out(tok0 + 16 * it2 + fr, 16 * it2 + fr, 16 * vt + 4 * fq, o); } }
    }
#pragma unroll
    for (int ki = 0; ki < Cf::KPW; ++ki) { const int kt = w + 8 * ki;
#pragma unroll
        for (int vt = 0; vt < NVT; ++vt) *(LAS v2u*)(lds + Cf::ST + (16 * vt + fr) * RSK + (16 * kt + 4 * fq) * 2) = pack4v(S[ki][vt]); }
}
template <class Cf, class OutFn>
__device__ __forceinline__ void rec_step(LAS unsigned char* lds, const int w, const int lane, f32x4 (&S)[Cf::KPW][Cf::VS / 16], const LAS float* cum, const OutFn& out, const int tok0) {
    f32x4 O[(Cf::VS / 16 * Cf::C / 16 + 7) / 8];
    rec_step_a<Cf>(lds, w, lane, S, cum, O);
    LDS_BARRIER();
    rec_step_b<Cf>(lds, w, lane, S, O, out, tok0);
    LDS_BARRIER();
}
template <class Cf> __device__ __forceinline__ void rec_zero_state(Frame& F, f32x4 (&S)[Cf::KPW][Cf::VS / 16]) {
#pragma unroll
    for (int ki = 0; ki < Cf::KPW; ++ki)
#pragma unroll
        for (int vt = 0; vt < Cf::VS / 16; ++vt) S[ki][vt] = (f32x4){0.f, 0.f, 0.f, 0.f};
    for (int o = F.tid * 16; o < Cf::VS * Cf::RSK; o += 512 * 16) *(LAS v4u*)(F.lds + Cf::ST + o) = (v4u){0u, 0u, 0u, 0u};
}
template <class Cf> __device__ __forceinline__ void rec_store_state(Frame& F, const f32x4 (&S)[Cf::KPW][Cf::VS / 16], float* dst, int ldv) {
    const int fr = F.lane & 15, fq = F.lane >> 4;
#pragma unroll
    for (int ki = 0; ki < Cf::KPW; ++ki) { const int kt = F.wave + 8 * ki;
#pragma unroll
        for (int vt = 0; vt < Cf::VS / 16; ++vt)
#pragma unroll
            for (int r = 0; r < 4; ++r) dst[(size_t)(16 * kt + 4 * fq + r) * ldv + 16 * vt + fr] = S[ki][vt][r]; }
}

struct CfRet { static constexpr int C = 64, KD = 256, VS = 64, KPW = 2, RSK = 528, RSV = 144, RSP = 144; static constexpr bool CH = false;
    static constexpr int QA = 0, KA = 33792, QB = QA, KB = KA, V = 67584, VB = 76800, PM = 86016, ST = 95232, CUM = 129024, DS = 0, END = 129280; };
static_assert(CfRet::END <= SCR_BYTES, "ret lds");
struct RetOut { bf16* dst;
    __device__ __forceinline__ void operator()(int tok, int i, int vv0, const f32x4 o) const { *(GAS v2u*)(dst + (size_t)tok * 2048 + vv0) = pack4v(o); } };
template <bool fuse>
__device__ __forceinline__ void ret_prompt_item(Frame& F, int item, const bf16* Q, const bf16* K, const bf16* V, bf16* RO, float* st_out,
                                                const float* sst_in, float* sst_out) {
    const int b = item >> 5, h = (item >> 3) & 3, vs = item & 7, tid = F.tid;
    const float lg = logf(1.f - exp2f(-5.f - (float)h));
    LAS float* cum = (LAS float*)(F.lds + CfRet::CUM);
    LAS float* sqk = (LAS float*)(F.lds + CfRet::END);
    LAS float* sred = sqk + 1024;
    __syncthreads();
    if (tid < 64) cum[tid] = (float)(tid + 1) * lg;
    f32x4 S[CfRet::KPW][4];
    rec_zero_state<CfRet>(F, S);
    const bf16* qg = Q + (size_t)(b * SEQ) * 1024 + h * 256; const bf16* kg = K + (size_t)(b * SEQ) * 1024 + h * 256; const bf16* vg = V + (size_t)(b * SEQ) * 2048 + h * 512 + vs * 64;
    const RetOut out{RO + (size_t)(b * SEQ) * 2048 + h * 512 + vs * 64};
    v4u qr[4], kr[4], vr;
#pragma unroll
    for (int i = 0; i < 4; ++i) { const int pc = tid + 512 * i, row = pc >> 5, c16 = pc & 31; qr[i] = *(const GAS v4u*)(qg + (size_t)row * 1024 + c16 * 8); kr[i] = *(const GAS v4u*)(kg + (size_t)row * 1024 + c16 * 8); }
    vr = *(const GAS v4u*)(vg + (size_t)(tid >> 3) * 2048 + (tid & 7) * 8);
    const float vsc = __expf((float)(63 - (tid >> 3)) * lg);
    const int sc4 = (tid & 127) * 4, srq = tid >> 7;
    f32x4 sv = (f32x4){0.f, 0.f, 0.f, 0.f}, so = sv, sst[4]; float sg = 0.f; const float* sin = sst_in; float* sout = sst_out; size_t srow = 0; int shh = 0;
#define RET_S_SETUP(si) do { const int sit_ = F.vcu + 256 * (si), bs_ = sit_ >> 2; shh = sit_ & 3; srow = MPR + bs_; \
        sqk[(si) * 512 + tid] = tid < 256 ? bf2f(Q[srow * 1024 + shh * 256 + tid]) : bf2f(K[srow * 1024 + shh * 256 + (tid - 256)]); \
        const v2u vw_ = *(const GAS v2u*)(V + srow * 2048 + shh * 512 + sc4); sv = (f32x4){bflo(vw_.x), bfhi(vw_.x), bflo(vw_.y), bfhi(vw_.y)}; \
        so = (f32x4){0.f, 0.f, 0.f, 0.f}; sg = 1.f - exp2f(-5.f - (float)shh); \
        sin = sst_in + ((size_t)(bs_ * 4 + shh) * 256) * 512 + sc4; sout = sst_out + ((size_t)(bs_ * 4 + shh) * 256) * 512 + sc4; } while (0)
#define RET_S_LOAD(st_) do { _Pragma("unroll") for (int k_ = 0; k_ < 4; ++k_) sst[k_] = __builtin_nontemporal_load((const GAS f32x4*)(sin + (size_t)(16 * (st_) + srq + 4 * k_) * 512)); } while (0)
    if (fuse) { RET_S_SETUP(0); RET_S_LOAD(0); __syncthreads(); }
    for (int c = 0; c < SEQ / 64; ++c) {
        const int sidx = c >> 4, sstep = c & 15;
        if (fuse) {
#pragma unroll
            for (int k = 0; k < 4; ++k) { const int rr = 16 * sstep + srq + 4 * k; const float kf = sqk[sidx * 512 + 256 + rr], qf = sqk[sidx * 512 + rr];
                const f32x4 s = sst[k] * sg + sv * kf;
                __builtin_nontemporal_store(s, (GAS f32x4*)(sout + (size_t)rr * 512)); so = so + s * qf; }
            if (sstep == 0 && sidx == 1) {
                const float acc = (sred[tid] + sred[512 + tid]) + (sred[1024 + tid] + sred[1536 + tid]);
                const int sit0 = F.vcu, bs0 = sit0 >> 2, h0 = sit0 & 3;
                RO[(size_t)(MPR + bs0) * 2048 + h0 * 512 + tid] = (bf16)(cvt_pk_bf16(acc, acc) & 0xffffu); }
            if (sstep == 15) { *(LAS f32x4*)(sred + srq * 512 + sc4) = so; if (sidx == 0) RET_S_SETUP(1); }
            if (c + 1 < SEQ / 64) RET_S_LOAD((c + 1) & 15);
        }
#pragma unroll
        for (int i = 0; i < 4; ++i) { const int pc = tid + 512 * i, row = pc >> 5, c16 = pc & 31;
            *(LAS v4u*)(F.lds + CfRet::QA + row * 528 + c16 * 16) = qr[i]; *(LAS v4u*)(F.lds + CfRet::KA + row * 528 + c16 * 16) = kr[i]; }
        { const int row = tid >> 3, c16 = tid & 7; *(LAS v4u*)(F.lds + CfRet::V + row * 144 + c16 * 16) = vr;
          float f[8]; unpack8(vr, f);
#pragma unroll
          for (int e = 0; e < 8; ++e) f[e] *= vsc;
          *(LAS v4u*)(F.lds + CfRet::VB + row * 144 + c16 * 16) = pack8(f); }
        if (c + 1 < SEQ / 64) { const size_t r0 = (size_t)(c + 1) * 64;
#pragma unroll
            for (int i = 0; i < 4; ++i) { const int pc = tid + 512 * i, row = pc >> 5, c16 = pc & 31; qr[i] = *(const GAS v4u*)(qg + (r0 + row) * 1024 + c16 * 8); kr[i] = *(const GAS v4u*)(kg + (r0 + row) * 1024 + c16 * 8); }
            vr = *(const GAS v4u*)(vg + (r0 + (tid >> 3)) * 2048 + (tid & 7) * 8); }
        LDS_BARRIER();
        rec_step<CfRet>(F.lds, F.wave, F.lane, S, cum, out, c * 64);
    }
#undef RET_S_SETUP
#undef RET_S_LOAD
    if (fuse) { __syncthreads();
        const float acc = (sred[tid] + sred[512 + tid]) + (sred[1024 + tid] + sred[1536 + tid]);
        RO[srow * 2048 + shh * 512 + tid] = (bf16)(cvt_pk_bf16(acc, acc) & 0xffffu); }
    rec_store_state<CfRet>(F, S, st_out + ((size_t)(b * 4 + h) * 256) * 512 + vs * 64, 512);
}
static_assert(CfRet::END + 4096 + 8192 <= SCR_BYTES, "ret lds + sample stream");
__device__ __forceinline__ void ret_sample_items(Frame& F, const bf16* Q, const bf16* K, const bf16* V, bf16* RO, const float* st_in, float* st_out) {
    LAS float* qk = (LAS float*)F.lds; LAS float* red = qk + 512;
    const int tid = F.tid, lane = F.lane, w = F.wave;
    for (int item = F.vcu; item < MS * 4; item += F.G) {
        const int bs = item >> 2, h = item & 3; const size_t row = MPR + bs;
        __syncthreads();
        qk[tid] = tid < 256 ? bf2f(Q[row * 1024 + h * 256 + tid]) : bf2f(K[row * 1024 + h * 256 + (tid - 256)]);
        float v[8]; unpack8(*(const GAS v4u*)(V + row * 2048 + h * 512 + 8 * lane), v);
        __syncthreads();
        const float g = 1.f - exp2f(-5.f - (float)h);
        const float* sin = st_in + ((size_t)(bs * 4 + h) * 256) * 512 + 8 * lane; float* sout = st_out + ((size_t)(bs * 4 + h) * 256) * 512 + 8 * lane;
        float o[8];
#pragma unroll
        for (int e = 0; e < 8; ++e) o[e] = 0.f;
#pragma unroll 8
        for (int r = 0; r < 32; ++r) { const int kk = 32 * w + r;
            f32x4 s0 = __builtin_nontemporal_load((const GAS f32x4*)(sin + (size_t)kk * 512)), s1 = __builtin_nontemporal_load((const GAS f32x4*)(sin + (size_t)kk * 512 + 4));
            const float kf = qk[256 + kk], qf = qk[kk];
#pragma unroll
            for (int e = 0; e < 4; ++e) { s0[e] = g * s0[e] + kf * v[e]; s1[e] = g * s1[e] + kf * v[4 + e]; o[e] += s0[e] * qf; o[4 + e] += s1[e] * qf; }
            __builtin_nontemporal_store(s0, (GAS f32x4*)(sout + (size_t)kk * 512)); __builtin_nontemporal_store(s1, (GAS f32x4*)(sout + (size_t)kk * 512 + 4)); }
#pragma unroll
        for (int e = 0; e < 8; ++e) red[w * 512 + 8 * lane + e] = o[e];
        __syncthreads();
        float acc = 0.f;
#pragma unroll
        for (int ww = 0; ww < 8; ++ww) acc += red[ww * 512 + tid];
        RO[row * 2048 + h * 512 + tid] = (bf16)(cvt_pk_bf16(acc, acc) & 0xffffu);
    }
    __syncthreads();
}

struct CfSsd { static constexpr int C = 64, KD = 128, VS = 64, KPW = 1, RSK = 272, RSV = 144, RSP = 144; static constexpr bool CH = false;
    static constexpr int QA = 0, KA = 17408, QB = QA, KB = KA, V = 34816, VB = 44032, PM = 53248, ST = 62464, XS = 79872, CUM = 89088, DTV = 89600, RAW = 90112, RSR = 656, DS = 0, END = RAW + 67 * 656; };
static_assert(CfSsd::END + 8 * 320 * 4 <= SCR_BYTES, "ssd lds + sample scratch");
struct SsdOut { bf16* dst; const LAS unsigned char* xs; float Dh;
    __device__ __forceinline__ void operator()(int tok, int i, int vv0, const f32x4 o) const {
        const v2u xw = *(const LAS v2u*)(xs + i * 144 + vv0 * 2);
        const f32x4 x = (f32x4){bflo(xw.x), bfhi(xw.x), bflo(xw.y), bfhi(xw.y)};
        *(GAS v2u*)(dst + (size_t)tok * 2048 + vv0) = pack4v(o + x * Dh); } };
__device__ __forceinline__ int ssd_gcol(int lch, int head, int grp) { return lch < 64 ? head * 64 + lch : (lch < 192 ? 2048 + grp * 128 + (lch - 64) : 2560 + grp * 128 + (lch - 192)); }
template <bool fuse>
__device__ __forceinline__ void ssd_prompt_item(Frame& F, int item, const bf16* XBC, const float* DT, bf16* T, float* st_out,
                                                const float* conv_w, const float* conv_b, const float* dt_bias, const float* a_log, const float* d_skip,
                                                const float* sst_in, float* sst_out, const float* conv_st) {
    const int b = item >> 5, head = item & 31, grp = head >> 3, tid = F.tid, lane = F.lane, w = F.wave;
    const float a = -expf(a_log[head]), dtb = dt_bias[head], Dh = d_skip[head];
    LAS float* cumb = (LAS float*)(F.lds + CfSsd::CUM); LAS float* dtvb = (LAS float*)(F.lds + CfSsd::DTV);
    __syncthreads();
    f32x4 S[CfSsd::KPW][4];
    rec_zero_state<CfSsd>(F, S);
    const bf16* xg = XBC + (size_t)(b * SEQ) * 3072; const float* dtg = DT + (size_t)(b * SEQ) * 32 + head;
    const SsdOut out{T + (size_t)(b * SEQ) * 2048 + head * 64, F.lds + CfSsd::XS, Dh};
    const bool conv_thr = tid < 440; const int cg = tid % 40, tb = tid / 40, gcolc = ssd_gcol(8 * cg, head, grp);
    float wr[4][8], br[8];
#pragma unroll
    for (int e = 0; e < 8; ++e) { br[e] = conv_b[gcolc + e];
#pragma unroll
        for (int tap = 0; tap < 4; ++tap) wr[tap][e] = conv_w[tap * 3072 + gcolc + e]; }
    const bool stg_thr = tid < 480; const int r0 = tid / 40;
    v4u raw[6];
#define SSD_LOAD_RAW(cc) do { const bf16* rp_ = xg + ((long)((cc) * 64 - 3 + r0) * 3072 + gcolc); _Pragma("unroll") for (int k_ = 0; k_ < 6; ++k_) { const int row_ = r0 + 12 * k_, tk_ = (cc) * 64 - 3 + row_; \
        raw[k_] = (v4u){0u, 0u, 0u, 0u}; if (stg_thr && row_ < 67 && tk_ >= 0) raw[k_] = *(const GAS v4u*)(rp_ + (long)k_ * 12 * 3072); } } while (0)
#define SSD_CUM(cc) do { if (w == 0) { const float dtv_ = softplusf_(dtn + dtb); float v_ = dtv_ * a; \
        _Pragma("unroll") for (int o_ = 1; o_ < 64; o_ <<= 1) { const float u_ = __shfl_up(v_, o_); if (lane >= o_) v_ += u_; } cumb[((cc) & 1) * 64 + lane] = v_; dtvb[((cc) & 1) * 64 + lane] = dtv_; } } while (0)
    float dtn = 0.f;
    if (w == 0) dtn = dtg[(size_t)lane * 32];
    SSD_CUM(0);
    if (w == 0) dtn = dtg[(size_t)(64 + lane) * 32];
    SSD_LOAD_RAW(0);
    LAS float* sscr = (LAS float*)(F.lds + CfSsd::END) + w * 320;
    const int sgw = F.vcu * NWAVES + w, sv4 = (lane & 15) * 4, skq = lane >> 4;
    f32x4 sxs = (f32x4){0.f, 0.f, 0.f, 0.f}, sxd = sxs, sy = sxs, sst[2]; float sdA = 0.f, sDh = 0.f; const float* sin = sst_in; float* sout = sst_out; size_t srow = 0; int shead = 0;
#define SSD_S_SETUP(si) do { const int sit_ = sgw + 2048 * (si), bs_ = sit_ >> 5; shead = sit_ & 31; const int sgrp_ = shead >> 3; srow = MPR + bs_; \
        _Pragma("unroll 1") for (int r_ = 0; r_ < 5; ++r_) { const int lch_ = lane + 64 * r_, gch_ = ssd_gcol(lch_, shead, sgrp_); float acc_ = conv_b[gch_]; \
            _Pragma("unroll") for (int tap_ = 0; tap_ < 3; ++tap_) acc_ += conv_st[((size_t)bs_ * 3 + tap_) * 3072 + gch_] * conv_w[tap_ * 3072 + gch_]; \
            acc_ += bf2f(XBC[srow * 3072 + gch_]) * conv_w[3 * 3072 + gch_]; sscr[lch_] = siluf_(acc_); } \
        LDS_WAIT(); \
        const float dtv_ = softplusf_(DT[srow * 32 + shead] + dt_bias[shead]); sdA = __expf(dtv_ * -expf(a_log[shead])); sDh = d_skip[shead]; \
        sxs = (f32x4){sscr[sv4], sscr[sv4 + 1], sscr[sv4 + 2], sscr[sv4 + 3]}; sxd = sxs * dtv_; sy = (f32x4){0.f, 0.f, 0.f, 0.f}; \
        sin = sst_in + ((size_t)(bs_ * 32 + shead) * 128) * 64 + sv4; sout = sst_out + ((size_t)(bs_ * 32 + shead) * 128) * 64 + sv4; } while (0)
#define SSD_S_LOAD(st_) do { _Pragma("unroll") for (int k_ = 0; k_ < 2; ++k_) sst[k_] = __builtin_nontemporal_load((const GAS f32x4*)(sin + (size_t)(8 * (st_) + 4 * k_ + skq) * 64)); } while (0)
    if (fuse) { SSD_S_SETUP(0); SSD_S_LOAD(0); }
    for (int c = 0; c < SEQ / 64; ++c) {
        if (fuse) { const int sidx = c >> 4, sstep = c & 15;
#pragma unroll
            for (int k = 0; k < 2; ++k) { const int kk = 8 * sstep + 4 * k + skq;
                const f32x4 s = sst[k] * sdA + sxd * sscr[64 + kk];
                __builtin_nontemporal_store(s, (GAS f32x4*)(sout + (size_t)kk * 64)); sy = sy + s * sscr[192 + kk]; }
            if (sstep == 15) {
#pragma unroll
                for (int e = 0; e < 4; ++e) { sy[e] += __shfl_xor(sy[e], 16); sy[e] += __shfl_xor(sy[e], 32); }
                if (lane < 16) *(GAS v2u*)(T + srow * 2048 + shead * 64 + sv4) = pack4v(sy + sxs * sDh);
                LDS_WAIT();
                if (sidx == 0) SSD_S_SETUP(1); }
            if (c + 1 < SEQ / 64) SSD_S_LOAD((c + 1) & 15);
        }
#pragma unroll
        for (int k = 0; k < 6; ++k) { const int row = r0 + 12 * k; if (stg_thr && row < 67) *(LAS v4u*)(F.lds + CfSsd::RAW + row * CfSsd::RSR + cg * 16) = raw[k]; }
        if (c + 1 < SEQ / 64) { SSD_CUM(c + 1); if (w == 0 && c + 2 < SEQ / 64) dtn = dtg[(size_t)((c + 2) * 64 + lane) * 32]; SSD_LOAD_RAW(c + 1); }
        LDS_BARRIER();
        const LAS float* cum = cumb + (c & 1) * 64; const LAS float* dtv = dtvb + (c & 1) * 64; const float tot = cum[63];
        if (conv_thr) {
            float win[3][8];
#pragma unroll
            for (int r = 0; r < 3; ++r) unpack8(*(const LAS v4u*)(F.lds + CfSsd::RAW + (6 * tb + r) * CfSsd::RSR + cg * 16), win[r]);
#pragma unroll
            for (int k = 0; k < 6; ++k) { const int i = 6 * tb + k;
                if (i < 64) {
                    float x3[8], acc[8]; unpack8(*(const LAS v4u*)(F.lds + CfSsd::RAW + (i + 3) * CfSsd::RSR + cg * 16), x3);
#pragma unroll
                    for (int e = 0; e < 8; ++e) { acc[e] = br[e] + win[0][e] * wr[0][e] + win[1][e] * wr[1][e] + win[2][e] * wr[2][e] + x3[e] * wr[3][e]; acc[e] = siluf_(acc[e]);
                        win[0][e] = win[1][e]; win[1][e] = win[2][e]; win[2][e] = x3[e]; }
                    if (cg < 8) { const float dv = dtv[i], wj = dv * __expf(tot - cum[i]);
                        *(LAS v4u*)(F.lds + CfSsd::XS + i * 144 + cg * 16) = pack8(acc);
                        float f[8];
#pragma unroll
                        for (int e = 0; e < 8; ++e) f[e] = acc[e] * dv;
                        *(LAS v4u*)(F.lds + CfSsd::V + i * 144 + cg * 16) = pack8(f);
#pragma unroll
                        for (int e = 0; e < 8; ++e) f[e] = acc[e] * wj;
                        *(LAS v4u*)(F.lds + CfSsd::VB + i * 144 + cg * 16) = pack8(f); }
                    else if (cg < 24) *(LAS v4u*)(F.lds + CfSsd::KA + i * 272 + (cg - 8) * 16) = pack8(acc);
                    else *(LAS v4u*)(F.lds + CfSsd::QA + i * 272 + (cg - 24) * 16) = pack8(acc);
                } }
        }
        LDS_BARRIER();
        rec_step<CfSsd>(F.lds, w, lane, S, cum, out, c * 64);
    }
#undef SSD_CUM
#undef SSD_LOAD_RAW
#undef SSD_S_SETUP
#undef SSD_S_LOAD
    rec_store_state<CfSsd>(F, S, st_out + ((size_t)(b * 32 + head) * 128) * 64, 64);
}
__device__ __forceinline__ void ssd_sample_items(Frame& F, const bf16* XBC, const float* DT, bf16* T, const float* st_in, float* st_out, const float* conv_st,
                                                 const float* conv_w, const float* conv_b, const float* dt_bias, const float* a_log, const float* d_skip) {
    const int gw = F.vcu * NWAVES + F.wave, NGW = F.G * NWAVES, lane = F.lane;
    LAS float* scr = (LAS float*)(F.lds + F.wave * 2048);
    __syncthreads();
    for (int item = gw; item < MS * 32; item += NGW) {
        const int bs = item >> 5, head = item & 31, grp = head >> 3; const size_t row = MPR + bs;
        asm volatile("" ::: "memory");
#pragma unroll
        for (int r = 0; r < 5; ++r) { const int lch = lane + 64 * r, gch = ssd_gcol(lch, head, grp);
            float acc = conv_b[gch];
#pragma unroll
            for (int tap = 0; tap < 3; ++tap) acc += conv_st[((size_t)bs * 3 + tap) * 3072 + gch] * conv_w[tap * 3072 + gch];
            acc += bf2f(XBC[row * 3072 + gch]) * conv_w[3 * 3072 + gch];
            scr[lch] = siluf_(acc); }
        LDS_WAIT();
        const float dtv = softplusf_(DT[row * 32 + head] + dt_bias[head]), dA = __expf(dtv * -expf(a_log[head])), Dh = d_skip[head];
        const int v4 = (lane & 15) * 4, kq = lane >> 4;
        const f32x4 xs4 = (f32x4){scr[v4], scr[v4 + 1], scr[v4 + 2], scr[v4 + 3]}, xd = xs4 * dtv;
        const float* sin = st_in + ((size_t)(bs * 32 + head) * 128) * 64 + v4; float* sout = st_out + ((size_t)(bs * 32 + head) * 128) * 64 + v4;
        f32x4 y = (f32x4){0.f, 0.f, 0.f, 0.f};
#pragma unroll 8
        for (int i = 0; i < 32; ++i) { const int kk = 4 * i + kq;
            f32x4 s = __builtin_nontemporal_load((const GAS f32x4*)(sin + (size_t)kk * 64));
            s = s * dA + xd * scr[64 + kk];
            __builtin_nontemporal_store(s, (GAS f32x4*)(sout + (size_t)kk * 64));
            y = y + s * scr[192 + kk]; }
#pragma unroll
        for (int e = 0; e < 4; ++e) { y[e] += __shfl_xor(y[e], 16); y[e] += __shfl_xor(y[e], 32); }
        if (lane < 16) *(GAS v2u*)(T + row * 2048 + head * 64 + v4) = pack4v(y + xs4 * Dh);
        LDS_WAIT();
    }
    __syncthreads();
}
__device__ __forceinline__ void ssd_conv_out(Frame& F, const bf16* XBC, const float* conv_st, float* outp, float* outs) {
    const int NP_ = BP * 3 * 3072, NS_ = MS * 3 * 3072;
    for (int idx = F.vcu * 512 + F.tid; idx < NP_ + NS_; idx += F.G * 512) {
        if (idx < NP_) { const int b = idx / 9216, rem = idx - b * 9216, wi = rem / 3072, ch = rem - wi * 3072; outp[idx] = bf2f(XBC[(size_t)(b * SEQ + SEQ - 3 + wi) * 3072 + ch]); }
        else { const int k = idx - NP_, bs = k / 9216, rem = k - bs * 9216, wi = rem / 3072, ch = rem - wi * 3072;
            outs[k] = wi < 2 ? conv_st[((size_t)bs * 3 + wi + 1) * 3072 + ch] : bf2f(XBC[(size_t)(MPR + bs) * 3072 + ch]); }
    }
}

template <int P> struct CfHgP { static constexpr int C = 32, KD = 128, VS = 32, KPW = 1, RSK = 272, RSV = 80, RSP = 80; static constexpr bool CH = true;
    static constexpr int BASE = P * 37888, QA = BASE, KA = BASE + 8704, QB = BASE + 17408, KB = BASE + 26112, V = BASE + 34816, VB = V, DS = BASE + 37376,
                         PM = 75776, ST = 78336, PART = 87040, CUM = 0, END = 87040 + 8 * 128 * 4; };
static_assert(CfHgP<1>::END + 8 * 1024 <= SCR_BYTES, "hgrn lds + sample scratch");
struct HgOut { bf16* dst;
    __device__ __forceinline__ void operator()(int tok, int i, int vv0, const f32x4 o) const { *(GAS v2u*)(dst + (size_t)tok * 1024 + vv0) = pack4v(o); } };
__device__ __forceinline__ void st_bf16_lds(LAS unsigned char* p, float x) { *(LAS unsigned short*)p = (unsigned short)(cvt_pk_bf16(x, x) & 0xffffu); }
typedef float f32x2_ __attribute__((ext_vector_type(2)));
template <int P>
__device__ __forceinline__ void hg_fill_images(LAS unsigned char* lds, const f32x2_ (&la)[4], const f32x2_ (&lc)[4], const unsigned (&qr)[4], const v4u vr, int tid) {
    typedef CfHgP<P> Cf;
    const int c2 = tid & 63, tg = tid >> 6;
    const LAS f32x2_* part = (const LAS f32x2_*)(lds + Cf::PART);
    f32x2_ off = (f32x2_){0.f, 0.f}, ref = off, tot = off;
#pragma unroll
    for (int g = 0; g < 8; ++g) { const f32x2_ pg = part[g * 64 + c2]; tot = tot + pg; if (g < 4) ref = ref + pg; const float m = (g < tg) ? 1.f : 0.f; off = off + pg * m; }
    const f32x2_ eref = (f32x2_){__expf(ref.x), __expf(ref.y)}, etr = (f32x2_){__expf(tot.x - ref.x), __expf(tot.y - ref.y)};
#pragma unroll
    for (int e = 0; e < 4; ++e) { const int i = 4 * tg + e; const f32x2_ cm = off + lc[e];
        const float d0 = fminf(fmaxf(cm.x - ref.x, -87.f), 87.f), d1 = fminf(fmaxf(cm.y - ref.y, -87.f), 87.f);
        const float qa0 = bflo(qr[e]) * __expf(d0), qa1 = bfhi(qr[e]) * __expf(d1);
        const float kb0 = (1.f - __expf(la[e].x)) * __expf(-d0), kb1 = (1.f - __expf(la[e].y)) * __expf(-d1);
        *(LAS unsigned*)(lds + Cf::QA + i * 272 + c2 * 4) = cvt_pk_bf16(qa0, qa1); *(LAS unsigned*)(lds + Cf::KA + i * 272 + c2 * 4) = cvt_pk_bf16(kb0, kb1);
        *(LAS unsigned*)(lds + Cf::QB + i * 272 + c2 * 4) = cvt_pk_bf16(qa0 * eref.x, qa1 * eref.y); *(LAS unsigned*)(lds + Cf::KB + i * 272 + c2 * 4) = cvt_pk_bf16(kb0 * etr.x, kb1 * etr.y); }
    if (tg == 0) ((LAS f32x2_*)(lds + Cf::DS))[c2] = eref * etr;
    if (tid < 128) *(LAS v4u*)(lds + Cf::V + (tid >> 2) * 80 + (tid & 3) * 16) = vr;
}
template <bool fuse>
__device__ __forceinline__ void hg_prompt_item(Frame& F, int item, const bf16* HQ, const float* LA, const bf16* HV, bf16* RO, float* st_out, const float* sst_in, float* sst_out) {
    typedef CfHgP<0> Cf0;
    const int b = item >> 5, h = (item >> 2) & 7, vs = item & 3, tid = F.tid, c2 = tid & 63, tg = tid >> 6, w = F.wave, lane = F.lane;
    LAS f32x2_* part = (LAS f32x2_*)(F.lds + Cf0::PART);
    constexpr int NCH = SEQ / 32;
    __syncthreads();
    f32x4 S[1][2];
    rec_zero_state<Cf0>(F, S);
    const size_t base = (size_t)(b * SEQ) * 1024 + h * 128;
    const HgOut out{RO + base + vs * 32};
    f32x2_ la[4], lc[4]; unsigned qr[4]; v4u vr = (v4u){0u, 0u, 0u, 0u};
#define HG_LOAD(cc) do { const size_t b2_ = base + (size_t)(cc) * 32 * 1024; _Pragma("unroll") for (int e_ = 0; e_ < 4; ++e_) { const size_t ix_ = b2_ + (size_t)(4 * tg + e_) * 1024 + 2 * c2; \
            la[e_] = *(const GAS f32x2_*)(LA + ix_); qr[e_] = *(const GAS unsigned*)(HQ + ix_); } \
        if (tid < 128) vr = *(const GAS v4u*)(HV + b2_ + (size_t)(tid >> 2) * 1024 + vs * 32 + (tid & 3) * 8); } while (0)
#define HG_CUMSUM() do { lc[0] = la[0]; _Pragma("unroll") for (int e_ = 1; e_ < 4; ++e_) lc[e_] = lc[e_ - 1] + la[e_]; part[tg * 64 + c2] = lc[3]; } while (0)
    HG_LOAD(0); HG_CUMSUM();
    LDS_BARRIER();
    hg_fill_images<0>(F.lds, la, lc, qr, vr, tid);
    HG_LOAD(1);
    LDS_BARRIER();
    f32x4 O[1];
    LAS float* sscr = (LAS float*)(F.lds + Cf0::END) + w * 256;
    const int sv4 = (lane & 15) * 4, skq = lane >> 4;
    f32x4 siv = (f32x4){0.f, 0.f, 0.f, 0.f}, so = siv, sst = siv; const float* sin = sst_in; float* sout = sst_out; size_t srb = 0; int svh = 0;
    if (fuse) { const int sit = F.vcu * NWAVES + w, bs = sit >> 4, sh = (sit >> 1) & 7; svh = sit & 1; srb = (size_t)(MPR + bs) * 1024 + sh * 128;
#pragma unroll
        for (int r = 0; r < 2; ++r) { const int k2 = lane + 64 * r; sscr[k2] = __expf(LA[srb + k2]); sscr[128 + k2] = bf2f(HQ[srb + k2]); }
        LDS_WAIT();
        const v2u iw = *(const GAS v2u*)(HV + srb + svh * 64 + sv4); siv = (f32x4){bflo(iw.x), bfhi(iw.x), bflo(iw.y), bfhi(iw.y)};
        sin = sst_in + ((size_t)(bs * 8 + sh) * 128) * 128 + svh * 64 + sv4; sout = sst_out + ((size_t)(bs * 8 + sh) * 128) * 128 + svh * 64 + sv4;
        sst = __builtin_nontemporal_load((const GAS f32x4*)(sin + (size_t)skq * 128)); }
#define HG_SAMPLE(cc) do { if (fuse && (cc) < 32) { const int kk_ = 4 * (cc) + skq; const float f_ = sscr[kk_]; \
        const f32x4 s_ = sst * f_ + siv * (1.f - f_); __builtin_nontemporal_store(s_, (GAS f32x4*)(sout + (size_t)kk_ * 128)); so = so + s_ * sscr[128 + kk_]; \
        if ((cc) == 31) { _Pragma("unroll") for (int e_ = 0; e_ < 4; ++e_) { so[e_] += __shfl_xor(so[e_], 16); so[e_] += __shfl_xor(so[e_], 32); } \
            if (lane < 16) *(GAS v2u*)(RO + srb + svh * 64 + sv4) = pack4v(so); } \
        else sst = __builtin_nontemporal_load((const GAS f32x4*)(sin + (size_t)(4 * ((cc) + 1) + skq) * 128)); } } while (0)
#define HG_STEP(P, cc) do { const bool more_ = (cc) + 1 < NCH; HG_SAMPLE(cc); \
        if (more_) HG_CUMSUM();                                      \
        rec_step_a<CfHgP<P>>(F.lds, w, lane, S, (const LAS float*)nullptr, O); \
        LDS_BARRIER(); \
        if (more_) { hg_fill_images<1 - P>(F.lds, la, lc, qr, vr, tid); if ((cc) + 2 < NCH) HG_LOAD((cc) + 2); } \
        rec_step_b<CfHgP<P>>(F.lds, w, lane, S, O, out, (cc) * 32); \
        LDS_BARRIER(); } while (0)
    for (int c = 0; c < NCH; c += 2) { HG_STEP(0, c); HG_STEP(1, c + 1); }
#undef HG_STEP
#undef HG_SAMPLE
#undef HG_CUMSUM
#undef HG_LOAD
    rec_store_state<Cf0>(F, S, st_out + ((size_t)(b * 8 + h) * 128) * 128 + vs * 32, 128);
}
__device__ __forceinline__ void hg_sample_items(Frame& F, const bf16* HQ, const float* LA, const bf16* HV, bf16* RO, const float* st_in, float* st_out) {
    const int gw = F.vcu * NWAVES + F.wave, NGW = F.G * NWAVES, lane = F.lane;
    LAS float* scr = (LAS float*)(F.lds + F.wave * 2048);
    __syncthreads();
    for (int item = gw; item < MS * 16; item += NGW) {
        const int bs = item >> 4, h = (item >> 1) & 7, vh = item & 1; const size_t rb = (size_t)(MPR + bs) * 1024 + h * 128;
        asm volatile("" ::: "memory");
#pragma unroll
        for (int r = 0; r < 2; ++r) { const int kk = lane + 64 * r; scr[kk] = __expf(LA[rb + kk]); scr[128 + kk] = bf2f(HQ[rb + kk]); }
        LDS_WAIT();
        const int v4 = (lane & 15) * 4, kq = lane >> 4;
        const v2u iw = *(const GAS v2u*)(HV + rb + vh * 64 + v4);
        const f32x4 iv = (f32x4){bflo(iw.x), bfhi(iw.x), bflo(iw.y), bfhi(iw.y)};
        const float* sin = st_in + ((size_t)(bs * 8 + h) * 128) * 128 + vh * 64 + v4; float* sout = st_out + ((size_t)(bs * 8 + h) * 128) * 128 + vh * 64 + v4;
        f32x4 o = (f32x4){0.f, 0.f, 0.f, 0.f};
#pragma unroll 8
        for (int i = 0; i < 32; ++i) { const int kk = 4 * i + kq; const float f = scr[kk];
            f32x4 s = __builtin_nontemporal_load((const GAS f32x4*)(sin + (size_t)kk * 128));
            s = s * f + iv * (1.f - f);
            __builtin_nontemporal_store(s, (GAS f32x4*)(sout + (size_t)kk * 128));
            o = o + s * scr[128 + kk]; }
#pragma unroll
        for (int e = 0; e < 4; ++e) { o[e] += __shfl_xor(o[e], 16); o[e] += __shfl_xor(o[e], 32); }
        if (lane < 16) *(GAS v2u*)(RO + rb + vh * 64 + v4) = pack4v(o);
        LDS_WAIT();
    }
    __syncthreads();
}

__device__ __forceinline__ void p0_transpose_item(const float* W, int K, int N, bf16* WT, LAS float* scr, int item, int lane, bool inter) {
    const int nblk = N / 32, kb = item / nblk, nb = item - kb * nblk, k0 = 64 * kb, n0 = 32 * nb;
    int s0 = n0; if (inter) { const int t = n0 >> 8, j = n0 & 255; s0 = j < 128 ? 128 * t + j : DFF + 128 * t + (j - 128); }
#pragma unroll 8
    for (int i = 0; i < 32; ++i) { const int kk = 2 * i + (lane >> 5); scr[kk * 33 + (lane & 31)] = W[(size_t)(k0 + kk) * N + s0 + (lane & 31)]; }
    LDS_WAIT(); asm volatile("" ::: "memory");
    const int c = lane & 7;
#pragma unroll
    for (int j = 0; j < 4; ++j) { const int n = (lane >> 3) + 8 * j; const LAS float* s = scr + (8 * c) * 33 + n;
        v4u o; o.x = cvt_pk_bf16(s[0 * 33], s[1 * 33]); o.y = cvt_pk_bf16(s[2 * 33], s[3 * 33]); o.z = cvt_pk_bf16(s[4 * 33], s[5 * 33]); o.w = cvt_pk_bf16(s[6 * 33], s[7 * 33]);
        *(GAS v4u*)(WT + (size_t)(n0 + n) * K + k0 + 8 * c) = o; }
    LDS_WAIT(); asm volatile("" ::: "memory");
}
__device__ __forceinline__ void p0_matrix(Frame& F, const float* W, int K, int N, bf16* WT, bool inter, int& itbase) {
    const int gw = F.vcu * NWAVES + F.wave, NGW = F.G * NWAVES, nit = (K / 64) * (N / 32);
    LAS float* scr = (LAS float*)(F.lds + F.wave * 16384);
    int first = (gw - itbase) % NGW; if (first < 0) first += NGW;
    for (int it = first; it < nit; it += NGW) p0_transpose_item(W, K, N, WT, scr, it, F.lane, inter);
    itbase += nit;
}

#ifndef REP_PROMPT
#define REP_PROMPT 1
#endif
#ifndef REP_PROMPT_SSD
#define REP_PROMPT_SSD REP_PROMPT
#endif
#ifndef REP_PROMPT_HG
#define REP_PROMPT_HG REP_PROMPT
#endif
#ifndef REP_SAMPLE
#define REP_SAMPLE 1
#endif
#ifndef REP_GEMM
#define REP_GEMM 1
#endif
#ifndef REP_GN
#define REP_GN 1
#endif
#ifndef REP_P0
#define REP_P0 1
#endif
#ifndef REP_SKINNY
#define REP_SKINNY 1
#endif
#ifndef REP_SK_ADA
#define REP_SK_ADA REP_SKINNY
#endif
#ifndef REP_SK_N1K
#define REP_SK_N1K REP_SKINNY
#endif
#define REPEAT(n) _Pragma("unroll 1") for (int rep_ = 0; rep_ < (n); ++rep_)
struct Args { const float* in[30]; float* out; unsigned char* ws; int ph_lo, ph_hi; };
enum { I_XP = 0, I_XS, I_CP, I_CS, I_SRET, I_SSSD, I_SCONV, I_SHG, I_WADA, I_BADA, I_NMPRE, I_NMPOST, I_NFPRE, I_NFPOST, I_RETIN, I_RETOUT, I_SSDIN, I_CONVW, I_CONVB, I_DTB, I_ALOG, I_SSDD,
       I_SSDNORM, I_SSDOUT, I_HGIN, I_HGLB, I_HGNORM, I_HGOUT, I_FFNIN, I_FFNOUT };
constexpr int N_PHASES = 3 + 8 * 4;

__global__ void __launch_bounds__(NWAVES * 64, 2) mk_fwd(Args args) {
    extern __shared__ __attribute__((aligned(16))) unsigned char lds_raw[];
    Frame F;
    F.lds = (LAS unsigned char*)lds_raw;
    F.tid = threadIdx.x; F.lane = F.tid & 63; F.wave = __builtin_amdgcn_readfirstlane(F.tid >> 6);
    F.G = gridDim.x; { const int bx = blockIdx.x; F.vcu = (F.G % 8 == 0) ? (bx % 8) * (F.G / 8) + bx / 8 : bx; }
    unsigned char* ws = args.ws;
    gu32* ctl = (gu32*)(ws + WS_CTL);
    for (int u = F.tid; u < (LDS_BYTES - LDSCTL_OFF) / 4; u += NWAVES * 64) ((LAS unsigned*)(F.lds + LDSCTL_OFF))[u] = 0u;
    __syncthreads();
    XcdBarrier bar; bar.bar = (unsigned*)(ctl + CW_BAR); bar.x = 0; bar.st = nullptr;
    if (MK_N_LAUNCHES == 1) bar = xcd_barrier_post((unsigned*)(ctl + CW_BAR), (volatile LAS unsigned*)(F.lds + LDSCTL_OFF) + 8);
    const int lo = args.ph_lo, hi = args.ph_hi;
#define IN(k) (lo <= (k) && (k) < hi)
#ifndef REP_BAR
#define REP_BAR 1
#endif
#define SEAM(k) do { if (IN((k) + 1)) { _Pragma("unroll") for (int rb_ = 0; rb_ < REP_BAR; ++rb_) xcd_barrier(bar); } } while (0)
#ifndef PF_B
#define PF_B 1
#endif
#define SEAM_PF(k, Bt_, N_, K_) do { if (IN((k) + 1)) { if (PF_B && MK_N_LAUNCHES == 1) xcd_barrier_pf(bar, F, (Bt_), (N_), (K_)); else xcd_barrier(bar); } } while (0)
#define BPRE(k) (PF_B && MK_N_LAUNCHES == 1 && IN((k) - 1) && IN(k))
    const bool ps_ = PANEL_SYNC && MK_N_LAUNCHES == 1 && F.G == 256;
    const int pm_ = panel_of_wg();
    gu32* const tmo_ = ctl + CW_BAR + XB_TMO;
#define SEAM_PANEL(k, seam, Bt_, N_, K_) do { if (IN((k) + 1)) { if (ps_) { panel_publish(F, ctl, (seam), pm_, (F.vcu < 16) ? 8u : 0u, !WT_ROW); panel_wait(F, panel_word(ctl, (seam), pm_), 4u, tmo_); } \
        else SEAM_PF(k, Bt_, N_, K_); } } while (0)
#define SEAM_PUB(k, seam, REL_, FALLBACK_) do { if (IN((k) + 1)) { if (ps_) panel_publish(F, ctl, (seam), pm_, 0u, (REL_)); else { FALLBACK_; } } } while (0)
#define PANEL_WAIT(k, seam) do { if (ps_ && IN((k) - 1)) panel_wait(F, panel_word(ctl, (seam), pm_), 4u, tmo_); } while (0)
#define SWAIT_ARG(k, seam) ((ps_ && IN((k) - 1)) ? panel_word(ctl, (seam), 65) : (gu32*)nullptr)
#define SAMPLE_WAIT(k, seam) do { if (ps_ && IN((k) - 1)) panel_wait(F, panel_word(ctl, (seam), 64), (unsigned)MS, tmo_); } while (0)
#define ALLWG_WAIT(k, seam) do { if (ps_ && IN((k) - 1)) panel_wait(F, panel_word(ctl, (seam), 65), 256u, tmo_); } while (0)
#define INP(i) (args.in[i])
    float* const out = args.out;
    float* const X = out + O_Y;
    bf16* const XB = (bf16*)(ws + WS_XB);
    bf16* const Hb = (bf16*)(ws + WS_H); bf16* const RO = (bf16*)(ws + WS_RO); bf16* const GO = (bf16*)(ws + WS_GO); bf16* const OUTB = (bf16*)(ws + WS_OUT); bf16* const ACT = (bf16*)(ws + WS_ACT);
    float* const MOD = (float*)(ws + WS_MOD); float* const LB = (float*)(ws + WS_LB);
    bf16* const CACT = (bf16*)(ws + WS_CACT);
    bf16* const WADA = (bf16*)(ws + WS_WADA);
    unsigned char* const PJ = ws + WS_PROJ;

    if (IN(0)) { REPEAT(REP_P0) {
        int itb = 0;
#pragma unroll 1
        for (int l = 0; l < 4; ++l) p0_matrix(F, INP(I_WADA) + (size_t)l * D * NMOD, D, NMOD, WADA + (size_t)l * NMOD * D, false, itb);
#pragma unroll 1
        for (int j = 0; j < 2; ++j) p0_matrix(F, INP(I_RETIN) + (size_t)j * D * RET_IN, D, RET_IN, (bf16*)(ws + WS_WRETIN) + (size_t)j * RET_IN * D, false, itb);
#pragma unroll 1
        for (int j = 0; j < 2; ++j) p0_matrix(F, INP(I_RETOUT) + (size_t)j * 2048 * D, 2048, D, (bf16*)(ws + WS_WRETOUT) + (size_t)j * D * 2048, false, itb);
        p0_matrix(F, INP(I_SSDIN), D, SSD_IN, (bf16*)(ws + WS_WSSDIN), false, itb);
        p0_matrix(F, INP(I_SSDOUT), 2048, D, (bf16*)(ws + WS_WSSDOUT), false, itb);
        p0_matrix(F, INP(I_HGIN), D, HG_IN, (bf16*)(ws + WS_WHGIN), false, itb);
        p0_matrix(F, INP(I_HGOUT), D, D, (bf16*)(ws + WS_WHGOUT), false, itb);
#pragma unroll 1
        for (int l = 0; l < 4; ++l) p0_matrix(F, INP(I_FFNIN) + (size_t)l * D * FFN_IN, D, FFN_IN, (bf16*)(ws + WS_WFFNIN) + (size_t)l * FFN_IN * D, true, itb);
#pragma unroll 1
        for (int l = 0; l < 4; ++l) p0_matrix(F, INP(I_FFNOUT) + (size_t)l * DFF * D, DFF, D, (bf16*)(ws + WS_WFFNOUT) + (size_t)l * D * DFF, false, itb);
        for (int idx = F.vcu * 512 + F.tid; idx < 256 * 128; idx += F.G * 512) { const int row = idx >> 7, c8 = (idx & 127) * 8; v4u o = (v4u){0u, 0u, 0u, 0u};
            if (row < NCOND) { const float* src = row < BP ? INP(I_CP) + (size_t)row * D : INP(I_CS) + (size_t)(row - BP) * D;
                const f32x4 a = *(const GAS f32x4*)(src + c8), b = *(const GAS f32x4*)(src + c8 + 4); o = pack8v(silu4(a), silu4(b)); }
            *(GAS v4u*)(CACT + (size_t)row * D + c8) = o; }
        for (int idx = F.vcu * 512 + F.tid; idx < 1024; idx += F.G * 512) { const float* lg = INP(I_HGLB);
            const float l0 = lg[idx], l1 = lg[1024 + idx], l2 = lg[2048 + idx], l3 = lg[3072 + idx], m = fmaxf(fmaxf(l0, l1), fmaxf(l2, l3));
            const float e0 = expf(l0 - m), e1 = expf(l1 - m), e2 = expf(l2 - m), e3 = expf(l3 - m); LB[idx] = (e1 + e2) / ((e0 + e1) + (e2 + e3)); }
        }
        SEAM(0);
    }
    if (IN(1)) {
        const EmitMod E{MOD, INP(I_BADA)};
        REPEAT(REP_SK_ADA) { skinny_gemm<8>(F, CACT, D, 1, 128, 0, WADA, (NMODALL / 256) * 8, false, E, 0, F.G);
                             skinny_gemm<1>(F, CACT + (size_t)128 * D, D, 1, NCOND - 128, 128, WADA, (NMODALL / 256) * 8, false, E, 0, F.G); }
        SEAM(1);
    }
    if (IN(2)) {
        resnorm_phase<0>(F, INP(I_XP), INP(I_XS), XB, X, nullptr, Hb, MOD, nullptr, 0, INP(I_NMPRE), 0 * NMOD + 0 * D, 0 * NMOD + 1 * D, ps_);
        SEAM_PANEL(2, 0, (const bf16*)(ws + WS_WRETIN), RET_IN, D);
    }

#ifndef STAGGER_TICKS
#define STAGGER_TICKS 0
#endif
#define GEMM_STAGGER(N_) do { if (STAGGER_TICKS > 0 && (N_) > 1024 && (blockIdx.x & 1)) { const unsigned long long t0_ = __builtin_amdgcn_s_memrealtime(); \
        while (__builtin_amdgcn_s_memrealtime() - t0_ < (unsigned long long)STAGGER_TICKS) __builtin_amdgcn_s_sleep(8); } } while (0)
#define MAIN_GEMM(PH_, PSK_, EmitT, eobj, Aptr, Btptr, N_, K_) do { GEMM_STAGGER(N_); pg8::Gemm g_{(const pg8::bf16_t*)(Aptr), (const pg8::bf16_t*)(Btptr), MPR, (N_), (K_)}; pg8::StaticOrder S_; S_.init(MPR, (N_), F.G, (int)blockIdx.x); \
        const EpiGen<EmitT> E_{eobj}; _Pragma("unroll") for (int rg_ = 0; rg_ < REP_GEMM; ++rg_) pg8::gemm_phase<EpiGen<EmitT>, pg8::StaticOrder, PG8_ALIGN, PG8_SP2>(F.lds, g_, S_, E_, BPRE(PH_) && !((PSK_) && ps_) && rg_ == 0); } while (0)
#define FFN_BLOCK(L, pb, LASTL, NXT_BT, NXT_N) do { \
    if (IN((pb) + 4)) { PANEL_WAIT((pb) + 4, 13 + 3 * (L)); resnorm_phase<1>(F, nullptr, nullptr, XB, X, OUTB, Hb, MOD, INP(I_NMPOST) + (L) * D, (L) * NMOD + 2 * D, INP(I_NFPRE) + (L) * D, (L) * NMOD + 3 * D, (L) * NMOD + 4 * D, ps_, SWAIT_ARG((pb) + 4, 13 + 3 * (L)), tmo_); SEAM_PANEL((pb) + 4, 2 + 3 * (L), (const bf16*)(ws + WS_WFFNIN) + (size_t)(L) * FFN_IN * D, FFN_IN, D); } \
    if (IN((pb) + 5)) { const bf16* wt_ = (const bf16*)(ws + WS_WFFNIN) + (size_t)(L) * FFN_IN * D; const EmitFfnIn e_{ACT}; \
        MAIN_GEMM((pb) + 5, 1, EmitFfnIn, e_, Hb, wt_, FFN_IN, D); SAMPLE_WAIT((pb) + 5, 2 + 3 * (L)); REPEAT(REP_SKINNY) skinny_gemm<8>(F, Hb + (size_t)MPR * D, D, 1, MS, MPR, wt_, (FFN_IN / 256) * 8, false, e_, F.G / 2, F.G / 2); SEAM_PUB((pb) + 5, 14 + 3 * (L), !WT_G3, SEAM_PF((pb) + 5, (const bf16*)(ws + WS_WFFNOUT) + (size_t)(L) * D * DFF, D, DFF)); } \
    if (IN((pb) + 6)) { const bf16* wt_ = (const bf16*)(ws + WS_WFFNOUT) + (size_t)(L) * D * DFF; const EmitOut e_{OUTB}; \
        PANEL_WAIT((pb) + 6, 14 + 3 * (L)); MAIN_GEMM((pb) + 6, 1, EmitOut, e_, ACT, wt_, D, DFF); if (ps_ && IN((pb) + 5)) panel_wait(F, panel_word(ctl, 14 + 3 * (L), 65), 256u, tmo_); REPEAT(REP_SK_N1K) skinny_gemm<2>(F, ACT + (size_t)MPR * DFF, DFF, 4, MS, MPR, wt_, (D / 256) * 8, false, e_, 0, F.G); SEAM_PUB((pb) + 6, 15 + 3 * (L), !WT_OUT, SEAM((pb) + 6)); } \
    if (IN((pb) + 7)) { PANEL_WAIT((pb) + 7, 15 + 3 * (L)); if (LASTL) resnorm_phase<2>(F, nullptr, nullptr, XB, X, OUTB, Hb, MOD, INP(I_NFPOST) + (L) * D, (L) * NMOD + 5 * D, nullptr, 0, 0, ps_, SWAIT_ARG((pb) + 7, 15 + 3 * (L)), tmo_); \
        else resnorm_phase<1>(F, nullptr, nullptr, XB, X, OUTB, Hb, MOD, INP(I_NFPOST) + (L) * D, (L) * NMOD + 5 * D, INP(I_NMPRE) + ((L) + 1) * D, ((L) + 1) * NMOD + 0 * D, ((L) + 1) * NMOD + 1 * D, ps_, SWAIT_ARG((pb) + 7, 15 + 3 * (L)), tmo_); \
        if (!(LASTL)) SEAM_PANEL((pb) + 7, 3 + 3 * (L), (NXT_BT), (NXT_N), D); } } while (0)
#define OUT_PROJ(L, pb, wt, K_) do { if (IN((pb) + 3)) { const EmitOut e_{OUTB}; MAIN_GEMM((pb) + 3, 1, EmitOut, e_, GO, (wt), D, (K_)); SAMPLE_WAIT((pb) + 3, 1 + 3 * (L)); REPEAT(REP_SK_N1K) skinny_gemm<2>(F, GO + (size_t)MPR * (K_), (K_), 4, MS, MPR, (wt), (D / 256) * 8, false, e_, 0, F.G); SEAM_PUB((pb) + 3, 13 + 3 * (L), !WT_OUT, SEAM((pb) + 3)); } } while (0)
#define RET_LAYER(L, J, pb) do { \
    bf16* const Qp_ = (bf16*)(PJ + PJ_RET_Q); bf16* const Kp_ = (bf16*)(PJ + PJ_RET_K); bf16* const Vp_ = (bf16*)(PJ + PJ_RET_V); bf16* const SGp_ = (bf16*)(PJ + PJ_RET_SG); \
    if (IN((pb) + 0)) { const bf16* wt_ = (const bf16*)(ws + WS_WRETIN) + (size_t)(J) * RET_IN * D; const EmitRetIn e_{Qp_, Kp_, Vp_, SGp_}; \
        MAIN_GEMM((pb) + 0, 1, EmitRetIn, e_, Hb, wt_, RET_IN, D); SAMPLE_WAIT((pb) + 0, 3 * (L)); REPEAT(REP_SKINNY) skinny_gemm<8>(F, Hb + (size_t)MPR * D, D, 1, MS, MPR, wt_, (RET_IN / 256) * 8, false, e_, 0, F.G); SEAM((pb) + 0); } \
    if (IN((pb) + 1)) { const bool fuse_ = (F.G == 256); const float* ssi_ = INP(I_SRET) + (size_t)(J) * 128 * 4 * 256 * 512; float* sso_ = out + O_RETS + (size_t)(J) * 128 * 4 * 256 * 512; \
        if (fuse_) { REPEAT(REP_PROMPT) ret_prompt_item<true>(F, F.vcu, Qp_, Kp_, Vp_, RO, out + O_RETP + (size_t)(J) * 8 * 4 * 256 * 512, ssi_, sso_); } \
        else { for (int item = F.vcu; item < 256; item += F.G) ret_prompt_item<false>(F, item, Qp_, Kp_, Vp_, RO, out + O_RETP + (size_t)(J) * 8 * 4 * 256 * 512, ssi_, sso_); \
            REPEAT(REP_SAMPLE) ret_sample_items(F, Qp_, Kp_, Vp_, RO, ssi_, sso_); } SEAM((pb) + 1); } \
    if (IN((pb) + 2)) { REPEAT(REP_GN) gatenorm_phase<0>(F, RO, SGp_, GO, nullptr, ps_); SEAM_PANEL((pb) + 2, 1 + 3 * (L), (const bf16*)(ws + WS_WRETOUT) + (size_t)(J) * D * 2048, D, 2048); } \
    OUT_PROJ(L, pb, (const bf16*)(ws + WS_WRETOUT) + (size_t)(J) * D * 2048, 2048); \
    } while (0)

    RET_LAYER(0, 0, 3);
    FFN_BLOCK(0, 3, false, (const bf16*)(ws + WS_WSSDIN), SSD_INM);
    {
        constexpr int pb = 11;
        bf16* const SZ_ = (bf16*)(PJ + PJ_SSD_SZ); bf16* const XBC_ = (bf16*)(PJ + PJ_SSD_XBC); float* const DT_ = (float*)(PJ + PJ_SSD_DT);
        if (IN(pb + 0)) { const bf16* wt_ = (const bf16*)(ws + WS_WSSDIN); const EmitSsdIn e_{SZ_, XBC_}; const EmitDt ed_{DT_};
            MAIN_GEMM(pb + 0, 1, EmitSsdIn, e_, Hb, wt_, SSD_INM, D); SAMPLE_WAIT(pb + 0, 3); ALLWG_WAIT(pb + 0, 3);
            REPEAT(REP_SKINNY) skinny_gemm<8>(F, Hb + (size_t)MPR * D, D, 1, MS, MPR, wt_, (SSD_INM / 256) * 8, false, e_, 0, F.G);
            REPEAT(REP_SKINNY) skinny_gemm<8>(F, Hb, D, MT / 128, MT, 0, wt_, 1, true, ed_, 0, F.G);
            SEAM(pb + 0); }
        if (IN(pb + 1)) {
            if (F.G == 256) { REPEAT(REP_PROMPT_SSD) ssd_prompt_item<true>(F, F.vcu, XBC_, DT_, RO, out + O_SSDP, INP(I_CONVW), INP(I_CONVB), INP(I_DTB), INP(I_ALOG), INP(I_SSDD), INP(I_SSSD), out + O_SSDS, INP(I_SCONV)); }
            else { for (int item = F.vcu; item < 256; item += F.G) ssd_prompt_item<false>(F, item, XBC_, DT_, RO, out + O_SSDP, INP(I_CONVW), INP(I_CONVB), INP(I_DTB), INP(I_ALOG), INP(I_SSDD), INP(I_SSSD), out + O_SSDS, INP(I_SCONV));
                REPEAT(REP_SAMPLE) ssd_sample_items(F, XBC_, DT_, RO, INP(I_SSSD), out + O_SSDS, INP(I_SCONV), INP(I_CONVW), INP(I_CONVB), INP(I_DTB), INP(I_ALOG), INP(I_SSDD)); }
            ssd_conv_out(F, XBC_, INP(I_SCONV), out + O_CONVP, out + O_CONVS);
            SEAM(pb + 1); }
        if (IN(pb + 2)) { REPEAT(REP_GN) gatenorm_phase<1>(F, RO, SZ_, GO, INP(I_SSDNORM), ps_); SEAM_PANEL(pb + 2, 4, (const bf16*)(ws + WS_WSSDOUT), D, 2048); }
        OUT_PROJ(1, pb, (const bf16*)(ws + WS_WSSDOUT), 2048);
    }
    FFN_BLOCK(1, 11, false, (const bf16*)(ws + WS_WHGIN), HG_IN);
    {
        constexpr int pb = 19;
        bf16* const HQ_ = (bf16*)(PJ + PJ_HG_Q); float* const LA_ = (float*)(PJ + PJ_HG_LA); bf16* const HV_ = (bf16*)(PJ + PJ_HG_V); bf16* const HSG_ = (bf16*)(PJ + PJ_HG_SG);
        if (IN(pb + 0)) { const bf16* wt_ = (const bf16*)(ws + WS_WHGIN); const EmitHgIn e_{HQ_, HV_, HSG_, LA_, LB};
            MAIN_GEMM(pb + 0, 1, EmitHgIn, e_, Hb, wt_, HG_IN, D); SAMPLE_WAIT(pb + 0, 6); REPEAT(REP_SKINNY) skinny_gemm<8>(F, Hb + (size_t)MPR * D, D, 1, MS, MPR, wt_, (HG_IN / 256) * 8, false, e_, 0, F.G); SEAM(pb + 0); }
        if (IN(pb + 1)) {
            if (F.G == 256) { REPEAT(REP_PROMPT_HG) hg_prompt_item<true>(F, F.vcu, HQ_, LA_, HV_, RO, out + O_HGP, INP(I_SHG), out + O_HGS); }
            else { for (int item = F.vcu; item < 256; item += F.G) hg_prompt_item<false>(F, item, HQ_, LA_, HV_, RO, out + O_HGP, INP(I_SHG), out + O_HGS);
                REPEAT(REP_SAMPLE) hg_sample_items(F, HQ_, LA_, HV_, RO, INP(I_SHG), out + O_HGS); }
            SEAM(pb + 1); }
        if (IN(pb + 2)) { REPEAT(REP_GN) gatenorm_phase<2>(F, RO, HSG_, GO, INP(I_HGNORM), ps_); SEAM_PANEL(pb + 2, 7, (const bf16*)(ws + WS_WHGOUT), D, 1024); }
        OUT_PROJ(2, pb, (const bf16*)(ws + WS_WHGOUT), 1024);
    }
    FFN_BLOCK(2, 19, false, (const bf16*)(ws + WS_WRETIN) + (size_t)RET_IN * D, RET_IN);
    RET_LAYER(3, 1, 27);
    FFN_BLOCK(3, 27, true, (const bf16*)nullptr, 0);
#undef IN
#undef SEAM
}

extern "C" void kernel_launch(void* const* d_in, const int* in_sizes, int n_in, void* d_out, int out_size, void* d_ws, size_t ws_size, hipStream_t stream) {
    static int grid = 0;
    if (grid == 0) {
        if (n_in != 30 || (size_t)out_size != O_END || ws_size < WS_END) { fprintf(stderr, "kernel_launch: unexpected shapes (n_in %d out %d ws %zu)\n", n_in, out_size, ws_size); grid = -1; return; }
        int dev = 0, cus = 0, per_cu = 0;
        if (hipGetDevice(&dev) != hipSuccess || hipDeviceGetAttribute(&cus, hipDeviceAttributeMultiprocessorCount, dev) != hipSuccess) { grid = -1; return; }
        if (hipFuncSetAttribute((const void*)mk_fwd, hipFuncAttributeMaxDynamicSharedMemorySize, LDS_BYTES) != hipSuccess) { fprintf(stderr, "kernel_launch: hipFuncSetAttribute failed\n"); grid = -1; return; }
        if (hipOccupancyMaxActiveBlocksPerMultiprocessor(&per_cu, (const void*)mk_fwd, NWAVES * 64, LDS_BYTES) != hipSuccess || per_cu < 1) { fprintf(stderr, "kernel_launch: occupancy query says %d\n", per_cu); }
        (void)hipGetLastError();
        grid = cus;
    }
    if (grid < 0) return;
    if (hipMemsetAsync((char*)d_ws + WS_CTL, 0, CTL_ZERO_BYTES, stream) != hipSuccess) { fprintf(stderr, "kernel_launch: memset failed\n"); return; }
    Args a{};
    for (int i = 0; i < 30; ++i) a.in[i] = (const float*)d_in[i];
    a.out = (float*)d_out; a.ws = (unsigned char*)d_ws;
#if MK_N_LAUNCHES == 1
    a.ph_lo = 0; a.ph_hi = N_PHASES;
    hipLaunchKernelGGL(mk_fwd, dim3(grid), dim3(NWAVES * 64), LDS_BYTES, stream, a);
#else
    for (int p = 0; p < N_PHASES; ++p) { a.ph_lo = p; a.ph_hi = p + 1; hipLaunchKernelGGL(mk_fwd, dim3(grid), dim3(NWAVES * 64), LDS_BYTES, stream, a); }
#endif
    const hipError_t le = hipPeekAtLastError();
    if (le != hipSuccess) fprintf(stderr, "kernel_launch: launch failed: %s\n", hipGetErrorName(le));
}
```

```cpp
#include <hip/hip_runtime.h>
#include <cstdio>
#include <cstdint>
namespace pg8 {
#define PG8_LAS __attribute__((address_space(3)))
typedef unsigned short bf16_t;
typedef short bf16x8 __attribute__((ext_vector_type(8)));
typedef float f32x4 __attribute__((ext_vector_type(4)));
typedef unsigned u32x4 __attribute__((ext_vector_type(4)));
constexpr int BM = 256, BK = 64, HALF = 128, HTB = HALF * BK * 2  , STAGE_BYTES = 8 * HTB, NXCD = 8, WGM = 8;

__host__ __device__ __forceinline__ int lds_byte(int r, int c) { const int st = (r >> 4) * 2 + (c >> 5), rr = r & 15, cc = c & 31, ob = rr * 64 + cc * 2; return st * 1024 + (ob ^ (((ob >> 9) & 1) << 5)); }
__host__ __device__ __forceinline__ void stage_rc(int b, int& R, int& C) { const int st = b / 1024, sb = b % 1024, swz = sb ^ (((sb >> 9) & 1) << 5); R = (st >> 1) * 16 + swz / 64; C = (st & 1) * 32 + (swz % 64) / 2; }
__host__ __device__ __forceinline__ int perm32(int rho) { const int n = rho >> 4, i = rho & 15; return 8 * (i >> 2) + 4 * n + (i & 3); }

struct Unit { int pm, pn; };
struct Gemm { const bf16_t* A; const bf16_t* Bt; int M, N, K; };

struct StaticOrder {
    int nM, nN, nwg, G, c;
    __host__ __device__ void init(int M, int N, int G_, int c_) { nM = M / BM; nN = N / BM; nwg = nM * nN; G = G_; c = c_; }
    __host__ __device__ bool next(int i, Unit& u) const {
        const long L = (long)i * G + c; if (L >= nwg) return false;
        int wgid = (int)L; { const int q = nwg / NXCD, r = nwg % NXCD, xcd = wgid % NXCD, off = wgid / NXCD; wgid = (xcd < r ? xcd * (q + 1) : r * (q + 1) + (xcd - r) * q) + off; }
        const int nig = WGM * nN, gid = wgid / nig, fm = gid * WGM, gsz = (nM - fm) < WGM ? (nM - fm) : WGM;
        u.pm = fm + ((wgid % nig) % gsz); u.pn = (wgid % nig) / gsz; return true;
    }
    __device__ __forceinline__ void a_ready(const Unit&) const {}
    __device__ __forceinline__ void done(const Unit&) const {}
};

__device__ __forceinline__ unsigned cvt_pk_bf16(float lo, float hi) { unsigned r; asm volatile("v_cvt_pk_bf16_f32 %0, %1, %2" : "=v"(r) : "v"(lo), "v"(hi)); return r; }
typedef float f32x2 __attribute__((ext_vector_type(2)));
template <class Epi, class Sched, bool ALIGN_EPI = false, bool SP2 = false>
__device__ __forceinline__ void gemm_phase(PG8_LAS unsigned char* lds, const Gemm g, const Sched& S, const Epi& E, const bool bpre = false) {
    const int tid = threadIdx.x, wid = __builtin_amdgcn_readfirstlane(tid >> 6), lane = tid & 63, wr = wid >> 2, wc = wid & 3, fr = lane & 15, fq = lane >> 4;
    const int K = g.K, nt = K / BK;
    unsigned voffA[2], voffB[2];
#pragma unroll
    for (int i = 0; i < 2; ++i) { int R, C; stage_rc(tid * 16 + i * 8192, R, C); const int Rb = Epi::PERM ? ((R & ~31) + perm32(R & 31)) : R;
        voffA[i] = (unsigned)(R * K + C) * 2u; voffB[i] = (unsigned)(Rb * K + C) * 2u; }
    const size_t kstep = (size_t)(BK * 2);
    const size_t hstep = (size_t)HALF * K * 2;
    const size_t tstep = 2 * hstep;
    const unsigned ldsw = (unsigned)wid * 1024u;
    const int aoff = lds_byte(wr * 64 + fr, fq * 8), boff = lds_byte(wc * 32 + fr, fq * 8);
#define PG8_SA(b, h) (((b) * 2 + (h)) * HTB)
#define PG8_SB(b, h) ((4 + (b) * 2 + (h)) * HTB)
#define PG8_STAGE(bufoff, gbase, voff) do { _Pragma("unroll") for (int _i = 0; _i < 2; ++_i) \
        __builtin_amdgcn_global_load_lds((const unsigned*)((const char*)(gbase) + (voff)[_i]), (PG8_LAS unsigned*)(lds + (bufoff) + ldsw + _i * 8192), 16, 0, 0); } while (0)
#define PG8_LDA(dst, b, h) do { _Pragma("unroll") for (int m = 0; m < 4; ++m) _Pragma("unroll") for (int k = 0; k < 2; ++k) dst[m][k] = *(const PG8_LAS bf16x8*)(lds + PG8_SA(b, h) + aoff + m * 2048 + k * 1024); } while (0)
#define PG8_LDB(dst, b, h) do { _Pragma("unroll") for (int n = 0; n < 2; ++n) _Pragma("unroll") for (int k = 0; k < 2; ++k) dst[n][k] = *(const PG8_LAS bf16x8*)(lds + PG8_SB(b, h) + boff + n * 2048 + k * 1024); } while (0)
#define PG8_MMA(ai, bj, At, Bt) do { __builtin_amdgcn_s_setprio(1); _Pragma("unroll") for (int m = 0; m < 4; ++m) _Pragma("unroll") for (int n = 0; n < 2; ++n) _Pragma("unroll") for (int k = 0; k < 2; ++k) \
        acc[ai][bj][m][n] = __builtin_amdgcn_mfma_f32_16x16x32_bf16(Bt[n][k], At[m][k], acc[ai][bj][m][n], 0, 0, 0); __builtin_amdgcn_s_setprio(0); } while (0)
#define PG8_WAIT_V(n) asm volatile("s_waitcnt vmcnt(" #n ")" ::: "memory")
#define PG8_WAIT_L(n) asm volatile("s_waitcnt lgkmcnt(" #n ")" ::: "memory")
#define PG8_BAR __builtin_amdgcn_s_barrier()
#define PG8_SCHED __builtin_amdgcn_sched_barrier(0)
    Unit cur, nxt; int ui = 0;
    if (!S.next(0, cur)) return;
    f32x4 acc[2][2][4][2];
#pragma unroll
    for (int a = 0; a < 2; ++a)
#pragma unroll
        for (int b = 0; b < 2; ++b)
#pragma unroll
            for (int m = 0; m < 4; ++m)
#pragma unroll
                for (int n = 0; n < 2; ++n) acc[a][b][m][n] = (f32x4){0.f, 0.f, 0.f, 0.f};
    bf16x8 At[4][2], B0[2][2], B1[2][2];
    const char* cA = (const char*)g.A + (size_t)cur.pm * tstep; const char* cB = (const char*)g.Bt + (size_t)cur.pn * tstep;
    S.a_ready(cur);
    if constexpr (SP2) {
        if (!(bpre && wid != 0)) { PG8_STAGE(PG8_SB(0, 0), cB, voffB); PG8_STAGE(PG8_SB(0, 1), cB + hstep, voffB); }
        PG8_STAGE(PG8_SA(0, 0), cA, voffA); PG8_STAGE(PG8_SA(0, 1), cA + hstep, voffA);
        if (wr == 1) PG8_BAR;
        PG8_WAIT_V(2); PG8_BAR;
        PG8_STAGE(PG8_SB(1, 0), cB + kstep, voffB); PG8_STAGE(PG8_SA(1, 0), cA + kstep, voffA); PG8_STAGE(PG8_SB(1, 1), cB + hstep + kstep, voffB);
        PG8_WAIT_V(6); PG8_BAR;
    } else {
        PG8_STAGE(PG8_SB(0, 0), cB, voffB); PG8_STAGE(PG8_SA(0, 0), cA, voffA); PG8_STAGE(PG8_SB(0, 1), cB + hstep, voffB); PG8_STAGE(PG8_SA(0, 1), cA + hstep, voffA);
        if (wr == 1) PG8_BAR;
        PG8_WAIT_V(4); PG8_BAR;
        PG8_STAGE(PG8_SB(1, 0), cB + kstep, voffB); PG8_STAGE(PG8_SA(1, 0), cA + kstep, voffA); PG8_STAGE(PG8_SB(1, 1), cB + hstep + kstep, voffB);
        PG8_WAIT_V(6); PG8_BAR;
    }
    for (;;) {
        const bool has_next = S.next(ui + 1, nxt);
        const char* nA = has_next ? (const char*)g.A + (size_t)nxt.pm * tstep : cA; const char* nB = has_next ? (const char*)g.Bt + (size_t)nxt.pn * tstep : cB;
        for (int t = 0; t < nt; t += 2) {
            const bool last = (t == nt - 2);
            const char* a1 = cA + (size_t)(t + 1) * kstep;
            const char* a2 = last ? nA : cA + (size_t)(t + 2) * kstep; const char* b2 = last ? nB : cB + (size_t)(t + 2) * kstep;
            const char* a3 = a2 + kstep; const char* b3 = b2 + kstep;
            if (last && has_next) S.a_ready(nxt);
            if constexpr (SP2) {
            PG8_LDB(B0, 0, 0); PG8_LDB(B1, 0, 1); PG8_SCHED; PG8_LDA(At, 0, 0); PG8_STAGE(PG8_SA(1, 1), a1 + hstep, voffA);
            PG8_WAIT_V(8); PG8_WAIT_L(0); PG8_BAR; PG8_MMA(0, 0, At, B0); PG8_MMA(0, 1, At, B1); PG8_BAR; PG8_SCHED;
            PG8_LDA(At, 0, 1); PG8_STAGE(PG8_SB(0, 0), b2, voffB); PG8_STAGE(PG8_SB(0, 1), b2 + hstep, voffB); PG8_STAGE(PG8_SA(0, 0), a2, voffA);
            PG8_WAIT_V(8); PG8_WAIT_L(0); PG8_BAR; PG8_MMA(1, 0, At, B0); PG8_MMA(1, 1, At, B1); PG8_BAR; PG8_SCHED;
            PG8_LDB(B0, 1, 0); PG8_LDB(B1, 1, 1); PG8_SCHED; PG8_LDA(At, 1, 0); PG8_STAGE(PG8_SA(0, 1), a2 + hstep, voffA);
            PG8_WAIT_V(8); PG8_WAIT_L(0); PG8_BAR; PG8_MMA(0, 0, At, B0); PG8_MMA(0, 1, At, B1); PG8_BAR; PG8_SCHED;
            PG8_LDA(At, 1, 1); PG8_STAGE(PG8_SB(1, 0), b3, voffB); PG8_STAGE(PG8_SB(1, 1), b3 + hstep, voffB); PG8_STAGE(PG8_SA(1, 0), a3, voffA);
            PG8_WAIT_V(8); PG8_WAIT_L(0); PG8_BAR; PG8_MMA(1, 0, At, B0); PG8_MMA(1, 1, At, B1); PG8_BAR; PG8_SCHED;
            } else {
            PG8_LDB(B0, 0, 0); PG8_SCHED; PG8_LDA(At, 0, 0); PG8_STAGE(PG8_SA(1, 1), a1 + hstep, voffA);
            PG8_WAIT_L(8); PG8_BAR; PG8_WAIT_L(0); PG8_MMA(0, 0, At, B0); PG8_BAR; PG8_SCHED;
            PG8_LDB(B1, 0, 1); PG8_STAGE(PG8_SB(0, 0), b2, voffB);
            PG8_BAR; PG8_WAIT_L(0); PG8_MMA(0, 1, At, B1); PG8_BAR;
            PG8_LDA(At, 0, 1); PG8_STAGE(PG8_SA(0, 0), a2, voffA);
            PG8_BAR; PG8_WAIT_L(0); PG8_MMA(1, 0, At, B0); PG8_BAR; PG8_SCHED;
            PG8_STAGE(PG8_SB(0, 1), b2 + hstep, voffB);
            PG8_WAIT_V(6); PG8_BAR; PG8_MMA(1, 1, At, B1); PG8_BAR;
            PG8_LDB(B0, 1, 0); PG8_SCHED; PG8_LDA(At, 1, 0); PG8_STAGE(PG8_SA(0, 1), a2 + hstep, voffA);
            PG8_WAIT_L(8); PG8_BAR; PG8_WAIT_L(0); PG8_MMA(0, 0, At, B0); PG8_BAR; PG8_SCHED;
            PG8_LDB(B1, 1, 1); PG8_STAGE(PG8_SB(1, 0), b3, voffB);
            PG8_BAR; PG8_WAIT_L(0); PG8_MMA(0, 1, At, B1); PG8_BAR;
            PG8_LDA(At, 1, 1); PG8_STAGE(PG8_SA(1, 0), a3, voffA);
            PG8_BAR; PG8_WAIT_L(0); PG8_MMA(1, 0, At, B0); PG8_BAR; PG8_SCHED;
            PG8_STAGE(PG8_SB(1, 1), b3 + hstep, voffB);
            PG8_WAIT_V(6); PG8_BAR; PG8_MMA(1, 1, At, B1); PG8_BAR;
            }
        }
        if constexpr (ALIGN_EPI) { if (wr == 0) PG8_BAR; }
        if constexpr (!Epi::AFTER_DRAIN) { E(acc, cur, wr, wc, fr, fq); S.done(cur); }
        if (!has_next) break;
#pragma unroll
        for (int a = 0; a < 2; ++a)
#pragma unroll
            for (int b = 0; b < 2; ++b)
#pragma unroll
                for (int m = 0; m < 4; ++m)
#pragma unroll
                    for (int n = 0; n < 2; ++n) acc[a][b][m][n] = (f32x4){0.f, 0.f, 0.f, 0.f};
        cur = nxt; cA = nA; cB = nB; ++ui;
        if constexpr (ALIGN_EPI) { if (wr == 1) PG8_BAR; }
    }
    PG8_WAIT_V(0);
    if constexpr (!ALIGN_EPI) { if (wr == 0) PG8_BAR; }
    PG8_BAR;
    if constexpr (Epi::AFTER_DRAIN) { E.fused(acc, cur, wr, wc, fr, fq, lds, wid, lane); S.done(cur); }
#undef PG8_SA
#undef PG8_SB
#undef PG8_STAGE
#undef PG8_LDA
#undef PG8_LDB
#undef PG8_MMA
#undef PG8_WAIT_V
#undef PG8_WAIT_L
#undef PG8_BAR
#undef PG8_SCHED
}
}

#ifndef PG8_SP2
#define PG8_SP2 true
#endif
#ifndef PG8_ALIGN
#define PG8_ALIGN true
#endif
#ifndef MK_N_LAUNCHES
#define MK_N_LAUNCHES 1
#endif

constexpr int D = 1024, BP = 8, SEQ = 2048, MPR = BP * SEQ  , MS = 128  , MT = MPR + MS  ;
constexpr int NCOND = BP + MS;
constexpr int DFF = 2816, NMOD = 6 * D  , NMODALL = 4 * NMOD  ;
constexpr int RET_IN = 6144, SSD_IN = 5152, SSD_INM = 5120, HG_IN = 4096, FFN_IN = 2 * DFF;
constexpr float EPS = 1e-6f;
constexpr int NWAVES = 8;

constexpr size_t MiB = 1u << 20;
constexpr size_t WS_CTL = 0, CTL_ZERO_BYTES = 1 * MiB;
constexpr size_t WS_WADA = 1 * MiB;
constexpr size_t WS_WRETIN = WS_WADA + 48 * MiB;
constexpr size_t WS_WRETOUT = WS_WRETIN + 24 * MiB;
constexpr size_t WS_WSSDIN = WS_WRETOUT + 8 * MiB;
constexpr size_t WS_WSSDOUT = WS_WSSDIN + 11 * MiB;
constexpr size_t WS_WHGIN = WS_WSSDOUT + 4 * MiB;
constexpr size_t WS_WHGOUT = WS_WHGIN + 8 * MiB;
constexpr size_t WS_WFFNIN = WS_WHGOUT + 2 * MiB;
constexpr size_t WS_WFFNOUT = WS_WFFNIN + 44 * MiB;
constexpr size_t WS_MOD = WS_WFFNOUT + 22 * MiB;
constexpr size_t WS_CACT = WS_MOD + 24 * MiB;
constexpr size_t WS_LB = WS_CACT + 512 * 1024;
constexpr size_t WS_H = WS_CACT + 1 * MiB;
constexpr size_t WS_PROJ = WS_H + 33 * MiB;
constexpr size_t WS_RO = WS_PROJ + 200 * MiB;
constexpr size_t WS_GO = WS_RO + 65 * MiB;
constexpr size_t WS_OUT = WS_GO + 65 * MiB;
constexpr size_t WS_ACT = WS_OUT + 33 * MiB;
constexpr size_t WS_XB = WS_ACT + 89 * MiB;
constexpr size_t WS_END = WS_XB + 33 * MiB;
constexpr size_t PJ_RET_Q = 0, PJ_RET_K = PJ_RET_Q + (size_t)MT * 1024 * 2, PJ_RET_V = PJ_RET_K + (size_t)MT * 1024 * 2, PJ_RET_SG = PJ_RET_V + (size_t)MT * 2048 * 2;
constexpr size_t PJ_SSD_SZ = 0, PJ_SSD_XBC = PJ_SSD_SZ + (size_t)MT * 2048 * 2, PJ_SSD_DT = PJ_SSD_XBC + (size_t)MT * 3072 * 2;
constexpr size_t PJ_HG_Q = 0, PJ_HG_LA = PJ_HG_Q + (size_t)MT * 1024 * 2, PJ_HG_V = PJ_HG_LA + (size_t)MT * 1024 * 4, PJ_HG_SG = PJ_HG_V + (size_t)MT * 1024 * 2;
static_assert(PJ_RET_SG + (size_t)MT * 2048 * 2 <= 200 * MiB && PJ_SSD_DT + (size_t)MT * 32 * 4 <= 200 * MiB && PJ_HG_SG + (size_t)MT * 1024 * 2 <= 200 * MiB, "proj map");
constexpr int CW_BAR = 4096;
#ifndef PANEL_SYNC
#define PANEL_SYNC 1
#endif
constexpr int CW_PANEL = 16384;

constexpr size_t O_Y = 0;
constexpr size_t O_RETP = (size_t)MT * D;
constexpr size_t O_RETS = O_RETP + (size_t)2 * 8 * 4 * 256 * 512;
constexpr size_t O_SSDP = O_RETS + (size_t)2 * 128 * 4 * 256 * 512;
constexpr size_t O_SSDS = O_SSDP + (size_t)8 * 32 * 128 * 64;
constexpr size_t O_CONVP = O_SSDS + (size_t)128 * 32 * 128 * 64;
constexpr size_t O_CONVS = O_CONVP + (size_t)8 * 3 * 3072;
constexpr size_t O_HGP = O_CONVS + (size_t)128 * 3 * 3072;
constexpr size_t O_HGS = O_HGP + (size_t)8 * 8 * 128 * 128;
constexpr size_t O_END = O_HGS + (size_t)128 * 8 * 128 * 128;
static_assert(O_END == 214245376ull, "output size");

constexpr int LDS_BYTES = 147456;
constexpr int LDSCTL_OFF = LDS_BYTES - 1024;
constexpr int SCR_BYTES = LDSCTL_OFF;

#define GAS __attribute__((address_space(1)))
#define LAS __attribute__((address_space(3)))
typedef unsigned short bf16;
typedef unsigned v4u __attribute__((ext_vector_type(4)));
typedef unsigned v2u __attribute__((ext_vector_type(2)));
typedef float f32x4 __attribute__((ext_vector_type(4)));
typedef short bf16x8 __attribute__((ext_vector_type(8)));
typedef short s16x4 __attribute__((ext_vector_type(4)));
typedef GAS unsigned gu32;
#define RLX_AGENT __ATOMIC_RELAXED, __HIP_MEMORY_SCOPE_AGENT
#define LDS_WAIT() asm volatile("s_waitcnt lgkmcnt(0)" ::: "memory")
#define VM_WAIT() asm volatile("s_waitcnt vmcnt(0)" ::: "memory")
typedef float f32x2_t __attribute__((ext_vector_type(2))); typedef __bf16 bf16x2_t __attribute__((ext_vector_type(2)));
__device__ __forceinline__ unsigned cvt_pk_bf16(float lo, float hi) { f32x2_t v = {lo, hi}; bf16x2_t b = __builtin_convertvector(v, bf16x2_t); return __builtin_bit_cast(unsigned, b); }
__device__ __forceinline__ float bf2f(unsigned b) { return __uint_as_float(b << 16); }
__device__ __forceinline__ float bflo(unsigned w) { return __uint_as_float(w << 16); }
__device__ __forceinline__ float bfhi(unsigned w) { return __uint_as_float(w & 0xffff0000u); }
__device__ __forceinline__ void unpack8(const v4u w, float (&f)[8]) { f[0] = bflo(w.x); f[1] = bfhi(w.x); f[2] = bflo(w.y); f[3] = bfhi(w.y); f[4] = bflo(w.z); f[5] = bfhi(w.z); f[6] = bflo(w.w); f[7] = bfhi(w.w); }
__device__ __forceinline__ v4u pack8(const float (&f)[8]) { v4u w; w.x = cvt_pk_bf16(f[0], f[1]); w.y = cvt_pk_bf16(f[2], f[3]); w.z = cvt_pk_bf16(f[4], f[5]); w.w = cvt_pk_bf16(f[6], f[7]); return w; }
__device__ __forceinline__ v4u pack8v(const f32x4 a, const f32x4 b) { v4u w; w.x = cvt_pk_bf16(a[0], a[1]); w.y = cvt_pk_bf16(a[2], a[3]); w.z = cvt_pk_bf16(b[0], b[1]); w.w = cvt_pk_bf16(b[2], b[3]); return w; }
__device__ __forceinline__ v2u pack4v(const f32x4 a) { v2u w; w.x = cvt_pk_bf16(a[0], a[1]); w.y = cvt_pk_bf16(a[2], a[3]); return w; }
__device__ __forceinline__ float sigmoidf_(float x) { return __builtin_amdgcn_rcpf(1.f + __expf(-x)); }
__device__ __forceinline__ float siluf_(float x) { return x * sigmoidf_(x); }
__device__ __forceinline__ float softplusf_(float x) { return x > 20.f ? x : log1pf(__expf(x)); }
__device__ __forceinline__ float wave_sum(float v) {
#pragma unroll
    for (int o = 1; o < 64; o <<= 1) v += __shfl_xor(v, o);
    return v;
}
__device__ __forceinline__ float grp16_sum(float v) {
#pragma unroll
    for (int o = 1; o < 16; o <<= 1) v += __shfl_xor(v, o);
    return v;
}
#define MFMA16(a, b, c) __builtin_amdgcn_mfma_f32_16x16x32_bf16((a), (b), (c), 0, 0, 0)
#define XB_TMO      128
#define XB_XCNT(j)  (256  + 64 * (j))
#define XB_XSUB(j)  (1280 + 64 * (j))
#define XB_XGEN(j)  (2304 + 64 * (j))
#define XB_TOP      3328
#define XB_TOPGEN   3392
#define XCD_BAR_WORDS 3456
#define XB_SPIN_CAP (1u << 18)

__device__ __forceinline__ unsigned xb_ld(unsigned* p)              { return __hip_atomic_load(p, __ATOMIC_RELAXED, __HIP_MEMORY_SCOPE_AGENT); }
__device__ __forceinline__ unsigned xb_add(unsigned* p, unsigned v) { return __hip_atomic_fetch_add(p, v, __ATOMIC_RELAXED, __HIP_MEMORY_SCOPE_AGENT); }
__device__ __forceinline__ unsigned xb_xcc_id() { return (unsigned)__builtin_amdgcn_s_getreg((3 << 11) | 20) & 0xFu; }
#define XB_SPIN(cond, bar) do { unsigned _sp = 0; while (cond) { __builtin_amdgcn_s_sleep(1); \
    if ((++_sp & 255u) == 0u) { if (xb_ld(&(bar)[XB_TMO])) break; if (_sp > XB_SPIN_CAP) { atomicAdd(&(bar)[XB_TMO], 1u); break; } } } } while (0)

struct XcdBarrier {
    unsigned* bar; unsigned x;
    volatile LAS unsigned* st;
};

__device__ __forceinline__ XcdBarrier xcd_barrier_post(unsigned* bar, volatile LAS unsigned* st) {
    XcdBarrier b; b.bar = bar; b.x = xb_xcc_id(); b.st = st;
    if (threadIdx.x == 0) (void)xb_add(&bar[XB_XCNT(b.x)], 1u);
    return b;
}
__device__ __forceinline__ void xcd_barrier_complete(unsigned* bar, unsigned x, unsigned& nloc, unsigned& nx) {
    const unsigned G = gridDim.x * gridDim.y * gridDim.z;
    unsigned sum, cnt, mine, sp = 0u;
    for (;;) {
        sum = 0u; cnt = 0u; mine = 0u;
#pragma unroll
        for (unsigned j = 0; j < 16; ++j) { const unsigned c = xb_ld(&bar[XB_XCNT(j)]); sum += c; cnt += (c > 0u) ? 1u : 0u; mine = (j == x) ? c : mine; }
        if (sum == G) break;
        __builtin_amdgcn_s_sleep(1);
        if ((++sp & 255u) == 0u) { if (xb_ld(&bar[XB_TMO])) break; if (sp > XB_SPIN_CAP) { atomicAdd(&bar[XB_TMO], 1u); break; } }
    }
    nloc = mine > 0u ? mine : 1u; nx = cnt > 0u ? cnt : 1u;
}

__device__ __forceinline__ void xcd_barrier(const XcdBarrier& b) {
    asm volatile("s_waitcnt vmcnt(0)" ::: "memory");
    __syncthreads();
    if (threadIdx.x == 0) {
        unsigned* bar = b.bar;
        __builtin_amdgcn_s_waitcnt(0);
        unsigned nloc = b.st[0], nx = b.st[1];
        if (nloc == 0u) { xcd_barrier_complete(bar, b.x, nloc, nx); b.st[0] = nloc; b.st[1] = nx; }
        const unsigned old = xb_add(&bar[XB_XSUB(b.x)], 1u);
        const unsigned gen = old / nloc;
        if (old + 1u == (gen + 1u) * nloc) {
            __builtin_amdgcn_fence(__ATOMIC_RELEASE, "agent");
            asm volatile("s_waitcnt vmcnt(0)" ::: "memory");
            const unsigned og = xb_add(&bar[XB_TOP], 1u);
            const unsigned tg = og / nx;
            if (og + 1u == (tg + 1u) * nx) xb_add(&bar[XB_TOPGEN], 1u);
            else XB_SPIN(xb_ld(&bar[XB_TOPGEN]) == tg, bar);
            __builtin_amdgcn_fence(__ATOMIC_ACQUIRE, "agent");
            xb_add(&bar[XB_XGEN(b.x)], 1u);
            asm volatile("s_waitcnt vmcnt(0)" ::: "memory");
        } else {
            XB_SPIN(xb_ld(&bar[XB_XGEN(b.x)]) == gen, bar);
            __builtin_amdgcn_fence(__ATOMIC_ACQUIRE, "agent");
            asm volatile("s_waitcnt vmcnt(0)" ::: "memory");
        }
    }
    __syncthreads();
}


struct Frame {
    LAS unsigned char* lds;
    int tid, lane, wave;
    int vcu, G;
};

__device__ __forceinline__ int panel_of_wg() { const int bx = blockIdx.x; return 8 * (bx & 7) + ((bx >> 3) & 7); }
__device__ __forceinline__ int panel_row0(const Frame& F) { const int bx = blockIdx.x; return 256 * panel_of_wg() + 64 * (bx >> 6) + 8 * F.wave; }
__device__ __forceinline__ gu32* panel_word(gu32* ctl, int seam, int idx) { return ctl + CW_PANEL + (seam * 66 + idx) * 64; }
#ifndef WT_ROW
#define WT_ROW 1
#endif
#ifndef WT_G3
#define WT_G3 1
#endif
#ifndef WT_OUT
#define WT_OUT 1
#endif
template <bool WT = true>
__device__ __forceinline__ void st16_wt(void* rowbase, int nbytes, int byteoff, const v4u v) {
    const __amdgpu_buffer_rsrc_t rs = __builtin_amdgcn_make_buffer_rsrc(rowbase, (short)0, nbytes, 0x00020000);
    __builtin_amdgcn_raw_buffer_store_b128(v, rs, byteoff, 0,   WT ? 16 : 0);
}
__device__ __forceinline__ void panel_publish(Frame& F, gu32* ctl, int seam, int pm, unsigned nsample, bool rel = false) {
    asm volatile("s_waitcnt vmcnt(0)" ::: "memory");
    __syncthreads();
    if (F.tid == 0) { if (rel) { __builtin_amdgcn_fence(__ATOMIC_RELEASE, "agent"); asm volatile("s_waitcnt vmcnt(0)" ::: "memory"); }
        (void)__hip_atomic_fetch_add(panel_word(ctl, seam, pm), 1u, RLX_AGENT); (void)__hip_atomic_fetch_add(panel_word(ctl, seam, 65), 1u, RLX_AGENT);
        if (nsample) (void)__hip_atomic_fetch_add(panel_word(ctl, seam, 64), nsample, RLX_AGENT); }
}
__device__ __forceinline__ void panel_wait(Frame& F, gu32* word, unsigned want, gu32* tmo) {
    if (F.wave == 0) { unsigned sp = 0;
        while ((unsigned)__builtin_amdgcn_readfirstlane(__hip_atomic_load(word, RLX_AGENT)) < want) { __builtin_amdgcn_s_sleep(1);
            if ((++sp & 255u) == 0u) { if (__builtin_amdgcn_readfirstlane(__hip_atomic_load(tmo, RLX_AGENT))) break;
                if (sp > (1u << 18)) { if (F.lane == 0) (void)__hip_atomic_fetch_add(tmo, 1u, RLX_AGENT); break; } } }
        __builtin_amdgcn_fence(__ATOMIC_ACQUIRE, "agent");
        asm volatile("s_waitcnt vmcnt(0)" ::: "memory"); }
    __syncthreads();
}

__device__ __forceinline__ void gemm_prefetch_b(LAS unsigned char* lds, const bf16* Bt, int N, int K, int G, int c, int tid, int wid) {
    pg8::StaticOrder S; S.init(MPR, N, G, c); pg8::Unit u; if (!S.next(0, u)) return;
    const size_t hstep = (size_t)pg8::HALF * K * 2;
    const char* cB = (const char*)Bt + (size_t)u.pn * (2 * hstep);
#pragma unroll
    for (int h = 0; h < 2; ++h)
#pragma unroll
        for (int i = 0; i < 2; ++i) { int R, C; pg8::stage_rc(tid * 16 + i * 8192, R, C); const int Rb = (R & ~31) + pg8::perm32(R & 31);
            __builtin_amdgcn_global_load_lds((const unsigned*)(cB + h * hstep + (size_t)(unsigned)(Rb * K + C) * 2u), (LAS unsigned*)(lds + (4 + h) * pg8::HTB + wid * 1024 + i * 8192), 16, 0, 0); }
}
__device__ __forceinline__ void xcd_barrier_pf(const XcdBarrier& b, Frame& F, const bf16* Bt, int N, int K) {
    asm volatile("s_waitcnt vmcnt(0)" ::: "memory");
    __syncthreads();
    if (F.wave != 0) gemm_prefetch_b(F.lds, Bt, N, K, F.G, (int)blockIdx.x, F.tid, F.wave);
    if (threadIdx.x == 0) {
        unsigned* bar = b.bar;
        __builtin_amdgcn_s_waitcnt(0);
        unsigned nloc = b.st[0], nx = b.st[1];
        if (nloc == 0u) { xcd_barrier_complete(bar, b.x, nloc, nx); b.st[0] = nloc; b.st[1] = nx; }
        const unsigned old = xb_add(&bar[XB_XSUB(b.x)], 1u);
        const unsigned gen = old / nloc;
        if (old + 1u == (gen + 1u) * nloc) {
            __builtin_amdgcn_fence(__ATOMIC_RELEASE, "agent");
            asm volatile("s_waitcnt vmcnt(0)" ::: "memory");
            const unsigned og = xb_add(&bar[XB_TOP], 1u);
            const unsigned tg = og / nx;
            if (og + 1u == (tg + 1u) * nx) xb_add(&bar[XB_TOPGEN], 1u);
            else XB_SPIN(xb_ld(&bar[XB_TOPGEN]) == tg, bar);
            __builtin_amdgcn_fence(__ATOMIC_ACQUIRE, "agent");
            xb_add(&bar[XB_XGEN(b.x)], 1u);
            asm volatile("s_waitcnt vmcnt(0)" ::: "memory");
        } else {
            XB_SPIN(xb_ld(&bar[XB_XGEN(b.x)]) == gen, bar);
            __builtin_amdgcn_fence(__ATOMIC_ACQUIRE, "agent");
            asm volatile("s_waitcnt vmcnt(0)" ::: "memory");
        }
    }
    __syncthreads();
}

template <class Fn> struct EpiGen {
    static constexpr bool PERM = true, AFTER_DRAIN = false;
    Fn f;
    __device__ __forceinline__ void operator()(const pg8::f32x4 (&acc)[2][2][4][2], const pg8::Unit& u, int wr, int wc, int fr, int fq) const {
        const int ca = u.pn * 256 + wc * 32 + 8 * fq;
#pragma unroll
        for (int ai = 0; ai < 2; ++ai)
#pragma unroll
            for (int m = 0; m < 4; ++m) {
                const int row = u.pm * 256 + ai * 128 + wr * 64 + m * 16 + fr;
                f.emit(row, ca, ca + 128, acc[ai][0][m][0], acc[ai][0][m][1], acc[ai][1][m][0], acc[ai][1][m][1]);
            }
    }
};
__device__ __forceinline__ void st8bf(bf16* p, const f32x4 a, const f32x4 b) { *(GAS v4u*)p = pack8v(a, b); }
__device__ __forceinline__ f32x4 silu4(const f32x4 a) { f32x4 r; r[0] = siluf_(a[0]); r[1] = siluf_(a[1]); r[2] = siluf_(a[2]); r[3] = siluf_(a[3]); return r; }

struct EmitRetIn {
    bf16 *Q, *K, *V, *SG;
    __device__ __forceinline__ void emit(int row, int ca, int cb, const f32x4 a0, const f32x4 a1, const f32x4 b0, const f32x4 b1) const {
        const int pn = ca >> 8, ch = ca & 255;
        if (pn < 8) {
            const float pos = row < MPR ? (float)(row & (SEQ - 1)) : 16384.f;
            const float sc = pn < 4 ? 1.f : 0.0625f;
            float x1[8] = {a0[0], a0[1], a0[2], a0[3], a1[0], a1[1], a1[2], a1[3]}, x2[8] = {b0[0], b0[1], b0[2], b0[3], b1[0], b1[1], b1[2], b1[3]}, o1[8], o2[8];
#pragma unroll
            for (int e = 0; e < 8; ++e) {
                const float inv = exp2f(-(float)(ch + e) * (13.287712379549449f / 128.f));
                float t = pos * inv * 0.15915494309189535f; t -= floorf(t);
                const float s = __builtin_amdgcn_sinf(t), c = __builtin_amdgcn_cosf(t);
                o1[e] = (x1[e] * c - x2[e] * s) * sc; o2[e] = (x2[e] * c + x1[e] * s) * sc;
            }
            bf16* dst = (pn < 4 ? Q : K) + (size_t)row * 1024 + (pn & 3) * 256 + ch;
            *(GAS v4u*)dst = pack8(o1); *(GAS v4u*)(dst + 128) = pack8(o2);
        } else if (pn < 16) {
            bf16* dst = V + (size_t)row * 2048 + (pn - 8) * 256 + ch; st8bf(dst, a0, a1); st8bf(dst + 128, b0, b1);
        } else {
            bf16* dst = SG + (size_t)row * 2048 + (pn - 16) * 256 + ch; st8bf(dst, silu4(a0), silu4(a1)); st8bf(dst + 128, silu4(b0), silu4(b1));
        }
    }
};
struct EmitSsdIn {
    bf16 *SZ, *XBC;
    __device__ __forceinline__ void emit(int row, int ca, int cb, const f32x4 a0, const f32x4 a1, const f32x4 b0, const f32x4 b1) const {
        const int pn = ca >> 8, ch = ca & 255;
        if (pn < 8) { bf16* dst = SZ + (size_t)row * 2048 + pn * 256 + ch; st8bf(dst, silu4(a0), silu4(a1)); st8bf(dst + 128, silu4(b0), silu4(b1)); }
        else { bf16* dst = XBC + (size_t)row * 3072 + (pn - 8) * 256 + ch; st8bf(dst, a0, a1); st8bf(dst + 128, b0, b1); }
    }
};
struct EmitDt {
    float* DT;
    __device__ __forceinline__ void emit(int row, int ca, int cb, const f32x4 a0, const f32x4 a1, const f32x4 b0, const f32x4 b1) const {
        float* d = DT + (size_t)row * 32; *(GAS f32x4*)(d + (ca - SSD_INM)) = a0; *(GAS f32x4*)(d + (ca - SSD_INM) + 4) = a1; *(GAS f32x4*)(d + (cb - SSD_INM)) = b0; *(GAS f32x4*)(d + (cb - SSD_INM) + 4) = b1;
    }
};
struct EmitHgIn {
    bf16 *HQ, *HV, *HSG; float* LA; const float* lb;
    __device__ __forceinline__ f32x4 logf4(const f32x4 x, const f32x4 l) const { f32x4 r;
#pragma unroll
        for (int e = 0; e < 4; ++e) r[e] = logf(l[e] + (1.f - l[e]) * sigmoidf_(x[e]));
        return r; }
    __device__ __forceinline__ void emit(int row, int ca, int cb, const f32x4 a0, const f32x4 a1, const f32x4 b0, const f32x4 b1) const {
        const int pn = ca >> 8, ch = ca & 255;
        if (pn < 4) { bf16* dst = HQ + (size_t)row * 1024 + pn * 256 + ch; const float s = 0.08838834764831845f; st8bf(dst, silu4(a0) * s, silu4(a1) * s); st8bf(dst + 128, silu4(b0) * s, silu4(b1) * s); }
        else if (pn < 8) { const int col = (pn - 4) * 256 + ch; float* dst = LA + (size_t)row * 1024 + col;
            const f32x4 l0 = *(const GAS f32x4*)(lb + col), l1 = *(const GAS f32x4*)(lb + col + 4), l2 = *(const GAS f32x4*)(lb + col + 128), l3 = *(const GAS f32x4*)(lb + col + 132);
            const f32x4 r0 = logf4(a0, l0), r1 = logf4(a1, l1), r2 = logf4(b0, l2), r3 = logf4(b1, l3);
            *(GAS f32x4*)dst = r0; *(GAS f32x4*)(dst + 4) = r1; *(GAS f32x4*)(dst + 128) = r2; *(GAS f32x4*)(dst + 132) = r3; }
        else if (pn < 12) { bf16* dst = HV + (size_t)row * 1024 + (pn - 8) * 256 + ch; st8bf(dst, a0, a1); st8bf(dst + 128, b0, b1); }
        else { bf16* dst = HSG + (size_t)row * 1024 + (pn - 12) * 256 + ch; st8bf(dst, silu4(a0), silu4(a1)); st8bf(dst + 128, silu4(b0), silu4(b1)); }
    }
};
struct EmitOut {
    bf16* OUT;
    __device__ __forceinline__ void emit(int row, int ca, int cb, const f32x4 a0, const f32x4 a1, const f32x4 b0, const f32x4 b1) const {
        if (PANEL_SYNC) { const int o_ = row * 2048; st16_wt<WT_OUT>(OUT, MT * 1024 * 2, o_ + ca * 2, pack8v(a0, a1)); st16_wt<WT_OUT>(OUT, MT * 1024 * 2, o_ + cb * 2, pack8v(b0, b1)); }
        else { bf16* dst = OUT + (size_t)row * 1024; st8bf(dst + ca, a0, a1); st8bf(dst + cb, b0, b1); }
    }
};
struct EmitFfnIn {
    bf16* ACT;
    __device__ __forceinline__ void emit(int row, int ca, int cb, const f32x4 a0, const f32x4 a1, const f32x4 b0, const f32x4 b1) const {
        if (PANEL_SYNC) st16_wt<WT_G3>(ACT, MT * DFF * 2, (row * DFF + (ca >> 8) * 128 + (ca & 255)) * 2, pack8v(silu4(a0) * b0, silu4(a1) * b1));
        else { bf16* dst = ACT + (size_t)row * DFF + (ca >> 8) * 128 + (ca & 255); st8bf(dst, silu4(a0) * b0, silu4(a1) * b1); }
    }
};
struct EmitMod {
    float* MOD; const float* bias;
    __device__ __forceinline__ void emit(int row, int ca, int cb, const f32x4 a0, const f32x4 a1, const f32x4 b0, const f32x4 b1) const {
        float* d = MOD + (size_t)row * NMODALL;
        const f32x4 q0 = *(const GAS f32x4*)(bias + ca), q1 = *(const GAS f32x4*)(bias + ca + 4), q2 = *(const GAS f32x4*)(bias + cb), q3 = *(const GAS f32x4*)(bias + cb + 4);
        *(GAS f32x4*)(d + ca) = a0 + q0; *(GAS f32x4*)(d + ca + 4) = a1 + q1; *(GAS f32x4*)(d + cb) = b0 + q2; *(GAS f32x4*)(d + cb + 4) = b1 + q3;
    }
};

__device__ __forceinline__ bf16x8 frag_perm(const bf16x8 v, const int addr) {
    const v4u u = __builtin_bit_cast(v4u, v); v4u r;
    r.x = (unsigned)__builtin_amdgcn_ds_bpermute(addr, (int)u.x); r.y = (unsigned)__builtin_amdgcn_ds_bpermute(addr, (int)u.y);
    r.z = (unsigned)__builtin_amdgcn_ds_bpermute(addr, (int)u.z); r.w = (unsigned)__builtin_amdgcn_ds_bpermute(addr, (int)u.w);
    return __builtin_bit_cast(bf16x8, r);
}
template <int NMT, class Fn>
__device__ __forceinline__ void skinny_gemm(Frame& F, const bf16* A, int K, int nrg, int nrows, int rowbase, const bf16* Bt, int ncu, bool dtmode, const Fn& f, int wg0, int span) {
    const int w = F.wave, lane = F.lane, fr = lane & 15, fq = lane >> 4;
    const int TP = K >> 6, pb = TP >> 3, prem = TP & 7, npairs = pb + (w < prem ? 1 : 0), kw0 = (w * pb + (w < prem ? w : prem)) * 64;
    constexpr int R = NMT * 16;
    LAS unsigned char* red = F.lds;
    const int nun = nrg * ncu, me = (int)blockIdx.x - wg0;
    if (me >= 0 && me < span) {
    for (int u = me; u < nun; u += span) {
        const int rg = u / ncu, cu = u - rg * ncu;
        int ca, cb; if (dtmode) { ca = SSD_INM; cb = SSD_INM + 16; } else { ca = 256 * (cu >> 3) + 16 * (cu & 7); cb = ca + 128; }
        const int lrow = lane >> 2, lpc = lane & 3;
        const bf16* ap = A + (size_t)(rg * R + lrow) * K + kw0 + lpc * 8;
        const bf16* bpa = Bt + (size_t)(ca + lrow) * K + kw0 + lpc * 8;
        const bf16* bpb = Bt + (size_t)(cb + lrow) * K + kw0 + lpc * 8;
        const int paddr = (4 * fr + fq) * 4;
        f32x4 acc[NMT][2];
#pragma unroll
        for (int mt = 0; mt < NMT; ++mt) { acc[mt][0] = (f32x4){0.f, 0.f, 0.f, 0.f}; acc[mt][1] = (f32x4){0.f, 0.f, 0.f, 0.f}; }
        constexpr int DEPTH = (NMT >= 8) ? 1 : 2;
        bf16x8 ra[DEPTH][2][NMT], rb0[DEPTH][2], rb1[DEPTH][2];
#define SK_LOAD(d_, pp_) do { _Pragma("unroll") for (int h_ = 0; h_ < 2; ++h_) { const int k_ = (pp_) * 64 + h_ * 32; \
            rb0[d_][h_] = *(const GAS bf16x8*)(bpa + k_); rb1[d_][h_] = *(const GAS bf16x8*)(bpb + k_); \
            _Pragma("unroll") for (int mt_ = 0; mt_ < NMT; ++mt_) ra[d_][h_][mt_] = *(const GAS bf16x8*)(ap + (size_t)mt_ * 16 * K + k_); } } while (0)
#define SK_MMA(d_) do { _Pragma("unroll") for (int h_ = 0; h_ < 2; ++h_) { const bf16x8 fb0_ = frag_perm(rb0[d_][h_], paddr), fb1_ = frag_perm(rb1[d_][h_], paddr); \
            _Pragma("unroll") for (int mt_ = 0; mt_ < NMT; ++mt_) { const bf16x8 fa_ = frag_perm(ra[d_][h_][mt_], paddr); \
                acc[mt_][0] = MFMA16(fb0_, fa_, acc[mt_][0]); acc[mt_][1] = MFMA16(fb1_, fa_, acc[mt_][1]); } } } while (0)
        if constexpr (DEPTH == 1) {
            SK_LOAD(0, 0);
            for (int pp = 0; pp < npairs; ++pp) { SK_MMA(0); SK_LOAD(0, pp + 1 < npairs ? pp + 1 : pp); }
        } else {
            SK_LOAD(0, 0); SK_LOAD(1, npairs > 1 ? 1 : 0);
            for (int pp = 0; pp < npairs; pp += 2) {
                SK_MMA(0); SK_LOAD(0, pp + 2 < npairs ? pp + 2 : pp);
                if (pp + 1 < npairs) { SK_MMA(1); SK_LOAD(1, pp + 3 < npairs ? pp + 3 : pp + 1); }
            }
        }
#undef SK_LOAD
#undef SK_MMA
        __syncthreads();
#pragma unroll
        for (int mt = 0; mt < NMT; ++mt)
#pragma unroll
            for (int nt = 0; nt < 2; ++nt) { const int row = mt * 16 + fr; *(LAS f32x4*)(red + ((w * R + row) * 8 + ((4 * nt + fq) ^ (row & 7))) * 16) = acc[mt][nt]; }
        __syncthreads();
        if (F.tid < 2 * R) {
            const int row = F.tid >> 1, hf = F.tid & 1;
            f32x4 va0 = (f32x4){0.f, 0.f, 0.f, 0.f}, va1 = va0, vb0 = va0, vb1 = va0;
#pragma unroll
            for (int ww = 0; ww < 8; ++ww) { const LAS unsigned char* pr = red + (ww * R + row) * 128;
                va0 += *(const LAS f32x4*)(pr + ((2 * hf) ^ (row & 7)) * 16); va1 += *(const LAS f32x4*)(pr + ((2 * hf + 1) ^ (row & 7)) * 16);
                vb0 += *(const LAS f32x4*)(pr + ((4 + 2 * hf) ^ (row & 7)) * 16); vb1 += *(const LAS f32x4*)(pr + ((5 + 2 * hf) ^ (row & 7)) * 16); }
            if (rg * R + row < nrows) f.emit(rowbase + rg * R + row, ca + hf * 8, cb + hf * 8, va0, va1, vb0, vb1);
        }
    }
    }
    __syncthreads();
}
static_assert(8 * 128 * 128 <= SCR_BYTES, "skinny reduction buffer");

__device__ __forceinline__ int cond_of_row(int row) { return row < MPR ? (row >> 11) : (BP + row - MPR); }
#define RNCOL(lane_, k_) (8 * (lane_) + 512 * ((k_) >> 1) + 4 * ((k_) & 1))
struct RnParams { f32x4 gwp[4], a[4], sh[4]; };
template <int MODE>
__device__ __forceinline__ void rn_load_params(RnParams& P, const float* modr, const float* wpost, int goff, const float* wpre, int shoff, int scoff, int lane) {
#pragma unroll
    for (int j = 0; j < 4; ++j) { const int c = RNCOL(lane, j);
        if (MODE != 0) P.gwp[j] = *(const GAS f32x4*)(modr + goff + c) * *(const GAS f32x4*)(wpost + c);
        if (MODE != 2) { P.a[j] = *(const GAS f32x4*)(wpre + c) * (*(const GAS f32x4*)(modr + scoff + c) + 1.f); P.sh[j] = *(const GAS f32x4*)(modr + shoff + c); } }
}
template <int MODE>
__device__ __forceinline__ void rn_row(const RnParams& P, f32x4 (&x)[4], const v2u (&yw)[4], bf16* Xbrow, float* Xfrow, bf16* Hrow, int lane, bool wt = false) {
    if (MODE != 0) {
        f32x4 y[4]; float ss = 0.f;
#pragma unroll
        for (int j = 0; j < 4; ++j) { y[j] = (f32x4){bflo(yw[j].x), bfhi(yw[j].x), bflo(yw[j].y), bfhi(yw[j].y)}; ss += (y[j][0] * y[j][0] + y[j][1] * y[j][1]) + (y[j][2] * y[j][2] + y[j][3] * y[j][3]); }
        const float r1 = rsqrtf(wave_sum(ss) * (1.f / D) + EPS);
#pragma unroll
        for (int j = 0; j < 4; ++j) x[j] = x[j] + P.gwp[j] * (y[j] * r1);
    }
#pragma unroll
    for (int j = 0; j < 4; ++j) { if (MODE == 2) *(GAS f32x4*)(Xfrow + RNCOL(lane, j)) = x[j]; else *(GAS v2u*)(Xbrow + RNCOL(lane, j)) = pack4v(x[j]); }
    if (MODE != 2) {
        float s2 = 0.f;
#pragma unroll
        for (int j = 0; j < 4; ++j) s2 += (x[j][0] * x[j][0] + x[j][1] * x[j][1]) + (x[j][2] * x[j][2] + x[j][3] * x[j][3]);
        const float r2 = rsqrtf(wave_sum(s2) * (1.f / D) + EPS);
#pragma unroll
        for (int j = 0; j < 4; ++j) x[j] = (x[j] * r2) * P.a[j] + P.sh[j];
        if (wt) { st16_wt<WT_ROW>(Hrow, D * 2, 16 * lane, pack8v(x[0], x[1])); st16_wt<WT_ROW>(Hrow, D * 2, 1024 + 16 * lane, pack8v(x[2], x[3])); }
        else {
#pragma unroll
            for (int j = 0; j < 4; ++j) *(GAS v2u*)(Hrow + RNCOL(lane, j)) = pack4v(x[j]); }
    }
}
__device__ __forceinline__ f32x4 ld_x4(const bf16* p) { const v2u w = *(const GAS v2u*)p; return (f32x4){bflo(w.x), bfhi(w.x), bflo(w.y), bfhi(w.y)}; }
template <int MODE>
__device__ __forceinline__ void resnorm_phase(Frame& F, const float* xp, const float* xs, bf16* Xb, float* Xf, const bf16* Y, bf16* H, const float* MOD,
                                              const float* wpost, int goff, const float* wpre, int shoff, int scoff, bool ps = false, gu32* swait = nullptr, gu32* tmo = nullptr) {
    const int gw = F.vcu * NWAVES + F.wave, NGW = F.G * NWAVES, lane = F.lane;
    const int per = (MPR + NGW - 1) / NGW;
    RnParams P;
    const int srow_ = MPR + gw; const bool has_s = (per == 8) && srow_ < MT;
    f32x4 sx_[4]; v2u sy_[4];
#pragma unroll
    for (int j = 0; j < 4; ++j) { sx_[j] = (f32x4){0.f, 0.f, 0.f, 0.f}; sy_[j] = (v2u){0u, 0u}; }
    if (has_s && swait != nullptr) panel_wait(F, swait, 256u, tmo);
    if (has_s) {
#pragma unroll
        for (int j = 0; j < 4; ++j) { const int c_ = RNCOL(lane, j); sx_[j] = (MODE == 0) ? *(const GAS f32x4*)(xs + (size_t)(srow_ - MPR) * D + c_) : ld_x4(Xb + (size_t)srow_ * D + c_); if (MODE != 0) sy_[j] = *(const GAS v2u*)(Y + (size_t)srow_ * D + c_); } }
    if (per == 8) {
        const int r0 = ps ? panel_row0(F) : gw * 8;
        rn_load_params<MODE>(P, MOD + (size_t)(r0 >> 11) * NMODALL, wpost, goff, wpre, shoff, scoff, lane);
        f32x4 qx[3][4]; v2u qy[3][4];
#define RN_FETCH(s_, row_) do { _Pragma("unroll") for (int j_ = 0; j_ < 4; ++j_) { const size_t o_ = (size_t)(row_) * D + RNCOL(lane, j_); \
            qx[s_][j_] = (MODE == 0) ? *(const GAS f32x4*)(xp + o_) : ld_x4(Xb + o_); qy[s_][j_] = (v2u){0u, 0u}; if (MODE != 0) qy[s_][j_] = *(const GAS v2u*)(Y + o_); } } while (0)
        RN_FETCH(0, r0); RN_FETCH(1, r0 + 1); RN_FETCH(2, r0 + 2);
#pragma unroll
        for (int i = 0; i < 8; ++i) {
            f32x4 x[4]; v2u yw[4];
#pragma unroll
            for (int j = 0; j < 4; ++j) { x[j] = qx[i % 3][j]; yw[j] = qy[i % 3][j]; }
            if (i + 3 < 8) RN_FETCH(i % 3, r0 + i + 3);
            rn_row<MODE>(P, x, yw, Xb + (size_t)(r0 + i) * D, Xf + (size_t)(r0 + i) * D, H + (size_t)(r0 + i) * D, lane, ps);
        }
#undef RN_FETCH
    } else
    for (int r0 = gw * per; r0 < MPR; r0 += NGW * per) {
        const int r1 = (r0 + per < MPR) ? r0 + per : MPR;
        int cond = r0 >> 11;
        rn_load_params<MODE>(P, MOD + (size_t)cond * NMODALL, wpost, goff, wpre, shoff, scoff, lane);
        f32x4 xn[4]; v2u yn[4];
#pragma unroll
        for (int j = 0; j < 4; ++j) { const size_t o_ = (size_t)r0 * D + RNCOL(lane, j); xn[j] = (MODE == 0) ? *(const GAS f32x4*)(xp + o_) : ld_x4(Xb + o_); yn[j] = (v2u){0u, 0u}; if (MODE != 0) yn[j] = *(const GAS v2u*)(Y + o_); }
        for (int row = r0; row < r1; ++row) {
            f32x4 x[4]; v2u yw[4];
#pragma unroll
            for (int j = 0; j < 4; ++j) { x[j] = xn[j]; yw[j] = yn[j]; }
            if ((row >> 11) != cond) { cond = row >> 11; rn_load_params<MODE>(P, MOD + (size_t)cond * NMODALL, wpost, goff, wpre, shoff, scoff, lane); }
            if (row + 1 < r1) {
#pragma unroll
                for (int j = 0; j < 4; ++j) { const size_t o_ = (size_t)(row + 1) * D + RNCOL(lane, j); xn[j] = (MODE == 0) ? *(const GAS f32x4*)(xp + o_) : ld_x4(Xb + o_); if (MODE != 0) yn[j] = *(const GAS v2u*)(Y + o_); } }
            rn_row<MODE>(P, x, yw, Xb + (size_t)row * D, Xf + (size_t)row * D, H + (size_t)row * D, lane);
        }
    }
    if (has_s) {
        rn_load_params<MODE>(P, MOD + (size_t)cond_of_row(srow_) * NMODALL, wpost, goff, wpre, shoff, scoff, lane);
        rn_row<MODE>(P, sx_, sy_, Xb + (size_t)srow_ * D, Xf + (size_t)srow_ * D, H + (size_t)srow_ * D, lane, ps);
    } else if (per != 8)
    for (int row = MPR + gw; row < MT; row += NGW) {
        rn_load_params<MODE>(P, MOD + (size_t)cond_of_row(row) * NMODALL, wpost, goff, wpre, shoff, scoff, lane);
        f32x4 x[4]; v2u yw[4];
#pragma unroll
        for (int j = 0; j < 4; ++j) { const int c_ = RNCOL(lane, j); x[j] = (MODE == 0) ? *(const GAS f32x4*)(xs + (size_t)(row - MPR) * D + c_) : ld_x4(Xb + (size_t)row * D + c_); yw[j] = (v2u){0u, 0u}; if (MODE != 0) yw[j] = *(const GAS v2u*)(Y + (size_t)row * D + c_); }
        rn_row<MODE>(P, x, yw, Xb + (size_t)row * D, Xf + (size_t)row * D, H + (size_t)row * D, lane);
    }
}
template <int MIX>
__device__ __forceinline__ void gatenorm_phase(Frame& F, const bf16* RO, const bf16* GATE, bf16* GO, const float* nw, bool ps = false) {
    const int gw = F.vcu * NWAVES + F.wave, NGW = F.G * NWAVES, lane = F.lane;
    constexpr int W = (MIX == 2) ? 1024 : 2048, NJ = W / 512;
    const int per = (MPR + NGW - 1) / NGW;
    float wv[NJ][8];
#pragma unroll
    for (int j = 0; j < NJ; ++j)
#pragma unroll
        for (int e = 0; e < 8; ++e) { const int c = 8 * lane + 512 * j + e; wv[j][e] = (MIX == 1) ? nw[c] : ((MIX == 2) ? nw[c & 127] : 1.f); }
    const int srow_ = MPR + gw; const bool has_s = (per == 8) && srow_ < MT;
    v4u so_[NJ], sg_[NJ];
#pragma unroll
    for (int j = 0; j < NJ; ++j) { so_[j] = (v4u){0u, 0u, 0u, 0u}; sg_[j] = so_[j]; }
    if (has_s) {
#pragma unroll
        for (int j = 0; j < NJ; ++j) { so_[j] = *(const GAS v4u*)(RO + (size_t)srow_ * W + 8 * lane + 512 * j); sg_[j] = *(const GAS v4u*)(GATE + (size_t)srow_ * W + 8 * lane + 512 * j); } }
    if (per == 8) {
        const int r0 = ps ? panel_row0(F) : gw * 8;
        v4u qo[3][NJ], qg[3][NJ];
#define GN_FETCH(s_, row_) do { _Pragma("unroll") for (int j_ = 0; j_ < NJ; ++j_) { qo[s_][j_] = *(const GAS v4u*)(RO + (size_t)(row_) * W + 8 * lane + 512 * j_); qg[s_][j_] = *(const GAS v4u*)(GATE + (size_t)(row_) * W + 8 * lane + 512 * j_); } } while (0)
        GN_FETCH(0, r0); GN_FETCH(1, r0 + 1); GN_FETCH(2, r0 + 2);
#pragma unroll
        for (int i = 0; i < 8; ++i) {
            v4u oc[NJ], gc[NJ];
#pragma unroll
            for (int j = 0; j < NJ; ++j) { oc[j] = qo[i % 3][j]; gc[j] = qg[i % 3][j]; }
            if (i + 3 < 8) GN_FETCH(i % 3, r0 + i + 3);
            float u[NJ][8], r[NJ];
#pragma unroll
            for (int j = 0; j < NJ; ++j) {
                float o[8], g[8]; unpack8(oc[j], o); unpack8(gc[j], g);
                float ss = 0.f;
#pragma unroll
                for (int e = 0; e < 8; ++e) { u[j][e] = o[e] * g[e]; ss += (MIX == 1) ? u[j][e] * u[j][e] : o[e] * o[e]; }
                if (MIX == 2) r[j] = rsqrtf(grp16_sum(ss) * (1.f / 128.f) + EPS); else r[j] = rsqrtf(wave_sum(ss) * (1.f / 512.f) + EPS);
            }
#pragma unroll
            for (int j = 0; j < NJ; ++j) { float v[8];
#pragma unroll
                for (int e = 0; e < 8; ++e) v[e] = u[j][e] * r[j] * wv[j][e];
                if (ps) st16_wt<WT_ROW>(GO + (size_t)(r0 + i) * W, W * 2, (8 * lane + 512 * j) * 2, pack8(v)); else *(GAS v4u*)(GO + (size_t)(r0 + i) * W + 8 * lane + 512 * j) = pack8(v); }
        }
#undef GN_FETCH
        if (has_s) {
            float u[NJ][8], r[NJ];
#pragma unroll
            for (int j = 0; j < NJ; ++j) {
                float o[8], g[8]; unpack8(so_[j], o); unpack8(sg_[j], g);
                float ss = 0.f;
#pragma unroll
                for (int e = 0; e < 8; ++e) { u[j][e] = o[e] * g[e]; ss += (MIX == 1) ? u[j][e] * u[j][e] : o[e] * o[e]; }
                if (MIX == 2) r[j] = rsqrtf(grp16_sum(ss) * (1.f / 128.f) + EPS); else r[j] = rsqrtf(wave_sum(ss) * (1.f / 512.f) + EPS);
            }
#pragma unroll
            for (int j = 0; j < NJ; ++j) { float v[8];
#pragma unroll
                for (int e = 0; e < 8; ++e) v[e] = u[j][e] * r[j] * wv[j][e];
                if (ps) st16_wt<WT_ROW>(GO + (size_t)srow_ * W, W * 2, (8 * lane + 512 * j) * 2, pack8(v)); else *(GAS v4u*)(GO + (size_t)srow_ * W + 8 * lane + 512 * j) = pack8(v); }
        }
    }
#pragma unroll 1
    for (int seg = (per == 8) ? 2 : 0; seg < 2; ++seg) {
        const int r0 = seg == 0 ? gw * per : MPR + gw;
        const int r1 = seg == 0 ? ((r0 + per < MPR) ? r0 + per : MPR) : ((r0 < MT) ? r0 + 1 : r0);
        if (r0 >= r1) continue;
        v4u on[NJ], gn[NJ];
#pragma unroll
        for (int j = 0; j < NJ; ++j) { on[j] = *(const GAS v4u*)(RO + (size_t)r0 * W + 8 * lane + 512 * j); gn[j] = *(const GAS v4u*)(GATE + (size_t)r0 * W + 8 * lane + 512 * j); }
        for (int row = r0; row < r1; ++row) {
            v4u oc[NJ], gc[NJ];
#pragma unroll
            for (int j = 0; j < NJ; ++j) { oc[j] = on[j]; gc[j] = gn[j]; }
            if (row + 1 < r1) {
#pragma unroll
                for (int j = 0; j < NJ; ++j) { on[j] = *(const GAS v4u*)(RO + (size_t)(row + 1) * W + 8 * lane + 512 * j); gn[j] = *(const GAS v4u*)(GATE + (size_t)(row + 1) * W + 8 * lane + 512 * j); } }
            float u[NJ][8], r[NJ];
#pragma unroll
            for (int j = 0; j < NJ; ++j) {
                float o[8], g[8]; unpack8(oc[j], o); unpack8(gc[j], g);
                float ss = 0.f;
#pragma unroll
                for (int e = 0; e < 8; ++e) { u[j][e] = o[e] * g[e]; ss += (MIX == 1) ? u[j][e] * u[j][e] : o[e] * o[e]; }
                if (MIX == 2) r[j] = rsqrtf(grp16_sum(ss) * (1.f / 128.f) + EPS); else r[j] = rsqrtf(wave_sum(ss) * (1.f / 512.f) + EPS);
            }
#pragma unroll
            for (int j = 0; j < NJ; ++j) { float v[8];
#pragma unroll
                for (int e = 0; e < 8; ++e) v[e] = u[j][e] * r[j] * wv[j][e];
                *(GAS v4u*)(GO + (size_t)row * W + 8 * lane + 512 * j) = pack8(v); }
        }
    }
}

template <int OFF> __device__ __forceinline__ bf16x8 tr_frag(unsigned addr) {
    s16x4 lo, hi;
    asm volatile("ds_read_b64_tr_b16 %0, %2\n\tds_read_b64_tr_b16 %1, %2 offset:%3\n\ts_waitcnt lgkmcnt(0)" : "=&v"(lo), "=&v"(hi) : "v"(addr), "i"(OFF) : "memory");
    return __builtin_shufflevector(lo, hi, 0, 1, 2, 3, 4, 5, 6, 7);
}
template <int OFF> __device__ __forceinline__ void tr_frag2(unsigned a0, unsigned a1, bf16x8& f0, bf16x8& f1) {
    s16x4 l0, h0, l1, h1;
    asm volatile("ds_read_b64_tr_b16 %0, %4\n\tds_read_b64_tr_b16 %1, %4 offset:%6\n\tds_read_b64_tr_b16 %2, %5\n\tds_read_b64_tr_b16 %3, %5 offset:%6\n\ts_waitcnt lgkmcnt(0)"
                 : "=&v"(l0), "=&v"(h0), "=&v"(l1), "=&v"(h1) : "v"(a0), "v"(a1), "i"(OFF) : "memory");
    f0 = __builtin_shufflevector(l0, h0, 0, 1, 2, 3, 4, 5, 6, 7); f1 = __builtin_shufflevector(l1, h1, 0, 1, 2, 3, 4, 5, 6, 7);
}

#define LDS_BARRIER() do { asm volatile("s_waitcnt lgkmcnt(0)" ::: "memory"); __builtin_amdgcn_s_barrier(); asm volatile("" ::: "memory"); } while (0)
#define TRRD(dst, addr, off) asm volatile("ds_read_b64_tr_b16 %0, %1 offset:%2" : "=&v"(dst) : "v"(addr), "i"(off) : "memory")
#define TR_WAIT() do { asm volatile("s_waitcnt lgkmcnt(0)" ::: "memory"); __builtin_amdgcn_sched_barrier(0); } while (0)
#define TR_JOIN(lo, hi) __builtin_shufflevector(lo, hi, 0, 1, 2, 3, 4, 5, 6, 7)
template <class Cf>
__device__ __forceinline__ void rec_step_a(LAS unsigned char* lds, const int w, const int lane, f32x4 (&S)[Cf::KPW][Cf::VS / 16], const LAS float* cum, f32x4 (&O)[(Cf::VS / 16 * Cf::C / 16 + 7) / 8]) {
    constexpr int C = Cf::C, KD = Cf::KD, VS = Cf::VS, NIT = C / 16, NJT = C / 16, NVT = VS / 16, KSK = KD / 32, KSC = C / 32;
    constexpr int RSK = Cf::RSK, RSV = Cf::RSV, RSP = Cf::RSP;
    constexpr bool CH = Cf::CH;
    const int fr = lane & 15, fq = lane >> 4, q4 = fr >> 2, p4 = fr & 3;
    const unsigned lbase = (unsigned)(size_t)lds;
    constexpr int NP = NIT * NJT, PPW = (NP + 7) / 8, NO = NVT * NIT, OPW = (NO + 7) / 8;
    static_assert((NIT == 4 && NVT == 4) || (NP <= 8 && NO <= 8), "tile deal");
    constexpr bool SHQ = (NIT == 4) && !CH;
    const int it = (NIT == 4) ? (w & 3) : (w / NJT);
    if constexpr (SHQ) {
        f32x4 p[2] = {(f32x4){0.f, 0.f, 0.f, 0.f}, (f32x4){0.f, 0.f, 0.f, 0.f}};
        f32x4 o2[2] = {(f32x4){0.f, 0.f, 0.f, 0.f}, (f32x4){0.f, 0.f, 0.f, 0.f}};
        const int j0 = w >> 2;
#pragma unroll 4
        for (int ks = 0; ks < KSK; ++ks) {
            const bf16x8 qf = *(const LAS bf16x8*)(lds + Cf::QA + (16 * it + fr) * RSK + (32 * ks + 8 * fq) * 2);
#pragma unroll
            for (int tt = 0; tt < 2; ++tt) { const int jt = j0 + 2 * tt;
                if (jt <= it) { const bf16x8 a = *(const LAS bf16x8*)(lds + Cf::KA + (16 * jt + fr) * RSK + (32 * ks + 8 * fq) * 2); p[tt] = MFMA16(a, qf, p[tt]); }
                const bf16x8 s = *(const LAS bf16x8*)(lds + Cf::ST + (16 * jt + fr) * RSK + (32 * ks + 8 * fq) * 2); o2[tt] = MFMA16(s, qf, o2[tt]); }
        }
        const int i = 16 * it + fr; const float ci = cum[i], ei = __expf(ci);
#pragma unroll
        for (int tt = 0; tt < 2; ++tt) { const int jt = j0 + 2 * tt;
#pragma unroll
            for (int r = 0; r < 4; ++r) { const int j = 16 * jt + 4 * fq + r; const float e = __expf(fminf(ci - cum[j], 0.f)); p[tt][r] = (j <= i) ? p[tt][r] * e : 0.f; }
            *(LAS v2u*)(lds + Cf::PM + (16 * it + fr) * RSP + (16 * jt + 4 * fq) * 2) = pack4v(p[tt]);
            O[tt] = o2[tt] * ei; }
    } else {
#pragma unroll
        for (int tt = 0; tt < PPW; ++tt) { const int t = w + 8 * tt;
            if (t < NP) { const int it1 = t / NJT, jt = t % NJT;
                f32x4 p = (f32x4){0.f, 0.f, 0.f, 0.f};
                if (jt <= it1) {
#pragma unroll
                    for (int ks = 0; ks < KSK; ++ks) {
                        const bf16x8 a = *(const LAS bf16x8*)(lds + Cf::KA + (16 * jt + fr) * RSK + (32 * ks + 8 * fq) * 2);
                        const bf16x8 b = *(const LAS bf16x8*)(lds + Cf::QA + (16 * it1 + fr) * RSK + (32 * ks + 8 * fq) * 2);
                        p = MFMA16(a, b, p); }
                    const int i = 16 * it1 + fr;
                    if (!CH) { const float ci = cum[i];
#pragma unroll
                        for (int r = 0; r < 4; ++r) { const int j = 16 * jt + 4 * fq + r; const float e = __expf(fminf(ci - cum[j], 0.f)); p[r] = (j <= i) ? p[r] * e : 0.f; } }
                    else {
#pragma unroll
                        for (int r = 0; r < 4; ++r) { const int j = 16 * jt + 4 * fq + r; p[r] = (j <= i) ? p[r] : 0.f; } }
                }
                *(LAS v2u*)(lds + Cf::PM + (16 * it1 + fr) * RSP + (16 * jt + 4 * fq) * 2) = pack4v(p);
            } }
#pragma unroll
        for (int tt = 0; tt < OPW; ++tt) { const int t = w + 8 * tt; O[tt] = (f32x4){0.f, 0.f, 0.f, 0.f};
            if (t < NO) { const int vt = t / NIT, it3 = t % NIT; f32x4 o = (f32x4){0.f, 0.f, 0.f, 0.f};
#pragma unroll
                for (int ks = 0; ks < KSK; ++ks) {
                    const bf16x8 a = *(const LAS bf16x8*)(lds + Cf::ST + (16 * vt + fr) * RSK + (32 * ks + 8 * fq) * 2);
                    const bf16x8 b = *(const LAS bf16x8*)(lds + Cf::QB + (16 * it3 + fr) * RSK + (32 * ks + 8 * fq) * 2);
                    o = MFMA16(a, b, o); }
                if (!CH) o = o * __expf(cum[16 * it3 + fr]);
                O[tt] = o; } }
    }
#pragma unroll
    for (int ki = 0; ki < Cf::KPW; ++ki) { const int kt = w + 8 * ki;
        if (!CH) { const float d = __expf(cum[C - 1]);
#pragma unroll
            for (int vt = 0; vt < NVT; ++vt) S[ki][vt] = S[ki][vt] * d; }
        else { const LAS float* ds = (const LAS float*)(lds + Cf::DS) + 16 * kt + 4 * fq; const f32x4 d = (f32x4){ds[0], ds[1], ds[2], ds[3]};
#pragma unroll
            for (int vt = 0; vt < NVT; ++vt) S[ki][vt] = S[ki][vt] * d; } }
#pragma unroll
    for (int ks = 0; ks < KSC; ++ks) {
        s16x4 vl[NVT], vh[NVT], kl[Cf::KPW], kh[Cf::KPW];
#pragma unroll
        for (int vt = 0; vt < NVT; ++vt) { const unsigned ad = lbase + Cf::VB + (32 * ks + 8 * fq + q4) * RSV + (16 * vt + 4 * p4) * 2; TRRD(vl[vt], ad, 0); TRRD(vh[vt], ad, 4 * RSV); }
#pragma unroll
        for (int ki = 0; ki < Cf::KPW; ++ki) { const unsigned ad = lbase + Cf::KB + (32 * ks + 8 * fq + q4) * RSK + (16 * (w + 8 * ki) + 4 * p4) * 2; TRRD(kl[ki], ad, 0); TRRD(kh[ki], ad, 4 * RSK); }
        TR_WAIT();
#pragma unroll
        for (int ki = 0; ki < Cf::KPW; ++ki) { const bf16x8 a = TR_JOIN(kl[ki], kh[ki]);
#pragma unroll
            for (int vt = 0; vt < NVT; ++vt) S[ki][vt] = MFMA16(a, TR_JOIN(vl[vt], vh[vt]), S[ki][vt]); }
    }
}
template <class Cf, class OutFn>
__device__ __forceinline__ void rec_step_b(LAS unsigned char* lds, const int w, const int lane, const f32x4 (&S)[Cf::KPW][Cf::VS / 16], f32x4 (&O)[(Cf::VS / 16 * Cf::C / 16 + 7) / 8], const OutFn& out, const int tok0) {
    constexpr int C = Cf::C, VS = Cf::VS, NIT = C / 16, NVT = VS / 16, KSC = C / 32;
    constexpr int RSK = Cf::RSK, RSV = Cf::RSV, RSP = Cf::RSP;
    constexpr int NO = NVT * NIT, OPW = (NO + 7) / 8;
    const int fr = lane & 15, fq = lane >> 4, q4 = fr >> 2, p4 = fr & 3;
    const unsigned lbase = (unsigned)(size_t)lds;
    const int it = (NIT == 4) ? (w & 3) : 0;
    if constexpr (NIT == 4) {
        const int v0 = w >> 2;
        s16x4 al[KSC][2], ah[KSC][2]; bf16x8 pb[KSC];
#pragma unroll
        for (int ks = 0; ks < KSC; ++ks) {
#pragma unroll
            for (int tt = 0; tt < 2; ++tt) { const unsigned ad = lbase + Cf::V + (32 * ks + 8 * fq + q4) * RSV + (16 * (v0 + 2 * tt) + 4 * p4) * 2; TRRD(al[ks][tt], ad, 0); TRRD(ah[ks][tt], ad, 4 * RSV); } }
#pragma unroll
        for (int ks = 0; ks < KSC; ++ks) pb[ks] = *(const LAS bf16x8*)(lds + Cf::PM + (16 * it + fr) * RSP + (32 * ks + 8 * fq) * 2);
        TR_WAIT();
#pragma unroll
        for (int ks = 0; ks < KSC; ++ks) { O[0] = MFMA16(TR_JOIN(al[ks][0], ah[ks][0]), pb[ks], O[0]); O[1] = MFMA16(TR_JOIN(al[ks][1], ah[ks][1]), pb[ks], O[1]); }
        out(tok0 + 16 * it + fr, 16 * it + fr, 16 * v0 + 4 * fq, O[0]);
        out(tok0 + 16 * it + fr, 16 * it + fr, 16 * (v0 + 2) + 4 * fq, O[1]);
    } else {
#pragma unroll
        for (int tt = 0; tt < OPW; ++tt) { const int t = w + 8 * tt;
            if (t < NO) { const int vt = t / NIT, it2 = t % NIT; f32x4 o = O[tt];
#pragma unroll
                for (int ks = 0; ks < KSC; ++ks) {
                    const bf16x8 a = tr_frag<4 * RSV>(lbase + Cf::V + (32 * ks + 8 * fq + q4) * RSV + (16 * vt + 4 * p4) * 2);
                    const bf16x8 b = *(const LAS bf16x8*)(lds + Cf::PM + (16 * it2 + fr) * RSP + (32 * ks + 8 * fq) * 2);
                    o = MFMA16(a, b, o); }
                out(tok0 + 16 * it2 + fr, 16 * it2 + fr, 16 * vt + 4 * fq, o); } }
    }
#pragma unroll
    for (int ki = 0; ki < Cf::KPW; ++ki) { const int kt = w + 8 * ki;
#pragma unroll
        for (int vt = 0; vt < NVT; ++vt) *(LAS v2u*)(lds + Cf::ST + (16 * vt + fr) * RSK + (16 * kt + 4 * fq) * 2) = pack4v(S[ki][vt]); }
}
template <class Cf, class OutFn>
__device__ __forceinline__ void rec_step(LAS unsigned char* lds, const int w, const int lane, f32x4 (&S)[Cf::KPW][Cf::VS / 16], const LAS float* cum, const OutFn& out, const int tok0) {
    f32x4 O[(Cf::VS / 16 * Cf::C / 16 + 7) / 8];
    rec_step_a<Cf>(lds, w, lane, S, cum, O);
    LDS_BARRIER();
    rec_step_b<Cf>(lds, w, lane, S, O, out, tok0);
    LDS_BARRIER();
}
template <class Cf> __device__ __forceinline__ void rec_zero_state(Frame& F, f32x4 (&S)[Cf::KPW][Cf::VS / 16]) {
#pragma unroll
    for (int ki = 0; ki < Cf::KPW; ++ki)
#pragma unroll
        for (int vt = 0; vt < Cf::VS / 16; ++vt) S[ki][vt] = (f32x4){0.f, 0.f, 0.f, 0.f};
    for (int o = F.tid * 16; o < Cf::VS * Cf::RSK; o += 512 * 16) *(LAS v4u*)(F.lds + Cf::ST + o) = (v4u){0u, 0u, 0u, 0u};
}
template <class Cf> __device__ __forceinline__ void rec_store_state(Frame& F, const f32x4 (&S)[Cf::KPW][Cf::VS / 16], float* dst, int ldv) {
    const int fr = F.lane & 15, fq = F.lane >> 4;
#pragma unroll
    for (int ki = 0; ki < Cf::KPW; ++ki) { const int kt = F.wave + 8 * ki;
#pragma unroll
        for (int vt = 0; vt < Cf::VS / 16; ++vt)
#pragma unroll
            for (int r = 0; r < 4; ++r) dst[(size_t)(16 * kt + 4 * fq + r) * ldv + 16 * vt + fr] = S[ki][vt][r]; }
}

struct CfRet { static constexpr int C = 64, KD = 256, VS = 64, KPW = 2, RSK = 528, RSV = 144, RSP = 144; static constexpr bool CH = false;
    static constexpr int QA = 0, KA = 33792, QB = QA, KB = KA, V = 67584, VB = 76800, PM = 86016, ST = 95232, CUM = 129024, DS = 0, END = 129280; };
static_assert(CfRet::END <= SCR_BYTES, "ret lds");
struct RetOut { bf16* dst;
    __device__ __forceinline__ void operator()(int tok, int i, int vv0, const f32x4 o) const { *(GAS v2u*)(dst + (size_t)tok * 2048 + vv0) = pack4v(o); } };
template <bool fuse>
__device__ __forceinline__ void ret_prompt_item(Frame& F, int item, const bf16* Q, const bf16* K, const bf16* V, bf16* RO, float* st_out,
                                                const float* sst_in, float* sst_out) {
    const int b = item >> 5, h = (item >> 3) & 3, vs = item & 7, tid = F.tid;
    const float lg = logf(1.f - exp2f(-5.f - (float)h));
    LAS float* cum = (LAS float*)(F.lds + CfRet::CUM);
    LAS float* sqk = (LAS float*)(F.lds + CfRet::END);
    LAS float* sred = sqk + 1024;
    __syncthreads();
    if (tid < 64) cum[tid] = (float)(tid + 1) * lg;
    f32x4 S[CfRet::KPW][4];
    rec_zero_state<CfRet>(F, S);
    const bf16* qg = Q + (size_t)(b * SEQ) * 1024 + h * 256; const bf16* kg = K + (size_t)(b * SEQ) * 1024 + h * 256; const bf16* vg = V + (size_t)(b * SEQ) * 2048 + h * 512 + vs * 64;
    const RetOut out{RO + (size_t)(b * SEQ) * 2048 + h * 512 + vs * 64};
    v4u qr[4], kr[4], vr;
#pragma unroll
    for (int i = 0; i < 4; ++i) { const int pc = tid + 512 * i, row = pc >> 5, c16 = pc & 31; qr[i] = *(const GAS v4u*)(qg + (size_t)row * 1024 + c16 * 8); kr[i] = *(const GAS v4u*)(kg + (size_t)row * 1024 + c16 * 8); }
    vr = *(const GAS v4u*)(vg + (size_t)(tid >> 3) * 2048 + (tid & 7) * 8);
    const float vsc = __expf((float)(63 - (tid >> 3)) * lg);
    const int sc4 = (tid & 127) * 4, srq = tid >> 7;
    f32x4 sv = (f32x4){0.f, 0.f, 0.f, 0.f}, so = sv, sst[4]; float sg = 0.f; const float* sin = sst_in; float* sout = sst_out; size_t srow = 0; int shh = 0;
#define RET_S_SETUP(si) do { const int sit_ = F.vcu + 256 * (si), bs_ = sit_ >> 2; shh = sit_ & 3; srow = MPR + bs_; \
        sqk[(si) * 512 + tid] = tid < 256 ? bf2f(Q[srow * 1024 + shh * 256 + tid]) : bf2f(K[srow * 1024 + shh * 256 + (tid - 256)]); \
        const v2u vw_ = *(const GAS v2u*)(V + srow * 2048 + shh * 512 + sc4); sv = (f32x4){bflo(vw_.x), bfhi(vw_.x), bflo(vw_.y), bfhi(vw_.y)}; \
        so = (f32x4){0.f, 0.f, 0.f, 0.f}; sg = 1.f - exp2f(-5.f - (float)shh); \
        sin = sst_in + ((size_t)(bs_ * 4 + shh) * 256) * 512 + sc4; sout = sst_out + ((size_t)(bs_ * 4 + shh) * 256) * 512 + sc4; } while (0)
#define RET_S_LOAD(st_) do { _Pragma("unroll") for (int k_ = 0; k_ < 4; ++k_) sst[k_] = __builtin_nontemporal_load((const GAS f32x4*)(sin + (size_t)(16 * (st_) + srq + 4 * k_) * 512)); } while (0)
    if (fuse) { RET_S_SETUP(0); RET_S_LOAD(0); __syncthreads(); }
    for (int c = 0; c < SEQ / 64; ++c) {
        const int sidx = c >> 4, sstep = c & 15;
        if (fuse) {
#pragma unroll
            for (int k = 0; k < 4; ++k) { const int rr = 16 * sstep + srq + 4 * k; const float kf = sqk[sidx * 512 + 256 + rr], qf = sqk[sidx * 512 + rr];
                const f32x4 s = sst[k] * sg + sv * kf;
                __builtin_nontemporal_store(s, (GAS f32x4*)(sout + (size_t)rr * 512)); so = so + s * qf; }
            if (sstep == 0 && sidx == 1) {
                const float acc = (sred[tid] + sred[512 + tid]) + (sred[1024 + tid] + sred[1536 + tid]);
                const int sit0 = F.vcu, bs0 = sit0 >> 2, h0 = sit0 & 3;
                RO[(size_t)(MPR + bs0) * 2048 + h0 * 512 + tid] = (bf16)(cvt_pk_bf16(acc, acc) & 0xffffu); }
            if (sstep == 15) { *(LAS f32x4*)(sred + srq * 512 + sc4) = so; if (sidx == 0) RET_S_SETUP(1); }
            if (c + 1 < SEQ / 64) RET_S_LOAD((c + 1) & 15);
        }
#pragma unroll
        for (int i = 0; i < 4; ++i) { const int pc = tid + 512 * i, row = pc >> 5, c16 = pc & 31;
            *(LAS v4u*)(F.lds + CfRet::QA + row * 528 + c16 * 16) = qr[i]; *(LAS v4u*)(F.lds + CfRet::KA + row * 528 + c16 * 16) = kr[i]; }
        { const int row = tid >> 3, c16 = tid & 7; *(LAS v4u*)(F.lds + CfRet::V + row * 144 + c16 * 16) = vr;
          float f[8]; unpack8(vr, f);
#pragma unroll
          for (int e = 0; e < 8; ++e) f[e] *= vsc;
          *(LAS v4u*)(F.lds + CfRet::VB + row * 144 + c16 * 16) = pack8(f); }
        if (c + 1 < SEQ / 64) { const size_t r0 = (size_t)(c + 1) * 64;
#pragma unroll
            for (int i = 0; i < 4; ++i) { const int pc = tid + 512 * i, row = pc >> 5, c16 = pc & 31; qr[i] = *(const GAS v4u*)(qg + (r0 + row) * 1024 + c16 * 8); kr[i] = *(const GAS v4u*)(kg + (r0 + row) * 1024 + c16 * 8); }
            vr = *(const GAS v4u*)(vg + (r0 + (tid >> 3)) * 2048 + (tid & 7) * 8); }
        LDS_BARRIER();
        rec_step<CfRet>(F.lds, F.wave, F.lane, S, cum, out, c * 64);
    }
#undef RET_S_SETUP
#undef RET_S_LOAD
    if (fuse) { __syncthreads();
        const float acc = (sred[tid] + sred[512 + tid]) + (sred[1024 + tid] + sred[1536 + tid]);
        RO[srow * 2048 + shh * 512 + tid] = (bf16)(cvt_pk_bf16(acc, acc) & 0xffffu); }
    rec_store_state<CfRet>(F, S, st_out + ((size_t)(b * 4 + h) * 256) * 512 + vs * 64, 512);
}
static_assert(CfRet::END + 4096 + 8192 <= SCR_BYTES, "ret lds + sample stream");
__device__ __forceinline__ void ret_sample_items(Frame& F, const bf16* Q, const bf16* K, const bf16* V, bf16* RO, const float* st_in, float* st_out) {
    LAS float* qk = (LAS float*)F.lds; LAS float* red = qk + 512;
    const int tid = F.tid, lane = F.lane, w = F.wave;
    for (int item = F.vcu; item < MS * 4; item += F.G) {
        const int bs = item >> 2, h = item & 3; const size_t row = MPR + bs;
        __syncthreads();
        qk[tid] = tid < 256 ? bf2f(Q[row * 1024 + h * 256 + tid]) : bf2f(K[row * 1024 + h * 256 + (tid - 256)]);
        float v[8]; unpack8(*(const GAS v4u*)(V + row * 2048 + h * 512 + 8 * lane), v);
        __syncthreads();
        const float g = 1.f - exp2f(-5.f - (float)h);
        const float* sin = st_in + ((size_t)(bs * 4 + h) * 256) * 512 + 8 * lane; float* sout = st_out + ((size_t)(bs * 4 + h) * 256) * 512 + 8 * lane;
        float o[8];
#pragma unroll
        for (int e = 0; e < 8; ++e) o[e] = 0.f;
#pragma unroll 8
        for (int r = 0; r < 32; ++r) { const int kk = 32 * w + r;
            f32x4 s0 = __builtin_nontemporal_load((const GAS f32x4*)(sin + (size_t)kk * 512)), s1 = __builtin_nontemporal_load((const GAS f32x4*)(sin + (size_t)kk * 512 + 4));
            const float kf = qk[256 + kk], qf = qk[kk];
#pragma unroll
            for (int e = 0; e < 4; ++e) { s0[e] = g * s0[e] + kf * v[e]; s1[e] = g * s1[e] + kf * v[4 + e]; o[e] += s0[e] * qf; o[4 + e] += s1[e] * qf; }
            __builtin_nontemporal_store(s0, (GAS f32x4*)(sout + (size_t)kk * 512)); __builtin_nontemporal_store(s1, (GAS f32x4*)(sout + (size_t)kk * 512 + 4)); }
#pragma unroll
        for (int e = 0; e < 8; ++e) red[w * 512 + 8 * lane + e] = o[e];
        __syncthreads();
        float acc = 0.f;
#pragma unroll
        for (int ww = 0; ww < 8; ++ww) acc += red[ww * 512 + tid];
        RO[row * 2048 + h * 512 + tid] = (bf16)(cvt_pk_bf16(acc, acc) & 0xffffu);
    }
    __syncthreads();
}

struct CfSsd { static constexpr int C = 64, KD = 128, VS = 64, KPW = 1, RSK = 272, RSV = 144, RSP = 144; static constexpr bool CH = false;
    static constexpr int QA = 0, KA = 17408, QB = QA, KB = KA, V = 34816, VB = 44032, PM = 53248, ST = 62464, XS = 79872, CUM = 89088, DTV = 89600, RAW = 90112, RSR = 656, DS = 0, END = RAW + 67 * 656; };
static_assert(CfSsd::END + 8 * 320 * 4 <= SCR_BYTES, "ssd lds + sample scratch");
struct SsdOut { bf16* dst; const LAS unsigned char* xs; float Dh;
    __device__ __forceinline__ void operator()(int tok, int i, int vv0, const f32x4 o) const {
        const v2u xw = *(const LAS v2u*)(xs + i * 144 + vv0 * 2);
        const f32x4 x = (f32x4){bflo(xw.x), bfhi(xw.x), bflo(xw.y), bfhi(xw.y)};
        *(GAS v2u*)(dst + (size_t)tok * 2048 + vv0) = pack4v(o + x * Dh); } };
__device__ __forceinline__ int ssd_gcol(int lch, int head, int grp) { return lch < 64 ? head * 64 + lch : (lch < 192 ? 2048 + grp * 128 + (lch - 64) : 2560 + grp * 128 + (lch - 192)); }
template <bool fuse>
__device__ __forceinline__ void ssd_prompt_item(Frame& F, int item, const bf16* XBC, const float* DT, bf16* T, float* st_out,
                                                const float* conv_w, const float* conv_b, const float* dt_bias, const float* a_log, const float* d_skip,
                                                const float* sst_in, float* sst_out, const float* conv_st) {
    const int b = item >> 5, head = item & 31, grp = head >> 3, tid = F.tid, lane = F.lane, w = F.wave;
    const float a = -expf(a_log[head]), dtb = dt_bias[head], Dh = d_skip[head];
    LAS float* cumb = (LAS float*)(F.lds + CfSsd::CUM); LAS float* dtvb = (LAS float*)(F.lds + CfSsd::DTV);
    __syncthreads();
    f32x4 S[CfSsd::KPW][4];
    rec_zero_state<CfSsd>(F, S);
    const bf16* xg = XBC + (size_t)(b * SEQ) * 3072; const float* dtg = DT + (size_t)(b * SEQ) * 32 + head;
    const SsdOut out{T + (size_t)(b * SEQ) * 2048 + head * 64, F.lds + CfSsd::XS, Dh};
    const bool conv_thr = tid < 440; const int cg = tid % 40, tb = tid / 40, gcolc = ssd_gcol(8 * cg, head, grp);
    float wr[4][8], br[8];
#pragma unroll
    for (int e = 0; e < 8; ++e) { br[e] = conv_b[gcolc + e];
#pragma unroll
        for (int tap = 0; tap < 4; ++tap) wr[tap][e] = conv_w[tap * 3072 + gcolc + e]; }
    const bool stg_thr = tid < 480; const int r0 = tid / 40;
    v4u raw[6];
#define SSD_LOAD_RAW(cc) do { const bf16* rp_ = xg + ((long)((cc) * 64 - 3 + r0) * 3072 + gcolc); _Pragma("unroll") for (int k_ = 0; k_ < 6; ++k_) { const int row_ = r0 + 12 * k_, tk_ = (cc) * 64 - 3 + row_; \
        raw[k_] = (v4u){0u, 0u, 0u, 0u}; if (stg_thr && row_ < 67 && tk_ >= 0) raw[k_] = *(const GAS v4u*)(rp_ + (long)k_ * 12 * 3072); } } while (0)
#define SSD_CUM(cc) do { if (w == 0) { const float dtv_ = softplusf_(dtn + dtb); float v_ = dtv_ * a; \
        _Pragma("unroll") for (int o_ = 1; o_ < 64; o_ <<= 1) { const float u_ = __shfl_up(v_, o_); if (lane >= o_) v_ += u_; } cumb[((cc) & 1) * 64 + lane] = v_; dtvb[((cc) & 1) * 64 + lane] = dtv_; } } while (0)
    float dtn = 0.f;
    if (w == 0) dtn = dtg[(size_t)lane * 32];
    SSD_CUM(0);
    if (w == 0) dtn = dtg[(size_t)(64 + lane) * 32];
    SSD_LOAD_RAW(0);
    LAS float* sscr = (LAS float*)(F.lds + CfSsd::END) + w * 320;
    const int sgw = F.vcu * NWAVES + w, sv4 = (lane & 15) * 4, skq = lane >> 4;
    f32x4 sxs = (f32x4){0.f, 0.f, 0.f, 0.f}, sxd = sxs, sy = sxs, sst[2]; float sdA = 0.f, sDh = 0.f; const float* sin = sst_in; float* sout = sst_out; size_t srow = 0; int shead = 0;
#define SSD_S_SETUP(si) do { const int sit_ = sgw + 2048 * (si), bs_ = sit_ >> 5; shead = sit_ & 31; const int sgrp_ = shead >> 3; srow = MPR + bs_; \
        _Pragma("unroll 1") for (int r_ = 0; r_ < 5; ++r_) { const int lch_ = lane + 64 * r_, gch_ = ssd_gcol(lch_, shead, sgrp_); float acc_ = conv_b[gch_]; \
            _Pragma("unroll") for (int tap_ = 0; tap_ < 3; ++tap_) acc_ += conv_st[((size_t)bs_ * 3 + tap_) * 3072 + gch_] * conv_w[tap_ * 3072 + gch_]; \
            acc_ += bf2f(XBC[srow * 3072 + gch_]) * conv_w[3 * 3072 + gch_]; sscr[lch_] = siluf_(acc_); } \
        LDS_WAIT(); \
        const float dtv_ = softplusf_(DT[srow * 32 + shead] + dt_bias[shead]); sdA = __expf(dtv_ * -expf(a_log[shead])); sDh = d_skip[shead]; \
        sxs = (f32x4){sscr[sv4], sscr[sv4 + 1], sscr[sv4 + 2], sscr[sv4 + 3]}; sxd = sxs * dtv_; sy = (f32x4){0.f, 0.f, 0.f, 0.f}; \
        sin = sst_in + ((size_t)(bs_ * 32 + shead) * 128) * 64 + sv4; sout = sst_out + ((size_t)(bs_ * 32 + shead) * 128) * 64 + sv4; } while (0)
#define SSD_S_LOAD(st_) do { _Pragma("unroll") for (int k_ = 0; k_ < 2; ++k_) sst[k_] = __builtin_nontemporal_load((const GAS f32x4*)(sin + (size_t)(8 * (st_) + 4 * k_ + skq) * 64)); } while (0)
    if (fuse) { SSD_S_SETUP(0); SSD_S_LOAD(0); }
    for (int c = 0; c < SEQ / 64; ++c) {
        if (fuse) { const int sidx = c >> 4, sstep = c & 15;
#pragma unroll
            for (int k = 0; k < 2; ++k) { const int kk = 8 * sstep + 4 * k + skq;
                const f32x4 s = sst[k] * sdA + sxd * sscr[64 + kk];
                __builtin_nontemporal_store(s, (GAS f32x4*)(sout + (size_t)kk * 64)); sy = sy + s * sscr[192 + kk]; }
            if (sstep == 15) {
#pragma unroll
                for (int e = 0; e < 4; ++e) { sy[e] += __shfl_xor(sy[e], 16); sy[e] += __shfl_xor(sy[e], 32); }
                if (lane < 16) *(GAS v2u*)(T + srow * 2048 + shead * 64 + sv4) = pack4v(sy + sxs * sDh);
                LDS_WAIT();
                if (sidx == 0) SSD_S_SETUP(1); }
            if (c + 1 < SEQ / 64) SSD_S_LOAD((c + 1) & 15);
        }
#pragma unroll
        for (int k = 0; k < 6; ++k) { const int row = r0 + 12 * k; if (stg_thr && row < 67) *(LAS v4u*)(F.lds + CfSsd::RAW + row * CfSsd::RSR + cg * 16) = raw[k]; }
        if (c + 1 < SEQ / 64) { SSD_CUM(c + 1); if (w == 0 && c + 2 < SEQ / 64) dtn = dtg[(size_t)((c + 2) * 64 + lane) * 32]; SSD_LOAD_RAW(c + 1); }
        LDS_BARRIER();
        const LAS float* cum = cumb + (c & 1) * 64; const LAS float* dtv = dtvb + (c & 1) * 64; const float tot = cum[63];
        if (conv_thr) {
            float win[3][8];
#pragma unroll
            for (int r = 0; r < 3; ++r) unpack8(*(const LAS v4u*)(F.lds + CfSsd::RAW + (6 * tb + r) * CfSsd::RSR + cg * 16), win[r]);
#pragma unroll
            for (int k = 0; k < 6; ++k) { const int i = 6 * tb + k;
                if (i < 64) {
                    float x3[8], acc[8]; unpack8(*(const LAS v4u*)(F.lds + CfSsd::RAW + (i + 3) * CfSsd::RSR + cg * 16), x3);
#pragma unroll
                    for (int e = 0; e < 8; ++e) { acc[e] = br[e] + win[0][e] * wr[0][e] + win[1][e] * wr[1][e] + win[2][e] * wr[2][e] + x3[e] * wr[3][e]; acc[e] = siluf_(acc[e]);
                        win[0][e] = win[1][e]; win[1][e] = win[2][e]; win[2][e] = x3[e]; }
                    if (cg < 8) { const float dv = dtv[i], wj = dv * __expf(tot - cum[i]);
                        *(LAS v4u*)(F.lds + CfSsd::XS + i * 144 + cg * 16) = pack8(acc);
                        float f[8];
#pragma unroll
                        for (int e = 0; e < 8; ++e) f[e] = acc[e] * dv;
                        *(LAS v4u*)(F.lds + CfSsd::V + i * 144 + cg * 16) = pack8(f);
#pragma unroll
                        for (int e = 0; e < 8; ++e) f[e] = acc[e] * wj;
                        *(LAS v4u*)(F.lds + CfSsd::VB + i * 144 + cg * 16) = pack8(f); }
                    else if (cg < 24) *(LAS v4u*)(F.lds + CfSsd::KA + i * 272 + (cg - 8) * 16) = pack8(acc);
                    else *(LAS v4u*)(F.lds + CfSsd::QA + i * 272 + (cg - 24) * 16) = pack8(acc);
                } }
        }
        LDS_BARRIER();
        rec_step<CfSsd>(F.lds, w, lane, S, cum, out, c * 64);
    }
#undef SSD_CUM
#undef SSD_LOAD_RAW
#undef SSD_S_SETUP
#undef SSD_S_LOAD
    rec_store_state<CfSsd>(F, S, st_out + ((size_t)(b * 32 + head) * 128) * 64, 64);
}
__device__ __forceinline__ void ssd_sample_items(Frame& F, const bf16* XBC, const float* DT, bf16* T, const float* st_in, float* st_out, const float* conv_st,
                                                 const float* conv_w, const float* conv_b, const float* dt_bias, const float* a_log, const float* d_skip) {
    const int gw = F.vcu * NWAVES + F.wave, NGW = F.G * NWAVES, lane = F.lane;
    LAS float* scr = (LAS float*)(F.lds + F.wave * 2048);
    __syncthreads();
    for (int item = gw; item < MS * 32; item += NGW) {
        const int bs = item >> 5, head = item & 31, grp = head >> 3; const size_t row = MPR + bs;
        asm volatile("" ::: "memory");
#pragma unroll
        for (int r = 0; r < 5; ++r) { const int lch = lane + 64 * r, gch = ssd_gcol(lch, head, grp);
            float acc = conv_b[gch];
#pragma unroll
            for (int tap = 0; tap < 3; ++tap) acc += conv_st[((size_t)bs * 3 + tap) * 3072 + gch] * conv_w[tap * 3072 + gch];
            acc += bf2f(XBC[row * 3072 + gch]) * conv_w[3 * 3072 + gch];
            scr[lch] = siluf_(acc); }
        LDS_WAIT();
        const float dtv = softplusf_(DT[row * 32 + head] + dt_bias[head]), dA = __expf(dtv * -expf(a_log[head])), Dh = d_skip[head];
        const int v4 = (lane & 15) * 4, kq = lane >> 4;
        const f32x4 xs4 = (f32x4){scr[v4], scr[v4 + 1], scr[v4 + 2], scr[v4 + 3]}, xd = xs4 * dtv;
        const float* sin = st_in + ((size_t)(bs * 32 + head) * 128) * 64 + v4; float* sout = st_out + ((size_t)(bs * 32 + head) * 128) * 64 + v4;
        f32x4 y = (f32x4){0.f, 0.f, 0.f, 0.f};
#pragma unroll 8
        for (int i = 0; i < 32; ++i) { const int kk = 4 * i + kq;
            f32x4 s = __builtin_nontemporal_load((const GAS f32x4*)(sin + (size_t)kk * 64));
            s = s * dA + xd * scr[64 + kk];
            __builtin_nontemporal_store(s, (GAS f32x4*)(sout + (size_t)kk * 64));
            y = y + s * scr[192 + kk]; }
#pragma unroll
        for (int e = 0; e < 4; ++e) { y[e] += __shfl_xor(y[e], 16); y[e] += __shfl_xor(y[e], 32); }
        if (lane < 16) *(GAS v2u*)(T + row * 2048 + head * 64 + v4) = pack4v(y + xs4 * Dh);
        LDS_WAIT();
    }
    __syncthreads();
}
__device__ __forceinline__ void ssd_conv_out(Frame& F, const bf16* XBC, const float* conv_st, float* outp, float* outs) {
    const int NP_ = BP * 3 * 3072, NS_ = MS * 3 * 3072;
    for (int idx = F.vcu * 512 + F.tid; idx < NP_ + NS_; idx += F.G * 512) {
        if (idx < NP_) { const int b = idx / 9216, rem = idx - b * 9216, wi = rem / 3072, ch = rem - wi * 3072; outp[idx] = bf2f(XBC[(size_t)(b * SEQ + SEQ - 3 + wi) * 3072 + ch]); }
        else { const int k = idx - NP_, bs = k / 9216, rem = k - bs * 9216, wi = rem / 3072, ch = rem - wi * 3072;
            outs[k] = wi < 2 ? conv_st[((size_t)bs * 3 + wi + 1) * 3072 + ch] : bf2f(XBC[(size_t)(MPR + bs) * 3072 + ch]); }
    }
}

template <int P> struct CfHgP { static constexpr int C = 32, KD = 128, VS = 32, KPW = 1, RSK = 272, RSV = 80, RSP = 80; static constexpr bool CH = true;
    static constexpr int BASE = P * 37888, QA = BASE, KA = BASE + 8704, QB = BASE + 17408, KB = BASE + 26112, V = BASE + 34816, VB = V, DS = BASE + 37376,
                         PM = 75776, ST = 78336, PART = 87040, CUM = 0, END = 87040 + 8 * 128 * 4; };
static_assert(CfHgP<1>::END + 8 * 1024 <= SCR_BYTES, "hgrn lds + sample scratch");
struct HgOut { bf16* dst;
    __device__ __forceinline__ void operator()(int tok, int i, int vv0, const f32x4 o) const { *(GAS v2u*)(dst + (size_t)tok * 1024 + vv0) = pack4v(o); } };
__device__ __forceinline__ void st_bf16_lds(LAS unsigned char* p, float x) { *(LAS unsigned short*)p = (unsigned short)(cvt_pk_bf16(x, x) & 0xffffu); }
typedef float f32x2_ __attribute__((ext_vector_type(2)));
template <int P>
__device__ __forceinline__ void hg_fill_images(LAS unsigned char* lds, const f32x2_ (&la)[4], const f32x2_ (&lc)[4], const unsigned (&qr)[4], const v4u vr, int tid) {
    typedef CfHgP<P> Cf;
    const int c2 = tid & 63, tg = tid >> 6;
    const LAS f32x2_* part = (const LAS f32x2_*)(lds + Cf::PART);
    f32x2_ off = (f32x2_){0.f, 0.f}, ref = off, tot = off;
#pragma unroll
    for (int g = 0; g < 8; ++g) { const f32x2_ pg = part[g * 64 + c2]; tot = tot + pg; if (g < 4) ref = ref + pg; const float m = (g < tg) ? 1.f : 0.f; off = off + pg * m; }
    const f32x2_ eref = (f32x2_){__expf(ref.x), __expf(ref.y)}, etr = (f32x2_){__expf(tot.x - ref.x), __expf(tot.y - ref.y)};
#pragma unroll
    for (int e = 0; e < 4; ++e) { const int i = 4 * tg + e; const f32x2_ cm = off + lc[e];
        const float d0 = fminf(fmaxf(cm.x - ref.x, -87.f), 87.f), d1 = fminf(fmaxf(cm.y - ref.y, -87.f), 87.f);
        const float qa0 = bflo(qr[e]) * __expf(d0), qa1 = bfhi(qr[e]) * __expf(d1);
        const float kb0 = (1.f - __expf(la[e].x)) * __expf(-d0), kb1 = (1.f - __expf(la[e].y)) * __expf(-d1);
        *(LAS unsigned*)(lds + Cf::QA + i * 272 + c2 * 4) = cvt_pk_bf16(qa0, qa1); *(LAS unsigned*)(lds + Cf::KA + i * 272 + c2 * 4) = cvt_pk_bf16(kb0, kb1);
        *(LAS unsigned*)(lds + Cf::QB + i * 272 + c2 * 4) = cvt_pk_bf16(qa0 * eref.x, qa1 * eref.y); *(LAS unsigned*)(lds + Cf::KB + i * 272 + c2 * 4) = cvt_pk_bf16(kb0 * etr.x, kb1 * etr.y); }
    if (tg == 0) ((LAS f32x2_*)(lds + Cf::DS))[c2] = eref * etr;
    if (tid < 128) *(LAS v4u*)(lds + Cf::V + (tid >> 2) * 80 + (tid & 3) * 16) = vr;
}
template <bool fuse>
__device__ __forceinline__ void hg_prompt_item(Frame& F, int item, const bf16* HQ, const float* LA, const bf16* HV, bf16* RO, float* st_out, const float* sst_in, float* sst_out) {
    typedef CfHgP<0> Cf0;
    const int b = item >> 5, h = (item >> 2) & 7, vs = item & 3, tid = F.tid, c2 = tid & 63, tg = tid >> 6, w = F.wave, lane = F.lane;
    LAS f32x2_* part = (LAS f32x2_*)(F.lds + Cf0::PART);
    constexpr int NCH = SEQ / 32;
    __syncthreads();
    f32x4 S[1][2];
    rec_zero_state<Cf0>(F, S);
    const size_t base = (size_t)(b * SEQ) * 1024 + h * 128;
    const HgOut out{RO + base + vs * 32};
    f32x2_ la[4], lc[4]; unsigned qr[4]; v4u vr = (v4u){0u, 0u, 0u, 0u};
#define HG_LOAD(cc) do { const size_t b2_ = base + (size_t)(cc) * 32 * 1024; _Pragma("unroll") for (int e_ = 0; e_ < 4; ++e_) { const size_t ix_ = b2_ + (size_t)(4 * tg + e_) * 1024 + 2 * c2; \
            la[e_] = *(const GAS f32x2_*)(LA + ix_); qr[e_] = *(const GAS unsigned*)(HQ + ix_); } \
        if (tid < 128) vr = *(const GAS v4u*)(HV + b2_ + (size_t)(tid >> 2) * 1024 + vs * 32 + (tid & 3) * 8); } while (0)
#define HG_CUMSUM() do { lc[0] = la[0]; _Pragma("unroll") for (int e_ = 1; e_ < 4; ++e_) lc[e_] = lc[e_ - 1] + la[e_]; part[tg * 64 + c2] = lc[3]; } while (0)
    HG_LOAD(0); HG_CUMSUM();
    LDS_BARRIER();
    hg_fill_images<0>(F.lds, la, lc, qr, vr, tid);
    HG_LOAD(1);
    LDS_BARRIER();
    f32x4 O[1];
    LAS float* sscr = (LAS float*)(F.lds + Cf0::END) + w * 256;
    const int sv4 = (lane & 15) * 4, skq = lane >> 4;
    f32x4 siv = (f32x4){0.f, 0.f, 0.f, 0.f}, so = siv, sst = siv; const float* sin = sst_in; float* sout = sst_out; size_t srb = 0; int svh = 0;
    if (fuse) { const int sit = F.vcu * NWAVES + w, bs = sit >> 4, sh = (sit >> 1) & 7; svh = sit & 1; srb = (size_t)(MPR + bs) * 1024 + sh * 128;
#pragma unroll
        for (int r = 0; r < 2; ++r) { const int k2 = lane + 64 * r; sscr[k2] = __expf(LA[srb + k2]); sscr[128 + k2] = bf2f(HQ[srb + k2]); }
        LDS_WAIT();
        const v2u iw = *(const GAS v2u*)(HV + srb + svh * 64 + sv4); siv = (f32x4){bflo(iw.x), bfhi(iw.x), bflo(iw.y), bfhi(iw.y)};
        sin = sst_in + ((size_t)(bs * 8 + sh) * 128) * 128 + svh * 64 + sv4; sout = sst_out + ((size_t)(bs * 8 + sh) * 128) * 128 + svh * 64 + sv4;
        sst = __builtin_nontemporal_load((const GAS f32x4*)(sin + (size_t)skq * 128)); }
#define HG_SAMPLE(cc) do { if (fuse && (cc) < 32) { const int kk_ = 4 * (cc) + skq; const float f_ = sscr[kk_]; \
        const f32x4 s_ = sst * f_ + siv * (1.f - f_); __builtin_nontemporal_store(s_, (GAS f32x4*)(sout + (size_t)kk_ * 128)); so = so + s_ * sscr[128 + kk_]; \
        if ((cc) == 31) { _Pragma("unroll") for (int e_ = 0; e_ < 4; ++e_) { so[e_] += __shfl_xor(so[e_], 16); so[e_] += __shfl_xor(so[e_], 32); } \
            if (lane < 16) *(GAS v2u*)(RO + srb + svh * 64 + sv4) = pack4v(so); } \
        else sst = __builtin_nontemporal_load((const GAS f32x4*)(sin + (size_t)(4 * ((cc) + 1) + skq) * 128)); } } while (0)
#define HG_STEP(P, cc) do { const bool more_ = (cc) + 1 < NCH; HG_SAMPLE(cc); \
        if (more_) HG_CUMSUM();                                      \
        rec_step_a<CfHgP<P>>(F.lds, w, lane, S, (const LAS float*)nullptr, O); \
        LDS_BARRIER(); \
        if (more_) { hg_fill_images<1 - P>(F.lds, la, lc, qr, vr, tid); if ((cc) + 2 < NCH) HG_LOAD((cc) + 2); } \
        rec_step_b<CfHgP<P>>(F.lds, w, lane, S, O, out, (cc) * 32); \
        LDS_BARRIER(); } while (0)
    for (int c = 0; c < NCH; c += 2) { HG_STEP(0, c); HG_STEP(1, c + 1); }
#undef HG_STEP
#undef HG_SAMPLE
#undef HG_CUMSUM
#undef HG_LOAD
    rec_store_state<Cf0>(F, S, st_out + ((size_t)(b * 8 + h) * 128) * 128 + vs * 32, 128);
}
__device__ __forceinline__ void hg_sample_items(Frame& F, const bf16* HQ, const float* LA, const bf16* HV, bf16* RO, const float* st_in, float* st_out) {
    const int gw = F.vcu * NWAVES + F.wave, NGW = F.G * NWAVES, lane = F.lane;
    LAS float* scr = (LAS float*)(F.lds + F.wave * 2048);
    __syncthreads();
    for (int item = gw; item < MS * 16; item += NGW) {
        const int bs = item >> 4, h = (item >> 1) & 7, vh = item & 1; const size_t rb = (size_t)(MPR + bs) * 1024 + h * 128;
        asm volatile("" ::: "memory");
#pragma unroll
        for (int r = 0; r < 2; ++r) { const int kk = lane + 64 * r; scr[kk] = __expf(LA[rb + kk]); scr[128 + kk] = bf2f(HQ[rb + kk]); }
        LDS_WAIT();
        const int v4 = (lane & 15) * 4, kq = lane >> 4;
        const v2u iw = *(const GAS v2u*)(HV + rb + vh * 64 + v4);
        const f32x4 iv = (f32x4){bflo(iw.x), bfhi(iw.x), bflo(iw.y), bfhi(iw.y)};
        const float* sin = st_in + ((size_t)(bs * 8 + h) * 128) * 128 + vh * 64 + v4; float* sout = st_out + ((size_t)(bs * 8 + h) * 128) * 128 + vh * 64 + v4;
        f32x4 o = (f32x4){0.f, 0.f, 0.f, 0.f};
#pragma unroll 8
        for (int i = 0; i < 32; ++i) { const int kk = 4 * i + kq; const float f = scr[kk];
            f32x4 s = __builtin_nontemporal_load((const GAS f32x4*)(sin + (size_t)kk * 128));
            s = s * f + iv * (1.f - f);
            __builtin_nontemporal_store(s, (GAS f32x4*)(sout + (size_t)kk * 128));
            o = o + s * scr[128 + kk]; }
#pragma unroll
        for (int e = 0; e < 4; ++e) { o[e] += __shfl_xor(o[e], 16); o[e] += __shfl_xor(o[e], 32); }
        if (lane < 16) *(GAS v2u*)(RO + rb + vh * 64 + v4) = pack4v(o);
        LDS_WAIT();
    }
    __syncthreads();
}

__device__ __forceinline__ void p0_transpose_item(const float* W, int K, int N, bf16* WT, LAS float* scr, int item, int lane, bool inter) {
    const int nblk = N / 32, kb = item / nblk, nb = item - kb * nblk, k0 = 64 * kb, n0 = 32 * nb;
    int s0 = n0; if (inter) { const int t = n0 >> 8, j = n0 & 255; s0 = j < 128 ? 128 * t + j : DFF + 128 * t + (j - 128); }
#pragma unroll 8
    for (int i = 0; i < 32; ++i) { const int kk = 2 * i + (lane >> 5); scr[kk * 33 + (lane & 31)] = W[(size_t)(k0 + kk) * N + s0 + (lane & 31)]; }
    LDS_WAIT(); asm volatile("" ::: "memory");
    const int c = lane & 7;
#pragma unroll
    for (int j = 0; j < 4; ++j) { const int n = (lane >> 3) + 8 * j; const LAS float* s = scr + (8 * c) * 33 + n;
        v4u o; o.x = cvt_pk_bf16(s[0 * 33], s[1 * 33]); o.y = cvt_pk_bf16(s[2 * 33], s[3 * 33]); o.z = cvt_pk_bf16(s[4 * 33], s[5 * 33]); o.w = cvt_pk_bf16(s[6 * 33], s[7 * 33]);
        *(GAS v4u*)(WT + (size_t)(n0 + n) * K + k0 + 8 * c) = o; }
    LDS_WAIT(); asm volatile("" ::: "memory");
}
__device__ __forceinline__ void p0_matrix(Frame& F, const float* W, int K, int N, bf16* WT, bool inter, int& itbase) {
    const int gw = F.vcu * NWAVES + F.wave, NGW = F.G * NWAVES, nit = (K / 64) * (N / 32);
    LAS float* scr = (LAS float*)(F.lds + F.wave * 16384);
    int first = (gw - itbase) % NGW; if (first < 0) first += NGW;
    for (int it = first; it < nit; it += NGW) p0_transpose_item(W, K, N, WT, scr, it, F.lane, inter);
    itbase += nit;
}

__device__ __forceinline__ void p1_ada_direct(Frame& F, const bf16* CACT, const float* Wada, const float* bias, float* MOD) {
    constexpr int RS = 1040;
    static_assert(NCOND * RS <= SCR_BYTES, "P1 A half");
    const int w = F.wave, lane = F.lane, fr = lane & 15, fq = lane >> 4, tid = F.tid;
#pragma unroll 1
    for (int strip = F.vcu; strip < NMODALL / 96; strip += F.G) {
        const int layer = strip >> 6, n0 = 96 * (strip & 63) + 16 * w;
        const float* wp = Wada + (size_t)layer * D * NMOD + (size_t)(8 * fq) * NMOD + n0 + fr;
        f32x4 acc[9];
#pragma unroll
        for (int mt = 0; mt < 9; ++mt) acc[mt] = (f32x4){0.f, 0.f, 0.f, 0.f};
        float raw[2][4][8];
#define P1_LOAD(buf_, g_) do { if (w < 6) { _Pragma("unroll") for (int s_ = 0; s_ < 4; ++s_) _Pragma("unroll") for (int j_ = 0; j_ < 8; ++j_) \
            raw[buf_][s_][j_] = wp[(size_t)(32 * (4 * (g_) + s_) + j_) * NMOD]; } } while (0)
#define P1_MMA(buf_, gl_) do { if (w < 6) { _Pragma("unroll") for (int s_ = 0; s_ < 4; ++s_) { v4u wv_; \
            wv_.x = cvt_pk_bf16(raw[buf_][s_][0], raw[buf_][s_][1]); wv_.y = cvt_pk_bf16(raw[buf_][s_][2], raw[buf_][s_][3]); wv_.z = cvt_pk_bf16(raw[buf_][s_][4], raw[buf_][s_][5]); wv_.w = cvt_pk_bf16(raw[buf_][s_][6], raw[buf_][s_][7]); \
            const bf16x8 wf_ = __builtin_bit_cast(bf16x8, wv_); \
            _Pragma("unroll") for (int mt_ = 0; mt_ < 9; ++mt_) { const int row_ = (16 * mt_ + fr < NCOND) ? 16 * mt_ + fr : NCOND - 1; \
                const bf16x8 af_ = *(const LAS bf16x8*)(F.lds + row_ * RS + (4 * (gl_) + s_) * 64 + fq * 16); acc[mt_] = MFMA16(wf_, af_, acc[mt_]); } } } } while (0)
        P1_LOAD(0, 0);
#pragma unroll
        for (int h = 0; h < 2; ++h) {
            __syncthreads();
#pragma unroll
            for (int i = 0; i < (NCOND * 64) / 512; ++i) { const int p = tid + 512 * i, row = p >> 6, c16 = p & 63;
                *(LAS v4u*)(F.lds + row * RS + c16 * 16) = *(const GAS v4u*)(CACT + (size_t)row * D + 512 * h + c16 * 8); }
            __syncthreads();
#pragma unroll
            for (int gl = 0; gl < 4; ++gl) { const int g = 4 * h + gl;
                if (g + 1 < 8) P1_LOAD((g + 1) & 1, g + 1);
                P1_MMA(g & 1, gl); }
        }
#undef P1_LOAD
#undef P1_MMA
        if (w < 6) { const int ncol = layer * NMOD + n0 + 4 * fq; const f32x4 bv = *(const GAS f32x4*)(bias + ncol);
#pragma unroll
            for (int mt = 0; mt < 9; ++mt) { const int row = 16 * mt + fr; if (row < NCOND) *(GAS f32x4*)(MOD + (size_t)row * NMODALL + ncol) = acc[mt] + bv; } }
    }
    __syncthreads();
}
static_assert((NCOND * 64) % 512 == 0 && NMOD % 96 == 0 && (NMOD / 96) == 64, "P1 strip geometry");

#ifndef REP_PROMPT
#define REP_PROMPT 1
#endif
#ifndef REP_PROMPT_SSD
#define REP_PROMPT_SSD REP_PROMPT
#endif
#ifndef REP_PROMPT_HG
#define REP_PROMPT_HG REP_PROMPT
#endif
#ifndef REP_SAMPLE
#define REP_SAMPLE 1
#endif
#ifndef REP_GEMM
#define REP_GEMM 1
#endif
#ifndef REP_GN
#define REP_GN 1
#endif
#ifndef REP_P0
#define REP_P0 1
#endif
#ifndef REP_SKINNY
#define REP_SKINNY 1
#endif
#ifndef REP_SK_ADA
#define REP_SK_ADA REP_SKINNY
#endif
#ifndef REP_SK_N1K
#define REP_SK_N1K REP_SKINNY
#endif
#define REPEAT(n) _Pragma("unroll 1") for (int rep_ = 0; rep_ < (n); ++rep_)
struct Args { const float* in[30]; float* out; unsigned char* ws; int ph_lo, ph_hi; };
enum { I_XP = 0, I_XS, I_CP, I_CS, I_SRET, I_SSSD, I_SCONV, I_SHG, I_WADA, I_BADA, I_NMPRE, I_NMPOST, I_NFPRE, I_NFPOST, I_RETIN, I_RETOUT, I_SSDIN, I_CONVW, I_CONVB, I_DTB, I_ALOG, I_SSDD,
       I_SSDNORM, I_SSDOUT, I_HGIN, I_HGLB, I_HGNORM, I_HGOUT, I_FFNIN, I_FFNOUT };
constexpr int N_PHASES = 3 + 8 * 4;

__global__ void __launch_bounds__(NWAVES * 64, 2) mk_fwd(Args args) {
    extern __shared__ __attribute__((aligned(16))) unsigned char lds_raw[];
    Frame F;
    F.lds = (LAS unsigned char*)lds_raw;
    F.tid = threadIdx.x; F.lane = F.tid & 63; F.wave = __builtin_amdgcn_readfirstlane(F.tid >> 6);
    F.G = gridDim.x; { const int bx = blockIdx.x; F.vcu = (F.G % 8 == 0) ? (bx % 8) * (F.G / 8) + bx / 8 : bx; }
    unsigned char* ws = args.ws;
    gu32* ctl = (gu32*)(ws + WS_CTL);
    for (int u = F.tid; u < (LDS_BYTES - LDSCTL_OFF) / 4; u += NWAVES * 64) ((LAS unsigned*)(F.lds + LDSCTL_OFF))[u] = 0u;
    __syncthreads();
    XcdBarrier bar; bar.bar = (unsigned*)(ctl + CW_BAR); bar.x = 0; bar.st = nullptr;
    if (MK_N_LAUNCHES == 1) bar = xcd_barrier_post((unsigned*)(ctl + CW_BAR), (volatile LAS unsigned*)(F.lds + LDSCTL_OFF) + 8);
    const int lo = args.ph_lo, hi = args.ph_hi;
#define IN(k) (lo <= (k) && (k) < hi)
#ifndef REP_BAR
#define REP_BAR 1
#endif
#define SEAM(k) do { if (IN((k) + 1)) { _Pragma("unroll") for (int rb_ = 0; rb_ < REP_BAR; ++rb_) xcd_barrier(bar); } } while (0)
#ifndef PF_B
#define PF_B 1
#endif
#define SEAM_PF(k, Bt_, N_, K_) do { if (IN((k) + 1)) { if (PF_B && MK_N_LAUNCHES == 1) xcd_barrier_pf(bar, F, (Bt_), (N_), (K_)); else xcd_barrier(bar); } } while (0)
#define BPRE(k) (PF_B && MK_N_LAUNCHES == 1 && IN((k) - 1) && IN(k))
    const bool ps_ = PANEL_SYNC && MK_N_LAUNCHES == 1 && F.G == 256;
    const int pm_ = panel_of_wg();
    gu32* const tmo_ = ctl + CW_BAR + XB_TMO;
#define SEAM_PANEL(k, seam, Bt_, N_, K_) do { if (IN((k) + 1)) { if (ps_) { panel_publish(F, ctl, (seam), pm_, (F.vcu < 16) ? 8u : 0u, !WT_ROW); panel_wait(F, panel_word(ctl, (seam), pm_), 4u, tmo_); } \
        else SEAM_PF(k, Bt_, N_, K_); } } while (0)
#define SEAM_PUB(k, seam, REL_, FALLBACK_) do { if (IN((k) + 1)) { if (ps_) panel_publish(F, ctl, (seam), pm_, 0u, (REL_)); else { FALLBACK_; } } } while (0)
#define PANEL_WAIT(k, seam) do { if (ps_ && IN((k) - 1)) panel_wait(F, panel_word(ctl, (seam), pm_), 4u, tmo_); } while (0)
#define SWAIT_ARG(k, seam) ((ps_ && IN((k) - 1)) ? panel_word(ctl, (seam), 65) : (gu32*)nullptr)
#define SAMPLE_WAIT(k, seam) do { if (ps_ && IN((k) - 1)) panel_wait(F, panel_word(ctl, (seam), 64), (unsigned)MS, tmo_); } while (0)
#define ALLWG_WAIT(k, seam) do { if (ps_ && IN((k) - 1)) panel_wait(F, panel_word(ctl, (seam), 65), 256u, tmo_); } while (0)
#define INP(i) (args.in[i])
    float* const out = args.out;
    float* const X = out + O_Y;
    bf16* const XB = (bf16*)(ws + WS_XB);
    bf16* const Hb = (bf16*)(ws + WS_H); bf16* const RO = (bf16*)(ws + WS_RO); bf16* const GO = (bf16*)(ws + WS_GO); bf16* const OUTB = (bf16*)(ws + WS_OUT); bf16* const ACT = (bf16*)(ws + WS_ACT);
    float* const MOD = (float*)(ws + WS_MOD); float* const LB = (float*)(ws + WS_LB);
    bf16* const CACT = (bf16*)(ws + WS_CACT);
    unsigned char* const PJ = ws + WS_PROJ;

    if (IN(0)) { REPEAT(REP_P0) {
        int itb = 0;
#pragma unroll 1
        for (int j = 0; j < 2; ++j) p0_matrix(F, INP(I_RETIN) + (size_t)j * D * RET_IN, D, RET_IN, (bf16*)(ws + WS_WRETIN) + (size_t)j * RET_IN * D, false, itb);
#pragma unroll 1
        for (int j = 0; j < 2; ++j) p0_matrix(F, INP(I_RETOUT) + (size_t)j * 2048 * D, 2048, D, (bf16*)(ws + WS_WRETOUT) + (size_t)j * D * 2048, false, itb);
        p0_matrix(F, INP(I_SSDIN), D, SSD_IN, (bf16*)(ws + WS_WSSDIN), false, itb);
        p0_matrix(F, INP(I_SSDOUT), 2048, D, (bf16*)(ws + WS_WSSDOUT), false, itb);
        p0_matrix(F, INP(I_HGIN), D, HG_IN, (bf16*)(ws + WS_WHGIN), false, itb);
        p0_matrix(F, INP(I_HGOUT), D, D, (bf16*)(ws + WS_WHGOUT), false, itb);
#pragma unroll 1
        for (int l = 0; l < 4; ++l) p0_matrix(F, INP(I_FFNIN) + (size_t)l * D * FFN_IN, D, FFN_IN, (bf16*)(ws + WS_WFFNIN) + (size_t)l * FFN_IN * D, true, itb);
#pragma unroll 1
        for (int l = 0; l < 4; ++l) p0_matrix(F, INP(I_FFNOUT) + (size_t)l * DFF * D, DFF, D, (bf16*)(ws + WS_WFFNOUT) + (size_t)l * D * DFF, false, itb);
        for (int idx = F.vcu * 512 + F.tid; idx < 256 * 128; idx += F.G * 512) { const int row = idx >> 7, c8 = (idx & 127) * 8; v4u o = (v4u){0u, 0u, 0u, 0u};
            if (row < NCOND) { const float* src = row < BP ? INP(I_CP) + (size_t)row * D : INP(I_CS) + (size_t)(row - BP) * D;
                const f32x4 a = *(const GAS f32x4*)(src + c8), b = *(const GAS f32x4*)(src + c8 + 4); o = pack8v(silu4(a), silu4(b)); }
            *(GAS v4u*)(CACT + (size_t)row * D + c8) = o; }
        for (int idx = F.vcu * 512 + F.tid; idx < 1024; idx += F.G * 512) { const float* lg = INP(I_HGLB);
            const float l0 = lg[idx], l1 = lg[1024 + idx], l2 = lg[2048 + idx], l3 = lg[3072 + idx], m = fmaxf(fmaxf(l0, l1), fmaxf(l2, l3));
            const float e0 = expf(l0 - m), e1 = expf(l1 - m), e2 = expf(l2 - m), e3 = expf(l3 - m); LB[idx] = (e1 + e2) / ((e0 + e1) + (e2 + e3)); }
        }
        SEAM(0);
    }
    if (IN(1)) {
        REPEAT(REP_SK_ADA) p1_ada_direct(F, CACT, INP(I_WADA), INP(I_BADA), MOD);
        SEAM(1);
    }
    if (IN(2)) {
        resnorm_phase<0>(F, INP(I_XP), INP(I_XS), XB, X, nullptr, Hb, MOD, nullptr, 0, INP(I_NMPRE), 0 * NMOD + 0 * D, 0 * NMOD + 1 * D, ps_);
        SEAM_PANEL(2, 0, (const bf16*)(ws + WS_WRETIN), RET_IN, D);
    }

#ifndef STAGGER_TICKS
#define STAGGER_TICKS 0
#endif
#define GEMM_STAGGER(N_) do { if (STAGGER_TICKS > 0 && (N_) > 1024 && (blockIdx.x & 1)) { const unsigned long long t0_ = __builtin_amdgcn_s_memrealtime(); \
        while (__builtin_amdgcn_s_memrealtime() - t0_ < (unsigned long long)STAGGER_TICKS) __builtin_amdgcn_s_sleep(8); } } while (0)
#define MAIN_GEMM(PH_, PSK_, EmitT, eobj, Aptr, Btptr, N_, K_) do { GEMM_STAGGER(N_); pg8::Gemm g_{(const pg8::bf16_t*)(Aptr), (const pg8::bf16_t*)(Btptr), MPR, (N_), (K_)}; pg8::StaticOrder S_; S_.init(MPR, (N_), F.G, (int)blockIdx.x); \
        const EpiGen<EmitT> E_{eobj}; _Pragma("unroll") for (int rg_ = 0; rg_ < REP_GEMM; ++rg_) pg8::gemm_phase<EpiGen<EmitT>, pg8::StaticOrder, PG8_ALIGN, PG8_SP2>(F.lds, g_, S_, E_, BPRE(PH_) && !((PSK_) && ps_) && rg_ == 0); } while (0)
#define FFN_BLOCK(L, pb, LASTL, NXT_BT, NXT_N) do { \
    if (IN((pb) + 4)) { PANEL_WAIT((pb) + 4, 13 + 3 * (L)); resnorm_phase<1>(F, nullptr, nullptr, XB, X, OUTB, Hb, MOD, INP(I_NMPOST) + (L) * D, (L) * NMOD + 2 * D, INP(I_NFPRE) + (L) * D, (L) * NMOD + 3 * D, (L) * NMOD + 4 * D, ps_, SWAIT_ARG((pb) + 4, 13 + 3 * (L)), tmo_); SEAM_PANEL((pb) + 4, 2 + 3 * (L), (const bf16*)(ws + WS_WFFNIN) + (size_t)(L) * FFN_IN * D, FFN_IN, D); } \
    if (IN((pb) + 5)) { const bf16* wt_ = (const bf16*)(ws + WS_WFFNIN) + (size_t)(L) * FFN_IN * D; const EmitFfnIn e_{ACT}; \
        MAIN_GEMM((pb) + 5, 1, EmitFfnIn, e_, Hb, wt_, FFN_IN, D); SAMPLE_WAIT((pb) + 5, 2 + 3 * (L)); REPEAT(REP_SKINNY) skinny_gemm<8>(F, Hb + (size_t)MPR * D, D, 1, MS, MPR, wt_, (FFN_IN / 256) * 8, false, e_, F.G / 2, F.G / 2); SEAM_PUB((pb) + 5, 14 + 3 * (L), !WT_G3, SEAM_PF((pb) + 5, (const bf16*)(ws + WS_WFFNOUT) + (size_t)(L) * D * DFF, D, DFF)); } \
    if (IN((pb) + 6)) { const bf16* wt_ = (const bf16*)(ws + WS_WFFNOUT) + (size_t)(L) * D * DFF; const EmitOut e_{OUTB}; \
        PANEL_WAIT((pb) + 6, 14 + 3 * (L)); MAIN_GEMM((pb) + 6, 1, EmitOut, e_, ACT, wt_, D, DFF); if (ps_ && IN((pb) + 5)) panel_wait(F, panel_word(ctl, 14 + 3 * (L), 65), 256u, tmo_); REPEAT(REP_SK_N1K) skinny_gemm<2>(F, ACT + (size_t)MPR * DFF, DFF, 4, MS, MPR, wt_, (D / 256) * 8, false, e_, 0, F.G); SEAM_PUB((pb) + 6, 15 + 3 * (L), !WT_OUT, SEAM((pb) + 6)); } \
    if (IN((pb) + 7)) { PANEL_WAIT((pb) + 7, 15 + 3 * (L)); if (LASTL) resnorm_phase<2>(F, nullptr, nullptr, XB, X, OUTB, Hb, MOD, INP(I_NFPOST) + (L) * D, (L) * NMOD + 5 * D, nullptr, 0, 0, ps_, SWAIT_ARG((pb) + 7, 15 + 3 * (L)), tmo_); \
        else resnorm_phase<1>(F, nullptr, nullptr, XB, X, OUTB, Hb, MOD, INP(I_NFPOST) + (L) * D, (L) * NMOD + 5 * D, INP(I_NMPRE) + ((L) + 1) * D, ((L) + 1) * NMOD + 0 * D, ((L) + 1) * NMOD + 1 * D, ps_, SWAIT_ARG((pb) + 7, 15 + 3 * (L)), tmo_); \
        if (!(LASTL)) SEAM_PANEL((pb) + 7, 3 + 3 * (L), (NXT_BT), (NXT_N), D); } } while (0)
#define OUT_PROJ(L, pb, wt, K_) do { if (IN((pb) + 3)) { const EmitOut e_{OUTB}; MAIN_GEMM((pb) + 3, 1, EmitOut, e_, GO, (wt), D, (K_)); SAMPLE_WAIT((pb) + 3, 1 + 3 * (L)); REPEAT(REP_SK_N1K) skinny_gemm<2>(F, GO + (size_t)MPR * (K_), (K_), 4, MS, MPR, (wt), (D / 256) * 8, false, e_, 0, F.G); SEAM_PUB((pb) + 3, 13 + 3 * (L), !WT_OUT, SEAM((pb) + 3)); } } while (0)
#define RET_LAYER(L, J, pb) do { \
    bf16* const Qp_ = (bf16*)(PJ + PJ_RET_Q); bf16* const Kp_ = (bf16*)(PJ + PJ_RET_K); bf16* const Vp_ = (bf16*)(PJ + PJ_RET_V); bf16* const SGp_ = (bf16*)(PJ + PJ_RET_SG); \
    if (IN((pb) + 0)) { const bf16* wt_ = (const bf16*)(ws + WS_WRETIN) + (size_t)(J) * RET_IN * D; const EmitRetIn e_{Qp_, Kp_, Vp_, SGp_}; \
        MAIN_GEMM((pb) + 0, 1, EmitRetIn, e_, Hb, wt_, RET_IN, D); SAMPLE_WAIT((pb) + 0, 3 * (L)); REPEAT(REP_SKINNY) skinny_gemm<8>(F, Hb + (size_t)MPR * D, D, 1, MS, MPR, wt_, (RET_IN / 256) * 8, false, e_, 0, F.G); SEAM((pb) + 0); } \
    if (IN((pb) + 1)) { const bool fuse_ = (F.G == 256); const float* ssi_ = INP(I_SRET) + (size_t)(J) * 128 * 4 * 256 * 512; float* sso_ = out + O_RETS + (size_t)(J) * 128 * 4 * 256 * 512; \
        if (fuse_) { REPEAT(REP_PROMPT) ret_prompt_item<true>(F, F.vcu, Qp_, Kp_, Vp_, RO, out + O_RETP + (size_t)(J) * 8 * 4 * 256 * 512, ssi_, sso_); } \
        else { for (int item = F.vcu; item < 256; item += F.G) ret_prompt_item<false>(F, item, Qp_, Kp_, Vp_, RO, out + O_RETP + (size_t)(J) * 8 * 4 * 256 * 512, ssi_, sso_); \
            REPEAT(REP_SAMPLE) ret_sample_items(F, Qp_, Kp_, Vp_, RO, ssi_, sso_); } SEAM((pb) + 1); } \
    if (IN((pb) + 2)) { REPEAT(REP_GN) gatenorm_phase<0>(F, RO, SGp_, GO, nullptr, ps_); SEAM_PANEL((pb) + 2, 1 + 3 * (L), (const bf16*)(ws + WS_WRETOUT) + (size_t)(J) * D * 2048, D, 2048); } \
    OUT_PROJ(L, pb, (const bf16*)(ws + WS_WRETOUT) + (size_t)(J) * D * 2048, 2048); \
    } while (0)

    RET_LAYER(0, 0, 3);
    FFN_BLOCK(0, 3, false, (const bf16*)(ws + WS_WSSDIN), SSD_INM);
    {
        constexpr int pb = 11;
        bf16* const SZ_ = (bf16*)(PJ + PJ_SSD_SZ); bf16* const XBC_ = (bf16*)(PJ + PJ_SSD_XBC); float* const DT_ = (float*)(PJ + PJ_SSD_DT);
        if (IN(pb + 0)) { const bf16* wt_ = (const bf16*)(ws + WS_WSSDIN); const EmitSsdIn e_{SZ_, XBC_}; const EmitDt ed_{DT_};
            MAIN_GEMM(pb + 0, 1, EmitSsdIn, e_, Hb, wt_, SSD_INM, D); SAMPLE_WAIT(pb + 0, 3); ALLWG_WAIT(pb + 0, 3);
            REPEAT(REP_SKINNY) skinny_gemm<8>(F, Hb + (size_t)MPR * D, D, 1, MS, MPR, wt_, (SSD_INM / 256) * 8, false, e_, 0, F.G);
            REPEAT(REP_SKINNY) skinny_gemm<8>(F, Hb, D, MT / 128, MT, 0, wt_, 1, true, ed_, 0, F.G);
            SEAM(pb + 0); }
        if (IN(pb + 1)) {
            if (F.G == 256) { REPEAT(REP_PROMPT_SSD) ssd_prompt_item<true>(F, F.vcu, XBC_, DT_, RO, out + O_SSDP, INP(I_CONVW), INP(I_CONVB), INP(I_DTB), INP(I_ALOG), INP(I_SSDD), INP(I_SSSD), out + O_SSDS, INP(I_SCONV)); }
            else { for (int item = F.vcu; item < 256; item += F.G) ssd_prompt_item<false>(F, item, XBC_, DT_, RO, out + O_SSDP, INP(I_CONVW), INP(I_CONVB), INP(I_DTB), INP(I_ALOG), INP(I_SSDD), INP(I_SSSD), out + O_SSDS, INP(I_SCONV));
                REPEAT(REP_SAMPLE) ssd_sample_items(F, XBC_, DT_, RO, INP(I_SSSD), out + O_SSDS, INP(I_SCONV), INP(I_CONVW), INP(I_CONVB), INP(I_DTB), INP(I_ALOG), INP(I_SSDD)); }
            ssd_conv_out(F, XBC_, INP(I_SCONV), out + O_CONVP, out + O_CONVS);
            SEAM(pb + 1); }
        if (IN(pb + 2)) { REPEAT(REP_GN) gatenorm_phase<1>(F, RO, SZ_, GO, INP(I_SSDNORM), ps_); SEAM_PANEL(pb + 2, 4, (const bf16*)(ws + WS_WSSDOUT), D, 2048); }
        OUT_PROJ(1, pb, (const bf16*)(ws + WS_WSSDOUT), 2048);
    }
    FFN_BLOCK(1, 11, false, (const bf16*)(ws + WS_WHGIN), HG_IN);
    {
        constexpr int pb = 19;
        bf16* const HQ_ = (bf16*)(PJ + PJ_HG_Q); float* const LA_ = (float*)(PJ + PJ_HG_LA); bf16* const HV_ = (bf16*)(PJ + PJ_HG_V); bf16* const HSG_ = (bf16*)(PJ + PJ_HG_SG);
        if (IN(pb + 0)) { const bf16* wt_ = (const bf16*)(ws + WS_WHGIN); const EmitHgIn e_{HQ_, HV_, HSG_, LA_, LB};
            MAIN_GEMM(pb + 0, 1, EmitHgIn, e_, Hb, wt_, HG_IN, D); SAMPLE_WAIT(pb + 0, 6); REPEAT(REP_SKINNY) skinny_gemm<8>(F, Hb + (size_t)MPR * D, D, 1, MS, MPR, wt_, (HG_IN / 256) * 8, false, e_, 0, F.G); SEAM(pb + 0); }
        if (IN(pb + 1)) {
            if (F.G == 256) { REPEAT(REP_PROMPT_HG) hg_prompt_item<true>(F, F.vcu, HQ_, LA_, HV_, RO, out + O_HGP, INP(I_SHG), out + O_HGS); }
            else { for (int item = F.vcu; item < 256; item += F.G) hg_prompt_item<false>(F, item, HQ_, LA_, HV_, RO, out + O_HGP, INP(I_SHG), out + O_HGS);
                REPEAT(REP_SAMPLE) hg_sample_items(F, HQ_, LA_, HV_, RO, INP(I_SHG), out + O_HGS); }
            SEAM(pb + 1); }
        if (IN(pb + 2)) { REPEAT(REP_GN) gatenorm_phase<2>(F, RO, HSG_, GO, INP(I_HGNORM), ps_); SEAM_PANEL(pb + 2, 7, (const bf16*)(ws + WS_WHGOUT), D, 1024); }
        OUT_PROJ(2, pb, (const bf16*)(ws + WS_WHGOUT), 1024);
    }
    FFN_BLOCK(2, 19, false, (const bf16*)(ws + WS_WRETIN) + (size_t)RET_IN * D, RET_IN);
    RET_LAYER(3, 1, 27);
    FFN_BLOCK(3, 27, true, (const bf16*)nullptr, 0);
#undef IN
#undef SEAM
}

extern "C" void kernel_launch(void* const* d_in, const int* in_sizes, int n_in, void* d_out, int out_size, void* d_ws, size_t ws_size, hipStream_t stream) {
    static int grid = 0;
    if (grid == 0) {
        if (n_in != 30 || (size_t)out_size != O_END || ws_size < WS_END) { fprintf(stderr, "kernel_launch: unexpected shapes (n_in %d out %d ws %zu)\n", n_in, out_size, ws_size); grid = -1; return; }
        int dev = 0, cus = 0, per_cu = 0;
        if (hipGetDevice(&dev) != hipSuccess || hipDeviceGetAttribute(&cus, hipDeviceAttributeMultiprocessorCount, dev) != hipSuccess) { grid = -1; return; }
        if (hipFuncSetAttribute((const void*)mk_fwd, hipFuncAttributeMaxDynamicSharedMemorySize, LDS_BYTES) != hipSuccess) { fprintf(stderr, "kernel_launch: hipFuncSetAttribute failed\n"); grid = -1; return; }
        if (hipOccupancyMaxActiveBlocksPerMultiprocessor(&per_cu, (const void*)mk_fwd, NWAVES * 64, LDS_BYTES) != hipSuccess || per_cu < 1) { fprintf(stderr, "kernel_launch: occupancy query says %d\n", per_cu); }
        (void)hipGetLastError();
        grid = cus;
    }
    if (grid < 0) return;
    if (hipMemsetAsync((char*)d_ws + WS_CTL, 0, CTL_ZERO_BYTES, stream) != hipSuccess) { fprintf(stderr, "kernel_launch: memset failed\n"); return; }
    Args a{};
    for (int i = 0; i < 30; ++i) a.in[i] = (const float*)d_in[i];
    a.out = (float*)d_out; a.ws = (unsigned char*)d_ws;
#if MK_N_LAUNCHES == 1
    a.ph_lo = 0; a.ph_hi = N_PHASES;
    hipLaunchKernelGGL(mk_fwd, dim3(grid), dim3(NWAVES * 64), LDS_BYTES, stream, a);
#else
    for (int p = 0; p < N_PHASES; ++p) { a.ph_lo = p; a.ph_hi = p + 1; hipLaunchKernelGGL(mk_fwd, dim3(grid), dim3(NWAVES * 64), LDS_BYTES, stream, a); }
#endif
    const hipError_t le = hipPeekAtLastError();
    if (le != hipSuccess) fprintf(stderr, "kernel_launch: launch failed: %s\n", hipGetErrorName(le));
}
```

```cpp
#include <hip/hip_runtime.h>
#include <cstdio>
#include <cstdint>
namespace pg8 {
#define PG8_LAS __attribute__((address_space(3)))
typedef unsigned short bf16_t;
typedef short bf16x8 __attribute__((ext_vector_type(8)));
typedef float f32x4 __attribute__((ext_vector_type(4)));
typedef unsigned u32x4 __attribute__((ext_vector_type(4)));
constexpr int BM = 256, BK = 64, HALF = 128, HTB = HALF * BK * 2  , STAGE_BYTES = 8 * HTB, NXCD = 8, WGM = 8;

__host__ __device__ __forceinline__ int lds_byte(int r, int c) { const int st = (r >> 4) * 2 + (c >> 5), rr = r & 15, cc = c & 31, ob = rr * 64 + cc * 2; return st * 1024 + (ob ^ (((ob >> 9) & 1) << 5)); }
__host__ __device__ __forceinline__ void stage_rc(int b, int& R, int& C) { const int st = b / 1024, sb = b % 1024, swz = sb ^ (((sb >> 9) & 1) << 5); R = (st >> 1) * 16 + swz / 64; C = (st & 1) * 32 + (swz % 64) / 2; }
__host__ __device__ __forceinline__ int perm32(int rho) { const int n = rho >> 4, i = rho & 15; return 8 * (i >> 2) + 4 * n + (i & 3); }

struct Unit { int pm, pn; };
struct Gemm { const bf16_t* A; const bf16_t* Bt; int M, N, K; };

struct StaticOrder {
    int nM, nN, nwg, G, c;
    __host__ __device__ void init(int M, int N, int G_, int c_) { nM = M / BM; nN = N / BM; nwg = nM * nN; G = G_; c = c_; }
    __host__ __device__ bool next(int i, Unit& u) const {
        const long L = (long)i * G + c; if (L >= nwg) return false;
        int wgid = (int)L; { const int q = nwg / NXCD, r = nwg % NXCD, xcd = wgid % NXCD, off = wgid / NXCD; wgid = (xcd < r ? xcd * (q + 1) : r * (q + 1) + (xcd - r) * q) + off; }
        const int nig = WGM * nN, gid = wgid / nig, fm = gid * WGM, gsz = (nM - fm) < WGM ? (nM - fm) : WGM;
        u.pm = fm + ((wgid % nig) % gsz); u.pn = (wgid % nig) / gsz; return true;
    }
    __device__ __forceinline__ void a_ready(const Unit&) const {}
    __device__ __forceinline__ void done(const Unit&) const {}
};

__device__ __forceinline__ unsigned cvt_pk_bf16(float lo, float hi) { unsigned r; asm volatile("v_cvt_pk_bf16_f32 %0, %1, %2" : "=v"(r) : "v"(lo), "v"(hi)); return r; }
typedef float f32x2 __attribute__((ext_vector_type(2)));
template <class Epi, class Sched, bool ALIGN_EPI = false, bool SP2 = false>
__device__ __forceinline__ void gemm_phase(PG8_LAS unsigned char* lds, const Gemm g, const Sched& S, const Epi& E, const bool bpre = false) {
    const int tid = threadIdx.x, wid = __builtin_amdgcn_readfirstlane(tid >> 6), lane = tid & 63, wr = wid >> 2, wc = wid & 3, fr = lane & 15, fq = lane >> 4;
    const int K = g.K, nt = K / BK;
    unsigned voffA[2], voffB[2];
#pragma unroll
    for (int i = 0; i < 2; ++i) { int R, C; stage_rc(tid * 16 + i * 8192, R, C); const int Rb = Epi::PERM ? ((R & ~31) + perm32(R & 31)) : R;
        voffA[i] = (unsigned)(R * K + C) * 2u; voffB[i] = (unsigned)(Rb * K + C) * 2u; }
    const size_t kstep = (size_t)(BK * 2);
    const size_t hstep = (size_t)HALF * K * 2;
    const size_t tstep = 2 * hstep;
    const unsigned ldsw = (unsigned)wid * 1024u;
    const int aoff = lds_byte(wr * 64 + fr, fq * 8), boff = lds_byte(wc * 32 + fr, fq * 8);
#define PG8_SA(b, h) (((b) * 2 + (h)) * HTB)
#define PG8_SB(b, h) ((4 + (b) * 2 + (h)) * HTB)
#define PG8_STAGE(bufoff, gbase, voff) do { _Pragma("unroll") for (int _i = 0; _i < 2; ++_i) \
        __builtin_amdgcn_global_load_lds((const unsigned*)((const char*)(gbase) + (voff)[_i]), (PG8_LAS unsigned*)(lds + (bufoff) + ldsw + _i * 8192), 16, 0, 0); } while (0)
#define PG8_LDA(dst, b, h) do { _Pragma("unroll") for (int m = 0; m < 4; ++m) _Pragma("unroll") for (int k = 0; k < 2; ++k) dst[m][k] = *(const PG8_LAS bf16x8*)(lds + PG8_SA(b, h) + aoff + m * 2048 + k * 1024); } while (0)
#define PG8_LDB(dst, b, h) do { _Pragma("unroll") for (int n = 0; n < 2; ++n) _Pragma("unroll") for (int k = 0; k < 2; ++k) dst[n][k] = *(const PG8_LAS bf16x8*)(lds + PG8_SB(b, h) + boff + n * 2048 + k * 1024); } while (0)
#define PG8_MMA(ai, bj, At, Bt) do { __builtin_amdgcn_s_setprio(1); _Pragma("unroll") for (int m = 0; m < 4; ++m) _Pragma("unroll") for (int n = 0; n < 2; ++n) _Pragma("unroll") for (int k = 0; k < 2; ++k) \
        acc[ai][bj][m][n] = __builtin_amdgcn_mfma_f32_16x16x32_bf16(Bt[n][k], At[m][k], acc[ai][bj][m][n], 0, 0, 0); __builtin_amdgcn_s_setprio(0); } while (0)
#define PG8_WAIT_V(n) asm volatile("s_waitcnt vmcnt(" #n ")" ::: "memory")
#define PG8_WAIT_L(n) asm volatile("s_waitcnt lgkmcnt(" #n ")" ::: "memory")
#define PG8_BAR __builtin_amdgcn_s_barrier()
#define PG8_SCHED __builtin_amdgcn_sched_barrier(0)
    Unit cur, nxt; int ui = 0;
    if (!S.next(0, cur)) return;
    f32x4 acc[2][2][4][2];
#pragma unroll
    for (int a = 0; a < 2; ++a)
#pragma unroll
        for (int b = 0; b < 2; ++b)
#pragma unroll
            for (int m = 0; m < 4; ++m)
#pragma unroll
                for (int n = 0; n < 2; ++n) acc[a][b][m][n] = (f32x4){0.f, 0.f, 0.f, 0.f};
    bf16x8 At[4][2], B0[2][2], B1[2][2];
    const char* cA = (const char*)g.A + (size_t)cur.pm * tstep; const char* cB = (const char*)g.Bt + (size_t)cur.pn * tstep;
    S.a_ready(cur);
    if constexpr (SP2) {
        if (!(bpre && wid != 0)) { PG8_STAGE(PG8_SB(0, 0), cB, voffB); PG8_STAGE(PG8_SB(0, 1), cB + hstep, voffB); }
        PG8_STAGE(PG8_SA(0, 0), cA, voffA); PG8_STAGE(PG8_SA(0, 1), cA + hstep, voffA);
        if (wr == 1) PG8_BAR;
        PG8_WAIT_V(2); PG8_BAR;
        PG8_STAGE(PG8_SB(1, 0), cB + kstep, voffB); PG8_STAGE(PG8_SA(1, 0), cA + kstep, voffA); PG8_STAGE(PG8_SB(1, 1), cB + hstep + kstep, voffB);
        PG8_WAIT_V(6); PG8_BAR;
    } else {
        PG8_STAGE(PG8_SB(0, 0), cB, voffB); PG8_STAGE(PG8_SA(0, 0), cA, voffA); PG8_STAGE(PG8_SB(0, 1), cB + hstep, voffB); PG8_STAGE(PG8_SA(0, 1), cA + hstep, voffA);
        if (wr == 1) PG8_BAR;
        PG8_WAIT_V(4); PG8_BAR;
        PG8_STAGE(PG8_SB(1, 0), cB + kstep, voffB); PG8_STAGE(PG8_SA(1, 0), cA + kstep, voffA); PG8_STAGE(PG8_SB(1, 1), cB + hstep + kstep, voffB);
        PG8_WAIT_V(6); PG8_BAR;
    }
    for (;;) {
        const bool has_next = S.next(ui + 1, nxt);
        const char* nA = has_next ? (const char*)g.A + (size_t)nxt.pm * tstep : cA; const char* nB = has_next ? (const char*)g.Bt + (size_t)nxt.pn * tstep : cB;
        for (int t = 0; t < nt; t += 2) {
            const bool last = (t == nt - 2);
            const char* a1 = cA + (size_t)(t + 1) * kstep;
            const char* a2 = last ? nA : cA + (size_t)(t + 2) * kstep; const char* b2 = last ? nB : cB + (size_t)(t + 2) * kstep;
            const char* a3 = a2 + kstep; const char* b3 = b2 + kstep;
            if (last && has_next) S.a_ready(nxt);
            if constexpr (SP2) {
            PG8_LDB(B0, 0, 0); PG8_LDB(B1, 0, 1); PG8_SCHED; PG8_LDA(At, 0, 0); PG8_STAGE(PG8_SA(1, 1), a1 + hstep, voffA);
            PG8_WAIT_V(8); PG8_WAIT_L(0); PG8_BAR; PG8_MMA(0, 0, At, B0); PG8_MMA(0, 1, At, B1); PG8_BAR; PG8_SCHED;
            PG8_LDA(At, 0, 1); PG8_STAGE(PG8_SB(0, 0), b2, voffB); PG8_STAGE(PG8_SB(0, 1), b2 + hstep, voffB); PG8_STAGE(PG8_SA(0, 0), a2, voffA);
            PG8_WAIT_V(8); PG8_WAIT_L(0); PG8_BAR; PG8_MMA(1, 0, At, B0); PG8_MMA(1, 1, At, B1); PG8_BAR; PG8_SCHED;
            PG8_LDB(B0, 1, 0); PG8_LDB(B1, 1, 1); PG8_SCHED; PG8_LDA(At, 1, 0); PG8_STAGE(PG8_SA(0, 1), a2 + hstep, voffA);
            PG8_WAIT_V(8); PG8_WAIT_L(0); PG8_BAR; PG8_MMA(0, 0, At, B0); PG8_MMA(0, 1, At, B1); PG8_BAR; PG8_SCHED;
            PG8_LDA(At, 1, 1); PG8_STAGE(PG8_SB(1, 0), b3, voffB); PG8_STAGE(PG8_SB(1, 1), b3 + hstep, voffB); PG8_STAGE(PG8_SA(1, 0), a3, voffA);
            PG8_WAIT_V(8); PG8_WAIT_L(0); PG8_BAR; PG8_MMA(1, 0, At, B0); PG8_MMA(1, 1, At, B1); PG8_BAR; PG8_SCHED;
            } else {
            PG8_LDB(B0, 0, 0); PG8_SCHED; PG8_LDA(At, 0, 0); PG8_STAGE(PG8_SA(1, 1), a1 + hstep, voffA);
            PG8_WAIT_L(8); PG8_BAR; PG8_WAIT_L(0); PG8_MMA(0, 0, At, B0); PG8_BAR; PG8_SCHED;
            PG8_LDB(B1, 0, 1); PG8_STAGE(PG8_SB(0, 0), b2, voffB);
            PG8_BAR; PG8_WAIT_L(0); PG8_MMA(0, 1, At, B1); PG8_BAR;
            PG8_LDA(At, 0, 1); PG8_STAGE(PG8_SA(0, 0), a2, voffA);
            PG8_BAR; PG8_WAIT_L(0); PG8_MMA(1, 0, At, B0); PG8_BAR; PG8_SCHED;
            PG8_STAGE(PG8_SB(0, 1), b2 + hstep, voffB);
            PG8_WAIT_V(6); PG8_BAR; PG8_MMA(1, 1, At, B1); PG8_BAR;
            PG8_LDB(B0, 1, 0); PG8_SCHED; PG8_LDA(At, 1, 0); PG8_STAGE(PG8_SA(0, 1), a2 + hstep, voffA);
            PG8_WAIT_L(8); PG8_BAR; PG8_WAIT_L(0); PG8_MMA(0, 0, At, B0); PG8_BAR; PG8_SCHED;
            PG8_LDB(B1, 1, 1); PG8_STAGE(PG8_SB(1, 0), b3, voffB);
            PG8_BAR; PG8_WAIT_L(0); PG8_MMA(0, 1, At, B1); PG8_BAR;
            PG8_LDA(At, 1, 1); PG8_STAGE(PG8_SA(1, 0), a3, voffA);
            PG8_BAR; PG8_WAIT_L(0); PG8_MMA(1, 0, At, B0); PG8_BAR; PG8_SCHED;
            PG8_STAGE(PG8_SB(1, 1), b3 + hstep, voffB);
            PG8_WAIT_V(6); PG8_BAR; PG8_MMA(1, 1, At, B1); PG8_BAR;
            }
        }
        if constexpr (ALIGN_EPI) { if (wr == 0) PG8_BAR; }
        if constexpr (!Epi::AFTER_DRAIN) { E(acc, cur, wr, wc, fr, fq); S.done(cur); }
        if (!has_next) break;
#pragma unroll
        for (int a = 0; a < 2; ++a)
#pragma unroll
            for (int b = 0; b < 2; ++b)
#pragma unroll
                for (int m = 0; m < 4; ++m)
#pragma unroll
                    for (int n = 0; n < 2; ++n) acc[a][b][m][n] = (f32x4){0.f, 0.f, 0.f, 0.f};
        cur = nxt; cA = nA; cB = nB; ++ui;
        if constexpr (ALIGN_EPI) { if (wr == 1) PG8_BAR; }
    }
    PG8_WAIT_V(0);
    if constexpr (!ALIGN_EPI) { if (wr == 0) PG8_BAR; }
    PG8_BAR;
    if constexpr (Epi::AFTER_DRAIN) { E.fused(acc, cur, wr, wc, fr, fq, lds, wid, lane); S.done(cur); }
#undef PG8_SA
#undef PG8_SB
#undef PG8_STAGE
#undef PG8_LDA
#undef PG8_LDB
#undef PG8_MMA
#undef PG8_WAIT_V
#undef PG8_WAIT_L
#undef PG8_BAR
#undef PG8_SCHED
}
}

#ifndef PG8_SP2
#define PG8_SP2 true
#endif
#ifndef PG8_ALIGN
#define PG8_ALIGN true
#endif
#ifndef MK_N_LAUNCHES
#define MK_N_LAUNCHES 1
#endif

constexpr int D = 1024, BP = 8, SEQ = 2048, MPR = BP * SEQ  , MS = 128  , MT = MPR + MS  ;
constexpr int NCOND = BP + MS;
constexpr int DFF = 2816, NMOD = 6 * D  , NMODALL = 4 * NMOD  ;
constexpr int RET_IN = 6144, SSD_IN = 5152, SSD_INM = 5120, HG_IN = 4096, FFN_IN = 2 * DFF;
constexpr float EPS = 1e-6f;
constexpr int NWAVES = 8;

constexpr size_t MiB = 1u << 20;
constexpr size_t WS_CTL = 0, CTL_ZERO_BYTES = 1 * MiB;
constexpr size_t WS_WADA = 1 * MiB;
constexpr size_t WS_WRETIN = WS_WADA + 48 * MiB;
constexpr size_t WS_WRETOUT = WS_WRETIN + 24 * MiB;
constexpr size_t WS_WSSDIN = WS_WRETOUT + 8 * MiB;
constexpr size_t WS_WSSDOUT = WS_WSSDIN + 11 * MiB;
constexpr size_t WS_WHGIN = WS_WSSDOUT + 4 * MiB;
constexpr size_t WS_WHGOUT = WS_WHGIN + 8 * MiB;
constexpr size_t WS_WFFNIN = WS_WHGOUT + 2 * MiB;
constexpr size_t WS_WFFNOUT = WS_WFFNIN + 44 * MiB;
constexpr size_t WS_MOD = WS_WFFNOUT + 22 * MiB;
constexpr size_t WS_CACT = WS_MOD + 24 * MiB;
constexpr size_t WS_LB = WS_CACT + 512 * 1024;
constexpr size_t WS_H = WS_CACT + 1 * MiB;
constexpr size_t WS_PROJ = WS_H + 33 * MiB;
constexpr size_t WS_RO = WS_PROJ + 200 * MiB;
constexpr size_t WS_GO = WS_RO + 65 * MiB;
constexpr size_t WS_OUT = WS_GO + 65 * MiB;
constexpr size_t WS_ACT = WS_OUT + 33 * MiB;
constexpr size_t WS_XB = WS_ACT + 89 * MiB;
constexpr size_t WS_END = WS_XB + 33 * MiB;
constexpr size_t PJ_RET_Q = 0, PJ_RET_K = PJ_RET_Q + (size_t)MT * 1024 * 2, PJ_RET_V = PJ_RET_K + (size_t)MT * 1024 * 2, PJ_RET_SG = PJ_RET_V + (size_t)MT * 2048 * 2;
constexpr size_t PJ_SSD_SZ = 0, PJ_SSD_XBC = PJ_SSD_SZ + (size_t)MT * 2048 * 2, PJ_SSD_DT = PJ_SSD_XBC + (size_t)MT * 3072 * 2;
constexpr size_t PJ_HG_Q = 0, PJ_HG_LA = PJ_HG_Q + (size_t)MT * 1024 * 2, PJ_HG_V = PJ_HG_LA + (size_t)MT * 1024 * 4, PJ_HG_SG = PJ_HG_V + (size_t)MT * 1024 * 2;
static_assert(PJ_RET_SG + (size_t)MT * 2048 * 2 <= 200 * MiB && PJ_SSD_DT + (size_t)MT * 32 * 4 <= 200 * MiB && PJ_HG_SG + (size_t)MT * 1024 * 2 <= 200 * MiB, "proj map");
constexpr int CW_BAR = 4096;
#ifndef PANEL_SYNC
#define PANEL_SYNC 1
#endif
constexpr int CW_PANEL = 16384;

constexpr size_t O_Y = 0;
constexpr size_t O_RETP = (size_t)MT * D;
constexpr size_t O_RETS = O_RETP + (size_t)2 * 8 * 4 * 256 * 512;
constexpr size_t O_SSDP = O_RETS + (size_t)2 * 128 * 4 * 256 * 512;
constexpr size_t O_SSDS = O_SSDP + (size_t)8 * 32 * 128 * 64;
constexpr size_t O_CONVP = O_SSDS + (size_t)128 * 32 * 128 * 64;
constexpr size_t O_CONVS = O_CONVP + (size_t)8 * 3 * 3072;
constexpr size_t O_HGP = O_CONVS + (size_t)128 * 3 * 3072;
constexpr size_t O_HGS = O_HGP + (size_t)8 * 8 * 128 * 128;
constexpr size_t O_END = O_HGS + (size_t)128 * 8 * 128 * 128;
static_assert(O_END == 214245376ull, "output size");

constexpr int LDS_BYTES = 147456;
constexpr int LDSCTL_OFF = LDS_BYTES - 1024;
constexpr int SCR_BYTES = LDSCTL_OFF;

#define GAS __attribute__((address_space(1)))
#define LAS __attribute__((address_space(3)))
typedef unsigned short bf16;
typedef unsigned v4u __attribute__((ext_vector_type(4)));
typedef unsigned v2u __attribute__((ext_vector_type(2)));
typedef float f32x4 __attribute__((ext_vector_type(4)));
typedef short bf16x8 __attribute__((ext_vector_type(8)));
typedef short s16x4 __attribute__((ext_vector_type(4)));
typedef GAS unsigned gu32;
#define RLX_AGENT __ATOMIC_RELAXED, __HIP_MEMORY_SCOPE_AGENT
#define LDS_WAIT() asm volatile("s_waitcnt lgkmcnt(0)" ::: "memory")
#define VM_WAIT() asm volatile("s_waitcnt vmcnt(0)" ::: "memory")
typedef float f32x2_t __attribute__((ext_vector_type(2))); typedef __bf16 bf16x2_t __attribute__((ext_vector_type(2)));
__device__ __forceinline__ unsigned cvt_pk_bf16(float lo, float hi) { f32x2_t v = {lo, hi}; bf16x2_t b = __builtin_convertvector(v, bf16x2_t); return __builtin_bit_cast(unsigned, b); }
__device__ __forceinline__ float bf2f(unsigned b) { return __uint_as_float(b << 16); }
__device__ __forceinline__ float bflo(unsigned w) { return __uint_as_float(w << 16); }
__device__ __forceinline__ float bfhi(unsigned w) { return __uint_as_float(w & 0xffff0000u); }
__device__ __forceinline__ void unpack8(const v4u w, float (&f)[8]) { f[0] = bflo(w.x); f[1] = bfhi(w.x); f[2] = bflo(w.y); f[3] = bfhi(w.y); f[4] = bflo(w.z); f[5] = bfhi(w.z); f[6] = bflo(w.w); f[7] = bfhi(w.w); }
__device__ __forceinline__ v4u pack8(const float (&f)[8]) { v4u w; w.x = cvt_pk_bf16(f[0], f[1]); w.y = cvt_pk_bf16(f[2], f[3]); w.z = cvt_pk_bf16(f[4], f[5]); w.w = cvt_pk_bf16(f[6], f[7]); return w; }
__device__ __forceinline__ v4u pack8v(const f32x4 a, const f32x4 b) { v4u w; w.x = cvt_pk_bf16(a[0], a[1]); w.y = cvt_pk_bf16(a[2], a[3]); w.z = cvt_pk_bf16(b[0], b[1]); w.w = cvt_pk_bf16(b[2], b[3]); return w; }
__device__ __forceinline__ v2u pack4v(const f32x4 a) { v2u w; w.x = cvt_pk_bf16(a[0], a[1]); w.y = cvt_pk_bf16(a[2], a[3]); return w; }
__device__ __forceinline__ float sigmoidf_(float x) { return __builtin_amdgcn_rcpf(1.f + __expf(-x)); }
__device__ __forceinline__ float siluf_(float x) { return x * sigmoidf_(x); }
__device__ __forceinline__ float softplusf_(float x) { return x > 20.f ? x : log1pf(__expf(x)); }
__device__ __forceinline__ float wave_sum(float v) {
#pragma unroll
    for (int o = 1; o < 64; o <<= 1) v += __shfl_xor(v, o);
    return v;
}
__device__ __forceinline__ float grp16_sum(float v) {
#pragma unroll
    for (int o = 1; o < 16; o <<= 1) v += __shfl_xor(v, o);
    return v;
}
#define MFMA16(a, b, c) __builtin_amdgcn_mfma_f32_16x16x32_bf16((a), (b), (c), 0, 0, 0)
#define XB_TMO      128
#define XB_XCNT(j)  (256  + 64 * (j))
#define XB_XSUB(j)  (1280 + 64 * (j))
#define XB_XGEN(j)  (2304 + 64 * (j))
#define XB_TOP      3328
#define XB_TOPGEN   3392
#define XCD_BAR_WORDS 3456
#define XB_SPIN_CAP (1u << 18)

__device__ __forceinline__ unsigned xb_ld(unsigned* p)              { return __hip_atomic_load(p, __ATOMIC_RELAXED, __HIP_MEMORY_SCOPE_AGENT); }
__device__ __forceinline__ unsigned xb_add(unsigned* p, unsigned v) { return __hip_atomic_fetch_add(p, v, __ATOMIC_RELAXED, __HIP_MEMORY_SCOPE_AGENT); }
__device__ __forceinline__ unsigned xb_xcc_id() { return (unsigned)__builtin_amdgcn_s_getreg((3 << 11) | 20) & 0xFu; }
#define XB_SPIN(cond, bar) do { unsigned _sp = 0; while (cond) { __builtin_amdgcn_s_sleep(1); \
    if ((++_sp & 255u) == 0u) { if (xb_ld(&(bar)[XB_TMO])) break; if (_sp > XB_SPIN_CAP) { atomicAdd(&(bar)[XB_TMO], 1u); break; } } } } while (0)

struct XcdBarrier {
    unsigned* bar; unsigned x;
    volatile LAS unsigned* st;
};

__device__ __forceinline__ XcdBarrier xcd_barrier_post(unsigned* bar, volatile LAS unsigned* st) {
    XcdBarrier b; b.bar = bar; b.x = xb_xcc_id(); b.st = st;
    if (threadIdx.x == 0) (void)xb_add(&bar[XB_XCNT(b.x)], 1u);
    return b;
}
__device__ __forceinline__ void xcd_barrier_complete(unsigned* bar, unsigned x, unsigned& nloc, unsigned& nx) {
    const unsigned G = gridDim.x * gridDim.y * gridDim.z;
    unsigned sum, cnt, mine, sp = 0u;
    for (;;) {
        sum = 0u; cnt = 0u; mine = 0u;
#pragma unroll
        for (unsigned j = 0; j < 16; ++j) { const unsigned c = xb_ld(&bar[XB_XCNT(j)]); sum += c; cnt += (c > 0u) ? 1u : 0u; mine = (j == x) ? c : mine; }
        if (sum == G) break;
        __builtin_amdgcn_s_sleep(1);
        if ((++sp & 255u) == 0u) { if (xb_ld(&bar[XB_TMO])) break; if (sp > XB_SPIN_CAP) { atomicAdd(&bar[XB_TMO], 1u); break; } }
    }
    nloc = mine > 0u ? mine : 1u; nx = cnt > 0u ? cnt : 1u;
}

__device__ __forceinline__ void xcd_barrier(const XcdBarrier& b) {
    asm volatile("s_waitcnt vmcnt(0)" ::: "memory");
    __syncthreads();
    if (threadIdx.x == 0) {
        unsigned* bar = b.bar;
        __builtin_amdgcn_s_waitcnt(0);
        unsigned nloc = b.st[0], nx = b.st[1];
        if (nloc == 0u) { xcd_barrier_complete(bar, b.x, nloc, nx); b.st[0] = nloc; b.st[1] = nx; }
        const unsigned old = xb_add(&bar[XB_XSUB(b.x)], 1u);
        const unsigned gen = old / nloc;
        if (old + 1u == (gen + 1u) * nloc) {
            __builtin_amdgcn_fence(__ATOMIC_RELEASE, "agent");
            asm volatile("s_waitcnt vmcnt(0)" ::: "memory");
            const unsigned og = xb_add(&bar[XB_TOP], 1u);
            const unsigned tg = og / nx;
            if (og + 1u == (tg + 1u) * nx) xb_add(&bar[XB_TOPGEN], 1u);
            else XB_SPIN(xb_ld(&bar[XB_TOPGEN]) == tg, bar);
            __builtin_amdgcn_fence(__ATOMIC_ACQUIRE, "agent");
            xb_add(&bar[XB_XGEN(b.x)], 1u);
            asm volatile("s_waitcnt vmcnt(0)" ::: "memory");
        } else {
            XB_SPIN(xb_ld(&bar[XB_XGEN(b.x)]) == gen, bar);
            __builtin_amdgcn_fence(__ATOMIC_ACQUIRE, "agent");
            asm volatile("s_waitcnt vmcnt(0)" ::: "memory");
        }
    }
    __syncthreads();
}


struct Frame {
    LAS unsigned char* lds;
    int tid, lane, wave;
    int vcu, G;
};

__device__ __forceinline__ int panel_of_wg() { const int bx = blockIdx.x; return 8 * (bx & 7) + ((bx >> 3) & 7); }
__device__ __forceinline__ int panel_row0(const Frame& F) { const int bx = blockIdx.x; return 256 * panel_of_wg() + 64 * (bx >> 6) + 8 * F.wave; }
__device__ __forceinline__ gu32* panel_word(gu32* ctl, int seam, int idx) { return ctl + CW_PANEL + (seam * 66 + idx) * 64; }
#ifndef WT_ROW
#define WT_ROW 1
#endif
#ifndef WT_G3
#define WT_G3 1
#endif
#ifndef WT_OUT
#define WT_OUT 1
#endif
template <bool WT = true>
__device__ __forceinline__ void st16_wt(void* rowbase, int nbytes, int byteoff, const v4u v) {
    const __amdgpu_buffer_rsrc_t rs = __builtin_amdgcn_make_buffer_rsrc(rowbase, (short)0, nbytes, 0x00020000);
    __builtin_amdgcn_raw_buffer_store_b128(v, rs, byteoff, 0,   WT ? 16 : 0);
}
__device__ __forceinline__ void panel_publish(Frame& F, gu32* ctl, int seam, int pm, unsigned nsample, bool rel = false) {
    asm volatile("s_waitcnt vmcnt(0)" ::: "memory");
    __syncthreads();
    if (F.tid == 0) { if (rel) { __builtin_amdgcn_fence(__ATOMIC_RELEASE, "agent"); asm volatile("s_waitcnt vmcnt(0)" ::: "memory"); }
        (void)__hip_atomic_fetch_add(panel_word(ctl, seam, pm), 1u, RLX_AGENT); (void)__hip_atomic_fetch_add(panel_word(ctl, seam, 65), 1u, RLX_AGENT);
        if (nsample) (void)__hip_atomic_fetch_add(panel_word(ctl, seam, 64), nsample, RLX_AGENT); }
}
__device__ __forceinline__ void panel_wait(Frame& F, gu32* word, unsigned want, gu32* tmo) {
    if (F.wave == 0) { unsigned sp = 0;
        while ((unsigned)__builtin_amdgcn_readfirstlane(__hip_atomic_load(word, RLX_AGENT)) < want) { __builtin_amdgcn_s_sleep(1);
            if ((++sp & 255u) == 0u) { if (__builtin_amdgcn_readfirstlane(__hip_atomic_load(tmo, RLX_AGENT))) break;
                if (sp > (1u << 18)) { if (F.lane == 0) (void)__hip_atomic_fetch_add(tmo, 1u, RLX_AGENT); break; } } }
        __builtin_amdgcn_fence(__ATOMIC_ACQUIRE, "agent");
        asm volatile("s_waitcnt vmcnt(0)" ::: "memory"); }
    __syncthreads();
}

__device__ __forceinline__ void gemm_prefetch_b(LAS unsigned char* lds, const bf16* Bt, int N, int K, int G, int c, int tid, int wid) {
    pg8::StaticOrder S; S.init(MPR, N, G, c); pg8::Unit u; if (!S.next(0, u)) return;
    const size_t hstep = (size_t)pg8::HALF * K * 2;
    const char* cB = (const char*)Bt + (size_t)u.pn * (2 * hstep);
#pragma unroll
    for (int h = 0; h < 2; ++h)
#pragma unroll
        for (int i = 0; i < 2; ++i) { int R, C; pg8::stage_rc(tid * 16 + i * 8192, R, C); const int Rb = (R & ~31) + pg8::perm32(R & 31);
            __builtin_amdgcn_global_load_lds((const unsigned*)(cB + h * hstep + (size_t)(unsigned)(Rb * K + C) * 2u), (LAS unsigned*)(lds + (4 + h) * pg8::HTB + wid * 1024 + i * 8192), 16, 0, 0); }
}
__device__ __forceinline__ void xcd_barrier_pf(const XcdBarrier& b, Frame& F, const bf16* Bt, int N, int K) {
    asm volatile("s_waitcnt vmcnt(0)" ::: "memory");
    __syncthreads();
    if (F.wave != 0) gemm_prefetch_b(F.lds, Bt, N, K, F.G, (int)blockIdx.x, F.tid, F.wave);
    if (threadIdx.x == 0) {
        unsigned* bar = b.bar;
        __builtin_amdgcn_s_waitcnt(0);
        unsigned nloc = b.st[0], nx = b.st[1];
        if (nloc == 0u) { xcd_barrier_complete(bar, b.x, nloc, nx); b.st[0] = nloc; b.st[1] = nx; }
        const unsigned old = xb_add(&bar[XB_XSUB(b.x)], 1u);
        const unsigned gen = old / nloc;
        if (old + 1u == (gen + 1u) * nloc) {
            __builtin_amdgcn_fence(__ATOMIC_RELEASE, "agent");
            asm volatile("s_waitcnt vmcnt(0)" ::: "memory");
            const unsigned og = xb_add(&bar[XB_TOP], 1u);
            const unsigned tg = og / nx;
            if (og + 1u == (tg + 1u) * nx) xb_add(&bar[XB_TOPGEN], 1u);
            else XB_SPIN(xb_ld(&bar[XB_TOPGEN]) == tg, bar);
            __builtin_amdgcn_fence(__ATOMIC_ACQUIRE, "agent");
            xb_add(&bar[XB_XGEN(b.x)], 1u);
            asm volatile("s_waitcnt vmcnt(0)" ::: "memory");
        } else {
            XB_SPIN(xb_ld(&bar[XB_XGEN(b.x)]) == gen, bar);
            __builtin_amdgcn_fence(__ATOMIC_ACQUIRE, "agent");
            asm volatile("s_waitcnt vmcnt(0)" ::: "memory");
        }
    }
    __syncthreads();
}

template <class Fn> struct EpiGen {
    static constexpr bool PERM = true, AFTER_DRAIN = false;
    Fn f;
    __device__ __forceinline__ void operator()(const pg8::f32x4 (&acc)[2][2][4][2], const pg8::Unit& u, int wr, int wc, int fr, int fq) const {
        const int ca = u.pn * 256 + wc * 32 + 8 * fq;
#pragma unroll
        for (int ai = 0; ai < 2; ++ai)
#pragma unroll
            for (int m = 0; m < 4; ++m) {
                const int row = u.pm * 256 + ai * 128 + wr * 64 + m * 16 + fr;
                f.emit(row, ca, ca + 128, acc[ai][0][m][0], acc[ai][0][m][1], acc[ai][1][m][0], acc[ai][1][m][1]);
            }
    }
};
__device__ __forceinline__ void st8bf(bf16* p, const f32x4 a, const f32x4 b) { *(GAS v4u*)p = pack8v(a, b); }
__device__ __forceinline__ f32x4 silu4(const f32x4 a) { f32x4 r; r[0] = siluf_(a[0]); r[1] = siluf_(a[1]); r[2] = siluf_(a[2]); r[3] = siluf_(a[3]); return r; }

struct EmitRetIn {
    bf16 *Q, *K, *V, *SG;
    __device__ __forceinline__ void emit(int row, int ca, int cb, const f32x4 a0, const f32x4 a1, const f32x4 b0, const f32x4 b1) const {
        const int pn = ca >> 8, ch = ca & 255;
        if (pn < 8) {
            const float pos = row < MPR ? (float)(row & (SEQ - 1)) : 16384.f;
            const float sc = pn < 4 ? 1.f : 0.0625f;
            float x1[8] = {a0[0], a0[1], a0[2], a0[3], a1[0], a1[1], a1[2], a1[3]}, x2[8] = {b0[0], b0[1], b0[2], b0[3], b1[0], b1[1], b1[2], b1[3]}, o1[8], o2[8];
#pragma unroll
            for (int e = 0; e < 8; ++e) {
                const float inv = exp2f(-(float)(ch + e) * (13.287712379549449f / 128.f));
                float t = pos * inv * 0.15915494309189535f; t -= floorf(t);
                const float s = __builtin_amdgcn_sinf(t), c = __builtin_amdgcn_cosf(t);
                o1[e] = (x1[e] * c - x2[e] * s) * sc; o2[e] = (x2[e] * c + x1[e] * s) * sc;
            }
            bf16* dst = (pn < 4 ? Q : K) + (size_t)row * 1024 + (pn & 3) * 256 + ch;
            *(GAS v4u*)dst = pack8(o1); *(GAS v4u*)(dst + 128) = pack8(o2);
        } else if (pn < 16) {
            bf16* dst = V + (size_t)row * 2048 + (pn - 8) * 256 + ch; st8bf(dst, a0, a1); st8bf(dst + 128, b0, b1);
        } else {
            bf16* dst = SG + (size_t)row * 2048 + (pn - 16) * 256 + ch; st8bf(dst, silu4(a0), silu4(a1)); st8bf(dst + 128, silu4(b0), silu4(b1));
        }
    }
};
struct EmitSsdIn {
    bf16 *SZ, *XBC;
    __device__ __forceinline__ void emit(int row, int ca, int cb, const f32x4 a0, const f32x4 a1, const f32x4 b0, const f32x4 b1) const {
        const int pn = ca >> 8, ch = ca & 255;
        if (pn < 8) { bf16* dst = SZ + (size_t)row * 2048 + pn * 256 + ch; st8bf(dst, silu4(a0), silu4(a1)); st8bf(dst + 128, silu4(b0), silu4(b1)); }
        else { bf16* dst = XBC + (size_t)row * 3072 + (pn - 8) * 256 + ch; st8bf(dst, a0, a1); st8bf(dst + 128, b0, b1); }
    }
};
struct EmitDt {
    float* DT;
    __device__ __forceinline__ void emit(int row, int ca, int cb, const f32x4 a0, const f32x4 a1, const f32x4 b0, const f32x4 b1) const {
        float* d = DT + (size_t)row * 32; *(GAS f32x4*)(d + (ca - SSD_INM)) = a0; *(GAS f32x4*)(d + (ca - SSD_INM) + 4) = a1; *(GAS f32x4*)(d + (cb - SSD_INM)) = b0; *(GAS f32x4*)(d + (cb - SSD_INM) + 4) = b1;
    }
};
struct EmitHgIn {
    bf16 *HQ, *HV, *HSG; float* LA; const float* lb;
    __device__ __forceinline__ f32x4 logf4(const f32x4 x, const f32x4 l) const { f32x4 r;
#pragma unroll
        for (int e = 0; e < 4; ++e) r[e] = logf(l[e] + (1.f - l[e]) * sigmoidf_(x[e]));
        return r; }
    __device__ __forceinline__ void emit(int row, int ca, int cb, const f32x4 a0, const f32x4 a1, const f32x4 b0, const f32x4 b1) const {
        const int pn = ca >> 8, ch = ca & 255;
        if (pn < 4) { bf16* dst = HQ + (size_t)row * 1024 + pn * 256 + ch; const float s = 0.08838834764831845f; st8bf(dst, silu4(a0) * s, silu4(a1) * s); st8bf(dst + 128, silu4(b0) * s, silu4(b1) * s); }
        else if (pn < 8) { const int col = (pn - 4) * 256 + ch; float* dst = LA + (size_t)row * 1024 + col;
            const f32x4 l0 = *(const GAS f32x4*)(lb + col), l1 = *(const GAS f32x4*)(lb + col + 4), l2 = *(const GAS f32x4*)(lb + col + 128), l3 = *(const GAS f32x4*)(lb + col + 132);
            const f32x4 r0 = logf4(a0, l0), r1 = logf4(a1, l1), r2 = logf4(b0, l2), r3 = logf4(b1, l3);
            *(GAS f32x4*)dst = r0; *(GAS f32x4*)(dst + 4) = r1; *(GAS f32x4*)(dst + 128) = r2; *(GAS f32x4*)(dst + 132) = r3; }
        else if (pn < 12) { bf16* dst = HV + (size_t)row * 1024 + (pn - 8) * 256 + ch; st8bf(dst, a0, a1); st8bf(dst + 128, b0, b1); }
        else { bf16* dst = HSG + (size_t)row * 1024 + (pn - 12) * 256 + ch; st8bf(dst, silu4(a0), silu4(a1)); st8bf(dst + 128, silu4(b0), silu4(b1)); }
    }
};
struct EmitOut {
    bf16* OUT;
    __device__ __forceinline__ void emit(int row, int ca, int cb, const f32x4 a0, const f32x4 a1, const f32x4 b0, const f32x4 b1) const {
        if (PANEL_SYNC) { const int o_ = row * 2048; st16_wt<WT_OUT>(OUT, MT * 1024 * 2, o_ + ca * 2, pack8v(a0, a1)); st16_wt<WT_OUT>(OUT, MT * 1024 * 2, o_ + cb * 2, pack8v(b0, b1)); }
        else { bf16* dst = OUT + (size_t)row * 1024; st8bf(dst + ca, a0, a1); st8bf(dst + cb, b0, b1); }
    }
};
struct EmitFfnIn {
    bf16* ACT;
    __device__ __forceinline__ void emit(int row, int ca, int cb, const f32x4 a0, const f32x4 a1, const f32x4 b0, const f32x4 b1) const {
        if (PANEL_SYNC) st16_wt<WT_G3>(ACT, MT * DFF * 2, (row * DFF + (ca >> 8) * 128 + (ca & 255)) * 2, pack8v(silu4(a0) * b0, silu4(a1) * b1));
        else { bf16* dst = ACT + (size_t)row * DFF + (ca >> 8) * 128 + (ca & 255); st8bf(dst, silu4(a0) * b0, silu4(a1) * b1); }
    }
};
struct EmitMod {
    float* MOD; const float* bias;
    __device__ __forceinline__ void emit(int row, int ca, int cb, const f32x4 a0, const f32x4 a1, const f32x4 b0, const f32x4 b1) const {
        float* d = MOD + (size_t)row * NMODALL;
        const f32x4 q0 = *(const GAS f32x4*)(bias + ca), q1 = *(const GAS f32x4*)(bias + ca + 4), q2 = *(const GAS f32x4*)(bias + cb), q3 = *(const GAS f32x4*)(bias + cb + 4);
        *(GAS f32x4*)(d + ca) = a0 + q0; *(GAS f32x4*)(d + ca + 4) = a1 + q1; *(GAS f32x4*)(d + cb) = b0 + q2; *(GAS f32x4*)(d + cb + 4) = b1 + q3;
    }
};

__device__ __forceinline__ bf16x8 frag_perm(const bf16x8 v, const int addr) {
    const v4u u = __builtin_bit_cast(v4u, v); v4u r;
    r.x = (unsigned)__builtin_amdgcn_ds_bpermute(addr, (int)u.x); r.y = (unsigned)__builtin_amdgcn_ds_bpermute(addr, (int)u.y);
    r.z = (unsigned)__builtin_amdgcn_ds_bpermute(addr, (int)u.z); r.w = (unsigned)__builtin_amdgcn_ds_bpermute(addr, (int)u.w);
    return __builtin_bit_cast(bf16x8, r);
}
template <int NMT, class Fn>
__device__ __forceinline__ void skinny_gemm(Frame& F, const bf16* A, int K, int nrg, int nrows, int rowbase, const bf16* Bt, int ncu, bool dtmode, const Fn& f, int wg0, int span) {
    const int w = F.wave, lane = F.lane, fr = lane & 15, fq = lane >> 4;
    const int TP = K >> 6, pb = TP >> 3, prem = TP & 7, npairs = pb + (w < prem ? 1 : 0), kw0 = (w * pb + (w < prem ? w : prem)) * 64;
    constexpr int R = NMT * 16;
    LAS unsigned char* red = F.lds;
    const int nun = nrg * ncu, me = (int)blockIdx.x - wg0;
    if (me >= 0 && me < span) {
    for (int u = me; u < nun; u += span) {
        const int rg = u / ncu, cu = u - rg * ncu;
        int ca, cb; if (dtmode) { ca = SSD_INM; cb = SSD_INM + 16; } else { ca = 256 * (cu >> 3) + 16 * (cu & 7); cb = ca + 128; }
        const int lrow = lane >> 2, lpc = lane & 3;
        const bf16* ap = A + (size_t)(rg * R + lrow) * K + kw0 + lpc * 8;
        const bf16* bpa = Bt + (size_t)(ca + lrow) * K + kw0 + lpc * 8;
        const bf16* bpb = Bt + (size_t)(cb + lrow) * K + kw0 + lpc * 8;
        const int paddr = (4 * fr + fq) * 4;
        f32x4 acc[NMT][2];
#pragma unroll
        for (int mt = 0; mt < NMT; ++mt) { acc[mt][0] = (f32x4){0.f, 0.f, 0.f, 0.f}; acc[mt][1] = (f32x4){0.f, 0.f, 0.f, 0.f}; }
        constexpr int DEPTH = (NMT >= 8) ? 1 : 2;
        bf16x8 ra[DEPTH][2][NMT], rb0[DEPTH][2], rb1[DEPTH][2];
#define SK_LOAD(d_, pp_) do { _Pragma("unroll") for (int h_ = 0; h_ < 2; ++h_) { const int k_ = (pp_) * 64 + h_ * 32; \
            rb0[d_][h_] = *(const GAS bf16x8*)(bpa + k_); rb1[d_][h_] = *(const GAS bf16x8*)(bpb + k_); \
            _Pragma("unroll") for (int mt_ = 0; mt_ < NMT; ++mt_) ra[d_][h_][mt_] = *(const GAS bf16x8*)(ap + (size_t)mt_ * 16 * K + k_); } } while (0)
#define SK_MMA(d_) do { _Pragma("unroll") for (int h_ = 0; h_ < 2; ++h_) { const bf16x8 fb0_ = frag_perm(rb0[d_][h_], paddr), fb1_ = frag_perm(rb1[d_][h_], paddr); \
            _Pragma("unroll") for (int mt_ = 0; mt_ < NMT; ++mt_) { const bf16x8 fa_ = frag_perm(ra[d_][h_][mt_], paddr); \
                acc[mt_][0] = MFMA16(fb0_, fa_, acc[mt_][0]); acc[mt_][1] = MFMA16(fb1_, fa_, acc[mt_][1]); } } } while (0)
        if constexpr (DEPTH == 1) {
            SK_LOAD(0, 0);
            for (int pp = 0; pp < npairs; ++pp) { SK_MMA(0); SK_LOAD(0, pp + 1 < npairs ? pp + 1 : pp); }
        } else {
            SK_LOAD(0, 0); SK_LOAD(1, npairs > 1 ? 1 : 0);
            for (int pp = 0; pp < npairs; pp += 2) {
                SK_MMA(0); SK_LOAD(0, pp + 2 < npairs ? pp + 2 : pp);
                if (pp + 1 < npairs) { SK_MMA(1); SK_LOAD(1, pp + 3 < npairs ? pp + 3 : pp + 1); }
            }
        }
#undef SK_LOAD
#undef SK_MMA
        __syncthreads();
#pragma unroll
        for (int mt = 0; mt < NMT; ++mt)
#pragma unroll
            for (int nt = 0; nt < 2; ++nt) { const int row = mt * 16 + fr; *(LAS f32x4*)(red + ((w * R + row) * 8 + ((4 * nt + fq) ^ (row & 7))) * 16) = acc[mt][nt]; }
        __syncthreads();
        if (F.tid < 2 * R) {
            const int row = F.tid >> 1, hf = F.tid & 1;
            f32x4 va0 = (f32x4){0.f, 0.f, 0.f, 0.f}, va1 = va0, vb0 = va0, vb1 = va0;
#pragma unroll
            for (int ww = 0; ww < 8; ++ww) { const LAS unsigned char* pr = red + (ww * R + row) * 128;
                va0 += *(const LAS f32x4*)(pr + ((2 * hf) ^ (row & 7)) * 16); va1 += *(const LAS f32x4*)(pr + ((2 * hf + 1) ^ (row & 7)) * 16);
                vb0 += *(const LAS f32x4*)(pr + ((4 + 2 * hf) ^ (row & 7)) * 16); vb1 += *(const LAS f32x4*)(pr + ((5 + 2 * hf) ^ (row & 7)) * 16); }
            if (rg * R + row < nrows) f.emit(rowbase + rg * R + row, ca + hf * 8, cb + hf * 8, va0, va1, vb0, vb1);
        }
    }
    }
    __syncthreads();
}
static_assert(8 * 128 * 128 <= SCR_BYTES, "skinny reduction buffer");

__device__ __forceinline__ int cond_of_row(int row) { return row < MPR ? (row >> 11) : (BP + row - MPR); }
#define RNCOL(lane_, k_) (8 * (lane_) + 512 * ((k_) >> 1) + 4 * ((k_) & 1))
struct RnParams { f32x4 gwp[4], a[4], sh[4]; };
template <int MODE>
__device__ __forceinline__ void rn_load_params(RnParams& P, const float* modr, const float* wpost, int goff, const float* wpre, int shoff, int scoff, int lane) {
#pragma unroll
    for (int j = 0; j < 4; ++j) { const int c = RNCOL(lane, j);
        if (MODE != 0) P.gwp[j] = *(const GAS f32x4*)(modr + goff + c) * *(const GAS f32x4*)(wpost + c);
        if (MODE != 2) { P.a[j] = *(const GAS f32x4*)(wpre + c) * (*(const GAS f32x4*)(modr + scoff + c) + 1.f); P.sh[j] = *(const GAS f32x4*)(modr + shoff + c); } }
}
template <int MODE>
__device__ __forceinline__ void rn_row(const RnParams& P, f32x4 (&x)[4], const v2u (&yw)[4], bf16* Xbrow, float* Xfrow, bf16* Hrow, int lane, bool wt = false) {
    if (MODE != 0) {
        f32x4 y[4]; float ss = 0.f;
#pragma unroll
        for (int j = 0; j < 4; ++j) { y[j] = (f32x4){bflo(yw[j].x), bfhi(yw[j].x), bflo(yw[j].y), bfhi(yw[j].y)}; ss += (y[j][0] * y[j][0] + y[j][1] * y[j][1]) + (y[j][2] * y[j][2] + y[j][3] * y[j][3]); }
        const float r1 = rsqrtf(wave_sum(ss) * (1.f / D) + EPS);
#pragma unroll
        for (int j = 0; j < 4; ++j) x[j] = x[j] + P.gwp[j] * (y[j] * r1);
    }
#pragma unroll
    for (int j = 0; j < 4; ++j) { if (MODE == 2) *(GAS f32x4*)(Xfrow + RNCOL(lane, j)) = x[j]; else *(GAS v2u*)(Xbrow + RNCOL(lane, j)) = pack4v(x[j]); }
    if (MODE != 2) {
        float s2 = 0.f;
#pragma unroll
        for (int j = 0; j < 4; ++j) s2 += (x[j][0] * x[j][0] + x[j][1] * x[j][1]) + (x[j][2] * x[j][2] + x[j][3] * x[j][3]);
        const float r2 = rsqrtf(wave_sum(s2) * (1.f / D) + EPS);
#pragma unroll
        for (int j = 0; j < 4; ++j) x[j] = (x[j] * r2) * P.a[j] + P.sh[j];
        if (wt) { st16_wt<WT_ROW>(Hrow, D * 2, 16 * lane, pack8v(x[0], x[1])); st16_wt<WT_ROW>(Hrow, D * 2, 1024 + 16 * lane, pack8v(x[2], x[3])); }
        else {
#pragma unroll
            for (int j = 0; j < 4; ++j) *(GAS v2u*)(Hrow + RNCOL(lane, j)) = pack4v(x[j]); }
    }
}
__device__ __forceinline__ f32x4 ld_x4(const bf16* p) { const v2u w = *(const GAS v2u*)p; return (f32x4){bflo(w.x), bfhi(w.x), bflo(w.y), bfhi(w.y)}; }
template <int MODE>
__device__ __forceinline__ void resnorm_phase(Frame& F, const float* xp, const float* xs, bf16* Xb, float* Xf, const bf16* Y, bf16* H, const float* MOD,
                                              const float* wpost, int goff, const float* wpre, int shoff, int scoff, bool ps = false, gu32* swait = nullptr, gu32* tmo = nullptr) {
    const int gw = F.vcu * NWAVES + F.wave, NGW = F.G * NWAVES, lane = F.lane;
    const int per = (MPR + NGW - 1) / NGW;
    RnParams P;
    const int srow_ = MPR + gw; const bool has_s = (per == 8) && srow_ < MT;
    f32x4 sx_[4]; v2u sy_[4];
#pragma unroll
    for (int j = 0; j < 4; ++j) { sx_[j] = (f32x4){0.f, 0.f, 0.f, 0.f}; sy_[j] = (v2u){0u, 0u}; }
    if (has_s && swait != nullptr) panel_wait(F, swait, 256u, tmo);
    if (has_s) {
#pragma unroll
        for (int j = 0; j < 4; ++j) { const int c_ = RNCOL(lane, j); sx_[j] = (MODE == 0) ? *(const GAS f32x4*)(xs + (size_t)(srow_ - MPR) * D + c_) : ld_x4(Xb + (size_t)srow_ * D + c_); if (MODE != 0) sy_[j] = *(const GAS v2u*)(Y + (size_t)srow_ * D + c_); } }
    if (per == 8) {
        const int r0 = ps ? panel_row0(F) : gw * 8;
        rn_load_params<MODE>(P, MOD + (size_t)(r0 >> 11) * NMODALL, wpost, goff, wpre, shoff, scoff, lane);
        f32x4 qx[3][4]; v2u qy[3][4];
#define RN_FETCH(s_, row_) do { _Pragma("unroll") for (int j_ = 0; j_ < 4; ++j_) { const size_t o_ = (size_t)(row_) * D + RNCOL(lane, j_); \
            qx[s_][j_] = (MODE == 0) ? *(const GAS f32x4*)(xp + o_) : ld_x4(Xb + o_); qy[s_][j_] = (v2u){0u, 0u}; if (MODE != 0) qy[s_][j_] = *(const GAS v2u*)(Y + o_); } } while (0)
        RN_FETCH(0, r0); RN_FETCH(1, r0 + 1); RN_FETCH(2, r0 + 2);
#pragma unroll
        for (int i = 0; i < 8; ++i) {
            f32x4 x[4]; v2u yw[4];
#pragma unroll
            for (int j = 0; j < 4; ++j) { x[j] = qx[i % 3][j]; yw[j] = qy[i % 3][j]; }
            if (i + 3 < 8) RN_FETCH(i % 3, r0 + i + 3);
            rn_row<MODE>(P, x, yw, Xb + (size_t)(r0 + i) * D, Xf + (size_t)(r0 + i) * D, H + (size_t)(r0 + i) * D, lane, ps);
        }
#undef RN_FETCH
    } else
    for (int r0 = gw * per; r0 < MPR; r0 += NGW * per) {
        const int r1 = (r0 + per < MPR) ? r0 + per : MPR;
        int cond = r0 >> 11;
        rn_load_params<MODE>(P, MOD + (size_t)cond * NMODALL, wpost, goff, wpre, shoff, scoff, lane);
        f32x4 xn[4]; v2u yn[4];
#pragma unroll
        for (int j = 0; j < 4; ++j) { const size_t o_ = (size_t)r0 * D + RNCOL(lane, j); xn[j] = (MODE == 0) ? *(const GAS f32x4*)(xp + o_) : ld_x4(Xb + o_); yn[j] = (v2u){0u, 0u}; if (MODE != 0) yn[j] = *(const GAS v2u*)(Y + o_); }
        for (int row = r0; row < r1; ++row) {
            f32x4 x[4]; v2u yw[4];
#pragma unroll
            for (int j = 0; j < 4; ++j) { x[j] = xn[j]; yw[j] = yn[j]; }
            if ((row >> 11) != cond) { cond = row >> 11; rn_load_params<MODE>(P, MOD + (size_t)cond * NMODALL, wpost, goff, wpre, shoff, scoff, lane); }
            if (row + 1 < r1) {
#pragma unroll
                for (int j = 0; j < 4; ++j) { const size_t o_ = (size_t)(row + 1) * D + RNCOL(lane, j); xn[j] = (MODE == 0) ? *(const GAS f32x4*)(xp + o_) : ld_x4(Xb + o_); if (MODE != 0) yn[j] = *(const GAS v2u*)(Y + o_); } }
            rn_row<MODE>(P, x, yw, Xb + (size_t)row * D, Xf + (size_t)row * D, H + (size_t)row * D, lane);
        }
    }
    if (has_s) {
        rn_load_params<MODE>(P, MOD + (size_t)cond_of_row(srow_) * NMODALL, wpost, goff, wpre, shoff, scoff, lane);
        rn_row<MODE>(P, sx_, sy_, Xb + (size_t)srow_ * D, Xf + (size_t)srow_ * D, H + (size_t)srow_ * D, lane, ps);
    } else if (per != 8)
    for (int row = MPR + gw; row < MT; row += NGW) {
        rn_load_params<MODE>(P, MOD + (size_t)cond_of_row(row) * NMODALL, wpost, goff, wpre, shoff, scoff, lane);
        f32x4 x[4]; v2u yw[4];
#pragma unroll
        for (int j = 0; j < 4; ++j) { const int c_ = RNCOL(lane, j); x[j] = (MODE == 0) ? *(const GAS f32x4*)(xs + (size_t)(row - MPR) * D + c_) : ld_x4(Xb + (size_t)row * D + c_); yw[j] = (v2u){0u, 0u}; if (MODE != 0) yw[j] = *(const GAS v2u*)(Y + (size_t)row * D + c_); }
        rn_row<MODE>(P, x, yw, Xb + (size_t)row * D, Xf + (size_t)row * D, H + (size_t)row * D, lane);
    }
}
template <int MIX>
__device__ __forceinline__ void gatenorm_phase(Frame& F, const bf16* RO, const bf16* GATE, bf16* GO, const float* nw, bool ps = false) {
    const int gw = F.vcu * NWAVES + F.wave, NGW = F.G * NWAVES, lane = F.lane;
    constexpr int W = (MIX == 2) ? 1024 : 2048, NJ = W / 512;
    const int per = (MPR + NGW - 1) / NGW;
    float wv[NJ][8];
#pragma unroll
    for (int j = 0; j < NJ; ++j)
#pragma unroll
        for (int e = 0; e < 8; ++e) { const int c = 8 * lane + 512 * j + e; wv[j][e] = (MIX == 1) ? nw[c] : ((MIX == 2) ? nw[c & 127] : 1.f); }
    const int srow_ = MPR + gw; const bool has_s = (per == 8) && srow_ < MT;
    v4u so_[NJ], sg_[NJ];
#pragma unroll
    for (int j = 0; j < NJ; ++j) { so_[j] = (v4u){0u, 0u, 0u, 0u}; sg_[j] = so_[j]; }
    if (has_s) {
#pragma unroll
        for (int j = 0; j < NJ; ++j) { so_[j] = *(const GAS v4u*)(RO + (size_t)srow_ * W + 8 * lane + 512 * j); sg_[j] = *(const GAS v4u*)(GATE + (size_t)srow_ * W + 8 * lane + 512 * j); } }
    if (per == 8) {
        const int r0 = ps ? panel_row0(F) : gw * 8;
        v4u qo[3][NJ], qg[3][NJ];
#define GN_FETCH(s_, row_) do { _Pragma("unroll") for (int j_ = 0; j_ < NJ; ++j_) { qo[s_][j_] = *(const GAS v4u*)(RO + (size_t)(row_) * W + 8 * lane + 512 * j_); qg[s_][j_] = *(const GAS v4u*)(GATE + (size_t)(row_) * W + 8 * lane + 512 * j_); } } while (0)
        GN_FETCH(0, r0); GN_FETCH(1, r0 + 1); GN_FETCH(2, r0 + 2);
#pragma unroll
        for (int i = 0; i < 8; ++i) {
            v4u oc[NJ], gc[NJ];
#pragma unroll
            for (int j = 0; j < NJ; ++j) { oc[j] = qo[i % 3][j]; gc[j] = qg[i % 3][j]; }
            if (i + 3 < 8) GN_FETCH(i % 3, r0 + i + 3);
            float u[NJ][8], r[NJ];
#pragma unroll
            for (int j = 0; j < NJ; ++j) {
                float o[8], g[8]; unpack8(oc[j], o); unpack8(gc[j], g);
                float ss = 0.f;
#pragma unroll
                for (int e = 0; e < 8; ++e) { u[j][e] = o[e] * g[e]; ss += (MIX == 1) ? u[j][e] * u[j][e] : o[e] * o[e]; }
                if (MIX == 2) r[j] = rsqrtf(grp16_sum(ss) * (1.f / 128.f) + EPS); else r[j] = rsqrtf(wave_sum(ss) * (1.f / 512.f) + EPS);
            }
#pragma unroll
            for (int j = 0; j < NJ; ++j) { float v[8];
#pragma unroll
                for (int e = 0; e < 8; ++e) v[e] = u[j][e] * r[j] * wv[j][e];
                if (ps) st16_wt<WT_ROW>(GO + (size_t)(r0 + i) * W, W * 2, (8 * lane + 512 * j) * 2, pack8(v)); else *(GAS v4u*)(GO + (size_t)(r0 + i) * W + 8 * lane + 512 * j) = pack8(v); }
        }
#undef GN_FETCH
        if (has_s) {
            float u[NJ][8], r[NJ];
#pragma unroll
            for (int j = 0; j < NJ; ++j) {
                float o[8], g[8]; unpack8(so_[j], o); unpack8(sg_[j], g);
                float ss = 0.f;
#pragma unroll
                for (int e = 0; e < 8; ++e) { u[j][e] = o[e] * g[e]; ss += (MIX == 1) ? u[j][e] * u[j][e] : o[e] * o[e]; }
                if (MIX == 2) r[j] = rsqrtf(grp16_sum(ss) * (1.f / 128.f) + EPS); else r[j] = rsqrtf(wave_sum(ss) * (1.f / 512.f) + EPS);
            }
#pragma unroll
            for (int j = 0; j < NJ; ++j) { float v[8];
#pragma unroll
                for (int e = 0; e < 8; ++e) v[e] = u[j][e] * r[j] * wv[j][e];
                if (ps) st16_wt<WT_ROW>(GO + (size_t)srow_ * W, W * 2, (8 * lane + 512 * j) * 2, pack8(v)); else *(GAS v4u*)(GO + (size_t)srow_ * W + 8 * lane + 512 * j) = pack8(v); }
        }
    }
#pragma unroll 1
    for (int seg = (per == 8) ? 2 : 0; seg < 2; ++seg) {
        const int r0 = seg == 0 ? gw * per : MPR + gw;
        const int r1 = seg == 0 ? ((r0 + per < MPR) ? r0 + per : MPR) : ((r0 < MT) ? r0 + 1 : r0);
        if (r0 >= r1) continue;
        v4u on[NJ], gn[NJ];
#pragma unroll
        for (int j = 0; j < NJ; ++j) { on[j] = *(const GAS v4u*)(RO + (size_t)r0 * W + 8 * lane + 512 * j); gn[j] = *(const GAS v4u*)(GATE + (size_t)r0 * W + 8 * lane + 512 * j); }
        for (int row = r0; row < r1; ++row) {
            v4u oc[NJ], gc[NJ];
#pragma unroll
            for (int j = 0; j < NJ; ++j) { oc[j] = on[j]; gc[j] = gn[j]; }
            if (row + 1 < r1) {
#pragma unroll
                for (int j = 0; j < NJ; ++j) { on[j] = *(const GAS v4u*)(RO + (size_t)(row + 1) * W + 8 * lane + 512 * j); gn[j] = *(const GAS v4u*)(GATE + (size_t)(row + 1) * W + 8 * lane + 512 * j); } }
            float u[NJ][8], r[NJ];
#pragma unroll
            for (int j = 0; j < NJ; ++j) {
                float o[8], g[8]; unpack8(oc[j], o); unpack8(gc[j], g);
                float ss = 0.f;
#pragma unroll
                for (int e = 0; e < 8; ++e) { u[j][e] = o[e] * g[e]; ss += (MIX == 1) ? u[j][e] * u[j][e] : o[e] * o[e]; }
                if (MIX == 2) r[j] = rsqrtf(grp16_sum(ss) * (1.f / 128.f) + EPS); else r[j] = rsqrtf(wave_sum(ss) * (1.f / 512.f) + EPS);
            }
#pragma unroll
            for (int j = 0; j < NJ; ++j) { float v[8];
#pragma unroll
                for (int e = 0; e < 8; ++e) v[e] = u[j][e] * r[j] * wv[j][e];
                *(GAS v4u*)(GO + (size_t)row * W + 8 * lane + 512 * j) = pack8(v); }
        }
    }
}

template <int OFF> __device__ __forceinline__ bf16x8 tr_frag(unsigned addr) {
    s16x4 lo, hi;
    asm volatile("ds_read_b64_tr_b16 %0, %2\n\tds_read_b64_tr_b16 %1, %2 offset:%3\n\ts_waitcnt lgkmcnt(0)" : "=&v"(lo), "=&v"(hi) : "v"(addr), "i"(OFF) : "memory");
    return __builtin_shufflevector(lo, hi, 0, 1, 2, 3, 4, 5, 6, 7);
}
template <int OFF> __device__ __forceinline__ void tr_frag2(unsigned a0, unsigned a1, bf16x8& f0, bf16x8& f1) {
    s16x4 l0, h0, l1, h1;
    asm volatile("ds_read_b64_tr_b16 %0, %4\n\tds_read_b64_tr_b16 %1, %4 offset:%6\n\tds_read_b64_tr_b16 %2, %5\n\tds_read_b64_tr_b16 %3, %5 offset:%6\n\ts_waitcnt lgkmcnt(0)"
                 : "=&v"(l0), "=&v"(h0), "=&v"(l1), "=&v"(h1) : "v"(a0), "v"(a1), "i"(OFF) : "memory");
    f0 = __builtin_shufflevector(l0, h0, 0, 1, 2, 3, 4, 5, 6, 7); f1 = __builtin_shufflevector(l1, h1, 0, 1, 2, 3, 4, 5, 6, 7);
}

#define LDS_BARRIER() do { asm volatile("s_waitcnt lgkmcnt(0)" ::: "memory"); __builtin_amdgcn_s_barrier(); asm volatile("" ::: "memory"); } while (0)
#define TRRD(dst, addr, off) asm volatile("ds_read_b64_tr_b16 %0, %1 offset:%2" : "=&v"(dst) : "v"(addr), "i"(off) : "memory")
#define TR_WAIT() do { asm volatile("s_waitcnt lgkmcnt(0)" ::: "memory"); __builtin_amdgcn_sched_barrier(0); } while (0)
#define TR_JOIN(lo, hi) __builtin_shufflevector(lo, hi, 0, 1, 2, 3, 4, 5, 6, 7)
template <class Cf>
__device__ __forceinline__ void rec_step_a(LAS unsigned char* lds, const int w, const int lane, f32x4 (&S)[Cf::KPW][Cf::VS / 16], const LAS float* cum, f32x4 (&O)[(Cf::VS / 16 * Cf::C / 16 + 7) / 8]) {
    constexpr int C = Cf::C, KD = Cf::KD, VS = Cf::VS, NIT = C / 16, NJT = C / 16, NVT = VS / 16, KSK = KD / 32, KSC = C / 32;
    constexpr int RSK = Cf::RSK, RSV = Cf::RSV, RSP = Cf::RSP;
    constexpr bool CH = Cf::CH;
    const int fr = lane & 15, fq = lane >> 4, q4 = fr >> 2, p4 = fr & 3;
    const unsigned lbase = (unsigned)(size_t)lds;
    constexpr int NP = NIT * NJT, PPW = (NP + 7) / 8, NO = NVT * NIT, OPW = (NO + 7) / 8;
    static_assert((NIT == 4 && NVT == 4) || (NP <= 8 && NO <= 8), "tile deal");
    constexpr bool SHQ = (NIT == 4) && !CH;
    const int it = (NIT == 4) ? (w & 3) : (w / NJT);
    if constexpr (SHQ) {
        f32x4 p[2] = {(f32x4){0.f, 0.f, 0.f, 0.f}, (f32x4){0.f, 0.f, 0.f, 0.f}};
        f32x4 o2[2] = {(f32x4){0.f, 0.f, 0.f, 0.f}, (f32x4){0.f, 0.f, 0.f, 0.f}};
        const int j0 = w >> 2;
#pragma unroll 4
        for (int ks = 0; ks < KSK; ++ks) {
            const bf16x8 qf = *(const LAS bf16x8*)(lds + Cf::QA + (16 * it + fr) * RSK + (32 * ks + 8 * fq) * 2);
#pragma unroll
            for (int tt = 0; tt < 2; ++tt) { const int jt = j0 + 2 * tt;
                if (jt <= it) { const bf16x8 a = *(const LAS bf16x8*)(lds + Cf::KA + (16 * jt + fr) * RSK + (32 * ks + 8 * fq) * 2); p[tt] = MFMA16(a, qf, p[tt]); }
                const bf16x8 s = *(const LAS bf16x8*)(lds + Cf::ST + (16 * jt + fr) * RSK + (32 * ks + 8 * fq) * 2); o2[tt] = MFMA16(s, qf, o2[tt]); }
        }
        const int i = 16 * it + fr; const float ci = cum[i], ei = __expf(ci);
#pragma unroll
        for (int tt = 0; tt < 2; ++tt) { const int jt = j0 + 2 * tt;
#pragma unroll
            for (int r = 0; r < 4; ++r) { const int j = 16 * jt + 4 * fq + r; const float e = __expf(fminf(ci - cum[j], 0.f)); p[tt][r] = (j <= i) ? p[tt][r] * e : 0.f; }
            *(LAS v2u*)(lds + Cf::PM + (16 * it + fr) * RSP + (16 * jt + 4 * fq) * 2) = pack4v(p[tt]);
            O[tt] = o2[tt] * ei; }
    } else {
#pragma unroll
        for (int tt = 0; tt < PPW; ++tt) { const int t = w + 8 * tt;
            if (t < NP) { const int it1 = t / NJT, jt = t % NJT;
                f32x4 p = (f32x4){0.f, 0.f, 0.f, 0.f};
                if (jt <= it1) {
#pragma unroll
                    for (int ks = 0; ks < KSK; ++ks) {
                        const bf16x8 a = *(const LAS bf16x8*)(lds + Cf::KA + (16 * jt + fr) * RSK + (32 * ks + 8 * fq) * 2);
                        const bf16x8 b = *(const LAS bf16x8*)(lds + Cf::QA + (16 * it1 + fr) * RSK + (32 * ks + 8 * fq) * 2);
                        p = MFMA16(a, b, p); }
                    const int i = 16 * it1 + fr;
                    if (!CH) { const float ci = cum[i];
#pragma unroll
                        for (int r = 0; r < 4; ++r) { const int j = 16 * jt + 4 * fq + r; const float e = __expf(fminf(ci - cum[j], 0.f)); p[r] = (j <= i) ? p[r] * e : 0.f; } }
                    else {
#pragma unroll
                        for (int r = 0; r < 4; ++r) { const int j = 16 * jt + 4 * fq + r; p[r] = (j <= i) ? p[r] : 0.f; } }
                }
                *(LAS v2u*)(lds + Cf::PM + (16 * it1 + fr) * RSP + (16 * jt + 4 * fq) * 2) = pack4v(p);
            } }
#pragma unroll
        for (int tt = 0; tt < OPW; ++tt) { const int t = w + 8 * tt; O[tt] = (f32x4){0.f, 0.f, 0.f, 0.f};
            if (t < NO) { const int vt = t / NIT, it3 = t % NIT; f32x4 o = (f32x4){0.f, 0.f, 0.f, 0.f};
#pragma unroll
                for (int ks = 0; ks < KSK; ++ks) {
                    const bf16x8 a = *(const LAS bf16x8*)(lds + Cf::ST + (16 * vt + fr) * RSK + (32 * ks + 8 * fq) * 2);
                    const bf16x8 b = *(const LAS bf16x8*)(lds + Cf::QB + (16 * it3 + fr) * RSK + (32 * ks + 8 * fq) * 2);
                    o = MFMA16(a, b, o); }
                if (!CH) o = o * __expf(cum[16 * it3 + fr]);
                O[tt] = o; } }
    }
#pragma unroll
    for (int ki = 0; ki < Cf::KPW; ++ki) { const int kt = w + 8 * ki;
        if (!CH) { const float d = __expf(cum[C - 1]);
#pragma unroll
            for (int vt = 0; vt < NVT; ++vt) S[ki][vt] = S[ki][vt] * d; }
        else { const LAS float* ds = (const LAS float*)(lds + Cf::DS) + 16 * kt + 4 * fq; const f32x4 d = (f32x4){ds[0], ds[1], ds[2], ds[3]};
#pragma unroll
            for (int vt = 0; vt < NVT; ++vt) S[ki][vt] = S[ki][vt] * d; } }
#pragma unroll
    for (int ks = 0; ks < KSC; ++ks) {
        s16x4 vl[NVT], vh[NVT], kl[Cf::KPW], kh[Cf::KPW];
#pragma unroll
        for (int vt = 0; vt < NVT; ++vt) { const unsigned ad = lbase + Cf::VB + (32 * ks + 8 * fq + q4) * RSV + (16 * vt + 4 * p4) * 2; TRRD(vl[vt], ad, 0); TRRD(vh[vt], ad, 4 * RSV); }
#pragma unroll
        for (int ki = 0; ki < Cf::KPW; ++ki) { const unsigned ad = lbase + Cf::KB + (32 * ks + 8 * fq + q4) * RSK + (16 * (w + 8 * ki) + 4 * p4) * 2; TRRD(kl[ki], ad, 0); TRRD(kh[ki], ad, 4 * RSK); }
        TR_WAIT();
#pragma unroll
        for (int ki = 0; ki < Cf::KPW; ++ki) { const bf16x8 a = TR_JOIN(kl[ki], kh[ki]);
#pragma unroll
            for (int vt = 0; vt < NVT; ++vt) S[ki][vt] = MFMA16(a, TR_JOIN(vl[vt], vh[vt]), S[ki][vt]); }
    }
}
template <class Cf, class OutFn>
__device__ __forceinline__ void rec_step_b(LAS unsigned char* lds, const int w, const int lane, const f32x4 (&S)[Cf::KPW][Cf::VS / 16], f32x4 (&O)[(Cf::VS / 16 * Cf::C / 16 + 7) / 8], const OutFn& out, const int tok0) {
    constexpr int C = Cf::C, VS = Cf::VS, NIT = C / 16, NVT = VS / 16, KSC = C / 32;
    constexpr int RSK = Cf::RSK, RSV = Cf::RSV, RSP = Cf::RSP;
    constexpr int NO = NVT * NIT, OPW = (NO + 7) / 8;
    const int fr = lane & 15, fq = lane >> 4, q4 = fr >> 2, p4 = fr & 3;
    const unsigned lbase = (unsigned)(size_t)lds;
    const int it = (NIT == 4) ? (w & 3) : 0;
    if constexpr (NIT == 4) {
        const int v0 = w >> 2;
        s16x4 al[KSC][2], ah[KSC][2]; bf16x8 pb[KSC];
#pragma unroll
        for (int ks = 0; ks < KSC; ++ks) {
#pragma unroll
            for (int tt = 0; tt < 2; ++tt) { const unsigned ad = lbase + Cf::V + (32 * ks + 8 * fq + q4) * RSV + (16 * (v0 + 2 * tt) + 4 * p4) * 2; TRRD(al[ks][tt], ad, 0); TRRD(ah[ks][tt], ad, 4 * RSV); } }
#pragma unroll
        for (int ks = 0; ks < KSC; ++ks) pb[ks] = *(const LAS bf16x8*)(lds + Cf::PM + (16 * it + fr) * RSP + (32 * ks + 8 * fq) * 2);
        TR_WAIT();
#pragma unroll
        for (int ks = 0; ks < KSC; ++ks) { O[0] = MFMA16(TR_JOIN(al[ks][0], ah[ks][0]), pb[ks], O[0]); O[1] = MFMA16(TR_JOIN(al[ks][1], ah[ks][1]), pb[ks], O[1]); }
        out(tok0 + 16 * it + fr, 16 * it + fr, 16 * v0 + 4 * fq, O[0]);
        out(tok0 + 16 * it + fr, 16 * it + fr, 16 * (v0 + 2) + 4 * fq, O[1]);
    } else {
#pragma unroll
        for (int tt = 0; tt < OPW; ++tt) { const int t = w + 8 * tt;
            if (t < NO) { const int vt = t / NIT, it2 = t % NIT; f32x4 o = O[tt];
#pragma unroll
                for (int ks = 0; ks < KSC; ++ks) {
                    const bf16x8 a = tr_frag<4 * RSV>(lbase + Cf::V + (32 * ks + 8 * fq + q4) * RSV + (16 * vt + 4 * p4) * 2);
                    const bf16x8 b = *(const LAS bf16x8*)(lds + Cf::PM + (16 * it2 + fr) * RSP + (32 * ks + 8 * fq) * 2);
                    o = MFMA16(a, b, o); }
                out(tok0 + 16 * it2 + fr, 16 * it2 + fr, 16 * vt + 4 * fq, o); } }
    }
#pragma unroll
    for (int ki = 0; ki < Cf::KPW; ++ki) { const int kt = w + 8 * ki;
#pragma unroll
        for (int vt = 0; vt < NVT; ++vt) *(LAS v2u*)(lds + Cf::ST + (16 * vt + fr) * RSK + (16 * kt + 4 * fq) * 2) = pack4v(S[ki][vt]); }
}
template <class Cf, class OutFn>
__device__ __forceinline__ void rec_step(LAS unsigned char* lds, const int w, const int lane, f32x4 (&S)[Cf::KPW][Cf::VS / 16], const LAS float* cum, const OutFn& out, const int tok0) {
    f32x4 O[(Cf::VS / 16 * Cf::C / 16 + 7) / 8];
    rec_step_a<Cf>(lds, w, lane, S, cum, O);
    LDS_BARRIER();
    rec_step_b<Cf>(lds, w, lane, S, O, out, tok0);
    LDS_BARRIER();
}
template <class Cf> __device__ __forceinline__ void rec_zero_state(Frame& F, f32x4 (&S)[Cf::KPW][Cf::VS / 16]) {
#pragma unroll
    for (int ki = 0; ki < Cf::KPW; ++ki)
#pragma unroll
        for (int vt = 0; vt < Cf::VS / 16; ++vt) S[ki][vt] = (f32x4){0.f, 0.f, 0.f, 0.f};
    for (int o = F.tid * 16; o < Cf::VS * Cf::RSK; o += 512 * 16) *(LAS v4u*)(F.lds + Cf::ST + o) = (v4u){0u, 0u, 0u, 0u};
}
template <class Cf> __device__ __forceinline__ void rec_store_state(Frame& F, const f32x4 (&S)[Cf::KPW][Cf::VS / 16], float* dst, int ldv) {
    const int fr = F.lane & 15, fq = F.lane >> 4;
#pragma unroll
    for (int ki = 0; ki < Cf::KPW; ++ki) { const int kt = F.wave + 8 * ki;
#pragma unroll
        for (int vt = 0; vt < Cf::VS / 16; ++vt)
#pragma unroll
            for (int r = 0; r < 4; ++r) dst[(size_t)(16 * kt + 4 * fq + r) * ldv + 16 * vt + fr] = S[ki][vt][r]; }
}

struct CfRet { static constexpr int C = 64, KD = 256, VS = 64, KPW = 2, RSK = 528, RSV = 144, RSP = 144; static constexpr bool CH = false;
    static constexpr int QA = 0, KA = 33792, QB = QA, KB = KA, V = 67584, VB = 76800, PM = 86016, ST = 95232, CUM = 129024, DS = 0, END = 129280; };
static_assert(CfRet::END <= SCR_BYTES, "ret lds");
struct RetOut { bf16* dst;
    __device__ __forceinline__ void operator()(int tok, int i, int vv0, const f32x4 o) const { *(GAS v2u*)(dst + (size_t)tok * 2048 + vv0) = pack4v(o); } };
template <bool fuse>
__device__ __forceinline__ void ret_prompt_item(Frame& F, int item, const bf16* Q, const bf16* K, const bf16* V, bf16* RO, float* st_out,
                                                const float* sst_in, float* sst_out) {
    const int b = item >> 5, h = (item >> 3) & 3, vs = item & 7, tid = F.tid;
    const float lg = logf(1.f - exp2f(-5.f - (float)h));
    LAS float* cum = (LAS float*)(F.lds + CfRet::CUM);
    LAS float* sqk = (LAS float*)(F.lds + CfRet::END);
    LAS float* sred = sqk + 1024;
    __syncthreads();
    if (tid < 64) cum[tid] = (float)(tid + 1) * lg;
    f32x4 S[CfRet::KPW][4];
    rec_zero_state<CfRet>(F, S);
    const bf16* qg = Q + (size_t)(b * SEQ) * 1024 + h * 256; const bf16* kg = K + (size_t)(b * SEQ) * 1024 + h * 256; const bf16* vg = V + (size_t)(b * SEQ) * 2048 + h * 512 + vs * 64;
    const RetOut out{RO + (size_t)(b * SEQ) * 2048 + h * 512 + vs * 64};
    v4u qr[4], kr[4], vr;
#pragma unroll
    for (int i = 0; i < 4; ++i) { const int pc = tid + 512 * i, row = pc >> 5, c16 = pc & 31; qr[i] = *(const GAS v4u*)(qg + (size_t)row * 1024 + c16 * 8); kr[i] = *(const GAS v4u*)(kg + (size_t)row * 1024 + c16 * 8); }
    vr = *(const GAS v4u*)(vg + (size_t)(tid >> 3) * 2048 + (tid & 7) * 8);
    const float vsc = __expf((float)(63 - (tid >> 3)) * lg);
    const int sc4 = (tid & 127) * 4, srq = tid >> 7;
    f32x4 sv = (f32x4){0.f, 0.f, 0.f, 0.f}, so = sv, sst[4]; float sg = 0.f; const float* sin = sst_in; float* sout = sst_out; size_t srow = 0; int shh = 0;
#define RET_S_SETUP(si) do { const int sit_ = F.vcu + 256 * (si), bs_ = sit_ >> 2; shh = sit_ & 3; srow = MPR + bs_; \
        sqk[(si) * 512 + tid] = tid < 256 ? bf2f(Q[srow * 1024 + shh * 256 + tid]) : bf2f(K[srow * 1024 + shh * 256 + (tid - 256)]); \
        const v2u vw_ = *(const GAS v2u*)(V + srow * 2048 + shh * 512 + sc4); sv = (f32x4){bflo(vw_.x), bfhi(vw_.x), bflo(vw_.y), bfhi(vw_.y)}; \
        so = (f32x4){0.f, 0.f, 0.f, 0.f}; sg = 1.f - exp2f(-5.f - (float)shh); \
        sin = sst_in + ((size_t)(bs_ * 4 + shh) * 256) * 512 + sc4; sout = sst_out + ((size_t)(bs_ * 4 + shh) * 256) * 512 + sc4; } while (0)
#define RET_S_LOAD(st_) do { _Pragma("unroll") for (int k_ = 0; k_ < 4; ++k_) sst[k_] = __builtin_nontemporal_load((const GAS f32x4*)(sin + (size_t)(16 * (st_) + srq + 4 * k_) * 512)); } while (0)
    if (fuse) { RET_S_SETUP(0); RET_S_LOAD(0); __syncthreads(); }
    for (int c = 0; c < SEQ / 64; ++c) {
        const int sidx = c >> 4, sstep = c & 15;
        if (fuse) {
#pragma unroll
            for (int k = 0; k < 4; ++k) { const int rr = 16 * sstep + srq + 4 * k; const float kf = sqk[sidx * 512 + 256 + rr], qf = sqk[sidx * 512 + rr];
                const f32x4 s = sst[k] * sg + sv * kf;
                __builtin_nontemporal_store(s, (GAS f32x4*)(sout + (size_t)rr * 512)); so = so + s * qf; }
            if (sstep == 0 && sidx == 1) {
                const float acc = (sred[tid] + sred[512 + tid]) + (sred[1024 + tid] + sred[1536 + tid]);
                const int sit0 = F.vcu, bs0 = sit0 >> 2, h0 = sit0 & 3;
                RO[(size_t)(MPR + bs0) * 2048 + h0 * 512 + tid] = (bf16)(cvt_pk_bf16(acc, acc) & 0xffffu); }
            if (sstep == 15) { *(LAS f32x4*)(sred + srq * 512 + sc4) = so; if (sidx == 0) RET_S_SETUP(1); }
            if (c + 1 < SEQ / 64) RET_S_LOAD((c + 1) & 15);
        }
#pragma unroll
        for (int i = 0; i < 4; ++i) { const int pc = tid + 512 * i, row = pc >> 5, c16 = pc & 31;
            *(LAS v4u*)(F.lds + CfRet::QA + row * 528 + c16 * 16) = qr[i]; *(LAS v4u*)(F.lds + CfRet::KA + row * 528 + c16 * 16) = kr[i]; }
        { const int row = tid >> 3, c16 = tid & 7; *(LAS v4u*)(F.lds + CfRet::V + row * 144 + c16 * 16) = vr;
          float f[8]; unpack8(vr, f);
#pragma unroll
          for (int e = 0; e < 8; ++e) f[e] *= vsc;
          *(LAS v4u*)(F.lds + CfRet::VB + row * 144 + c16 * 16) = pack8(f); }
        if (c + 1 < SEQ / 64) { const size_t r0 = (size_t)(c + 1) * 64;
#pragma unroll
            for (int i = 0; i < 4; ++i) { const int pc = tid + 512 * i, row = pc >> 5, c16 = pc & 31; qr[i] = *(const GAS v4u*)(qg + (r0 + row) * 1024 + c16 * 8); kr[i] = *(const GAS v4u*)(kg + (r0 + row) * 1024 + c16 * 8); }
            vr = *(const GAS v4u*)(vg + (r0 + (tid >> 3)) * 2048 + (tid & 7) * 8); }
        LDS_BARRIER();
        rec_step<CfRet>(F.lds, F.wave, F.lane, S, cum, out, c * 64);
    }
#undef RET_S_SETUP
#undef RET_S_LOAD
    if (fuse) { __syncthreads();
        const float acc = (sred[tid] + sred[512 + tid]) + (sred[1024 + tid] + sred[1536 + tid]);
        RO[srow * 2048 + shh * 512 + tid] = (bf16)(cvt_pk_bf16(acc, acc) & 0xffffu); }
    rec_store_state<CfRet>(F, S, st_out + ((size_t)(b * 4 + h) * 256) * 512 + vs * 64, 512);
}
static_assert(CfRet::END + 4096 + 8192 <= SCR_BYTES, "ret lds + sample stream");
__device__ __forceinline__ void ret_sample_items(Frame& F, const bf16* Q, const bf16* K, const bf16* V, bf16* RO, const float* st_in, float* st_out) {
    LAS float* qk = (LAS float*)F.lds; LAS float* red = qk + 512;
    const int tid = F.tid, lane = F.lane, w = F.wave;
    for (int item = F.vcu; item < MS * 4; item += F.G) {
        const int bs = item >> 2, h = item & 3; const size_t row = MPR + bs;
        __syncthreads();
        qk[tid] = tid < 256 ? bf2f(Q[row * 1024 + h * 256 + tid]) : bf2f(K[row * 1024 + h * 256 + (tid - 256)]);
        float v[8]; unpack8(*(const GAS v4u*)(V + row * 2048 + h * 512 + 8 * lane), v);
        __syncthreads();
        const float g = 1.f - exp2f(-5.f - (float)h);
        const float* sin = st_in + ((size_t)(bs * 4 + h) * 256) * 512 + 8 * lane; float* sout = st_out + ((size_t)(bs * 4 + h) * 256) * 512 + 8 * lane;
        float o[8];
#pragma unroll
        for (int e = 0; e < 8; ++e) o[e] = 0.f;
#pragma unroll 8
        for (int r = 0; r < 32; ++r) { const int kk = 32 * w + r;
            f32x4 s0 = __builtin_nontemporal_load((const GAS f32x4*)(sin + (size_t)kk * 512)), s1 = __builtin_nontemporal_load((const GAS f32x4*)(sin + (size_t)kk * 512 + 4));
            const float kf = qk[256 + kk], qf = qk[kk];
#pragma unroll
            for (int e = 0; e < 4; ++e) { s0[e] = g * s0[e] + kf * v[e]; s1[e] = g * s1[e] + kf * v[4 + e]; o[e] += s0[e] * qf; o[4 + e] += s1[e] * qf; }
            __builtin_nontemporal_store(s0, (GAS f32x4*)(sout + (size_t)kk * 512)); __builtin_nontemporal_store(s1, (GAS f32x4*)(sout + (size_t)kk * 512 + 4)); }
#pragma unroll
        for (int e = 0; e < 8; ++e) red[w * 512 + 8 * lane + e] = o[e];
        __syncthreads();
        float acc = 0.f;
#pragma unroll
        for (int ww = 0; ww < 8; ++ww) acc += red[ww * 512 + tid];
        RO[row * 2048 + h * 512 + tid] = (bf16)(cvt_pk_bf16(acc, acc) & 0xffffu);
    }
    __syncthreads();
}

struct CfSsd { static constexpr int C = 64, KD = 128, VS = 64, KPW = 1, RSK = 272, RSV = 144, RSP = 144; static constexpr bool CH = false;
    static constexpr int QA = 0, KA = 17408, QB = QA, KB = KA, V = 34816, VB = 44032, PM = 53248, ST = 62464, XS = 79872, CUM = 89088, DTV = 89600, RAW = 90112, RSR = 656, DS = 0, END = RAW + 67 * 656; };
static_assert(CfSsd::END + 8 * 320 * 4 <= SCR_BYTES, "ssd lds + sample scratch");
struct SsdOut { bf16* dst; const LAS unsigned char* xs; float Dh;
    __device__ __forceinline__ void operator()(int tok, int i, int vv0, const f32x4 o) const {
        const v2u xw = *(const LAS v2u*)(xs + i * 144 + vv0 * 2);
        const f32x4 x = (f32x4){bflo(xw.x), bfhi(xw.x), bflo(xw.y), bfhi(xw.y)};
        *(GAS v2u*)(dst + (size_t)tok * 2048 + vv0) = pack4v(o + x * Dh); } };
__device__ __forceinline__ int ssd_gcol(int lch, int head, int grp) { return lch < 64 ? head * 64 + lch : (lch < 192 ? 2048 + grp * 128 + (lch - 64) : 2560 + grp * 128 + (lch - 192)); }
template <bool fuse>
__device__ __forceinline__ void ssd_prompt_item(Frame& F, int item, const bf16* XBC, const float* DT, bf16* T, float* st_out,
                                                const float* conv_w, const float* conv_b, const float* dt_bias, const float* a_log, const float* d_skip,
                                                const float* sst_in, float* sst_out, const float* conv_st) {
    const int b = item >> 5, head = item & 31, grp = head >> 3, tid = F.tid, lane = F.lane, w = F.wave;
    const float a = -expf(a_log[head]), dtb = dt_bias[head], Dh = d_skip[head];
    LAS float* cumb = (LAS float*)(F.lds + CfSsd::CUM); LAS float* dtvb = (LAS float*)(F.lds + CfSsd::DTV);
    __syncthreads();
    f32x4 S[CfSsd::KPW][4];
    rec_zero_state<CfSsd>(F, S);
    const bf16* xg = XBC + (size_t)(b * SEQ) * 3072; const float* dtg = DT + (size_t)(b * SEQ) * 32 + head;
    const SsdOut out{T + (size_t)(b * SEQ) * 2048 + head * 64, F.lds + CfSsd::XS, Dh};
    const bool conv_thr = tid < 440; const int cg = tid % 40, tb = tid / 40, gcolc = ssd_gcol(8 * cg, head, grp);
    float wr[4][8], br[8];
#pragma unroll
    for (int e = 0; e < 8; ++e) { br[e] = conv_b[gcolc + e];
#pragma unroll
        for (int tap = 0; tap < 4; ++tap) wr[tap][e] = conv_w[tap * 3072 + gcolc + e]; }
    const bool stg_thr = tid < 480; const int r0 = tid / 40;
    v4u raw[6];
#define SSD_LOAD_RAW(cc) do { const bf16* rp_ = xg + ((long)((cc) * 64 - 3 + r0) * 3072 + gcolc); _Pragma("unroll") for (int k_ = 0; k_ < 6; ++k_) { const int row_ = r0 + 12 * k_, tk_ = (cc) * 64 - 3 + row_; \
        raw[k_] = (v4u){0u, 0u, 0u, 0u}; if (stg_thr && row_ < 67 && tk_ >= 0) raw[k_] = *(const GAS v4u*)(rp_ + (long)k_ * 12 * 3072); } } while (0)
#define SSD_CUM(cc) do { if (w == 0) { const float dtv_ = softplusf_(dtn + dtb); float v_ = dtv_ * a; \
        _Pragma("unroll") for (int o_ = 1; o_ < 64; o_ <<= 1) { const float u_ = __shfl_up(v_, o_); if (lane >= o_) v_ += u_; } cumb[((cc) & 1) * 64 + lane] = v_; dtvb[((cc) & 1) * 64 + lane] = dtv_; } } while (0)
    float dtn = 0.f;
    if (w == 0) dtn = dtg[(size_t)lane * 32];
    SSD_CUM(0);
    if (w == 0) dtn = dtg[(size_t)(64 + lane) * 32];
    SSD_LOAD_RAW(0);
    LAS float* sscr = (LAS float*)(F.lds + CfSsd::END) + w * 320;
    const int sgw = F.vcu * NWAVES + w, sv4 = (lane & 15) * 4, skq = lane >> 4;
    f32x4 sxs = (f32x4){0.f, 0.f, 0.f, 0.f}, sxd = sxs, sy = sxs, sst[2]; float sdA = 0.f, sDh = 0.f; const float* sin = sst_in; float* sout = sst_out; size_t srow = 0; int shead = 0;
#define SSD_S_SETUP(si) do { const int sit_ = sgw + 2048 * (si), bs_ = sit_ >> 5; shead = sit_ & 31; const int sgrp_ = shead >> 3; srow = MPR + bs_; \
        _Pragma("unroll 1") for (int r_ = 0; r_ < 5; ++r_) { const int lch_ = lane + 64 * r_, gch_ = ssd_gcol(lch_, shead, sgrp_); float acc_ = conv_b[gch_]; \
            _Pragma("unroll") for (int tap_ = 0; tap_ < 3; ++tap_) acc_ += conv_st[((size_t)bs_ * 3 + tap_) * 3072 + gch_] * conv_w[tap_ * 3072 + gch_]; \
            acc_ += bf2f(XBC[srow * 3072 + gch_]) * conv_w[3 * 3072 + gch_]; sscr[lch_] = siluf_(acc_); } \
        LDS_WAIT(); \
        const float dtv_ = softplusf_(DT[srow * 32 + shead] + dt_bias[shead]); sdA = __expf(dtv_ * -expf(a_log[shead])); sDh = d_skip[shead]; \
        sxs = (f32x4){sscr[sv4], sscr[sv4 + 1], sscr[sv4 + 2], sscr[sv4 + 3]}; sxd = sxs * dtv_; sy = (f32x4){0.f, 0.f, 0.f, 0.f}; \
        sin = sst_in + ((size_t)(bs_ * 32 + shead) * 128) * 64 + sv4; sout = sst_out + ((size_t)(bs_ * 32 + shead) * 128) * 64 + sv4; } while (0)
#define SSD_S_LOAD(st_) do { _Pragma("unroll") for (int k_ = 0; k_ < 2; ++k_) sst[k_] = __builtin_nontemporal_load((const GAS f32x4*)(sin + (size_t)(8 * (st_) + 4 * k_ + skq) * 64)); } while (0)
    if (fuse) { SSD_S_SETUP(0); SSD_S_LOAD(0); }
    for (int c = 0; c < SEQ / 64; ++c) {
        if (fuse) { const int sidx = c >> 4, sstep = c & 15;
#pragma unroll
            for (int k = 0; k < 2; ++k) { const int kk = 8 * sstep + 4 * k + skq;
                const f32x4 s = sst[k] * sdA + sxd * sscr[64 + kk];
                __builtin_nontemporal_store(s, (GAS f32x4*)(sout + (size_t)kk * 64)); sy = sy + s * sscr[192 + kk]; }
            if (sstep == 15) {
#pragma unroll
                for (int e = 0; e < 4; ++e) { sy[e] += __shfl_xor(sy[e], 16); sy[e] += __shfl_xor(sy[e], 32); }
                if (lane < 16) *(GAS v2u*)(T + srow * 2048 + shead * 64 + sv4) = pack4v(sy + sxs * sDh);
                LDS_WAIT();
                if (sidx == 0) SSD_S_SETUP(1); }
            if (c + 1 < SEQ / 64) SSD_S_LOAD((c + 1) & 15);
        }
#pragma unroll
        for (int k = 0; k < 6; ++k) { const int row = r0 + 12 * k; if (stg_thr && row < 67) *(LAS v4u*)(F.lds + CfSsd::RAW + row * CfSsd::RSR + cg * 16) = raw[k]; }
        if (c + 1 < SEQ / 64) { SSD_CUM(c + 1); if (w == 0 && c + 2 < SEQ / 64) dtn = dtg[(size_t)((c + 2) * 64 + lane) * 32]; SSD_LOAD_RAW(c + 1); }
        LDS_BARRIER();
        const LAS float* cum = cumb + (c & 1) * 64; const LAS float* dtv = dtvb + (c & 1) * 64; const float tot = cum[63];
        if (conv_thr) {
            float win[3][8];
#pragma unroll
            for (int r = 0; r < 3; ++r) unpack8(*(const LAS v4u*)(F.lds + CfSsd::RAW + (6 * tb + r) * CfSsd::RSR + cg * 16), win[r]);
#pragma unroll
            for (int k = 0; k < 6; ++k) { const int i = 6 * tb + k;
                if (i < 64) {
                    float x3[8], acc[8]; unpack8(*(const LAS v4u*)(F.lds + CfSsd::RAW + (i + 3) * CfSsd::RSR + cg * 16), x3);
#pragma unroll
                    for (int e = 0; e < 8; ++e) { acc[e] = br[e] + win[0][e] * wr[0][e] + win[1][e] * wr[1][e] + win[2][e] * wr[2][e] + x3[e] * wr[3][e]; acc[e] = siluf_(acc[e]);
                        win[0][e] = win[1][e]; win[1][e] = win[2][e]; win[2][e] = x3[e]; }
                    if (cg < 8) { const float dv = dtv[i], wj = dv * __expf(tot - cum[i]);
                        *(LAS v4u*)(F.lds + CfSsd::XS + i * 144 + cg * 16) = pack8(acc);
                        float f[8];
#pragma unroll
                        for (int e = 0; e < 8; ++e) f[e] = acc[e] * dv;
                        *(LAS v4u*)(F.lds + CfSsd::V + i * 144 + cg * 16) = pack8(f);
#pragma unroll
                        for (int e = 0; e < 8; ++e) f[e] = acc[e] * wj;
                        *(LAS v4u*)(F.lds + CfSsd::VB + i * 144 + cg * 16) = pack8(f); }
                    else if (cg < 24) *(LAS v4u*)(F.lds + CfSsd::KA + i * 272 + (cg - 8) * 16) = pack8(acc);
                    else *(LAS v4u*)(F.lds + CfSsd::QA + i * 272 + (cg - 24) * 16) = pack8(acc);
                } }
        }
        LDS_BARRIER();
        rec_step<CfSsd>(F.lds, w, lane, S, cum, out, c * 64);
    }
#undef SSD_CUM
#undef SSD_LOAD_RAW
#undef SSD_S_SETUP
#undef SSD_S_LOAD
    rec_store_state<CfSsd>(F, S, st_out + ((size_t)(b * 32 + head) * 128) * 64, 64);
}
__device__ __forceinline__ void ssd_sample_items(Frame& F, const bf16* XBC, const float* DT, bf16* T, const float* st_in, float* st_out, const float* conv_st,
                                                 const float* conv_w, const float* conv_b, const float* dt_bias, const float* a_log, const float* d_skip) {
    const int gw = F.vcu * NWAVES + F.wave, NGW = F.G * NWAVES, lane = F.lane;
    LAS float* scr = (LAS float*)(F.lds + F.wave * 2048);
    __syncthreads();
    for (int item = gw; item < MS * 32; item += NGW) {
        const int bs = item >> 5, head = item & 31, grp = head >> 3; const size_t row = MPR + bs;
        asm volatile("" ::: "memory");
#pragma unroll
        for (int r = 0; r < 5; ++r) { const int lch = lane + 64 * r, gch = ssd_gcol(lch, head, grp);
            float acc = conv_b[gch];
#pragma unroll
            for (int tap = 0; tap < 3; ++tap) acc += conv_st[((size_t)bs * 3 + tap) * 3072 + gch] * conv_w[tap * 3072 + gch];
            acc += bf2f(XBC[row * 3072 + gch]) * conv_w[3 * 3072 + gch];
            scr[lch] = siluf_(acc); }
        LDS_WAIT();
        const float dtv = softplusf_(DT[row * 32 + head] + dt_bias[head]), dA = __expf(dtv * -expf(a_log[head])), Dh = d_skip[head];
        const int v4 = (lane & 15) * 4, kq = lane >> 4;
        const f32x4 xs4 = (f32x4){scr[v4], scr[v4 + 1], scr[v4 + 2], scr[v4 + 3]}, xd = xs4 * dtv;
        const float* sin = st_in + ((size_t)(bs * 32 + head) * 128) * 64 + v4; float* sout = st_out + ((size_t)(bs * 32 + head) * 128) * 64 + v4;
        f32x4 y = (f32x4){0.f, 0.f, 0.f, 0.f};
#pragma unroll 8
        for (int i = 0; i < 32; ++i) { const int kk = 4 * i + kq;
            f32x4 s = __builtin_nontemporal_load((const GAS f32x4*)(sin + (size_t)kk * 64));
            s = s * dA + xd * scr[64 + kk];
            __builtin_nontemporal_store(s, (GAS f32x4*)(sout + (size_t)kk * 64));
            y = y + s * scr[192 + kk]; }
#pragma unroll
        for (int e = 0; e < 4; ++e) { y[e] += __shfl_xor(y[e], 16); y[e] += __shfl_xor(y[e], 32); }
        if (lane < 16) *(GAS v2u*)(T + row * 2048 + head * 64 + v4) = pack4v(y + xs4 * Dh);
        LDS_WAIT();
    }
    __syncthreads();
}
__device__ __forceinline__ void ssd_conv_out(Frame& F, const bf16* XBC, const float* conv_st, float* outp, float* outs) {
    const int NP_ = BP * 3 * 3072, NS_ = MS * 3 * 3072;
    for (int idx = F.vcu * 512 + F.tid; idx < NP_ + NS_; idx += F.G * 512) {
        if (idx < NP_) { const int b = idx / 9216, rem = idx - b * 9216, wi = rem / 3072, ch = rem - wi * 3072; outp[idx] = bf2f(XBC[(size_t)(b * SEQ + SEQ - 3 + wi) * 3072 + ch]); }
        else { const int k = idx - NP_, bs = k / 9216, rem = k - bs * 9216, wi = rem / 3072, ch = rem - wi * 3072;
            outs[k] = wi < 2 ? conv_st[((size_t)bs * 3 + wi + 1) * 3072 + ch] : bf2f(XBC[(size_t)(MPR + bs) * 3072 + ch]); }
    }
}

template <int P> struct CfHgP { static constexpr int C = 32, KD = 128, VS = 32, KPW = 1, RSK = 272, RSV = 80, RSP = 80; static constexpr bool CH = true;
    static constexpr int BASE = P * 37888, QA = BASE, KA = BASE + 8704, QB = BASE + 17408, KB = BASE + 26112, V = BASE + 34816, VB = V, DS = BASE + 37376,
                         PM = 75776, ST = 78336, PART = 87040, CUM = 0, END = 87040 + 8 * 128 * 4; };
static_assert(CfHgP<1>::END + 8 * 1024 <= SCR_BYTES, "hgrn lds + sample scratch");
struct HgOut { bf16* dst;
    __device__ __forceinline__ void operator()(int tok, int i, int vv0, const f32x4 o) const { *(GAS v2u*)(dst + (size_t)tok * 1024 + vv0) = pack4v(o); } };
__device__ __forceinline__ void st_bf16_lds(LAS unsigned char* p, float x) { *(LAS unsigned short*)p = (unsigned short)(cvt_pk_bf16(x, x) & 0xffffu); }
typedef float f32x2_ __attribute__((ext_vector_type(2)));
template <int P>
__device__ __forceinline__ void hg_fill_images(LAS unsigned char* lds, const f32x2_ (&la)[4], const f32x2_ (&lc)[4], const unsigned (&qr)[4], const v4u vr, int tid) {
    typedef CfHgP<P> Cf;
    const int c2 = tid & 63, tg = tid >> 6;
    const LAS f32x2_* part = (const LAS f32x2_*)(lds + Cf::PART);
    f32x2_ off = (f32x2_){0.f, 0.f}, ref = off, tot = off;
#pragma unroll
    for (int g = 0; g < 8; ++g) { const f32x2_ pg = part[g * 64 + c2]; tot = tot + pg; if (g < 4) ref = ref + pg; const float m = (g < tg) ? 1.f : 0.f; off = off + pg * m; }
    const f32x2_ eref = (f32x2_){__expf(ref.x), __expf(ref.y)}, etr = (f32x2_){__expf(tot.x - ref.x), __expf(tot.y - ref.y)};
#pragma unroll
    for (int e = 0; e < 4; ++e) { const int i = 4 * tg + e; const f32x2_ cm = off + lc[e];
        const float d0 = fminf(fmaxf(cm.x - ref.x, -87.f), 87.f), d1 = fminf(fmaxf(cm.y - ref.y, -87.f), 87.f);
        const float qa0 = bflo(qr[e]) * __expf(d0), qa1 = bfhi(qr[e]) * __expf(d1);
        const float kb0 = (1.f - __expf(la[e].x)) * __expf(-d0), kb1 = (1.f - __expf(la[e].y)) * __expf(-d1);
        *(LAS unsigned*)(lds + Cf::QA + i * 272 + c2 * 4) = cvt_pk_bf16(qa0, qa1); *(LAS unsigned*)(lds + Cf::KA + i * 272 + c2 * 4) = cvt_pk_bf16(kb0, kb1);
        *(LAS unsigned*)(lds + Cf::QB + i * 272 + c2 * 4) = cvt_pk_bf16(qa0 * eref.x, qa1 * eref.y); *(LAS unsigned*)(lds + Cf::KB + i * 272 + c2 * 4) = cvt_pk_bf16(kb0 * etr.x, kb1 * etr.y); }
    if (tg == 0) ((LAS f32x2_*)(lds + Cf::DS))[c2] = eref * etr;
    if (tid < 128) *(LAS v4u*)(lds + Cf::V + (tid >> 2) * 80 + (tid & 3) * 16) = vr;
}
template <bool fuse>
__device__ __forceinline__ void hg_prompt_item(Frame& F, int item, const bf16* HQ, const float* LA, const bf16* HV, bf16* RO, float* st_out, const float* sst_in, float* sst_out) {
    typedef CfHgP<0> Cf0;
    const int b = item >> 5, h = (item >> 2) & 7, vs = item & 3, tid = F.tid, c2 = tid & 63, tg = tid >> 6, w = F.wave, lane = F.lane;
    LAS f32x2_* part = (LAS f32x2_*)(F.lds + Cf0::PART);
    constexpr int NCH = SEQ / 32;
    __syncthreads();
    f32x4 S[1][2];
    rec_zero_state<Cf0>(F, S);
    const size_t base = (size_t)(b * SEQ) * 1024 + h * 128;
    const HgOut out{RO + base + vs * 32};
    f32x2_ la[4], lc[4]; unsigned qr[4]; v4u vr = (v4u){0u, 0u, 0u, 0u};
#define HG_LOAD(cc) do { const size_t b2_ = base + (size_t)(cc) * 32 * 1024; _Pragma("unroll") for (int e_ = 0; e_ < 4; ++e_) { const size_t ix_ = b2_ + (size_t)(4 * tg + e_) * 1024 + 2 * c2; \
            la[e_] = *(const GAS f32x2_*)(LA + ix_); qr[e_] = *(const GAS unsigned*)(HQ + ix_); } \
        if (tid < 128) vr = *(const GAS v4u*)(HV + b2_ + (size_t)(tid >> 2) * 1024 + vs * 32 + (tid & 3) * 8); } while (0)
#define HG_CUMSUM() do { lc[0] = la[0]; _Pragma("unroll") for (int e_ = 1; e_ < 4; ++e_) lc[e_] = lc[e_ - 1] + la[e_]; part[tg * 64 + c2] = lc[3]; } while (0)
    HG_LOAD(0); HG_CUMSUM();
    LDS_BARRIER();
    hg_fill_images<0>(F.lds, la, lc, qr, vr, tid);
    HG_LOAD(1);
    LDS_BARRIER();
    f32x4 O[1];
    LAS float* sscr = (LAS float*)(F.lds + Cf0::END) + w * 256;
    const int sv4 = (lane & 15) * 4, skq = lane >> 4;
    f32x4 siv = (f32x4){0.f, 0.f, 0.f, 0.f}, so = siv, sst = siv; const float* sin = sst_in; float* sout = sst_out; size_t srb = 0; int svh = 0;
    if (fuse) { const int sit = F.vcu * NWAVES + w, bs = sit >> 4, sh = (sit >> 1) & 7; svh = sit & 1; srb = (size_t)(MPR + bs) * 1024 + sh * 128;
#pragma unroll
        for (int r = 0; r < 2; ++r) { const int k2 = lane + 64 * r; sscr[k2] = __expf(LA[srb + k2]); sscr[128 + k2] = bf2f(HQ[srb + k2]); }
        LDS_WAIT();
        const v2u iw = *(const GAS v2u*)(HV + srb + svh * 64 + sv4); siv = (f32x4){bflo(iw.x), bfhi(iw.x), bflo(iw.y), bfhi(iw.y)};
        sin = sst_in + ((size_t)(bs * 8 + sh) * 128) * 128 + svh * 64 + sv4; sout = sst_out + ((size_t)(bs * 8 + sh) * 128) * 128 + svh * 64 + sv4;
        sst = __builtin_nontemporal_load((const GAS f32x4*)(sin + (size_t)skq * 128)); }
#define HG_SAMPLE(cc) do { if (fuse && (cc) < 32) { const int kk_ = 4 * (cc) + skq; const float f_ = sscr[kk_]; \
        const f32x4 s_ = sst * f_ + siv * (1.f - f_); __builtin_nontemporal_store(s_, (GAS f32x4*)(sout + (size_t)kk_ * 128)); so = so + s_ * sscr[128 + kk_]; \
        if ((cc) == 31) { _Pragma("unroll") for (int e_ = 0; e_ < 4; ++e_) { so[e_] += __shfl_xor(so[e_], 16); so[e_] += __shfl_xor(so[e_], 32); } \
            if (lane < 16) *(GAS v2u*)(RO + srb + svh * 64 + sv4) = pack4v(so); } \
        else sst = __builtin_nontemporal_load((const GAS f32x4*)(sin + (size_t)(4 * ((cc) + 1) + skq) * 128)); } } while (0)
#define HG_STEP(P, cc) do { const bool more_ = (cc) + 1 < NCH; HG_SAMPLE(cc); \
        if (more_) HG_CUMSUM();                                      \
        rec_step_a<CfHgP<P>>(F.lds, w, lane, S, (const LAS float*)nullptr, O); \
        LDS_BARRIER(); \
        if (more_) { hg_fill_images<1 - P>(F.lds, la, lc, qr, vr, tid); if ((cc) + 2 < NCH) HG_LOAD((cc) + 2); } \
        rec_step_b<CfHgP<P>>(F.lds, w, lane, S, O, out, (cc) * 32); \
        LDS_BARRIER(); } while (0)
    for (int c = 0; c < NCH; c += 2) { HG_STEP(0, c); HG_STEP(1, c + 1); }
#undef HG_STEP
#undef HG_SAMPLE
#undef HG_CUMSUM
#undef HG_LOAD
    rec_store_state<Cf0>(F, S, st_out + ((size_t)(b * 8 + h) * 128) * 128 + vs * 32, 128);
}
__device__ __forceinline__ void hg_sample_items(Frame& F, const bf16* HQ, const float* LA, const bf16* HV, bf16* RO, const float* st_in, float* st_out) {
    const int gw = F.vcu * NWAVES + F.wave, NGW = F.G * NWAVES, lane = F.lane;
    LAS float* scr = (LAS float*)(F.lds + F.wave * 2048);
    __syncthreads();
    for (int item = gw; item < MS * 16; item += NGW) {
        const int bs = item >> 4, h = (item >> 1) & 7, vh = item & 1; const size_t rb = (size_t)(MPR + bs) * 1024 + h * 128;
        asm volatile("" ::: "memory");
#pragma unroll
        for (int r = 0; r < 2; ++r) { const int kk = lane + 64 * r; scr[kk] = __expf(LA[rb + kk]); scr[128 + kk] = bf2f(HQ[rb + kk]); }
        LDS_WAIT();
        const int v4 = (lane & 15) * 4, kq = lane >> 4;
        const v2u iw = *(const GAS v2u*)(HV + rb + vh * 64 + v4);
        const f32x4 iv = (f32x4){bflo(iw.x), bfhi(iw.x), bflo(iw.y), bfhi(iw.y)};
        const float* sin = st_in + ((size_t)(bs * 8 + h) * 128) * 128 + vh * 64 + v4; float* sout = st_out + ((size_t)(bs * 8 + h) * 128) * 128 + vh * 64 + v4;
        f32x4 o = (f32x4){0.f, 0.f, 0.f, 0.f};
#pragma unroll 8
        for (int i = 0; i < 32; ++i) { const int kk = 4 * i + kq; const float f = scr[kk];
            f32x4 s = __builtin_nontemporal_load((const GAS f32x4*)(sin + (size_t)kk * 128));
            s = s * f + iv * (1.f - f);
            __builtin_nontemporal_store(s, (GAS f32x4*)(sout + (size_t)kk * 128));
            o = o + s * scr[128 + kk]; }
#pragma unroll
        for (int e = 0; e < 4; ++e) { o[e] += __shfl_xor(o[e], 16); o[e] += __shfl_xor(o[e], 32); }
        if (lane < 16) *(GAS v2u*)(RO + rb + vh * 64 + v4) = pack4v(o);
        LDS_WAIT();
    }
    __syncthreads();
}

__device__ __forceinline__ void p0_transpose_item(const float* W, int K, int N, bf16* WT, LAS float* scr, int item, int lane, bool inter) {
    const int nblk = N / 32, kb = item / nblk, nb = item - kb * nblk, k0 = 64 * kb, n0 = 32 * nb;
    int s0 = n0; if (inter) { const int t = n0 >> 8, j = n0 & 255; s0 = j < 128 ? 128 * t + j : DFF + 128 * t + (j - 128); }
#pragma unroll 8
    for (int i = 0; i < 32; ++i) { const int kk = 2 * i + (lane >> 5); scr[kk * 33 + (lane & 31)] = W[(size_t)(k0 + kk) * N + s0 + (lane & 31)]; }
    LDS_WAIT(); asm volatile("" ::: "memory");
    const int c = lane & 7;
#pragma unroll
    for (int j = 0; j < 4; ++j) { const int n = (lane >> 3) + 8 * j; const LAS float* s = scr + (8 * c) * 33 + n;
        v4u o; o.x = cvt_pk_bf16(s[0 * 33], s[1 * 33]); o.y = cvt_pk_bf16(s[2 * 33], s[3 * 33]); o.z = cvt_pk_bf16(s[4 * 33], s[5 * 33]); o.w = cvt_pk_bf16(s[6 * 33], s[7 * 33]);
        *(GAS v4u*)(WT + (size_t)(n0 + n) * K + k0 + 8 * c) = o; }
    LDS_WAIT(); asm volatile("" ::: "memory");
}
__device__ __forceinline__ void p0_matrix(Frame& F, const float* W, int K, int N, bf16* WT, bool inter, int& itbase) {
    const int gw = F.vcu * NWAVES + F.wave, NGW = F.G * NWAVES, nit = (K / 64) * (N / 32);
    LAS float* scr = (LAS float*)(F.lds + F.wave * 16384);
    int first = (gw - itbase) % NGW; if (first < 0) first += NGW;
    for (int it = first; it < nit; it += NGW) p0_transpose_item(W, K, N, WT, scr, it, F.lane, inter);
    itbase += nit;
}

__device__ __forceinline__ void p1_ada_direct(Frame& F, const float* cp, const float* cs, const float* Wada, const float* bias, float* MOD) {
    constexpr int RS = 1040;
    static_assert(NCOND * RS <= SCR_BYTES, "P1 A half");
    const int w = F.wave, lane = F.lane, fr = lane & 15, fq = lane >> 4, tid = F.tid;
#pragma unroll 1
    for (int strip = F.vcu; strip < NMODALL / 96; strip += F.G) {
        const int layer = strip >> 6, n0 = 96 * (strip & 63) + 16 * w;
        const float* wp = Wada + (size_t)layer * D * NMOD + (size_t)(8 * fq) * NMOD + n0 + fr;
        f32x4 acc[9];
#pragma unroll
        for (int mt = 0; mt < 9; ++mt) acc[mt] = (f32x4){0.f, 0.f, 0.f, 0.f};
        float raw[2][4][8];
#define P1_LOAD(buf_, g_) do { if (w < 6) { _Pragma("unroll") for (int s_ = 0; s_ < 4; ++s_) _Pragma("unroll") for (int j_ = 0; j_ < 8; ++j_) \
            raw[buf_][s_][j_] = wp[(size_t)(32 * (4 * (g_) + s_) + j_) * NMOD]; } } while (0)
#define P1_MMA(buf_, gl_) do { if (w < 6) { _Pragma("unroll") for (int s_ = 0; s_ < 4; ++s_) { v4u wv_; \
            wv_.x = cvt_pk_bf16(raw[buf_][s_][0], raw[buf_][s_][1]); wv_.y = cvt_pk_bf16(raw[buf_][s_][2], raw[buf_][s_][3]); wv_.z = cvt_pk_bf16(raw[buf_][s_][4], raw[buf_][s_][5]); wv_.w = cvt_pk_bf16(raw[buf_][s_][6], raw[buf_][s_][7]); \
            const bf16x8 wf_ = __builtin_bit_cast(bf16x8, wv_); \
            _Pragma("unroll") for (int mt_ = 0; mt_ < 9; ++mt_) { const int row_ = (16 * mt_ + fr < NCOND) ? 16 * mt_ + fr : NCOND - 1; \
                const bf16x8 af_ = *(const LAS bf16x8*)(F.lds + row_ * RS + (4 * (gl_) + s_) * 64 + fq * 16); acc[mt_] = MFMA16(wf_, af_, acc[mt_]); } } } } while (0)
        P1_LOAD(0, 0);
#pragma unroll
        for (int h = 0; h < 2; ++h) {
            __syncthreads();
#pragma unroll
            for (int i = 0; i < (NCOND * 64) / 512; ++i) { const int p = tid + 512 * i, row = p >> 6, c16 = p & 63;
                const float* src = (row < BP ? cp + (size_t)row * D : cs + (size_t)(row - BP) * D) + 512 * h + c16 * 8;
                const f32x4 a = *(const GAS f32x4*)src, b = *(const GAS f32x4*)(src + 4);
                *(LAS v4u*)(F.lds + row * RS + c16 * 16) = pack8v(silu4(a), silu4(b)); }
            __syncthreads();
#pragma unroll
            for (int gl = 0; gl < 4; ++gl) { const int g = 4 * h + gl;
                if (g + 1 < 8) P1_LOAD((g + 1) & 1, g + 1);
                P1_MMA(g & 1, gl); }
        }
#undef P1_LOAD
#undef P1_MMA
        if (w < 6) { const int ncol = layer * NMOD + n0 + 4 * fq; const f32x4 bv = *(const GAS f32x4*)(bias + ncol);
#pragma unroll
            for (int mt = 0; mt < 9; ++mt) { const int row = 16 * mt + fr; if (row < NCOND) *(GAS f32x4*)(MOD + (size_t)row * NMODALL + ncol) = acc[mt] + bv; } }
    }
    __syncthreads();
}
static_assert((NCOND * 64) % 512 == 0 && NMOD % 96 == 0 && (NMOD / 96) == 64, "P1 strip geometry");

#ifndef REP_PROMPT
#define REP_PROMPT 1
#endif
#ifndef REP_PROMPT_SSD
#define REP_PROMPT_SSD REP_PROMPT
#endif
#ifndef REP_PROMPT_HG
#define REP_PROMPT_HG REP_PROMPT
#endif
#ifndef REP_SAMPLE
#define REP_SAMPLE 1
#endif
#ifndef REP_GEMM
#define REP_GEMM 1
#endif
#ifndef REP_GN
#define REP_GN 1
#endif
#ifndef REP_P0
#define REP_P0 1
#endif
#ifndef REP_SKINNY
#define REP_SKINNY 1
#endif
#ifndef REP_SK_ADA
#define REP_SK_ADA REP_SKINNY
#endif
#ifndef REP_SK_N1K
#define REP_SK_N1K REP_SKINNY
#endif
#define REPEAT(n) _Pragma("unroll 1") for (int rep_ = 0; rep_ < (n); ++rep_)
struct Args { const float* in[30]; float* out; unsigned char* ws; int ph_lo, ph_hi; };
enum { I_XP = 0, I_XS, I_CP, I_CS, I_SRET, I_SSSD, I_SCONV, I_SHG, I_WADA, I_BADA, I_NMPRE, I_NMPOST, I_NFPRE, I_NFPOST, I_RETIN, I_RETOUT, I_SSDIN, I_CONVW, I_CONVB, I_DTB, I_ALOG, I_SSDD,
       I_SSDNORM, I_SSDOUT, I_HGIN, I_HGLB, I_HGNORM, I_HGOUT, I_FFNIN, I_FFNOUT };
constexpr int N_PHASES = 3 + 8 * 4;

__global__ void __launch_bounds__(NWAVES * 64, 2) mk_fwd(Args args) {
    extern __shared__ __attribute__((aligned(16))) unsigned char lds_raw[];
    Frame F;
    F.lds = (LAS unsigned char*)lds_raw;
    F.tid = threadIdx.x; F.lane = F.tid & 63; F.wave = __builtin_amdgcn_readfirstlane(F.tid >> 6);
    F.G = gridDim.x; { const int bx = blockIdx.x; F.vcu = (F.G % 8 == 0) ? (bx % 8) * (F.G / 8) + bx / 8 : bx; }
    unsigned char* ws = args.ws;
    gu32* ctl = (gu32*)(ws + WS_CTL);
    for (int u = F.tid; u < (LDS_BYTES - LDSCTL_OFF) / 4; u += NWAVES * 64) ((LAS unsigned*)(F.lds + LDSCTL_OFF))[u] = 0u;
    __syncthreads();
    XcdBarrier bar; bar.bar = (unsigned*)(ctl + CW_BAR); bar.x = 0; bar.st = nullptr;
    if (MK_N_LAUNCHES == 1) bar = xcd_barrier_post((unsigned*)(ctl + CW_BAR), (volatile LAS unsigned*)(F.lds + LDSCTL_OFF) + 8);
    const int lo = args.ph_lo, hi = args.ph_hi;
#define IN(k) (lo <= (k) && (k) < hi)
#ifndef REP_BAR
#define REP_BAR 1
#endif
#define SEAM(k) do { if (IN((k) + 1)) { _Pragma("unroll") for (int rb_ = 0; rb_ < REP_BAR; ++rb_) xcd_barrier(bar); } } while (0)
#ifndef PF_B
#define PF_B 1
#endif
#define SEAM_PF(k, Bt_, N_, K_) do { if (IN((k) + 1)) { if (PF_B && MK_N_LAUNCHES == 1) xcd_barrier_pf(bar, F, (Bt_), (N_), (K_)); else xcd_barrier(bar); } } while (0)
#define BPRE(k) (PF_B && MK_N_LAUNCHES == 1 && IN((k) - 1) && IN(k))
    const bool ps_ = PANEL_SYNC && MK_N_LAUNCHES == 1 && F.G == 256;
    const int pm_ = panel_of_wg();
    gu32* const tmo_ = ctl + CW_BAR + XB_TMO;
#define SEAM_PANEL(k, seam, Bt_, N_, K_) do { if (IN((k) + 1)) { if (ps_) { panel_publish(F, ctl, (seam), pm_, (F.vcu < 16) ? 8u : 0u, !WT_ROW); panel_wait(F, panel_word(ctl, (seam), pm_), 4u, tmo_); } \
        else SEAM_PF(k, Bt_, N_, K_); } } while (0)
#define SEAM_PUB(k, seam, REL_, FALLBACK_) do { if (IN((k) + 1)) { if (ps_) panel_publish(F, ctl, (seam), pm_, 0u, (REL_)); else { FALLBACK_; } } } while (0)
#define PANEL_WAIT(k, seam) do { if (ps_ && IN((k) - 1)) panel_wait(F, panel_word(ctl, (seam), pm_), 4u, tmo_); } while (0)
#define SWAIT_ARG(k, seam) ((ps_ && IN((k) - 1)) ? panel_word(ctl, (seam), 65) : (gu32*)nullptr)
#define SAMPLE_WAIT(k, seam) do { if (ps_ && IN((k) - 1)) panel_wait(F, panel_word(ctl, (seam), 64), (unsigned)MS, tmo_); } while (0)
#define ALLWG_WAIT(k, seam) do { if (ps_ && IN((k) - 1)) panel_wait(F, panel_word(ctl, (seam), 65), 256u, tmo_); } while (0)
#define INP(i) (args.in[i])
    float* const out = args.out;
    float* const X = out + O_Y;
    bf16* const XB = (bf16*)(ws + WS_XB);
    bf16* const Hb = (bf16*)(ws + WS_H); bf16* const RO = (bf16*)(ws + WS_RO); bf16* const GO = (bf16*)(ws + WS_GO); bf16* const OUTB = (bf16*)(ws + WS_OUT); bf16* const ACT = (bf16*)(ws + WS_ACT);
    float* const MOD = (float*)(ws + WS_MOD); float* const LB = (float*)(ws + WS_LB);
    unsigned char* const PJ = ws + WS_PROJ;

    if (IN(0)) { REPEAT(REP_P0) {
        int itb = 0;
#pragma unroll 1
        for (int j = 0; j < 2; ++j) p0_matrix(F, INP(I_RETIN) + (size_t)j * D * RET_IN, D, RET_IN, (bf16*)(ws + WS_WRETIN) + (size_t)j * RET_IN * D, false, itb);
#pragma unroll 1
        for (int j = 0; j < 2; ++j) p0_matrix(F, INP(I_RETOUT) + (size_t)j * 2048 * D, 2048, D, (bf16*)(ws + WS_WRETOUT) + (size_t)j * D * 2048, false, itb);
        p0_matrix(F, INP(I_SSDIN), D, SSD_IN, (bf16*)(ws + WS_WSSDIN), false, itb);
        p0_matrix(F, INP(I_SSDOUT), 2048, D, (bf16*)(ws + WS_WSSDOUT), false, itb);
        p0_matrix(F, INP(I_HGIN), D, HG_IN, (bf16*)(ws + WS_WHGIN), false, itb);
        p0_matrix(F, INP(I_HGOUT), D, D, (bf16*)(ws + WS_WHGOUT), false, itb);
#pragma unroll 1
        for (int l = 0; l < 4; ++l) p0_matrix(F, INP(I_FFNIN) + (size_t)l * D * FFN_IN, D, FFN_IN, (bf16*)(ws + WS_WFFNIN) + (size_t)l * FFN_IN * D, true, itb);
#pragma unroll 1
        for (int l = 0; l < 4; ++l) p0_matrix(F, INP(I_FFNOUT) + (size_t)l * DFF * D, DFF, D, (bf16*)(ws + WS_WFFNOUT) + (size_t)l * D * DFF, false, itb);
        for (int idx = F.vcu * 512 + F.tid; idx < 1024; idx += F.G * 512) { const float* lg = INP(I_HGLB);
            const float l0 = lg[idx], l1 = lg[1024 + idx], l2 = lg[2048 + idx], l3 = lg[3072 + idx], m = fmaxf(fmaxf(l0, l1), fmaxf(l2, l3));
            const float e0 = expf(l0 - m), e1 = expf(l1 - m), e2 = expf(l2 - m), e3 = expf(l3 - m); LB[idx] = (e1 + e2) / ((e0 + e1) + (e2 + e3)); }
        }
        __syncthreads();
    }
    if (IN(1)) {
        REPEAT(REP_SK_ADA) p1_ada_direct(F, INP(I_CP), INP(I_CS), INP(I_WADA), INP(I_BADA), MOD);
        SEAM(1);
    }
    if (IN(2)) {
        resnorm_phase<0>(F, INP(I_XP), INP(I_XS), XB, X, nullptr, Hb, MOD, nullptr, 0, INP(I_NMPRE), 0 * NMOD + 0 * D, 0 * NMOD + 1 * D, ps_);
        SEAM_PANEL(2, 0, (const bf16*)(ws + WS_WRETIN), RET_IN, D);
    }

#ifndef STAGGER_TICKS
#define STAGGER_TICKS 0
#endif
#define GEMM_STAGGER(N_) do { if (STAGGER_TICKS > 0 && (N_) > 1024 && (blockIdx.x & 1)) { const unsigned long long t0_ = __builtin_amdgcn_s_memrealtime(); \
        while (__builtin_amdgcn_s_memrealtime() - t0_ < (unsigned long long)STAGGER_TICKS) __builtin_amdgcn_s_sleep(8); } } while (0)
#define MAIN_GEMM(PH_, PSK_, EmitT, eobj, Aptr, Btptr, N_, K_) do { GEMM_STAGGER(N_); pg8::Gemm g_{(const pg8::bf16_t*)(Aptr), (const pg8::bf16_t*)(Btptr), MPR, (N_), (K_)}; pg8::StaticOrder S_; S_.init(MPR, (N_), F.G, (int)blockIdx.x); \
        const EpiGen<EmitT> E_{eobj}; _Pragma("unroll") for (int rg_ = 0; rg_ < REP_GEMM; ++rg_) pg8::gemm_phase<EpiGen<EmitT>, pg8::StaticOrder, PG8_ALIGN, PG8_SP2>(F.lds, g_, S_, E_, BPRE(PH_) && !((PSK_) && ps_) && rg_ == 0); } while (0)
#define FFN_BLOCK(L, pb, LASTL, NXT_BT, NXT_N) do { \
    if (IN((pb) + 4)) { PANEL_WAIT((pb) + 4, 13 + 3 * (L)); resnorm_phase<1>(F, nullptr, nullptr, XB, X, OUTB, Hb, MOD, INP(I_NMPOST) + (L) * D, (L) * NMOD + 2 * D, INP(I_NFPRE) + (L) * D, (L) * NMOD + 3 * D, (L) * NMOD + 4 * D, ps_, SWAIT_ARG((pb) + 4, 13 + 3 * (L)), tmo_); SEAM_PANEL((pb) + 4, 2 + 3 * (L), (const bf16*)(ws + WS_WFFNIN) + (size_t)(L) * FFN_IN * D, FFN_IN, D); } \
    if (IN((pb) + 5)) { const bf16* wt_ = (const bf16*)(ws + WS_WFFNIN) + (size_t)(L) * FFN_IN * D; const EmitFfnIn e_{ACT}; \
        MAIN_GEMM((pb) + 5, 1, EmitFfnIn, e_, Hb, wt_, FFN_IN, D); SAMPLE_WAIT((pb) + 5, 2 + 3 * (L)); REPEAT(REP_SKINNY) skinny_gemm<8>(F, Hb + (size_t)MPR * D, D, 1, MS, MPR, wt_, (FFN_IN / 256) * 8, false, e_, F.G / 2, F.G / 2); SEAM_PUB((pb) + 5, 14 + 3 * (L), !WT_G3, SEAM_PF((pb) + 5, (const bf16*)(ws + WS_WFFNOUT) + (size_t)(L) * D * DFF, D, DFF)); } \
    if (IN((pb) + 6)) { const bf16* wt_ = (const bf16*)(ws + WS_WFFNOUT) + (size_t)(L) * D * DFF; const EmitOut e_{OUTB}; \
        PANEL_WAIT((pb) + 6, 14 + 3 * (L)); MAIN_GEMM((pb) + 6, 1, EmitOut, e_, ACT, wt_, D, DFF); if (ps_ && IN((pb) + 5)) panel_wait(F, panel_word(ctl, 14 + 3 * (L), 65), 256u, tmo_); REPEAT(REP_SK_N1K) skinny_gemm<2>(F, ACT + (size_t)MPR * DFF, DFF, 4, MS, MPR, wt_, (D / 256) * 8, false, e_, 0, F.G); SEAM_PUB((pb) + 6, 15 + 3 * (L), !WT_OUT, SEAM((pb) + 6)); } \
    if (IN((pb) + 7)) { PANEL_WAIT((pb) + 7, 15 + 3 * (L)); if (LASTL) resnorm_phase<2>(F, nullptr, nullptr, XB, X, OUTB, Hb, MOD, INP(I_NFPOST) + (L) * D, (L) * NMOD + 5 * D, nullptr, 0, 0, ps_, SWAIT_ARG((pb) + 7, 15 + 3 * (L)), tmo_); \
        else resnorm_phase<1>(F, nullptr, nullptr, XB, X, OUTB, Hb, MOD, INP(I_NFPOST) + (L) * D, (L) * NMOD + 5 * D, INP(I_NMPRE) + ((L) + 1) * D, ((L) + 1) * NMOD + 0 * D, ((L) + 1) * NMOD + 1 * D, ps_, SWAIT_ARG((pb) + 7, 15 + 3 * (L)), tmo_); \
        if (!(LASTL)) SEAM_PANEL((pb) + 7, 3 + 3 * (L), (NXT_BT), (NXT_N), D); } } while (0)
#define OUT_PROJ(L, pb, wt, K_) do { if (IN((pb) + 3)) { const EmitOut e_{OUTB}; MAIN_GEMM((pb) + 3, 1, EmitOut, e_, GO, (wt), D, (K_)); SAMPLE_WAIT((pb) + 3, 1 + 3 * (L)); REPEAT(REP_SK_N1K) skinny_gemm<2>(F, GO + (size_t)MPR * (K_), (K_), 4, MS, MPR, (wt), (D / 256) * 8, false, e_, 0, F.G); SEAM_PUB((pb) + 3, 13 + 3 * (L), !WT_OUT, SEAM((pb) + 3)); } } while (0)
#define RET_LAYER(L, J, pb) do { \
    bf16* const Qp_ = (bf16*)(PJ + PJ_RET_Q); bf16* const Kp_ = (bf16*)(PJ + PJ_RET_K); bf16* const Vp_ = (bf16*)(PJ + PJ_RET_V); bf16* const SGp_ = (bf16*)(PJ + PJ_RET_SG); \
    if (IN((pb) + 0)) { const bf16* wt_ = (const bf16*)(ws + WS_WRETIN) + (size_t)(J) * RET_IN * D; const EmitRetIn e_{Qp_, Kp_, Vp_, SGp_}; \
        MAIN_GEMM((pb) + 0, 1, EmitRetIn, e_, Hb, wt_, RET_IN, D); SAMPLE_WAIT((pb) + 0, 3 * (L)); REPEAT(REP_SKINNY) skinny_gemm<8>(F, Hb + (size_t)MPR * D, D, 1, MS, MPR, wt_, (RET_IN / 256) * 8, false, e_, 0, F.G); SEAM((pb) + 0); } \
    if (IN((pb) + 1)) { const bool fuse_ = (F.G == 256); const float* ssi_ = INP(I_SRET) + (size_t)(J) * 128 * 4 * 256 * 512; float* sso_ = out + O_RETS + (size_t)(J) * 128 * 4 * 256 * 512; \
        if (fuse_) { REPEAT(REP_PROMPT) ret_prompt_item<true>(F, F.vcu, Qp_, Kp_, Vp_, RO, out + O_RETP + (size_t)(J) * 8 * 4 * 256 * 512, ssi_, sso_); } \
        else { for (int item = F.vcu; item < 256; item += F.G) ret_prompt_item<false>(F, item, Qp_, Kp_, Vp_, RO, out + O_RETP + (size_t)(J) * 8 * 4 * 256 * 512, ssi_, sso_); \
            REPEAT(REP_SAMPLE) ret_sample_items(F, Qp_, Kp_, Vp_, RO, ssi_, sso_); } SEAM((pb) + 1); } \
    if (IN((pb) + 2)) { REPEAT(REP_GN) gatenorm_phase<0>(F, RO, SGp_, GO, nullptr, ps_); SEAM_PANEL((pb) + 2, 1 + 3 * (L), (const bf16*)(ws + WS_WRETOUT) + (size_t)(J) * D * 2048, D, 2048); } \
    OUT_PROJ(L, pb, (const bf16*)(ws + WS_WRETOUT) + (size_t)(J) * D * 2048, 2048); \
    } while (0)

    RET_LAYER(0, 0, 3);
    FFN_BLOCK(0, 3, false, (const bf16*)(ws + WS_WSSDIN), SSD_INM);
    {
        constexpr int pb = 11;
        bf16* const SZ_ = (bf16*)(PJ + PJ_SSD_SZ); bf16* const XBC_ = (bf16*)(PJ + PJ_SSD_XBC); float* const DT_ = (float*)(PJ + PJ_SSD_DT);
        if (IN(pb + 0)) { const bf16* wt_ = (const bf16*)(ws + WS_WSSDIN); const EmitSsdIn e_{SZ_, XBC_}; const EmitDt ed_{DT_};
            MAIN_GEMM(pb + 0, 1, EmitSsdIn, e_, Hb, wt_, SSD_INM, D); SAMPLE_WAIT(pb + 0, 3); ALLWG_WAIT(pb + 0, 3);
            REPEAT(REP_SKINNY) skinny_gemm<8>(F, Hb + (size_t)MPR * D, D, 1, MS, MPR, wt_, (SSD_INM / 256) * 8, false, e_, 0, F.G);
            REPEAT(REP_SKINNY) skinny_gemm<8>(F, Hb, D, MT / 128, MT, 0, wt_, 1, true, ed_, 0, F.G);
            SEAM(pb + 0); }
        if (IN(pb + 1)) {
            if (F.G == 256) { REPEAT(REP_PROMPT_SSD) ssd_prompt_item<true>(F, F.vcu, XBC_, DT_, RO, out + O_SSDP, INP(I_CONVW), INP(I_CONVB), INP(I_DTB), INP(I_ALOG), INP(I_SSDD), INP(I_SSSD), out + O_SSDS, INP(I_SCONV)); }
            else { for (int item = F.vcu; item < 256; item += F.G) ssd_prompt_item<false>(F, item, XBC_, DT_, RO, out + O_SSDP, INP(I_CONVW), INP(I_CONVB), INP(I_DTB), INP(I_ALOG), INP(I_SSDD), INP(I_SSSD), out + O_SSDS, INP(I_SCONV));
                REPEAT(REP_SAMPLE) ssd_sample_items(F, XBC_, DT_, RO, INP(I_SSSD), out + O_SSDS, INP(I_SCONV), INP(I_CONVW), INP(I_CONVB), INP(I_DTB), INP(I_ALOG), INP(I_SSDD)); }
            ssd_conv_out(F, XBC_, INP(I_SCONV), out + O_CONVP, out + O_CONVS);
            SEAM(pb + 1); }
        if (IN(pb + 2)) { REPEAT(REP_GN) gatenorm_phase<1>(F, RO, SZ_, GO, INP(I_SSDNORM), ps_); SEAM_PANEL(pb + 2, 4, (const bf16*)(ws + WS_WSSDOUT), D, 2048); }
        OUT_PROJ(1, pb, (const bf16*)(ws + WS_WSSDOUT), 2048);
    }
    FFN_BLOCK(1, 11, false, (const bf16*)(ws + WS_WHGIN), HG_IN);
    {
        constexpr int pb = 19;
        bf16* const HQ_ = (bf16*)(PJ + PJ_HG_Q); float* const LA_ = (float*)(PJ + PJ_HG_LA); bf16* const HV_ = (bf16*)(PJ + PJ_HG_V); bf16* const HSG_ = (bf16*)(PJ + PJ_HG_SG);
        if (IN(pb + 0)) { const bf16* wt_ = (const bf16*)(ws + WS_WHGIN); const EmitHgIn e_{HQ_, HV_, HSG_, LA_, LB};
            MAIN_GEMM(pb + 0, 1, EmitHgIn, e_, Hb, wt_, HG_IN, D); SAMPLE_WAIT(pb + 0, 6); REPEAT(REP_SKINNY) skinny_gemm<8>(F, Hb + (size_t)MPR * D, D, 1, MS, MPR, wt_, (HG_IN / 256) * 8, false, e_, 0, F.G); SEAM(pb + 0); }
        if (IN(pb + 1)) {
            if (F.G == 256) { REPEAT(REP_PROMPT_HG) hg_prompt_item<true>(F, F.vcu, HQ_, LA_, HV_, RO, out + O_HGP, INP(I_SHG), out + O_HGS); }
            else { for (int item = F.vcu; item < 256; item += F.G) hg_prompt_item<false>(F, item, HQ_, LA_, HV_, RO, out + O_HGP, INP(I_SHG), out + O_HGS);
                REPEAT(REP_SAMPLE) hg_sample_items(F, HQ_, LA_, HV_, RO, INP(I_SHG), out + O_HGS); }
            SEAM(pb + 1); }
        if (IN(pb + 2)) { REPEAT(REP_GN) gatenorm_phase<2>(F, RO, HSG_, GO, INP(I_HGNORM), ps_); SEAM_PANEL(pb + 2, 7, (const bf16*)(ws + WS_WHGOUT), D, 1024); }
        OUT_PROJ(2, pb, (const bf16*)(ws + WS_WHGOUT), 1024);
    }
    FFN_BLOCK(2, 19, false, (const bf16*)(ws + WS_WRETIN) + (size_t)RET_IN * D, RET_IN);
    RET_LAYER(3, 1, 27);
    FFN_BLOCK(3, 27, true, (const bf16*)nullptr, 0);
#undef IN
#undef SEAM
}

extern "C" void kernel_launch(void* const* d_in, const int* in_sizes, int n_in, void* d_out, int out_size, void* d_ws, size_t ws_size, hipStream_t stream) {
    static int grid = 0;
    if (grid == 0) {
        if (n_in != 30 || (size_t)out_size != O_END || ws_size < WS_END) { fprintf(stderr, "kernel_launch: unexpected shapes (n_in %d out %d ws %zu)\n", n_in, out_size, ws_size); grid = -1; return; }
        int dev = 0, cus = 0, per_cu = 0;
        if (hipGetDevice(&dev) != hipSuccess || hipDeviceGetAttribute(&cus, hipDeviceAttributeMultiprocessorCount, dev) != hipSuccess) { grid = -1; return; }
        if (hipFuncSetAttribute((const void*)mk_fwd, hipFuncAttributeMaxDynamicSharedMemorySize, LDS_BYTES) != hipSuccess) { fprintf(stderr, "kernel_launch: hipFuncSetAttribute failed\n"); grid = -1; return; }
        if (hipOccupancyMaxActiveBlocksPerMultiprocessor(&per_cu, (const void*)mk_fwd, NWAVES * 64, LDS_BYTES) != hipSuccess || per_cu < 1) { fprintf(stderr, "kernel_launch: occupancy query says %d\n", per_cu); }
        (void)hipGetLastError();
        grid = cus;
    }
    if (grid < 0) return;
    if (hipMemsetAsync((char*)d_ws + WS_CTL, 0, CTL_ZERO_BYTES, stream) != hipSuccess) { fprintf(stderr, "kernel_launch: memset failed\n"); return; }
    Args a{};
    for (int i = 0; i < 30; ++i) a.in[i] = (const float*)d_in[i];
    a.out = (float*)d_out; a.ws = (unsigned char*)d_ws;
#if MK_N_LAUNCHES == 1
    a.ph_lo = 0; a.ph_hi = N_PHASES;
    hipLaunchKernelGGL(mk_fwd, dim3(grid), dim3(NWAVES * 64), LDS_BYTES, stream, a);
#else
    for (int p = 0; p < N_PHASES; ++p) { a.ph_lo = p; a.ph_hi = p + 1; hipLaunchKernelGGL(mk_fwd, dim3(grid), dim3(NWAVES * 64), LDS_BYTES, stream, a); }
#endif
    const hipError_t le = hipPeekAtLastError();
    if (le != hipSuccess) fprintf(stderr, "kernel_launch: launch failed: %s\n", hipGetErrorName(le));
}
```

```cpp
#include <hip/hip_runtime.h>
#include <cstdio>
#include <cstdint>
namespace pg8 {
#define PG8_LAS __attribute__((address_space(3)))
typedef unsigned short bf16_t;
typedef short bf16x8 __attribute__((ext_vector_type(8)));
typedef float f32x4 __attribute__((ext_vector_type(4)));
typedef unsigned u32x4 __attribute__((ext_vector_type(4)));
constexpr int BM = 256, BK = 64, HALF = 128, HTB = HALF * BK * 2  , STAGE_BYTES = 8 * HTB, NXCD = 8, WGM = 8;

__host__ __device__ __forceinline__ int lds_byte(int r, int c) { const int st = (r >> 4) * 2 + (c >> 5), rr = r & 15, cc = c & 31, ob = rr * 64 + cc * 2; return st * 1024 + (ob ^ (((ob >> 9) & 1) << 5)); }
__host__ __device__ __forceinline__ void stage_rc(int b, int& R, int& C) { const int st = b / 1024, sb = b % 1024, swz = sb ^ (((sb >> 9) & 1) << 5); R = (st >> 1) * 16 + swz / 64; C = (st & 1) * 32 + (swz % 64) / 2; }
__host__ __device__ __forceinline__ int perm32(int rho) { const int n = rho >> 4, i = rho & 15; return 8 * (i >> 2) + 4 * n + (i & 3); }

struct Unit { int pm, pn; };
struct Gemm { const bf16_t* A; const bf16_t* Bt; int M, N, K; };

struct StaticOrder {
    int nM, nN, nwg, G, c;
    __host__ __device__ void init(int M, int N, int G_, int c_) { nM = M / BM; nN = N / BM; nwg = nM * nN; G = G_; c = c_; }
    __host__ __device__ bool next(int i, Unit& u) const {
        const long L = (long)i * G + c; if (L >= nwg) return false;
        int wgid = (int)L; { const int q = nwg / NXCD, r = nwg % NXCD, xcd = wgid % NXCD, off = wgid / NXCD; wgid = (xcd < r ? xcd * (q + 1) : r * (q + 1) + (xcd - r) * q) + off; }
        const int nig = WGM * nN, gid = wgid / nig, fm = gid * WGM, gsz = (nM - fm) < WGM ? (nM - fm) : WGM;
        u.pm = fm + ((wgid % nig) % gsz); u.pn = (wgid % nig) / gsz; return true;
    }
    __device__ __forceinline__ void a_ready(const Unit&) const {}
    __device__ __forceinline__ void done(const Unit&) const {}
};

__device__ __forceinline__ unsigned cvt_pk_bf16(float lo, float hi) { unsigned r; asm volatile("v_cvt_pk_bf16_f32 %0, %1, %2" : "=v"(r) : "v"(lo), "v"(hi)); return r; }
typedef float f32x2 __attribute__((ext_vector_type(2)));
template <class Epi, class Sched, bool ALIGN_EPI = false, bool SP2 = false>
__device__ __forceinline__ void gemm_phase(PG8_LAS unsigned char* lds, const Gemm g, const Sched& S, const Epi& E, const bool bpre = false) {
    const int tid = threadIdx.x, wid = __builtin_amdgcn_readfirstlane(tid >> 6), lane = tid & 63, wr = wid >> 2, wc = wid & 3, fr = lane & 15, fq = lane >> 4;
    const int K = g.K, nt = K / BK;
    unsigned voffA[2], voffB[2];
#pragma unroll
    for (int i = 0; i < 2; ++i) { int R, C; stage_rc(tid * 16 + i * 8192, R, C); const int Rb = Epi::PERM ? ((R & ~31) + perm32(R & 31)) : R;
        voffA[i] = (unsigned)(R * K + C) * 2u; voffB[i] = (unsigned)(Rb * K + C) * 2u; }
    const size_t kstep = (size_t)(BK * 2);
    const size_t hstep = (size_t)HALF * K * 2;
    const size_t tstep = 2 * hstep;
    const unsigned ldsw = (unsigned)wid * 1024u;
    const int aoff = lds_byte(wr * 64 + fr, fq * 8), boff = lds_byte(wc * 32 + fr, fq * 8);
#define PG8_SA(b, h) (((b) * 2 + (h)) * HTB)
#define PG8_SB(b, h) ((4 + (b) * 2 + (h)) * HTB)
#define PG8_STAGE(bufoff, gbase, voff) do { _Pragma("unroll") for (int _i = 0; _i < 2; ++_i) \
        __builtin_amdgcn_global_load_lds((const unsigned*)((const char*)(gbase) + (voff)[_i]), (PG8_LAS unsigned*)(lds + (bufoff) + ldsw + _i * 8192), 16, 0, 0); } while (0)
#define PG8_LDA(dst, b, h) do { _Pragma("unroll") for (int m = 0; m < 4; ++m) _Pragma("unroll") for (int k = 0; k < 2; ++k) dst[m][k] = *(const PG8_LAS bf16x8*)(lds + PG8_SA(b, h) + aoff + m * 2048 + k * 1024); } while (0)
#define PG8_LDB(dst, b, h) do { _Pragma("unroll") for (int n = 0; n < 2; ++n) _Pragma("unroll") for (int k = 0; k < 2; ++k) dst[n][k] = *(const PG8_LAS bf16x8*)(lds + PG8_SB(b, h) + boff + n * 2048 + k * 1024); } while (0)
#define PG8_MMA(ai, bj, At, Bt) do { __builtin_amdgcn_s_setprio(1); _Pragma("unroll") for (int m = 0; m < 4; ++m) _Pragma("unroll") for (int n = 0; n < 2; ++n) _Pragma("unroll") for (int k = 0; k < 2; ++k) \
        acc[ai][bj][m][n] = __builtin_amdgcn_mfma_f32_16x16x32_bf16(Bt[n][k], At[m][k], acc[ai][bj][m][n], 0, 0, 0); __builtin_amdgcn_s_setprio(0); } while (0)
#define PG8_WAIT_V(n) asm volatile("s_waitcnt vmcnt(" #n ")" ::: "memory")
#define PG8_WAIT_L(n) asm volatile("s_waitcnt lgkmcnt(" #n ")" ::: "memory")
#define PG8_BAR __builtin_amdgcn_s_barrier()
#define PG8_SCHED __builtin_amdgcn_sched_barrier(0)
    Unit cur, nxt; int ui = 0;
    if (!S.next(0, cur)) return;
    f32x4 acc[2][2][4][2];
#pragma unroll
    for (int a = 0; a < 2; ++a)
#pragma unroll
        for (int b = 0; b < 2; ++b)
#pragma unroll
            for (int m = 0; m < 4; ++m)
#pragma unroll
                for (int n = 0; n < 2; ++n) acc[a][b][m][n] = (f32x4){0.f, 0.f, 0.f, 0.f};
    bf16x8 At[4][2], B0[2][2], B1[2][2];
    const char* cA = (const char*)g.A + (size_t)cur.pm * tstep; const char* cB = (const char*)g.Bt + (size_t)cur.pn * tstep;
    S.a_ready(cur);
    if constexpr (SP2) {
        if (!(bpre && wid != 0)) { PG8_STAGE(PG8_SB(0, 0), cB, voffB); PG8_STAGE(PG8_SB(0, 1), cB + hstep, voffB); }
        PG8_STAGE(PG8_SA(0, 0), cA, voffA); PG8_STAGE(PG8_SA(0, 1), cA + hstep, voffA);
        if (wr == 1) PG8_BAR;
        PG8_WAIT_V(2); PG8_BAR;
        PG8_STAGE(PG8_SB(1, 0), cB + kstep, voffB); PG8_STAGE(PG8_SA(1, 0), cA + kstep, voffA); PG8_STAGE(PG8_SB(1, 1), cB + hstep + kstep, voffB);
        PG8_WAIT_V(6); PG8_BAR;
    } else {
        PG8_STAGE(PG8_SB(0, 0), cB, voffB); PG8_STAGE(PG8_SA(0, 0), cA, voffA); PG8_STAGE(PG8_SB(0, 1), cB + hstep, voffB); PG8_STAGE(PG8_SA(0, 1), cA + hstep, voffA);
        if (wr == 1) PG8_BAR;
        PG8_WAIT_V(4); PG8_BAR;
        PG8_STAGE(PG8_SB(1, 0), cB + kstep, voffB); PG8_STAGE(PG8_SA(1, 0), cA + kstep, voffA); PG8_STAGE(PG8_SB(1, 1), cB + hstep + kstep, voffB);
        PG8_WAIT_V(6); PG8_BAR;
    }
    for (;;) {
        const bool has_next = S.next(ui + 1, nxt);
        const char* nA = has_next ? (const char*)g.A + (size_t)nxt.pm * tstep : cA; const char* nB = has_next ? (const char*)g.Bt + (size_t)nxt.pn * tstep : cB;
        for (int t = 0; t < nt; t += 2) {
            const bool last = (t == nt - 2);
            const char* a1 = cA + (size_t)(t + 1) * kstep;
            const char* a2 = last ? nA : cA + (size_t)(t + 2) * kstep; const char* b2 = last ? nB : cB + (size_t)(t + 2) * kstep;
            const char* a3 = a2 + kstep; const char* b3 = b2 + kstep;
            if (last && has_next) S.a_ready(nxt);
            if constexpr (SP2) {
            PG8_LDB(B0, 0, 0); PG8_LDB(B1, 0, 1); PG8_SCHED; PG8_LDA(At, 0, 0); PG8_STAGE(PG8_SA(1, 1), a1 + hstep, voffA);
            PG8_WAIT_V(8); PG8_WAIT_L(0); PG8_BAR; PG8_MMA(0, 0, At, B0); PG8_MMA(0, 1, At, B1); PG8_BAR; PG8_SCHED;
            PG8_LDA(At, 0, 1); PG8_STAGE(PG8_SB(0, 0), b2, voffB); PG8_STAGE(PG8_SB(0, 1), b2 + hstep, voffB); PG8_STAGE(PG8_SA(0, 0), a2, voffA);
            PG8_WAIT_V(8); PG8_WAIT_L(0); PG8_BAR; PG8_MMA(1, 0, At, B0); PG8_MMA(1, 1, At, B1); PG8_BAR; PG8_SCHED;
            PG8_LDB(B0, 1, 0); PG8_LDB(B1, 1, 1); PG8_SCHED; PG8_LDA(At, 1, 0); PG8_STAGE(PG8_SA(0, 1), a2 + hstep, voffA);
            PG8_WAIT_V(8); PG8_WAIT_L(0); PG8_BAR; PG8_MMA(0, 0, At, B0); PG8_MMA(0, 1, At, B1); PG8_BAR; PG8_SCHED;
            PG8_LDA(At, 1, 1); PG8_STAGE(PG8_SB(1, 0), b3, voffB); PG8_STAGE(PG8_SB(1, 1), b3 + hstep, voffB); PG8_STAGE(PG8_SA(1, 0), a3, voffA);
            PG8_WAIT_V(8); PG8_WAIT_L(0); PG8_BAR; PG8_MMA(1, 0, At, B0); PG8_MMA(1, 1, At, B1); PG8_BAR; PG8_SCHED;
            } else {
            PG8_LDB(B0, 0, 0); PG8_SCHED; PG8_LDA(At, 0, 0); PG8_STAGE(PG8_SA(1, 1), a1 + hstep, voffA);
            PG8_WAIT_L(8); PG8_BAR; PG8_WAIT_L(0); PG8_MMA(0, 0, At, B0); PG8_BAR; PG8_SCHED;
            PG8_LDB(B1, 0, 1); PG8_STAGE(PG8_SB(0, 0), b2, voffB);
            PG8_BAR; PG8_WAIT_L(0); PG8_MMA(0, 1, At, B1); PG8_BAR;
            PG8_LDA(At, 0, 1); PG8_STAGE(PG8_SA(0, 0), a2, voffA);
            PG8_BAR; PG8_WAIT_L(0); PG8_MMA(1, 0, At, B0); PG8_BAR; PG8_SCHED;
            PG8_STAGE(PG8_SB(0, 1), b2 + hstep, voffB);
            PG8_WAIT_V(6); PG8_BAR; PG8_MMA(1, 1, At, B1); PG8_BAR;
            PG8_LDB(B0, 1, 0); PG8_SCHED; PG8_LDA(At, 1, 0); PG8_STAGE(PG8_SA(0, 1), a2 + hstep, voffA);
            PG8_WAIT_L(8); PG8_BAR; PG8_WAIT_L(0); PG8_MMA(0, 0, At, B0); PG8_BAR; PG8_SCHED;
            PG8_LDB(B1, 1, 1); PG8_STAGE(PG8_SB(1, 0), b3, voffB);
            PG8_BAR; PG8_WAIT_L(0); PG8_MMA(0, 1, At, B1); PG8_BAR;
            PG8_LDA(At, 1, 1); PG8_STAGE(PG8_SA(1, 0), a3, voffA);
            PG8_BAR; PG8_WAIT_L(0); PG8_MMA(1, 0, At, B0); PG8_BAR; PG8_SCHED;
            PG8_STAGE(PG8_SB(1, 1), b3 + hstep, voffB);
            PG8_WAIT_V(6); PG8_BAR; PG8_MMA(1, 1, At, B1); PG8_BAR;
            }
        }
        if constexpr (ALIGN_EPI) { if (wr == 0) PG8_BAR; }
        if constexpr (!Epi::AFTER_DRAIN) { E(acc, cur, wr, wc, fr, fq); S.done(cur); }
        if (!has_next) break;
#pragma unroll
        for (int a = 0; a < 2; ++a)
#pragma unroll
            for (int b = 0; b < 2; ++b)
#pragma unroll
                for (int m = 0; m < 4; ++m)
#pragma unroll
                    for (int n = 0; n < 2; ++n) acc[a][b][m][n] = (f32x4){0.f, 0.f, 0.f, 0.f};
        cur = nxt; cA = nA; cB = nB; ++ui;
        if constexpr (ALIGN_EPI) { if (wr == 1) PG8_BAR; }
    }
    PG8_WAIT_V(0);
    if constexpr (!ALIGN_EPI) { if (wr == 0) PG8_BAR; }
    PG8_BAR;
    if constexpr (Epi::AFTER_DRAIN) { E.fused(acc, cur, wr, wc, fr, fq, lds, wid, lane); S.done(cur); }
#undef PG8_SA
#undef PG8_SB
#undef PG8_STAGE
#undef PG8_LDA
#undef PG8_LDB
#undef PG8_MMA
#undef PG8_WAIT_V
#undef PG8_WAIT_L
#undef PG8_BAR
#undef PG8_SCHED
}
}

#ifndef PG8_SP2
#define PG8_SP2 true
#endif
#ifndef PG8_ALIGN
#define PG8_ALIGN true
#endif
#ifndef MK_N_LAUNCHES
#define MK_N_LAUNCHES 1
#endif

constexpr int D = 1024, BP = 8, SEQ = 2048, MPR = BP * SEQ  , MS = 128  , MT = MPR + MS  ;
constexpr int NCOND = BP + MS;
constexpr int DFF = 2816, NMOD = 6 * D  , NMODALL = 4 * NMOD  ;
constexpr int RET_IN = 6144, SSD_IN = 5152, SSD_INM = 5120, HG_IN = 4096, FFN_IN = 2 * DFF;
constexpr float EPS = 1e-6f;
constexpr int NWAVES = 8;

constexpr size_t MiB = 1u << 20;
constexpr size_t WS_CTL = 0, CTL_ZERO_BYTES = 1 * MiB;
constexpr size_t WS_WADA = 1 * MiB;
constexpr size_t WS_WRETIN = WS_WADA + 48 * MiB;
constexpr size_t WS_WRETOUT = WS_WRETIN + 24 * MiB;
constexpr size_t WS_WSSDIN = WS_WRETOUT + 8 * MiB;
constexpr size_t WS_WSSDOUT = WS_WSSDIN + 11 * MiB;
constexpr size_t WS_WHGIN = WS_WSSDOUT + 4 * MiB;
constexpr size_t WS_WHGOUT = WS_WHGIN + 8 * MiB;
constexpr size_t WS_WFFNIN = WS_WHGOUT + 2 * MiB;
constexpr size_t WS_WFFNOUT = WS_WFFNIN + 44 * MiB;
constexpr size_t WS_MOD = WS_WFFNOUT + 22 * MiB;
constexpr size_t WS_CACT = WS_MOD + 24 * MiB;
constexpr size_t WS_LB = WS_CACT + 512 * 1024;
constexpr size_t WS_H = WS_CACT + 1 * MiB;
constexpr size_t WS_PROJ = WS_H + 33 * MiB;
constexpr size_t WS_RO = WS_PROJ + 200 * MiB;
constexpr size_t WS_GO = WS_RO + 65 * MiB;
constexpr size_t WS_OUT = WS_GO + 65 * MiB;
constexpr size_t WS_ACT = WS_OUT + 33 * MiB;
constexpr size_t WS_XB = WS_ACT + 89 * MiB;
constexpr size_t WS_END = WS_XB + 33 * MiB;
constexpr size_t PJ_RET_Q = 0, PJ_RET_K = PJ_RET_Q + (size_t)MT * 1024 * 2, PJ_RET_V = PJ_RET_K + (size_t)MT * 1024 * 2, PJ_RET_SG = PJ_RET_V + (size_t)MT * 2048 * 2;
constexpr size_t PJ_SSD_SZ = 0, PJ_SSD_XBC = PJ_SSD_SZ + (size_t)MT * 2048 * 2, PJ_SSD_DT = PJ_SSD_XBC + (size_t)MT * 3072 * 2;
constexpr size_t PJ_SSD_CBC = PJ_SSD_DT + (size_t)MT * 32 * 4;
static_assert(PJ_SSD_CBC + (size_t)MT * 1024 * 2 <= 200 * MiB, "proj map (cbc)");
constexpr size_t PJ_HG_Q = 0, PJ_HG_LA = PJ_HG_Q + (size_t)MT * 1024 * 2, PJ_HG_V = PJ_HG_LA + (size_t)MT * 1024 * 4, PJ_HG_SG = PJ_HG_V + (size_t)MT * 1024 * 2;
static_assert(PJ_RET_SG + (size_t)MT * 2048 * 2 <= 200 * MiB && PJ_SSD_DT + (size_t)MT * 32 * 4 <= 200 * MiB && PJ_HG_SG + (size_t)MT * 1024 * 2 <= 200 * MiB, "proj map");
constexpr int CW_BAR = 4096;
#ifndef PANEL_SYNC
#define PANEL_SYNC 1
#endif
constexpr int CW_PANEL = 16384;

constexpr size_t O_Y = 0;
constexpr size_t O_RETP = (size_t)MT * D;
constexpr size_t O_RETS = O_RETP + (size_t)2 * 8 * 4 * 256 * 512;
constexpr size_t O_SSDP = O_RETS + (size_t)2 * 128 * 4 * 256 * 512;
constexpr size_t O_SSDS = O_SSDP + (size_t)8 * 32 * 128 * 64;
constexpr size_t O_CONVP = O_SSDS + (size_t)128 * 32 * 128 * 64;
constexpr size_t O_CONVS = O_CONVP + (size_t)8 * 3 * 3072;
constexpr size_t O_HGP = O_CONVS + (size_t)128 * 3 * 3072;
constexpr size_t O_HGS = O_HGP + (size_t)8 * 8 * 128 * 128;
constexpr size_t O_END = O_HGS + (size_t)128 * 8 * 128 * 128;
static_assert(O_END == 214245376ull, "output size");

constexpr int LDS_BYTES = 147456;
constexpr int LDSCTL_OFF = LDS_BYTES - 1024;
constexpr int SCR_BYTES = LDSCTL_OFF;

#define GAS __attribute__((address_space(1)))
#define LAS __attribute__((address_space(3)))
typedef unsigned short bf16;
typedef unsigned v4u __attribute__((ext_vector_type(4)));
typedef unsigned v2u __attribute__((ext_vector_type(2)));
typedef float f32x4 __attribute__((ext_vector_type(4)));
typedef short bf16x8 __attribute__((ext_vector_type(8)));
typedef short s16x4 __attribute__((ext_vector_type(4)));
typedef GAS unsigned gu32;
#define RLX_AGENT __ATOMIC_RELAXED, __HIP_MEMORY_SCOPE_AGENT
#define LDS_WAIT() asm volatile("s_waitcnt lgkmcnt(0)" ::: "memory")
#define VM_WAIT() asm volatile("s_waitcnt vmcnt(0)" ::: "memory")
typedef float f32x2_t __attribute__((ext_vector_type(2))); typedef __bf16 bf16x2_t __attribute__((ext_vector_type(2)));
__device__ __forceinline__ unsigned cvt_pk_bf16(float lo, float hi) { f32x2_t v = {lo, hi}; bf16x2_t b = __builtin_convertvector(v, bf16x2_t); return __builtin_bit_cast(unsigned, b); }
__device__ __forceinline__ float bf2f(unsigned b) { return __uint_as_float(b << 16); }
__device__ __forceinline__ float bflo(unsigned w) { return __uint_as_float(w << 16); }
__device__ __forceinline__ float bfhi(unsigned w) { return __uint_as_float(w & 0xffff0000u); }
__device__ __forceinline__ void unpack8(const v4u w, float (&f)[8]) { f[0] = bflo(w.x); f[1] = bfhi(w.x); f[2] = bflo(w.y); f[3] = bfhi(w.y); f[4] = bflo(w.z); f[5] = bfhi(w.z); f[6] = bflo(w.w); f[7] = bfhi(w.w); }
__device__ __forceinline__ v4u pack8(const float (&f)[8]) { v4u w; w.x = cvt_pk_bf16(f[0], f[1]); w.y = cvt_pk_bf16(f[2], f[3]); w.z = cvt_pk_bf16(f[4], f[5]); w.w = cvt_pk_bf16(f[6], f[7]); return w; }
__device__ __forceinline__ v4u pack8v(const f32x4 a, const f32x4 b) { v4u w; w.x = cvt_pk_bf16(a[0], a[1]); w.y = cvt_pk_bf16(a[2], a[3]); w.z = cvt_pk_bf16(b[0], b[1]); w.w = cvt_pk_bf16(b[2], b[3]); return w; }
__device__ __forceinline__ v2u pack4v(const f32x4 a) { v2u w; w.x = cvt_pk_bf16(a[0], a[1]); w.y = cvt_pk_bf16(a[2], a[3]); return w; }
__device__ __forceinline__ float sigmoidf_(float x) { return __builtin_amdgcn_rcpf(1.f + __expf(-x)); }
__device__ __forceinline__ float siluf_(float x) { return x * sigmoidf_(x); }
__device__ __forceinline__ float softplusf_(float x) { return x > 20.f ? x : log1pf(__expf(x)); }
__device__ __forceinline__ float wave_sum(float v) {
#pragma unroll
    for (int o = 1; o < 64; o <<= 1) v += __shfl_xor(v, o);
    return v;
}
__device__ __forceinline__ float grp16_sum(float v) {
#pragma unroll
    for (int o = 1; o < 16; o <<= 1) v += __shfl_xor(v, o);
    return v;
}
#define MFMA16(a, b, c) __builtin_amdgcn_mfma_f32_16x16x32_bf16((a), (b), (c), 0, 0, 0)
#define XB_TMO      128
#define XB_XCNT(j)  (256  + 64 * (j))
#define XB_XSUB(j)  (1280 + 64 * (j))
#define XB_XGEN(j)  (2304 + 64 * (j))
#define XB_TOP      3328
#define XB_TOPGEN   3392
#define XCD_BAR_WORDS 3456
#define XB_SPIN_CAP (1u << 18)

__device__ __forceinline__ unsigned xb_ld(unsigned* p)              { return __hip_atomic_load(p, __ATOMIC_RELAXED, __HIP_MEMORY_SCOPE_AGENT); }
__device__ __forceinline__ unsigned xb_add(unsigned* p, unsigned v) { return __hip_atomic_fetch_add(p, v, __ATOMIC_RELAXED, __HIP_MEMORY_SCOPE_AGENT); }
__device__ __forceinline__ unsigned xb_xcc_id() { return (unsigned)__builtin_amdgcn_s_getreg((3 << 11) | 20) & 0xFu; }
#define XB_SPIN(cond, bar) do { unsigned _sp = 0; while (cond) { __builtin_amdgcn_s_sleep(1); \
    if ((++_sp & 255u) == 0u) { if (xb_ld(&(bar)[XB_TMO])) break; if (_sp > XB_SPIN_CAP) { atomicAdd(&(bar)[XB_TMO], 1u); break; } } } } while (0)

struct XcdBarrier {
    unsigned* bar; unsigned x;
    volatile LAS unsigned* st;
};

__device__ __forceinline__ XcdBarrier xcd_barrier_post(unsigned* bar, volatile LAS unsigned* st) {
    XcdBarrier b; b.bar = bar; b.x = xb_xcc_id(); b.st = st;
    if (threadIdx.x == 0) (void)xb_add(&bar[XB_XCNT(b.x)], 1u);
    return b;
}
__device__ __forceinline__ void xcd_barrier_complete(unsigned* bar, unsigned x, unsigned& nloc, unsigned& nx) {
    const unsigned G = gridDim.x * gridDim.y * gridDim.z;
    unsigned sum, cnt, mine, sp = 0u;
    for (;;) {
        sum = 0u; cnt = 0u; mine = 0u;
#pragma unroll
        for (unsigned j = 0; j < 16; ++j) { const unsigned c = xb_ld(&bar[XB_XCNT(j)]); sum += c; cnt += (c > 0u) ? 1u : 0u; mine = (j == x) ? c : mine; }
        if (sum == G) break;
        __builtin_amdgcn_s_sleep(1);
        if ((++sp & 255u) == 0u) { if (xb_ld(&bar[XB_TMO])) break; if (sp > XB_SPIN_CAP) { atomicAdd(&bar[XB_TMO], 1u); break; } }
    }
    nloc = mine > 0u ? mine : 1u; nx = cnt > 0u ? cnt : 1u;
}

__device__ __forceinline__ void xcd_barrier(const XcdBarrier& b) {
    asm volatile("s_waitcnt vmcnt(0)" ::: "memory");
    __syncthreads();
    if (threadIdx.x == 0) {
        unsigned* bar = b.bar;
        __builtin_amdgcn_s_waitcnt(0);
        unsigned nloc = b.st[0], nx = b.st[1];
        if (nloc == 0u) { xcd_barrier_complete(bar, b.x, nloc, nx); b.st[0] = nloc; b.st[1] = nx; }
        const unsigned old = xb_add(&bar[XB_XSUB(b.x)], 1u);
        const unsigned gen = old / nloc;
        if (old + 1u == (gen + 1u) * nloc) {
            __builtin_amdgcn_fence(__ATOMIC_RELEASE, "agent");
            asm volatile("s_waitcnt vmcnt(0)" ::: "memory");
            const unsigned og = xb_add(&bar[XB_TOP], 1u);
            const unsigned tg = og / nx;
            if (og + 1u == (tg + 1u) * nx) xb_add(&bar[XB_TOPGEN], 1u);
            else XB_SPIN(xb_ld(&bar[XB_TOPGEN]) == tg, bar);
            __builtin_amdgcn_fence(__ATOMIC_ACQUIRE, "agent");
            xb_add(&bar[XB_XGEN(b.x)], 1u);
            asm volatile("s_waitcnt vmcnt(0)" ::: "memory");
        } else {
            XB_SPIN(xb_ld(&bar[XB_XGEN(b.x)]) == gen, bar);
            __builtin_amdgcn_fence(__ATOMIC_ACQUIRE, "agent");
            asm volatile("s_waitcnt vmcnt(0)" ::: "memory");
        }
    }
    __syncthreads();
}


struct Frame {
    LAS unsigned char* lds;
    int tid, lane, wave;
    int vcu, G;
};

__device__ __forceinline__ int panel_of_wg() { const int bx = blockIdx.x; return 8 * (bx & 7) + ((bx >> 3) & 7); }
__device__ __forceinline__ int panel_row0(const Frame& F) { const int bx = blockIdx.x; return 256 * panel_of_wg() + 64 * (bx >> 6) + 8 * F.wave; }
__device__ __forceinline__ gu32* panel_word(gu32* ctl, int seam, int idx) { return ctl + CW_PANEL + (seam * 66 + idx) * 64; }
#ifndef WT_ROW
#define WT_ROW 1
#endif
#ifndef WT_G3
#define WT_G3 1
#endif
#ifndef WT_OUT
#define WT_OUT 1
#endif
template <bool WT = true>
__device__ __forceinline__ void st16_wt(void* rowbase, int nbytes, int byteoff, const v4u v) {
    const __amdgpu_buffer_rsrc_t rs = __builtin_amdgcn_make_buffer_rsrc(rowbase, (short)0, nbytes, 0x00020000);
    __builtin_amdgcn_raw_buffer_store_b128(v, rs, byteoff, 0,   WT ? 16 : 0);
}
__device__ __forceinline__ void panel_publish(Frame& F, gu32* ctl, int seam, int pm, unsigned nsample, bool rel = false) {
    asm volatile("s_waitcnt vmcnt(0)" ::: "memory");
    __syncthreads();
    if (F.tid == 0) { if (rel) { __builtin_amdgcn_fence(__ATOMIC_RELEASE, "agent"); asm volatile("s_waitcnt vmcnt(0)" ::: "memory"); }
        (void)__hip_atomic_fetch_add(panel_word(ctl, seam, pm), 1u, RLX_AGENT); (void)__hip_atomic_fetch_add(panel_word(ctl, seam, 65), 1u, RLX_AGENT);
        if (nsample) (void)__hip_atomic_fetch_add(panel_word(ctl, seam, 64), nsample, RLX_AGENT); }
}
__device__ __forceinline__ void panel_wait(Frame& F, gu32* word, unsigned want, gu32* tmo) {
    if (F.wave == 0) { unsigned sp = 0;
        while ((unsigned)__builtin_amdgcn_readfirstlane(__hip_atomic_load(word, RLX_AGENT)) < want) { __builtin_amdgcn_s_sleep(1);
            if ((++sp & 255u) == 0u) { if (__builtin_amdgcn_readfirstlane(__hip_atomic_load(tmo, RLX_AGENT))) break;
                if (sp > (1u << 18)) { if (F.lane == 0) (void)__hip_atomic_fetch_add(tmo, 1u, RLX_AGENT); break; } } }
        __builtin_amdgcn_fence(__ATOMIC_ACQUIRE, "agent");
        asm volatile("s_waitcnt vmcnt(0)" ::: "memory"); }
    __syncthreads();
}

__device__ __forceinline__ void gemm_prefetch_b(LAS unsigned char* lds, const bf16* Bt, int N, int K, int G, int c, int tid, int wid) {
    pg8::StaticOrder S; S.init(MPR, N, G, c); pg8::Unit u; if (!S.next(0, u)) return;
    const size_t hstep = (size_t)pg8::HALF * K * 2;
    const char* cB = (const char*)Bt + (size_t)u.pn * (2 * hstep);
#pragma unroll
    for (int h = 0; h < 2; ++h)
#pragma unroll
        for (int i = 0; i < 2; ++i) { int R, C; pg8::stage_rc(tid * 16 + i * 8192, R, C); const int Rb = (R & ~31) + pg8::perm32(R & 31);
            __builtin_amdgcn_global_load_lds((const unsigned*)(cB + h * hstep + (size_t)(unsigned)(Rb * K + C) * 2u), (LAS unsigned*)(lds + (4 + h) * pg8::HTB + wid * 1024 + i * 8192), 16, 0, 0); }
}
__device__ __forceinline__ void xcd_barrier_pf(const XcdBarrier& b, Frame& F, const bf16* Bt, int N, int K) {
    asm volatile("s_waitcnt vmcnt(0)" ::: "memory");
    __syncthreads();
    if (F.wave != 0) gemm_prefetch_b(F.lds, Bt, N, K, F.G, (int)blockIdx.x, F.tid, F.wave);
    if (threadIdx.x == 0) {
        unsigned* bar = b.bar;
        __builtin_amdgcn_s_waitcnt(0);
        unsigned nloc = b.st[0], nx = b.st[1];
        if (nloc == 0u) { xcd_barrier_complete(bar, b.x, nloc, nx); b.st[0] = nloc; b.st[1] = nx; }
        const unsigned old = xb_add(&bar[XB_XSUB(b.x)], 1u);
        const unsigned gen = old / nloc;
        if (old + 1u == (gen + 1u) * nloc) {
            __builtin_amdgcn_fence(__ATOMIC_RELEASE, "agent");
            asm volatile("s_waitcnt vmcnt(0)" ::: "memory");
            const unsigned og = xb_add(&bar[XB_TOP], 1u);
            const unsigned tg = og / nx;
            if (og + 1u == (tg + 1u) * nx) xb_add(&bar[XB_TOPGEN], 1u);
            else XB_SPIN(xb_ld(&bar[XB_TOPGEN]) == tg, bar);
            __builtin_amdgcn_fence(__ATOMIC_ACQUIRE, "agent");
            xb_add(&bar[XB_XGEN(b.x)], 1u);
            asm volatile("s_waitcnt vmcnt(0)" ::: "memory");
        } else {
            XB_SPIN(xb_ld(&bar[XB_XGEN(b.x)]) == gen, bar);
            __builtin_amdgcn_fence(__ATOMIC_ACQUIRE, "agent");
            asm volatile("s_waitcnt vmcnt(0)" ::: "memory");
        }
    }
    __syncthreads();
}

template <class Fn> struct EpiGen {
    static constexpr bool PERM = true, AFTER_DRAIN = false;
    Fn f;
    __device__ __forceinline__ void operator()(const pg8::f32x4 (&acc)[2][2][4][2], const pg8::Unit& u, int wr, int wc, int fr, int fq) const {
        const int ca = u.pn * 256 + wc * 32 + 8 * fq;
#pragma unroll
        for (int ai = 0; ai < 2; ++ai)
#pragma unroll
            for (int m = 0; m < 4; ++m) {
                const int row = u.pm * 256 + ai * 128 + wr * 64 + m * 16 + fr;
                f.emit(row, ca, ca + 128, acc[ai][0][m][0], acc[ai][0][m][1], acc[ai][1][m][0], acc[ai][1][m][1]);
            }
    }
};
__device__ __forceinline__ void st8bf(bf16* p, const f32x4 a, const f32x4 b) { *(GAS v4u*)p = pack8v(a, b); }
__device__ __forceinline__ f32x4 silu4(const f32x4 a) { f32x4 r; r[0] = siluf_(a[0]); r[1] = siluf_(a[1]); r[2] = siluf_(a[2]); r[3] = siluf_(a[3]); return r; }

struct EmitRetIn {
    bf16 *Q, *K, *V, *SG;
    __device__ __forceinline__ void emit(int row, int ca, int cb, const f32x4 a0, const f32x4 a1, const f32x4 b0, const f32x4 b1) const {
        const int pn = ca >> 8, ch = ca & 255;
        if (pn < 8) {
            const float pos = row < MPR ? (float)(row & (SEQ - 1)) : 16384.f;
            const float sc = pn < 4 ? 1.f : 0.0625f;
            float x1[8] = {a0[0], a0[1], a0[2], a0[3], a1[0], a1[1], a1[2], a1[3]}, x2[8] = {b0[0], b0[1], b0[2], b0[3], b1[0], b1[1], b1[2], b1[3]}, o1[8], o2[8];
#pragma unroll
            for (int e = 0; e < 8; ++e) {
                const float inv = exp2f(-(float)(ch + e) * (13.287712379549449f / 128.f));
                float t = pos * inv * 0.15915494309189535f; t -= floorf(t);
                const float s = __builtin_amdgcn_sinf(t), c = __builtin_amdgcn_cosf(t);
                o1[e] = (x1[e] * c - x2[e] * s) * sc; o2[e] = (x2[e] * c + x1[e] * s) * sc;
            }
            bf16* dst = (pn < 4 ? Q : K) + (size_t)row * 1024 + (pn & 3) * 256 + ch;
            *(GAS v4u*)dst = pack8(o1); *(GAS v4u*)(dst + 128) = pack8(o2);
        } else if (pn < 16) {
            bf16* dst = V + (size_t)row * 2048 + (pn - 8) * 256 + ch; st8bf(dst, a0, a1); st8bf(dst + 128, b0, b1);
        } else {
            bf16* dst = SG + (size_t)row * 2048 + (pn - 16) * 256 + ch; st8bf(dst, silu4(a0), silu4(a1)); st8bf(dst + 128, silu4(b0), silu4(b1));
        }
    }
};
struct EmitSsdIn {
    bf16 *SZ, *XBC;
    __device__ __forceinline__ void emit(int row, int ca, int cb, const f32x4 a0, const f32x4 a1, const f32x4 b0, const f32x4 b1) const {
        const int pn = ca >> 8, ch = ca & 255;
        if (pn < 8) { bf16* dst = SZ + (size_t)row * 2048 + pn * 256 + ch; st8bf(dst, silu4(a0), silu4(a1)); st8bf(dst + 128, silu4(b0), silu4(b1)); }
        else { if (PANEL_SYNC) { const int o_ = (row * 3072 + (pn - 8) * 256 + ch) * 2; st16_wt<true>(XBC, MT * 3072 * 2, o_, pack8v(a0, a1)); st16_wt<true>(XBC, MT * 3072 * 2, o_ + 256, pack8v(b0, b1)); }
               else { bf16* dst = XBC + (size_t)row * 3072 + (pn - 8) * 256 + ch; st8bf(dst, a0, a1); st8bf(dst + 128, b0, b1); } }
    }
};
struct EmitDt {
    float* DT;
    __device__ __forceinline__ void emit(int row, int ca, int cb, const f32x4 a0, const f32x4 a1, const f32x4 b0, const f32x4 b1) const {
        float* d = DT + (size_t)row * 32; *(GAS f32x4*)(d + (ca - SSD_INM)) = a0; *(GAS f32x4*)(d + (ca - SSD_INM) + 4) = a1; *(GAS f32x4*)(d + (cb - SSD_INM)) = b0; *(GAS f32x4*)(d + (cb - SSD_INM) + 4) = b1;
    }
};
struct EmitHgIn {
    bf16 *HQ, *HV, *HSG; float* LA; const float* lb;
    __device__ __forceinline__ f32x4 logf4(const f32x4 x, const f32x4 l) const { f32x4 r;
#pragma unroll
        for (int e = 0; e < 4; ++e) r[e] = logf(l[e] + (1.f - l[e]) * sigmoidf_(x[e]));
        return r; }
    __device__ __forceinline__ void emit(int row, int ca, int cb, const f32x4 a0, const f32x4 a1, const f32x4 b0, const f32x4 b1) const {
        const int pn = ca >> 8, ch = ca & 255;
        if (pn < 4) { bf16* dst = HQ + (size_t)row * 1024 + pn * 256 + ch; const float s = 0.08838834764831845f; st8bf(dst, silu4(a0) * s, silu4(a1) * s); st8bf(dst + 128, silu4(b0) * s, silu4(b1) * s); }
        else if (pn < 8) { const int col = (pn - 4) * 256 + ch; float* dst = LA + (size_t)row * 1024 + col;
            const f32x4 l0 = *(const GAS f32x4*)(lb + col), l1 = *(const GAS f32x4*)(lb + col + 4), l2 = *(const GAS f32x4*)(lb + col + 128), l3 = *(const GAS f32x4*)(lb + col + 132);
            const f32x4 r0 = logf4(a0, l0), r1 = logf4(a1, l1), r2 = logf4(b0, l2), r3 = logf4(b1, l3);
            *(GAS f32x4*)dst = r0; *(GAS f32x4*)(dst + 4) = r1; *(GAS f32x4*)(dst + 128) = r2; *(GAS f32x4*)(dst + 132) = r3; }
        else if (pn < 12) { bf16* dst = HV + (size_t)row * 1024 + (pn - 8) * 256 + ch; st8bf(dst, a0, a1); st8bf(dst + 128, b0, b1); }
        else { bf16* dst = HSG + (size_t)row * 1024 + (pn - 12) * 256 + ch; st8bf(dst, silu4(a0), silu4(a1)); st8bf(dst + 128, silu4(b0), silu4(b1)); }
    }
};
struct EmitOut {
    bf16* OUT;
    __device__ __forceinline__ void emit(int row, int ca, int cb, const f32x4 a0, const f32x4 a1, const f32x4 b0, const f32x4 b1) const {
        if (PANEL_SYNC) { const int o_ = row * 2048; st16_wt<WT_OUT>(OUT, MT * 1024 * 2, o_ + ca * 2, pack8v(a0, a1)); st16_wt<WT_OUT>(OUT, MT * 1024 * 2, o_ + cb * 2, pack8v(b0, b1)); }
        else { bf16* dst = OUT + (size_t)row * 1024; st8bf(dst + ca, a0, a1); st8bf(dst + cb, b0, b1); }
    }
};
struct EmitFfnIn {
    bf16* ACT;
    __device__ __forceinline__ void emit(int row, int ca, int cb, const f32x4 a0, const f32x4 a1, const f32x4 b0, const f32x4 b1) const {
        if (PANEL_SYNC) st16_wt<WT_G3>(ACT, MT * DFF * 2, (row * DFF + (ca >> 8) * 128 + (ca & 255)) * 2, pack8v(silu4(a0) * b0, silu4(a1) * b1));
        else { bf16* dst = ACT + (size_t)row * DFF + (ca >> 8) * 128 + (ca & 255); st8bf(dst, silu4(a0) * b0, silu4(a1) * b1); }
    }
};
struct EmitMod {
    float* MOD; const float* bias;
    __device__ __forceinline__ void emit(int row, int ca, int cb, const f32x4 a0, const f32x4 a1, const f32x4 b0, const f32x4 b1) const {
        float* d = MOD + (size_t)row * NMODALL;
        const f32x4 q0 = *(const GAS f32x4*)(bias + ca), q1 = *(const GAS f32x4*)(bias + ca + 4), q2 = *(const GAS f32x4*)(bias + cb), q3 = *(const GAS f32x4*)(bias + cb + 4);
        *(GAS f32x4*)(d + ca) = a0 + q0; *(GAS f32x4*)(d + ca + 4) = a1 + q1; *(GAS f32x4*)(d + cb) = b0 + q2; *(GAS f32x4*)(d + cb + 4) = b1 + q3;
    }
};

__device__ __forceinline__ bf16x8 frag_perm(const bf16x8 v, const int addr) {
    const v4u u = __builtin_bit_cast(v4u, v); v4u r;
    r.x = (unsigned)__builtin_amdgcn_ds_bpermute(addr, (int)u.x); r.y = (unsigned)__builtin_amdgcn_ds_bpermute(addr, (int)u.y);
    r.z = (unsigned)__builtin_amdgcn_ds_bpermute(addr, (int)u.z); r.w = (unsigned)__builtin_amdgcn_ds_bpermute(addr, (int)u.w);
    return __builtin_bit_cast(bf16x8, r);
}
template <int NMT, class Fn>
__device__ __forceinline__ void skinny_gemm(Frame& F, const bf16* A, int K, int nrg, int nrows, int rowbase, const bf16* Bt, int ncu, bool dtmode, const Fn& f, int wg0, int span) {
    const int w = F.wave, lane = F.lane, fr = lane & 15, fq = lane >> 4;
    const int TP = K >> 6, pb = TP >> 3, prem = TP & 7, npairs = pb + (w < prem ? 1 : 0), kw0 = (w * pb + (w < prem ? w : prem)) * 64;
    constexpr int R = NMT * 16;
    LAS unsigned char* red = F.lds;
    const int nun = nrg * ncu, me = (int)blockIdx.x - wg0;
    if (me >= 0 && me < span) {
    for (int u = me; u < nun; u += span) {
        const int rg = u / ncu, cu = u - rg * ncu;
        int ca, cb; if (dtmode) { ca = SSD_INM; cb = SSD_INM + 16; } else { ca = 256 * (cu >> 3) + 16 * (cu & 7); cb = ca + 128; }
        const int lrow = lane >> 2, lpc = lane & 3;
        const bf16* ap = A + (size_t)(rg * R + lrow) * K + kw0 + lpc * 8;
        const bf16* bpa = Bt + (size_t)(ca + lrow) * K + kw0 + lpc * 8;
        const bf16* bpb = Bt + (size_t)(cb + lrow) * K + kw0 + lpc * 8;
        const int paddr = (4 * fr + fq) * 4;
        f32x4 acc[NMT][2];
#pragma unroll
        for (int mt = 0; mt < NMT; ++mt) { acc[mt][0] = (f32x4){0.f, 0.f, 0.f, 0.f}; acc[mt][1] = (f32x4){0.f, 0.f, 0.f, 0.f}; }
        constexpr int DEPTH = (NMT >= 8) ? 1 : 2;
        bf16x8 ra[DEPTH][2][NMT], rb0[DEPTH][2], rb1[DEPTH][2];
#define SK_LOAD(d_, pp_) do { _Pragma("unroll") for (int h_ = 0; h_ < 2; ++h_) { const int k_ = (pp_) * 64 + h_ * 32; \
            rb0[d_][h_] = *(const GAS bf16x8*)(bpa + k_); rb1[d_][h_] = *(const GAS bf16x8*)(bpb + k_); \
            _Pragma("unroll") for (int mt_ = 0; mt_ < NMT; ++mt_) ra[d_][h_][mt_] = *(const GAS bf16x8*)(ap + (size_t)mt_ * 16 * K + k_); } } while (0)
#define SK_MMA(d_) do { _Pragma("unroll") for (int h_ = 0; h_ < 2; ++h_) { const bf16x8 fb0_ = frag_perm(rb0[d_][h_], paddr), fb1_ = frag_perm(rb1[d_][h_], paddr); \
            _Pragma("unroll") for (int mt_ = 0; mt_ < NMT; ++mt_) { const bf16x8 fa_ = frag_perm(ra[d_][h_][mt_], paddr); \
                acc[mt_][0] = MFMA16(fb0_, fa_, acc[mt_][0]); acc[mt_][1] = MFMA16(fb1_, fa_, acc[mt_][1]); } } } while (0)
        if constexpr (DEPTH == 1) {
            SK_LOAD(0, 0);
            for (int pp = 0; pp < npairs; ++pp) { SK_MMA(0); SK_LOAD(0, pp + 1 < npairs ? pp + 1 : pp); }
        } else {
            SK_LOAD(0, 0); SK_LOAD(1, npairs > 1 ? 1 : 0);
            for (int pp = 0; pp < npairs; pp += 2) {
                SK_MMA(0); SK_LOAD(0, pp + 2 < npairs ? pp + 2 : pp);
                if (pp + 1 < npairs) { SK_MMA(1); SK_LOAD(1, pp + 3 < npairs ? pp + 3 : pp + 1); }
            }
        }
#undef SK_LOAD
#undef SK_MMA
        __syncthreads();
#pragma unroll
        for (int mt = 0; mt < NMT; ++mt)
#pragma unroll
            for (int nt = 0; nt < 2; ++nt) { const int row = mt * 16 + fr; *(LAS f32x4*)(red + ((w * R + row) * 8 + ((4 * nt + fq) ^ (row & 7))) * 16) = acc[mt][nt]; }
        __syncthreads();
        if (F.tid < 2 * R) {
            const int row = F.tid >> 1, hf = F.tid & 1;
            f32x4 va0 = (f32x4){0.f, 0.f, 0.f, 0.f}, va1 = va0, vb0 = va0, vb1 = va0;
#pragma unroll
            for (int ww = 0; ww < 8; ++ww) { const LAS unsigned char* pr = red + (ww * R + row) * 128;
                va0 += *(const LAS f32x4*)(pr + ((2 * hf) ^ (row & 7)) * 16); va1 += *(const LAS f32x4*)(pr + ((2 * hf + 1) ^ (row & 7)) * 16);
                vb0 += *(const LAS f32x4*)(pr + ((4 + 2 * hf) ^ (row & 7)) * 16); vb1 += *(const LAS f32x4*)(pr + ((5 + 2 * hf) ^ (row & 7)) * 16); }
            if (rg * R + row < nrows) f.emit(rowbase + rg * R + row, ca + hf * 8, cb + hf * 8, va0, va1, vb0, vb1);
        }
    }
    }
    __syncthreads();
}
static_assert(8 * 128 * 128 <= SCR_BYTES, "skinny reduction buffer");

__device__ __forceinline__ int cond_of_row(int row) { return row < MPR ? (row >> 11) : (BP + row - MPR); }
#define RNCOL(lane_, k_) (8 * (lane_) + 512 * ((k_) >> 1) + 4 * ((k_) & 1))
struct RnParams { f32x4 gwp[4], a[4], sh[4]; };
template <int MODE>
__device__ __forceinline__ void rn_load_params(RnParams& P, const float* modr, const float* wpost, int goff, const float* wpre, int shoff, int scoff, int lane) {
#pragma unroll
    for (int j = 0; j < 4; ++j) { const int c = RNCOL(lane, j);
        if (MODE != 0) P.gwp[j] = *(const GAS f32x4*)(modr + goff + c) * *(const GAS f32x4*)(wpost + c);
        if (MODE != 2) { P.a[j] = *(const GAS f32x4*)(wpre + c) * (*(const GAS f32x4*)(modr + scoff + c) + 1.f); P.sh[j] = *(const GAS f32x4*)(modr + shoff + c); } }
}
template <int MODE>
__device__ __forceinline__ void rn_row(const RnParams& P, f32x4 (&x)[4], const v2u (&yw)[4], bf16* Xbrow, float* Xfrow, bf16* Hrow, int lane, bool wt = false) {
    if (MODE != 0) {
        f32x4 y[4]; float ss = 0.f;
#pragma unroll
        for (int j = 0; j < 4; ++j) { y[j] = (f32x4){bflo(yw[j].x), bfhi(yw[j].x), bflo(yw[j].y), bfhi(yw[j].y)}; ss += (y[j][0] * y[j][0] + y[j][1] * y[j][1]) + (y[j][2] * y[j][2] + y[j][3] * y[j][3]); }
        const float r1 = rsqrtf(wave_sum(ss) * (1.f / D) + EPS);
#pragma unroll
        for (int j = 0; j < 4; ++j) x[j] = x[j] + P.gwp[j] * (y[j] * r1);
    }
#pragma unroll
    for (int j = 0; j < 4; ++j) { if (MODE == 2) *(GAS f32x4*)(Xfrow + RNCOL(lane, j)) = x[j]; else *(GAS v2u*)(Xbrow + RNCOL(lane, j)) = pack4v(x[j]); }
    if (MODE != 2) {
        float s2 = 0.f;
#pragma unroll
        for (int j = 0; j < 4; ++j) s2 += (x[j][0] * x[j][0] + x[j][1] * x[j][1]) + (x[j][2] * x[j][2] + x[j][3] * x[j][3]);
        const float r2 = rsqrtf(wave_sum(s2) * (1.f / D) + EPS);
#pragma unroll
        for (int j = 0; j < 4; ++j) x[j] = (x[j] * r2) * P.a[j] + P.sh[j];
        if (wt) { st16_wt<WT_ROW>(Hrow, D * 2, 16 * lane, pack8v(x[0], x[1])); st16_wt<WT_ROW>(Hrow, D * 2, 1024 + 16 * lane, pack8v(x[2], x[3])); }
        else {
#pragma unroll
            for (int j = 0; j < 4; ++j) *(GAS v2u*)(Hrow + RNCOL(lane, j)) = pack4v(x[j]); }
    }
}
__device__ __forceinline__ f32x4 ld_x4(const bf16* p) { const v2u w = *(const GAS v2u*)p; return (f32x4){bflo(w.x), bfhi(w.x), bflo(w.y), bfhi(w.y)}; }
template <int MODE>
__device__ __forceinline__ void resnorm_phase(Frame& F, const float* xp, const float* xs, bf16* Xb, float* Xf, const bf16* Y, bf16* H, const float* MOD,
                                              const float* wpost, int goff, const float* wpre, int shoff, int scoff, bool ps = false, gu32* swait = nullptr, gu32* tmo = nullptr) {
    const int gw = F.vcu * NWAVES + F.wave, NGW = F.G * NWAVES, lane = F.lane;
    const int per = (MPR + NGW - 1) / NGW;
    RnParams P;
    const int srow_ = MPR + gw; const bool has_s = (per == 8) && srow_ < MT;
    f32x4 sx_[4]; v2u sy_[4];
#pragma unroll
    for (int j = 0; j < 4; ++j) { sx_[j] = (f32x4){0.f, 0.f, 0.f, 0.f}; sy_[j] = (v2u){0u, 0u}; }
    if (has_s && swait != nullptr) panel_wait(F, swait, 256u, tmo);
    if (has_s) {
#pragma unroll
        for (int j = 0; j < 4; ++j) { const int c_ = RNCOL(lane, j); sx_[j] = (MODE == 0) ? *(const GAS f32x4*)(xs + (size_t)(srow_ - MPR) * D + c_) : ld_x4(Xb + (size_t)srow_ * D + c_); if (MODE != 0) sy_[j] = *(const GAS v2u*)(Y + (size_t)srow_ * D + c_); } }
    if (per == 8) {
        const int r0 = ps ? panel_row0(F) : gw * 8;
        rn_load_params<MODE>(P, MOD + (size_t)(r0 >> 11) * NMODALL, wpost, goff, wpre, shoff, scoff, lane);
        f32x4 qx[3][4]; v2u qy[3][4];
#define RN_FETCH(s_, row_) do { _Pragma("unroll") for (int j_ = 0; j_ < 4; ++j_) { const size_t o_ = (size_t)(row_) * D + RNCOL(lane, j_); \
            qx[s_][j_] = (MODE == 0) ? *(const GAS f32x4*)(xp + o_) : ld_x4(Xb + o_); qy[s_][j_] = (v2u){0u, 0u}; if (MODE != 0) qy[s_][j_] = *(const GAS v2u*)(Y + o_); } } while (0)
        RN_FETCH(0, r0); RN_FETCH(1, r0 + 1); RN_FETCH(2, r0 + 2);
#pragma unroll
        for (int i = 0; i < 8; ++i) {
            f32x4 x[4]; v2u yw[4];
#pragma unroll
            for (int j = 0; j < 4; ++j) { x[j] = qx[i % 3][j]; yw[j] = qy[i % 3][j]; }
            if (i + 3 < 8) RN_FETCH(i % 3, r0 + i + 3);
            rn_row<MODE>(P, x, yw, Xb + (size_t)(r0 + i) * D, Xf + (size_t)(r0 + i) * D, H + (size_t)(r0 + i) * D, lane, ps);
        }
#undef RN_FETCH
    } else
    for (int r0 = gw * per; r0 < MPR; r0 += NGW * per) {
        const int r1 = (r0 + per < MPR) ? r0 + per : MPR;
        int cond = r0 >> 11;
        rn_load_params<MODE>(P, MOD + (size_t)cond * NMODALL, wpost, goff, wpre, shoff, scoff, lane);
        f32x4 xn[4]; v2u yn[4];
#pragma unroll
        for (int j = 0; j < 4; ++j) { const size_t o_ = (size_t)r0 * D + RNCOL(lane, j); xn[j] = (MODE == 0) ? *(const GAS f32x4*)(xp + o_) : ld_x4(Xb + o_); yn[j] = (v2u){0u, 0u}; if (MODE != 0) yn[j] = *(const GAS v2u*)(Y + o_); }
        for (int row = r0; row < r1; ++row) {
            f32x4 x[4]; v2u yw[4];
#pragma unroll
            for (int j = 0; j < 4; ++j) { x[j] = xn[j]; yw[j] = yn[j]; }
            if ((row >> 11) != cond) { cond = row >> 11; rn_load_params<MODE>(P, MOD + (size_t)cond * NMODALL, wpost, goff, wpre, shoff, scoff, lane); }
            if (row + 1 < r1) {
#pragma unroll
                for (int j = 0; j < 4; ++j) { const size_t o_ = (size_t)(row + 1) * D + RNCOL(lane, j); xn[j] = (MODE == 0) ? *(const GAS f32x4*)(xp + o_) : ld_x4(Xb + o_); if (MODE != 0) yn[j] = *(const GAS v2u*)(Y + o_); } }
            rn_row<MODE>(P, x, yw, Xb + (size_t)row * D, Xf + (size_t)row * D, H + (size_t)row * D, lane);
        }
    }
    if (has_s) {
        rn_load_params<MODE>(P, MOD + (size_t)cond_of_row(srow_) * NMODALL, wpost, goff, wpre, shoff, scoff, lane);
        rn_row<MODE>(P, sx_, sy_, Xb + (size_t)srow_ * D, Xf + (size_t)srow_ * D, H + (size_t)srow_ * D, lane, ps);
    } else if (per != 8)
    for (int row = MPR + gw; row < MT; row += NGW) {
        rn_load_params<MODE>(P, MOD + (size_t)cond_of_row(row) * NMODALL, wpost, goff, wpre, shoff, scoff, lane);
        f32x4 x[4]; v2u yw[4];
#pragma unroll
        for (int j = 0; j < 4; ++j) { const int c_ = RNCOL(lane, j); x[j] = (MODE == 0) ? *(const GAS f32x4*)(xs + (size_t)(row - MPR) * D + c_) : ld_x4(Xb + (size_t)row * D + c_); yw[j] = (v2u){0u, 0u}; if (MODE != 0) yw[j] = *(const GAS v2u*)(Y + (size_t)row * D + c_); }
        rn_row<MODE>(P, x, yw, Xb + (size_t)row * D, Xf + (size_t)row * D, H + (size_t)row * D, lane);
    }
}
template <int MIX>
__device__ __forceinline__ void gatenorm_phase(Frame& F, const bf16* RO, const bf16* GATE, bf16* GO, const float* nw, bool ps = false) {
    const int gw = F.vcu * NWAVES + F.wave, NGW = F.G * NWAVES, lane = F.lane;
    constexpr int W = (MIX == 2) ? 1024 : 2048, NJ = W / 512;
    const int per = (MPR + NGW - 1) / NGW;
    float wv[NJ][8];
#pragma unroll
    for (int j = 0; j < NJ; ++j)
#pragma unroll
        for (int e = 0; e < 8; ++e) { const int c = 8 * lane + 512 * j + e; wv[j][e] = (MIX == 1) ? nw[c] : ((MIX == 2) ? nw[c & 127] : 1.f); }
    const int srow_ = MPR + gw; const bool has_s = (per == 8) && srow_ < MT;
    v4u so_[NJ], sg_[NJ];
#pragma unroll
    for (int j = 0; j < NJ; ++j) { so_[j] = (v4u){0u, 0u, 0u, 0u}; sg_[j] = so_[j]; }
    if (has_s) {
#pragma unroll
        for (int j = 0; j < NJ; ++j) { so_[j] = *(const GAS v4u*)(RO + (size_t)srow_ * W + 8 * lane + 512 * j); sg_[j] = *(const GAS v4u*)(GATE + (size_t)srow_ * W + 8 * lane + 512 * j); } }
    if (per == 8) {
        const int r0 = ps ? panel_row0(F) : gw * 8;
        v4u qo[3][NJ], qg[3][NJ];
#define GN_FETCH(s_, row_) do { _Pragma("unroll") for (int j_ = 0; j_ < NJ; ++j_) { qo[s_][j_] = *(const GAS v4u*)(RO + (size_t)(row_) * W + 8 * lane + 512 * j_); qg[s_][j_] = *(const GAS v4u*)(GATE + (size_t)(row_) * W + 8 * lane + 512 * j_); } } while (0)
        GN_FETCH(0, r0); GN_FETCH(1, r0 + 1); GN_FETCH(2, r0 + 2);
#pragma unroll
        for (int i = 0; i < 8; ++i) {
            v4u oc[NJ], gc[NJ];
#pragma unroll
            for (int j = 0; j < NJ; ++j) { oc[j] = qo[i % 3][j]; gc[j] = qg[i % 3][j]; }
            if (i + 3 < 8) GN_FETCH(i % 3, r0 + i + 3);
            float u[NJ][8], r[NJ];
#pragma unroll
            for (int j = 0; j < NJ; ++j) {
                float o[8], g[8]; unpack8(oc[j], o); unpack8(gc[j], g);
                float ss = 0.f;
#pragma unroll
                for (int e = 0; e < 8; ++e) { u[j][e] = o[e] * g[e]; ss += (MIX == 1) ? u[j][e] * u[j][e] : o[e] * o[e]; }
                if (MIX == 2) r[j] = rsqrtf(grp16_sum(ss) * (1.f / 128.f) + EPS); else r[j] = rsqrtf(wave_sum(ss) * (1.f / 512.f) + EPS);
            }
#pragma unroll
            for (int j = 0; j < NJ; ++j) { float v[8];
#pragma unroll
                for (int e = 0; e < 8; ++e) v[e] = u[j][e] * r[j] * wv[j][e];
                if (ps) st16_wt<WT_ROW>(GO + (size_t)(r0 + i) * W, W * 2, (8 * lane + 512 * j) * 2, pack8(v)); else *(GAS v4u*)(GO + (size_t)(r0 + i) * W + 8 * lane + 512 * j) = pack8(v); }
        }
#undef GN_FETCH
        if (has_s) {
            float u[NJ][8], r[NJ];
#pragma unroll
            for (int j = 0; j < NJ; ++j) {
                float o[8], g[8]; unpack8(so_[j], o); unpack8(sg_[j], g);
                float ss = 0.f;
#pragma unroll
                for (int e = 0; e < 8; ++e) { u[j][e] = o[e] * g[e]; ss += (MIX == 1) ? u[j][e] * u[j][e] : o[e] * o[e]; }
                if (MIX == 2) r[j] = rsqrtf(grp16_sum(ss) * (1.f / 128.f) + EPS); else r[j] = rsqrtf(wave_sum(ss) * (1.f / 512.f) + EPS);
            }
#pragma unroll
            for (int j = 0; j < NJ; ++j) { float v[8];
#pragma unroll
                for (int e = 0; e < 8; ++e) v[e] = u[j][e] * r[j] * wv[j][e];
                if (ps) st16_wt<WT_ROW>(GO + (size_t)srow_ * W, W * 2, (8 * lane + 512 * j) * 2, pack8(v)); else *(GAS v4u*)(GO + (size_t)srow_ * W + 8 * lane + 512 * j) = pack8(v); }
        }
    }
#pragma unroll 1
    for (int seg = (per == 8) ? 2 : 0; seg < 2; ++seg) {
        const int r0 = seg == 0 ? gw * per : MPR + gw;
        const int r1 = seg == 0 ? ((r0 + per < MPR) ? r0 + per : MPR) : ((r0 < MT) ? r0 + 1 : r0);
        if (r0 >= r1) continue;
        v4u on[NJ], gn[NJ];
#pragma unroll
        for (int j = 0; j < NJ; ++j) { on[j] = *(const GAS v4u*)(RO + (size_t)r0 * W + 8 * lane + 512 * j); gn[j] = *(const GAS v4u*)(GATE + (size_t)r0 * W + 8 * lane + 512 * j); }
        for (int row = r0; row < r1; ++row) {
            v4u oc[NJ], gc[NJ];
#pragma unroll
            for (int j = 0; j < NJ; ++j) { oc[j] = on[j]; gc[j] = gn[j]; }
            if (row + 1 < r1) {
#pragma unroll
                for (int j = 0; j < NJ; ++j) { on[j] = *(const GAS v4u*)(RO + (size_t)(row + 1) * W + 8 * lane + 512 * j); gn[j] = *(const GAS v4u*)(GATE + (size_t)(row + 1) * W + 8 * lane + 512 * j); } }
            float u[NJ][8], r[NJ];
#pragma unroll
            for (int j = 0; j < NJ; ++j) {
                float o[8], g[8]; unpack8(oc[j], o); unpack8(gc[j], g);
                float ss = 0.f;
#pragma unroll
                for (int e = 0; e < 8; ++e) { u[j][e] = o[e] * g[e]; ss += (MIX == 1) ? u[j][e] * u[j][e] : o[e] * o[e]; }
                if (MIX == 2) r[j] = rsqrtf(grp16_sum(ss) * (1.f / 128.f) + EPS); else r[j] = rsqrtf(wave_sum(ss) * (1.f / 512.f) + EPS);
            }
#pragma unroll
            for (int j = 0; j < NJ; ++j) { float v[8];
#pragma unroll
                for (int e = 0; e < 8; ++e) v[e] = u[j][e] * r[j] * wv[j][e];
                *(GAS v4u*)(GO + (size_t)row * W + 8 * lane + 512 * j) = pack8(v); }
        }
    }
}

template <int OFF> __device__ __forceinline__ bf16x8 tr_frag(unsigned addr) {
    s16x4 lo, hi;
    asm volatile("ds_read_b64_tr_b16 %0, %2\n\tds_read_b64_tr_b16 %1, %2 offset:%3\n\ts_waitcnt lgkmcnt(0)" : "=&v"(lo), "=&v"(hi) : "v"(addr), "i"(OFF) : "memory");
    return __builtin_shufflevector(lo, hi, 0, 1, 2, 3, 4, 5, 6, 7);
}
template <int OFF> __device__ __forceinline__ void tr_frag2(unsigned a0, unsigned a1, bf16x8& f0, bf16x8& f1) {
    s16x4 l0, h0, l1, h1;
    asm volatile("ds_read_b64_tr_b16 %0, %4\n\tds_read_b64_tr_b16 %1, %4 offset:%6\n\tds_read_b64_tr_b16 %2, %5\n\tds_read_b64_tr_b16 %3, %5 offset:%6\n\ts_waitcnt lgkmcnt(0)"
                 : "=&v"(l0), "=&v"(h0), "=&v"(l1), "=&v"(h1) : "v"(a0), "v"(a1), "i"(OFF) : "memory");
    f0 = __builtin_shufflevector(l0, h0, 0, 1, 2, 3, 4, 5, 6, 7); f1 = __builtin_shufflevector(l1, h1, 0, 1, 2, 3, 4, 5, 6, 7);
}

#define LDS_BARRIER() do { asm volatile("s_waitcnt lgkmcnt(0)" ::: "memory"); __builtin_amdgcn_s_barrier(); asm volatile("" ::: "memory"); } while (0)
#define TRRD(dst, addr, off) asm volatile("ds_read_b64_tr_b16 %0, %1 offset:%2" : "=&v"(dst) : "v"(addr), "i"(off) : "memory")
#define TR_WAIT() do { asm volatile("s_waitcnt lgkmcnt(0)" ::: "memory"); __builtin_amdgcn_sched_barrier(0); } while (0)
#define TR_JOIN(lo, hi) __builtin_shufflevector(lo, hi, 0, 1, 2, 3, 4, 5, 6, 7)
template <class Cf>
__device__ __forceinline__ void rec_step_a(LAS unsigned char* lds, const int w, const int lane, f32x4 (&S)[Cf::KPW][Cf::VS / 16], const LAS float* cum, f32x4 (&O)[(Cf::VS / 16 * Cf::C / 16 + 7) / 8]) {
    constexpr int C = Cf::C, KD = Cf::KD, VS = Cf::VS, NIT = C / 16, NJT = C / 16, NVT = VS / 16, KSK = KD / 32, KSC = C / 32;
    constexpr int RSK = Cf::RSK, RSV = Cf::RSV, RSP = Cf::RSP;
    constexpr bool CH = Cf::CH;
    const int fr = lane & 15, fq = lane >> 4, q4 = fr >> 2, p4 = fr & 3;
    const unsigned lbase = (unsigned)(size_t)lds;
    constexpr int NP = NIT * NJT, PPW = (NP + 7) / 8, NO = NVT * NIT, OPW = (NO + 7) / 8;
    static_assert((NIT == 4 && NVT == 4) || (NP <= 8 && NO <= 8), "tile deal");
    constexpr bool SHQ = (NIT == 4) && !CH;
    const int it = (NIT == 4) ? (w & 3) : (w / NJT);
    if constexpr (SHQ) {
        f32x4 p[2] = {(f32x4){0.f, 0.f, 0.f, 0.f}, (f32x4){0.f, 0.f, 0.f, 0.f}};
        f32x4 o2[2] = {(f32x4){0.f, 0.f, 0.f, 0.f}, (f32x4){0.f, 0.f, 0.f, 0.f}};
        const int j0 = w >> 2;
#pragma unroll 4
        for (int ks = 0; ks < KSK; ++ks) {
            const bf16x8 qf = *(const LAS bf16x8*)(lds + Cf::QA + (16 * it + fr) * RSK + (32 * ks + 8 * fq) * 2);
#pragma unroll
            for (int tt = 0; tt < 2; ++tt) { const int jt = j0 + 2 * tt;
                if (jt <= it) { const bf16x8 a = *(const LAS bf16x8*)(lds + Cf::KA + (16 * jt + fr) * RSK + (32 * ks + 8 * fq) * 2); p[tt] = MFMA16(a, qf, p[tt]); }
                const bf16x8 s = *(const LAS bf16x8*)(lds + Cf::ST + (16 * jt + fr) * RSK + (32 * ks + 8 * fq) * 2); o2[tt] = MFMA16(s, qf, o2[tt]); }
        }
        const int i = 16 * it + fr; const float ci = cum[i], ei = __expf(ci);
#pragma unroll
        for (int tt = 0; tt < 2; ++tt) { const int jt = j0 + 2 * tt;
#pragma unroll
            for (int r = 0; r < 4; ++r) { const int j = 16 * jt + 4 * fq + r; const float e = __expf(fminf(ci - cum[j], 0.f)); p[tt][r] = (j <= i) ? p[tt][r] * e : 0.f; }
            *(LAS v2u*)(lds + Cf::PM + (16 * it + fr) * RSP + (16 * jt + 4 * fq) * 2) = pack4v(p[tt]);
            O[tt] = o2[tt] * ei; }
    } else {
#pragma unroll
        for (int tt = 0; tt < PPW; ++tt) { const int t = w + 8 * tt;
            if (t < NP) { const int it1 = t / NJT, jt = t % NJT;
                f32x4 p = (f32x4){0.f, 0.f, 0.f, 0.f};
                if (jt <= it1) {
#pragma unroll
                    for (int ks = 0; ks < KSK; ++ks) {
                        const bf16x8 a = *(const LAS bf16x8*)(lds + Cf::KA + (16 * jt + fr) * RSK + (32 * ks + 8 * fq) * 2);
                        const bf16x8 b = *(const LAS bf16x8*)(lds + Cf::QA + (16 * it1 + fr) * RSK + (32 * ks + 8 * fq) * 2);
                        p = MFMA16(a, b, p); }
                    const int i = 16 * it1 + fr;
                    if (!CH) { const float ci = cum[i];
#pragma unroll
                        for (int r = 0; r < 4; ++r) { const int j = 16 * jt + 4 * fq + r; const float e = __expf(fminf(ci - cum[j], 0.f)); p[r] = (j <= i) ? p[r] * e : 0.f; } }
                    else {
#pragma unroll
                        for (int r = 0; r < 4; ++r) { const int j = 16 * jt + 4 * fq + r; p[r] = (j <= i) ? p[r] : 0.f; } }
                }
                *(LAS v2u*)(lds + Cf::PM + (16 * it1 + fr) * RSP + (16 * jt + 4 * fq) * 2) = pack4v(p);
            } }
#pragma unroll
        for (int tt = 0; tt < OPW; ++tt) { const int t = w + 8 * tt; O[tt] = (f32x4){0.f, 0.f, 0.f, 0.f};
            if (t < NO) { const int vt = t / NIT, it3 = t % NIT; f32x4 o = (f32x4){0.f, 0.f, 0.f, 0.f};
#pragma unroll
                for (int ks = 0; ks < KSK; ++ks) {
                    const bf16x8 a = *(const LAS bf16x8*)(lds + Cf::ST + (16 * vt + fr) * RSK + (32 * ks + 8 * fq) * 2);
                    const bf16x8 b = *(const LAS bf16x8*)(lds + Cf::QB + (16 * it3 + fr) * RSK + (32 * ks + 8 * fq) * 2);
                    o = MFMA16(a, b, o); }
                if (!CH) o = o * __expf(cum[16 * it3 + fr]);
                O[tt] = o; } }
    }
#pragma unroll
    for (int ki = 0; ki < Cf::KPW; ++ki) { const int kt = w + 8 * ki;
        if (!CH) { const float d = __expf(cum[C - 1]);
#pragma unroll
            for (int vt = 0; vt < NVT; ++vt) S[ki][vt] = S[ki][vt] * d; }
        else { const LAS float* ds = (const LAS float*)(lds + Cf::DS) + 16 * kt + 4 * fq; const f32x4 d = (f32x4){ds[0], ds[1], ds[2], ds[3]};
#pragma unroll
            for (int vt = 0; vt < NVT; ++vt) S[ki][vt] = S[ki][vt] * d; } }
#pragma unroll
    for (int ks = 0; ks < KSC; ++ks) {
        s16x4 vl[NVT], vh[NVT], kl[Cf::KPW], kh[Cf::KPW];
#pragma unroll
        for (int vt = 0; vt < NVT; ++vt) { const unsigned ad = lbase + Cf::VB + (32 * ks + 8 * fq + q4) * RSV + (16 * vt + 4 * p4) * 2; TRRD(vl[vt], ad, 0); TRRD(vh[vt], ad, 4 * RSV); }
#pragma unroll
        for (int ki = 0; ki < Cf::KPW; ++ki) { const unsigned ad = lbase + Cf::KB + (32 * ks + 8 * fq + q4) * RSK + (16 * (w + 8 * ki) + 4 * p4) * 2; TRRD(kl[ki], ad, 0); TRRD(kh[ki], ad, 4 * RSK); }
        TR_WAIT();
#pragma unroll
        for (int ki = 0; ki < Cf::KPW; ++ki) { const bf16x8 a = TR_JOIN(kl[ki], kh[ki]);
#pragma unroll
            for (int vt = 0; vt < NVT; ++vt) S[ki][vt] = MFMA16(a, TR_JOIN(vl[vt], vh[vt]), S[ki][vt]); }
    }
}
template <class Cf, class OutFn>
__device__ __forceinline__ void rec_step_b(LAS unsigned char* lds, const int w, const int lane, const f32x4 (&S)[Cf::KPW][Cf::VS / 16], f32x4 (&O)[(Cf::VS / 16 * Cf::C / 16 + 7) / 8], const OutFn& out, const int tok0) {
    constexpr int C = Cf::C, VS = Cf::VS, NIT = C / 16, NVT = VS / 16, KSC = C / 32;
    constexpr int RSK = Cf::RSK, RSV = Cf::RSV, RSP = Cf::RSP;
    constexpr int NO = NVT * NIT, OPW = (NO + 7) / 8;
    const int fr = lane & 15, fq = lane >> 4, q4 = fr >> 2, p4 = fr & 3;
    const unsigned lbase = (unsigned)(size_t)lds;
    const int it = (NIT == 4) ? (w & 3) : 0;
    if constexpr (NIT == 4) {
        const int v0 = w >> 2;
        s16x4 al[KSC][2], ah[KSC][2]; bf16x8 pb[KSC];
#pragma unroll
        for (int ks = 0; ks < KSC; ++ks) {
#pragma unroll
            for (int tt = 0; tt < 2; ++tt) { const unsigned ad = lbase + Cf::V + (32 * ks + 8 * fq + q4) * RSV + (16 * (v0 + 2 * tt) + 4 * p4) * 2; TRRD(al[ks][tt], ad, 0); TRRD(ah[ks][tt], ad, 4 * RSV); } }
#pragma unroll
        for (int ks = 0; ks < KSC; ++ks) pb[ks] = *(const LAS bf16x8*)(lds + Cf::PM + (16 * it + fr) * RSP + (32 * ks + 8 * fq) * 2);
        TR_WAIT();
#pragma unroll
        for (int ks = 0; ks < KSC; ++ks) { O[0] = MFMA16(TR_JOIN(al[ks][0], ah[ks][0]), pb[ks], O[0]); O[1] = MFMA16(TR_JOIN(al[ks][1], ah[ks][1]), pb[ks], O[1]); }
        out(tok0 + 16 * it + fr, 16 * it + fr, 16 * v0 + 4 * fq, O[0]);
        out(tok0 + 16 * it + fr, 16 * it + fr, 16 * (v0 + 2) + 4 * fq, O[1]);
    } else {
#pragma unroll
        for (int tt = 0; tt < OPW; ++tt) { const int t = w + 8 * tt;
            if (t < NO) { const int vt = t / NIT, it2 = t % NIT; f32x4 o = O[tt];
#pragma unroll
                for (int ks = 0; ks < KSC; ++ks) {
                    const bf16x8 a = tr_frag<4 * RSV>(lbase + Cf::V + (32 * ks + 8 * fq + q4) * RSV + (16 * vt + 4 * p4) * 2);
                    const bf16x8 b = *(const LAS bf16x8*)(lds + Cf::PM + (16 * it2 + fr) * RSP + (32 * ks + 8 * fq) * 2);
                    o = MFMA16(a, b, o); }
                out(tok0 + 16 * it2 + fr, 16 * it2 + fr, 16 * vt + 4 * fq, o); } }
    }
#pragma unroll
    for (int ki = 0; ki < Cf::KPW; ++ki) { const int kt = w + 8 * ki;
#pragma unroll
        for (int vt = 0; vt < NVT; ++vt) *(LAS v2u*)(lds + Cf::ST + (16 * vt + fr) * RSK + (16 * kt + 4 * fq) * 2) = pack4v(S[ki][vt]); }
}
template <class Cf, class OutFn>
__device__ __forceinline__ void rec_step(LAS unsigned char* lds, const int w, const int lane, f32x4 (&S)[Cf::KPW][Cf::VS / 16], const LAS float* cum, const OutFn& out, const int tok0) {
    f32x4 O[(Cf::VS / 16 * Cf::C / 16 + 7) / 8];
    rec_step_a<Cf>(lds, w, lane, S, cum, O);
    LDS_BARRIER();
    rec_step_b<Cf>(lds, w, lane, S, O, out, tok0);
    LDS_BARRIER();
}
template <class Cf> __device__ __forceinline__ void rec_zero_state(Frame& F, f32x4 (&S)[Cf::KPW][Cf::VS / 16]) {
#pragma unroll
    for (int ki = 0; ki < Cf::KPW; ++ki)
#pragma unroll
        for (int vt = 0; vt < Cf::VS / 16; ++vt) S[ki][vt] = (f32x4){0.f, 0.f, 0.f, 0.f};
    for (int o = F.tid * 16; o < Cf::VS * Cf::RSK; o += 512 * 16) *(LAS v4u*)(F.lds + Cf::ST + o) = (v4u){0u, 0u, 0u, 0u};
}
template <class Cf> __device__ __forceinline__ void rec_store_state(Frame& F, const f32x4 (&S)[Cf::KPW][Cf::VS / 16], float* dst, int ldv) {
    const int fr = F.lane & 15, fq = F.lane >> 4;
#pragma unroll
    for (int ki = 0; ki < Cf::KPW; ++ki) { const int kt = F.wave + 8 * ki;
#pragma unroll
        for (int vt = 0; vt < Cf::VS / 16; ++vt)
#pragma unroll
            for (int r = 0; r < 4; ++r) dst[(size_t)(16 * kt + 4 * fq + r) * ldv + 16 * vt + fr] = S[ki][vt][r]; }
}

struct CfRet { static constexpr int C = 64, KD = 256, VS = 64, KPW = 2, RSK = 528, RSV = 144, RSP = 144; static constexpr bool CH = false;
    static constexpr int QA = 0, KA = 33792, QB = QA, KB = KA, V = 67584, VB = 76800, PM = 86016, ST = 95232, CUM = 129024, DS = 0, END = 129280; };
static_assert(CfRet::END <= SCR_BYTES, "ret lds");
struct RetOut { bf16* dst;
    __device__ __forceinline__ void operator()(int tok, int i, int vv0, const f32x4 o) const { *(GAS v2u*)(dst + (size_t)tok * 2048 + vv0) = pack4v(o); } };
template <bool fuse>
__device__ __forceinline__ void ret_prompt_item(Frame& F, int item, const bf16* Q, const bf16* K, const bf16* V, bf16* RO, float* st_out,
                                                const float* sst_in, float* sst_out) {
    const int b = item >> 5, h = (item >> 3) & 3, vs = item & 7, tid = F.tid;
    const float lg = logf(1.f - exp2f(-5.f - (float)h));
    LAS float* cum = (LAS float*)(F.lds + CfRet::CUM);
    LAS float* sqk = (LAS float*)(F.lds + CfRet::END);
    LAS float* sred = sqk + 1024;
    __syncthreads();
    if (tid < 64) cum[tid] = (float)(tid + 1) * lg;
    f32x4 S[CfRet::KPW][4];
    rec_zero_state<CfRet>(F, S);
    const bf16* qg = Q + (size_t)(b * SEQ) * 1024 + h * 256; const bf16* kg = K + (size_t)(b * SEQ) * 1024 + h * 256; const bf16* vg = V + (size_t)(b * SEQ) * 2048 + h * 512 + vs * 64;
    const RetOut out{RO + (size_t)(b * SEQ) * 2048 + h * 512 + vs * 64};
    v4u qr[4], kr[4], vr;
#pragma unroll
    for (int i = 0; i < 4; ++i) { const int pc = tid + 512 * i, row = pc >> 5, c16 = pc & 31; qr[i] = *(const GAS v4u*)(qg + (size_t)row * 1024 + c16 * 8); kr[i] = *(const GAS v4u*)(kg + (size_t)row * 1024 + c16 * 8); }
    vr = *(const GAS v4u*)(vg + (size_t)(tid >> 3) * 2048 + (tid & 7) * 8);
    const float vsc = __expf((float)(63 - (tid >> 3)) * lg);
    const int sc4 = (tid & 127) * 4, srq = tid >> 7;
    f32x4 sv = (f32x4){0.f, 0.f, 0.f, 0.f}, so = sv, sst[4]; float sg = 0.f; const float* sin = sst_in; float* sout = sst_out; size_t srow = 0; int shh = 0;
#define RET_S_SETUP(si) do { const int sit_ = F.vcu + 256 * (si), bs_ = sit_ >> 2; shh = sit_ & 3; srow = MPR + bs_; \
        sqk[(si) * 512 + tid] = tid < 256 ? bf2f(Q[srow * 1024 + shh * 256 + tid]) : bf2f(K[srow * 1024 + shh * 256 + (tid - 256)]); \
        const v2u vw_ = *(const GAS v2u*)(V + srow * 2048 + shh * 512 + sc4); sv = (f32x4){bflo(vw_.x), bfhi(vw_.x), bflo(vw_.y), bfhi(vw_.y)}; \
        so = (f32x4){0.f, 0.f, 0.f, 0.f}; sg = 1.f - exp2f(-5.f - (float)shh); \
        sin = sst_in + ((size_t)(bs_ * 4 + shh) * 256) * 512 + sc4; sout = sst_out + ((size_t)(bs_ * 4 + shh) * 256) * 512 + sc4; } while (0)
#define RET_S_LOAD(st_) do { _Pragma("unroll") for (int k_ = 0; k_ < 4; ++k_) sst[k_] = __builtin_nontemporal_load((const GAS f32x4*)(sin + (size_t)(16 * (st_) + srq + 4 * k_) * 512)); } while (0)
    if (fuse) { RET_S_SETUP(0); RET_S_LOAD(0); __syncthreads(); }
    for (int c = 0; c < SEQ / 64; ++c) {
        const int sidx = c >> 4, sstep = c & 15;
        if (fuse) {
#pragma unroll
            for (int k = 0; k < 4; ++k) { const int rr = 16 * sstep + srq + 4 * k; const float kf = sqk[sidx * 512 + 256 + rr], qf = sqk[sidx * 512 + rr];
                const f32x4 s = sst[k] * sg + sv * kf;
                __builtin_nontemporal_store(s, (GAS f32x4*)(sout + (size_t)rr * 512)); so = so + s * qf; }
            if (sstep == 0 && sidx == 1) {
                const float acc = (sred[tid] + sred[512 + tid]) + (sred[1024 + tid] + sred[1536 + tid]);
                const int sit0 = F.vcu, bs0 = sit0 >> 2, h0 = sit0 & 3;
                RO[(size_t)(MPR + bs0) * 2048 + h0 * 512 + tid] = (bf16)(cvt_pk_bf16(acc, acc) & 0xffffu); }
            if (sstep == 15) { *(LAS f32x4*)(sred + srq * 512 + sc4) = so; if (sidx == 0) RET_S_SETUP(1); }
            if (c + 1 < SEQ / 64) RET_S_LOAD((c + 1) & 15);
        }
#pragma unroll
        for (int i = 0; i < 4; ++i) { const int pc = tid + 512 * i, row = pc >> 5, c16 = pc & 31;
            *(LAS v4u*)(F.lds + CfRet::QA + row * 528 + c16 * 16) = qr[i]; *(LAS v4u*)(F.lds + CfRet::KA + row * 528 + c16 * 16) = kr[i]; }
        { const int row = tid >> 3, c16 = tid & 7; *(LAS v4u*)(F.lds + CfRet::V + row * 144 + c16 * 16) = vr;
          float f[8]; unpack8(vr, f);
#pragma unroll
          for (int e = 0; e < 8; ++e) f[e] *= vsc;
          *(LAS v4u*)(F.lds + CfRet::VB + row * 144 + c16 * 16) = pack8(f); }
        if (c + 1 < SEQ / 64) { const size_t r0 = (size_t)(c + 1) * 64;
#pragma unroll
            for (int i = 0; i < 4; ++i) { const int pc = tid + 512 * i, row = pc >> 5, c16 = pc & 31; qr[i] = *(const GAS v4u*)(qg + (r0 + row) * 1024 + c16 * 8); kr[i] = *(const GAS v4u*)(kg + (r0 + row) * 1024 + c16 * 8); }
            vr = *(const GAS v4u*)(vg + (r0 + (tid >> 3)) * 2048 + (tid & 7) * 8); }
        LDS_BARRIER();
        rec_step<CfRet>(F.lds, F.wave, F.lane, S, cum, out, c * 64);
    }
#undef RET_S_SETUP
#undef RET_S_LOAD
    if (fuse) { __syncthreads();
        const float acc = (sred[tid] + sred[512 + tid]) + (sred[1024 + tid] + sred[1536 + tid]);
        RO[srow * 2048 + shh * 512 + tid] = (bf16)(cvt_pk_bf16(acc, acc) & 0xffffu); }
    rec_store_state<CfRet>(F, S, st_out + ((size_t)(b * 4 + h) * 256) * 512 + vs * 64, 512);
}
static_assert(CfRet::END + 4096 + 8192 <= SCR_BYTES, "ret lds + sample stream");
__device__ __forceinline__ void ret_sample_items(Frame& F, const bf16* Q, const bf16* K, const bf16* V, bf16* RO, const float* st_in, float* st_out) {
    LAS float* qk = (LAS float*)F.lds; LAS float* red = qk + 512;
    const int tid = F.tid, lane = F.lane, w = F.wave;
    for (int item = F.vcu; item < MS * 4; item += F.G) {
        const int bs = item >> 2, h = item & 3; const size_t row = MPR + bs;
        __syncthreads();
        qk[tid] = tid < 256 ? bf2f(Q[row * 1024 + h * 256 + tid]) : bf2f(K[row * 1024 + h * 256 + (tid - 256)]);
        float v[8]; unpack8(*(const GAS v4u*)(V + row * 2048 + h * 512 + 8 * lane), v);
        __syncthreads();
        const float g = 1.f - exp2f(-5.f - (float)h);
        const float* sin = st_in + ((size_t)(bs * 4 + h) * 256) * 512 + 8 * lane; float* sout = st_out + ((size_t)(bs * 4 + h) * 256) * 512 + 8 * lane;
        float o[8];
#pragma unroll
        for (int e = 0; e < 8; ++e) o[e] = 0.f;
#pragma unroll 8
        for (int r = 0; r < 32; ++r) { const int kk = 32 * w + r;
            f32x4 s0 = __builtin_nontemporal_load((const GAS f32x4*)(sin + (size_t)kk * 512)), s1 = __builtin_nontemporal_load((const GAS f32x4*)(sin + (size_t)kk * 512 + 4));
            const float kf = qk[256 + kk], qf = qk[kk];
#pragma unroll
            for (int e = 0; e < 4; ++e) { s0[e] = g * s0[e] + kf * v[e]; s1[e] = g * s1[e] + kf * v[4 + e]; o[e] += s0[e] * qf; o[4 + e] += s1[e] * qf; }
            __builtin_nontemporal_store(s0, (GAS f32x4*)(sout + (size_t)kk * 512)); __builtin_nontemporal_store(s1, (GAS f32x4*)(sout + (size_t)kk * 512 + 4)); }
#pragma unroll
        for (int e = 0; e < 8; ++e) red[w * 512 + 8 * lane + e] = o[e];
        __syncthreads();
        float acc = 0.f;
#pragma unroll
        for (int ww = 0; ww < 8; ++ww) acc += red[ww * 512 + tid];
        RO[row * 2048 + h * 512 + tid] = (bf16)(cvt_pk_bf16(acc, acc) & 0xffffu);
    }
    __syncthreads();
}

struct CfSsd { static constexpr int C = 64, KD = 128, VS = 64, KPW = 1, RSK = 272, RSV = 144, RSP = 144; static constexpr bool CH = false;
    static constexpr int QA = 0, KA = 17408, QB = QA, KB = KA, V = 34816, VB = 44032, PM = 53248, ST = 62464, XS = 79872, CUM = 89088, DTV = 89600, RAW = 90112, RSR = 656, DS = 0, END = RAW + 67 * 656; };
static_assert(CfSsd::END + 8 * 320 * 4 <= SCR_BYTES, "ssd lds + sample scratch");
struct SsdOut { bf16* dst; const LAS unsigned char* xs; float Dh;
    __device__ __forceinline__ void operator()(int tok, int i, int vv0, const f32x4 o) const {
        const v2u xw = *(const LAS v2u*)(xs + i * 144 + vv0 * 2);
        const f32x4 x = (f32x4){bflo(xw.x), bfhi(xw.x), bflo(xw.y), bfhi(xw.y)};
        *(GAS v2u*)(dst + (size_t)tok * 2048 + vv0) = pack4v(o + x * Dh); } };
__device__ __forceinline__ int ssd_gcol(int lch, int head, int grp) { return lch < 64 ? head * 64 + lch : (lch < 192 ? 2048 + grp * 128 + (lch - 64) : 2560 + grp * 128 + (lch - 192)); }
__device__ __forceinline__ void ssd_preconv(Frame& F, const bf16* XBC, bf16* CBC, const float* conv_w, const float* conv_b, bool panel) {
    const int gw = F.vcu * NWAVES + F.wave, NGW = F.G * NWAVES, lane = F.lane;
#pragma unroll 1
    for (int rb = panel ? panel_row0(F) : gw * 8; rb < MPR; rb += panel ? MPR : NGW * 8) {
        const int t0 = rb & (SEQ - 1);
#pragma unroll 1
        for (int pass = 0; pass < 2; ++pass) {
            const int col = 8 * (lane + 64 * pass);
            float wr[4][8], br[8];
#pragma unroll
            for (int e = 0; e < 8; ++e) { br[e] = conv_b[2048 + col + e];
#pragma unroll
                for (int tap = 0; tap < 4; ++tap) wr[tap][e] = conv_w[tap * 3072 + 2048 + col + e]; }
            v4u x[11];
#pragma unroll
            for (int q = 0; q < 11; ++q) { x[q] = (v4u){0u, 0u, 0u, 0u}; if (t0 - 3 + q >= 0) x[q] = *(const GAS v4u*)(XBC + (size_t)(rb - 3 + q) * 3072 + 2048 + col); }
            float win[3][8];
#pragma unroll
            for (int q = 0; q < 3; ++q) unpack8(x[q], win[q]);
#pragma unroll
            for (int i = 0; i < 8; ++i) { float x3[8], acc[8]; unpack8(x[i + 3], x3);
#pragma unroll
                for (int e = 0; e < 8; ++e) { acc[e] = br[e] + win[0][e] * wr[0][e] + win[1][e] * wr[1][e] + win[2][e] * wr[2][e] + x3[e] * wr[3][e]; acc[e] = siluf_(acc[e]);
                    win[0][e] = win[1][e]; win[1][e] = win[2][e]; win[2][e] = x3[e]; }
                *(GAS v4u*)(CBC + (size_t)(rb + i) * 1024 + col) = pack8(acc); }
        }
    }
}
template <bool fuse>
__device__ __forceinline__ void ssd_prompt_item(Frame& F, int item, const bf16* XBC, const bf16* CBC, const float* DT, bf16* T, float* st_out,
                                                const float* conv_w, const float* conv_b, const float* dt_bias, const float* a_log, const float* d_skip,
                                                const float* sst_in, float* sst_out, const float* conv_st) {
    const int b = item >> 5, head = item & 31, grp = head >> 3, tid = F.tid, lane = F.lane, w = F.wave;
    const float a = -expf(a_log[head]), dtb = dt_bias[head], Dh = d_skip[head];
    LAS float* cumb = (LAS float*)(F.lds + CfSsd::CUM); LAS float* dtvb = (LAS float*)(F.lds + CfSsd::DTV);
    __syncthreads();
    f32x4 S[CfSsd::KPW][4];
    rec_zero_state<CfSsd>(F, S);
    const bf16* xg = XBC + (size_t)(b * SEQ) * 3072; const float* dtg = DT + (size_t)(b * SEQ) * 32 + head;
    const SsdOut out{T + (size_t)(b * SEQ) * 2048 + head * 64, F.lds + CfSsd::XS, Dh};
    const int cg = tid & 7, tkx = tid >> 3, gcolc = head * 64 + 8 * cg;
    float wr[4][8], br[8];
#pragma unroll
    for (int e = 0; e < 8; ++e) { br[e] = conv_b[gcolc + e];
#pragma unroll
        for (int tap = 0; tap < 4; ++tap) wr[tap][e] = conv_w[tap * 3072 + gcolc + e]; }
    const bf16* cbg = CBC + (size_t)(b * SEQ) * 1024 + grp * 128;
    v4u raw[2], bc[4];
#define SSD_LOAD_RAW(cc) do { const int tk_ = (cc) * 64 - 3 + tkx; raw[0] = (v4u){0u, 0u, 0u, 0u}; raw[1] = raw[0]; \
        if (tk_ >= 0) raw[0] = *(const GAS v4u*)(xg + (long)tk_ * 3072 + gcolc); if (tid < 24) raw[1] = *(const GAS v4u*)(xg + (long)(tk_ + 64) * 3072 + gcolc); \
        _Pragma("unroll") for (int j_ = 0; j_ < 4; ++j_) { const int p_ = tid + 512 * j_, cb_ = p_ & 31; \
            bc[j_] = *(const GAS v4u*)(cbg + (size_t)((cc) * 64 + (p_ >> 5)) * 1024 + (cb_ < 16 ? cb_ * 8 : 512 + (cb_ - 16) * 8)); } } while (0)
#define SSD_CUM(cc) do { if (w == 0) { const float dtv_ = softplusf_(dtn + dtb); float v_ = dtv_ * a; \
        _Pragma("unroll") for (int o_ = 1; o_ < 64; o_ <<= 1) { const float u_ = __shfl_up(v_, o_); if (lane >= o_) v_ += u_; } cumb[((cc) & 1) * 64 + lane] = v_; dtvb[((cc) & 1) * 64 + lane] = dtv_; } } while (0)
    float dtn = 0.f;
    if (w == 0) dtn = dtg[(size_t)lane * 32];
    SSD_CUM(0);
    if (w == 0) dtn = dtg[(size_t)(64 + lane) * 32];
    SSD_LOAD_RAW(0);
    LAS float* sscr = (LAS float*)(F.lds + CfSsd::END) + w * 320;
    const int sgw = F.vcu * NWAVES + w, sv4 = (lane & 15) * 4, skq = lane >> 4;
    f32x4 sxs = (f32x4){0.f, 0.f, 0.f, 0.f}, sxd = sxs, sy = sxs, sst[2]; float sdA = 0.f, sDh = 0.f; const float* sin = sst_in; float* sout = sst_out; size_t srow = 0; int shead = 0;
#define SSD_S_SETUP(si) do { const int sit_ = sgw + 2048 * (si), bs_ = sit_ >> 5; shead = sit_ & 31; const int sgrp_ = shead >> 3; srow = MPR + bs_; \
        _Pragma("unroll 1") for (int r_ = 0; r_ < 5; ++r_) { const int lch_ = lane + 64 * r_, gch_ = ssd_gcol(lch_, shead, sgrp_); float acc_ = conv_b[gch_]; \
            _Pragma("unroll") for (int tap_ = 0; tap_ < 3; ++tap_) acc_ += conv_st[((size_t)bs_ * 3 + tap_) * 3072 + gch_] * conv_w[tap_ * 3072 + gch_]; \
            acc_ += bf2f(XBC[srow * 3072 + gch_]) * conv_w[3 * 3072 + gch_]; sscr[lch_] = siluf_(acc_); } \
        LDS_WAIT(); \
        const float dtv_ = softplusf_(DT[srow * 32 + shead] + dt_bias[shead]); sdA = __expf(dtv_ * -expf(a_log[shead])); sDh = d_skip[shead]; \
        sxs = (f32x4){sscr[sv4], sscr[sv4 + 1], sscr[sv4 + 2], sscr[sv4 + 3]}; sxd = sxs * dtv_; sy = (f32x4){0.f, 0.f, 0.f, 0.f}; \
        sin = sst_in + ((size_t)(bs_ * 32 + shead) * 128) * 64 + sv4; sout = sst_out + ((size_t)(bs_ * 32 + shead) * 128) * 64 + sv4; } while (0)
#define SSD_S_LOAD(st_) do { _Pragma("unroll") for (int k_ = 0; k_ < 2; ++k_) sst[k_] = __builtin_nontemporal_load((const GAS f32x4*)(sin + (size_t)(8 * (st_) + 4 * k_ + skq) * 64)); } while (0)
    if (fuse) { SSD_S_SETUP(0); SSD_S_LOAD(0); }
    for (int c = 0; c < SEQ / 64; ++c) {
        if (fuse) { const int sidx = c >> 4, sstep = c & 15;
#pragma unroll
            for (int k = 0; k < 2; ++k) { const int kk = 8 * sstep + 4 * k + skq;
                const f32x4 s = sst[k] * sdA + sxd * sscr[64 + kk];
                __builtin_nontemporal_store(s, (GAS f32x4*)(sout + (size_t)kk * 64)); sy = sy + s * sscr[192 + kk]; }
            if (sstep == 15) {
#pragma unroll
                for (int e = 0; e < 4; ++e) { sy[e] += __shfl_xor(sy[e], 16); sy[e] += __shfl_xor(sy[e], 32); }
                if (lane < 16) *(GAS v2u*)(T + srow * 2048 + shead * 64 + sv4) = pack4v(sy + sxs * sDh);
                LDS_WAIT();
                if (sidx == 0) SSD_S_SETUP(1); }
            if (c + 1 < SEQ / 64) SSD_S_LOAD((c + 1) & 15);
        }
        *(LAS v4u*)(F.lds + CfSsd::RAW + tkx * CfSsd::RSR + cg * 16) = raw[0]; if (tid < 24) *(LAS v4u*)(F.lds + CfSsd::RAW + (64 + tkx) * CfSsd::RSR + cg * 16) = raw[1];
        v4u bcc[4];
#pragma unroll
        for (int j = 0; j < 4; ++j) bcc[j] = bc[j];
        if (c + 1 < SEQ / 64) { SSD_CUM(c + 1); if (w == 0 && c + 2 < SEQ / 64) dtn = dtg[(size_t)((c + 2) * 64 + lane) * 32]; SSD_LOAD_RAW(c + 1); }
        LDS_BARRIER();
        const LAS float* cum = cumb + (c & 1) * 64; const LAS float* dtv = dtvb + (c & 1) * 64; const float tot = cum[63];
        {
            const int i = tkx; float x0[8], x1[8], x2[8], x3[8], acc[8];
            unpack8(*(const LAS v4u*)(F.lds + CfSsd::RAW + (i + 0) * CfSsd::RSR + cg * 16), x0); unpack8(*(const LAS v4u*)(F.lds + CfSsd::RAW + (i + 1) * CfSsd::RSR + cg * 16), x1);
            unpack8(*(const LAS v4u*)(F.lds + CfSsd::RAW + (i + 2) * CfSsd::RSR + cg * 16), x2); unpack8(*(const LAS v4u*)(F.lds + CfSsd::RAW + (i + 3) * CfSsd::RSR + cg * 16), x3);
#pragma unroll
            for (int e = 0; e < 8; ++e) { acc[e] = br[e] + x0[e] * wr[0][e] + x1[e] * wr[1][e] + x2[e] * wr[2][e] + x3[e] * wr[3][e]; acc[e] = siluf_(acc[e]); }
            const float dv = dtv[i], wj = dv * __expf(tot - cum[i]);
            *(LAS v4u*)(F.lds + CfSsd::XS + i * 144 + cg * 16) = pack8(acc);
            float f[8];
#pragma unroll
            for (int e = 0; e < 8; ++e) f[e] = acc[e] * dv;
            *(LAS v4u*)(F.lds + CfSsd::V + i * 144 + cg * 16) = pack8(f);
#pragma unroll
            for (int e = 0; e < 8; ++e) f[e] = acc[e] * wj;
            *(LAS v4u*)(F.lds + CfSsd::VB + i * 144 + cg * 16) = pack8(f);
#pragma unroll
            for (int j = 0; j < 4; ++j) { const int p = tid + 512 * j, row = p >> 5, cb = p & 31;
                *(LAS v4u*)(F.lds + (cb < 16 ? CfSsd::KA + row * 272 + cb * 16 : CfSsd::QA + row * 272 + (cb - 16) * 16)) = bcc[j]; }
        }
        LDS_BARRIER();
        rec_step<CfSsd>(F.lds, w, lane, S, cum, out, c * 64);
    }
#undef SSD_CUM
#undef SSD_LOAD_RAW
#undef SSD_S_SETUP
#undef SSD_S_LOAD
    rec_store_state<CfSsd>(F, S, st_out + ((size_t)(b * 32 + head) * 128) * 64, 64);
}
__device__ __forceinline__ void ssd_sample_items(Frame& F, const bf16* XBC, const float* DT, bf16* T, const float* st_in, float* st_out, const float* conv_st,
                                                 const float* conv_w, const float* conv_b, const float* dt_bias, const float* a_log, const float* d_skip) {
    const int gw = F.vcu * NWAVES + F.wave, NGW = F.G * NWAVES, lane = F.lane;
    LAS float* scr = (LAS float*)(F.lds + F.wave * 2048);
    __syncthreads();
    for (int item = gw; item < MS * 32; item += NGW) {
        const int bs = item >> 5, head = item & 31, grp = head >> 3; const size_t row = MPR + bs;
        asm volatile("" ::: "memory");
#pragma unroll
        for (int r = 0; r < 5; ++r) { const int lch = lane + 64 * r, gch = ssd_gcol(lch, head, grp);
            float acc = conv_b[gch];
#pragma unroll
            for (int tap = 0; tap < 3; ++tap) acc += conv_st[((size_t)bs * 3 + tap) * 3072 + gch] * conv_w[tap * 3072 + gch];
            acc += bf2f(XBC[row * 3072 + gch]) * conv_w[3 * 3072 + gch];
            scr[lch] = siluf_(acc); }
        LDS_WAIT();
        const float dtv = softplusf_(DT[row * 32 + head] + dt_bias[head]), dA = __expf(dtv * -expf(a_log[head])), Dh = d_skip[head];
        const int v4 = (lane & 15) * 4, kq = lane >> 4;
        const f32x4 xs4 = (f32x4){scr[v4], scr[v4 + 1], scr[v4 + 2], scr[v4 + 3]}, xd = xs4 * dtv;
        const float* sin = st_in + ((size_t)(bs * 32 + head) * 128) * 64 + v4; float* sout = st_out + ((size_t)(bs * 32 + head) * 128) * 64 + v4;
        f32x4 y = (f32x4){0.f, 0.f, 0.f, 0.f};
#pragma unroll 8
        for (int i = 0; i < 32; ++i) { const int kk = 4 * i + kq;
            f32x4 s = __builtin_nontemporal_load((const GAS f32x4*)(sin + (size_t)kk * 64));
            s = s * dA + xd * scr[64 + kk];
            __builtin_nontemporal_store(s, (GAS f32x4*)(sout + (size_t)kk * 64));
            y = y + s * scr[192 + kk]; }
#pragma unroll
        for (int e = 0; e < 4; ++e) { y[e] += __shfl_xor(y[e], 16); y[e] += __shfl_xor(y[e], 32); }
        if (lane < 16) *(GAS v2u*)(T + row * 2048 + head * 64 + v4) = pack4v(y + xs4 * Dh);
        LDS_WAIT();
    }
    __syncthreads();
}
__device__ __forceinline__ void ssd_conv_out(Frame& F, const bf16* XBC, const float* conv_st, float* outp, float* outs) {
    const int NP_ = BP * 3 * 3072, NS_ = MS * 3 * 3072;
    for (int idx = F.vcu * 512 + F.tid; idx < NP_ + NS_; idx += F.G * 512) {
        if (idx < NP_) { const int b = idx / 9216, rem = idx - b * 9216, wi = rem / 3072, ch = rem - wi * 3072; outp[idx] = bf2f(XBC[(size_t)(b * SEQ + SEQ - 3 + wi) * 3072 + ch]); }
        else { const int k = idx - NP_, bs = k / 9216, rem = k - bs * 9216, wi = rem / 3072, ch = rem - wi * 3072;
            outs[k] = wi < 2 ? conv_st[((size_t)bs * 3 + wi + 1) * 3072 + ch] : bf2f(XBC[(size_t)(MPR + bs) * 3072 + ch]); }
    }
}

template <int P> struct CfHgP { static constexpr int C = 32, KD = 128, VS = 32, KPW = 1, RSK = 272, RSV = 80, RSP = 80; static constexpr bool CH = true;
    static constexpr int BASE = P * 37888, QA = BASE, KA = BASE + 8704, QB = BASE + 17408, KB = BASE + 26112, V = BASE + 34816, VB = V, DS = BASE + 37376,
                         PM = 75776, ST = 78336, PART = 87040, CUM = 0, END = 87040 + 8 * 128 * 4; };
static_assert(CfHgP<1>::END + 8 * 1024 <= SCR_BYTES, "hgrn lds + sample scratch");
struct HgOut { bf16* dst;
    __device__ __forceinline__ void operator()(int tok, int i, int vv0, const f32x4 o) const { *(GAS v2u*)(dst + (size_t)tok * 1024 + vv0) = pack4v(o); } };
__device__ __forceinline__ void st_bf16_lds(LAS unsigned char* p, float x) { *(LAS unsigned short*)p = (unsigned short)(cvt_pk_bf16(x, x) & 0xffffu); }
typedef float f32x2_ __attribute__((ext_vector_type(2)));
template <int P>
__device__ __forceinline__ void hg_fill_images(LAS unsigned char* lds, const f32x2_ (&la)[4], const f32x2_ (&lc)[4], const unsigned (&qr)[4], const v4u vr, int tid) {
    typedef CfHgP<P> Cf;
    const int c2 = tid & 63, tg = tid >> 6;
    const LAS f32x2_* part = (const LAS f32x2_*)(lds + Cf::PART);
    f32x2_ off = (f32x2_){0.f, 0.f}, ref = off, tot = off;
#pragma unroll
    for (int g = 0; g < 8; ++g) { const f32x2_ pg = part[g * 64 + c2]; tot = tot + pg; if (g < 4) ref = ref + pg; const float m = (g < tg) ? 1.f : 0.f; off = off + pg * m; }
    const f32x2_ eref = (f32x2_){__expf(ref.x), __expf(ref.y)}, etr = (f32x2_){__expf(tot.x - ref.x), __expf(tot.y - ref.y)};
#pragma unroll
    for (int e = 0; e < 4; ++e) { const int i = 4 * tg + e; const f32x2_ cm = off + lc[e];
        const float d0 = fminf(fmaxf(cm.x - ref.x, -87.f), 87.f), d1 = fminf(fmaxf(cm.y - ref.y, -87.f), 87.f);
        const float qa0 = bflo(qr[e]) * __expf(d0), qa1 = bfhi(qr[e]) * __expf(d1);
        const float kb0 = (1.f - __expf(la[e].x)) * __expf(-d0), kb1 = (1.f - __expf(la[e].y)) * __expf(-d1);
        *(LAS unsigned*)(lds + Cf::QA + i * 272 + c2 * 4) = cvt_pk_bf16(qa0, qa1); *(LAS unsigned*)(lds + Cf::KA + i * 272 + c2 * 4) = cvt_pk_bf16(kb0, kb1);
        *(LAS unsigned*)(lds + Cf::QB + i * 272 + c2 * 4) = cvt_pk_bf16(qa0 * eref.x, qa1 * eref.y); *(LAS unsigned*)(lds + Cf::KB + i * 272 + c2 * 4) = cvt_pk_bf16(kb0 * etr.x, kb1 * etr.y); }
    if (tg == 0) ((LAS f32x2_*)(lds + Cf::DS))[c2] = eref * etr;
    if (tid < 128) *(LAS v4u*)(lds + Cf::V + (tid >> 2) * 80 + (tid & 3) * 16) = vr;
}
template <bool fuse>
__device__ __forceinline__ void hg_prompt_item(Frame& F, int item, const bf16* HQ, const float* LA, const bf16* HV, bf16* RO, float* st_out, const float* sst_in, float* sst_out) {
    typedef CfHgP<0> Cf0;
    const int b = item >> 5, h = (item >> 2) & 7, vs = item & 3, tid = F.tid, c2 = tid & 63, tg = tid >> 6, w = F.wave, lane = F.lane;
    LAS f32x2_* part = (LAS f32x2_*)(F.lds + Cf0::PART);
    constexpr int NCH = SEQ / 32;
    __syncthreads();
    f32x4 S[1][2];
    rec_zero_state<Cf0>(F, S);
    const size_t base = (size_t)(b * SEQ) * 1024 + h * 128;
    const HgOut out{RO + base + vs * 32};
    f32x2_ la[4], lc[4]; unsigned qr[4]; v4u vr = (v4u){0u, 0u, 0u, 0u};
#define HG_LOAD(cc) do { const size_t b2_ = base + (size_t)(cc) * 32 * 1024; _Pragma("unroll") for (int e_ = 0; e_ < 4; ++e_) { const size_t ix_ = b2_ + (size_t)(4 * tg + e_) * 1024 + 2 * c2; \
            la[e_] = *(const GAS f32x2_*)(LA + ix_); qr[e_] = *(const GAS unsigned*)(HQ + ix_); } \
        if (tid < 128) vr = *(const GAS v4u*)(HV + b2_ + (size_t)(tid >> 2) * 1024 + vs * 32 + (tid & 3) * 8); } while (0)
#define HG_CUMSUM() do { lc[0] = la[0]; _Pragma("unroll") for (int e_ = 1; e_ < 4; ++e_) lc[e_] = lc[e_ - 1] + la[e_]; part[tg * 64 + c2] = lc[3]; } while (0)
    HG_LOAD(0); HG_CUMSUM();
    LDS_BARRIER();
    hg_fill_images<0>(F.lds, la, lc, qr, vr, tid);
    HG_LOAD(1);
    LDS_BARRIER();
    f32x4 O[1];
    LAS float* sscr = (LAS float*)(F.lds + Cf0::END) + w * 256;
    const int sv4 = (lane & 15) * 4, skq = lane >> 4;
    f32x4 siv = (f32x4){0.f, 0.f, 0.f, 0.f}, so = siv, sst = siv; const float* sin = sst_in; float* sout = sst_out; size_t srb = 0; int svh = 0;
    if (fuse) { const int sit = F.vcu * NWAVES + w, bs = sit >> 4, sh = (sit >> 1) & 7; svh = sit & 1; srb = (size_t)(MPR + bs) * 1024 + sh * 128;
#pragma unroll
        for (int r = 0; r < 2; ++r) { const int k2 = lane + 64 * r; sscr[k2] = __expf(LA[srb + k2]); sscr[128 + k2] = bf2f(HQ[srb + k2]); }
        LDS_WAIT();
        const v2u iw = *(const GAS v2u*)(HV + srb + svh * 64 + sv4); siv = (f32x4){bflo(iw.x), bfhi(iw.x), bflo(iw.y), bfhi(iw.y)};
        sin = sst_in + ((size_t)(bs * 8 + sh) * 128) * 128 + svh * 64 + sv4; sout = sst_out + ((size_t)(bs * 8 + sh) * 128) * 128 + svh * 64 + sv4;
        sst = __builtin_nontemporal_load((const GAS f32x4*)(sin + (size_t)skq * 128)); }
#define HG_SAMPLE(cc) do { if (fuse && (cc) < 32) { const int kk_ = 4 * (cc) + skq; const float f_ = sscr[kk_]; \
        const f32x4 s_ = sst * f_ + siv * (1.f - f_); __builtin_nontemporal_store(s_, (GAS f32x4*)(sout + (size_t)kk_ * 128)); so = so + s_ * sscr[128 + kk_]; \
        if ((cc) == 31) { _Pragma("unroll") for (int e_ = 0; e_ < 4; ++e_) { so[e_] += __shfl_xor(so[e_], 16); so[e_] += __shfl_xor(so[e_], 32); } \
            if (lane < 16) *(GAS v2u*)(RO + srb + svh * 64 + sv4) = pack4v(so); } \
        else sst = __builtin_nontemporal_load((const GAS f32x4*)(sin + (size_t)(4 * ((cc) + 1) + skq) * 128)); } } while (0)
#define HG_STEP(P, cc) do { const bool more_ = (cc) + 1 < NCH; HG_SAMPLE(cc); \
        if (more_) HG_CUMSUM();                                      \
        rec_step_a<CfHgP<P>>(F.lds, w, lane, S, (const LAS float*)nullptr, O); \
        LDS_BARRIER(); \
        if (more_) { hg_fill_images<1 - P>(F.lds, la, lc, qr, vr, tid); if ((cc) + 2 < NCH) HG_LOAD((cc) + 2); } \
        rec_step_b<CfHgP<P>>(F.lds, w, lane, S, O, out, (cc) * 32); \
        LDS_BARRIER(); } while (0)
    for (int c = 0; c < NCH; c += 2) { HG_STEP(0, c); HG_STEP(1, c + 1); }
#undef HG_STEP
#undef HG_SAMPLE
#undef HG_CUMSUM
#undef HG_LOAD
    rec_store_state<Cf0>(F, S, st_out + ((size_t)(b * 8 + h) * 128) * 128 + vs * 32, 128);
}
__device__ __forceinline__ void hg_sample_items(Frame& F, const bf16* HQ, const float* LA, const bf16* HV, bf16* RO, const float* st_in, float* st_out) {
    const int gw = F.vcu * NWAVES + F.wave, NGW = F.G * NWAVES, lane = F.lane;
    LAS float* scr = (LAS float*)(F.lds + F.wave * 2048);
    __syncthreads();
    for (int item = gw; item < MS * 16; item += NGW) {
        const int bs = item >> 4, h = (item >> 1) & 7, vh = item & 1; const size_t rb = (size_t)(MPR + bs) * 1024 + h * 128;
        asm volatile("" ::: "memory");
#pragma unroll
        for (int r = 0; r < 2; ++r) { const int kk = lane + 64 * r; scr[kk] = __expf(LA[rb + kk]); scr[128 + kk] = bf2f(HQ[rb + kk]); }
        LDS_WAIT();
        const int v4 = (lane & 15) * 4, kq = lane >> 4;
        const v2u iw = *(const GAS v2u*)(HV + rb + vh * 64 + v4);
        const f32x4 iv = (f32x4){bflo(iw.x), bfhi(iw.x), bflo(iw.y), bfhi(iw.y)};
        const float* sin = st_in + ((size_t)(bs * 8 + h) * 128) * 128 + vh * 64 + v4; float* sout = st_out + ((size_t)(bs * 8 + h) * 128) * 128 + vh * 64 + v4;
        f32x4 o = (f32x4){0.f, 0.f, 0.f, 0.f};
#pragma unroll 8
        for (int i = 0; i < 32; ++i) { const int kk = 4 * i + kq; const float f = scr[kk];
            f32x4 s = __builtin_nontemporal_load((const GAS f32x4*)(sin + (size_t)kk * 128));
            s = s * f + iv * (1.f - f);
            __builtin_nontemporal_store(s, (GAS f32x4*)(sout + (size_t)kk * 128));
            o = o + s * scr[128 + kk]; }
#pragma unroll
        for (int e = 0; e < 4; ++e) { o[e] += __shfl_xor(o[e], 16); o[e] += __shfl_xor(o[e], 32); }
        if (lane < 16) *(GAS v2u*)(RO + rb + vh * 64 + v4) = pack4v(o);
        LDS_WAIT();
    }
    __syncthreads();
}

__device__ __forceinline__ void p0_transpose_item(const float* W, int K, int N, bf16* WT, LAS float* scr, int item, int lane, bool inter) {
    const int nblk = N / 32, kb = item / nblk, nb = item - kb * nblk, k0 = 64 * kb, n0 = 32 * nb;
    int s0 = n0; if (inter) { const int t = n0 >> 8, j = n0 & 255; s0 = j < 128 ? 128 * t + j : DFF + 128 * t + (j - 128); }
#pragma unroll 8
    for (int i = 0; i < 32; ++i) { const int kk = 2 * i + (lane >> 5); scr[kk * 33 + (lane & 31)] = W[(size_t)(k0 + kk) * N + s0 + (lane & 31)]; }
    LDS_WAIT(); asm volatile("" ::: "memory");
    const int c = lane & 7;
#pragma unroll
    for (int j = 0; j < 4; ++j) { const int n = (lane >> 3) + 8 * j; const LAS float* s = scr + (8 * c) * 33 + n;
        v4u o; o.x = cvt_pk_bf16(s[0 * 33], s[1 * 33]); o.y = cvt_pk_bf16(s[2 * 33], s[3 * 33]); o.z = cvt_pk_bf16(s[4 * 33], s[5 * 33]); o.w = cvt_pk_bf16(s[6 * 33], s[7 * 33]);
        *(GAS v4u*)(WT + (size_t)(n0 + n) * K + k0 + 8 * c) = o; }
    LDS_WAIT(); asm volatile("" ::: "memory");
}
__device__ __forceinline__ void p0_matrix(Frame& F, const float* W, int K, int N, bf16* WT, bool inter, int& itbase) {
    const int gw = F.vcu * NWAVES + F.wave, NGW = F.G * NWAVES, nit = (K / 64) * (N / 32);
    LAS float* scr = (LAS float*)(F.lds + F.wave * 16384);
    int first = (gw - itbase) % NGW; if (first < 0) first += NGW;
    for (int it = first; it < nit; it += NGW) p0_transpose_item(W, K, N, WT, scr, it, F.lane, inter);
    itbase += nit;
}

__device__ __forceinline__ void p1_ada_direct(Frame& F, const float* cp, const float* cs, const float* Wada, const float* bias, float* MOD) {
    constexpr int RS = 1040;
    static_assert(NCOND * RS <= SCR_BYTES, "P1 A half");
    const int w = F.wave, lane = F.lane, fr = lane & 15, fq = lane >> 4, tid = F.tid;
#pragma unroll 1
    for (int strip = F.vcu; strip < NMODALL / 96; strip += F.G) {
        const int layer = strip >> 6, n0 = 96 * (strip & 63) + 16 * w;
        const float* wp = Wada + (size_t)layer * D * NMOD + (size_t)(8 * fq) * NMOD + n0 + fr;
        f32x4 acc[9];
#pragma unroll
        for (int mt = 0; mt < 9; ++mt) acc[mt] = (f32x4){0.f, 0.f, 0.f, 0.f};
        float raw[2][4][8];
#define P1_LOAD(buf_, g_) do { if (w < 6) { _Pragma("unroll") for (int s_ = 0; s_ < 4; ++s_) _Pragma("unroll") for (int j_ = 0; j_ < 8; ++j_) \
            raw[buf_][s_][j_] = wp[(size_t)(32 * (4 * (g_) + s_) + j_) * NMOD]; } } while (0)
#define P1_MMA(buf_, gl_) do { if (w < 6) { _Pragma("unroll") for (int s_ = 0; s_ < 4; ++s_) { v4u wv_; \
            wv_.x = cvt_pk_bf16(raw[buf_][s_][0], raw[buf_][s_][1]); wv_.y = cvt_pk_bf16(raw[buf_][s_][2], raw[buf_][s_][3]); wv_.z = cvt_pk_bf16(raw[buf_][s_][4], raw[buf_][s_][5]); wv_.w = cvt_pk_bf16(raw[buf_][s_][6], raw[buf_][s_][7]); \
            const bf16x8 wf_ = __builtin_bit_cast(bf16x8, wv_); \
            _Pragma("unroll") for (int mt_ = 0; mt_ < 9; ++mt_) { const int row_ = (16 * mt_ + fr < NCOND) ? 16 * mt_ + fr : NCOND - 1; \
                const bf16x8 af_ = *(const LAS bf16x8*)(F.lds + row_ * RS + (4 * (gl_) + s_) * 64 + fq * 16); acc[mt_] = MFMA16(wf_, af_, acc[mt_]); } } } } while (0)
        P1_LOAD(0, 0);
#pragma unroll
        for (int h = 0; h < 2; ++h) {
            __syncthreads();
#pragma unroll
            for (int i = 0; i < (NCOND * 64) / 512; ++i) { const int p = tid + 512 * i, row = p >> 6, c16 = p & 63;
                const float* src = (row < BP ? cp + (size_t)row * D : cs + (size_t)(row - BP) * D) + 512 * h + c16 * 8;
                const f32x4 a = *(const GAS f32x4*)src, b = *(const GAS f32x4*)(src + 4);
                *(LAS v4u*)(F.lds + row * RS + c16 * 16) = pack8v(silu4(a), silu4(b)); }
            __syncthreads();
#pragma unroll
            for (int gl = 0; gl < 4; ++gl) { const int g = 4 * h + gl;
                if (g + 1 < 8) P1_LOAD((g + 1) & 1, g + 1);
                P1_MMA(g & 1, gl); }
        }
#undef P1_LOAD
#undef P1_MMA
        if (w < 6) { const int ncol = layer * NMOD + n0 + 4 * fq; const f32x4 bv = *(const GAS f32x4*)(bias + ncol);
#pragma unroll
            for (int mt = 0; mt < 9; ++mt) { const int row = 16 * mt + fr; if (row < NCOND) *(GAS f32x4*)(MOD + (size_t)row * NMODALL + ncol) = acc[mt] + bv; } }
    }
    __syncthreads();
}
static_assert((NCOND * 64) % 512 == 0 && NMOD % 96 == 0 && (NMOD / 96) == 64, "P1 strip geometry");

#ifndef REP_PROMPT
#define REP_PROMPT 1
#endif
#ifndef REP_PROMPT_SSD
#define REP_PROMPT_SSD REP_PROMPT
#endif
#ifndef REP_PROMPT_HG
#define REP_PROMPT_HG REP_PROMPT
#endif
#ifndef REP_SAMPLE
#define REP_SAMPLE 1
#endif
#ifndef REP_GEMM
#define REP_GEMM 1
#endif
#ifndef REP_GN
#define REP_GN 1
#endif
#ifndef REP_P0
#define REP_P0 1
#endif
#ifndef REP_SKINNY
#define REP_SKINNY 1
#endif
#ifndef REP_SK_ADA
#define REP_SK_ADA REP_SKINNY
#endif
#ifndef REP_SK_N1K
#define REP_SK_N1K REP_SKINNY
#endif
#define REPEAT(n) _Pragma("unroll 1") for (int rep_ = 0; rep_ < (n); ++rep_)
struct Args { const float* in[30]; float* out; unsigned char* ws; int ph_lo, ph_hi; };
enum { I_XP = 0, I_XS, I_CP, I_CS, I_SRET, I_SSSD, I_SCONV, I_SHG, I_WADA, I_BADA, I_NMPRE, I_NMPOST, I_NFPRE, I_NFPOST, I_RETIN, I_RETOUT, I_SSDIN, I_CONVW, I_CONVB, I_DTB, I_ALOG, I_SSDD,
       I_SSDNORM, I_SSDOUT, I_HGIN, I_HGLB, I_HGNORM, I_HGOUT, I_FFNIN, I_FFNOUT };
constexpr int N_PHASES = 3 + 8 * 4;

__global__ void __launch_bounds__(NWAVES * 64, 2) mk_fwd(Args args) {
    extern __shared__ __attribute__((aligned(16))) unsigned char lds_raw[];
    Frame F;
    F.lds = (LAS unsigned char*)lds_raw;
    F.tid = threadIdx.x; F.lane = F.tid & 63; F.wave = __builtin_amdgcn_readfirstlane(F.tid >> 6);
    F.G = gridDim.x; { const int bx = blockIdx.x; F.vcu = (F.G % 8 == 0) ? (bx % 8) * (F.G / 8) + bx / 8 : bx; }
    unsigned char* ws = args.ws;
    gu32* ctl = (gu32*)(ws + WS_CTL);
    for (int u = F.tid; u < (LDS_BYTES - LDSCTL_OFF) / 4; u += NWAVES * 64) ((LAS unsigned*)(F.lds + LDSCTL_OFF))[u] = 0u;
    __syncthreads();
    XcdBarrier bar; bar.bar = (unsigned*)(ctl + CW_BAR); bar.x = 0; bar.st = nullptr;
    if (MK_N_LAUNCHES == 1) bar = xcd_barrier_post((unsigned*)(ctl + CW_BAR), (volatile LAS unsigned*)(F.lds + LDSCTL_OFF) + 8);
    const int lo = args.ph_lo, hi = args.ph_hi;
#define IN(k) (lo <= (k) && (k) < hi)
#ifndef REP_BAR
#define REP_BAR 1
#endif
#define SEAM(k) do { if (IN((k) + 1)) { _Pragma("unroll") for (int rb_ = 0; rb_ < REP_BAR; ++rb_) xcd_barrier(bar); } } while (0)
#ifndef PF_B
#define PF_B 1
#endif
#define SEAM_PF(k, Bt_, N_, K_) do { if (IN((k) + 1)) { if (PF_B && MK_N_LAUNCHES == 1) xcd_barrier_pf(bar, F, (Bt_), (N_), (K_)); else xcd_barrier(bar); } } while (0)
#define BPRE(k) (PF_B && MK_N_LAUNCHES == 1 && IN((k) - 1) && IN(k))
    const bool ps_ = PANEL_SYNC && MK_N_LAUNCHES == 1 && F.G == 256;
    const int pm_ = panel_of_wg();
    gu32* const tmo_ = ctl + CW_BAR + XB_TMO;
#define SEAM_PANEL(k, seam, Bt_, N_, K_) do { if (IN((k) + 1)) { if (ps_) { panel_publish(F, ctl, (seam), pm_, (F.vcu < 16) ? 8u : 0u, !WT_ROW); panel_wait(F, panel_word(ctl, (seam), pm_), 4u, tmo_); } \
        else SEAM_PF(k, Bt_, N_, K_); } } while (0)
#define SEAM_PUB(k, seam, REL_, FALLBACK_) do { if (IN((k) + 1)) { if (ps_) panel_publish(F, ctl, (seam), pm_, 0u, (REL_)); else { FALLBACK_; } } } while (0)
#define PANEL_WAIT(k, seam) do { if (ps_ && IN((k) - 1)) panel_wait(F, panel_word(ctl, (seam), pm_), 4u, tmo_); } while (0)
#define SWAIT_ARG(k, seam) ((ps_ && IN((k) - 1)) ? panel_word(ctl, (seam), 65) : (gu32*)nullptr)
#define SAMPLE_WAIT(k, seam) do { if (ps_ && IN((k) - 1)) panel_wait(F, panel_word(ctl, (seam), 64), (unsigned)MS, tmo_); } while (0)
#define ALLWG_WAIT(k, seam) do { if (ps_ && IN((k) - 1)) panel_wait(F, panel_word(ctl, (seam), 65), 256u, tmo_); } while (0)
#define INP(i) (args.in[i])
    float* const out = args.out;
    float* const X = out + O_Y;
    bf16* const XB = (bf16*)(ws + WS_XB);
    bf16* const Hb = (bf16*)(ws + WS_H); bf16* const RO = (bf16*)(ws + WS_RO); bf16* const GO = (bf16*)(ws + WS_GO); bf16* const OUTB = (bf16*)(ws + WS_OUT); bf16* const ACT = (bf16*)(ws + WS_ACT);
    float* const MOD = (float*)(ws + WS_MOD); float* const LB = (float*)(ws + WS_LB);
    unsigned char* const PJ = ws + WS_PROJ;

    if (IN(0)) { REPEAT(REP_P0) {
        int itb = 0;
#pragma unroll 1
        for (int j = 0; j < 2; ++j) p0_matrix(F, INP(I_RETIN) + (size_t)j * D * RET_IN, D, RET_IN, (bf16*)(ws + WS_WRETIN) + (size_t)j * RET_IN * D, false, itb);
#pragma unroll 1
        for (int j = 0; j < 2; ++j) p0_matrix(F, INP(I_RETOUT) + (size_t)j * 2048 * D, 2048, D, (bf16*)(ws + WS_WRETOUT) + (size_t)j * D * 2048, false, itb);
        p0_matrix(F, INP(I_SSDIN), D, SSD_IN, (bf16*)(ws + WS_WSSDIN), false, itb);
        p0_matrix(F, INP(I_SSDOUT), 2048, D, (bf16*)(ws + WS_WSSDOUT), false, itb);
        p0_matrix(F, INP(I_HGIN), D, HG_IN, (bf16*)(ws + WS_WHGIN), false, itb);
        p0_matrix(F, INP(I_HGOUT), D, D, (bf16*)(ws + WS_WHGOUT), false, itb);
#pragma unroll 1
        for (int l = 0; l < 4; ++l) p0_matrix(F, INP(I_FFNIN) + (size_t)l * D * FFN_IN, D, FFN_IN, (bf16*)(ws + WS_WFFNIN) + (size_t)l * FFN_IN * D, true, itb);
#pragma unroll 1
        for (int l = 0; l < 4; ++l) p0_matrix(F, INP(I_FFNOUT) + (size_t)l * DFF * D, DFF, D, (bf16*)(ws + WS_WFFNOUT) + (size_t)l * D * DFF, false, itb);
        for (int idx = F.vcu * 512 + F.tid; idx < 1024; idx += F.G * 512) { const float* lg = INP(I_HGLB);
            const float l0 = lg[idx], l1 = lg[1024 + idx], l2 = lg[2048 + idx], l3 = lg[3072 + idx], m = fmaxf(fmaxf(l0, l1), fmaxf(l2, l3));
            const float e0 = expf(l0 - m), e1 = expf(l1 - m), e2 = expf(l2 - m), e3 = expf(l3 - m); LB[idx] = (e1 + e2) / ((e0 + e1) + (e2 + e3)); }
        }
        __syncthreads();
    }
    if (IN(1)) {
        REPEAT(REP_SK_ADA) p1_ada_direct(F, INP(I_CP), INP(I_CS), INP(I_WADA), INP(I_BADA), MOD);
        SEAM(1);
    }
    if (IN(2)) {
        resnorm_phase<0>(F, INP(I_XP), INP(I_XS), XB, X, nullptr, Hb, MOD, nullptr, 0, INP(I_NMPRE), 0 * NMOD + 0 * D, 0 * NMOD + 1 * D, ps_);
        SEAM_PANEL(2, 0, (const bf16*)(ws + WS_WRETIN), RET_IN, D);
    }

#ifndef STAGGER_TICKS
#define STAGGER_TICKS 0
#endif
#define GEMM_STAGGER(N_) do { if (STAGGER_TICKS > 0 && (N_) > 1024 && (blockIdx.x & 1)) { const unsigned long long t0_ = __builtin_amdgcn_s_memrealtime(); \
        while (__builtin_amdgcn_s_memrealtime() - t0_ < (unsigned long long)STAGGER_TICKS) __builtin_amdgcn_s_sleep(8); } } while (0)
#define MAIN_GEMM(PH_, PSK_, EmitT, eobj, Aptr, Btptr, N_, K_) do { GEMM_STAGGER(N_); pg8::Gemm g_{(const pg8::bf16_t*)(Aptr), (const pg8::bf16_t*)(Btptr), MPR, (N_), (K_)}; pg8::StaticOrder S_; S_.init(MPR, (N_), F.G, (int)blockIdx.x); \
        const EpiGen<EmitT> E_{eobj}; _Pragma("unroll") for (int rg_ = 0; rg_ < REP_GEMM; ++rg_) pg8::gemm_phase<EpiGen<EmitT>, pg8::StaticOrder, PG8_ALIGN, PG8_SP2>(F.lds, g_, S_, E_, BPRE(PH_) && !((PSK_) && ps_) && rg_ == 0); } while (0)
#define FFN_BLOCK(L, pb, LASTL, NXT_BT, NXT_N) do { \
    if (IN((pb) + 4)) { PANEL_WAIT((pb) + 4, 13 + 3 * (L)); resnorm_phase<1>(F, nullptr, nullptr, XB, X, OUTB, Hb, MOD, INP(I_NMPOST) + (L) * D, (L) * NMOD + 2 * D, INP(I_NFPRE) + (L) * D, (L) * NMOD + 3 * D, (L) * NMOD + 4 * D, ps_, SWAIT_ARG((pb) + 4, 13 + 3 * (L)), tmo_); SEAM_PANEL((pb) + 4, 2 + 3 * (L), (const bf16*)(ws + WS_WFFNIN) + (size_t)(L) * FFN_IN * D, FFN_IN, D); } \
    if (IN((pb) + 5)) { const bf16* wt_ = (const bf16*)(ws + WS_WFFNIN) + (size_t)(L) * FFN_IN * D; const EmitFfnIn e_{ACT}; \
        MAIN_GEMM((pb) + 5, 1, EmitFfnIn, e_, Hb, wt_, FFN_IN, D); SAMPLE_WAIT((pb) + 5, 2 + 3 * (L)); REPEAT(REP_SKINNY) skinny_gemm<8>(F, Hb + (size_t)MPR * D, D, 1, MS, MPR, wt_, (FFN_IN / 256) * 8, false, e_, F.G / 2, F.G / 2); SEAM_PUB((pb) + 5, 14 + 3 * (L), !WT_G3, SEAM_PF((pb) + 5, (const bf16*)(ws + WS_WFFNOUT) + (size_t)(L) * D * DFF, D, DFF)); } \
    if (IN((pb) + 6)) { const bf16* wt_ = (const bf16*)(ws + WS_WFFNOUT) + (size_t)(L) * D * DFF; const EmitOut e_{OUTB}; \
        PANEL_WAIT((pb) + 6, 14 + 3 * (L)); MAIN_GEMM((pb) + 6, 1, EmitOut, e_, ACT, wt_, D, DFF); if (ps_ && IN((pb) + 5)) panel_wait(F, panel_word(ctl, 14 + 3 * (L), 65), 256u, tmo_); REPEAT(REP_SK_N1K) skinny_gemm<2>(F, ACT + (size_t)MPR * DFF, DFF, 4, MS, MPR, wt_, (D / 256) * 8, false, e_, 0, F.G); SEAM_PUB((pb) + 6, 15 + 3 * (L), !WT_OUT, SEAM((pb) + 6)); } \
    if (IN((pb) + 7)) { PANEL_WAIT((pb) + 7, 15 + 3 * (L)); if (LASTL) resnorm_phase<2>(F, nullptr, nullptr, XB, X, OUTB, Hb, MOD, INP(I_NFPOST) + (L) * D, (L) * NMOD + 5 * D, nullptr, 0, 0, ps_, SWAIT_ARG((pb) + 7, 15 + 3 * (L)), tmo_); \
        else resnorm_phase<1>(F, nullptr, nullptr, XB, X, OUTB, Hb, MOD, INP(I_NFPOST) + (L) * D, (L) * NMOD + 5 * D, INP(I_NMPRE) + ((L) + 1) * D, ((L) + 1) * NMOD + 0 * D, ((L) + 1) * NMOD + 1 * D, ps_, SWAIT_ARG((pb) + 7, 15 + 3 * (L)), tmo_); \
        if (!(LASTL)) SEAM_PANEL((pb) + 7, 3 + 3 * (L), (NXT_BT), (NXT_N), D); } } while (0)
#define OUT_PROJ(L, pb, wt, K_) do { if (IN((pb) + 3)) { const EmitOut e_{OUTB}; MAIN_GEMM((pb) + 3, 1, EmitOut, e_, GO, (wt), D, (K_)); SAMPLE_WAIT((pb) + 3, 1 + 3 * (L)); REPEAT(REP_SK_N1K) skinny_gemm<2>(F, GO + (size_t)MPR * (K_), (K_), 4, MS, MPR, (wt), (D / 256) * 8, false, e_, 0, F.G); SEAM_PUB((pb) + 3, 13 + 3 * (L), !WT_OUT, SEAM((pb) + 3)); } } while (0)
#define RET_LAYER(L, J, pb) do { \
    bf16* const Qp_ = (bf16*)(PJ + PJ_RET_Q); bf16* const Kp_ = (bf16*)(PJ + PJ_RET_K); bf16* const Vp_ = (bf16*)(PJ + PJ_RET_V); bf16* const SGp_ = (bf16*)(PJ + PJ_RET_SG); \
    if (IN((pb) + 0)) { const bf16* wt_ = (const bf16*)(ws + WS_WRETIN) + (size_t)(J) * RET_IN * D; const EmitRetIn e_{Qp_, Kp_, Vp_, SGp_}; \
        MAIN_GEMM((pb) + 0, 1, EmitRetIn, e_, Hb, wt_, RET_IN, D); SAMPLE_WAIT((pb) + 0, 3 * (L)); REPEAT(REP_SKINNY) skinny_gemm<8>(F, Hb + (size_t)MPR * D, D, 1, MS, MPR, wt_, (RET_IN / 256) * 8, false, e_, 0, F.G); SEAM((pb) + 0); } \
    if (IN((pb) + 1)) { const bool fuse_ = (F.G == 256); const float* ssi_ = INP(I_SRET) + (size_t)(J) * 128 * 4 * 256 * 512; float* sso_ = out + O_RETS + (size_t)(J) * 128 * 4 * 256 * 512; \
        if (fuse_) { REPEAT(REP_PROMPT) ret_prompt_item<true>(F, F.vcu, Qp_, Kp_, Vp_, RO, out + O_RETP + (size_t)(J) * 8 * 4 * 256 * 512, ssi_, sso_); } \
        else { for (int item = F.vcu; item < 256; item += F.G) ret_prompt_item<false>(F, item, Qp_, Kp_, Vp_, RO, out + O_RETP + (size_t)(J) * 8 * 4 * 256 * 512, ssi_, sso_); \
            REPEAT(REP_SAMPLE) ret_sample_items(F, Qp_, Kp_, Vp_, RO, ssi_, sso_); } SEAM((pb) + 1); } \
    if (IN((pb) + 2)) { REPEAT(REP_GN) gatenorm_phase<0>(F, RO, SGp_, GO, nullptr, ps_); SEAM_PANEL((pb) + 2, 1 + 3 * (L), (const bf16*)(ws + WS_WRETOUT) + (size_t)(J) * D * 2048, D, 2048); } \
    OUT_PROJ(L, pb, (const bf16*)(ws + WS_WRETOUT) + (size_t)(J) * D * 2048, 2048); \
    } while (0)

    RET_LAYER(0, 0, 3);
    FFN_BLOCK(0, 3, false, (const bf16*)(ws + WS_WSSDIN), SSD_INM);
    {
        constexpr int pb = 11;
        bf16* const SZ_ = (bf16*)(PJ + PJ_SSD_SZ); bf16* const XBC_ = (bf16*)(PJ + PJ_SSD_XBC); float* const DT_ = (float*)(PJ + PJ_SSD_DT); bf16* const CBC_ = (bf16*)(PJ + PJ_SSD_CBC);
        if (IN(pb + 0)) { const bf16* wt_ = (const bf16*)(ws + WS_WSSDIN); const EmitSsdIn e_{SZ_, XBC_}; const EmitDt ed_{DT_};
            MAIN_GEMM(pb + 0, 1, EmitSsdIn, e_, Hb, wt_, SSD_INM, D); SAMPLE_WAIT(pb + 0, 3); ALLWG_WAIT(pb + 0, 3);
            REPEAT(REP_SKINNY) skinny_gemm<8>(F, Hb + (size_t)MPR * D, D, 1, MS, MPR, wt_, (SSD_INM / 256) * 8, false, e_, 0, F.G);
            REPEAT(REP_SKINNY) skinny_gemm<8>(F, Hb, D, MT / 128, MT, 0, wt_, 1, true, ed_, 0, F.G);
            if (ps_) { panel_publish(F, ctl, 25, pm_, 0u); panel_wait(F, panel_word(ctl, 25, pm_), 4u, tmo_); if (pm_ & 7) panel_wait(F, panel_word(ctl, 25, pm_ - 1), 4u, tmo_);
                ssd_preconv(F, XBC_, CBC_, INP(I_CONVW), INP(I_CONVB), true); }
            SEAM(pb + 0); }
        if (IN(pb + 1)) {
            if (!ps_) { ssd_preconv(F, XBC_, CBC_, INP(I_CONVW), INP(I_CONVB), false); if (MK_N_LAUNCHES == 1) xcd_barrier(bar); }
            if (F.G == 256) { REPEAT(REP_PROMPT_SSD) ssd_prompt_item<true>(F, F.vcu, XBC_, CBC_, DT_, RO, out + O_SSDP, INP(I_CONVW), INP(I_CONVB), INP(I_DTB), INP(I_ALOG), INP(I_SSDD), INP(I_SSSD), out + O_SSDS, INP(I_SCONV)); }
            else { for (int item = F.vcu; item < 256; item += F.G) ssd_prompt_item<false>(F, item, XBC_, CBC_, DT_, RO, out + O_SSDP, INP(I_CONVW), INP(I_CONVB), INP(I_DTB), INP(I_ALOG), INP(I_SSDD), INP(I_SSSD), out + O_SSDS, INP(I_SCONV));
                REPEAT(REP_SAMPLE) ssd_sample_items(F, XBC_, DT_, RO, INP(I_SSSD), out + O_SSDS, INP(I_SCONV), INP(I_CONVW), INP(I_CONVB), INP(I_DTB), INP(I_ALOG), INP(I_SSDD)); }
            ssd_conv_out(F, XBC_, INP(I_SCONV), out + O_CONVP, out + O_CONVS);
            SEAM(pb + 1); }
        if (IN(pb + 2)) { REPEAT(REP_GN) gatenorm_phase<1>(F, RO, SZ_, GO, INP(I_SSDNORM), ps_); SEAM_PANEL(pb + 2, 4, (const bf16*)(ws + WS_WSSDOUT), D, 2048); }
        OUT_PROJ(1, pb, (const bf16*)(ws + WS_WSSDOUT), 2048);
    }
    FFN_BLOCK(1, 11, false, (const bf16*)(ws + WS_WHGIN), HG_IN);
    {
        constexpr int pb = 19;
        bf16* const HQ_ = (bf16*)(PJ + PJ_HG_Q); float* const LA_ = (float*)(PJ + PJ_HG_LA); bf16* const HV_ = (bf16*)(PJ + PJ_HG_V); bf16* const HSG_ = (bf16*)(PJ + PJ_HG_SG);
        if (IN(pb + 0)) { const bf16* wt_ = (const bf16*)(ws + WS_WHGIN); const EmitHgIn e_{HQ_, HV_, HSG_, LA_, LB};
            MAIN_GEMM(pb + 0, 1, EmitHgIn, e_, Hb, wt_, HG_IN, D); SAMPLE_WAIT(pb + 0, 6); REPEAT(REP_SKINNY) skinny_gemm<8>(F, Hb + (size_t)MPR * D, D, 1, MS, MPR, wt_, (HG_IN / 256) * 8, false, e_, 0, F.G); SEAM(pb + 0); }
        if (IN(pb + 1)) {
            if (F.G == 256) { REPEAT(REP_PROMPT_HG) hg_prompt_item<true>(F, F.vcu, HQ_, LA_, HV_, RO, out + O_HGP, INP(I_SHG), out + O_HGS); }
            else { for (int item = F.vcu; item < 256; item += F.G) hg_prompt_item<false>(F, item, HQ_, LA_, HV_, RO, out + O_HGP, INP(I_SHG), out + O_HGS);
                REPEAT(REP_SAMPLE) hg_sample_items(F, HQ_, LA_, HV_, RO, INP(I_SHG), out + O_HGS); }
            SEAM(pb + 1); }
        if (IN(pb + 2)) { REPEAT(REP_GN) gatenorm_phase<2>(F, RO, HSG_, GO, INP(I_HGNORM), ps_); SEAM_PANEL(pb + 2, 7, (const bf16*)(ws + WS_WHGOUT), D, 1024); }
        OUT_PROJ(2, pb, (const bf16*)(ws + WS_WHGOUT), 1024);
    }
    FFN_BLOCK(2, 19, false, (const bf16*)(ws + WS_WRETIN) + (size_t)RET_IN * D, RET_IN);
    RET_LAYER(3, 1, 27);
    FFN_BLOCK(3, 27, true, (const bf16*)nullptr, 0);
#undef IN
#undef SEAM
}

extern "C" void kernel_launch(void* const* d_in, const int* in_sizes, int n_in, void* d_out, int out_size, void* d_ws, size_t ws_size, hipStream_t stream) {
    static int grid = 0;
    if (grid == 0) {
        if (n_in != 30 || (size_t)out_size != O_END || ws_size < WS_END) { fprintf(stderr, "kernel_launch: unexpected shapes (n_in %d out %d ws %zu)\n", n_in, out_size, ws_size); grid = -1; return; }
        int dev = 0, cus = 0, per_cu = 0;
        if (hipGetDevice(&dev) != hipSuccess || hipDeviceGetAttribute(&cus, hipDeviceAttributeMultiprocessorCount, dev) != hipSuccess) { grid = -1; return; }
        if (hipFuncSetAttribute((const void*)mk_fwd, hipFuncAttributeMaxDynamicSharedMemorySize, LDS_BYTES) != hipSuccess) { fprintf(stderr, "kernel_launch: hipFuncSetAttribute failed\n"); grid = -1; return; }
        if (hipOccupancyMaxActiveBlocksPerMultiprocessor(&per_cu, (const void*)mk_fwd, NWAVES * 64, LDS_BYTES) != hipSuccess || per_cu < 1) { fprintf(stderr, "kernel_launch: occupancy query says %d\n", per_cu); }
        (void)hipGetLastError();
        grid = cus;
    }
    if (grid < 0) return;
    if (hipMemsetAsync((char*)d_ws + WS_CTL, 0, CTL_ZERO_BYTES, stream) != hipSuccess) { fprintf(stderr, "kernel_launch: memset failed\n"); return; }
    Args a{};
    for (int i = 0; i < 30; ++i) a.in[i] = (const float*)d_in[i];
    a.out = (float*)d_out; a.ws = (unsigned char*)d_ws;
#if MK_N_LAUNCHES == 1
    a.ph_lo = 0; a.ph_hi = N_PHASES;
    hipLaunchKernelGGL(mk_fwd, dim3(grid), dim3(NWAVES * 64), LDS_BYTES, stream, a);
#else
    for (int p = 0; p < N_PHASES; ++p) { a.ph_lo = p; a.ph_hi = p + 1; hipLaunchKernelGGL(mk_fwd, dim3(grid), dim3(NWAVES * 64), LDS_BYTES, stream, a); }
#endif
    const hipError_t le = hipPeekAtLastError();
    if (le != hipSuccess) fprintf(stderr, "kernel_launch: launch failed: %s\n", hipGetErrorName(le));
}
```
